# Optimizing an MI355X kernel written in HIP

```python
import math
import jax, jax.numpy as jnp
from jax import lax
import numpy as np

D_MODEL = 1024
BATCH = 2
SEQ = 8192
DEPTH = 2

D_MIX = D_MODEL
A_WIDTH = D_MIX // 2
A_HEADS = 8
A_HEAD_DIM = A_WIDTH // A_HEADS
CHUNK = 128
B_HEADS = 8
B_HEAD_DIM = (D_MIX - A_WIDTH) // B_HEADS
B_KV_GROUPS = 2
B_HPG = B_HEADS // B_KV_GROUPS
CMP_BLOCK = 32
CMP_STRIDE = 16
SEL_BLOCK = 64
SEL_TOP = 16
WINDOW = 512
Q_BLOCK = 128
ROPE_THETA = 10000.0
KV_W = B_KV_GROUPS * B_HEAD_DIM
P_IN = 2 * A_WIDTH + B_HEADS * B_HEAD_DIM + 6 * KV_W + 3 * B_HEADS
N_EXPERTS = 32
TOP_K = 4
D_EXPERT = D_MODEL
SWIGLU_LIMIT = 7.0
SWIGLU_ALPHA = 1.702
EXPERT_ROWS = 256
NORM_EPS = 1e-6
ADA_SCALE = 0.5

kernel_name = "hybrid_sgu_nsa_moe_adaln"


def rms_norm(x, g):
    xf = x.astype(jnp.float32)
    y = xf * lax.rsqrt(jnp.mean(xf * xf, axis=-1, keepdims=True) + NORM_EPS)
    return (y * g.astype(jnp.float32)).astype(x.dtype)


def masked_softmax(s, mask):
    s = jnp.where(mask, s.astype(jnp.float32), -jnp.inf)
    m = jnp.max(s, axis=-1, keepdims=True)
    m = jnp.where(jnp.isfinite(m), m, 0.0)
    e = jnp.exp(s - m)
    d = jnp.sum(e, axis=-1, keepdims=True)
    return e / jnp.where(d > 0, d, 1.0)


def rope(x, pos):
    half = B_HEAD_DIM // 2
    inv = ROPE_THETA ** (-jnp.arange(half, dtype=jnp.float32) / half)
    ang = pos.astype(jnp.float32)[..., None] * inv
    cos = jnp.cos(ang)[:, :, None, :]
    sin = jnp.sin(ang)[:, :, None, :]
    xf = x.astype(jnp.float32)
    x1, x2 = xf[..., :half], xf[..., half:]
    return jnp.concatenate([x1 * cos - x2 * sin, x2 * cos + x1 * sin], axis=-1).astype(x.dtype)


def spatial_gating(u, v, ln_g, ln_b, w_s, b_s):
    b, s, _ = u.shape
    u = jax.nn.gelu(u)
    vf = jax.nn.gelu(v).astype(jnp.float32)
    mu = jnp.mean(vf, axis=-1, keepdims=True)
    var = jnp.mean(jnp.square(vf - mu), axis=-1, keepdims=True)
    v = ((vf - mu) * lax.rsqrt(var + NORM_EPS) * ln_g + ln_b).astype(u.dtype)
    v = v.reshape(b, s // CHUNK, CHUNK, A_HEADS, A_HEAD_DIM)
    causal = jnp.tril(jnp.ones((CHUNK, CHUNK), dtype=bool))
    w = jnp.where(causal[None], w_s, 0.0)
    mixed = jnp.einsum('hts,bcshd->bcthd', w, v) + b_s.T[:, :, None]
    return u * mixed.reshape(b, s, A_WIDTH)


def compress_tokens(tok, pe, w1, w2):
    b, s = tok.shape[:2]
    n_cmp = (s - CMP_BLOCK) // CMP_STRIDE + 1
    idx = CMP_STRIDE * jnp.arange(n_cmp)[:, None] + jnp.arange(CMP_BLOCK)[None, :]
    blk = tok[:, idx] + pe[:, None, :]
    blk = blk.transpose(0, 1, 3, 2, 4).reshape(b, n_cmp, B_KV_GROUPS, CMP_BLOCK * B_HEAD_DIM)
    return jax.nn.gelu(blk @ w1) @ w2


def cmp_to_sel_matrix(n_cmp, n_sel):
    cs = CMP_STRIDE * np.arange(n_cmp)[:, None]
    ce = cs + CMP_BLOCK
    ss = SEL_BLOCK * np.arange(n_sel)[None, :]
    se = ss + SEL_BLOCK
    ov = np.clip(np.minimum(ce, se) - np.maximum(cs, ss), 0, None) / CMP_STRIDE
    return jnp.asarray(ov, dtype=jnp.float32)


def native_sparse_attention(q, kc, vc, ks, vs, kw, vw, gate_logits, positions,
                            pe_k, pe_v, w1k, w2k, w1v, w2v):
    b, s = q.shape[:2]
    scale = B_HEAD_DIM ** -0.5
    n_cmp = (s - CMP_BLOCK) // CMP_STRIDE + 1
    n_sel = s // SEL_BLOCK
    n_top = min(SEL_TOP, n_sel)
    cmp_end = CMP_STRIDE * jnp.arange(n_cmp) + CMP_BLOCK - 1

    q = rope(q, positions)
    q5 = q.reshape(b, s, B_KV_GROUPS, B_HPG, B_HEAD_DIM)
    k_cmp = rope(compress_tokens(kc, pe_k, w1k, w2k), positions[:, cmp_end])
    v_cmp = compress_tokens(vc, pe_v, w1v, w2v)
    ks = rope(ks, positions)
    kw = rope(kw, positions)
    ks_blk = ks.reshape(b, n_sel, SEL_BLOCK, B_KV_GROUPS, B_HEAD_DIM).transpose(0, 3, 1, 2, 4)
    vs_blk = vs.reshape(b, n_sel, SEL_BLOCK, B_KV_GROUPS, B_HEAD_DIM).transpose(0, 3, 1, 2, 4)
    pad = ((0, 0), (WINDOW, 0), (0, 0), (0, 0))
    kw_pad = jnp.pad(kw, pad)
    vw_pad = jnp.pad(vw, pad)
    sel_map = cmp_to_sel_matrix(n_cmp, n_sel)
    gates = jax.nn.sigmoid(gate_logits.astype(jnp.float32))
    bi = jnp.arange(b)[:, None, None, None]
    gi = jnp.arange(B_KV_GROUPS)[None, :, None, None]

    def query_block(qb):
        q0 = qb * Q_BLOCK
        t = q0 + jnp.arange(Q_BLOCK)
        qblk = lax.dynamic_slice_in_dim(q5, q0, Q_BLOCK, axis=1)
        s1 = jnp.einsum('bqghd,bngd->bghqn', qblk, k_cmp) * scale
        m1 = (cmp_end[None, :] <= t[:, None])[None, None, None]
        p1 = masked_softmax(s1, m1)
        o_c = jnp.einsum('bghqn,bngd->bqghd', p1, v_cmp.astype(jnp.float32))
        imp = jnp.einsum('bghqn,nj->bgqj', p1, sel_map)
        cur = t // SEL_BLOCK
        j = jnp.arange(n_sel)
        valid = j[None, :] <= cur[:, None]
        forced = (j[None, :] == 0) | (j[None, :] == cur[:, None]) | (j[None, :] == cur[:, None] - 1)
        imp = jnp.where(valid, jnp.where(forced, jnp.inf, imp), -jnp.inf)
        _, sel = lax.top_k(imp, n_top)
        kg = ks_blk[bi, gi, sel]
        vg = vs_blk[bi, gi, sel]
        s2 = jnp.einsum('bqghd,bgqnkd->bghqnk', qblk, kg) * scale
        kpos = sel[..., None] * SEL_BLOCK + jnp.arange(SEL_BLOCK)
        m2 = (kpos <= t[None, None, :, None, None]).reshape(b, B_KV_GROUPS, 1, Q_BLOCK, n_top * SEL_BLOCK)
        p2 = masked_softmax(s2.reshape(b, B_KV_GROUPS, B_HPG, Q_BLOCK, n_top * SEL_BLOCK), m2)
        p2 = p2.reshape(b, B_KV_GROUPS, B_HPG, Q_BLOCK, n_top, SEL_BLOCK)
        o_s = jnp.einsum('bghqnk,bgqnkd->bqghd', p2, vg.astype(jnp.float32))
        kwb = lax.dynamic_slice_in_dim(kw_pad, q0, Q_BLOCK + WINDOW, axis=1)
        vwb = lax.dynamic_slice_in_dim(vw_pad, q0, Q_BLOCK + WINDOW, axis=1)
        spos = q0 - WINDOW + jnp.arange(Q_BLOCK + WINDOW)
        dlt = t[:, None] - spos[None, :]
        m3 = ((dlt >= 0) & (dlt < WINDOW) & (spos[None, :] >= 0))[None, None, None]
        s3 = jnp.einsum('bqghd,bkgd->bghqk', qblk, kwb) * scale
        p3 = masked_softmax(s3, m3)
        o_w = jnp.einsum('bghqk,bkgd->bqghd', p3, vwb.astype(jnp.float32))
        g = lax.dynamic_slice_in_dim(gates, q0, Q_BLOCK, axis=1).reshape(b, Q_BLOCK, B_KV_GROUPS, B_HPG, 3)
        o = g[..., 0:1] * o_c + g[..., 1:2] * o_s + g[..., 2:3] * o_w
        return o.reshape(b, Q_BLOCK, B_HEADS * B_HEAD_DIM).astype(q.dtype)

    out = lax.map(query_block, jnp.arange(s // Q_BLOCK))
    return jnp.moveaxis(out, 0, 1).reshape(b, s, B_HEADS * B_HEAD_DIM)


def clamped_swiglu(hdn):
    glu, lin = jnp.split(hdn, 2, axis=-1)
    glu = jnp.minimum(glu, SWIGLU_LIMIT)
    lin = jnp.clip(lin, -SWIGLU_LIMIT, SWIGLU_LIMIT)
    return glu * jax.nn.sigmoid(SWIGLU_ALPHA * glu) * (lin + 1.0)


def moe_ffn(h, router_w, router_b, w1, b1, w2, b2):
    b, s, d = h.shape
    n_tok = b * s
    xf = h.reshape(n_tok, d)
    logits = (xf @ router_w + router_b).astype(jnp.float32)
    top_val, top_idx = lax.top_k(logits, TOP_K)
    gates = jax.nn.softmax(top_val, axis=-1).astype(h.dtype)
    e_flat = top_idx.reshape(-1)
    tok_flat = jnp.repeat(jnp.arange(n_tok, dtype=jnp.int32), TOP_K)
    g_flat = gates.reshape(-1)
    n_assign = n_tok * TOP_K
    order = jnp.argsort(e_flat, stable=True)
    e_sorted = e_flat[order]
    counts = jnp.bincount(e_flat, length=N_EXPERTS)
    padded = ((counts + EXPERT_ROWS - 1) // EXPERT_ROWS) * EXPERT_ROWS
    pad_end = jnp.cumsum(padded)
    pad_start = pad_end - padded
    start = jnp.cumsum(counts) - counts
    dest = pad_start[e_sorted] + (jnp.arange(n_assign) - start[e_sorted])
    n_blocks = -(-n_assign // EXPERT_ROWS) + N_EXPERTS
    n_rows = n_blocks * EXPERT_ROWS
    row_tok = jnp.full((n_rows,), n_tok, dtype=jnp.int32).at[dest].set(tok_flat[order])
    row_gate = jnp.zeros((n_rows,), dtype=h.dtype).at[dest].set(g_flat[order])
    block_exp = jnp.minimum(jnp.searchsorted(pad_end, jnp.arange(n_blocks) * EXPERT_ROWS, side='right'),
                            N_EXPERTS - 1)
    x_pad = jnp.concatenate([xf, jnp.zeros((1, d), dtype=xf.dtype)], axis=0)
    rows = x_pad[row_tok].reshape(n_blocks, EXPERT_ROWS, d)

    def expert_block(args):
        xb, e = args
        return clamped_swiglu(xb @ w1[e] + b1[e]) @ w2[e] + b2[e]

    out = lax.map(expert_block, (rows, block_exp)).reshape(n_rows, d)
    y = jax.ops.segment_sum(out * row_gate[:, None], row_tok, num_segments=n_tok + 1)[:n_tok]
    return y.reshape(b, s, d)


def setup_inputs(seed: int = 0) -> dict:
    key = jax.random.key(seed)
    ks = jax.random.split(key, 32)
    nrm = jax.random.normal
    f32 = jnp.float32
    L, D, E, F, DK = DEPTH, D_MODEL, N_EXPERTS, D_EXPERT, B_HEAD_DIM
    offset = jax.random.randint(ks[2], (BATCH, 1), 0, 1024, dtype=jnp.int32)
    return {
        "x": nrm(ks[0], (BATCH, SEQ, D), f32),
        "c": nrm(ks[1], (BATCH, D), f32),
        "positions": offset + jnp.arange(SEQ, dtype=jnp.int32)[None, :],
        "ada_w": nrm(ks[3], (L, D, 6 * D), f32) * (ADA_SCALE * D ** -0.5),
        "ada_b": nrm(ks[4], (L, 6 * D), f32) * 0.02,
        "norm1_g": 1.0 + 0.02 * nrm(ks[5], (L, D), f32),
        "norm2_g": 1.0 + 0.02 * nrm(ks[6], (L, D), f32),
        "w_in": nrm(ks[7], (L, D, P_IN), f32) * D ** -0.5,
        "w_out": nrm(ks[8], (L, D_MIX, D), f32) * D_MIX ** -0.5,
        "sg_ln_g": 1.0 + 0.02 * nrm(ks[9], (L, A_WIDTH), f32),
        "sg_ln_b": 0.02 * nrm(ks[10], (L, A_WIDTH), f32),
        "sg_w": nrm(ks[11], (L, A_HEADS, CHUNK, CHUNK), f32) * CHUNK ** -0.5,
        "sg_b": 1.0 + 0.02 * nrm(ks[12], (L, A_HEADS, CHUNK), f32),
        "cmp_pe_k": 0.02 * nrm(ks[13], (L, CMP_BLOCK, DK), f32),
        "cmp_pe_v": 0.02 * nrm(ks[14], (L, CMP_BLOCK, DK), f32),
        "cmp_w1_k": nrm(ks[15], (L, CMP_BLOCK * DK, DK), f32) * (CMP_BLOCK * DK) ** -0.5,
        "cmp_w2_k": nrm(ks[16], (L, DK, DK), f32) * DK ** -0.5,
        "cmp_w1_v": nrm(ks[17], (L, CMP_BLOCK * DK, DK), f32) * (CMP_BLOCK * DK) ** -0.5,
        "cmp_w2_v": nrm(ks[18], (L, DK, DK), f32) * DK ** -0.5,
        "router_w": nrm(ks[19], (L, D, E), f32) * D ** -0.5,
        "router_b": 0.01 * nrm(ks[20], (L, E), f32),
        "exp_w1": nrm(ks[21], (L, E, D, 2 * F), f32) * D ** -0.5,
        "exp_b1": 0.02 * nrm(ks[22], (L, E, 2 * F), f32),
        "exp_w2": nrm(ks[23], (L, E, F, D), f32) * F ** -0.5,
        "exp_b2": 0.02 * nrm(ks[24], (L, E, D), f32),
        "final_g": 1.0 + 0.02 * nrm(ks[25], (D,), f32),
    }


def reference(x, c, positions, ada_w, ada_b, norm1_g, norm2_g, w_in, w_out,
              sg_ln_g, sg_ln_b, sg_w, sg_b, cmp_pe_k, cmp_pe_v, cmp_w1_k, cmp_w2_k,
              cmp_w1_v, cmp_w2_v, router_w, router_b, exp_w1, exp_b1, exp_w2, exp_b2, final_g):
    b, s, _ = x.shape
    offs = np.cumsum([A_WIDTH, A_WIDTH, B_HEADS * B_HEAD_DIM] + [KV_W] * 6).tolist()
    cond = jax.nn.silu(c)
    for l in range(DEPTH):
        mod = cond @ ada_w[l] + ada_b[l]
        sh1, sc1, g1, sh2, sc2, g2 = jnp.split(mod, 6, axis=-1)
        h = rms_norm(x, norm1_g[l]) * (1.0 + sc1[:, None, :]) + sh1[:, None, :]
        proj = h @ w_in[l]
        u, v, q, kc, vc, ksl, vsl, kwn, vwn, gl = jnp.split(proj, offs, axis=-1)
        kv = lambda t: t.reshape(b, s, B_KV_GROUPS, B_HEAD_DIM)
        y_a = spatial_gating(u, v, sg_ln_g[l], sg_ln_b[l], sg_w[l], sg_b[l])
        y_b = native_sparse_attention(
            q.reshape(b, s, B_HEADS, B_HEAD_DIM), kv(kc), kv(vc), kv(ksl), kv(vsl), kv(kwn), kv(vwn),
            gl.reshape(b, s, B_HEADS, 3), positions,
            cmp_pe_k[l], cmp_pe_v[l], cmp_w1_k[l], cmp_w2_k[l], cmp_w1_v[l], cmp_w2_v[l])
        mixed = jnp.concatenate([y_a, y_b], axis=-1) @ w_out[l]
        x = x + g1[:, None, :] * mixed
        h2 = rms_norm(x, norm2_g[l]) * (1.0 + sc2[:, None, :]) + sh2[:, None, :]
        x = x + g2[:, None, :] * moe_ffn(h2, router_w[l], router_b[l], exp_w1[l], exp_b1[l],
                                         exp_w2[l], exp_b2[l])
    return rms_norm(x, final_g)
```

```cpp
#include <hip/hip_runtime.h>
#include <cstdio>
#include <cstdint>

#ifndef SKIPMASK
#define SKIPMASK 0
#endif
#ifndef REPMASK
#define REPMASK 0
#endif
#ifndef NREP
#define NREP 3
#endif
#ifndef DUMMYINT
#define DUMMYINT 0
#endif
#ifndef ATTREP
#define ATTREP 0
#endif
#ifndef MK_PER_PHASE
#define MK_PER_PHASE 0
#endif

#define LAS __attribute__((address_space(3)))
typedef unsigned short bf16_t;
typedef short bf16x8 __attribute__((ext_vector_type(8)));
typedef float f32x4 __attribute__((ext_vector_type(4)));
typedef float f32x2 __attribute__((ext_vector_type(2)));
typedef float f32x16 __attribute__((ext_vector_type(16)));
typedef unsigned u32x4 __attribute__((ext_vector_type(4)));
typedef unsigned u32x2 __attribute__((ext_vector_type(2)));
typedef __bf16 bf16x2_t __attribute__((ext_vector_type(2)));
typedef int i32x4 __attribute__((ext_vector_type(4)));
typedef int i32x8 __attribute__((ext_vector_type(8)));

constexpr int BATCH = 2, SEQ = 8192, DM = 1024, T = BATCH * SEQ, DEPTH = 2;
constexpr int PIN = 2328, PINP = 2560;
constexpr int NE = 32, FF = 1024, TOPK = 4;
constexpr int NCMP = 511, NCMPP = 512;
constexpr float NORM_EPS = 1e-6f;
constexpr float W8SCALE = 64.f;
constexpr int W8_E8M0 = 0x79797979, ONE_E8M0 = 0x7f7f7f7f;
constexpr float QSCALE = 0.125f * 1.4426950408889634f;
constexpr int NWAVES = 8, NTHREADS = 512;

constexpr size_t MiB = 1u << 20;
constexpr size_t WS_CTL = 0, CTL_ZERO_BYTES = 1 * MiB;
constexpr size_t WS_WIN = 1 * MiB;
constexpr size_t WS_WOUT = 11 * MiB;
constexpr size_t WS_SGW = 15 * MiB;
constexpr size_t WS_CW1 = 15 * MiB + 512 * 1024;
constexpr size_t WS_ROPE = 17 * MiB;
constexpr size_t WS_RWP = 21 * MiB;
constexpr size_t WS_MISC = 21 * MiB + 512 * 1024;
constexpr size_t WS_W1T = 32 * MiB;
constexpr size_t WS_W2T = 288 * MiB;
constexpr size_t WS_XR = 416 * MiB;
constexpr size_t WS_H = 480 * MiB;
constexpr size_t WS_UG = 513 * MiB, WS_VG = 529 * MiB, WS_Q = 545 * MiB;
constexpr size_t WS_KC = 561 * MiB, WS_VC = 565 * MiB, WS_KS = 569 * MiB, WS_KW = 573 * MiB;
constexpr size_t WS_VST = 577 * MiB, WS_VWT = 581 * MiB;
constexpr size_t WS_GATES = 585 * MiB;
constexpr size_t WS_KCMP = 587 * MiB;
constexpr size_t WS_VCT = 587 * MiB + 512 * 1024;
constexpr size_t WS_Y = 588 * MiB;
constexpr size_t WS_TOK = 620 * MiB;
constexpr size_t WS_ASG = 622 * MiB;
constexpr size_t WS_GATE4 = 622 * MiB + 512 * 1024;
constexpr size_t WS_YPART = 912 * MiB;
constexpr size_t WS_CNTI = 623 * MiB;
constexpr size_t WS_ACT = 624 * MiB;
constexpr size_t WS_YROWS = 768 * MiB;
constexpr size_t WS_H8 = 944 * MiB;
constexpr size_t WS_END = 962 * MiB;
constexpr int CW_BAR = 4096;
constexpr int CW_MOD = 16384;
constexpr int CW_CNT = 40960;
constexpr int CW_KMAX = 41088;
constexpr int CW_GCNT = 41216;

__device__ __forceinline__ unsigned cvtpk(float lo, float hi) { f32x2 v = {lo, hi}; bf16x2_t b = __builtin_convertvector(v, bf16x2_t); return __builtin_bit_cast(unsigned, b); }
__device__ __forceinline__ unsigned cvt4_fp8(float a, float b, float c, float d) { int w = 0; w = __builtin_amdgcn_cvt_pk_fp8_f32(a, b, w, false); w = __builtin_amdgcn_cvt_pk_fp8_f32(c, d, w, true); return (unsigned)w; }
__device__ __forceinline__ float bf2f(unsigned short b) { return __uint_as_float((unsigned)b << 16); }
__device__ __forceinline__ float bflo(unsigned w) { return __uint_as_float(w << 16); }
__device__ __forceinline__ float bfhi(unsigned w) { return __uint_as_float(w & 0xffff0000u); }
__device__ __forceinline__ float fast_exp2(float x) { return __builtin_amdgcn_exp2f(x); }
__device__ __forceinline__ float fast_rcp(float x) { return __builtin_amdgcn_rcpf(x); }
__device__ __forceinline__ float sigmoidf_(float x) { return fast_rcp(1.f + fast_exp2(-1.4426950408889634f * x)); }
__device__ __forceinline__ float gelu_tanh(float x) { const float u = 0.7978845608028654f * (x + 0.044715f * x * x * x); return x * fast_rcp(1.f + fast_exp2(-2.885390081777927f * u)); }

__device__ __forceinline__ float x16_sum(float x) { auto r = __builtin_amdgcn_permlane16_swap(__float_as_uint(x), __float_as_uint(x), false, false); return __uint_as_float(r[0]) + __uint_as_float(r[1]); }
__device__ __forceinline__ float x32_sum(float x) { auto r = __builtin_amdgcn_permlane32_swap(__float_as_uint(x), __float_as_uint(x), false, false); return __uint_as_float(r[0]) + __uint_as_float(r[1]); }
__device__ __forceinline__ float x16_max(float x) { auto r = __builtin_amdgcn_permlane16_swap(__float_as_uint(x), __float_as_uint(x), false, false); return fmaxf(__uint_as_float(r[0]), __uint_as_float(r[1])); }
__device__ __forceinline__ float x32_max(float x) { auto r = __builtin_amdgcn_permlane32_swap(__float_as_uint(x), __float_as_uint(x), false, false); return fmaxf(__uint_as_float(r[0]), __uint_as_float(r[1])); }
__device__ __forceinline__ float kg_sum(float x) { return x32_sum(x16_sum(x)); }
__device__ __forceinline__ float kg_max(float x) { return x32_max(x16_max(x)); }
__device__ __forceinline__ float quad_sum(float x) { x += __uint_as_float(__builtin_amdgcn_update_dpp(0u, __float_as_uint(x), 0xB1, 0xF, 0xF, true)); x += __uint_as_float(__builtin_amdgcn_update_dpp(0u, __float_as_uint(x), 0x4E, 0xF, 0xF, true)); return x; }
__device__ __forceinline__ float wave_sum(float v) {
    v = quad_sum(v);
    v += __uint_as_float(__builtin_amdgcn_update_dpp(0u, __float_as_uint(v), 0x141, 0xF, 0xF, true));
    v += __uint_as_float(__builtin_amdgcn_update_dpp(0u, __float_as_uint(v), 0x140, 0xF, 0xF, true));
    return x32_sum(x16_sum(v));
}
#define LDS_WAIT() asm volatile("s_waitcnt lgkmcnt(0)" ::: "memory")
#define VM_WAIT() asm volatile("s_waitcnt vmcnt(0)" ::: "memory")

__device__ __forceinline__ int kfrag_off(int key, int c8) {
    const int s = key >> 5, ko = key & 31, u = (ko >> 2) & 1, r16 = ((ko >> 3) << 2) | (ko & 3), ks = c8 >> 2, kg = c8 & 3;
    return s * 2048 + (u * 2 + ks) * 512 + (kg * 16 + r16) * 8;
}
__device__ __forceinline__ int vfrag_off(int key, int d) {
    const int s = key >> 5, ko = key & 31;
    return s * 2048 + (d >> 4) * 512 + ((ko >> 3) * 16 + (d & 15)) * 8 + (ko & 7);
}
namespace pg8 {
constexpr int BM = 256, BK = 64, HALF = 128, HTB = HALF * BK * 2, STAGE_BYTES = 8 * HTB, NXCD = 8, WGM = 8;
__host__ __device__ __forceinline__ int lds_byte(int r, int c) { const int st = (r >> 4) * 2 + (c >> 5), rr = r & 15, cc = c & 31, ob = rr * 64 + cc * 2; return st * 1024 + (ob ^ (((ob >> 9) & 1) << 5)); }
__host__ __device__ __forceinline__ void stage_rc(int b, int& R, int& C) { const int st = b / 1024, sb = b % 1024, swz = sb ^ (((sb >> 9) & 1) << 5); R = (st >> 1) * 16 + swz / 64; C = (st & 1) * 32 + (swz % 64) / 2; }
__host__ __device__ __forceinline__ int perm32(int rho) { const int n = rho >> 4, i = rho & 15; return 8 * (i >> 2) + 4 * n + (i & 3); }

struct Unit { int pm, pn, e, pnl, rloc; };

struct DenseOrder {
    int nM, nN, nwg, G, c;
    __device__ void init(int M, int N, int G_, int c_) { nM = M / BM; nN = N / BM; nwg = nM * nN; G = G_; c = c_; }
    __device__ bool next(int i, Unit& u) const {
        const long L = (long)i * G + c; if (L >= nwg) return false;
        int wgid = (int)L; { const int q = nwg / NXCD, r = nwg % NXCD, xcd = wgid % NXCD, off = wgid / NXCD; wgid = (xcd < r ? xcd * (q + 1) : r * (q + 1) + (xcd - r) * q) + off; }
        const int nig = WGM * nN, gid = wgid / nig, fm = gid * WGM, gsz = (nM - fm) < WGM ? (nM - fm) : WGM;
        u.pm = fm + ((wgid % nig) % gsz); u.pn = (wgid % nig) / gsz; u.e = 0; u.pnl = u.pn; u.rloc = 0; return true;
    }
    __device__ __forceinline__ unsigned rowoff(const Unit&, int) const { return 0u; }
};

struct MoeOrder {
    const LAS int* ust;
    const LAS int* bst;
    const LAS int* cnt;
    const int* tok;
    int NT, G, c, total, rowbytes;
    __device__ bool next(int i, Unit& u) const {
        const int L = i * G + c; if (L >= total) return false;
        int e = 0;
        for (int k = 1; k < NE; ++k) e += (L >= ust[k]) ? 1 : 0;
        e = __builtin_amdgcn_readfirstlane(e);
        const int loc = __builtin_amdgcn_readfirstlane(L - ust[e]), b0 = __builtin_amdgcn_readfirstlane(bst[e]), nb = __builtin_amdgcn_readfirstlane(bst[e + 1]) - b0;
        u.e = e; u.pnl = loc / nb; u.rloc = loc - u.pnl * nb; u.pm = b0 + u.rloc; u.pn = e * NT + u.pnl; return true;
    }
    __device__ __forceinline__ unsigned rowoff(const Unit& u, int r) const {
        const int slot = u.rloc * 256 + r; const int tk = slot < cnt[u.e] ? tok[u.e * 16384 + slot] : T;
        return (unsigned)tk * (unsigned)rowbytes;
    }
};

template <class Epi, class Sched, bool GATHER, bool ALIGN_EPI, bool FP8 = false>
__device__ __forceinline__ void gemm_phase(LAS unsigned char* lds, const bf16_t* A, const bf16_t* Bt, const int K, const Sched& S, const Epi& E) {
    int tid_ = threadIdx.x; asm volatile("" : "+v"(tid_));
    const int tid = tid_, wid = __builtin_amdgcn_readfirstlane(tid >> 6), lane = tid & 63, wr = wid >> 2, wc = wid & 3, fr = lane & 15, fq = lane >> 4;
    const int nt = K / BK;
    int Rr[2], Cc[2]; unsigned voffB[2];
#pragma unroll
    for (int i = 0; i < 2; ++i) { int R, C; stage_rc(tid * 16 + i * 8192, R, C); Rr[i] = R; Cc[i] = C; const int Rb = Epi::PERM ? ((R & ~31) + perm32(R & 31)) : R; voffB[i] = (unsigned)(Rb * K + C) * 2u; }
    const size_t kstep = (size_t)(BK * 2);
    const size_t hstep = (size_t)HALF * K * 2;
    const size_t tstep = 2 * hstep;
    const unsigned ldsw = (unsigned)wid * 1024u;
    const int aoff = lds_byte(wr * 64 + fr, fq * 8), boff = lds_byte(wc * 32 + fr, fq * 8);
#define PG8_SA(b, h) (((b) * 2 + (h)) * HTB)
#define PG8_SB(b, h) ((4 + (b) * 2 + (h)) * HTB)
#define PG8_STAGE(bufoff, gbase, v0, v1) do { \
        __builtin_amdgcn_global_load_lds((const unsigned*)((const char*)(gbase) + (v0)), (LAS unsigned*)(lds + (bufoff) + ldsw), 16, 0, 0); \
        __builtin_amdgcn_global_load_lds((const unsigned*)((const char*)(gbase) + (v1)), (LAS unsigned*)(lds + (bufoff) + ldsw + 8192), 16, 0, 0); } while (0)
#define PG8_STAGEB(bufoff, gbase) PG8_STAGE(bufoff, gbase, voffB[0], voffB[1])
#define PG8_CAT8(x0, x1) __builtin_shufflevector(x0, x1, 0, 1, 2, 3, 4, 5, 6, 7)
#define PG8_RD4(off) (*(const LAS i32x4*)(lds + (off)))
#define PG8_LDA(dst, b, h) do { if constexpr (FP8) { _Pragma("unroll") for (int m = 0; m < 4; ++m) dst##8[m] = PG8_CAT8(PG8_RD4(PG8_SA(b, h) + aoff + m * 2048), PG8_RD4(PG8_SA(b, h) + aoff + m * 2048 + 1024)); } \
        else { _Pragma("unroll") for (int m = 0; m < 4; ++m) _Pragma("unroll") for (int k = 0; k < 2; ++k) dst[m][k] = *(const LAS bf16x8*)(lds + PG8_SA(b, h) + aoff + m * 2048 + k * 1024); } } while (0)
#define PG8_LDB(dst, b, h) do { if constexpr (FP8) { _Pragma("unroll") for (int n = 0; n < 2; ++n) dst##8[n] = PG8_CAT8(PG8_RD4(PG8_SB(b, h) + boff + n * 2048), PG8_RD4(PG8_SB(b, h) + boff + n * 2048 + 1024)); } \
        else { _Pragma("unroll") for (int n = 0; n < 2; ++n) _Pragma("unroll") for (int k = 0; k < 2; ++k) dst[n][k] = *(const LAS bf16x8*)(lds + PG8_SB(b, h) + boff + n * 2048 + k * 1024); } } while (0)
#define PG8_MMA(ai, bj, At, Bt_) do { __builtin_amdgcn_s_setprio(1); _Pragma("unroll") for (int m = 0; m < 4; ++m) _Pragma("unroll") for (int n = 0; n < 2; ++n) { \
        if constexpr (FP8) { asm volatile("v_mfma_scale_f32_16x16x128_f8f6f4 %0, %1, %2, %0, %3, %4 op_sel_hi:[0,0,0]" : "+v"(acc[ai][bj][m][n]) : "v"(Bt_##8[n]), "v"(At##8[m]), "v"(sc_w), "v"(sc_x)); } \
        else { _Pragma("unroll") for (int k = 0; k < 2; ++k) acc[ai][bj][m][n] = __builtin_amdgcn_mfma_f32_16x16x32_bf16(Bt_[n][k], At[m][k], acc[ai][bj][m][n], 0, 0, 0); } } \
        __builtin_amdgcn_s_setprio(0); } while (0)
#define PG8_WAIT_V(n) asm volatile("s_waitcnt vmcnt(" #n ")" ::: "memory")
#define PG8_WAIT_L(n) asm volatile("s_waitcnt lgkmcnt(" #n ")" ::: "memory")
#define PG8_BAR __builtin_amdgcn_s_barrier()
#define PG8_SCHED __builtin_amdgcn_sched_barrier(0)
#define PG8_SETV(v, u) do { _Pragma("unroll") for (int h_ = 0; h_ < 2; ++h_) _Pragma("unroll") for (int i_ = 0; i_ < 2; ++i_) \
        v[h_][i_] = GATHER ? (S.rowoff(u, Rr[i_] + HALF * h_) + (unsigned)Cc[i_] * 2u) : (unsigned)((Rr[i_] + HALF * h_) * K + Cc[i_]) * 2u; } while (0)
    Unit cur, nxt; int ui = 0;
    if (!S.next(0, cur)) return;
    unsigned vc[2][2], vn[2][2];
    PG8_SETV(vc, cur);
    f32x4 acc[2][2][4][2];
#pragma unroll
    for (int a = 0; a < 2; ++a)
#pragma unroll
        for (int b = 0; b < 2; ++b)
#pragma unroll
            for (int m = 0; m < 4; ++m)
#pragma unroll
                for (int n = 0; n < 2; ++n) acc[a][b][m][n] = (f32x4){0.f, 0.f, 0.f, 0.f};
    bf16x8 At[4][2], B0[2][2], B1[2][2]; i32x8 At8[4], B08[2], B18[2];
    int sc_w = W8_E8M0, sc_x = ONE_E8M0; asm volatile("" : "+v"(sc_w), "+v"(sc_x));
    const char* cA = GATHER ? (const char*)A : (const char*)A + (size_t)cur.pm * tstep;
    const char* cB = (const char*)Bt + (size_t)cur.pn * tstep;
    PG8_STAGEB(PG8_SB(0, 0), cB); PG8_STAGEB(PG8_SB(0, 1), cB + hstep); PG8_STAGE(PG8_SA(0, 0), cA, vc[0][0], vc[0][1]); PG8_STAGE(PG8_SA(0, 1), cA, vc[1][0], vc[1][1]);
    if (wr == 1) PG8_BAR;
    PG8_WAIT_V(2); PG8_BAR;
    PG8_STAGEB(PG8_SB(1, 0), cB + kstep); PG8_STAGE(PG8_SA(1, 0), cA + kstep, vc[0][0], vc[0][1]); PG8_STAGEB(PG8_SB(1, 1), cB + hstep + kstep);
    PG8_WAIT_V(6); PG8_BAR;
    for (;;) {
        const bool has_next = S.next(ui + 1, nxt);
        const char* nA = GATHER ? (const char*)A : (has_next ? (const char*)A + (size_t)nxt.pm * tstep : cA);
        const char* nB = has_next ? (const char*)Bt + (size_t)nxt.pn * tstep : cB;
        if constexpr (GATHER) { if (has_next) { PG8_SETV(vn, nxt); } else {
#pragma unroll
            for (int h_ = 0; h_ < 2; ++h_)
#pragma unroll
                for (int i_ = 0; i_ < 2; ++i_) vn[h_][i_] = vc[h_][i_]; } }
#pragma nounroll
        for (int t = 0; t < nt; t += 2) {
            const bool last = (t == nt - 2);
            const char* a1 = cA + (size_t)(t + 1) * kstep;
            const char* a2 = last ? nA : cA + (size_t)(t + 2) * kstep; const char* b2 = last ? nB : cB + (size_t)(t + 2) * kstep;
            const char* a3 = a2 + kstep; const char* b3 = b2 + kstep;
            const unsigned w00 = (GATHER && last) ? vn[0][0] : vc[0][0], w01 = (GATHER && last) ? vn[0][1] : vc[0][1], w10 = (GATHER && last) ? vn[1][0] : vc[1][0], w11 = (GATHER && last) ? vn[1][1] : vc[1][1];
            PG8_LDB(B0, 0, 0); PG8_LDB(B1, 0, 1); PG8_SCHED; PG8_LDA(At, 0, 0); PG8_STAGE(PG8_SA(1, 1), a1, vc[1][0], vc[1][1]);
            PG8_WAIT_V(8); PG8_WAIT_L(0); PG8_BAR; PG8_MMA(0, 0, At, B0); PG8_MMA(0, 1, At, B1); PG8_BAR; PG8_SCHED;
            PG8_LDA(At, 0, 1); PG8_STAGEB(PG8_SB(0, 0), b2); PG8_STAGEB(PG8_SB(0, 1), b2 + hstep); PG8_STAGE(PG8_SA(0, 0), a2, w00, w01);
            PG8_WAIT_V(8); PG8_WAIT_L(0); PG8_BAR; PG8_MMA(1, 0, At, B0); PG8_MMA(1, 1, At, B1); PG8_BAR; PG8_SCHED;
            PG8_LDB(B0, 1, 0); PG8_LDB(B1, 1, 1); PG8_SCHED; PG8_LDA(At, 1, 0); PG8_STAGE(PG8_SA(0, 1), a2, w10, w11);
            PG8_WAIT_V(8); PG8_WAIT_L(0); PG8_BAR; PG8_MMA(0, 0, At, B0); PG8_MMA(0, 1, At, B1); PG8_BAR; PG8_SCHED;
            PG8_LDA(At, 1, 1); PG8_STAGEB(PG8_SB(1, 0), b3); PG8_STAGEB(PG8_SB(1, 1), b3 + hstep); PG8_STAGE(PG8_SA(1, 0), a3, w00, w01);
            PG8_WAIT_V(8); PG8_WAIT_L(0); PG8_BAR; PG8_MMA(1, 0, At, B0); PG8_MMA(1, 1, At, B1); PG8_BAR; PG8_SCHED;
        }
        if constexpr (FP8) { asm volatile("s_nop 15\n\ts_nop 15" ::: "memory"); }
        if constexpr (ALIGN_EPI) { if (wr == 0) PG8_BAR; }
        E(acc, cur, wr, wc, fr, fq);
        if (!has_next) break;
#pragma unroll
        for (int a = 0; a < 2; ++a)
#pragma unroll
            for (int b = 0; b < 2; ++b)
#pragma unroll
                for (int m = 0; m < 4; ++m)
#pragma unroll
                    for (int n = 0; n < 2; ++n) acc[a][b][m][n] = (f32x4){0.f, 0.f, 0.f, 0.f};
        cur = nxt; cA = nA; cB = nB; ++ui;
        if constexpr (GATHER) {
#pragma unroll
        for (int h_ = 0; h_ < 2; ++h_)
#pragma unroll
            for (int i_ = 0; i_ < 2; ++i_) vc[h_][i_] = vn[h_][i_]; }
        if constexpr (ALIGN_EPI) { if (wr == 1) PG8_BAR; }
    }
    PG8_WAIT_V(0);
    if constexpr (!ALIGN_EPI) { if (wr == 0) PG8_BAR; }
    PG8_BAR;
#undef PG8_SA
#undef PG8_SB
#undef PG8_STAGE
#undef PG8_STAGEB
#undef PG8_LDA
#undef PG8_LDB
#undef PG8_MMA
#undef PG8_CAT8
#undef PG8_RD4
#undef PG8_WAIT_V
#undef PG8_WAIT_L
#undef PG8_BAR
#undef PG8_SCHED
#undef PG8_SETV
}
}

#define XB_TMO      128
#define XB_XCNT(j)  (256  + 64 * (j))
#define XB_XSUB(j)  (1280 + 64 * (j))
#define XB_XGEN(j)  (2304 + 64 * (j))
#define XB_TOP      3328
#define XB_TOPGEN   3392
#define XCD_BAR_WORDS 3456
#define XB_SPIN_CAP (1u << 22)
__device__ __forceinline__ unsigned xb_ld(unsigned* p)              { return __hip_atomic_load(p, __ATOMIC_RELAXED, __HIP_MEMORY_SCOPE_AGENT); }
__device__ __forceinline__ unsigned xb_add(unsigned* p, unsigned v) { return __hip_atomic_fetch_add(p, v, __ATOMIC_RELAXED, __HIP_MEMORY_SCOPE_AGENT); }
__device__ __forceinline__ unsigned xb_xcc_id() { return (unsigned)__builtin_amdgcn_s_getreg((3 << 11) | 20) & 0xFu; }
#define XB_SPIN(cond, bar) do { unsigned _sp = 0; while (cond) { __builtin_amdgcn_s_sleep(1); \
    if ((++_sp & 255u) == 0u) { if (xb_ld(&(bar)[XB_TMO])) break; if (_sp > XB_SPIN_CAP) { atomicAdd(&(bar)[XB_TMO], 1u); break; } } } } while (0)
struct XcdBarrier { unsigned* bar; unsigned x; volatile LAS unsigned* st; };
__device__ __forceinline__ XcdBarrier xcd_barrier_post(unsigned* bar, volatile LAS unsigned* st) {
    XcdBarrier b; b.bar = bar; b.x = xb_xcc_id(); b.st = st;
    if (threadIdx.x == 0) (void)xb_add(&bar[XB_XCNT(b.x)], 1u);
    return b;
}
__device__ __forceinline__ void xcd_barrier_complete(unsigned* bar, unsigned x, unsigned& nloc, unsigned& nx) {
    const unsigned G = gridDim.x * gridDim.y * gridDim.z;
    unsigned sum, cnt, mine, sp = 0u;
    for (;;) {
        sum = 0u; cnt = 0u; mine = 0u;
#pragma unroll
        for (unsigned j = 0; j < 16; ++j) { const unsigned c = xb_ld(&bar[XB_XCNT(j)]); sum += c; cnt += (c > 0u) ? 1u : 0u; mine = (j == x) ? c : mine; }
        if (sum == G) break;
        __builtin_amdgcn_s_sleep(1);
        if ((++sp & 255u) == 0u) { if (xb_ld(&bar[XB_TMO])) break; if (sp > XB_SPIN_CAP) { atomicAdd(&bar[XB_TMO], 1u); break; } }
    }
    nloc = mine > 0u ? mine : 1u; nx = cnt > 0u ? cnt : 1u;
}
__device__ __forceinline__ void xcd_barrier(const XcdBarrier& b) {
    asm volatile("s_waitcnt vmcnt(0)" ::: "memory");
    __syncthreads();
    if (threadIdx.x == 0) {
        unsigned* bar = b.bar;
        __builtin_amdgcn_s_waitcnt(0);
        unsigned nloc = b.st[0], nx = b.st[1];
        if (nloc == 0u) { xcd_barrier_complete(bar, b.x, nloc, nx); b.st[0] = nloc; b.st[1] = nx; }
        const unsigned old = xb_add(&bar[XB_XSUB(b.x)], 1u);
        const unsigned gen = old / nloc;
        if (old + 1u == (gen + 1u) * nloc) {
            __builtin_amdgcn_fence(__ATOMIC_RELEASE, "agent");
            asm volatile("s_waitcnt vmcnt(0)" ::: "memory");
            const unsigned og = xb_add(&bar[XB_TOP], 1u);
            const unsigned tg = og / nx;
            if (og + 1u == (tg + 1u) * nx) xb_add(&bar[XB_TOPGEN], 1u);
            else XB_SPIN(xb_ld(&bar[XB_TOPGEN]) == tg, bar);
            __builtin_amdgcn_fence(__ATOMIC_ACQUIRE, "agent");
            xb_add(&bar[XB_XGEN(b.x)], 1u);
            asm volatile("s_waitcnt vmcnt(0)" ::: "memory");
        } else {
            XB_SPIN(xb_ld(&bar[XB_XGEN(b.x)]) == gen, bar);
            __builtin_amdgcn_fence(__ATOMIC_ACQUIRE, "agent");
            asm volatile("s_waitcnt vmcnt(0)" ::: "memory");
        }
    }
    __syncthreads();
}

struct Args { const void* in[26]; float* out; unsigned char* ws; int ph_lo, ph_hi, li, pad; };
enum { I_X = 0, I_C, I_POS, I_ADAW, I_ADAB, I_N1G, I_N2G, I_WIN, I_WOUT, I_SGLNG, I_SGLNB, I_SGW, I_SGB, I_PEK, I_PEV, I_CW1K, I_CW2K, I_CW1V, I_CW2V, I_RW, I_RB, I_EW1, I_EB1, I_EW2, I_EB2, I_FING };

struct Frame {
    LAS unsigned char* lds;
    unsigned* ctl;
    unsigned char* ws;
    int tid, lane, wave, vcu, G;
};
#define WSP(type, off) ((type*)(F.ws + (off)))
#define MODP(l, b, part) ((const float*)(F.ctl + CW_MOD) + ((size_t)((l) * 2 + (b)) * 6 + (part)) * 1024)

constexpr int RING_BYTES = 131072;
constexpr int ATT_LDS_BYTES = 147456;
constexpr int LDSCTL_OFF = ATT_LDS_BYTES;
constexpr int MISC_OFF = LDSCTL_OFF + 320;
constexpr int MOE_OFF = MISC_OFF + 128;
constexpr int LDS_BYTES = 163840;

struct EpiProj {
    static constexpr bool PERM = true;
    bf16_t *UG, *VG, *Q, *KC, *VC, *KS, *KW, *VST, *VWT; float* GATES; const float* ROPE; unsigned* kmax;
    __device__ __forceinline__ void operator()(const f32x4 (&acc)[2][2][4][2], const pg8::Unit& u, int wr, int wc, int fr, int fq) const {
        const int pn = u.pn; const int row0 = u.pm * 256 + wr * 64 + fr; const int b = u.pm >> 5;
        if (pn < 4 || pn == 6) {
#pragma unroll
            for (int ai = 0; ai < 2; ++ai)
#pragma unroll
                for (int m = 0; m < 4; ++m) { const size_t r = (size_t)(row0 + ai * 128 + m * 16);
#pragma unroll
                    for (int bj = 0; bj < 2; ++bj) { f32x4 v0 = acc[ai][bj][m][0], v1 = acc[ai][bj][m][1];
                        if (pn < 4) {
#pragma unroll
                            for (int i = 0; i < 4; ++i) { v0[i] = gelu_tanh(v0[i]); v1[i] = gelu_tanh(v1[i]); } }
                        u32x4 w; w.x = cvtpk(v0[0], v0[1]); w.y = cvtpk(v0[2], v0[3]); w.z = cvtpk(v1[0], v1[1]); w.w = cvtpk(v1[2], v1[3]);
                        bf16_t* dst;
                        if (pn < 2) dst = UG + r * 512 + pn * 256 + bj * 128 + wc * 32 + fq * 8;
                        else if (pn < 4) dst = VG + r * 512 + (pn - 2) * 256 + bj * 128 + wc * 32 + fq * 8;
                        else dst = (bj ? VC : KC) + r * 128 + wc * 32 + fq * 8;
                        *(u32x4*)dst = w; } }
        } else if (pn == 4 || pn == 5 || pn == 7) {
            const float sc = (pn == 7) ? 1.f : QSCALE; float nmax = 0.f;
#pragma unroll
            for (int ai = 0; ai < 2; ++ai)
#pragma unroll
                for (int m = 0; m < 4; ++m) { const size_t r = (size_t)(row0 + ai * 128 + m * 16);
                    const f32x4* cs = (const f32x4*)(ROPE + (r * 32 + fq * 8) * 2);
                    float o1[8], o2[8], nsq = 0.f;
#pragma unroll
                    for (int n = 0; n < 2; ++n) { const f32x4 c0 = cs[2 * n], c1 = cs[2 * n + 1]; const f32x4 x1 = acc[ai][0][m][n], x2 = acc[ai][1][m][n];
                        const float cc[4] = {c0[0], c0[2], c1[0], c1[2]}, ss[4] = {c0[1], c0[3], c1[1], c1[3]};
#pragma unroll
                        for (int i = 0; i < 4; ++i) { o1[4 * n + i] = (x1[i] * cc[i] - x2[i] * ss[i]) * sc; o2[4 * n + i] = (x2[i] * cc[i] + x1[i] * ss[i]) * sc; nsq += x1[i] * x1[i] + x2[i] * x2[i]; } }
                    u32x4 w1, w2; w1.x = cvtpk(o1[0], o1[1]); w1.y = cvtpk(o1[2], o1[3]); w1.z = cvtpk(o1[4], o1[5]); w1.w = cvtpk(o1[6], o1[7]);
                    w2.x = cvtpk(o2[0], o2[1]); w2.y = cvtpk(o2[2], o2[3]); w2.z = cvtpk(o2[4], o2[5]); w2.w = cvtpk(o2[6], o2[7]);
                    if (pn != 7) { bf16_t* dst = Q + r * 512 + (4 * (pn - 4) + wc) * 64 + fq * 8; *(u32x4*)dst = w1; *(u32x4*)(dst + 32) = w2; }
                    else { bf16_t* img = ((wc < 2) ? KS : KW) + (size_t)(b * 2 + (wc & 1)) * SEQ * 64; const int t = (int)r & (SEQ - 1);
                        *(u32x4*)(img + kfrag_off(t, fq)) = w1; *(u32x4*)(img + kfrag_off(t, 4 + fq)) = w2; }
                    nsq = kg_sum(nsq); nmax = fmaxf(nmax, nsq); }
            if (pn == 7) {
#pragma unroll
                for (int o = 1; o < 16; o <<= 1) nmax = fmaxf(nmax, __shfl_xor(nmax, o));
                if ((threadIdx.x & 63) == 0) atomicMax(kmax + ((wc < 2) ? 0 : 8) + b * 2 + (wc & 1), __float_as_uint(nmax * 1.02f));
            }
        } else if (pn == 8) {
            const int g = wc >> 1; float vmx = 0.f;
#pragma unroll
            for (int ai = 0; ai < 2; ++ai)
#pragma unroll
                for (int m = 0; m < 4; ++m) { const int r = row0 + ai * 128 + m * 16; const int s = r & (SEQ - 1);
#pragma unroll
                    for (int bj = 0; bj < 2; ++bj) { bf16_t* img = (bj ? VWT : VST) + (size_t)(b * 2 + g) * SEQ * 64;
#pragma unroll
                        for (int n = 0; n < 2; ++n)
#pragma unroll
                            for (int i = 0; i < 4; ++i) { img[vfrag_off(s, (wc & 1) * 32 + fq * 8 + n * 4 + i)] = (bf16_t)(cvtpk(acc[ai][bj][m][n][i], 0.f) & 0xffffu); if (bj == 0) vmx = fmaxf(vmx, fabsf(acc[ai][0][m][n][i])); } } }
#pragma unroll
            for (int o = 1; o < 64; o <<= 1) vmx = fmaxf(vmx, __shfl_xor(vmx, o));
            if ((threadIdx.x & 63) == 0) atomicMax(kmax + 4 + b * 2 + g, __float_as_uint(vmx * 1.01f));
        } else {
            if (wc == 0 && fq < 3) {
#pragma unroll
                for (int ai = 0; ai < 2; ++ai)
#pragma unroll
                    for (int m = 0; m < 4; ++m) { const size_t r = (size_t)(row0 + ai * 128 + m * 16);
#pragma unroll
                        for (int n = 0; n < 2; ++n) { f32x4 v = acc[ai][0][m][n];
#pragma unroll
                            for (int i = 0; i < 4; ++i) v[i] = sigmoidf_(v[i]);
                            *(f32x4*)(GATES + r * 24 + fq * 8 + n * 4) = v; } }
            }
        }
    }
};
struct EpiOut {
    static constexpr bool PERM = false;
    const float* xin; float* xout; const float* g1;
    __device__ __forceinline__ void operator()(const f32x4 (&acc)[2][2][4][2], const pg8::Unit& u, int wr, int wc, int fr, int fq) const {
        const int row0 = u.pm * 256 + wr * 64 + fr; const int b = u.pm >> 5; const int col0 = u.pn * 256 + wc * 32 + fq * 4;
        const float* gb = g1 + (size_t)b * 6144 + 2048;
        f32x4 gv[2][2];
#pragma unroll
        for (int bj = 0; bj < 2; ++bj)
#pragma unroll
            for (int n = 0; n < 2; ++n) gv[bj][n] = *(const f32x4*)(gb + col0 + bj * 128 + n * 16);
#pragma unroll
        for (int ai = 0; ai < 2; ++ai)
#pragma unroll
            for (int m = 0; m < 4; ++m) { const size_t off = (size_t)(row0 + ai * 128 + m * 16) * DM + col0;
#pragma unroll
                for (int bj = 0; bj < 2; ++bj)
#pragma unroll
                    for (int n = 0; n < 2; ++n) { const f32x4 xi = *(const f32x4*)(xin + off + bj * 128 + n * 16); *(f32x4*)(xout + off + bj * 128 + n * 16) = xi + gv[bj][n] * acc[ai][bj][m][n]; } }
    }
};
struct EpiSwiglu {
    static constexpr bool PERM = true;
    unsigned char* ACT; const float* b1;
    __device__ __forceinline__ void operator()(const f32x4 (&acc)[2][2][4][2], const pg8::Unit& u, int wr, int wc, int fr, int fq) const {
        const int row0 = u.pm * 256 + wr * 64 + fr; const int j0 = u.pnl * 128 + wc * 32 + fq * 8;
        const float* bb = b1 + (size_t)u.e * 2048 + j0;
        f32x4 bg[2], bl[2];
#pragma unroll
        for (int n = 0; n < 2; ++n) { bg[n] = *(const f32x4*)(bb + n * 4); bl[n] = *(const f32x4*)(bb + 1024 + n * 4); }
#pragma unroll
        for (int ai = 0; ai < 2; ++ai)
#pragma unroll
            for (int m = 0; m < 4; ++m) { float o[8];
#pragma unroll
                for (int n = 0; n < 2; ++n) { const f32x4 gl = acc[ai][0][m][n] + bg[n], ln = acc[ai][1][m][n] + bl[n];
#pragma unroll
                    for (int i = 0; i < 4; ++i) { const float gg = fminf(gl[i], 7.f), ll = fminf(fmaxf(ln[i], -7.f), 7.f); o[n * 4 + i] = gg * sigmoidf_(1.702f * gg) * (ll + 1.f); } }
                u32x2 w; w.x = cvt4_fp8(o[0], o[1], o[2], o[3]); w.y = cvt4_fp8(o[4], o[5], o[6], o[7]);
                *(u32x2*)(ACT + (size_t)(row0 + ai * 128 + m * 16) * FF + j0) = w; }
    }
};
struct EpiDown {
    static constexpr bool PERM = true;
    bf16_t* YR; const float* b2;
    __device__ __forceinline__ void operator()(const f32x4 (&acc)[2][2][4][2], const pg8::Unit& u, int wr, int wc, int fr, int fq) const {
        const int row0 = u.pm * 256 + wr * 64 + fr; const int c0 = u.pnl * 256 + wc * 32 + fq * 8;
        const float* bb = b2 + (size_t)u.e * 1024 + c0;
        f32x4 bv[2][2];
#pragma unroll
        for (int bj = 0; bj < 2; ++bj)
#pragma unroll
            for (int n = 0; n < 2; ++n) bv[bj][n] = *(const f32x4*)(bb + bj * 128 + n * 4);
#pragma unroll
        for (int ai = 0; ai < 2; ++ai)
#pragma unroll
            for (int m = 0; m < 4; ++m)
#pragma unroll
                for (int bj = 0; bj < 2; ++bj) { const f32x4 v0 = acc[ai][bj][m][0] + bv[bj][0], v1 = acc[ai][bj][m][1] + bv[bj][1];
                    u32x4 w; w.x = cvtpk(v0[0], v0[1]); w.y = cvtpk(v0[2], v0[3]); w.z = cvtpk(v1[0], v1[1]); w.w = cvtpk(v1[2], v1[3]);
                    *(u32x4*)(YR + (size_t)(row0 + ai * 128 + m * 16) * DM + c0 + bj * 128) = w; }
    }
};

__device__ __forceinline__ void tr_item(const float* W, int ldn, int k0, int c0, int nvalid, bf16_t* WT, int K, int drow0, LAS float* scr, int lane) {
    const int nn = lane & 31;
#pragma unroll 8
    for (int i = 0; i < 32; ++i) { const int kk = 2 * i + (lane >> 5); scr[kk * 33 + nn] = (nn < nvalid) ? W[(size_t)(k0 + kk) * ldn + c0 + nn] : 0.f; }
    LDS_WAIT(); asm volatile("" ::: "memory");
    const int c = lane & 7;
#pragma unroll
    for (int j = 0; j < 4; ++j) { const int n = (lane >> 3) + 8 * j; const LAS float* s = scr + (8 * c) * 33 + n;
        u32x4 o; o.x = cvtpk(s[0 * 33], s[1 * 33]); o.y = cvtpk(s[2 * 33], s[3 * 33]); o.z = cvtpk(s[4 * 33], s[5 * 33]); o.w = cvtpk(s[6 * 33], s[7 * 33]);
        *(u32x4*)(WT + (size_t)(drow0 + n) * K + k0 + 8 * c) = o; }
    LDS_WAIT(); asm volatile("" ::: "memory");
}
__device__ __forceinline__ void tr_item8(const float* W, int ldn, int k0, int c0, unsigned char* W8, int K, int drow0, LAS float* scr, int lane) {
    const int nn = lane & 31;
#pragma unroll 8
    for (int i = 0; i < 32; ++i) { const int kk = 2 * i + (lane >> 5); scr[kk * 33 + nn] = W[(size_t)(k0 + kk) * ldn + c0 + nn] * W8SCALE; }
    LDS_WAIT(); asm volatile("" ::: "memory");
    const int c = lane & 3;
#pragma unroll
    for (int j = 0; j < 2; ++j) { const int n = (lane >> 2) + 16 * j; const LAS float* s = scr + (16 * c) * 33 + n;
        u32x4 o; o.x = cvt4_fp8(s[0 * 33], s[1 * 33], s[2 * 33], s[3 * 33]); o.y = cvt4_fp8(s[4 * 33], s[5 * 33], s[6 * 33], s[7 * 33]);
        o.z = cvt4_fp8(s[8 * 33], s[9 * 33], s[10 * 33], s[11 * 33]); o.w = cvt4_fp8(s[12 * 33], s[13 * 33], s[14 * 33], s[15 * 33]);
        *(u32x4*)(W8 + (size_t)(drow0 + n) * K + k0 + 16 * c) = o; }
    LDS_WAIT(); asm volatile("" ::: "memory");
}
__device__ __forceinline__ void win_src(int p, int& c0, int& nvalid) {
    const int pn = p >> 8; nvalid = 32;
    if (pn < 4 || pn == 6) { c0 = p; }
    else if (pn == 4 || pn == 5) { const int pp = p - 1024 - 256 * (pn - 4), bj = pp >> 7, j = pp & 127; c0 = 1024 + (4 * (pn - 4) + (j >> 5)) * 64 + bj * 32; }
    else if (pn == 7) { const int pp = p - 1792, bj = pp >> 7, j = pp & 127, which = j >> 6, g = (j >> 5) & 1; c0 = (which ? 2048 : 1792) + g * 64 + bj * 32; }
    else if (pn == 8) { const int pp = p - 2048, bj = pp >> 7, j = pp & 127; c0 = (bj ? 2176 : 1920) + j; }
    else { const int pp = p - 2304; c0 = 2304 + pp; nvalid = 24 - pp; nvalid = nvalid < 0 ? 0 : (nvalid > 32 ? 32 : nvalid); if (nvalid == 0) c0 = 0; }
}
__device__ __forceinline__ void phase_prologue(Frame& F, const Args& a) {
    LAS float* scr = (LAS float*)(F.lds + F.wave * 8704);
    const int gw = F.vcu * NWAVES + F.wave, NGW = F.G * NWAVES; const int lane = F.lane;
    {
        const float* c = (const float*)a.in[I_C]; const float* adaw = (const float*)a.in[I_ADAW]; const float* adab = (const float*)a.in[I_ADAB];
        float* mod = (float*)(F.ctl + CW_MOD);
        LAS float* red = (LAS float*)(F.lds + 8 * 8704);
        for (int it = F.vcu; it < 2 * 24; it += F.G) {
            const int l = it / 24, nb = it % 24;
            const float* wp = adaw + ((size_t)l * 1024 + F.wave * 128) * 6144 + nb * 256 + lane * 4;
            f32x4 a0 = {0.f, 0.f, 0.f, 0.f}, a1 = a0;
#pragma unroll 4
            for (int k = 0; k < 128; ++k) { const f32x4 w = *(const f32x4*)(wp + (size_t)k * 6144);
                const float c0 = c[F.wave * 128 + k], c1 = c[1024 + F.wave * 128 + k]; const float s0 = c0 * sigmoidf_(c0), s1 = c1 * sigmoidf_(c1);
                a0 += w * s0; a1 += w * s1; }
            *(LAS f32x4*)(red + (F.wave * 2 + 0) * 256 + lane * 4) = a0; *(LAS f32x4*)(red + (F.wave * 2 + 1) * 256 + lane * 4) = a1;
            __syncthreads();
            { const int b = F.tid >> 8, col = F.tid & 255; float sum = adab[(size_t)l * 6144 + nb * 256 + col];
#pragma unroll
              for (int ww = 0; ww < 8; ++ww) sum += red[(ww * 2 + b) * 256 + col];
              mod[((size_t)l * 2 + b) * 6144 + nb * 256 + col] = sum; }
            __syncthreads();
        }
    }
    {
        const float* win = (const float*)a.in[I_WIN]; bf16_t* WinT = WSP(bf16_t, WS_WIN);
        for (int it = gw; it < 2 * 16 * 80; it += NGW) { const int l = it / 1280, kb = (it % 1280) / 80, nb = it % 80; int c0, nv; win_src(nb * 32, c0, nv);
            tr_item(win + (size_t)l * 1024 * PIN, PIN, kb * 64, c0, nv, WinT + (size_t)l * PINP * 1024, 1024, nb * 32, scr, lane); }
        const float* wout = (const float*)a.in[I_WOUT]; bf16_t* WoutT = WSP(bf16_t, WS_WOUT);
        for (int it = gw; it < 2 * 16 * 32; it += NGW) { const int l = it / 512, kb = (it % 512) / 32, nb = it % 32;
            tr_item(wout + (size_t)l * 1024 * 1024, 1024, kb * 64, nb * 32, 32, WoutT + (size_t)l * 1024 * 1024, 1024, nb * 32, scr, lane); }
        bf16_t* CW1 = WSP(bf16_t, WS_CW1);
        for (int it = gw; it < 2 * 2 * 32 * 2; it += NGW) { const int l = it / 128, which = (it / 64) & 1, kb = (it % 64) / 2, nb = it & 1;
            const float* src = (const float*)a.in[which ? I_CW1V : I_CW1K] + (size_t)l * 2048 * 64;
            tr_item(src, 64, kb * 64, nb * 32, 32, CW1 + (size_t)(l * 2 + which) * 64 * 2048, 2048, nb * 32, scr, lane); }
        const float* ew1 = (const float*)a.in[I_EW1]; unsigned char* W1T = WSP(unsigned char, WS_W1T);
        for (int it = gw; it < 2 * 32 * 16 * 64; it += NGW) { const int le = it >> 10, kb = (it >> 6) & 15, nb = it & 63; const int p = nb * 32, tile = p >> 8, bj = (p >> 7) & 1, j = p & 127;
            tr_item8(ew1 + (size_t)le * 1024 * 2048, 2048, kb * 64, bj * 1024 + tile * 128 + j, W1T + (size_t)le * 2048 * 1024, 1024, p, scr, lane); }
        const float* ew2 = (const float*)a.in[I_EW2]; unsigned char* W2T = WSP(unsigned char, WS_W2T);
        for (int it = gw; it < 2 * 32 * 16 * 32; it += NGW) { const int le = it >> 9, kb = (it >> 5) & 15, nb = it & 31;
            tr_item8(ew2 + (size_t)le * 1024 * 1024, 1024, kb * 64, nb * 32, W2T + (size_t)le * 1024 * 1024, 1024, nb * 32, scr, lane); }
    }
    {
        const int gt = (F.vcu * NWAVES + F.wave) * 64 + lane, NGT = NGW * 64;
        const float* sgw = (const float*)a.in[I_SGW]; bf16_t* SGW = WSP(bf16_t, WS_SGW);
        for (int i = gt; i < 2 * 8 * 128 * 128; i += NGT) { const int s = i & 127, t = (i >> 7) & 127; SGW[i] = (bf16_t)(cvtpk(s <= t ? sgw[i] : 0.f, 0.f) & 0xffffu); }
        const int* pos = (const int*)a.in[I_POS]; float* rope = WSP(float, WS_ROPE);
        for (int i = gt; i < T * 32; i += NGT) { const int tok = i >> 5, d = i & 31;
            const double inv = exp2(-(double)d * (13.287712379549449 / 32.0));
            const double rv = (double)pos[tok] * inv * 0.15915494309189535; const float fr = (float)(rv - __builtin_rint(rv));
            rope[2 * i] = __builtin_amdgcn_cosf(fr); rope[2 * i + 1] = __builtin_amdgcn_sinf(fr); }
        bf16_t* H = WSP(bf16_t, WS_H);
        for (int i = gt; i < 1024; i += NGT) { H[(size_t)T * 1024 + i] = 0; WSP(unsigned char, WS_H8)[(size_t)T * 1024 + i] = 0; }
        bf16_t* KCMP = WSP(bf16_t, WS_KCMP); bf16_t* VCT = WSP(bf16_t, WS_VCT);
        for (int i = gt; i < 2 * 2 * 64; i += NGT) { const int b = i >> 7, g = (i >> 6) & 1, d = i & 63; KCMP[(size_t)(b * 2 + g) * 512 * 64 + kfrag_off(511, d >> 3) + (d & 7)] = 0; VCT[(size_t)(b * 2 + g) * 512 * 64 + vfrag_off(511, d)] = 0; }
    }
    {
        float* cb = WSP(float, WS_MISC);
        for (int it = gw; it < 2 * 2 * 64; it += NGW) { const int l = it >> 7, which = (it >> 6) & 1, n = it & 63;
            const float* pe = (const float*)a.in[which ? I_PEV : I_PEK] + (size_t)l * 2048; const float* w1 = (const float*)a.in[which ? I_CW1V : I_CW1K] + (size_t)l * 2048 * 64;
            float s = 0.f; for (int k = lane; k < 2048; k += 64) s += pe[k] * w1[(size_t)k * 64 + n];
            s = wave_sum(s); if (lane == 0) cb[it] = s; }
    }
}

struct RowV { f32x4 v[4]; };
__device__ __forceinline__ RowV row_load(const float* p, int lane) { RowV r; const f32x4* q = (const f32x4*)p + lane;
#pragma unroll
    for (int j = 0; j < 4; ++j) r.v[j] = q[64 * j]; return r; }
__device__ __forceinline__ float row_ssq(const RowV& r) { float s = 0.f;
#pragma unroll
    for (int j = 0; j < 4; ++j) s += (r.v[j].x * r.v[j].x + r.v[j].y * r.v[j].y) + (r.v[j].z * r.v[j].z + r.v[j].w * r.v[j].w); return wave_sum(s); }
__device__ __forceinline__ void row_norm_store(const RowV& x, float rstd, const float* g, const float* sc, const float* sh, bf16_t* orow, int lane) {
    u32x2* o8 = (u32x2*)orow + lane;
#pragma unroll
    for (int j = 0; j < 4; ++j) { const f32x4 gg = ((const f32x4*)g)[lane + 64 * j], ss = ((const f32x4*)sc)[lane + 64 * j], hh = ((const f32x4*)sh)[lane + 64 * j];
        const f32x4 y = x.v[j] * rstd * gg * (ss + 1.f) + hh; u32x2 w; w.x = cvtpk(y.x, y.y); w.y = cvtpk(y.z, y.w); o8[64 * j] = w; }
}
__device__ __forceinline__ void row_norm_store8(const RowV& x, float rstd, const float* g, const float* sc, const float* sh, unsigned char* orow, int lane) {
    unsigned* o4 = (unsigned*)orow + lane;
#pragma unroll
    for (int j = 0; j < 4; ++j) { const f32x4 gg = ((const f32x4*)g)[lane + 64 * j], ss = ((const f32x4*)sc)[lane + 64 * j], hh = ((const f32x4*)sh)[lane + 64 * j];
        const f32x4 y = x.v[j] * rstd * gg * (ss + 1.f) + hh; o4[64 * j] = cvt4_fp8(y.x, y.y, y.z, y.w); }
}
__device__ __forceinline__ int expert_block_prefix(const unsigned* cnt, int lane) {
    int nb = (lane < NE) ? (int)((cnt[lane] + 255u) >> 8) : 0; int inc = nb;
#pragma unroll
    for (int o = 1; o < 32; o <<= 1) { const int t = __shfl_up(inc, o); if ((lane & 31) >= o) inc += t; }
    return inc - nb;
}
__device__ __forceinline__ void phase_n1_first(Frame& F, const Args& a) {
    const int gw = F.vcu * NWAVES + F.wave, NGW = F.G * NWAVES; const int lane = F.lane;
    const float* x = (const float*)a.in[I_X]; const float* g = (const float*)a.in[I_N1G]; bf16_t* H = WSP(bf16_t, WS_H);
    for (int m = gw; m < T; m += 2 * NGW) { const int m2 = m + NGW; const int b = m >> 13, b2 = m2 >> 13;
        const RowV r = row_load(x + (size_t)m * DM, lane); const RowV r2 = row_load(x + (size_t)m2 * DM, lane);
        const float rstd = 1.f / sqrtf(row_ssq(r) * (1.f / DM) + NORM_EPS), rstd2 = 1.f / sqrtf(row_ssq(r2) * (1.f / DM) + NORM_EPS);
        row_norm_store(r, rstd, g, MODP(0, b, 1), MODP(0, b, 0), H + (size_t)m * DM, lane);
        row_norm_store(r2, rstd2, g, MODP(0, b2, 1), MODP(0, b2, 0), H + (size_t)m2 * DM, lane); }
    float* RWP = WSP(float, WS_RWP); float* RBP = WSP(float, WS_MISC + 4096);
    const float* rw = (const float*)a.in[I_RW]; const float* rb = (const float*)a.in[I_RB]; const float* n2g = (const float*)a.in[I_N2G];
    const int gt = gw * 64 + lane, NGT = NGW * 64;
    for (int i = gt; i < 2 * 2 * 1024 * 32; i += NGT) { const int l = i >> 16, b = (i >> 15) & 1, k = (i >> 5) & 1023, e = i & 31;
        RWP[i] = n2g[l * 1024 + k] * (1.f + MODP(l, b, 4)[k]) * rw[((size_t)l * 1024 + k) * 32 + e]; }
    for (int it = gw; it < 2 * 2 * 32; it += NGW) { const int l = it >> 6, b = (it >> 5) & 1, e = it & 31; float s = 0.f;
        for (int k = lane; k < 1024; k += 64) s += MODP(l, b, 3)[k] * rw[((size_t)l * 1024 + k) * 32 + e];
        s = wave_sum(s); if (lane == 0) RBP[it] = s + rb[l * 32 + e]; }
}
__device__ __forceinline__ void phase_combine(Frame& F, const Args& a, int l) {
    const int gw = F.vcu * NWAVES + F.wave, NGW = F.G * NWAVES; const int lane = F.lane;
    float* XR = WSP(float, WS_XR); bf16_t* H = WSP(bf16_t, WS_H); const bf16_t* YR = WSP(bf16_t, WS_YROWS);
    const int* ASG = WSP(int, WS_ASG); const float* G4 = WSP(float, WS_GATE4);
    const int myprefix = expert_block_prefix(F.ctl + CW_CNT + l * 32, lane);
    const bool last = (l == DEPTH - 1);
    const float* g = last ? (const float*)a.in[I_FING] : (const float*)a.in[I_N1G] + (l + 1) * 1024;
#define COMB_LOAD(R_, WV_, GT_, M_) do { const int4 as4_ = *(const int4*)(ASG + (M_) * 4); const f32x4 gt4_ = *(const f32x4*)(G4 + (M_) * 4); \
        R_ = row_load(XR + (size_t)(M_) * DM, lane); const int asv_[4] = {as4_.x, as4_.y, as4_.z, as4_.w}; GT_[0] = gt4_.x; GT_[1] = gt4_.y; GT_[2] = gt4_.z; GT_[3] = gt4_.w; \
        _Pragma("unroll") for (int k = 0; k < 4; ++k) { const int e = asv_[k] >> 16, slot = asv_[k] & 0xffff; const int blk = __shfl(myprefix, e); \
            const u32x2* yr = (const u32x2*)(YR + ((size_t)blk * 256 + slot) * DM) + lane; _Pragma("unroll") for (int j = 0; j < 4; ++j) WV_[k][j] = yr[64 * j]; } } while (0)
#define COMB_FINISH(R_, WV_, GT_, M_) do { const int b = (M_) >> 13; f32x4 y[4]; \
        _Pragma("unroll") for (int j = 0; j < 4; ++j) y[j] = (f32x4){0.f, 0.f, 0.f, 0.f}; \
        _Pragma("unroll") for (int k = 0; k < 4; ++k) _Pragma("unroll") for (int j = 0; j < 4; ++j) { const u32x2 w = WV_[k][j]; y[j] += (f32x4){bflo(w.x), bfhi(w.x), bflo(w.y), bfhi(w.y)} * GT_[k]; } \
        const float* g2 = MODP(l, b, 5); \
        _Pragma("unroll") for (int j = 0; j < 4; ++j) R_.v[j] += ((const f32x4*)g2)[lane + 64 * j] * y[j]; \
        const float rstd = 1.f / sqrtf(row_ssq(R_) * (1.f / DM) + NORM_EPS); \
        if (last) { f32x4* o = (f32x4*)(a.out + (size_t)(M_) * DM) + lane; _Pragma("unroll") for (int j = 0; j < 4; ++j) o[64 * j] = R_.v[j] * rstd * ((const f32x4*)g)[lane + 64 * j]; } \
        else { f32x4* xo = (f32x4*)(XR + (size_t)(M_) * DM) + lane; _Pragma("unroll") for (int j = 0; j < 4; ++j) xo[64 * j] = R_.v[j]; \
            row_norm_store(R_, rstd, g, MODP(l + 1, b, 1), MODP(l + 1, b, 0), H + (size_t)(M_) * DM, lane); } } while (0)
    for (int m = gw; m < T; m += 2 * NGW) { const int m2 = m + NGW;
        RowV rA, rB; u32x2 wA[4][4], wB[4][4]; float gA[4], gB[4];
        COMB_LOAD(rA, wA, gA, m); COMB_LOAD(rB, wB, gB, m2);
        COMB_FINISH(rA, wA, gA, m); COMB_FINISH(rB, wB, gB, m2);
    }
#undef COMB_LOAD
#undef COMB_FINISH
}
__device__ __forceinline__ void compress_item(Frame& F, const Args& a, int l, int item) {
    const int which = item >> 7, b = (item >> 6) & 1, g = (item >> 5) & 1, n0 = (item & 31) * 16;
    const int lane = F.lane, w = F.wave, r16 = lane & 15, kg = lane >> 4;
    const bf16_t* src = WSP(bf16_t, which ? WS_VC : WS_KC);
    const bf16_t* W1 = WSP(bf16_t, WS_CW1) + (size_t)(l * 2 + which) * 64 * 2048;
    LAS float* red = (LAS float*)F.lds;
    LAS float* hid = (LAS float*)(F.lds + 32768);
    f32x4 acc[4];
#pragma unroll
    for (int i = 0; i < 4; ++i) acc[i] = (f32x4){0.f, 0.f, 0.f, 0.f};
    const int n = n0 + r16; const bool nval = n < NCMP;
#pragma unroll 2
    for (int ks = 0; ks < 8; ++ks) { const int k = 256 * w + 32 * ks + 8 * kg; const int li = k >> 6, d = k & 63;
        bf16x8 af = (bf16x8){0, 0, 0, 0, 0, 0, 0, 0};
        if (nval) af = *(const bf16x8*)(src + ((size_t)b * SEQ + 16 * n + li) * 128 + g * 64 + d);
#pragma unroll
        for (int nt = 0; nt < 4; ++nt) { const bf16x8 bf = *(const bf16x8*)(W1 + (size_t)(nt * 16 + r16) * 2048 + k); acc[nt] = __builtin_amdgcn_mfma_f32_16x16x32_bf16(af, bf, acc[nt], 0, 0, 0); } }
#pragma unroll
    for (int nt = 0; nt < 4; ++nt)
#pragma unroll
        for (int i = 0; i < 4; ++i) red[(w * 16 + 4 * kg + i) * 64 + nt * 16 + r16] = acc[nt][i];
    __syncthreads();
    const float* cb = WSP(float, WS_MISC) + (l * 2 + which) * 64;
    for (int i = F.tid; i < 1024; i += NTHREADS) { float s = cb[i & 63];
#pragma unroll
        for (int ww = 0; ww < 8; ++ww) s += red[ww * 1024 + i];
        hid[i] = gelu_tanh(s); }
    { const float* w2 = (const float*)a.in[which ? I_CW2V : I_CW2K] + (size_t)l * 4096; LAS f32x4* w2s4 = (LAS f32x4*)(F.lds + 40960);
      for (int i = F.tid; i < 1024; i += NTHREADS) w2s4[i] = ((const f32x4*)w2)[i]; }
    __syncthreads();
    {
        const int nn = F.tid >> 5, c = F.tid & 31; LAS float* w2s = (LAS float*)(F.lds + 40960);
        float o1 = 0.f, o2 = 0.f;
#pragma unroll 16
        for (int k = 0; k < 64; ++k) { const float h = hid[nn * 64 + k]; o1 += h * w2s[k * 64 + c]; o2 += h * w2s[k * 64 + c + 32]; }
        const int np = n0 + nn; float nsq_ = 0.f;
        if (np < NCMP) {
            if (!which) { const float* cs = WSP(float, WS_ROPE) + (((size_t)b * SEQ + 16 * np + 31) * 32 + c) * 2; const float cc = cs[0], ss = cs[1];
                const float r1 = o1 * cc - o2 * ss, r2 = o2 * cc + o1 * ss;
                bf16_t* img = WSP(bf16_t, WS_KCMP) + (size_t)(b * 2 + g) * 512 * 64; img[kfrag_off(np, c >> 3) + (c & 7)] = (bf16_t)(cvtpk(r1, 0.f) & 0xffffu); img[kfrag_off(np, 4 + (c >> 3)) + (c & 7)] = (bf16_t)(cvtpk(r2, 0.f) & 0xffffu);
                nsq_ = r1 * r1 + r2 * r2;
            } else { bf16_t* img = WSP(bf16_t, WS_VCT) + (size_t)(b * 2 + g) * 512 * 64; img[vfrag_off(np, c)] = (bf16_t)(cvtpk(o1, 0.f) & 0xffffu); img[vfrag_off(np, c + 32)] = (bf16_t)(cvtpk(o2, 0.f) & 0xffffu); }
        }
        if (!which) {
            float mx = quad_sum(nsq_);
            mx += __uint_as_float(__builtin_amdgcn_update_dpp(0u, __float_as_uint(mx), 0x141, 0xF, 0xF, true)); mx += __uint_as_float(__builtin_amdgcn_update_dpp(0u, __float_as_uint(mx), 0x140, 0xF, 0xF, true));
            mx = x16_sum(mx);
            mx = x32_max(mx);
            if (F.lane == 0) atomicMax(F.ctl + CW_KMAX + l * 16 + 12 + b * 2 + g, __float_as_uint(mx * 1.02f));
        }
    }
    __syncthreads();
}
__device__ __forceinline__ void sgu_item(Frame& F, const Args& a, int l, int item) {
    const int hh = item & 1, ch = item >> 1;
    const size_t tok0 = (size_t)ch * 128;
    const int lane = F.lane, w = F.wave, r16 = lane & 15, kg = lane >> 4;
    const bf16_t* VG = WSP(bf16_t, WS_VG); const bf16_t* UG = WSP(bf16_t, WS_UG); bf16_t* Y = WSP(bf16_t, WS_Y);
    LAS float* stats = (LAS float*)F.lds;
    LAS bf16_t* vnT = (LAS bf16_t*)(F.lds + 1024);
    constexpr int VP = 136;
    for (int tt = 0; tt < 16; ++tt) { const int s = 16 * w + tt; const u32x4 v = *(const u32x4*)(VG + (tok0 + s) * 512 + lane * 8);
        const float f[8] = {bflo(v.x), bfhi(v.x), bflo(v.y), bfhi(v.y), bflo(v.z), bfhi(v.z), bflo(v.w), bfhi(v.w)};
        float sm = 0.f;
#pragma unroll
        for (int i = 0; i < 8; ++i) sm += f[i];
        const float mu = wave_sum(sm) * (1.f / 512.f); float q = 0.f;
#pragma unroll
        for (int i = 0; i < 8; ++i) q += (f[i] - mu) * (f[i] - mu);
        const float var = wave_sum(q) * (1.f / 512.f);
        if (lane == 0) { stats[2 * s] = mu; stats[2 * s + 1] = 1.f / sqrtf(var + NORM_EPS); } }
    __syncthreads();
    {
        const int s = F.tid & 127, hl = F.tid >> 7; const float mu = stats[2 * s], rs = stats[2 * s + 1];
        const int cbase = (4 * hh + hl) * 64; const float* lg = (const float*)a.in[I_SGLNG] + l * 512 + cbase; const float* lb = (const float*)a.in[I_SGLNB] + l * 512 + cbase;
#pragma unroll 2
        for (int d0 = 0; d0 < 64; d0 += 8) { const u32x4 v = *(const u32x4*)(VG + (tok0 + s) * 512 + cbase + d0);
            const float f[8] = {bflo(v.x), bfhi(v.x), bflo(v.y), bfhi(v.y), bflo(v.z), bfhi(v.z), bflo(v.w), bfhi(v.w)};
#pragma unroll
            for (int i = 0; i < 8; ++i) vnT[(hl * 64 + d0 + i) * VP + s] = (bf16_t)(cvtpk((f[i] - mu) * rs * lg[d0 + i] + lb[d0 + i], 0.f) & 0xffffu); }
    }
    __syncthreads();
    {
        const int hl = w & 3, th = w >> 2, h = 4 * hh + hl;
        const bf16_t* Wm = WSP(bf16_t, WS_SGW) + (size_t)(l * 8 + h) * 128 * 128; const float* bs = (const float*)a.in[I_SGB] + (size_t)(l * 8 + h) * 128;
        for (int tt = 4 * th; tt < 4 * th + 4; ++tt) {
            f32x4 acc[4];
#pragma unroll
            for (int i = 0; i < 4; ++i) acc[i] = (f32x4){0.f, 0.f, 0.f, 0.f};
            const int nks = (16 * tt + 15) / 32 + 1;
            for (int ks = 0; ks < nks; ++ks) { const bf16x8 bfr = *(const bf16x8*)(Wm + (size_t)(16 * tt + r16) * 128 + 32 * ks + 8 * kg);
#pragma unroll
                for (int dt = 0; dt < 4; ++dt) { const bf16x8 afr = *(const LAS bf16x8*)(vnT + (hl * 64 + dt * 16 + r16) * VP + 32 * ks + 8 * kg); acc[dt] = __builtin_amdgcn_mfma_f32_16x16x32_bf16(afr, bfr, acc[dt], 0, 0, 0); } }
            const int t = 16 * tt + r16; const float bb = bs[t];
#pragma unroll
            for (int dt = 0; dt < 4; ++dt) { const size_t off = (tok0 + t) * 512 + h * 64 + dt * 16 + 4 * kg; const u32x2 uu = *(const u32x2*)(UG + off);
                u32x2 o; o.x = cvtpk(bflo(uu.x) * (acc[dt][0] + bb), bfhi(uu.x) * (acc[dt][1] + bb)); o.y = cvtpk(bflo(uu.y) * (acc[dt][2] + bb), bfhi(uu.y) * (acc[dt][3] + bb));
                *(u32x2*)(Y + (tok0 + t) * 1024 + h * 64 + dt * 16 + 4 * kg) = o; }
        }
    }
    __syncthreads();
}

namespace att {
constexpr int OSP = 65;
constexpr int L_OH = 0;
constexpr int L_OL = 66560;
constexpr int L_LS = 133120;
constexpr int L_MREF = L_LS + 2048;
constexpr int USP = 129;
constexpr int L_SEL = L_MREF + 1024;
constexpr int L_CNT = L_SEL + 1024;
constexpr int L_LIST = L_CNT + 512;
constexpr int L_WCTR = L_LIST + 8192;
static_assert(L_WCTR + 16 <= ATT_LDS_BYTES, "attention LDS map");

struct Ptrs { const bf16_t *Q, *KS, *KW, *VST, *VWT, *KCMP, *VCT; const float* GATES; bf16_t* Y; float* YPART; float kmax, vmax, kwmax, kcmax; };

#define MFMA16(a, b, c) __builtin_amdgcn_mfma_f32_16x16x32_bf16(a, b, c, 0, 0, 0)

__device__ __forceinline__ void attn_unit(Frame& F, const Ptrs& P, int b, int g, int qb) {
    LAS unsigned char* lds = F.lds;
    const int tid = F.tid, lane = F.lane, w = F.wave, r16 = lane & 15, kg = lane >> 4;
    LAS int* Oh = (LAS int*)(lds + L_OH); LAS int* Ol = (LAS int*)(lds + L_OL); LAS float* imp = (LAS float*)(lds + L_OH);
    LAS int* lsel = (LAS int*)(lds + L_LS); LAS float* mref = (LAS float*)(lds + L_MREF);
    LAS unsigned* selm = (LAS unsigned*)(lds + L_SEL); LAS int* cnts = (LAS int*)(lds + L_CNT); LAS unsigned char* lists = lds + L_LIST; LAS int* wctr = (LAS int*)(lds + L_WCTR);
    const size_t tokb = (size_t)b * SEQ; const int t0 = qb * 64;
    const bf16_t* Qg = P.Q + (tokb + t0) * 512 + g * 256;
    LAS float* U = (LAS float*)(lds + L_OH); LAS float* linvc = (LAS float*)(lds + L_LS);
    {
        const int q = tid >> 3, part = tid & 7, hd = part >> 1, hf = part & 1;
        const u32x4* src = (const u32x4*)(Qg + (size_t)q * 512 + part * 32);
        float ss = 0.f;
#pragma unroll
        for (int i = 0; i < 4; ++i) { const u32x4 v = src[i]; const float f[8] = {bflo(v.x), bfhi(v.x), bflo(v.y), bfhi(v.y), bflo(v.z), bfhi(v.z), bflo(v.w), bfhi(v.w)};
#pragma unroll
            for (int k = 0; k < 8; ++k) ss += f[k] * f[k]; }
        ss += __uint_as_float(__builtin_amdgcn_update_dpp(0u, __float_as_uint(ss), 0xB1, 0xF, 0xF, true));
        if (hf == 0) mref[q * 4 + hd] = sqrtf(ss);
        for (int i = tid; i < 256 * USP; i += NTHREADS) U[i] = 0.f;
    }
    __syncthreads();
    const int hl = r16 & 3;
#define ATT_LDK(dst, base, key0) do { const char* kb_ = (const char*)(base) + (size_t)(key0) * 128; _Pragma("unroll") for (int u_ = 0; u_ < 2; ++u_) _Pragma("unroll") for (int ks_ = 0; ks_ < 2; ++ks_) \
        dst[u_][ks_] = *(const bf16x8*)(kb_ + koff + (u_ * 2 + ks_) * 1024); } while (0)
#define ATT_LDV(dst, vbase, LEN, key0) do { const char* vb_ = (const char*)(vbase) + (size_t)(key0) * 128; _Pragma("unroll") for (int dt_ = 0; dt_ < 4; ++dt_) \
        dst[dt_] = *(const bf16x8*)(vb_ + koff + dt_ * 1024); } while (0)
#define ATT_SHADOW() int ln_ = F.lane; asm volatile("" : "+v"(ln_)); const int r16 = ln_ & 15, kg = ln_ >> 4, hl = r16 & 3; const unsigned koff = (unsigned)ln_ * 16u
    {
        ATT_SHADOW();
        bf16x8 qf[2][2]; float mrc[2], lpart[2], carry[2] = {0.f, 0.f}; int nlim[2]; f32x4 o[2][4];
#pragma unroll
        for (int rt = 0; rt < 2; ++rt) { const int q = 8 * w + 4 * rt + (r16 >> 2);
#pragma unroll
            for (int ks = 0; ks < 2; ++ks) qf[rt][ks] = *(const bf16x8*)(Qg + (size_t)q * 512 + hl * 64 + ks * 32 + kg * 8);
            mrc[rt] = mref[q * 4 + hl] * P.kcmax; lpart[rt] = 0.f; nlim[rt] = (t0 + q - 31) >> 4;
#pragma unroll
            for (int dt = 0; dt < 4; ++dt) o[rt][dt] = (f32x4){0.f, 0.f, 0.f, 0.f}; }
        const int nkeys = 4 * qb + 3, NP = (nkeys + 31) >> 5;
        const int nlim_min = (t0 + 8 * w - 31) >> 4;
        const bf16_t* Kc = P.KCMP + (size_t)(b * 2 + g) * 512 * 64; const bf16_t* Vc = P.VCT + (size_t)(b * 2 + g) * 64 * 512;
#define ATT_S1_STEP(KF, VF, s_) do { _Pragma("unroll") for (int rt = 0; rt < 2; ++rt) { \
            f32x4 st[2]; float p[2][4]; \
            _Pragma("unroll") for (int u = 0; u < 2; ++u) { st[u] = MFMA16(KF[u][0], qf[rt][0], ((f32x4){0.f, 0.f, 0.f, 0.f})); st[u] = MFMA16(KF[u][1], qf[rt][1], st[u]); } \
            _Pragma("unroll") for (int u = 0; u < 2; ++u) _Pragma("unroll") for (int i = 0; i < 4; ++i) p[u][i] = fast_exp2(st[u][i] - mrc[rt]); \
            if (32 * (s_) + 31 > nlim_min) { _Pragma("unroll") for (int u = 0; u < 2; ++u) _Pragma("unroll") for (int i = 0; i < 4; ++i) { const int n = 32 * (s_) + 8 * kg + 4 * u + i; if (n > nlim[rt]) p[u][i] = 0.f; } } \
            const float s01 = (p[0][0] + p[0][1]) + (p[0][2] + p[0][3]), s11 = (p[1][0] + p[1][1]) + (p[1][2] + p[1][3]); lpart[rt] += s01 + s11; \
            {   \
                \
              const unsigned x_ = __float_as_uint(p[1][3]); const auto s16_ = __builtin_amdgcn_permlane16_swap(x_, x_, false, false); const auto s32_ = __builtin_amdgcn_permlane32_swap(s16_[1], s16_[1], false, false); \
              const float inc_ = (kg & 1) ? __uint_as_float(s16_[0]) : ((kg == 2) ? __uint_as_float(s32_[0]) : carry[rt]); carry[rt] = __uint_as_float(s32_[1]); \
              LAS float* ur = U + ((8 * w + 4 * rt + (r16 >> 2)) * 4 + hl) * USP + 8 * (s_) + 2 * kg; \
              ur[0] += (2.f * s01 - p[0][3]) + inc_; ur[1] += (2.f * s11 - p[1][3]) + p[0][3]; } \
            u32x4 pw; pw.x = cvtpk(p[0][0], p[0][1]); pw.y = cvtpk(p[0][2], p[0][3]); pw.z = cvtpk(p[1][0], p[1][1]); pw.w = cvtpk(p[1][2], p[1][3]); \
            const bf16x8 pf = __builtin_bit_cast(bf16x8, pw); \
            _Pragma("unroll") for (int dt = 0; dt < 4; ++dt) o[rt][dt] = MFMA16(VF[dt], pf, o[rt][dt]); } } while (0)
        {
            bf16x8 kA[2][2], vA[4], kB[2][2], vB[4];
            ATT_LDK(kA, Kc, 0); ATT_LDV(vA, Vc, 512, 0); if (NP > 1) { ATT_LDK(kB, Kc, 32); ATT_LDV(vB, Vc, 512, 32); }
#pragma nounroll
            for (int s2 = 0; s2 < NP; s2 += 2) {
                ATT_S1_STEP(kA, vA, s2);
                if (s2 + 2 < NP) { ATT_LDK(kA, Kc, 32 * (s2 + 2)); ATT_LDV(vA, Vc, 512, 32 * (s2 + 2)); }
                if (s2 + 1 < NP) { ATT_S1_STEP(kB, vB, s2 + 1);
                    if (s2 + 3 < NP) { ATT_LDK(kB, Kc, 32 * (s2 + 3)); ATT_LDV(vB, Vc, 512, 32 * (s2 + 3)); } }
            }
        }
#undef ATT_S1_STEP
#pragma unroll
        for (int rt = 0; rt < 2; ++rt) { const int q = 8 * w + 4 * rt + (r16 >> 2); const float lrow = kg_sum(lpart[rt]); const float linv = lrow > 0.f ? 1.f / lrow : 0.f;
            if (kg == 0) linvc[q * 4 + hl] = linv;
            const float gc = P.GATES[(tokb + t0 + q) * 24 + (g * 4 + hl) * 3 + 0] * linv;
            float* yp = P.YPART + (tokb + t0 + q) * 512 + (g * 4 + hl) * 64 + 4 * kg;
#pragma unroll
            for (int dt = 0; dt < 4; ++dt) *(f32x4*)(yp + dt * 16) = o[rt][dt] * gc; }
    }
    LDS_WAIT();
#pragma nounroll
    for (int qg = 0; qg < 2; ++qg) {
        if (qb <= 15) {
            if (lane < 4) { const int q = 8 * w + 4 * qg + lane; const unsigned long long m0 = (1ull << (qb + 1)) - 1ull;
                selm[q * 4 + 0] = (unsigned)m0; selm[q * 4 + 1] = (unsigned)(m0 >> 32); selm[q * 4 + 2] = 0u; selm[q * 4 + 3] = 0u; }
        } else {
            const int j0 = lane, j1 = lane + 64; int v0[4], v1[4], thr[4];
#pragma unroll
            for (int k = 0; k < 4; ++k) { const int q = 8 * w + 4 * qg + k; const LAS float* ur = U + (q * 4) * USP; const LAS float* li = linvc + q * 4;
                float i0 = 0.f, i1 = 0.f;
#pragma unroll
                for (int h = 0; h < 4; ++h) { i0 += ur[h * USP + j0] * li[h]; i1 += ur[h * USP + j1] * li[h]; }
                v0[k] = (j0 >= 1 && j0 <= qb - 2) ? (int)__float_as_uint(i0) : -1;
                v1[k] = (j1 <= qb - 2) ? (int)__float_as_uint(i1) : -1; thr[k] = 0; }
#pragma nounroll
            for (int bit = 30; bit >= 0; --bit) {
#pragma unroll
                for (int k = 0; k < 4; ++k) { const int cand = thr[k] | (1 << bit);
                    const int c = __popcll(__ballot(v0[k] >= cand)) + __popcll(__ballot(v1[k] >= cand)); if (c >= 13) thr[k] = cand; } }
            const unsigned long long below = (1ull << lane) - 1ull;
#pragma nounroll
            for (int k = 0; k < 4; ++k) {
                const int vv0 = (k == 0) ? v0[0] : (k == 1) ? v0[1] : (k == 2) ? v0[2] : v0[3], vv1 = (k == 0) ? v1[0] : (k == 1) ? v1[1] : (k == 2) ? v1[2] : v1[3];
                const int th = (k == 0) ? thr[0] : (k == 1) ? thr[1] : (k == 2) ? thr[2] : thr[3];
                const bool gt0 = vv0 > th, gt1 = vv1 > th, eq0 = vv0 == th, eq1 = vv1 == th;
                const int need = 13 - (__popcll(__ballot(gt0)) + __popcll(__ballot(gt1)));
                const unsigned long long B0 = __ballot(eq0), B1 = __ballot(eq1);
                const int rk0 = __popcll(B0 & below), rk1 = __popcll(B0) + __popcll(B1 & below);
                unsigned long long m0 = __ballot(gt0 || (eq0 && rk0 < need)), m1 = __ballot(gt1 || (eq1 && rk1 < need));
                m0 |= 1ull;
                if (qb < 64) m0 |= (1ull << qb); else m1 |= (1ull << (qb - 64));
                if (qb - 1 < 64) m0 |= (1ull << (qb - 1)); else m1 |= (1ull << (qb - 65));
                if (lane == 0) { const int q = 8 * w + 4 * qg + k; selm[q * 4 + 0] = (unsigned)m0; selm[q * 4 + 1] = (unsigned)(m0 >> 32); selm[q * 4 + 2] = (unsigned)m1; selm[q * 4 + 3] = (unsigned)(m1 >> 32); } }
        }
    }
    __syncthreads();
    for (int i = tid; i < 2 * 256 * OSP; i += NTHREADS) Oh[i] = 0;
    lsel[tid] = 0;
    if (tid == 0) wctr[0] = 0;
    if (tid < 128) { const int j = tid; int c = 0;
        if (j <= qb) for (int q = 0; q < 64; ++q) { if ((selm[q * 4 + (j >> 5)] >> (j & 31)) & 1u) { lists[j * 64 + c] = (unsigned char)q; ++c; } }
        cnts[j] = c; }
    __syncthreads();
    for (int rep5 = 0; rep5 < ((ATTREP & 8) ? NREP : 1); ++rep5)
    {
        if (rep5 > 0) { __syncthreads(); if (tid == 0) wctr[0] = 0; __syncthreads(); }
        ATT_SHADOW();
        const bf16_t* Ks = P.KS + (size_t)(b * 2 + g) * SEQ * 64; const bf16_t* Vs = P.VST + (size_t)(b * 2 + g) * 64 * SEQ;
        const float S1 = 1048576.f / fmaxf(P.vmax, 1e-30f);
#define ATT_FETCH(idx_) do { int i_ = 0; if (lane == 0) i_ = __hip_atomic_fetch_add(wctr, 1, __ATOMIC_RELAXED, __HIP_MEMORY_SCOPE_WORKGROUP); idx_ = __builtin_amdgcn_readfirstlane(i_); } while (0)
#define ATT_JOF(idx_) (((idx_) == 0) ? 0 : (((idx_) == 1) ? qb : (((idx_) == 2) ? qb - 1 : (idx_) - 2)))
        bf16x8 kn[2][2][2], vn[2][4];
        int idx; ATT_FETCH(idx);
        if (idx <= qb) { const int j = ATT_JOF(idx); ATT_LDK(kn[0], Ks, 64 * j); ATT_LDK(kn[1], Ks, 64 * j + 32); ATT_LDV(vn[0], Vs, SEQ, 64 * j); ATT_LDV(vn[1], Vs, SEQ, 64 * j + 32); }
#pragma nounroll
        while (idx <= qb) {
            const int j = ATT_JOF(idx);
            bf16x8 kf[2][2][2], vf[2][4];
#pragma unroll
            for (int sp = 0; sp < 2; ++sp) {
#pragma unroll
                for (int u = 0; u < 2; ++u) { kf[sp][u][0] = kn[sp][u][0]; kf[sp][u][1] = kn[sp][u][1]; }
#pragma unroll
                for (int dt = 0; dt < 4; ++dt) vf[sp][dt] = vn[sp][dt]; }
            int idx2; ATT_FETCH(idx2);
            if (idx2 <= qb) { const int j2 = ATT_JOF(idx2); ATT_LDK(kn[0], Ks, 64 * j2); ATT_LDK(kn[1], Ks, 64 * j2 + 32); ATT_LDV(vn[0], Vs, SEQ, 64 * j2); ATT_LDV(vn[1], Vs, SEQ, 64 * j2 + 32); }
            const int cnt = cnts[j];
            const int nch = (cnt + 3) >> 2;
            bf16x8 qn0, qn1; int qnx; bool vnx;
            { const int qs = (r16 >> 2); vnx = qs < cnt; qnx = lists[j * 64 + (vnx ? qs : (cnt > 0 ? cnt - 1 : 0))];
              const bf16_t* qp = Qg + (size_t)qnx * 512 + hl * 64 + kg * 8; qn0 = *(const bf16x8*)qp; qn1 = *(const bf16x8*)(qp + 32); }
#pragma nounroll
            for (int c = 0; c < nch; ++c) {
                const bool valid = vnx; const int q = qnx; const int row = q * 4 + hl; const bf16x8 q0 = qn0, q1 = qn1;
                if (c + 1 < nch) { const int qs = 4 * (c + 1) + (r16 >> 2); vnx = qs < cnt; qnx = lists[j * 64 + (vnx ? qs : cnt - 1)];
                    const bf16_t* qp = Qg + (size_t)qnx * 512 + hl * 64 + kg * 8; qn0 = *(const bf16x8*)qp; qn1 = *(const bf16x8*)(qp + 32); }
                const float mr = mref[row] * P.kmax;
                f32x4 o[4];
                float ps = 0.f;
                const bool slow = (j == qb) || (4 * c + 4 > cnt);
#define ATT_CHUNK(MASKED) \
                _Pragma("unroll") for (int sp = 0; sp < 2; ++sp) { \
                    f32x4 st[2]; float p[2][4]; \
                    _Pragma("unroll") for (int u = 0; u < 2; ++u) { st[u] = MFMA16(kf[sp][u][0], q0, ((f32x4){0.f, 0.f, 0.f, 0.f})); st[u] = MFMA16(kf[sp][u][1], q1, st[u]); } \
                    _Pragma("unroll") for (int u = 0; u < 2; ++u) _Pragma("unroll") for (int i = 0; i < 4; ++i) { float e = fast_exp2(st[u][i] - mr); \
                        if (MASKED) { const int kk = 32 * sp + 8 * kg + 4 * u + i; if (!valid || (j == qb && kk > q)) e = 0.f; } p[u][i] = e; ps += e; } \
                    u32x4 pw; pw.x = cvtpk(p[0][0], p[0][1]); pw.y = cvtpk(p[0][2], p[0][3]); pw.z = cvtpk(p[1][0], p[1][1]); pw.w = cvtpk(p[1][2], p[1][3]); \
                    const bf16x8 pf = __builtin_bit_cast(bf16x8, pw); \
                    _Pragma("unroll") for (int dt = 0; dt < 4; ++dt) o[dt] = (sp == 0) ? MFMA16(vf[0][dt], pf, ((f32x4){0.f, 0.f, 0.f, 0.f})) : MFMA16(vf[1][dt], pf, o[dt]); }
                if (slow) { ATT_CHUNK(true) } else { ATT_CHUNK(false) }
#undef ATT_CHUNK
                ps = kg_sum(ps);
                if (valid) {
                    if (kg == 0) { const float xs = ps * 1048576.f, hf_ = __builtin_rintf(xs); __hip_atomic_fetch_add(lsel + row, (int)hf_, __ATOMIC_RELAXED, __HIP_MEMORY_SCOPE_WORKGROUP);
                        __hip_atomic_fetch_add(lsel + 256 + row, (int)((xs - hf_) * 1048576.f), __ATOMIC_RELAXED, __HIP_MEMORY_SCOPE_WORKGROUP); }
#pragma unroll
                    for (int dt = 0; dt < 4; ++dt)
#pragma unroll
                        for (int i = 0; i < 4; ++i) { const float xs = o[dt][i] * S1, hf_ = __builtin_rintf(xs); const int off = row * OSP + dt * 16 + 4 * kg + i;
                            __hip_atomic_fetch_add(Oh + off, (int)hf_, __ATOMIC_RELAXED, __HIP_MEMORY_SCOPE_WORKGROUP);
                            __hip_atomic_fetch_add(Ol + off, (int)((xs - hf_) * 1048576.f), __ATOMIC_RELAXED, __HIP_MEMORY_SCOPE_WORKGROUP); }
                }
            }
            idx = idx2;
        }
    }
    f32x4 yacc[2][4];
    {
        ATT_SHADOW();
        bf16x8 qf[2][2]; float mrw[2], lpart[2]; f32x4 o[2][4];
#pragma unroll
        for (int rt = 0; rt < 2; ++rt) { const int q = 8 * w + 4 * rt + (r16 >> 2);
#pragma unroll
            for (int ks = 0; ks < 2; ++ks) qf[rt][ks] = *(const bf16x8*)(Qg + (size_t)q * 512 + hl * 64 + ks * 32 + kg * 8);
            mrw[rt] = mref[q * 4 + hl] * P.kwmax; lpart[rt] = 0.f;
#pragma unroll
            for (int dt = 0; dt < 4; ++dt) o[rt][dt] = (f32x4){0.f, 0.f, 0.f, 0.f}; }
        const bf16_t* Kw = P.KW + (size_t)(b * 2 + g) * SEQ * 64; const bf16_t* Vw = P.VWT + (size_t)(b * 2 + g) * 64 * SEQ;
        const int jlo = qb >= 8 ? qb - 8 : 0; const int nit = 2 * (qb - jlo + 1);
#define ATT_S4_STEP(KF, VF, it_) do { const int jw_ = jlo + ((it_) >> 1), sp_ = (it_) & 1; const int mode_ = (jw_ == qb) ? 1 : ((jw_ == qb - 8) ? 2 : 0); \
        _Pragma("unroll") for (int rt = 0; rt < 2; ++rt) { \
            f32x4 st[2]; float p[2][4]; \
            _Pragma("unroll") for (int u = 0; u < 2; ++u) { st[u] = MFMA16(KF[u][0], qf[rt][0], ((f32x4){0.f, 0.f, 0.f, 0.f})); st[u] = MFMA16(KF[u][1], qf[rt][1], st[u]); } \
            _Pragma("unroll") for (int u = 0; u < 2; ++u) _Pragma("unroll") for (int i = 0; i < 4; ++i) p[u][i] = fast_exp2(st[u][i] - mrw[rt]); \
            if (mode_) { const int tq = 8 * w + 4 * rt + (r16 >> 2); \
                _Pragma("unroll") for (int u = 0; u < 2; ++u) _Pragma("unroll") for (int i = 0; i < 4; ++i) { const int kk = 32 * sp_ + 8 * kg + 4 * u + i; const bool vis = (mode_ == 1) ? (kk <= tq) : (kk > tq); if (!vis) p[u][i] = 0.f; } } \
            lpart[rt] += ((p[0][0] + p[0][1]) + (p[0][2] + p[0][3])) + ((p[1][0] + p[1][1]) + (p[1][2] + p[1][3])); \
            u32x4 pw; pw.x = cvtpk(p[0][0], p[0][1]); pw.y = cvtpk(p[0][2], p[0][3]); pw.z = cvtpk(p[1][0], p[1][1]); pw.w = cvtpk(p[1][2], p[1][3]); \
            const bf16x8 pf = __builtin_bit_cast(bf16x8, pw); \
            _Pragma("unroll") for (int dt = 0; dt < 4; ++dt) o[rt][dt] = MFMA16(VF[dt], pf, o[rt][dt]); } } while (0)
        {
            bf16x8 kA[2][2], vA[4], kB[2][2], vB[4];
            ATT_LDK(kA, Kw, 64 * jlo); ATT_LDV(vA, Vw, SEQ, 64 * jlo); ATT_LDK(kB, Kw, 64 * jlo + 32); ATT_LDV(vB, Vw, SEQ, 64 * jlo + 32);
#pragma nounroll
            for (int it = 0; it < nit; it += 2) {
                ATT_S4_STEP(kA, vA, it);
                if (it + 2 < nit) { ATT_LDK(kA, Kw, 64 * jlo + 32 * (it + 2)); ATT_LDV(vA, Vw, SEQ, 64 * jlo + 32 * (it + 2)); }
                ATT_S4_STEP(kB, vB, it + 1);
                if (it + 3 < nit) { ATT_LDK(kB, Kw, 64 * jlo + 32 * (it + 3)); ATT_LDV(vB, Vw, SEQ, 64 * jlo + 32 * (it + 3)); }
            }
        }
#undef ATT_S4_STEP
#pragma unroll
        for (int rt = 0; rt < 2; ++rt) { const int q = 8 * w + 4 * rt + (r16 >> 2); const float lw_ = kg_sum(lpart[rt]); const float sc = lw_ > 0.f ? P.GATES[(tokb + t0 + q) * 24 + (g * 4 + hl) * 3 + 2] / lw_ : 0.f;
#pragma unroll
            for (int dt = 0; dt < 4; ++dt) yacc[rt][dt] = o[rt][dt] * sc; }
    }
    __syncthreads();
#pragma unroll
    for (int rt = 0; rt < 2; ++rt) { const int q = 8 * w + 4 * rt + (r16 >> 2), row = q * 4 + hl;
        const float lrow = (float)lsel[row] * (1.f / 1048576.f) + (float)lsel[256 + row] * (1.f / 1099511627776.f);
        const float invS1 = fmaxf(P.vmax, 1e-30f) * (1.f / 1048576.f);
        const float sc = lrow > 0.f ? P.GATES[(tokb + t0 + q) * 24 + (g * 4 + hl) * 3 + 1] / lrow * invS1 : 0.f;
        bf16_t* dst = P.Y + (tokb + t0 + q) * 1024 + 512 + (g * 4 + hl) * 64 + 4 * kg;
        const float* yp = P.YPART + (tokb + t0 + q) * 512 + (g * 4 + hl) * 64 + 4 * kg;
#pragma unroll
        for (int dt = 0; dt < 4; ++dt) { const LAS int* oh = Oh + row * OSP + dt * 16 + 4 * kg; const LAS int* ol = Ol + row * OSP + dt * 16 + 4 * kg;
            const f32x4 osel = (f32x4){(float)oh[0] + (float)ol[0] * (1.f / 1048576.f), (float)oh[1] + (float)ol[1] * (1.f / 1048576.f), (float)oh[2] + (float)ol[2] * (1.f / 1048576.f), (float)oh[3] + (float)ol[3] * (1.f / 1048576.f)};
            const f32x4 v = yacc[rt][dt] + *(const f32x4*)(yp + dt * 16) + osel * sc;
            u32x2 o; o.x = cvtpk(v[0], v[1]); o.y = cvtpk(v[2], v[3]); *(u32x2*)(dst + dt * 16) = o; } }
    __syncthreads();
}
#undef MFMA16
#undef ATT_LDK
#undef ATT_LDV
#undef ATT_SHADOW
#undef ATT_FETCH
#undef ATT_JOF
}

__device__ __forceinline__ void phase_n2(Frame& F, const Args& a, int l) {
    const int lane = F.lane, w = F.wave;
    const float* XR = WSP(float, WS_XR); unsigned char* H8 = WSP(unsigned char, WS_H8);
    const float* g = (const float*)a.in[I_N2G] + l * 1024;
    LAS float* part = (LAS float*)F.lds;
    LAS float* ssqp = (LAS float*)(F.lds + 32768);
    LAS float* lg = (LAS float*)(F.lds + 32768 + 1024);
    int* CNTI = WSP(int, WS_CNTI); int* ASG = WSP(int, WS_ASG); float* G4 = WSP(float, WS_GATE4);
    for (int item = F.vcu; item < T / 64; item += F.G) {
        const int tk0 = item * 64, b = tk0 >> 13; const int tt = w & 1, kq = w >> 1;
        const float* rwp = WSP(float, WS_RWP) + (size_t)(l * 2 + b) * 1024 * 32; const float* rbp = WSP(float, WS_MISC + 4096) + (l * 2 + b) * 32;
        const int i31 = lane & 31, hf = lane >> 5;
        {
            const float* xp = XR + (size_t)(tk0 + tt * 32 + i31) * DM + kq * 256 + 4 * hf; const float* wp = rwp + (size_t)(kq * 256 + 4 * hf) * 32 + i31;
            f32x16 acc;
#pragma unroll
            for (int r = 0; r < 16; ++r) acc[r] = 0.f;
            float ssq = 0.f;
#pragma nounroll
            for (int bt = 0; bt < 4; ++bt) {
                f32x4 xv[8]; float wv[8][4];
#pragma unroll
                for (int s = 0; s < 8; ++s) { xv[s] = *(const f32x4*)(xp + 8 * (bt * 8 + s)); const float* wq = wp + (size_t)(8 * (bt * 8 + s)) * 32;
                    wv[s][0] = wq[0]; wv[s][1] = wq[32]; wv[s][2] = wq[64]; wv[s][3] = wq[96]; }
#pragma unroll
                for (int s = 0; s < 8; ++s) { ssq += (xv[s].x * xv[s].x + xv[s].y * xv[s].y) + (xv[s].z * xv[s].z + xv[s].w * xv[s].w);
                    acc = __builtin_amdgcn_mfma_f32_32x32x2f32(xv[s].x, wv[s][0], acc, 0, 0, 0); acc = __builtin_amdgcn_mfma_f32_32x32x2f32(xv[s].y, wv[s][1], acc, 0, 0, 0);
                    acc = __builtin_amdgcn_mfma_f32_32x32x2f32(xv[s].z, wv[s][2], acc, 0, 0, 0); acc = __builtin_amdgcn_mfma_f32_32x32x2f32(xv[s].w, wv[s][3], acc, 0, 0, 0); }
            }
            ssq += __shfl_xor(ssq, 32);
            if (hf == 0) ssqp[kq * 64 + tt * 32 + i31] = ssq;
#pragma unroll
            for (int r = 0; r < 16; ++r) { const int tk = (r & 3) + 8 * (r >> 2) + 4 * hf; part[(w * 32 + tk) * 32 + i31] = acc[r]; }
        }
        __syncthreads();
        for (int i = F.tid; i < 64 * 32; i += NTHREADS) { const int tk = i >> 5, e = i & 31, t2 = tk >> 5, tl = tk & 31;
            const float sq = (ssqp[tk] + ssqp[64 + tk]) + (ssqp[128 + tk] + ssqp[192 + tk]); const float rstd = 1.f / sqrtf(sq * (1.f / DM) + NORM_EPS);
            const float v = (part[((0 * 2 + t2) * 32 + tl) * 32 + e] + part[((1 * 2 + t2) * 32 + tl) * 32 + e]) + (part[((2 * 2 + t2) * 32 + tl) * 32 + e] + part[((3 * 2 + t2) * 32 + tl) * 32 + e]);
            lg[tk * 33 + e] = v * rstd + rbp[e]; }
        __syncthreads();
        if (w < 2) {
            const int it = item * 2 + w;
            float v0 = -INFINITY, v1 = -INFINITY, v2 = -INFINITY, v3 = -INFINITY; int i0 = -1, i1 = -1, i2 = -1, i3 = -1;
            if (lane < 32) {
#pragma unroll 8
                for (int e = 0; e < 32; ++e) { const float v = lg[(w * 32 + lane) * 33 + e];
                    if (v > v3) { if (v > v2) { v3 = v2; i3 = i2; if (v > v1) { v2 = v1; i2 = i1; if (v > v0) { v1 = v0; i1 = i0; v0 = v; i0 = e; } else { v1 = v; i1 = e; } } else { v2 = v; i2 = e; } } else { v3 = v; i3 = e; } } }
            }
            const float e1 = __expf(v1 - v0), e2 = __expf(v2 - v0), e3 = __expf(v3 - v0); const float inv = 1.f / (1.f + e1 + e2 + e3);
            int r0 = 0, r1 = 0, r2 = 0, r3 = 0, mycnt = 0;
            for (int e = 0; e < 32; ++e) { const bool hit = (i0 == e) | (i1 == e) | (i2 == e) | (i3 == e); const unsigned long long U = __ballot(hit);
                const int rk = __popcll(U & ((1ull << lane) - 1ull));
                if (i0 == e) r0 = rk; if (i1 == e) r1 = rk; if (i2 == e) r2 = rk; if (i3 == e) r3 = rk;
                if (lane == e) mycnt = __popcll(U); }
            if (lane < 32) { const int tk = tk0 + w * 32 + lane; CNTI[it * 32 + lane] = mycnt;
                if (mycnt > 0) { atomicAdd(F.ctl + CW_GCNT + (l * 32 + (it >> 4)) * 32 + lane, (unsigned)mycnt); atomicAdd(F.ctl + CW_CNT + l * 32 + lane, (unsigned)mycnt); }
                *(int4*)(ASG + tk * 4) = make_int4((i0 << 16) | r0, (i1 << 16) | r1, (i2 << 16) | r2, (i3 << 16) | r3);
                *(f32x4*)(G4 + tk * 4) = (f32x4){inv, e1 * inv, e2 * inv, e3 * inv}; }
        }
#pragma unroll 2
        for (int rr = 0; rr < 8; ++rr) { const int m = tk0 + w * 8 + rr; const RowV r = row_load(XR + (size_t)m * DM, lane);
            const float rstd = 1.f / sqrtf(row_ssq(r) * (1.f / DM) + NORM_EPS);
            row_norm_store8(r, rstd, g, MODP(l, b, 4), MODP(l, b, 3), H8 + (size_t)m * DM, lane); }
        __syncthreads();
    }
}

__device__ __forceinline__ void phase_n2b(Frame& F, int l) {
    const int gw = F.vcu * NWAVES + F.wave, NGW = F.G * NWAVES; const int lane = F.lane;
    const int* CNTI = WSP(int, WS_CNTI); int* TOK = WSP(int, WS_TOK); int* ASG = WSP(int, WS_ASG); unsigned* cnt = F.ctl + CW_CNT + l * 32;
    for (int it = gw; it < T / 32; it += NGW) {
        int base = 0;
        {
            const unsigned* gc = F.ctl + CW_GCNT + l * 1024; const int grp = it >> 4, e = lane & 31; int s0 = 0, s1 = 0;
#pragma unroll
            for (int gI = 0; gI < 32; ++gI) { const int v = (int)gc[gI * 32 + e]; s0 += (gI < grp) ? v : 0; }
#pragma unroll
            for (int i = 0; i < 16; ++i) { const int v = CNTI[((grp << 4) + i) * 32 + e]; s1 += (((grp << 4) + i) < it) ? v : 0; }
            base = s0 + s1; }
        { const int tk = it * 32 + (lane & 31); const int4 as = *(const int4*)(ASG + tk * 4); int v[4] = {as.x, as.y, as.z, as.w};
#pragma unroll
            for (int k = 0; k < 4; ++k) { const int e = v[k] >> 16, rk = v[k] & 0xffff; const int sl = __shfl(base, e & 31) + rk; if (lane < 32) TOK[e * 16384 + sl] = tk; v[k] = (e << 16) | sl; }
            if (lane < 32) *(int4*)(ASG + tk * 4) = make_int4(v[0], v[1], v[2], v[3]); }
    }
}

__device__ __forceinline__ void moe_tables(Frame& F, int l, int NT, int& total) {
    LAS int* ust = (LAS int*)(F.lds + MOE_OFF); LAS int* bst = ust + 33; LAS int* cn = bst + 33;
    if (F.tid < 64) { const unsigned* cnt = F.ctl + CW_CNT + l * 32; const int lane = F.tid;
        const int c = (lane < NE) ? (int)cnt[lane] : 0; const int nb = (c + 255) >> 8; int inc = nb;
#pragma unroll
        for (int o = 1; o < 32; o <<= 1) { const int t = __shfl_up(inc, o); if ((lane & 31) >= o) inc += t; }
        if (lane < NE) { bst[lane] = inc - nb; ust[lane] = (inc - nb) * NT; cn[lane] = c; if (lane == NE - 1) { bst[NE] = inc; ust[NE] = inc * NT; } } }
    __syncthreads();
    total = ust[NE];
}

constexpr int PH_PROLOGUE = 0, PH_N1 = 1, PH_LAYER0 = 2, PH_PER_LAYER = 9, NPHASES = PH_LAYER0 + DEPTH * PH_PER_LAYER;
__global__ void __launch_bounds__(NTHREADS, 2) fwd_kernel(Args args) {
    extern __shared__ __attribute__((aligned(16))) unsigned char lds_raw[];
    Frame F;
    F.lds = (LAS unsigned char*)lds_raw; F.ws = args.ws; F.ctl = (unsigned*)(args.ws + WS_CTL);
    F.tid = threadIdx.x; F.lane = F.tid & 63; F.wave = __builtin_amdgcn_readfirstlane(F.tid >> 6);
    F.G = gridDim.x; { const int bx = blockIdx.x; F.vcu = (F.G % 8 == 0) ? (bx % 8) * (F.G / 8) + bx / 8 : bx; }
    for (int u = F.tid; u < (LDS_BYTES - LDSCTL_OFF) / 4; u += NTHREADS) ((LAS unsigned*)(F.lds + LDSCTL_OFF))[u] = 0u;
    __syncthreads();
    volatile LAS unsigned* MISC = (volatile LAS unsigned*)(F.lds + MISC_OFF);
    XcdBarrier bar; bar.bar = F.ctl + CW_BAR; bar.x = 0; bar.st = nullptr;
#if !MK_PER_PHASE
    bar = xcd_barrier_post(F.ctl + CW_BAR, MISC + 8);
#endif
    const int lo = args.ph_lo, hi = args.ph_hi;
#define IN(k) (lo <= (k) && (k) < hi)
#define REFRESH() do { int t_ = threadIdx.x; asm volatile("" : "+v"(t_)); F.tid = t_; F.lane = t_ & 63; F.wave = __builtin_amdgcn_readfirstlane(t_ >> 6); } while (0)
#define SEAM(k) do { if (IN(k) && IN((k) + 1)) xcd_barrier(bar); } while (0)
#define REPS(bit, idem) (((REPMASK & (bit)) && (idem)) ? NREP : 1)

    if (IN(PH_PROLOGUE) && !(SKIPMASK & 1)) for (int rep = 0; rep < REPS(1, true); ++rep) { REFRESH(); phase_prologue(F, args); } SEAM(PH_PROLOGUE);
    if (IN(PH_N1) && !(SKIPMASK & 2)) for (int rep = 0; rep < REPS(2, true); ++rep) { REFRESH(); phase_n1_first(F, args); } SEAM(PH_N1);
    for (int l = 0; l < DEPTH; ++l) {
        const int p0 = PH_LAYER0 + l * PH_PER_LAYER;
        if (IN(p0 + 0) && !(SKIPMASK & 4)) for (int rep = 0; rep < REPS(4, l == 0); ++rep) {
            pg8::DenseOrder S; S.init(T, PINP, F.G, (int)blockIdx.x);
            EpiProj E{WSP(bf16_t, WS_UG), WSP(bf16_t, WS_VG), WSP(bf16_t, WS_Q), WSP(bf16_t, WS_KC), WSP(bf16_t, WS_VC), WSP(bf16_t, WS_KS), WSP(bf16_t, WS_KW), WSP(bf16_t, WS_VST), WSP(bf16_t, WS_VWT),
                      WSP(float, WS_GATES), WSP(float, WS_ROPE), F.ctl + CW_KMAX + l * 16};
            pg8::gemm_phase<EpiProj, pg8::DenseOrder, false, true>(F.lds, WSP(bf16_t, WS_H), WSP(bf16_t, WS_WIN) + (size_t)l * PINP * 1024, 1024, S, E);
        }
        SEAM(p0 + 0);
        if (IN(p0 + 1) && !(SKIPMASK & 8)) for (int rep = 0; rep < REPS(8, l == 0); ++rep) { REFRESH();
            for (int it = F.vcu; it < 256 + 256; it += F.G) { if (it < 256) compress_item(F, args, l, it); else sgu_item(F, args, l, it - 256); }
        }
        SEAM(p0 + 1);
        if (IN(p0 + 2) && !(SKIPMASK & 16)) for (int rep = 0; rep < REPS(16, l == 0); ++rep) { REFRESH();
            att::Ptrs P{WSP(bf16_t, WS_Q), WSP(bf16_t, WS_KS), WSP(bf16_t, WS_KW), WSP(bf16_t, WS_VST), WSP(bf16_t, WS_VWT), WSP(bf16_t, WS_KCMP), WSP(bf16_t, WS_VCT), WSP(float, WS_GATES), WSP(bf16_t, WS_Y), WSP(float, WS_YPART), 0.f};
            for (int it = F.vcu; it < 512; it += F.G) {
                const int uu = (it < 256) ? it : (767 - it);
                const int bg = uu >> 7, qb = uu & 127;
                const unsigned* km = F.ctl + CW_KMAX + l * 16 + bg;
                P.kmax = sqrtf(__uint_as_float(__hip_atomic_load(km, __ATOMIC_RELAXED, __HIP_MEMORY_SCOPE_AGENT)));
                P.vmax = __uint_as_float(__hip_atomic_load(km + 4, __ATOMIC_RELAXED, __HIP_MEMORY_SCOPE_AGENT));
                P.kwmax = sqrtf(__uint_as_float(__hip_atomic_load(km + 8, __ATOMIC_RELAXED, __HIP_MEMORY_SCOPE_AGENT)));
                P.kcmax = sqrtf(__uint_as_float(__hip_atomic_load(km + 12, __ATOMIC_RELAXED, __HIP_MEMORY_SCOPE_AGENT)));
                att::attn_unit(F, P, bg >> 1, bg & 1, qb);
            }
        }
        SEAM(p0 + 2);
        if (IN(p0 + 3) && !(SKIPMASK & 32)) for (int rep = 0; rep < REPS(32, l == 0); ++rep) {
            pg8::DenseOrder S; S.init(T, DM, F.G, (int)blockIdx.x);
            EpiOut E{l == 0 ? (const float*)args.in[I_X] : WSP(float, WS_XR), WSP(float, WS_XR), (const float*)(F.ctl + CW_MOD) + (size_t)l * 2 * 6144};
            pg8::gemm_phase<EpiOut, pg8::DenseOrder, false, true>(F.lds, WSP(bf16_t, WS_Y), WSP(bf16_t, WS_WOUT) + (size_t)l * 1024 * 1024, 1024, S, E);
        }
        SEAM(p0 + 3);
        if (IN(p0 + 4) && !(SKIPMASK & 64)) for (int rep = 0; rep < REPS(64, l == 0); ++rep) { REFRESH(); phase_n2(F, args, l); }
        SEAM(p0 + 4);
        if (IN(p0 + 5) && !(SKIPMASK & 64)) for (int rep = 0; rep < REPS(1024, l == 0); ++rep) { REFRESH(); phase_n2b(F, l); }
        SEAM(p0 + 5);
        if (IN(p0 + 6) && !(SKIPMASK & 128)) for (int rep = 0; rep < REPS(128, l == 0); ++rep) { REFRESH();
            int total; moe_tables(F, l, 8, total);
            LAS int* ust = (LAS int*)(F.lds + MOE_OFF);
            pg8::MoeOrder S{ust, ust + 33, ust + 66, WSP(int, WS_TOK), 8, F.G, F.vcu, total, 1024};
            EpiSwiglu E{WSP(unsigned char, WS_ACT), (const float*)args.in[I_EB1] + (size_t)l * NE * 2048};
            pg8::gemm_phase<EpiSwiglu, pg8::MoeOrder, true, true, true>(F.lds, WSP(bf16_t, WS_H8), (const bf16_t*)(WSP(unsigned char, WS_W1T) + (size_t)l * NE * 2048 * 1024), 512, S, E);
        }
        SEAM(p0 + 6);
        if (IN(p0 + 7) && !(SKIPMASK & 256)) for (int rep = 0; rep < REPS(256, l == 0); ++rep) { REFRESH();
            int total; moe_tables(F, l, 4, total);
            LAS int* ust = (LAS int*)(F.lds + MOE_OFF);
            pg8::MoeOrder S{ust, ust + 33, ust + 66, WSP(int, WS_TOK), 4, F.G, F.vcu, total, 1024};
            EpiDown E{WSP(bf16_t, WS_YROWS), (const float*)args.in[I_EB2] + (size_t)l * NE * 1024};
            pg8::gemm_phase<EpiDown, pg8::MoeOrder, false, true, true>(F.lds, WSP(bf16_t, WS_ACT), (const bf16_t*)(WSP(unsigned char, WS_W2T) + (size_t)l * NE * 1024 * 1024), 512, S, E);
        }
        SEAM(p0 + 7);
        if (IN(p0 + 8) && !(SKIPMASK & 512)) for (int rep = 0; rep < REPS(512, l == DEPTH - 1); ++rep) { REFRESH(); phase_combine(F, args, l); }
        if (l + 1 < DEPTH) SEAM(p0 + 8);
    }
#undef IN
#undef SEAM
}

extern "C" void kernel_launch(void* const* d_in, const int* in_sizes, int n_in, void* d_out, int out_size, void* d_ws, size_t ws_size, hipStream_t stream) {
    static int grid = 0;
    if (grid == 0) {
        if (n_in != 26 || out_size != T * DM || ws_size < WS_END) { fprintf(stderr, "kernel_launch: unexpected problem (n_in %d, out %d, ws %zu; need ws >= %zu)\n", n_in, out_size, ws_size, (size_t)WS_END); grid = -1; return; }
        int dev = 0, cus = 0, per_cu = 0;
        if (hipGetDevice(&dev) != hipSuccess || hipDeviceGetAttribute(&cus, hipDeviceAttributeMultiprocessorCount, dev) != hipSuccess) { grid = -1; return; }
        if (hipFuncSetAttribute((const void*)fwd_kernel, hipFuncAttributeMaxDynamicSharedMemorySize, LDS_BYTES) != hipSuccess) { fprintf(stderr, "kernel_launch: hipFuncSetAttribute failed\n"); grid = -1; return; }
        if (hipOccupancyMaxActiveBlocksPerMultiprocessor(&per_cu, (const void*)fwd_kernel, NTHREADS, LDS_BYTES) != hipSuccess || per_cu < 1) { fprintf(stderr, "kernel_launch: occupancy query says %d\n", per_cu); (void)hipGetLastError(); per_cu = 1; }
        grid = cus;
    }
    if (grid < 0) return;
    if (hipMemsetAsync((char*)d_ws + WS_CTL, 0, CTL_ZERO_BYTES, stream) != hipSuccess) { fprintf(stderr, "kernel_launch: memset failed\n"); return; }
    Args a{};
    for (int i = 0; i < 26; ++i) a.in[i] = d_in[i];
    a.out = (float*)d_out; a.ws = (unsigned char*)d_ws;
#if MK_PER_PHASE
    for (int p = 0; p < NPHASES; ++p) { a.ph_lo = p; a.ph_hi = p + 1; a.li = 0;
        hipLaunchKernelGGL(fwd_kernel, dim3(grid), dim3(NTHREADS), LDS_BYTES, stream, a); }
#else
    a.ph_lo = 0; a.ph_hi = NPHASES; a.li = 0;
    void* kargs[] = {&a};
    hipError_t e = hipLaunchCooperativeKernel((const void*)fwd_kernel, dim3(grid), dim3(NTHREADS), kargs, LDS_BYTES, stream);
    if (e != hipSuccess) fprintf(stderr, "kernel_launch: cooperative launch failed: %s (grid %d)\n", hipGetErrorString(e), grid);
#endif
}
```

```cpp
#include <hip/hip_runtime.h>
#include <cstdio>
#include <cstdint>

#ifndef SKIPMASK
#define SKIPMASK 0
#endif
#ifndef REPMASK
#define REPMASK 0
#endif
#ifndef NREP
#define NREP 3
#endif
#ifndef DUMMYINT
#define DUMMYINT 0
#endif
#ifndef ATTREP
#define ATTREP 0
#endif
#ifndef MK_PER_PHASE
#define MK_PER_PHASE 0
#endif

#define LAS __attribute__((address_space(3)))
typedef unsigned short bf16_t;
typedef short bf16x8 __attribute__((ext_vector_type(8)));
typedef float f32x4 __attribute__((ext_vector_type(4)));
typedef float f32x2 __attribute__((ext_vector_type(2)));
typedef float f32x16 __attribute__((ext_vector_type(16)));
typedef unsigned u32x4 __attribute__((ext_vector_type(4)));
typedef unsigned u32x2 __attribute__((ext_vector_type(2)));
typedef __bf16 bf16x2_t __attribute__((ext_vector_type(2)));
typedef int i32x4 __attribute__((ext_vector_type(4)));
typedef int i32x8 __attribute__((ext_vector_type(8)));

constexpr int BATCH = 2, SEQ = 8192, DM = 1024, T = BATCH * SEQ, DEPTH = 2;
constexpr int PIN = 2328, PINP = 2560;
constexpr int NE = 32, FF = 1024, TOPK = 4;
constexpr int NCMP = 511, NCMPP = 512;
constexpr float NORM_EPS = 1e-6f;
constexpr float W8SCALE = 64.f;
constexpr int W8_E8M0 = 0x79797979, ONE_E8M0 = 0x7f7f7f7f;
constexpr float QSCALE = 0.125f * 1.4426950408889634f;
constexpr int NWAVES = 8, NTHREADS = 512;

constexpr size_t MiB = 1u << 20;
constexpr size_t WS_CTL = 0, CTL_ZERO_BYTES = 1 * MiB;
constexpr size_t WS_WIN = 1 * MiB;
constexpr size_t WS_WOUT = 11 * MiB;
constexpr size_t WS_SGW = 15 * MiB;
constexpr size_t WS_CW1 = 15 * MiB + 512 * 1024;
constexpr size_t WS_ROPE = 17 * MiB;
constexpr size_t WS_RWP = 21 * MiB;
constexpr size_t WS_MISC = 21 * MiB + 512 * 1024;
constexpr size_t WS_W1T = 32 * MiB;
constexpr size_t WS_W2T = 288 * MiB;
constexpr size_t WS_XR = 416 * MiB;
constexpr size_t WS_H = 480 * MiB;
constexpr size_t WS_UG = 513 * MiB, WS_VG = 529 * MiB, WS_Q = 545 * MiB;
constexpr size_t WS_KC = 561 * MiB, WS_VC = 565 * MiB, WS_KS = 569 * MiB, WS_KW = 573 * MiB;
constexpr size_t WS_VST = 577 * MiB, WS_VWT = 581 * MiB;
constexpr size_t WS_GATES = 585 * MiB;
constexpr size_t WS_KCMP = 587 * MiB;
constexpr size_t WS_VCT = 587 * MiB + 512 * 1024;
constexpr size_t WS_Y = 588 * MiB;
constexpr size_t WS_TOK = 620 * MiB;
constexpr size_t WS_ASG = 622 * MiB;
constexpr size_t WS_GATE4 = 622 * MiB + 512 * 1024;
constexpr size_t WS_YPART = 912 * MiB;
constexpr size_t WS_CNTI = 623 * MiB;
constexpr size_t WS_ACT = 624 * MiB;
constexpr size_t WS_YROWS = 768 * MiB;
constexpr size_t WS_H8 = 944 * MiB;
constexpr size_t WS_END = 962 * MiB;
constexpr int CW_BAR = 4096;
constexpr int CW_MOD = 16384;
constexpr int CW_CNT = 40960;
constexpr int CW_KMAX = 41088;
constexpr int CW_GCNT = 41216;

__device__ __forceinline__ unsigned cvtpk(float lo, float hi) { f32x2 v = {lo, hi}; bf16x2_t b = __builtin_convertvector(v, bf16x2_t); return __builtin_bit_cast(unsigned, b); }
__device__ __forceinline__ unsigned cvt4_fp8(float a, float b, float c, float d) { int w = 0; w = __builtin_amdgcn_cvt_pk_fp8_f32(a, b, w, false); w = __builtin_amdgcn_cvt_pk_fp8_f32(c, d, w, true); return (unsigned)w; }
__device__ __forceinline__ float bf2f(unsigned short b) { return __uint_as_float((unsigned)b << 16); }
__device__ __forceinline__ float bflo(unsigned w) { return __uint_as_float(w << 16); }
__device__ __forceinline__ float bfhi(unsigned w) { return __uint_as_float(w & 0xffff0000u); }
__device__ __forceinline__ float fast_exp2(float x) { return __builtin_amdgcn_exp2f(x); }
__device__ __forceinline__ float fast_rcp(float x) { return __builtin_amdgcn_rcpf(x); }
__device__ __forceinline__ float sigmoidf_(float x) { return fast_rcp(1.f + fast_exp2(-1.4426950408889634f * x)); }
__device__ __forceinline__ float gelu_tanh(float x) { const float u = 0.7978845608028654f * (x + 0.044715f * x * x * x); return x * fast_rcp(1.f + fast_exp2(-2.885390081777927f * u)); }

__device__ __forceinline__ float x16_sum(float x) { auto r = __builtin_amdgcn_permlane16_swap(__float_as_uint(x), __float_as_uint(x), false, false); return __uint_as_float(r[0]) + __uint_as_float(r[1]); }
__device__ __forceinline__ float x32_sum(float x) { auto r = __builtin_amdgcn_permlane32_swap(__float_as_uint(x), __float_as_uint(x), false, false); return __uint_as_float(r[0]) + __uint_as_float(r[1]); }
__device__ __forceinline__ float x16_max(float x) { auto r = __builtin_amdgcn_permlane16_swap(__float_as_uint(x), __float_as_uint(x), false, false); return fmaxf(__uint_as_float(r[0]), __uint_as_float(r[1])); }
__device__ __forceinline__ float x32_max(float x) { auto r = __builtin_amdgcn_permlane32_swap(__float_as_uint(x), __float_as_uint(x), false, false); return fmaxf(__uint_as_float(r[0]), __uint_as_float(r[1])); }
__device__ __forceinline__ float kg_sum(float x) { return x32_sum(x16_sum(x)); }
__device__ __forceinline__ float kg_max(float x) { return x32_max(x16_max(x)); }
__device__ __forceinline__ float quad_sum(float x) { x += __uint_as_float(__builtin_amdgcn_update_dpp(0u, __float_as_uint(x), 0xB1, 0xF, 0xF, true)); x += __uint_as_float(__builtin_amdgcn_update_dpp(0u, __float_as_uint(x), 0x4E, 0xF, 0xF, true)); return x; }
__device__ __forceinline__ float wave_sum(float v) {
    v = quad_sum(v);
    v += __uint_as_float(__builtin_amdgcn_update_dpp(0u, __float_as_uint(v), 0x141, 0xF, 0xF, true));
    v += __uint_as_float(__builtin_amdgcn_update_dpp(0u, __float_as_uint(v), 0x140, 0xF, 0xF, true));
    return x32_sum(x16_sum(v));
}
#define LDS_WAIT() asm volatile("s_waitcnt lgkmcnt(0)" ::: "memory")
#define VM_WAIT() asm volatile("s_waitcnt vmcnt(0)" ::: "memory")

__device__ __forceinline__ int kfrag_off(int key, int c8) {
    const int s = key >> 5, ko = key & 31, u = (ko >> 2) & 1, r16 = ((ko >> 3) << 2) | (ko & 3), ks = c8 >> 2, kg = c8 & 3;
    return s * 2048 + (u * 2 + ks) * 512 + (kg * 16 + r16) * 8;
}
__device__ __forceinline__ int vfrag_off(int key, int d) {
    const int s = key >> 5, ko = key & 31;
    return s * 2048 + (d >> 4) * 512 + ((ko >> 3) * 16 + (d & 15)) * 8 + (ko & 7);
}
namespace pg8 {
constexpr int BM = 256, BK = 64, HALF = 128, HTB = HALF * BK * 2, STAGE_BYTES = 8 * HTB, NXCD = 8, WGM = 8;
__host__ __device__ __forceinline__ int lds_byte(int r, int c) { const int st = (r >> 4) * 2 + (c >> 5), rr = r & 15, cc = c & 31, ob = rr * 64 + cc * 2; return st * 1024 + (ob ^ (((ob >> 9) & 1) << 5)); }
__host__ __device__ __forceinline__ void stage_rc(int b, int& R, int& C) { const int st = b / 1024, sb = b % 1024, swz = sb ^ (((sb >> 9) & 1) << 5); R = (st >> 1) * 16 + swz / 64; C = (st & 1) * 32 + (swz % 64) / 2; }
__host__ __device__ __forceinline__ int perm32(int rho) { const int n = rho >> 4, i = rho & 15; return 8 * (i >> 2) + 4 * n + (i & 3); }

struct Unit { int pm, pn, e, pnl, rloc; };

struct DenseOrder {
    int nM, nN, nwg, G, c;
    __device__ void init(int M, int N, int G_, int c_) { nM = M / BM; nN = N / BM; nwg = nM * nN; G = G_; c = c_; }
    __device__ bool next(int i, Unit& u) const {
        const long L = (long)i * G + c; if (L >= nwg) return false;
        int wgid = (int)L; { const int q = nwg / NXCD, r = nwg % NXCD, xcd = wgid % NXCD, off = wgid / NXCD; wgid = (xcd < r ? xcd * (q + 1) : r * (q + 1) + (xcd - r) * q) + off; }
        const int nig = WGM * nN, gid = wgid / nig, fm = gid * WGM, gsz = (nM - fm) < WGM ? (nM - fm) : WGM;
        u.pm = fm + ((wgid % nig) % gsz); u.pn = (wgid % nig) / gsz; u.e = 0; u.pnl = u.pn; u.rloc = 0; return true;
    }
    __device__ __forceinline__ unsigned rowoff(const Unit&, int) const { return 0u; }
};

struct MoeOrder {
    const LAS int* ust;
    const LAS int* bst;
    const LAS int* cnt;
    const int* tok;
    int NT, G, c, total, rowbytes;
    __device__ bool next(int i, Unit& u) const {
        const int L = i * G + c; if (L >= total) return false;
        int e = 0;
        for (int k = 1; k < NE; ++k) e += (L >= ust[k]) ? 1 : 0;
        e = __builtin_amdgcn_readfirstlane(e);
        const int loc = __builtin_amdgcn_readfirstlane(L - ust[e]), b0 = __builtin_amdgcn_readfirstlane(bst[e]), nb = __builtin_amdgcn_readfirstlane(bst[e + 1]) - b0;
        u.e = e; u.pnl = loc / nb; u.rloc = loc - u.pnl * nb; u.pm = b0 + u.rloc; u.pn = e * NT + u.pnl; return true;
    }
    __device__ __forceinline__ unsigned rowoff(const Unit& u, int r) const {
        const int slot = u.rloc * 256 + r; const int tk = slot < cnt[u.e] ? tok[u.e * 16384 + slot] : T;
        return (unsigned)tk * (unsigned)rowbytes;
    }
};

template <class Epi, class Sched, bool GATHER, bool ALIGN_EPI, bool FP8 = false>
__device__ __forceinline__ void gemm_phase(LAS unsigned char* lds, const bf16_t* A, const bf16_t* Bt, const int K, const Sched& S, const Epi& E) {
    int tid_ = threadIdx.x; asm volatile("" : "+v"(tid_));
    const int tid = tid_, wid = __builtin_amdgcn_readfirstlane(tid >> 6), lane = tid & 63, wr = wid >> 2, wc = wid & 3, fr = lane & 15, fq = lane >> 4;
    const int nt = K / BK;
    int Rr[2], Cc[2]; unsigned voffB[2];
#pragma unroll
    for (int i = 0; i < 2; ++i) { int R, C; stage_rc(tid * 16 + i * 8192, R, C); Rr[i] = R; Cc[i] = C; const int Rb = Epi::PERM ? ((R & ~31) + perm32(R & 31)) : R; voffB[i] = (unsigned)(Rb * K + C) * 2u; }
    const size_t kstep = (size_t)(BK * 2);
    const size_t hstep = (size_t)HALF * K * 2;
    const size_t tstep = 2 * hstep;
    const unsigned ldsw = (unsigned)wid * 1024u;
    const int aoff = lds_byte(wr * 64 + fr, fq * 8), boff = lds_byte(wc * 32 + fr, fq * 8);
#define PG8_SA(b, h) (((b) * 2 + (h)) * HTB)
#define PG8_SB(b, h) ((4 + (b) * 2 + (h)) * HTB)
#define PG8_STAGE(bufoff, gbase, v0, v1) do { \
        __builtin_amdgcn_global_load_lds((const unsigned*)((const char*)(gbase) + (v0)), (LAS unsigned*)(lds + (bufoff) + ldsw), 16, 0, 0); \
        __builtin_amdgcn_global_load_lds((const unsigned*)((const char*)(gbase) + (v1)), (LAS unsigned*)(lds + (bufoff) + ldsw + 8192), 16, 0, 0); } while (0)
#define PG8_STAGEB(bufoff, gbase) PG8_STAGE(bufoff, gbase, voffB[0], voffB[1])
#define PG8_CAT8(x0, x1) __builtin_shufflevector(x0, x1, 0, 1, 2, 3, 4, 5, 6, 7)
#define PG8_RD4(off) (*(const LAS i32x4*)(lds + (off)))
#define PG8_LDA(dst, b, h) do { if constexpr (FP8) { _Pragma("unroll") for (int m = 0; m < 4; ++m) dst##8[m] = PG8_CAT8(PG8_RD4(PG8_SA(b, h) + aoff + m * 2048), PG8_RD4(PG8_SA(b, h) + aoff + m * 2048 + 1024)); } \
        else { _Pragma("unroll") for (int m = 0; m < 4; ++m) _Pragma("unroll") for (int k = 0; k < 2; ++k) dst[m][k] = *(const LAS bf16x8*)(lds + PG8_SA(b, h) + aoff + m * 2048 + k * 1024); } } while (0)
#define PG8_LDB(dst, b, h) do { if constexpr (FP8) { _Pragma("unroll") for (int n = 0; n < 2; ++n) dst##8[n] = PG8_CAT8(PG8_RD4(PG8_SB(b, h) + boff + n * 2048), PG8_RD4(PG8_SB(b, h) + boff + n * 2048 + 1024)); } \
        else { _Pragma("unroll") for (int n = 0; n < 2; ++n) _Pragma("unroll") for (int k = 0; k < 2; ++k) dst[n][k] = *(const LAS bf16x8*)(lds + PG8_SB(b, h) + boff + n * 2048 + k * 1024); } } while (0)
#define PG8_MMA(ai, bj, At, Bt_) do { __builtin_amdgcn_s_setprio(1); _Pragma("unroll") for (int m = 0; m < 4; ++m) _Pragma("unroll") for (int n = 0; n < 2; ++n) { \
        if constexpr (FP8) { asm volatile("v_mfma_scale_f32_16x16x128_f8f6f4 %0, %1, %2, %0, %3, %4 op_sel_hi:[0,0,0]" : "+v"(acc[ai][bj][m][n]) : "v"(Bt_##8[n]), "v"(At##8[m]), "v"(sc_w), "v"(sc_x)); } \
        else { _Pragma("unroll") for (int k = 0; k < 2; ++k) acc[ai][bj][m][n] = __builtin_amdgcn_mfma_f32_16x16x32_bf16(Bt_[n][k], At[m][k], acc[ai][bj][m][n], 0, 0, 0); } } \
        __builtin_amdgcn_s_setprio(0); } while (0)
#define PG8_WAIT_V(n) asm volatile("s_waitcnt vmcnt(" #n ")" ::: "memory")
#define PG8_WAIT_L(n) asm volatile("s_waitcnt lgkmcnt(" #n ")" ::: "memory")
#define PG8_BAR __builtin_amdgcn_s_barrier()
#define PG8_SCHED __builtin_amdgcn_sched_barrier(0)
#define PG8_SETV(v, u) do { _Pragma("unroll") for (int h_ = 0; h_ < 2; ++h_) _Pragma("unroll") for (int i_ = 0; i_ < 2; ++i_) \
        v[h_][i_] = GATHER ? (S.rowoff(u, Rr[i_] + HALF * h_) + (unsigned)Cc[i_] * 2u) : (unsigned)((Rr[i_] + HALF * h_) * K + Cc[i_]) * 2u; } while (0)
    Unit cur, nxt; int ui = 0;
    if (!S.next(0, cur)) return;
    unsigned vc[2][2], vn[2][2];
    PG8_SETV(vc, cur);
    f32x4 acc[2][2][4][2];
#pragma unroll
    for (int a = 0; a < 2; ++a)
#pragma unroll
        for (int b = 0; b < 2; ++b)
#pragma unroll
            for (int m = 0; m < 4; ++m)
#pragma unroll
                for (int n = 0; n < 2; ++n) acc[a][b][m][n] = (f32x4){0.f, 0.f, 0.f, 0.f};
    bf16x8 At[4][2], B0[2][2], B1[2][2]; i32x8 At8[4], B08[2], B18[2];
    int sc_w = W8_E8M0, sc_x = ONE_E8M0; asm volatile("" : "+v"(sc_w), "+v"(sc_x));
    const char* cA = GATHER ? (const char*)A : (const char*)A + (size_t)cur.pm * tstep;
    const char* cB = (const char*)Bt + (size_t)cur.pn * tstep;
    PG8_STAGEB(PG8_SB(0, 0), cB); PG8_STAGEB(PG8_SB(0, 1), cB + hstep); PG8_STAGE(PG8_SA(0, 0), cA, vc[0][0], vc[0][1]); PG8_STAGE(PG8_SA(0, 1), cA, vc[1][0], vc[1][1]);
    if (wr == 1) PG8_BAR;
    PG8_WAIT_V(2); PG8_BAR;
    PG8_STAGEB(PG8_SB(1, 0), cB + kstep); PG8_STAGE(PG8_SA(1, 0), cA + kstep, vc[0][0], vc[0][1]); PG8_STAGEB(PG8_SB(1, 1), cB + hstep + kstep);
    PG8_WAIT_V(6); PG8_BAR;
    for (;;) {
        const bool has_next = S.next(ui + 1, nxt);
        const char* nA = GATHER ? (const char*)A : (has_next ? (const char*)A + (size_t)nxt.pm * tstep : cA);
        const char* nB = has_next ? (const char*)Bt + (size_t)nxt.pn * tstep : cB;
        if constexpr (GATHER) { if (has_next) { PG8_SETV(vn, nxt); } else {
#pragma unroll
            for (int h_ = 0; h_ < 2; ++h_)
#pragma unroll
                for (int i_ = 0; i_ < 2; ++i_) vn[h_][i_] = vc[h_][i_]; } }
#pragma nounroll
        for (int t = 0; t < nt; t += 2) {
            const bool last = (t == nt - 2);
            const char* a1 = cA + (size_t)(t + 1) * kstep;
            const char* a2 = last ? nA : cA + (size_t)(t + 2) * kstep; const char* b2 = last ? nB : cB + (size_t)(t + 2) * kstep;
            const char* a3 = a2 + kstep; const char* b3 = b2 + kstep;
            const unsigned w00 = (GATHER && last) ? vn[0][0] : vc[0][0], w01 = (GATHER && last) ? vn[0][1] : vc[0][1], w10 = (GATHER && last) ? vn[1][0] : vc[1][0], w11 = (GATHER && last) ? vn[1][1] : vc[1][1];
            PG8_LDB(B0, 0, 0); PG8_LDB(B1, 0, 1); PG8_SCHED; PG8_LDA(At, 0, 0); PG8_STAGE(PG8_SA(1, 1), a1, vc[1][0], vc[1][1]);
            PG8_WAIT_V(8); PG8_WAIT_L(0); PG8_BAR; PG8_MMA(0, 0, At, B0); PG8_MMA(0, 1, At, B1); PG8_BAR; PG8_SCHED;
            PG8_LDA(At, 0, 1); PG8_STAGEB(PG8_SB(0, 0), b2); PG8_STAGEB(PG8_SB(0, 1), b2 + hstep); PG8_STAGE(PG8_SA(0, 0), a2, w00, w01);
            PG8_WAIT_V(8); PG8_WAIT_L(0); PG8_BAR; PG8_MMA(1, 0, At, B0); PG8_MMA(1, 1, At, B1); PG8_BAR; PG8_SCHED;
            PG8_LDB(B0, 1, 0); PG8_LDB(B1, 1, 1); PG8_SCHED; PG8_LDA(At, 1, 0); PG8_STAGE(PG8_SA(0, 1), a2, w10, w11);
            PG8_WAIT_V(8); PG8_WAIT_L(0); PG8_BAR; PG8_MMA(0, 0, At, B0); PG8_MMA(0, 1, At, B1); PG8_BAR; PG8_SCHED;
            PG8_LDA(At, 1, 1); PG8_STAGEB(PG8_SB(1, 0), b3); PG8_STAGEB(PG8_SB(1, 1), b3 + hstep); PG8_STAGE(PG8_SA(1, 0), a3, w00, w01);
            PG8_WAIT_V(8); PG8_WAIT_L(0); PG8_BAR; PG8_MMA(1, 0, At, B0); PG8_MMA(1, 1, At, B1); PG8_BAR; PG8_SCHED;
        }
        if constexpr (FP8) { asm volatile("s_nop 15\n\ts_nop 15" ::: "memory"); }
        if constexpr (ALIGN_EPI) { if (wr == 0) PG8_BAR; }
        E(acc, cur, wr, wc, fr, fq);
        if (!has_next) break;
#pragma unroll
        for (int a = 0; a < 2; ++a)
#pragma unroll
            for (int b = 0; b < 2; ++b)
#pragma unroll
                for (int m = 0; m < 4; ++m)
#pragma unroll
                    for (int n = 0; n < 2; ++n) acc[a][b][m][n] = (f32x4){0.f, 0.f, 0.f, 0.f};
        cur = nxt; cA = nA; cB = nB; ++ui;
        if constexpr (GATHER) {
#pragma unroll
        for (int h_ = 0; h_ < 2; ++h_)
#pragma unroll
            for (int i_ = 0; i_ < 2; ++i_) vc[h_][i_] = vn[h_][i_]; }
        if constexpr (ALIGN_EPI) { if (wr == 1) PG8_BAR; }
    }
    PG8_WAIT_V(0);
    if constexpr (!ALIGN_EPI) { if (wr == 0) PG8_BAR; }
    PG8_BAR;
#undef PG8_SA
#undef PG8_SB
#undef PG8_STAGE
#undef PG8_STAGEB
#undef PG8_LDA
#undef PG8_LDB
#undef PG8_MMA
#undef PG8_CAT8
#undef PG8_RD4
#undef PG8_WAIT_V
#undef PG8_WAIT_L
#undef PG8_BAR
#undef PG8_SCHED
#undef PG8_SETV
}
}

#define XB_TMO      128
#define XB_XCNT(j)  (256  + 64 * (j))
#define XB_XSUB(j)  (1280 + 64 * (j))
#define XB_XGEN(j)  (2304 + 64 * (j))
#define XB_TOP      3328
#define XB_TOPGEN   3392
#define XCD_BAR_WORDS 3456
#define XB_SPIN_CAP (1u << 22)
__device__ __forceinline__ unsigned xb_ld(unsigned* p)              { return __hip_atomic_load(p, __ATOMIC_RELAXED, __HIP_MEMORY_SCOPE_AGENT); }
__device__ __forceinline__ unsigned xb_add(unsigned* p, unsigned v) { return __hip_atomic_fetch_add(p, v, __ATOMIC_RELAXED, __HIP_MEMORY_SCOPE_AGENT); }
__device__ __forceinline__ unsigned xb_xcc_id() { return (unsigned)__builtin_amdgcn_s_getreg((3 << 11) | 20) & 0xFu; }
#define XB_SPIN(cond, bar) do { unsigned _sp = 0; while (cond) { __builtin_amdgcn_s_sleep(1); \
    if ((++_sp & 255u) == 0u) { if (xb_ld(&(bar)[XB_TMO])) break; if (_sp > XB_SPIN_CAP) { atomicAdd(&(bar)[XB_TMO], 1u); break; } } } } while (0)
struct XcdBarrier { unsigned* bar; unsigned x; volatile LAS unsigned* st; };
__device__ __forceinline__ XcdBarrier xcd_barrier_post(unsigned* bar, volatile LAS unsigned* st) {
    XcdBarrier b; b.bar = bar; b.x = xb_xcc_id(); b.st = st;
    if (threadIdx.x == 0) (void)xb_add(&bar[XB_XCNT(b.x)], 1u);
    return b;
}
__device__ __forceinline__ void xcd_barrier_complete(unsigned* bar, unsigned x, unsigned& nloc, unsigned& nx) {
    const unsigned G = gridDim.x * gridDim.y * gridDim.z;
    unsigned sum, cnt, mine, sp = 0u;
    for (;;) {
        sum = 0u; cnt = 0u; mine = 0u;
#pragma unroll
        for (unsigned j = 0; j < 16; ++j) { const unsigned c = xb_ld(&bar[XB_XCNT(j)]); sum += c; cnt += (c > 0u) ? 1u : 0u; mine = (j == x) ? c : mine; }
        if (sum == G) break;
        __builtin_amdgcn_s_sleep(1);
        if ((++sp & 255u) == 0u) { if (xb_ld(&bar[XB_TMO])) break; if (sp > XB_SPIN_CAP) { atomicAdd(&bar[XB_TMO], 1u); break; } }
    }
    nloc = mine > 0u ? mine : 1u; nx = cnt > 0u ? cnt : 1u;
}
__device__ __forceinline__ void xcd_barrier(const XcdBarrier& b) {
    asm volatile("s_waitcnt vmcnt(0)" ::: "memory");
    __syncthreads();
    if (threadIdx.x == 0) {
        unsigned* bar = b.bar;
        __builtin_amdgcn_s_waitcnt(0);
        unsigned nloc = b.st[0], nx = b.st[1];
        if (nloc == 0u) { xcd_barrier_complete(bar, b.x, nloc, nx); b.st[0] = nloc; b.st[1] = nx; }
        const unsigned old = xb_add(&bar[XB_XSUB(b.x)], 1u);
        const unsigned gen = old / nloc;
        if (old + 1u == (gen + 1u) * nloc) {
            __builtin_amdgcn_fence(__ATOMIC_RELEASE, "agent");
            asm volatile("s_waitcnt vmcnt(0)" ::: "memory");
            const unsigned og = xb_add(&bar[XB_TOP], 1u);
            const unsigned tg = og / nx;
            if (og + 1u == (tg + 1u) * nx) xb_add(&bar[XB_TOPGEN], 1u);
            else XB_SPIN(xb_ld(&bar[XB_TOPGEN]) == tg, bar);
            __builtin_amdgcn_fence(__ATOMIC_ACQUIRE, "agent");
            xb_add(&bar[XB_XGEN(b.x)], 1u);
            asm volatile("s_waitcnt vmcnt(0)" ::: "memory");
        } else {
            XB_SPIN(xb_ld(&bar[XB_XGEN(b.x)]) == gen, bar);
            __builtin_amdgcn_fence(__ATOMIC_ACQUIRE, "agent");
            asm volatile("s_waitcnt vmcnt(0)" ::: "memory");
        }
    }
    __syncthreads();
}

struct Args { const void* in[26]; float* out; unsigned char* ws; int ph_lo, ph_hi, li, pad; };
enum { I_X = 0, I_C, I_POS, I_ADAW, I_ADAB, I_N1G, I_N2G, I_WIN, I_WOUT, I_SGLNG, I_SGLNB, I_SGW, I_SGB, I_PEK, I_PEV, I_CW1K, I_CW2K, I_CW1V, I_CW2V, I_RW, I_RB, I_EW1, I_EB1, I_EW2, I_EB2, I_FING };

struct Frame {
    LAS unsigned char* lds;
    unsigned* ctl;
    unsigned char* ws;
    int tid, lane, wave, vcu, G;
};
#define WSP(type, off) ((type*)(F.ws + (off)))
#define MODP(l, b, part) ((const float*)(F.ctl + CW_MOD) + ((size_t)((l) * 2 + (b)) * 6 + (part)) * 1024)

constexpr int RING_BYTES = 131072;
constexpr int ATT_LDS_BYTES = 147456;
constexpr int LDSCTL_OFF = ATT_LDS_BYTES;
constexpr int MISC_OFF = LDSCTL_OFF + 320;
constexpr int MOE_OFF = MISC_OFF + 128;
constexpr int LDS_BYTES = 163840;

struct EpiProj {
    static constexpr bool PERM = true;
    bf16_t *UG, *VG, *Q, *KC, *VC, *KS, *KW, *VST, *VWT; float* GATES; const float* ROPE; unsigned* kmax;
    __device__ __forceinline__ void operator()(const f32x4 (&acc)[2][2][4][2], const pg8::Unit& u, int wr, int wc, int fr, int fq) const {
        const int pn = u.pn; const int row0 = u.pm * 256 + wr * 64 + fr; const int b = u.pm >> 5;
        if (pn < 4 || pn == 6) {
#pragma unroll
            for (int ai = 0; ai < 2; ++ai)
#pragma unroll
                for (int m = 0; m < 4; ++m) { const size_t r = (size_t)(row0 + ai * 128 + m * 16);
#pragma unroll
                    for (int bj = 0; bj < 2; ++bj) { f32x4 v0 = acc[ai][bj][m][0], v1 = acc[ai][bj][m][1];
                        if (pn < 4) {
#pragma unroll
                            for (int i = 0; i < 4; ++i) { v0[i] = gelu_tanh(v0[i]); v1[i] = gelu_tanh(v1[i]); } }
                        u32x4 w; w.x = cvtpk(v0[0], v0[1]); w.y = cvtpk(v0[2], v0[3]); w.z = cvtpk(v1[0], v1[1]); w.w = cvtpk(v1[2], v1[3]);
                        bf16_t* dst;
                        if (pn < 2) dst = UG + r * 512 + pn * 256 + bj * 128 + wc * 32 + fq * 8;
                        else if (pn < 4) dst = VG + r * 512 + (pn - 2) * 256 + bj * 128 + wc * 32 + fq * 8;
                        else dst = (bj ? VC : KC) + r * 128 + wc * 32 + fq * 8;
                        *(u32x4*)dst = w; } }
        } else if (pn == 4 || pn == 5 || pn == 7) {
            const float sc = (pn == 7) ? 1.f : QSCALE; float nmax = 0.f;
#pragma unroll
            for (int ai = 0; ai < 2; ++ai)
#pragma unroll
                for (int m = 0; m < 4; ++m) { const size_t r = (size_t)(row0 + ai * 128 + m * 16);
                    const f32x4* cs = (const f32x4*)(ROPE + (r * 32 + fq * 8) * 2);
                    float o1[8], o2[8], nsq = 0.f;
#pragma unroll
                    for (int n = 0; n < 2; ++n) { const f32x4 c0 = cs[2 * n], c1 = cs[2 * n + 1]; const f32x4 x1 = acc[ai][0][m][n], x2 = acc[ai][1][m][n];
                        const float cc[4] = {c0[0], c0[2], c1[0], c1[2]}, ss[4] = {c0[1], c0[3], c1[1], c1[3]};
#pragma unroll
                        for (int i = 0; i < 4; ++i) { o1[4 * n + i] = (x1[i] * cc[i] - x2[i] * ss[i]) * sc; o2[4 * n + i] = (x2[i] * cc[i] + x1[i] * ss[i]) * sc; nsq += x1[i] * x1[i] + x2[i] * x2[i]; } }
                    u32x4 w1, w2; w1.x = cvtpk(o1[0], o1[1]); w1.y = cvtpk(o1[2], o1[3]); w1.z = cvtpk(o1[4], o1[5]); w1.w = cvtpk(o1[6], o1[7]);
                    w2.x = cvtpk(o2[0], o2[1]); w2.y = cvtpk(o2[2], o2[3]); w2.z = cvtpk(o2[4], o2[5]); w2.w = cvtpk(o2[6], o2[7]);
                    if (pn != 7) { bf16_t* dst = Q + r * 512 + (4 * (pn - 4) + wc) * 64 + fq * 8; *(u32x4*)dst = w1; *(u32x4*)(dst + 32) = w2; }
                    else { bf16_t* img = ((wc < 2) ? KS : KW) + (size_t)(b * 2 + (wc & 1)) * SEQ * 64; const int t = (int)r & (SEQ - 1);
                        *(u32x4*)(img + kfrag_off(t, fq)) = w1; *(u32x4*)(img + kfrag_off(t, 4 + fq)) = w2; }
                    nsq = kg_sum(nsq); nmax = fmaxf(nmax, nsq); }
            if (pn == 7) {
#pragma unroll
                for (int o = 1; o < 16; o <<= 1) nmax = fmaxf(nmax, __shfl_xor(nmax, o));
                if ((threadIdx.x & 63) == 0) atomicMax(kmax + ((wc < 2) ? 0 : 8) + b * 2 + (wc & 1), __float_as_uint(nmax * 1.02f));
            }
        } else if (pn == 8) {
            const int g = wc >> 1; float vmx = 0.f;
#pragma unroll
            for (int ai = 0; ai < 2; ++ai)
#pragma unroll
                for (int m = 0; m < 4; ++m) { const int r = row0 + ai * 128 + m * 16; const int s = r & (SEQ - 1);
#pragma unroll
                    for (int bj = 0; bj < 2; ++bj) { bf16_t* img = (bj ? VWT : VST) + (size_t)(b * 2 + g) * SEQ * 64;
#pragma unroll
                        for (int n = 0; n < 2; ++n)
#pragma unroll
                            for (int i = 0; i < 4; ++i) { img[vfrag_off(s, (wc & 1) * 32 + fq * 8 + n * 4 + i)] = (bf16_t)(cvtpk(acc[ai][bj][m][n][i], 0.f) & 0xffffu); if (bj == 0) vmx = fmaxf(vmx, fabsf(acc[ai][0][m][n][i])); } } }
#pragma unroll
            for (int o = 1; o < 64; o <<= 1) vmx = fmaxf(vmx, __shfl_xor(vmx, o));
            if ((threadIdx.x & 63) == 0) atomicMax(kmax + 4 + b * 2 + g, __float_as_uint(vmx * 1.01f));
        } else {
            if (wc == 0 && fq < 3) {
#pragma unroll
                for (int ai = 0; ai < 2; ++ai)
#pragma unroll
                    for (int m = 0; m < 4; ++m) { const size_t r = (size_t)(row0 + ai * 128 + m * 16);
#pragma unroll
                        for (int n = 0; n < 2; ++n) { f32x4 v = acc[ai][0][m][n];
#pragma unroll
                            for (int i = 0; i < 4; ++i) v[i] = sigmoidf_(v[i]);
                            *(f32x4*)(GATES + r * 24 + fq * 8 + n * 4) = v; } }
            }
        }
    }
};
struct EpiOut {
    static constexpr bool PERM = false;
    const float* xin; float* xout; const float* g1;
    __device__ __forceinline__ void operator()(const f32x4 (&acc)[2][2][4][2], const pg8::Unit& u, int wr, int wc, int fr, int fq) const {
        const int row0 = u.pm * 256 + wr * 64 + fr; const int b = u.pm >> 5; const int col0 = u.pn * 256 + wc * 32 + fq * 4;
        const float* gb = g1 + (size_t)b * 6144 + 2048;
        f32x4 gv[2][2];
#pragma unroll
        for (int bj = 0; bj < 2; ++bj)
#pragma unroll
            for (int n = 0; n < 2; ++n) gv[bj][n] = *(const f32x4*)(gb + col0 + bj * 128 + n * 16);
#pragma unroll
        for (int ai = 0; ai < 2; ++ai)
#pragma unroll
            for (int m = 0; m < 4; ++m) { const size_t off = (size_t)(row0 + ai * 128 + m * 16) * DM + col0;
#pragma unroll
                for (int bj = 0; bj < 2; ++bj)
#pragma unroll
                    for (int n = 0; n < 2; ++n) { const f32x4 xi = *(const f32x4*)(xin + off + bj * 128 + n * 16); *(f32x4*)(xout + off + bj * 128 + n * 16) = xi + gv[bj][n] * acc[ai][bj][m][n]; } }
    }
};
struct EpiSwiglu {
    static constexpr bool PERM = true;
    unsigned char* ACT; const float* b1;
    __device__ __forceinline__ void operator()(const f32x4 (&acc)[2][2][4][2], const pg8::Unit& u, int wr, int wc, int fr, int fq) const {
        const int row0 = u.pm * 256 + wr * 64 + fr; const int j0 = u.pnl * 128 + wc * 32 + fq * 8;
        const float* bb = b1 + (size_t)u.e * 2048 + j0;
        f32x4 bg[2], bl[2];
#pragma unroll
        for (int n = 0; n < 2; ++n) { bg[n] = *(const f32x4*)(bb + n * 4); bl[n] = *(const f32x4*)(bb + 1024 + n * 4); }
#pragma unroll
        for (int ai = 0; ai < 2; ++ai)
#pragma unroll
            for (int m = 0; m < 4; ++m) { float o[8];
#pragma unroll
                for (int n = 0; n < 2; ++n) { const f32x4 gl = acc[ai][0][m][n] + bg[n], ln = acc[ai][1][m][n] + bl[n];
#pragma unroll
                    for (int i = 0; i < 4; ++i) { const float gg = fminf(gl[i], 7.f), ll = fminf(fmaxf(ln[i], -7.f), 7.f); o[n * 4 + i] = gg * sigmoidf_(1.702f * gg) * (ll + 1.f); } }
                u32x2 w; w.x = cvt4_fp8(o[0], o[1], o[2], o[3]); w.y = cvt4_fp8(o[4], o[5], o[6], o[7]);
                *(u32x2*)(ACT + (size_t)(row0 + ai * 128 + m * 16) * FF + j0) = w; }
    }
};
struct EpiDown {
    static constexpr bool PERM = true;
    bf16_t* YR; const float* b2;
    __device__ __forceinline__ void operator()(const f32x4 (&acc)[2][2][4][2], const pg8::Unit& u, int wr, int wc, int fr, int fq) const {
        const int row0 = u.pm * 256 + wr * 64 + fr; const int c0 = u.pnl * 256 + wc * 32 + fq * 8;
        const float* bb = b2 + (size_t)u.e * 1024 + c0;
        f32x4 bv[2][2];
#pragma unroll
        for (int bj = 0; bj < 2; ++bj)
#pragma unroll
            for (int n = 0; n < 2; ++n) bv[bj][n] = *(const f32x4*)(bb + bj * 128 + n * 4);
#pragma unroll
        for (int ai = 0; ai < 2; ++ai)
#pragma unroll
            for (int m = 0; m < 4; ++m)
#pragma unroll
                for (int bj = 0; bj < 2; ++bj) { const f32x4 v0 = acc[ai][bj][m][0] + bv[bj][0], v1 = acc[ai][bj][m][1] + bv[bj][1];
                    u32x4 w; w.x = cvtpk(v0[0], v0[1]); w.y = cvtpk(v0[2], v0[3]); w.z = cvtpk(v1[0], v1[1]); w.w = cvtpk(v1[2], v1[3]);
                    *(u32x4*)(YR + (size_t)(row0 + ai * 128 + m * 16) * DM + c0 + bj * 128) = w; }
    }
};

__device__ __forceinline__ void tr_item(const float* W, int ldn, int k0, int c0, int nvalid, bf16_t* WT, int K, int drow0, LAS float* scr, int lane) {
    const int nn = lane & 31;
#pragma unroll 8
    for (int i = 0; i < 32; ++i) { const int kk = 2 * i + (lane >> 5); scr[kk * 33 + nn] = (nn < nvalid) ? W[(size_t)(k0 + kk) * ldn + c0 + nn] : 0.f; }
    LDS_WAIT(); asm volatile("" ::: "memory");
    const int c = lane & 7;
#pragma unroll
    for (int j = 0; j < 4; ++j) { const int n = (lane >> 3) + 8 * j; const LAS float* s = scr + (8 * c) * 33 + n;
        u32x4 o; o.x = cvtpk(s[0 * 33], s[1 * 33]); o.y = cvtpk(s[2 * 33], s[3 * 33]); o.z = cvtpk(s[4 * 33], s[5 * 33]); o.w = cvtpk(s[6 * 33], s[7 * 33]);
        *(u32x4*)(WT + (size_t)(drow0 + n) * K + k0 + 8 * c) = o; }
    LDS_WAIT(); asm volatile("" ::: "memory");
}
__device__ __forceinline__ void tr_item8(const float* W, int ldn, int k0, int c0, unsigned char* W8, int K, int drow0, LAS float* scr, int lane) {
    const int nn = lane & 31;
#pragma unroll 8
    for (int i = 0; i < 32; ++i) { const int kk = 2 * i + (lane >> 5); scr[kk * 33 + nn] = __builtin_nontemporal_load(W + (size_t)(k0 + kk) * ldn + c0 + nn) * W8SCALE; }
    LDS_WAIT(); asm volatile("" ::: "memory");
    const int c = lane & 3;
#pragma unroll
    for (int j = 0; j < 2; ++j) { const int n = (lane >> 2) + 16 * j; const LAS float* s = scr + (16 * c) * 33 + n;
        u32x4 o; o.x = cvt4_fp8(s[0 * 33], s[1 * 33], s[2 * 33], s[3 * 33]); o.y = cvt4_fp8(s[4 * 33], s[5 * 33], s[6 * 33], s[7 * 33]);
        o.z = cvt4_fp8(s[8 * 33], s[9 * 33], s[10 * 33], s[11 * 33]); o.w = cvt4_fp8(s[12 * 33], s[13 * 33], s[14 * 33], s[15 * 33]);
        *(u32x4*)(W8 + (size_t)(drow0 + n) * K + k0 + 16 * c) = o; }
    LDS_WAIT(); asm volatile("" ::: "memory");
}
__device__ __forceinline__ void win_src(int p, int& c0, int& nvalid) {
    const int pn = p >> 8; nvalid = 32;
    if (pn < 4 || pn == 6) { c0 = p; }
    else if (pn == 4 || pn == 5) { const int pp = p - 1024 - 256 * (pn - 4), bj = pp >> 7, j = pp & 127; c0 = 1024 + (4 * (pn - 4) + (j >> 5)) * 64 + bj * 32; }
    else if (pn == 7) { const int pp = p - 1792, bj = pp >> 7, j = pp & 127, which = j >> 6, g = (j >> 5) & 1; c0 = (which ? 2048 : 1792) + g * 64 + bj * 32; }
    else if (pn == 8) { const int pp = p - 2048, bj = pp >> 7, j = pp & 127; c0 = (bj ? 2176 : 1920) + j; }
    else { const int pp = p - 2304; c0 = 2304 + pp; nvalid = 24 - pp; nvalid = nvalid < 0 ? 0 : (nvalid > 32 ? 32 : nvalid); if (nvalid == 0) c0 = 0; }
}
__device__ __forceinline__ void phase_prologue(Frame& F, const Args& a) {
    LAS float* scr = (LAS float*)(F.lds + F.wave * 8704);
    const int gw = F.vcu * NWAVES + F.wave, NGW = F.G * NWAVES; const int lane = F.lane;
    {
        const float* c = (const float*)a.in[I_C]; const float* adaw = (const float*)a.in[I_ADAW]; const float* adab = (const float*)a.in[I_ADAB];
        float* mod = (float*)(F.ctl + CW_MOD);
        LAS float* red = (LAS float*)(F.lds + 8 * 8704);
        for (int it = F.vcu; it < 2 * 24; it += F.G) {
            const int l = it / 24, nb = it % 24;
            const float* wp = adaw + ((size_t)l * 1024 + F.wave * 128) * 6144 + nb * 256 + lane * 4;
            f32x4 a0 = {0.f, 0.f, 0.f, 0.f}, a1 = a0;
#pragma unroll 4
            for (int k = 0; k < 128; ++k) { const f32x4 w = __builtin_nontemporal_load((const f32x4*)(wp + (size_t)k * 6144));
                const float c0 = c[F.wave * 128 + k], c1 = c[1024 + F.wave * 128 + k]; const float s0 = c0 * sigmoidf_(c0), s1 = c1 * sigmoidf_(c1);
                a0 += w * s0; a1 += w * s1; }
            *(LAS f32x4*)(red + (F.wave * 2 + 0) * 256 + lane * 4) = a0; *(LAS f32x4*)(red + (F.wave * 2 + 1) * 256 + lane * 4) = a1;
            __syncthreads();
            { const int b = F.tid >> 8, col = F.tid & 255; float sum = adab[(size_t)l * 6144 + nb * 256 + col];
#pragma unroll
              for (int ww = 0; ww < 8; ++ww) sum += red[(ww * 2 + b) * 256 + col];
              mod[((size_t)l * 2 + b) * 6144 + nb * 256 + col] = sum; }
            __syncthreads();
        }
    }
    {
        const float* win = (const float*)a.in[I_WIN]; bf16_t* WinT = WSP(bf16_t, WS_WIN);
        for (int it = gw; it < 2 * 16 * 80; it += NGW) { const int l = it / 1280, kb = (it % 1280) / 80, nb = it % 80; int c0, nv; win_src(nb * 32, c0, nv);
            tr_item(win + (size_t)l * 1024 * PIN, PIN, kb * 64, c0, nv, WinT + (size_t)l * PINP * 1024, 1024, nb * 32, scr, lane); }
        const float* wout = (const float*)a.in[I_WOUT]; bf16_t* WoutT = WSP(bf16_t, WS_WOUT);
        for (int it = gw; it < 2 * 16 * 32; it += NGW) { const int l = it / 512, kb = (it % 512) / 32, nb = it % 32;
            tr_item(wout + (size_t)l * 1024 * 1024, 1024, kb * 64, nb * 32, 32, WoutT + (size_t)l * 1024 * 1024, 1024, nb * 32, scr, lane); }
        bf16_t* CW1 = WSP(bf16_t, WS_CW1);
        for (int it = gw; it < 2 * 2 * 32 * 2; it += NGW) { const int l = it / 128, which = (it / 64) & 1, kb = (it % 64) / 2, nb = it & 1;
            const float* src = (const float*)a.in[which ? I_CW1V : I_CW1K] + (size_t)l * 2048 * 64;
            tr_item(src, 64, kb * 64, nb * 32, 32, CW1 + (size_t)(l * 2 + which) * 64 * 2048, 2048, nb * 32, scr, lane); }
        const float* ew1 = (const float*)a.in[I_EW1]; unsigned char* W1T = WSP(unsigned char, WS_W1T);
        for (int it = gw; it < 2 * 32 * 16 * 64; it += NGW) { const int le = it >> 10, kb = (it >> 6) & 15, nb = it & 63; const int p = nb * 32, tile = p >> 8, bj = (p >> 7) & 1, j = p & 127;
            tr_item8(ew1 + (size_t)le * 1024 * 2048, 2048, kb * 64, bj * 1024 + tile * 128 + j, W1T + (size_t)le * 2048 * 1024, 1024, p, scr, lane); }
        const float* ew2 = (const float*)a.in[I_EW2]; unsigned char* W2T = WSP(unsigned char, WS_W2T);
        for (int it = gw; it < 2 * 32 * 16 * 32; it += NGW) { const int le = it >> 9, kb = (it >> 5) & 15, nb = it & 31;
            tr_item8(ew2 + (size_t)le * 1024 * 1024, 1024, kb * 64, nb * 32, W2T + (size_t)le * 1024 * 1024, 1024, nb * 32, scr, lane); }
    }
    {
        const int gt = (F.vcu * NWAVES + F.wave) * 64 + lane, NGT = NGW * 64;
        const float* sgw = (const float*)a.in[I_SGW]; bf16_t* SGW = WSP(bf16_t, WS_SGW);
        for (int i = gt; i < 2 * 8 * 128 * 128; i += NGT) { const int s = i & 127, t = (i >> 7) & 127; SGW[i] = (bf16_t)(cvtpk(s <= t ? sgw[i] : 0.f, 0.f) & 0xffffu); }
        const int* pos = (const int*)a.in[I_POS]; float* rope = WSP(float, WS_ROPE);
        for (int i = gt; i < T * 32; i += NGT) { const int tok = i >> 5, d = i & 31;
            const double inv = exp2(-(double)d * (13.287712379549449 / 32.0));
            const double rv = (double)pos[tok] * inv * 0.15915494309189535; const float fr = (float)(rv - __builtin_rint(rv));
            rope[2 * i] = __builtin_amdgcn_cosf(fr); rope[2 * i + 1] = __builtin_amdgcn_sinf(fr); }
        bf16_t* H = WSP(bf16_t, WS_H);
        for (int i = gt; i < 1024; i += NGT) { H[(size_t)T * 1024 + i] = 0; WSP(unsigned char, WS_H8)[(size_t)T * 1024 + i] = 0; }
        bf16_t* KCMP = WSP(bf16_t, WS_KCMP); bf16_t* VCT = WSP(bf16_t, WS_VCT);
        for (int i = gt; i < 2 * 2 * 64; i += NGT) { const int b = i >> 7, g = (i >> 6) & 1, d = i & 63; KCMP[(size_t)(b * 2 + g) * 512 * 64 + kfrag_off(511, d >> 3) + (d & 7)] = 0; VCT[(size_t)(b * 2 + g) * 512 * 64 + vfrag_off(511, d)] = 0; }
    }
    {
        float* cb = WSP(float, WS_MISC);
        for (int it = gw; it < 2 * 2 * 64; it += NGW) { const int l = it >> 7, which = (it >> 6) & 1, n = it & 63;
            const float* pe = (const float*)a.in[which ? I_PEV : I_PEK] + (size_t)l * 2048; const float* w1 = (const float*)a.in[which ? I_CW1V : I_CW1K] + (size_t)l * 2048 * 64;
            float s = 0.f; for (int k = lane; k < 2048; k += 64) s += pe[k] * w1[(size_t)k * 64 + n];
            s = wave_sum(s); if (lane == 0) cb[it] = s; }
    }
}

struct RowV { f32x4 v[4]; };
__device__ __forceinline__ RowV row_load(const float* p, int lane) { RowV r; const f32x4* q = (const f32x4*)p + lane;
#pragma unroll
    for (int j = 0; j < 4; ++j) r.v[j] = q[64 * j]; return r; }
__device__ __forceinline__ float row_ssq(const RowV& r) { float s = 0.f;
#pragma unroll
    for (int j = 0; j < 4; ++j) s += (r.v[j].x * r.v[j].x + r.v[j].y * r.v[j].y) + (r.v[j].z * r.v[j].z + r.v[j].w * r.v[j].w); return wave_sum(s); }
__device__ __forceinline__ void row_norm_store(const RowV& x, float rstd, const float* g, const float* sc, const float* sh, bf16_t* orow, int lane) {
    u32x2* o8 = (u32x2*)orow + lane;
#pragma unroll
    for (int j = 0; j < 4; ++j) { const f32x4 gg = ((const f32x4*)g)[lane + 64 * j], ss = ((const f32x4*)sc)[lane + 64 * j], hh = ((const f32x4*)sh)[lane + 64 * j];
        const f32x4 y = x.v[j] * rstd * gg * (ss + 1.f) + hh; u32x2 w; w.x = cvtpk(y.x, y.y); w.y = cvtpk(y.z, y.w); o8[64 * j] = w; }
}
__device__ __forceinline__ void row_norm_store8(const RowV& x, float rstd, const float* g, const float* sc, const float* sh, unsigned char* orow, int lane) {
    unsigned* o4 = (unsigned*)orow + lane;
#pragma unroll
    for (int j = 0; j < 4; ++j) { const f32x4 gg = ((const f32x4*)g)[lane + 64 * j], ss = ((const f32x4*)sc)[lane + 64 * j], hh = ((const f32x4*)sh)[lane + 64 * j];
        const f32x4 y = x.v[j] * rstd * gg * (ss + 1.f) + hh; o4[64 * j] = cvt4_fp8(y.x, y.y, y.z, y.w); }
}
__device__ __forceinline__ int expert_block_prefix(const unsigned* cnt, int lane) {
    int nb = (lane < NE) ? (int)((cnt[lane] + 255u) >> 8) : 0; int inc = nb;
#pragma unroll
    for (int o = 1; o < 32; o <<= 1) { const int t = __shfl_up(inc, o); if ((lane & 31) >= o) inc += t; }
    return inc - nb;
}
__device__ __forceinline__ void phase_n1_first(Frame& F, const Args& a) {
    const int gw = F.vcu * NWAVES + F.wave, NGW = F.G * NWAVES; const int lane = F.lane;
    const float* x = (const float*)a.in[I_X]; const float* g = (const float*)a.in[I_N1G]; bf16_t* H = WSP(bf16_t, WS_H);
    for (int m = gw; m < T; m += 2 * NGW) { const int m2 = m + NGW; const int b = m >> 13, b2 = m2 >> 13;
        const RowV r = row_load(x + (size_t)m * DM, lane); const RowV r2 = row_load(x + (size_t)m2 * DM, lane);
        const float rstd = 1.f / sqrtf(row_ssq(r) * (1.f / DM) + NORM_EPS), rstd2 = 1.f / sqrtf(row_ssq(r2) * (1.f / DM) + NORM_EPS);
        row_norm_store(r, rstd, g, MODP(0, b, 1), MODP(0, b, 0), H + (size_t)m * DM, lane);
        row_norm_store(r2, rstd2, g, MODP(0, b2, 1), MODP(0, b2, 0), H + (size_t)m2 * DM, lane); }
    float* RWP = WSP(float, WS_RWP); float* RBP = WSP(float, WS_MISC + 4096);
    const float* rw = (const float*)a.in[I_RW]; const float* rb = (const float*)a.in[I_RB]; const float* n2g = (const float*)a.in[I_N2G];
    const int gt = gw * 64 + lane, NGT = NGW * 64;
    for (int i = gt; i < 2 * 2 * 1024 * 32; i += NGT) { const int l = i >> 16, b = (i >> 15) & 1, k = (i >> 5) & 1023, e = i & 31;
        RWP[i] = n2g[l * 1024 + k] * (1.f + MODP(l, b, 4)[k]) * rw[((size_t)l * 1024 + k) * 32 + e]; }
    for (int it = gw; it < 2 * 2 * 32; it += NGW) { const int l = it >> 6, b = (it >> 5) & 1, e = it & 31; float s = 0.f;
        for (int k = lane; k < 1024; k += 64) s += MODP(l, b, 3)[k] * rw[((size_t)l * 1024 + k) * 32 + e];
        s = wave_sum(s); if (lane == 0) RBP[it] = s + rb[l * 32 + e]; }
}
__device__ __forceinline__ void phase_combine(Frame& F, const Args& a, int l) {
    const int gw = F.vcu * NWAVES + F.wave, NGW = F.G * NWAVES; const int lane = F.lane;
    float* XR = WSP(float, WS_XR); bf16_t* H = WSP(bf16_t, WS_H); const bf16_t* YR = WSP(bf16_t, WS_YROWS);
    const int* ASG = WSP(int, WS_ASG); const float* G4 = WSP(float, WS_GATE4);
    const int myprefix = expert_block_prefix(F.ctl + CW_CNT + l * 32, lane);
    const bool last = (l == DEPTH - 1);
    const float* g = last ? (const float*)a.in[I_FING] : (const float*)a.in[I_N1G] + (l + 1) * 1024;
#define COMB_LOAD(R_, WV_, GT_, M_) do { const int4 as4_ = *(const int4*)(ASG + (M_) * 4); const f32x4 gt4_ = *(const f32x4*)(G4 + (M_) * 4); \
        R_ = row_load(XR + (size_t)(M_) * DM, lane); const int asv_[4] = {as4_.x, as4_.y, as4_.z, as4_.w}; GT_[0] = gt4_.x; GT_[1] = gt4_.y; GT_[2] = gt4_.z; GT_[3] = gt4_.w; \
        _Pragma("unroll") for (int k = 0; k < 4; ++k) { const int e = asv_[k] >> 16, slot = asv_[k] & 0xffff; const int blk = __shfl(myprefix, e); \
            const u32x2* yr = (const u32x2*)(YR + ((size_t)blk * 256 + slot) * DM) + lane; _Pragma("unroll") for (int j = 0; j < 4; ++j) WV_[k][j] = __builtin_nontemporal_load(yr + 64 * j); } } while (0)
#define COMB_FINISH(R_, WV_, GT_, M_) do { const int b = (M_) >> 13; f32x4 y[4]; \
        _Pragma("unroll") for (int j = 0; j < 4; ++j) y[j] = (f32x4){0.f, 0.f, 0.f, 0.f}; \
        _Pragma("unroll") for (int k = 0; k < 4; ++k) _Pragma("unroll") for (int j = 0; j < 4; ++j) { const u32x2 w = WV_[k][j]; y[j] += (f32x4){bflo(w.x), bfhi(w.x), bflo(w.y), bfhi(w.y)} * GT_[k]; } \
        const float* g2 = MODP(l, b, 5); \
        _Pragma("unroll") for (int j = 0; j < 4; ++j) R_.v[j] += ((const f32x4*)g2)[lane + 64 * j] * y[j]; \
        const float rstd = 1.f / sqrtf(row_ssq(R_) * (1.f / DM) + NORM_EPS); \
        if (last) { f32x4* o = (f32x4*)(a.out + (size_t)(M_) * DM) + lane; _Pragma("unroll") for (int j = 0; j < 4; ++j) o[64 * j] = R_.v[j] * rstd * ((const f32x4*)g)[lane + 64 * j]; } \
        else { f32x4* xo = (f32x4*)(XR + (size_t)(M_) * DM) + lane; _Pragma("unroll") for (int j = 0; j < 4; ++j) xo[64 * j] = R_.v[j]; \
            row_norm_store(R_, rstd, g, MODP(l + 1, b, 1), MODP(l + 1, b, 0), H + (size_t)(M_) * DM, lane); } } while (0)
    for (int m = gw; m < T; m += 2 * NGW) { const int m2 = m + NGW;
        RowV rA, rB; u32x2 wA[4][4], wB[4][4]; float gA[4], gB[4];
        COMB_LOAD(rA, wA, gA, m); COMB_LOAD(rB, wB, gB, m2);
        COMB_FINISH(rA, wA, gA, m); COMB_FINISH(rB, wB, gB, m2);
    }
#undef COMB_LOAD
#undef COMB_FINISH
}
__device__ __forceinline__ void compress_item(Frame& F, const Args& a, int l, int item) {
    const int which = item >> 7, b = (item >> 6) & 1, g = (item >> 5) & 1, n0 = (item & 31) * 16;
    const int lane = F.lane, w = F.wave, r16 = lane & 15, kg = lane >> 4;
    const bf16_t* src = WSP(bf16_t, which ? WS_VC : WS_KC);
    const bf16_t* W1 = WSP(bf16_t, WS_CW1) + (size_t)(l * 2 + which) * 64 * 2048;
    LAS float* red = (LAS float*)F.lds;
    LAS float* hid = (LAS float*)(F.lds + 32768);
    f32x4 acc[4];
#pragma unroll
    for (int i = 0; i < 4; ++i) acc[i] = (f32x4){0.f, 0.f, 0.f, 0.f};
    const int n = n0 + r16; const bool nval = n < NCMP;
#pragma unroll 2
    for (int ks = 0; ks < 8; ++ks) { const int k = 256 * w + 32 * ks + 8 * kg; const int li = k >> 6, d = k & 63;
        bf16x8 af = (bf16x8){0, 0, 0, 0, 0, 0, 0, 0};
        if (nval) af = *(const bf16x8*)(src + ((size_t)b * SEQ + 16 * n + li) * 128 + g * 64 + d);
#pragma unroll
        for (int nt = 0; nt < 4; ++nt) { const bf16x8 bf = *(const bf16x8*)(W1 + (size_t)(nt * 16 + r16) * 2048 + k); acc[nt] = __builtin_amdgcn_mfma_f32_16x16x32_bf16(af, bf, acc[nt], 0, 0, 0); } }
#pragma unroll
    for (int nt = 0; nt < 4; ++nt)
#pragma unroll
        for (int i = 0; i < 4; ++i) red[(w * 16 + 4 * kg + i) * 64 + nt * 16 + r16] = acc[nt][i];
    __syncthreads();
    const float* cb = WSP(float, WS_MISC) + (l * 2 + which) * 64;
    for (int i = F.tid; i < 1024; i += NTHREADS) { float s = cb[i & 63];
#pragma unroll
        for (int ww = 0; ww < 8; ++ww) s += red[ww * 1024 + i];
        hid[i] = gelu_tanh(s); }
    { const float* w2 = (const float*)a.in[which ? I_CW2V : I_CW2K] + (size_t)l * 4096; LAS f32x4* w2s4 = (LAS f32x4*)(F.lds + 40960);
      for (int i = F.tid; i < 1024; i += NTHREADS) w2s4[i] = ((const f32x4*)w2)[i]; }
    __syncthreads();
    {
        const int nn = F.tid >> 5, c = F.tid & 31; LAS float* w2s = (LAS float*)(F.lds + 40960);
        float o1 = 0.f, o2 = 0.f;
#pragma unroll 16
        for (int k = 0; k < 64; ++k) { const float h = hid[nn * 64 + k]; o1 += h * w2s[k * 64 + c]; o2 += h * w2s[k * 64 + c + 32]; }
        const int np = n0 + nn; float nsq_ = 0.f;
        if (np < NCMP) {
            if (!which) { const float* cs = WSP(float, WS_ROPE) + (((size_t)b * SEQ + 16 * np + 31) * 32 + c) * 2; const float cc = cs[0], ss = cs[1];
                const float r1 = o1 * cc - o2 * ss, r2 = o2 * cc + o1 * ss;
                bf16_t* img = WSP(bf16_t, WS_KCMP) + (size_t)(b * 2 + g) * 512 * 64; img[kfrag_off(np, c >> 3) + (c & 7)] = (bf16_t)(cvtpk(r1, 0.f) & 0xffffu); img[kfrag_off(np, 4 + (c >> 3)) + (c & 7)] = (bf16_t)(cvtpk(r2, 0.f) & 0xffffu);
                nsq_ = r1 * r1 + r2 * r2;
            } else { bf16_t* img = WSP(bf16_t, WS_VCT) + (size_t)(b * 2 + g) * 512 * 64; img[vfrag_off(np, c)] = (bf16_t)(cvtpk(o1, 0.f) & 0xffffu); img[vfrag_off(np, c + 32)] = (bf16_t)(cvtpk(o2, 0.f) & 0xffffu); }
        }
        if (!which) {
            float mx = quad_sum(nsq_);
            mx += __uint_as_float(__builtin_amdgcn_update_dpp(0u, __float_as_uint(mx), 0x141, 0xF, 0xF, true)); mx += __uint_as_float(__builtin_amdgcn_update_dpp(0u, __float_as_uint(mx), 0x140, 0xF, 0xF, true));
            mx = x16_sum(mx);
            mx = x32_max(mx);
            if (F.lane == 0) atomicMax(F.ctl + CW_KMAX + l * 16 + 12 + b * 2 + g, __float_as_uint(mx * 1.02f));
        }
    }
    __syncthreads();
}
__device__ __forceinline__ void sgu_item(Frame& F, const Args& a, int l, int item) {
    const int hh = item & 1, ch = item >> 1;
    const size_t tok0 = (size_t)ch * 128;
    const int lane = F.lane, w = F.wave, r16 = lane & 15, kg = lane >> 4;
    const bf16_t* VG = WSP(bf16_t, WS_VG); const bf16_t* UG = WSP(bf16_t, WS_UG); bf16_t* Y = WSP(bf16_t, WS_Y);
    LAS float* stats = (LAS float*)F.lds;
    LAS bf16_t* vnT = (LAS bf16_t*)(F.lds + 1024);
    constexpr int VP = 136;
    for (int tt = 0; tt < 16; ++tt) { const int s = 16 * w + tt; const u32x4 v = *(const u32x4*)(VG + (tok0 + s) * 512 + lane * 8);
        const float f[8] = {bflo(v.x), bfhi(v.x), bflo(v.y), bfhi(v.y), bflo(v.z), bfhi(v.z), bflo(v.w), bfhi(v.w)};
        float sm = 0.f;
#pragma unroll
        for (int i = 0; i < 8; ++i) sm += f[i];
        const float mu = wave_sum(sm) * (1.f / 512.f); float q = 0.f;
#pragma unroll
        for (int i = 0; i < 8; ++i) q += (f[i] - mu) * (f[i] - mu);
        const float var = wave_sum(q) * (1.f / 512.f);
        if (lane == 0) { stats[2 * s] = mu; stats[2 * s + 1] = 1.f / sqrtf(var + NORM_EPS); } }
    __syncthreads();
    {
        const int s = F.tid & 127, hl = F.tid >> 7; const float mu = stats[2 * s], rs = stats[2 * s + 1];
        const int cbase = (4 * hh + hl) * 64; const float* lg = (const float*)a.in[I_SGLNG] + l * 512 + cbase; const float* lb = (const float*)a.in[I_SGLNB] + l * 512 + cbase;
#pragma unroll 2
        for (int d0 = 0; d0 < 64; d0 += 8) { const u32x4 v = *(const u32x4*)(VG + (tok0 + s) * 512 + cbase + d0);
            const float f[8] = {bflo(v.x), bfhi(v.x), bflo(v.y), bfhi(v.y), bflo(v.z), bfhi(v.z), bflo(v.w), bfhi(v.w)};
#pragma unroll
            for (int i = 0; i < 8; ++i) vnT[(hl * 64 + d0 + i) * VP + s] = (bf16_t)(cvtpk((f[i] - mu) * rs * lg[d0 + i] + lb[d0 + i], 0.f) & 0xffffu); }
    }
    __syncthreads();
    {
        const int hl = w & 3, th = w >> 2, h = 4 * hh + hl;
        const bf16_t* Wm = WSP(bf16_t, WS_SGW) + (size_t)(l * 8 + h) * 128 * 128; const float* bs = (const float*)a.in[I_SGB] + (size_t)(l * 8 + h) * 128;
        for (int tt = 4 * th; tt < 4 * th + 4; ++tt) {
            f32x4 acc[4];
#pragma unroll
            for (int i = 0; i < 4; ++i) acc[i] = (f32x4){0.f, 0.f, 0.f, 0.f};
            const int nks = (16 * tt + 15) / 32 + 1;
            for (int ks = 0; ks < nks; ++ks) { const bf16x8 bfr = *(const bf16x8*)(Wm + (size_t)(16 * tt + r16) * 128 + 32 * ks + 8 * kg);
#pragma unroll
                for (int dt = 0; dt < 4; ++dt) { const bf16x8 afr = *(const LAS bf16x8*)(vnT + (hl * 64 + dt * 16 + r16) * VP + 32 * ks + 8 * kg); acc[dt] = __builtin_amdgcn_mfma_f32_16x16x32_bf16(afr, bfr, acc[dt], 0, 0, 0); } }
            const int t = 16 * tt + r16; const float bb = bs[t];
#pragma unroll
            for (int dt = 0; dt < 4; ++dt) { const size_t off = (tok0 + t) * 512 + h * 64 + dt * 16 + 4 * kg; const u32x2 uu = *(const u32x2*)(UG + off);
                u32x2 o; o.x = cvtpk(bflo(uu.x) * (acc[dt][0] + bb), bfhi(uu.x) * (acc[dt][1] + bb)); o.y = cvtpk(bflo(uu.y) * (acc[dt][2] + bb), bfhi(uu.y) * (acc[dt][3] + bb));
                *(u32x2*)(Y + (tok0 + t) * 1024 + h * 64 + dt * 16 + 4 * kg) = o; }
        }
    }
    __syncthreads();
}

namespace att {
constexpr int OSP = 65;
constexpr int L_OH = 0;
constexpr int L_OL = 66560;
constexpr int L_LS = 133120;
constexpr int L_MREF = L_LS + 2048;
constexpr int USP = 129;
constexpr int L_SEL = L_MREF + 1024;
constexpr int L_CNT = L_SEL + 1024;
constexpr int L_LIST = L_CNT + 512;
constexpr int L_WCTR = L_LIST + 8192;
static_assert(L_WCTR + 16 <= ATT_LDS_BYTES, "attention LDS map");

struct Ptrs { const bf16_t *Q, *KS, *KW, *VST, *VWT, *KCMP, *VCT; const float* GATES; bf16_t* Y; float* YPART; float kmax, vmax, kwmax, kcmax; };

#define MFMA16(a, b, c) __builtin_amdgcn_mfma_f32_16x16x32_bf16(a, b, c, 0, 0, 0)

__device__ __forceinline__ void attn_unit(Frame& F, const Ptrs& P, int b, int g, int qb) {
    LAS unsigned char* lds = F.lds;
    const int tid = F.tid, lane = F.lane, w = F.wave, r16 = lane & 15, kg = lane >> 4;
    LAS int* Oh = (LAS int*)(lds + L_OH); LAS int* Ol = (LAS int*)(lds + L_OL); LAS float* imp = (LAS float*)(lds + L_OH);
    LAS int* lsel = (LAS int*)(lds + L_LS); LAS float* mref = (LAS float*)(lds + L_MREF);
    LAS unsigned* selm = (LAS unsigned*)(lds + L_SEL); LAS int* cnts = (LAS int*)(lds + L_CNT); LAS unsigned char* lists = lds + L_LIST; LAS int* wctr = (LAS int*)(lds + L_WCTR);
    const size_t tokb = (size_t)b * SEQ; const int t0 = qb * 64;
    const bf16_t* Qg = P.Q + (tokb + t0) * 512 + g * 256;
    LAS float* U = (LAS float*)(lds + L_OH); LAS float* linvc = (LAS float*)(lds + L_LS);
    {
        const int q = tid >> 3, part = tid & 7, hd = part >> 1, hf = part & 1;
        const u32x4* src = (const u32x4*)(Qg + (size_t)q * 512 + part * 32);
        float ss = 0.f;
#pragma unroll
        for (int i = 0; i < 4; ++i) { const u32x4 v = src[i]; const float f[8] = {bflo(v.x), bfhi(v.x), bflo(v.y), bfhi(v.y), bflo(v.z), bfhi(v.z), bflo(v.w), bfhi(v.w)};
#pragma unroll
            for (int k = 0; k < 8; ++k) ss += f[k] * f[k]; }
        ss += __uint_as_float(__builtin_amdgcn_update_dpp(0u, __float_as_uint(ss), 0xB1, 0xF, 0xF, true));
        if (hf == 0) mref[q * 4 + hd] = sqrtf(ss);
        for (int i = tid; i < 256 * USP; i += NTHREADS) U[i] = 0.f;
    }
    __syncthreads();
    const int hl = r16 & 3;
#define ATT_LDK(dst, base, key0) do { const char* kb_ = (const char*)(base) + (size_t)(key0) * 128; _Pragma("unroll") for (int u_ = 0; u_ < 2; ++u_) _Pragma("unroll") for (int ks_ = 0; ks_ < 2; ++ks_) \
        dst[u_][ks_] = *(const bf16x8*)(kb_ + koff + (u_ * 2 + ks_) * 1024); } while (0)
#define ATT_LDV(dst, vbase, LEN, key0) do { const char* vb_ = (const char*)(vbase) + (size_t)(key0) * 128; _Pragma("unroll") for (int dt_ = 0; dt_ < 4; ++dt_) \
        dst[dt_] = *(const bf16x8*)(vb_ + koff + dt_ * 1024); } while (0)
#define ATT_SHADOW() int ln_ = F.lane; asm volatile("" : "+v"(ln_)); const int r16 = ln_ & 15, kg = ln_ >> 4, hl = r16 & 3; const unsigned koff = (unsigned)ln_ * 16u
    {
        ATT_SHADOW();
        bf16x8 qf[2][2]; float mrc[2], lpart[2], carry[2] = {0.f, 0.f}; int nlim[2]; f32x4 o[2][4];
#pragma unroll
        for (int rt = 0; rt < 2; ++rt) { const int q = 8 * w + 4 * rt + (r16 >> 2);
#pragma unroll
            for (int ks = 0; ks < 2; ++ks) qf[rt][ks] = *(const bf16x8*)(Qg + (size_t)q * 512 + hl * 64 + ks * 32 + kg * 8);
            mrc[rt] = mref[q * 4 + hl] * P.kcmax; lpart[rt] = 0.f; nlim[rt] = (t0 + q - 31) >> 4;
#pragma unroll
            for (int dt = 0; dt < 4; ++dt) o[rt][dt] = (f32x4){0.f, 0.f, 0.f, 0.f}; }
        const int nkeys = 4 * qb + 3, NP = (nkeys + 31) >> 5;
        const int nlim_min = (t0 + 8 * w - 31) >> 4;
        const bf16_t* Kc = P.KCMP + (size_t)(b * 2 + g) * 512 * 64; const bf16_t* Vc = P.VCT + (size_t)(b * 2 + g) * 64 * 512;
#define ATT_S1_STEP(KF, VF, s_) do { _Pragma("unroll") for (int rt = 0; rt < 2; ++rt) { \
            f32x4 st[2]; float p[2][4]; \
            _Pragma("unroll") for (int u = 0; u < 2; ++u) { st[u] = MFMA16(KF[u][0], qf[rt][0], ((f32x4){0.f, 0.f, 0.f, 0.f})); st[u] = MFMA16(KF[u][1], qf[rt][1], st[u]); } \
            _Pragma("unroll") for (int u = 0; u < 2; ++u) _Pragma("unroll") for (int i = 0; i < 4; ++i) p[u][i] = fast_exp2(st[u][i] - mrc[rt]); \
            if (32 * (s_) + 31 > nlim_min) { _Pragma("unroll") for (int u = 0; u < 2; ++u) _Pragma("unroll") for (int i = 0; i < 4; ++i) { const int n = 32 * (s_) + 8 * kg + 4 * u + i; if (n > nlim[rt]) p[u][i] = 0.f; } } \
            const float s01 = (p[0][0] + p[0][1]) + (p[0][2] + p[0][3]), s11 = (p[1][0] + p[1][1]) + (p[1][2] + p[1][3]); lpart[rt] += s01 + s11; \
            {   \
                \
              const unsigned x_ = __float_as_uint(p[1][3]); const auto s16_ = __builtin_amdgcn_permlane16_swap(x_, x_, false, false); const auto s32_ = __builtin_amdgcn_permlane32_swap(s16_[1], s16_[1], false, false); \
              const float inc_ = (kg & 1) ? __uint_as_float(s16_[0]) : ((kg == 2) ? __uint_as_float(s32_[0]) : carry[rt]); carry[rt] = __uint_as_float(s32_[1]); \
              LAS float* ur = U + ((8 * w + 4 * rt + (r16 >> 2)) * 4 + hl) * USP + 8 * (s_) + 2 * kg; \
              ur[0] += (2.f * s01 - p[0][3]) + inc_; ur[1] += (2.f * s11 - p[1][3]) + p[0][3]; } \
            u32x4 pw; pw.x = cvtpk(p[0][0], p[0][1]); pw.y = cvtpk(p[0][2], p[0][3]); pw.z = cvtpk(p[1][0], p[1][1]); pw.w = cvtpk(p[1][2], p[1][3]); \
            const bf16x8 pf = __builtin_bit_cast(bf16x8, pw); \
            _Pragma("unroll") for (int dt = 0; dt < 4; ++dt) o[rt][dt] = MFMA16(VF[dt], pf, o[rt][dt]); } } while (0)
        {
            bf16x8 kA[2][2], vA[4], kB[2][2], vB[4];
            ATT_LDK(kA, Kc, 0); ATT_LDV(vA, Vc, 512, 0); if (NP > 1) { ATT_LDK(kB, Kc, 32); ATT_LDV(vB, Vc, 512, 32); }
#pragma nounroll
            for (int s2 = 0; s2 < NP; s2 += 2) {
                ATT_S1_STEP(kA, vA, s2);
                if (s2 + 2 < NP) { ATT_LDK(kA, Kc, 32 * (s2 + 2)); ATT_LDV(vA, Vc, 512, 32 * (s2 + 2)); }
                if (s2 + 1 < NP) { ATT_S1_STEP(kB, vB, s2 + 1);
                    if (s2 + 3 < NP) { ATT_LDK(kB, Kc, 32 * (s2 + 3)); ATT_LDV(vB, Vc, 512, 32 * (s2 + 3)); } }
            }
        }
#undef ATT_S1_STEP
#pragma unroll
        for (int rt = 0; rt < 2; ++rt) { const int q = 8 * w + 4 * rt + (r16 >> 2); const float lrow = kg_sum(lpart[rt]); const float linv = lrow > 0.f ? 1.f / lrow : 0.f;
            if (kg == 0) linvc[q * 4 + hl] = linv;
            const float gc = P.GATES[(tokb + t0 + q) * 24 + (g * 4 + hl) * 3 + 0] * linv;
            float* yp = P.YPART + (tokb + t0 + q) * 512 + (g * 4 + hl) * 64 + 4 * kg;
#pragma unroll
            for (int dt = 0; dt < 4; ++dt) *(f32x4*)(yp + dt * 16) = o[rt][dt] * gc; }
    }
    LDS_WAIT();
#pragma nounroll
    for (int qg = 0; qg < 2; ++qg) {
        if (qb <= 15) {
            if (lane < 4) { const int q = 8 * w + 4 * qg + lane; const unsigned long long m0 = (1ull << (qb + 1)) - 1ull;
                selm[q * 4 + 0] = (unsigned)m0; selm[q * 4 + 1] = (unsigned)(m0 >> 32); selm[q * 4 + 2] = 0u; selm[q * 4 + 3] = 0u; }
        } else {
            const int j0 = lane, j1 = lane + 64; int v0[4], v1[4], thr[4];
#pragma unroll
            for (int k = 0; k < 4; ++k) { const int q = 8 * w + 4 * qg + k; const LAS float* ur = U + (q * 4) * USP; const LAS float* li = linvc + q * 4;
                float i0 = 0.f, i1 = 0.f;
#pragma unroll
                for (int h = 0; h < 4; ++h) { i0 += ur[h * USP + j0] * li[h]; i1 += ur[h * USP + j1] * li[h]; }
                v0[k] = (j0 >= 1 && j0 <= qb - 2) ? (int)__float_as_uint(i0) : -1;
                v1[k] = (j1 <= qb - 2) ? (int)__float_as_uint(i1) : -1; thr[k] = 0; }
#pragma nounroll
            for (int bit = 30; bit >= 0; --bit) {
#pragma unroll
                for (int k = 0; k < 4; ++k) { const int cand = thr[k] | (1 << bit);
                    const int c = __popcll(__ballot(v0[k] >= cand)) + __popcll(__ballot(v1[k] >= cand)); if (c >= 13) thr[k] = cand; } }
            const unsigned long long below = (1ull << lane) - 1ull;
#pragma nounroll
            for (int k = 0; k < 4; ++k) {
                const int vv0 = (k == 0) ? v0[0] : (k == 1) ? v0[1] : (k == 2) ? v0[2] : v0[3], vv1 = (k == 0) ? v1[0] : (k == 1) ? v1[1] : (k == 2) ? v1[2] : v1[3];
                const int th = (k == 0) ? thr[0] : (k == 1) ? thr[1] : (k == 2) ? thr[2] : thr[3];
                const bool gt0 = vv0 > th, gt1 = vv1 > th, eq0 = vv0 == th, eq1 = vv1 == th;
                const int need = 13 - (__popcll(__ballot(gt0)) + __popcll(__ballot(gt1)));
                const unsigned long long B0 = __ballot(eq0), B1 = __ballot(eq1);
                const int rk0 = __popcll(B0 & below), rk1 = __popcll(B0) + __popcll(B1 & below);
                unsigned long long m0 = __ballot(gt0 || (eq0 && rk0 < need)), m1 = __ballot(gt1 || (eq1 && rk1 < need));
                m0 |= 1ull;
                if (qb < 64) m0 |= (1ull << qb); else m1 |= (1ull << (qb - 64));
                if (qb - 1 < 64) m0 |= (1ull << (qb - 1)); else m1 |= (1ull << (qb - 65));
                if (lane == 0) { const int q = 8 * w + 4 * qg + k; selm[q * 4 + 0] = (unsigned)m0; selm[q * 4 + 1] = (unsigned)(m0 >> 32); selm[q * 4 + 2] = (unsigned)m1; selm[q * 4 + 3] = (unsigned)(m1 >> 32); } }
        }
    }
    __syncthreads();
    for (int i = tid; i < 2 * 256 * OSP; i += NTHREADS) Oh[i] = 0;
    lsel[tid] = 0;
    if (tid == 0) wctr[0] = 0;
    if (tid < 128) { const int j = tid; int c = 0;
        if (j <= qb) for (int q = 0; q < 64; ++q) { if ((selm[q * 4 + (j >> 5)] >> (j & 31)) & 1u) { lists[j * 64 + c] = (unsigned char)q; ++c; } }
        cnts[j] = c; }
    __syncthreads();
    for (int rep5 = 0; rep5 < ((ATTREP & 8) ? NREP : 1); ++rep5)
    {
        if (rep5 > 0) { __syncthreads(); if (tid == 0) wctr[0] = 0; __syncthreads(); }
        ATT_SHADOW();
        const bf16_t* Ks = P.KS + (size_t)(b * 2 + g) * SEQ * 64; const bf16_t* Vs = P.VST + (size_t)(b * 2 + g) * 64 * SEQ;
        const float S1 = 1048576.f / fmaxf(P.vmax, 1e-30f);
#define ATT_FETCH(idx_) do { int i_ = 0; if (lane == 0) i_ = __hip_atomic_fetch_add(wctr, 1, __ATOMIC_RELAXED, __HIP_MEMORY_SCOPE_WORKGROUP); idx_ = __builtin_amdgcn_readfirstlane(i_); } while (0)
#define ATT_JOF(idx_) (((idx_) == 0) ? 0 : (((idx_) == 1) ? qb : (((idx_) == 2) ? qb - 1 : (idx_) - 2)))
        bf16x8 kn[2][2][2], vn[2][4];
        int idx; ATT_FETCH(idx);
        if (idx <= qb) { const int j = ATT_JOF(idx); ATT_LDK(kn[0], Ks, 64 * j); ATT_LDK(kn[1], Ks, 64 * j + 32); ATT_LDV(vn[0], Vs, SEQ, 64 * j); ATT_LDV(vn[1], Vs, SEQ, 64 * j + 32); }
#pragma nounroll
        while (idx <= qb) {
            const int j = ATT_JOF(idx);
            bf16x8 kf[2][2][2], vf[2][4];
#pragma unroll
            for (int sp = 0; sp < 2; ++sp) {
#pragma unroll
                for (int u = 0; u < 2; ++u) { kf[sp][u][0] = kn[sp][u][0]; kf[sp][u][1] = kn[sp][u][1]; }
#pragma unroll
                for (int dt = 0; dt < 4; ++dt) vf[sp][dt] = vn[sp][dt]; }
            int idx2; ATT_FETCH(idx2);
            if (idx2 <= qb) { const int j2 = ATT_JOF(idx2); ATT_LDK(kn[0], Ks, 64 * j2); ATT_LDK(kn[1], Ks, 64 * j2 + 32); ATT_LDV(vn[0], Vs, SEQ, 64 * j2); ATT_LDV(vn[1], Vs, SEQ, 64 * j2 + 32); }
            const int cnt = cnts[j];
            const int nch = (cnt + 3) >> 2;
            bf16x8 qn0, qn1; int qnx; bool vnx;
            { const int qs = (r16 >> 2); vnx = qs < cnt; qnx = lists[j * 64 + (vnx ? qs : (cnt > 0 ? cnt - 1 : 0))];
              const bf16_t* qp = Qg + (size_t)qnx * 512 + hl * 64 + kg * 8; qn0 = *(const bf16x8*)qp; qn1 = *(const bf16x8*)(qp + 32); }
#pragma nounroll
            for (int c = 0; c < nch; ++c) {
                const bool valid = vnx; const int q = qnx; const int row = q * 4 + hl; const bf16x8 q0 = qn0, q1 = qn1;
                if (c + 1 < nch) { const int qs = 4 * (c + 1) + (r16 >> 2); vnx = qs < cnt; qnx = lists[j * 64 + (vnx ? qs : cnt - 1)];
                    const bf16_t* qp = Qg + (size_t)qnx * 512 + hl * 64 + kg * 8; qn0 = *(const bf16x8*)qp; qn1 = *(const bf16x8*)(qp + 32); }
                const float mr = mref[row] * P.kmax;
                f32x4 o[4];
                float ps = 0.f;
                const bool slow = (j == qb) || (4 * c + 4 > cnt);
#define ATT_CHUNK(MASKED) \
                _Pragma("unroll") for (int sp = 0; sp < 2; ++sp) { \
                    f32x4 st[2]; float p[2][4]; \
                    _Pragma("unroll") for (int u = 0; u < 2; ++u) { st[u] = MFMA16(kf[sp][u][0], q0, ((f32x4){0.f, 0.f, 0.f, 0.f})); st[u] = MFMA16(kf[sp][u][1], q1, st[u]); } \
                    _Pragma("unroll") for (int u = 0; u < 2; ++u) _Pragma("unroll") for (int i = 0; i < 4; ++i) { float e = fast_exp2(st[u][i] - mr); \
                        if (MASKED) { const int kk = 32 * sp + 8 * kg + 4 * u + i; if (!valid || (j == qb && kk > q)) e = 0.f; } p[u][i] = e; ps += e; } \
                    u32x4 pw; pw.x = cvtpk(p[0][0], p[0][1]); pw.y = cvtpk(p[0][2], p[0][3]); pw.z = cvtpk(p[1][0], p[1][1]); pw.w = cvtpk(p[1][2], p[1][3]); \
                    const bf16x8 pf = __builtin_bit_cast(bf16x8, pw); \
                    _Pragma("unroll") for (int dt = 0; dt < 4; ++dt) o[dt] = (sp == 0) ? MFMA16(vf[0][dt], pf, ((f32x4){0.f, 0.f, 0.f, 0.f})) : MFMA16(vf[1][dt], pf, o[dt]); }
                if (slow) { ATT_CHUNK(true) } else { ATT_CHUNK(false) }
#undef ATT_CHUNK
                ps = kg_sum(ps);
                if (valid) {
                    if (kg == 0) { const float xs = ps * 1048576.f, hf_ = __builtin_rintf(xs); __hip_atomic_fetch_add(lsel + row, (int)hf_, __ATOMIC_RELAXED, __HIP_MEMORY_SCOPE_WORKGROUP);
                        __hip_atomic_fetch_add(lsel + 256 + row, (int)((xs - hf_) * 1048576.f), __ATOMIC_RELAXED, __HIP_MEMORY_SCOPE_WORKGROUP); }
#pragma unroll
                    for (int dt = 0; dt < 4; ++dt)
#pragma unroll
                        for (int i = 0; i < 4; ++i) { const float xs = o[dt][i] * S1, hf_ = __builtin_rintf(xs); const int off = row * OSP + dt * 16 + 4 * kg + i;
                            __hip_atomic_fetch_add(Oh + off, (int)hf_, __ATOMIC_RELAXED, __HIP_MEMORY_SCOPE_WORKGROUP);
                            __hip_atomic_fetch_add(Ol + off, (int)((xs - hf_) * 1048576.f), __ATOMIC_RELAXED, __HIP_MEMORY_SCOPE_WORKGROUP); }
                }
            }
            idx = idx2;
        }
    }
    f32x4 yacc[2][4];
    {
        ATT_SHADOW();
        bf16x8 qf[2][2]; float mrw[2], lpart[2]; f32x4 o[2][4];
#pragma unroll
        for (int rt = 0; rt < 2; ++rt) { const int q = 8 * w + 4 * rt + (r16 >> 2);
#pragma unroll
            for (int ks = 0; ks < 2; ++ks) qf[rt][ks] = *(const bf16x8*)(Qg + (size_t)q * 512 + hl * 64 + ks * 32 + kg * 8);
            mrw[rt] = mref[q * 4 + hl] * P.kwmax; lpart[rt] = 0.f;
#pragma unroll
            for (int dt = 0; dt < 4; ++dt) o[rt][dt] = (f32x4){0.f, 0.f, 0.f, 0.f}; }
        const bf16_t* Kw = P.KW + (size_t)(b * 2 + g) * SEQ * 64; const bf16_t* Vw = P.VWT + (size_t)(b * 2 + g) * 64 * SEQ;
        const int jlo = qb >= 8 ? qb - 8 : 0; const int nit = 2 * (qb - jlo + 1);
#define ATT_S4_STEP(KF, VF, it_) do { const int jw_ = jlo + ((it_) >> 1), sp_ = (it_) & 1; const int mode_ = (jw_ == qb) ? 1 : ((jw_ == qb - 8) ? 2 : 0); \
        _Pragma("unroll") for (int rt = 0; rt < 2; ++rt) { \
            f32x4 st[2]; float p[2][4]; \
            _Pragma("unroll") for (int u = 0; u < 2; ++u) { st[u] = MFMA16(KF[u][0], qf[rt][0], ((f32x4){0.f, 0.f, 0.f, 0.f})); st[u] = MFMA16(KF[u][1], qf[rt][1], st[u]); } \
            _Pragma("unroll") for (int u = 0; u < 2; ++u) _Pragma("unroll") for (int i = 0; i < 4; ++i) p[u][i] = fast_exp2(st[u][i] - mrw[rt]); \
            if (mode_) { const int tq = 8 * w + 4 * rt + (r16 >> 2); \
                _Pragma("unroll") for (int u = 0; u < 2; ++u) _Pragma("unroll") for (int i = 0; i < 4; ++i) { const int kk = 32 * sp_ + 8 * kg + 4 * u + i; const bool vis = (mode_ == 1) ? (kk <= tq) : (kk > tq); if (!vis) p[u][i] = 0.f; } } \
            lpart[rt] += ((p[0][0] + p[0][1]) + (p[0][2] + p[0][3])) + ((p[1][0] + p[1][1]) + (p[1][2] + p[1][3])); \
            u32x4 pw; pw.x = cvtpk(p[0][0], p[0][1]); pw.y = cvtpk(p[0][2], p[0][3]); pw.z = cvtpk(p[1][0], p[1][1]); pw.w = cvtpk(p[1][2], p[1][3]); \
            const bf16x8 pf = __builtin_bit_cast(bf16x8, pw); \
            _Pragma("unroll") for (int dt = 0; dt < 4; ++dt) o[rt][dt] = MFMA16(VF[dt], pf, o[rt][dt]); } } while (0)
        {
            bf16x8 kA[2][2], vA[4], kB[2][2], vB[4];
            ATT_LDK(kA, Kw, 64 * jlo); ATT_LDV(vA, Vw, SEQ, 64 * jlo); ATT_LDK(kB, Kw, 64 * jlo + 32); ATT_LDV(vB, Vw, SEQ, 64 * jlo + 32);
#pragma nounroll
            for (int it = 0; it < nit; it += 2) {
                ATT_S4_STEP(kA, vA, it);
                if (it + 2 < nit) { ATT_LDK(kA, Kw, 64 * jlo + 32 * (it + 2)); ATT_LDV(vA, Vw, SEQ, 64 * jlo + 32 * (it + 2)); }
                ATT_S4_STEP(kB, vB, it + 1);
                if (it + 3 < nit) { ATT_LDK(kB, Kw, 64 * jlo + 32 * (it + 3)); ATT_LDV(vB, Vw, SEQ, 64 * jlo + 32 * (it + 3)); }
            }
        }
#undef ATT_S4_STEP
#pragma unroll
        for (int rt = 0; rt < 2; ++rt) { const int q = 8 * w + 4 * rt + (r16 >> 2); const float lw_ = kg_sum(lpart[rt]); const float sc = lw_ > 0.f ? P.GATES[(tokb + t0 + q) * 24 + (g * 4 + hl) * 3 + 2] / lw_ : 0.f;
#pragma unroll
            for (int dt = 0; dt < 4; ++dt) yacc[rt][dt] = o[rt][dt] * sc; }
    }
    __syncthreads();
#pragma unroll
    for (int rt = 0; rt < 2; ++rt) { const int q = 8 * w + 4 * rt + (r16 >> 2), row = q * 4 + hl;
        const float lrow = (float)lsel[row] * (1.f / 1048576.f) + (float)lsel[256 + row] * (1.f / 1099511627776.f);
        const float invS1 = fmaxf(P.vmax, 1e-30f) * (1.f / 1048576.f);
        const float sc = lrow > 0.f ? P.GATES[(tokb + t0 + q) * 24 + (g * 4 + hl) * 3 + 1] / lrow * invS1 : 0.f;
        bf16_t* dst = P.Y + (tokb + t0 + q) * 1024 + 512 + (g * 4 + hl) * 64 + 4 * kg;
        const float* yp = P.YPART + (tokb + t0 + q) * 512 + (g * 4 + hl) * 64 + 4 * kg;
#pragma unroll
        for (int dt = 0; dt < 4; ++dt) { const LAS int* oh = Oh + row * OSP + dt * 16 + 4 * kg; const LAS int* ol = Ol + row * OSP + dt * 16 + 4 * kg;
            const f32x4 osel = (f32x4){(float)oh[0] + (float)ol[0] * (1.f / 1048576.f), (float)oh[1] + (float)ol[1] * (1.f / 1048576.f), (float)oh[2] + (float)ol[2] * (1.f / 1048576.f), (float)oh[3] + (float)ol[3] * (1.f / 1048576.f)};
            const f32x4 v = yacc[rt][dt] + *(const f32x4*)(yp + dt * 16) + osel * sc;
            u32x2 o; o.x = cvtpk(v[0], v[1]); o.y = cvtpk(v[2], v[3]); *(u32x2*)(dst + dt * 16) = o; } }
    __syncthreads();
}
#undef MFMA16
#undef ATT_LDK
#undef ATT_LDV
#undef ATT_SHADOW
#undef ATT_FETCH
#undef ATT_JOF
}

__device__ __forceinline__ void phase_n2(Frame& F, const Args& a, int l) {
    const int lane = F.lane, w = F.wave;
    const float* XR = WSP(float, WS_XR); unsigned char* H8 = WSP(unsigned char, WS_H8);
    const float* g = (const float*)a.in[I_N2G] + l * 1024;
    LAS float* part = (LAS float*)F.lds;
    LAS float* ssqp = (LAS float*)(F.lds + 32768);
    LAS float* lg = (LAS float*)(F.lds + 32768 + 1024);
    int* CNTI = WSP(int, WS_CNTI); int* ASG = WSP(int, WS_ASG); float* G4 = WSP(float, WS_GATE4);
    for (int item = F.vcu; item < T / 64; item += F.G) {
        const int tk0 = item * 64, b = tk0 >> 13; const int tt = w & 1, kq = w >> 1;
        const float* rwp = WSP(float, WS_RWP) + (size_t)(l * 2 + b) * 1024 * 32; const float* rbp = WSP(float, WS_MISC + 4096) + (l * 2 + b) * 32;
        const int i31 = lane & 31, hf = lane >> 5;
        {
            const float* xp = XR + (size_t)(tk0 + tt * 32 + i31) * DM + kq * 256 + 4 * hf; const float* wp = rwp + (size_t)(kq * 256 + 4 * hf) * 32 + i31;
            f32x16 acc;
#pragma unroll
            for (int r = 0; r < 16; ++r) acc[r] = 0.f;
            float ssq = 0.f;
#pragma nounroll
            for (int bt = 0; bt < 4; ++bt) {
                f32x4 xv[8]; float wv[8][4];
#pragma unroll
                for (int s = 0; s < 8; ++s) { xv[s] = *(const f32x4*)(xp + 8 * (bt * 8 + s)); const float* wq = wp + (size_t)(8 * (bt * 8 + s)) * 32;
                    wv[s][0] = wq[0]; wv[s][1] = wq[32]; wv[s][2] = wq[64]; wv[s][3] = wq[96]; }
#pragma unroll
                for (int s = 0; s < 8; ++s) { ssq += (xv[s].x * xv[s].x + xv[s].y * xv[s].y) + (xv[s].z * xv[s].z + xv[s].w * xv[s].w);
                    acc = __builtin_amdgcn_mfma_f32_32x32x2f32(xv[s].x, wv[s][0], acc, 0, 0, 0); acc = __builtin_amdgcn_mfma_f32_32x32x2f32(xv[s].y, wv[s][1], acc, 0, 0, 0);
                    acc = __builtin_amdgcn_mfma_f32_32x32x2f32(xv[s].z, wv[s][2], acc, 0, 0, 0); acc = __builtin_amdgcn_mfma_f32_32x32x2f32(xv[s].w, wv[s][3], acc, 0, 0, 0); }
            }
            ssq += __shfl_xor(ssq, 32);
            if (hf == 0) ssqp[kq * 64 + tt * 32 + i31] = ssq;
#pragma unroll
            for (int r = 0; r < 16; ++r) { const int tk = (r & 3) + 8 * (r >> 2) + 4 * hf; part[(w * 32 + tk) * 32 + i31] = acc[r]; }
        }
        __syncthreads();
        for (int i = F.tid; i < 64 * 32; i += NTHREADS) { const int tk = i >> 5, e = i & 31, t2 = tk >> 5, tl = tk & 31;
            const float sq = (ssqp[tk] + ssqp[64 + tk]) + (ssqp[128 + tk] + ssqp[192 + tk]); const float rstd = 1.f / sqrtf(sq * (1.f / DM) + NORM_EPS);
            const float v = (part[((0 * 2 + t2) * 32 + tl) * 32 + e] + part[((1 * 2 + t2) * 32 + tl) * 32 + e]) + (part[((2 * 2 + t2) * 32 + tl) * 32 + e] + part[((3 * 2 + t2) * 32 + tl) * 32 + e]);
            lg[tk * 33 + e] = v * rstd + rbp[e]; }
        __syncthreads();
        if (w < 2) {
            const int it = item * 2 + w;
            float v0 = -INFINITY, v1 = -INFINITY, v2 = -INFINITY, v3 = -INFINITY; int i0 = -1, i1 = -1, i2 = -1, i3 = -1;
            if (lane < 32) {
#pragma unroll 8
                for (int e = 0; e < 32; ++e) { const float v = lg[(w * 32 + lane) * 33 + e];
                    if (v > v3) { if (v > v2) { v3 = v2; i3 = i2; if (v > v1) { v2 = v1; i2 = i1; if (v > v0) { v1 = v0; i1 = i0; v0 = v; i0 = e; } else { v1 = v; i1 = e; } } else { v2 = v; i2 = e; } } else { v3 = v; i3 = e; } } }
            }
            const float e1 = __expf(v1 - v0), e2 = __expf(v2 - v0), e3 = __expf(v3 - v0); const float inv = 1.f / (1.f + e1 + e2 + e3);
            int r0 = 0, r1 = 0, r2 = 0, r3 = 0, mycnt = 0;
            for (int e = 0; e < 32; ++e) { const bool hit = (i0 == e) | (i1 == e) | (i2 == e) | (i3 == e); const unsigned long long U = __ballot(hit);
                const int rk = __popcll(U & ((1ull << lane) - 1ull));
                if (i0 == e) r0 = rk; if (i1 == e) r1 = rk; if (i2 == e) r2 = rk; if (i3 == e) r3 = rk;
                if (lane == e) mycnt = __popcll(U); }
            if (lane < 32) { const int tk = tk0 + w * 32 + lane; CNTI[it * 32 + lane] = mycnt;
                if (mycnt > 0) { atomicAdd(F.ctl + CW_GCNT + (l * 32 + (it >> 4)) * 32 + lane, (unsigned)mycnt); atomicAdd(F.ctl + CW_CNT + l * 32 + lane, (unsigned)mycnt); }
                *(int4*)(ASG + tk * 4) = make_int4((i0 << 16) | r0, (i1 << 16) | r1, (i2 << 16) | r2, (i3 << 16) | r3);
                *(f32x4*)(G4 + tk * 4) = (f32x4){inv, e1 * inv, e2 * inv, e3 * inv}; }
        }
#pragma unroll 2
        for (int rr = 0; rr < 8; ++rr) { const int m = tk0 + w * 8 + rr; const RowV r = row_load(XR + (size_t)m * DM, lane);
            const float rstd = 1.f / sqrtf(row_ssq(r) * (1.f / DM) + NORM_EPS);
            row_norm_store8(r, rstd, g, MODP(l, b, 4), MODP(l, b, 3), H8 + (size_t)m * DM, lane); }
        __syncthreads();
    }
}

__device__ __forceinline__ void phase_n2b(Frame& F, int l) {
    const int gw = F.vcu * NWAVES + F.wave, NGW = F.G * NWAVES; const int lane = F.lane;
    const int* CNTI = WSP(int, WS_CNTI); int* TOK = WSP(int, WS_TOK); int* ASG = WSP(int, WS_ASG); unsigned* cnt = F.ctl + CW_CNT + l * 32;
    for (int it = gw; it < T / 32; it += NGW) {
        int base = 0;
        {
            const unsigned* gc = F.ctl + CW_GCNT + l * 1024; const int grp = it >> 4, e = lane & 31; int s0 = 0, s1 = 0;
#pragma unroll
            for (int gI = 0; gI < 32; ++gI) { const int v = (int)gc[gI * 32 + e]; s0 += (gI < grp) ? v : 0; }
#pragma unroll
            for (int i = 0; i < 16; ++i) { const int v = CNTI[((grp << 4) + i) * 32 + e]; s1 += (((grp << 4) + i) < it) ? v : 0; }
            base = s0 + s1; }
        { const int tk = it * 32 + (lane & 31); const int4 as = *(const int4*)(ASG + tk * 4); int v[4] = {as.x, as.y, as.z, as.w};
#pragma unroll
            for (int k = 0; k < 4; ++k) { const int e = v[k] >> 16, rk = v[k] & 0xffff; const int sl = __shfl(base, e & 31) + rk; if (lane < 32) TOK[e * 16384 + sl] = tk; v[k] = (e << 16) | sl; }
            if (lane < 32) *(int4*)(ASG + tk * 4) = make_int4(v[0], v[1], v[2], v[3]); }
    }
}

__device__ __forceinline__ void moe_tables(Frame& F, int l, int NT, int& total) {
    LAS int* ust = (LAS int*)(F.lds + MOE_OFF); LAS int* bst = ust + 33; LAS int* cn = bst + 33;
    if (F.tid < 64) { const unsigned* cnt = F.ctl + CW_CNT + l * 32; const int lane = F.tid;
        const int c = (lane < NE) ? (int)cnt[lane] : 0; const int nb = (c + 255) >> 8; int inc = nb;
#pragma unroll
        for (int o = 1; o < 32; o <<= 1) { const int t = __shfl_up(inc, o); if ((lane & 31) >= o) inc += t; }
        if (lane < NE) { bst[lane] = inc - nb; ust[lane] = (inc - nb) * NT; cn[lane] = c; if (lane == NE - 1) { bst[NE] = inc; ust[NE] = inc * NT; } } }
    __syncthreads();
    total = ust[NE];
}

constexpr int PH_PROLOGUE = 0, PH_N1 = 1, PH_LAYER0 = 2, PH_PER_LAYER = 9, NPHASES = PH_LAYER0 + DEPTH * PH_PER_LAYER;
__global__ void __launch_bounds__(NTHREADS, 2) fwd_kernel(Args args) {
    extern __shared__ __attribute__((aligned(16))) unsigned char lds_raw[];
    Frame F;
    F.lds = (LAS unsigned char*)lds_raw; F.ws = args.ws; F.ctl = (unsigned*)(args.ws + WS_CTL);
    F.tid = threadIdx.x; F.lane = F.tid & 63; F.wave = __builtin_amdgcn_readfirstlane(F.tid >> 6);
    F.G = gridDim.x; { const int bx = blockIdx.x; F.vcu = (F.G % 8 == 0) ? (bx % 8) * (F.G / 8) + bx / 8 : bx; }
    for (int u = F.tid; u < (LDS_BYTES - LDSCTL_OFF) / 4; u += NTHREADS) ((LAS unsigned*)(F.lds + LDSCTL_OFF))[u] = 0u;
    __syncthreads();
    volatile LAS unsigned* MISC = (volatile LAS unsigned*)(F.lds + MISC_OFF);
    XcdBarrier bar; bar.bar = F.ctl + CW_BAR; bar.x = 0; bar.st = nullptr;
#if !MK_PER_PHASE
    bar = xcd_barrier_post(F.ctl + CW_BAR, MISC + 8);
#endif
    const int lo = args.ph_lo, hi = args.ph_hi;
#define IN(k) (lo <= (k) && (k) < hi)
#define REFRESH() do { int t_ = threadIdx.x; asm volatile("" : "+v"(t_)); F.tid = t_; F.lane = t_ & 63; F.wave = __builtin_amdgcn_readfirstlane(t_ >> 6); } while (0)
#define SEAM(k) do { if (IN(k) && IN((k) + 1)) xcd_barrier(bar); } while (0)
#define REPS(bit, idem) (((REPMASK & (bit)) && (idem)) ? NREP : 1)

    if (IN(PH_PROLOGUE) && !(SKIPMASK & 1)) for (int rep = 0; rep < REPS(1, true); ++rep) { REFRESH(); phase_prologue(F, args); } SEAM(PH_PROLOGUE);
    if (IN(PH_N1) && !(SKIPMASK & 2)) for (int rep = 0; rep < REPS(2, true); ++rep) { REFRESH(); phase_n1_first(F, args); } SEAM(PH_N1);
    for (int l = 0; l < DEPTH; ++l) {
        const int p0 = PH_LAYER0 + l * PH_PER_LAYER;
        if (IN(p0 + 0) && !(SKIPMASK & 4)) for (int rep = 0; rep < REPS(4, l == 0); ++rep) {
            pg8::DenseOrder S; S.init(T, PINP, F.G, (int)blockIdx.x);
            EpiProj E{WSP(bf16_t, WS_UG), WSP(bf16_t, WS_VG), WSP(bf16_t, WS_Q), WSP(bf16_t, WS_KC), WSP(bf16_t, WS_VC), WSP(bf16_t, WS_KS), WSP(bf16_t, WS_KW), WSP(bf16_t, WS_VST), WSP(bf16_t, WS_VWT),
                      WSP(float, WS_GATES), WSP(float, WS_ROPE), F.ctl + CW_KMAX + l * 16};
            pg8::gemm_phase<EpiProj, pg8::DenseOrder, false, true>(F.lds, WSP(bf16_t, WS_H), WSP(bf16_t, WS_WIN) + (size_t)l * PINP * 1024, 1024, S, E);
        }
        SEAM(p0 + 0);
        if (IN(p0 + 1) && !(SKIPMASK & 8)) for (int rep = 0; rep < REPS(8, l == 0); ++rep) { REFRESH();
            for (int it = F.vcu; it < 256 + 256; it += F.G) { if (it < 256) compress_item(F, args, l, it); else sgu_item(F, args, l, it - 256); }
        }
        SEAM(p0 + 1);
        if (IN(p0 + 2) && !(SKIPMASK & 16)) for (int rep = 0; rep < REPS(16, l == 0); ++rep) { REFRESH();
            att::Ptrs P{WSP(bf16_t, WS_Q), WSP(bf16_t, WS_KS), WSP(bf16_t, WS_KW), WSP(bf16_t, WS_VST), WSP(bf16_t, WS_VWT), WSP(bf16_t, WS_KCMP), WSP(bf16_t, WS_VCT), WSP(float, WS_GATES), WSP(bf16_t, WS_Y), WSP(float, WS_YPART), 0.f};
            for (int it = F.vcu; it < 512; it += F.G) {
                const int uu = (it < 256) ? it : (767 - it);
                const int bg = uu >> 7, qb = uu & 127;
                const unsigned* km = F.ctl + CW_KMAX + l * 16 + bg;
                P.kmax = sqrtf(__uint_as_float(__hip_atomic_load(km, __ATOMIC_RELAXED, __HIP_MEMORY_SCOPE_AGENT)));
                P.vmax = __uint_as_float(__hip_atomic_load(km + 4, __ATOMIC_RELAXED, __HIP_MEMORY_SCOPE_AGENT));
                P.kwmax = sqrtf(__uint_as_float(__hip_atomic_load(km + 8, __ATOMIC_RELAXED, __HIP_MEMORY_SCOPE_AGENT)));
                P.kcmax = sqrtf(__uint_as_float(__hip_atomic_load(km + 12, __ATOMIC_RELAXED, __HIP_MEMORY_SCOPE_AGENT)));
                att::attn_unit(F, P, bg >> 1, bg & 1, qb);
            }
        }
        SEAM(p0 + 2);
        if (IN(p0 + 3) && !(SKIPMASK & 32)) for (int rep = 0; rep < REPS(32, l == 0); ++rep) {
            pg8::DenseOrder S; S.init(T, DM, F.G, (int)blockIdx.x);
            EpiOut E{l == 0 ? (const float*)args.in[I_X] : WSP(float, WS_XR), WSP(float, WS_XR), (const float*)(F.ctl + CW_MOD) + (size_t)l * 2 * 6144};
            pg8::gemm_phase<EpiOut, pg8::DenseOrder, false, true>(F.lds, WSP(bf16_t, WS_Y), WSP(bf16_t, WS_WOUT) + (size_t)l * 1024 * 1024, 1024, S, E);
        }
        SEAM(p0 + 3);
        if (IN(p0 + 4) && !(SKIPMASK & 64)) for (int rep = 0; rep < REPS(64, l == 0); ++rep) { REFRESH(); phase_n2(F, args, l); }
        SEAM(p0 + 4);
        if (IN(p0 + 5) && !(SKIPMASK & 64)) for (int rep = 0; rep < REPS(1024, l == 0); ++rep) { REFRESH(); phase_n2b(F, l); }
        SEAM(p0 + 5);
        if (IN(p0 + 6) && !(SKIPMASK & 128)) for (int rep = 0; rep < REPS(128, l == 0); ++rep) { REFRESH();
            int total; moe_tables(F, l, 8, total);
            LAS int* ust = (LAS int*)(F.lds + MOE_OFF);
            pg8::MoeOrder S{ust, ust + 33, ust + 66, WSP(int, WS_TOK), 8, F.G, F.vcu, total, 1024};
            EpiSwiglu E{WSP(unsigned char, WS_ACT), (const float*)args.in[I_EB1] + (size_t)l * NE * 2048};
            pg8::gemm_phase<EpiSwiglu, pg8::MoeOrder, true, true, true>(F.lds, WSP(bf16_t, WS_H8), (const bf16_t*)(WSP(unsigned char, WS_W1T) + (size_t)l * NE * 2048 * 1024), 512, S, E);
        }
        SEAM(p0 + 6);
        if (IN(p0 + 7) && !(SKIPMASK & 256)) for (int rep = 0; rep < REPS(256, l == 0); ++rep) { REFRESH();
            int total; moe_tables(F, l, 4, total);
            LAS int* ust = (LAS int*)(F.lds + MOE_OFF);
            pg8::MoeOrder S{ust, ust + 33, ust + 66, WSP(int, WS_TOK), 4, F.G, F.vcu, total, 1024};
            EpiDown E{WSP(bf16_t, WS_YROWS), (const float*)args.in[I_EB2] + (size_t)l * NE * 1024};
            pg8::gemm_phase<EpiDown, pg8::MoeOrder, false, true, true>(F.lds, WSP(bf16_t, WS_ACT), (const bf16_t*)(WSP(unsigned char, WS_W2T) + (size_t)l * NE * 1024 * 1024), 512, S, E);
        }
        SEAM(p0 + 7);
        if (IN(p0 + 8) && !(SKIPMASK & 512)) for (int rep = 0; rep < REPS(512, l == DEPTH - 1); ++rep) { REFRESH(); phase_combine(F, args, l); }
        if (l + 1 < DEPTH) SEAM(p0 + 8);
    }
#undef IN
#undef SEAM
}

extern "C" void kernel_launch(void* const* d_in, const int* in_sizes, int n_in, void* d_out, int out_size, void* d_ws, size_t ws_size, hipStream_t stream) {
    static int grid = 0;
    if (grid == 0) {
        if (n_in != 26 || out_size != T * DM || ws_size < WS_END) { fprintf(stderr, "kernel_launch: unexpected problem (n_in %d, out %d, ws %zu; need ws >= %zu)\n", n_in, out_size, ws_size, (size_t)WS_END); grid = -1; return; }
        int dev = 0, cus = 0, per_cu = 0;
        if (hipGetDevice(&dev) != hipSuccess || hipDeviceGetAttribute(&cus, hipDeviceAttributeMultiprocessorCount, dev) != hipSuccess) { grid = -1; return; }
        if (hipFuncSetAttribute((const void*)fwd_kernel, hipFuncAttributeMaxDynamicSharedMemorySize, LDS_BYTES) != hipSuccess) { fprintf(stderr, "kernel_launch: hipFuncSetAttribute failed\n"); grid = -1; return; }
        if (hipOccupancyMaxActiveBlocksPerMultiprocessor(&per_cu, (const void*)fwd_kernel, NTHREADS, LDS_BYTES) != hipSuccess || per_cu < 1) { fprintf(stderr, "kernel_launch: occupancy query says %d\n", per_cu); (void)hipGetLastError(); per_cu = 1; }
        grid = cus;
    }
    if (grid < 0) return;
    if (hipMemsetAsync((char*)d_ws + WS_CTL, 0, CTL_ZERO_BYTES, stream) != hipSuccess) { fprintf(stderr, "kernel_launch: memset failed\n"); return; }
    Args a{};
    for (int i = 0; i < 26; ++i) a.in[i] = d_in[i];
    a.out = (float*)d_out; a.ws = (unsigned char*)d_ws;
#if MK_PER_PHASE
    for (int p = 0; p < NPHASES; ++p) { a.ph_lo = p; a.ph_hi = p + 1; a.li = 0;
        hipLaunchKernelGGL(fwd_kernel, dim3(grid), dim3(NTHREADS), LDS_BYTES, stream, a); }
#else
    a.ph_lo = 0; a.ph_hi = NPHASES; a.li = 0;
    void* kargs[] = {&a};
    hipError_t e = hipLaunchCooperativeKernel((const void*)fwd_kernel, dim3(grid), dim3(NTHREADS), kargs, LDS_BYTES, stream);
    if (e != hipSuccess) fprintf(stderr, "kernel_launch: cooperative launch failed: %s (grid %d)\n", hipGetErrorString(e), grid);
#endif
}
```

```cpp
#include <hip/hip_runtime.h>
#include <cstdio>
#include <cstdint>

#ifndef SKIPMASK
#define SKIPMASK 0
#endif
#ifndef REPMASK
#define REPMASK 0
#endif
#ifndef NREP
#define NREP 3
#endif
#ifndef DUMMYINT
#define DUMMYINT 0
#endif
#ifndef ATTREP
#define ATTREP 0
#endif
#ifndef MK_PER_PHASE
#define MK_PER_PHASE 0
#endif

#define LAS __attribute__((address_space(3)))
typedef unsigned short bf16_t;
typedef short bf16x8 __attribute__((ext_vector_type(8)));
typedef float f32x4 __attribute__((ext_vector_type(4)));
typedef float f32x2 __attribute__((ext_vector_type(2)));
typedef float f32x16 __attribute__((ext_vector_type(16)));
typedef unsigned u32x4 __attribute__((ext_vector_type(4)));
typedef unsigned u32x2 __attribute__((ext_vector_type(2)));
typedef __bf16 bf16x2_t __attribute__((ext_vector_type(2)));
typedef int i32x4 __attribute__((ext_vector_type(4)));
typedef int i32x8 __attribute__((ext_vector_type(8)));

constexpr int BATCH = 2, SEQ = 8192, DM = 1024, T = BATCH * SEQ, DEPTH = 2;
constexpr int PIN = 2328, PINP = 2560;
constexpr int NE = 32, FF = 1024, TOPK = 4;
constexpr int NCMP = 511, NCMPP = 512;
constexpr float NORM_EPS = 1e-6f;
constexpr float W8SCALE = 64.f;
constexpr int W8_E8M0 = 0x79797979, ONE_E8M0 = 0x7f7f7f7f;
constexpr float QSCALE = 0.125f * 1.4426950408889634f;
constexpr int NWAVES = 8, NTHREADS = 512;

constexpr size_t MiB = 1u << 20;
constexpr size_t WS_CTL = 0, CTL_ZERO_BYTES = 1 * MiB;
constexpr size_t WS_WIN = 1 * MiB;
constexpr size_t WS_WOUT = 11 * MiB;
constexpr size_t WS_SGW = 15 * MiB;
constexpr size_t WS_CW1 = 15 * MiB + 512 * 1024;
constexpr size_t WS_ROPE = 17 * MiB;
constexpr size_t WS_RWP = 21 * MiB;
constexpr size_t WS_MISC = 21 * MiB + 512 * 1024;
constexpr size_t WS_W1T = 32 * MiB;
constexpr size_t WS_W2T = 288 * MiB;
constexpr size_t WS_XR = 416 * MiB;
constexpr size_t WS_H = 480 * MiB;
constexpr size_t WS_UG = 513 * MiB, WS_VG = 529 * MiB, WS_Q = 545 * MiB;
constexpr size_t WS_KC = 561 * MiB, WS_VC = 565 * MiB, WS_KS = 569 * MiB, WS_KW = 573 * MiB;
constexpr size_t WS_VST = 577 * MiB, WS_VWT = 581 * MiB;
constexpr size_t WS_GATES = 585 * MiB;
constexpr size_t WS_KCMP = 587 * MiB;
constexpr size_t WS_VCT = 587 * MiB + 512 * 1024;
constexpr size_t WS_Y = 588 * MiB;
constexpr size_t WS_TOK = 620 * MiB;
constexpr size_t WS_ASG = 622 * MiB;
constexpr size_t WS_GATE4 = 622 * MiB + 512 * 1024;
constexpr size_t WS_YPART = 912 * MiB;
constexpr size_t WS_CNTI = 623 * MiB;
constexpr size_t WS_ACT = 624 * MiB;
constexpr size_t WS_YROWS = 768 * MiB;
constexpr size_t WS_H8 = 944 * MiB;
constexpr size_t WS_END = 962 * MiB;
constexpr int CW_BAR = 4096;
constexpr int CW_MOD = 16384;
constexpr int CW_CNT = 40960;
constexpr int CW_KMAX = 41088;
constexpr int CW_GCNT = 41216;

__device__ __forceinline__ unsigned cvtpk(float lo, float hi) { f32x2 v = {lo, hi}; bf16x2_t b = __builtin_convertvector(v, bf16x2_t); return __builtin_bit_cast(unsigned, b); }
__device__ __forceinline__ unsigned cvt4_fp8(float a, float b, float c, float d) { int w = 0; w = __builtin_amdgcn_cvt_pk_fp8_f32(a, b, w, false); w = __builtin_amdgcn_cvt_pk_fp8_f32(c, d, w, true); return (unsigned)w; }
__device__ __forceinline__ float bf2f(unsigned short b) { return __uint_as_float((unsigned)b << 16); }
__device__ __forceinline__ float bflo(unsigned w) { return __uint_as_float(w << 16); }
__device__ __forceinline__ float bfhi(unsigned w) { return __uint_as_float(w & 0xffff0000u); }
__device__ __forceinline__ float fast_exp2(float x) { return __builtin_amdgcn_exp2f(x); }
__device__ __forceinline__ float fast_rcp(float x) { return __builtin_amdgcn_rcpf(x); }
__device__ __forceinline__ float sigmoidf_(float x) { return fast_rcp(1.f + fast_exp2(-1.4426950408889634f * x)); }
__device__ __forceinline__ float gelu_tanh(float x) { const float u = 0.7978845608028654f * (x + 0.044715f * x * x * x); return x * fast_rcp(1.f + fast_exp2(-2.885390081777927f * u)); }

__device__ __forceinline__ float x16_sum(float x) { auto r = __builtin_amdgcn_permlane16_swap(__float_as_uint(x), __float_as_uint(x), false, false); return __uint_as_float(r[0]) + __uint_as_float(r[1]); }
__device__ __forceinline__ float x32_sum(float x) { auto r = __builtin_amdgcn_permlane32_swap(__float_as_uint(x), __float_as_uint(x), false, false); return __uint_as_float(r[0]) + __uint_as_float(r[1]); }
__device__ __forceinline__ float x16_max(float x) { auto r = __builtin_amdgcn_permlane16_swap(__float_as_uint(x), __float_as_uint(x), false, false); return fmaxf(__uint_as_float(r[0]), __uint_as_float(r[1])); }
__device__ __forceinline__ float x32_max(float x) { auto r = __builtin_amdgcn_permlane32_swap(__float_as_uint(x), __float_as_uint(x), false, false); return fmaxf(__uint_as_float(r[0]), __uint_as_float(r[1])); }
__device__ __forceinline__ float kg_sum(float x) { return x32_sum(x16_sum(x)); }
__device__ __forceinline__ float kg_max(float x) { return x32_max(x16_max(x)); }
__device__ __forceinline__ float quad_sum(float x) { x += __uint_as_float(__builtin_amdgcn_update_dpp(0u, __float_as_uint(x), 0xB1, 0xF, 0xF, true)); x += __uint_as_float(__builtin_amdgcn_update_dpp(0u, __float_as_uint(x), 0x4E, 0xF, 0xF, true)); return x; }
__device__ __forceinline__ float wave_sum(float v) {
    v = quad_sum(v);
    v += __uint_as_float(__builtin_amdgcn_update_dpp(0u, __float_as_uint(v), 0x141, 0xF, 0xF, true));
    v += __uint_as_float(__builtin_amdgcn_update_dpp(0u, __float_as_uint(v), 0x140, 0xF, 0xF, true));
    return x32_sum(x16_sum(v));
}
#define LDS_WAIT() asm volatile("s_waitcnt lgkmcnt(0)" ::: "memory")
#define VM_WAIT() asm volatile("s_waitcnt vmcnt(0)" ::: "memory")

__device__ __forceinline__ int kfrag_off(int key, int c8) {
    const int s = key >> 5, ko = key & 31, u = (ko >> 2) & 1, r16 = ((ko >> 3) << 2) | (ko & 3), ks = c8 >> 2, kg = c8 & 3;
    return s * 2048 + (u * 2 + ks) * 512 + (kg * 16 + r16) * 8;
}
__device__ __forceinline__ int vfrag_off(int key, int d) {
    const int s = key >> 5, ko = key & 31;
    return s * 2048 + (d >> 4) * 512 + ((ko >> 3) * 16 + (d & 15)) * 8 + (ko & 7);
}
namespace pg8 {
constexpr int BM = 256, BK = 64, HALF = 128, HTB = HALF * BK * 2, STAGE_BYTES = 8 * HTB, NXCD = 8, WGM = 8;
__host__ __device__ __forceinline__ int lds_byte(int r, int c) { const int st = (r >> 4) * 2 + (c >> 5), rr = r & 15, cc = c & 31, ob = rr * 64 + cc * 2; return st * 1024 + (ob ^ (((ob >> 9) & 1) << 5)); }
__host__ __device__ __forceinline__ void stage_rc(int b, int& R, int& C) { const int st = b / 1024, sb = b % 1024, swz = sb ^ (((sb >> 9) & 1) << 5); R = (st >> 1) * 16 + swz / 64; C = (st & 1) * 32 + (swz % 64) / 2; }
__host__ __device__ __forceinline__ int perm32(int rho) { const int n = rho >> 4, i = rho & 15; return 8 * (i >> 2) + 4 * n + (i & 3); }

struct Unit { int pm, pn, e, pnl, rloc; };

struct DenseOrder {
    int nM, nN, nwg, G, c;
    __device__ void init(int M, int N, int G_, int c_) { nM = M / BM; nN = N / BM; nwg = nM * nN; G = G_; c = c_; }
    __device__ bool next(int i, Unit& u) const {
        const long L = (long)i * G + c; if (L >= nwg) return false;
        int wgid = (int)L; { const int q = nwg / NXCD, r = nwg % NXCD, xcd = wgid % NXCD, off = wgid / NXCD; wgid = (xcd < r ? xcd * (q + 1) : r * (q + 1) + (xcd - r) * q) + off; }
        const int nig = WGM * nN, gid = wgid / nig, fm = gid * WGM, gsz = (nM - fm) < WGM ? (nM - fm) : WGM;
        u.pm = fm + ((wgid % nig) % gsz); u.pn = (wgid % nig) / gsz; u.e = 0; u.pnl = u.pn; u.rloc = 0; return true;
    }
    __device__ __forceinline__ unsigned rowoff(const Unit&, int) const { return 0u; }
};

struct MoeOrder {
    const LAS int* ust;
    const LAS int* bst;
    const LAS int* cnt;
    const int* tok;
    int NT, G, c, total, rowbytes;
    __device__ bool next(int i, Unit& u) const {
        const int L = i * G + c; if (L >= total) return false;
        int e = 0;
        for (int k = 1; k < NE; ++k) e += (L >= ust[k]) ? 1 : 0;
        e = __builtin_amdgcn_readfirstlane(e);
        const int loc = __builtin_amdgcn_readfirstlane(L - ust[e]), b0 = __builtin_amdgcn_readfirstlane(bst[e]), nb = __builtin_amdgcn_readfirstlane(bst[e + 1]) - b0;
        u.e = e; u.pnl = loc / nb; u.rloc = loc - u.pnl * nb; u.pm = b0 + u.rloc; u.pn = e * NT + u.pnl; return true;
    }
    __device__ __forceinline__ unsigned rowoff(const Unit& u, int r) const {
        const int slot = u.rloc * 256 + r; const int tk = slot < cnt[u.e] ? tok[u.e * 16384 + slot] : T;
        return (unsigned)tk * (unsigned)rowbytes;
    }
};

template <class Epi, class Sched, bool GATHER, bool ALIGN_EPI, bool FP8 = false>
__device__ __forceinline__ void gemm_phase(LAS unsigned char* lds, const bf16_t* A, const bf16_t* Bt, const int K, const Sched& S, const Epi& E) {
    int tid_ = threadIdx.x; asm volatile("" : "+v"(tid_));
    const int tid = tid_, wid = __builtin_amdgcn_readfirstlane(tid >> 6), lane = tid & 63, wr = wid >> 2, wc = wid & 3, fr = lane & 15, fq = lane >> 4;
    const int nt = K / BK;
    int Rr[2], Cc[2]; unsigned voffB[2];
#pragma unroll
    for (int i = 0; i < 2; ++i) { int R, C; stage_rc(tid * 16 + i * 8192, R, C); Rr[i] = R; Cc[i] = C; const int Rb = Epi::PERM ? ((R & ~31) + perm32(R & 31)) : R; voffB[i] = (unsigned)(Rb * K + C) * 2u; }
    const size_t kstep = (size_t)(BK * 2);
    const size_t hstep = (size_t)HALF * K * 2;
    const size_t tstep = 2 * hstep;
    const unsigned ldsw = (unsigned)wid * 1024u;
    const int aoff = lds_byte(wr * 64 + fr, fq * 8), boff = lds_byte(wc * 32 + fr, fq * 8);
#define PG8_SA(b, h) (((b) * 2 + (h)) * HTB)
#define PG8_SB(b, h) ((4 + (b) * 2 + (h)) * HTB)
#define PG8_STAGE(bufoff, gbase, v0, v1) do { \
        __builtin_amdgcn_global_load_lds((const unsigned*)((const char*)(gbase) + (v0)), (LAS unsigned*)(lds + (bufoff) + ldsw), 16, 0, 0); \
        __builtin_amdgcn_global_load_lds((const unsigned*)((const char*)(gbase) + (v1)), (LAS unsigned*)(lds + (bufoff) + ldsw + 8192), 16, 0, 0); } while (0)
#define PG8_STAGEB(bufoff, gbase) PG8_STAGE(bufoff, gbase, voffB[0], voffB[1])
#define PG8_CAT8(x0, x1) __builtin_shufflevector(x0, x1, 0, 1, 2, 3, 4, 5, 6, 7)
#define PG8_RD4(off) (*(const LAS i32x4*)(lds + (off)))
#define PG8_LDA(dst, b, h) do { if constexpr (FP8) { _Pragma("unroll") for (int m = 0; m < 4; ++m) dst##8[m] = PG8_CAT8(PG8_RD4(PG8_SA(b, h) + aoff + m * 2048), PG8_RD4(PG8_SA(b, h) + aoff + m * 2048 + 1024)); } \
        else { _Pragma("unroll") for (int m = 0; m < 4; ++m) _Pragma("unroll") for (int k = 0; k < 2; ++k) dst[m][k] = *(const LAS bf16x8*)(lds + PG8_SA(b, h) + aoff + m * 2048 + k * 1024); } } while (0)
#define PG8_LDB(dst, b, h) do { if constexpr (FP8) { _Pragma("unroll") for (int n = 0; n < 2; ++n) dst##8[n] = PG8_CAT8(PG8_RD4(PG8_SB(b, h) + boff + n * 2048), PG8_RD4(PG8_SB(b, h) + boff + n * 2048 + 1024)); } \
        else { _Pragma("unroll") for (int n = 0; n < 2; ++n) _Pragma("unroll") for (int k = 0; k < 2; ++k) dst[n][k] = *(const LAS bf16x8*)(lds + PG8_SB(b, h) + boff + n * 2048 + k * 1024); } } while (0)
#define PG8_MMA(ai, bj, At, Bt_) do { __builtin_amdgcn_s_setprio(1); _Pragma("unroll") for (int m = 0; m < 4; ++m) _Pragma("unroll") for (int n = 0; n < 2; ++n) { \
        if constexpr (FP8) { asm volatile("v_mfma_scale_f32_16x16x128_f8f6f4 %0, %1, %2, %0, %3, %4 op_sel_hi:[0,0,0]" : "+v"(acc[ai][bj][m][n]) : "v"(Bt_##8[n]), "v"(At##8[m]), "v"(sc_w), "v"(sc_x)); } \
        else { _Pragma("unroll") for (int k = 0; k < 2; ++k) acc[ai][bj][m][n] = __builtin_amdgcn_mfma_f32_16x16x32_bf16(Bt_[n][k], At[m][k], acc[ai][bj][m][n], 0, 0, 0); } } \
        __builtin_amdgcn_s_setprio(0); } while (0)
#define PG8_WAIT_V(n) asm volatile("s_waitcnt vmcnt(" #n ")" ::: "memory")
#define PG8_WAIT_L(n) asm volatile("s_waitcnt lgkmcnt(" #n ")" ::: "memory")
#define PG8_BAR __builtin_amdgcn_s_barrier()
#define PG8_SCHED __builtin_amdgcn_sched_barrier(0)
#define PG8_SETV(v, u) do { _Pragma("unroll") for (int h_ = 0; h_ < 2; ++h_) _Pragma("unroll") for (int i_ = 0; i_ < 2; ++i_) \
        v[h_][i_] = GATHER ? (S.rowoff(u, Rr[i_] + HALF * h_) + (unsigned)Cc[i_] * 2u) : (unsigned)((Rr[i_] + HALF * h_) * K + Cc[i_]) * 2u; } while (0)
    Unit cur, nxt; int ui = 0;
    if (!S.next(0, cur)) return;
    unsigned vc[2][2], vn[2][2];
    PG8_SETV(vc, cur);
    f32x4 acc[2][2][4][2];
#pragma unroll
    for (int a = 0; a < 2; ++a)
#pragma unroll
        for (int b = 0; b < 2; ++b)
#pragma unroll
            for (int m = 0; m < 4; ++m)
#pragma unroll
                for (int n = 0; n < 2; ++n) acc[a][b][m][n] = (f32x4){0.f, 0.f, 0.f, 0.f};
    bf16x8 At[4][2], B0[2][2], B1[2][2]; i32x8 At8[4], B08[2], B18[2];
    int sc_w = W8_E8M0, sc_x = ONE_E8M0; asm volatile("" : "+v"(sc_w), "+v"(sc_x));
    const char* cA = GATHER ? (const char*)A : (const char*)A + (size_t)cur.pm * tstep;
    const char* cB = (const char*)Bt + (size_t)cur.pn * tstep;
    PG8_STAGEB(PG8_SB(0, 0), cB); PG8_STAGEB(PG8_SB(0, 1), cB + hstep); PG8_STAGE(PG8_SA(0, 0), cA, vc[0][0], vc[0][1]); PG8_STAGE(PG8_SA(0, 1), cA, vc[1][0], vc[1][1]);
    if (wr == 1) PG8_BAR;
    PG8_WAIT_V(2); PG8_BAR;
    PG8_STAGEB(PG8_SB(1, 0), cB + kstep); PG8_STAGE(PG8_SA(1, 0), cA + kstep, vc[0][0], vc[0][1]); PG8_STAGEB(PG8_SB(1, 1), cB + hstep + kstep);
    PG8_WAIT_V(6); PG8_BAR;
    for (;;) {
        const bool has_next = S.next(ui + 1, nxt);
        const char* nA = GATHER ? (const char*)A : (has_next ? (const char*)A + (size_t)nxt.pm * tstep : cA);
        const char* nB = has_next ? (const char*)Bt + (size_t)nxt.pn * tstep : cB;
        if constexpr (GATHER) { if (has_next) { PG8_SETV(vn, nxt); } else {
#pragma unroll
            for (int h_ = 0; h_ < 2; ++h_)
#pragma unroll
                for (int i_ = 0; i_ < 2; ++i_) vn[h_][i_] = vc[h_][i_]; } }
#pragma nounroll
        for (int t = 0; t < nt; t += 2) {
            const bool last = (t == nt - 2);
            const char* a1 = cA + (size_t)(t + 1) * kstep;
            const char* a2 = last ? nA : cA + (size_t)(t + 2) * kstep; const char* b2 = last ? nB : cB + (size_t)(t + 2) * kstep;
            const char* a3 = a2 + kstep; const char* b3 = b2 + kstep;
            const unsigned w00 = (GATHER && last) ? vn[0][0] : vc[0][0], w01 = (GATHER && last) ? vn[0][1] : vc[0][1], w10 = (GATHER && last) ? vn[1][0] : vc[1][0], w11 = (GATHER && last) ? vn[1][1] : vc[1][1];
            PG8_LDB(B0, 0, 0); PG8_LDB(B1, 0, 1); PG8_SCHED; PG8_LDA(At, 0, 0); PG8_STAGE(PG8_SA(1, 1), a1, vc[1][0], vc[1][1]);
            PG8_WAIT_V(8); PG8_WAIT_L(0); PG8_BAR; PG8_MMA(0, 0, At, B0); PG8_MMA(0, 1, At, B1); PG8_BAR; PG8_SCHED;
            PG8_LDA(At, 0, 1); PG8_STAGEB(PG8_SB(0, 0), b2); PG8_STAGEB(PG8_SB(0, 1), b2 + hstep); PG8_STAGE(PG8_SA(0, 0), a2, w00, w01);
            PG8_WAIT_V(8); PG8_WAIT_L(0); PG8_BAR; PG8_MMA(1, 0, At, B0); PG8_MMA(1, 1, At, B1); PG8_BAR; PG8_SCHED;
            PG8_LDB(B0, 1, 0); PG8_LDB(B1, 1, 1); PG8_SCHED; PG8_LDA(At, 1, 0); PG8_STAGE(PG8_SA(0, 1), a2, w10, w11);
            PG8_WAIT_V(8); PG8_WAIT_L(0); PG8_BAR; PG8_MMA(0, 0, At, B0); PG8_MMA(0, 1, At, B1); PG8_BAR; PG8_SCHED;
            PG8_LDA(At, 1, 1); PG8_STAGEB(PG8_SB(1, 0), b3); PG8_STAGEB(PG8_SB(1, 1), b3 + hstep); PG8_STAGE(PG8_SA(1, 0), a3, w00, w01);
            PG8_WAIT_V(8); PG8_WAIT_L(0); PG8_BAR; PG8_MMA(1, 0, At, B0); PG8_MMA(1, 1, At, B1); PG8_BAR; PG8_SCHED;
        }
        if constexpr (FP8) { asm volatile("s_nop 15\n\ts_nop 15" ::: "memory"); }
        if constexpr (ALIGN_EPI) { if (wr == 0) PG8_BAR; }
        E(acc, cur, wr, wc, fr, fq);
        if (!has_next) break;
#pragma unroll
        for (int a = 0; a < 2; ++a)
#pragma unroll
            for (int b = 0; b < 2; ++b)
#pragma unroll
                for (int m = 0; m < 4; ++m)
#pragma unroll
                    for (int n = 0; n < 2; ++n) acc[a][b][m][n] = (f32x4){0.f, 0.f, 0.f, 0.f};
        cur = nxt; cA = nA; cB = nB; ++ui;
        if constexpr (GATHER) {
#pragma unroll
        for (int h_ = 0; h_ < 2; ++h_)
#pragma unroll
            for (int i_ = 0; i_ < 2; ++i_) vc[h_][i_] = vn[h_][i_]; }
        if constexpr (ALIGN_EPI) { if (wr == 1) PG8_BAR; }
    }
    PG8_WAIT_V(0);
    if constexpr (!ALIGN_EPI) { if (wr == 0) PG8_BAR; }
    PG8_BAR;
#undef PG8_SA
#undef PG8_SB
#undef PG8_STAGE
#undef PG8_STAGEB
#undef PG8_LDA
#undef PG8_LDB
#undef PG8_MMA
#undef PG8_CAT8
#undef PG8_RD4
#undef PG8_WAIT_V
#undef PG8_WAIT_L
#undef PG8_BAR
#undef PG8_SCHED
#undef PG8_SETV
}
}

#define XB_TMO      128
#define XB_XCNT(j)  (256  + 64 * (j))
#define XB_XSUB(j)  (1280 + 64 * (j))
#define XB_XGEN(j)  (2304 + 64 * (j))
#define XB_TOP      3328
#define XB_TOPGEN   3392
#define XCD_BAR_WORDS 3456
#define XB_SPIN_CAP (1u << 22)
__device__ __forceinline__ unsigned xb_ld(unsigned* p)              { return __hip_atomic_load(p, __ATOMIC_RELAXED, __HIP_MEMORY_SCOPE_AGENT); }
__device__ __forceinline__ unsigned xb_add(unsigned* p, unsigned v) { return __hip_atomic_fetch_add(p, v, __ATOMIC_RELAXED, __HIP_MEMORY_SCOPE_AGENT); }
__device__ __forceinline__ unsigned xb_xcc_id() { return (unsigned)__builtin_amdgcn_s_getreg((3 << 11) | 20) & 0xFu; }
#define XB_SPIN(cond, bar) do { unsigned _sp = 0; while (cond) { __builtin_amdgcn_s_sleep(1); \
    if ((++_sp & 255u) == 0u) { if (xb_ld(&(bar)[XB_TMO])) break; if (_sp > XB_SPIN_CAP) { atomicAdd(&(bar)[XB_TMO], 1u); break; } } } } while (0)
struct XcdBarrier { unsigned* bar; unsigned x; volatile LAS unsigned* st; };
__device__ __forceinline__ XcdBarrier xcd_barrier_post(unsigned* bar, volatile LAS unsigned* st) {
    XcdBarrier b; b.bar = bar; b.x = xb_xcc_id(); b.st = st;
    if (threadIdx.x == 0) (void)xb_add(&bar[XB_XCNT(b.x)], 1u);
    return b;
}
__device__ __forceinline__ void xcd_barrier_complete(unsigned* bar, unsigned x, unsigned& nloc, unsigned& nx) {
    const unsigned G = gridDim.x * gridDim.y * gridDim.z;
    unsigned sum, cnt, mine, sp = 0u;
    for (;;) {
        sum = 0u; cnt = 0u; mine = 0u;
#pragma unroll
        for (unsigned j = 0; j < 16; ++j) { const unsigned c = xb_ld(&bar[XB_XCNT(j)]); sum += c; cnt += (c > 0u) ? 1u : 0u; mine = (j == x) ? c : mine; }
        if (sum == G) break;
        __builtin_amdgcn_s_sleep(1);
        if ((++sp & 255u) == 0u) { if (xb_ld(&bar[XB_TMO])) break; if (sp > XB_SPIN_CAP) { atomicAdd(&bar[XB_TMO], 1u); break; } }
    }
    nloc = mine > 0u ? mine : 1u; nx = cnt > 0u ? cnt : 1u;
}
__device__ __forceinline__ void xcd_barrier(const XcdBarrier& b) {
    asm volatile("s_waitcnt vmcnt(0)" ::: "memory");
    __syncthreads();
    if (threadIdx.x == 0) {
        unsigned* bar = b.bar;
        __builtin_amdgcn_s_waitcnt(0);
        unsigned nloc = b.st[0], nx = b.st[1];
        if (nloc == 0u) { xcd_barrier_complete(bar, b.x, nloc, nx); b.st[0] = nloc; b.st[1] = nx; }
        const unsigned old = xb_add(&bar[XB_XSUB(b.x)], 1u);
        const unsigned gen = old / nloc;
        if (old + 1u == (gen + 1u) * nloc) {
            __builtin_amdgcn_fence(__ATOMIC_RELEASE, "agent");
            asm volatile("s_waitcnt vmcnt(0)" ::: "memory");
            const unsigned og = xb_add(&bar[XB_TOP], 1u);
            const unsigned tg = og / nx;
            if (og + 1u == (tg + 1u) * nx) xb_add(&bar[XB_TOPGEN], 1u);
            else XB_SPIN(xb_ld(&bar[XB_TOPGEN]) == tg, bar);
            __builtin_amdgcn_fence(__ATOMIC_ACQUIRE, "agent");
            xb_add(&bar[XB_XGEN(b.x)], 1u);
            asm volatile("s_waitcnt vmcnt(0)" ::: "memory");
        } else {
            XB_SPIN(xb_ld(&bar[XB_XGEN(b.x)]) == gen, bar);
            __builtin_amdgcn_fence(__ATOMIC_ACQUIRE, "agent");
            asm volatile("s_waitcnt vmcnt(0)" ::: "memory");
        }
    }
    __syncthreads();
}

struct Args { const void* in[26]; float* out; unsigned char* ws; int ph_lo, ph_hi, li, pad; };
enum { I_X = 0, I_C, I_POS, I_ADAW, I_ADAB, I_N1G, I_N2G, I_WIN, I_WOUT, I_SGLNG, I_SGLNB, I_SGW, I_SGB, I_PEK, I_PEV, I_CW1K, I_CW2K, I_CW1V, I_CW2V, I_RW, I_RB, I_EW1, I_EB1, I_EW2, I_EB2, I_FING };

struct Frame {
    LAS unsigned char* lds;
    unsigned* ctl;
    unsigned char* ws;
    int tid, lane, wave, vcu, G;
};
#define WSP(type, off) ((type*)(F.ws + (off)))
#define MODP(l, b, part) ((const float*)(F.ctl + CW_MOD) + ((size_t)((l) * 2 + (b)) * 6 + (part)) * 1024)

constexpr int RING_BYTES = 131072;
constexpr int ATT_LDS_BYTES = 147456;
constexpr int LDSCTL_OFF = ATT_LDS_BYTES;
constexpr int MISC_OFF = LDSCTL_OFF + 320;
constexpr int MOE_OFF = MISC_OFF + 128;
constexpr int LDS_BYTES = 163840;

struct EpiProj {
    static constexpr bool PERM = true;
    bf16_t *UG, *VG, *Q, *KC, *VC, *KS, *KW, *VST, *VWT; float* GATES; const float* ROPE; unsigned* kmax;
    __device__ __forceinline__ void operator()(const f32x4 (&acc)[2][2][4][2], const pg8::Unit& u, int wr, int wc, int fr, int fq) const {
        const int pn = u.pn; const int row0 = u.pm * 256 + wr * 64 + fr; const int b = u.pm >> 5;
        if (pn < 4 || pn == 6) {
#pragma unroll
            for (int ai = 0; ai < 2; ++ai)
#pragma unroll
                for (int m = 0; m < 4; ++m) { const size_t r = (size_t)(row0 + ai * 128 + m * 16);
#pragma unroll
                    for (int bj = 0; bj < 2; ++bj) { f32x4 v0 = acc[ai][bj][m][0], v1 = acc[ai][bj][m][1];
                        if (pn < 4) {
#pragma unroll
                            for (int i = 0; i < 4; ++i) { v0[i] = gelu_tanh(v0[i]); v1[i] = gelu_tanh(v1[i]); } }
                        u32x4 w; w.x = cvtpk(v0[0], v0[1]); w.y = cvtpk(v0[2], v0[3]); w.z = cvtpk(v1[0], v1[1]); w.w = cvtpk(v1[2], v1[3]);
                        bf16_t* dst;
                        if (pn < 2) dst = UG + r * 512 + pn * 256 + bj * 128 + wc * 32 + fq * 8;
                        else if (pn < 4) dst = VG + r * 512 + (pn - 2) * 256 + bj * 128 + wc * 32 + fq * 8;
                        else dst = (bj ? VC : KC) + r * 128 + wc * 32 + fq * 8;
                        *(u32x4*)dst = w; } }
        } else if (pn == 4 || pn == 5 || pn == 7) {
            const float sc = (pn == 7) ? 1.f : QSCALE; float nmax = 0.f;
#pragma unroll
            for (int ai = 0; ai < 2; ++ai)
#pragma unroll
                for (int m = 0; m < 4; ++m) { const size_t r = (size_t)(row0 + ai * 128 + m * 16);
                    const f32x4* cs = (const f32x4*)(ROPE + (r * 32 + fq * 8) * 2);
                    float o1[8], o2[8], nsq = 0.f;
#pragma unroll
                    for (int n = 0; n < 2; ++n) { const f32x4 c0 = cs[2 * n], c1 = cs[2 * n + 1]; const f32x4 x1 = acc[ai][0][m][n], x2 = acc[ai][1][m][n];
                        const float cc[4] = {c0[0], c0[2], c1[0], c1[2]}, ss[4] = {c0[1], c0[3], c1[1], c1[3]};
#pragma unroll
                        for (int i = 0; i < 4; ++i) { o1[4 * n + i] = (x1[i] * cc[i] - x2[i] * ss[i]) * sc; o2[4 * n + i] = (x2[i] * cc[i] + x1[i] * ss[i]) * sc; nsq += x1[i] * x1[i] + x2[i] * x2[i]; } }
                    u32x4 w1, w2; w1.x = cvtpk(o1[0], o1[1]); w1.y = cvtpk(o1[2], o1[3]); w1.z = cvtpk(o1[4], o1[5]); w1.w = cvtpk(o1[6], o1[7]);
                    w2.x = cvtpk(o2[0], o2[1]); w2.y = cvtpk(o2[2], o2[3]); w2.z = cvtpk(o2[4], o2[5]); w2.w = cvtpk(o2[6], o2[7]);
                    if (pn != 7) { bf16_t* dst = Q + r * 512 + (4 * (pn - 4) + wc) * 64 + fq * 8; *(u32x4*)dst = w1; *(u32x4*)(dst + 32) = w2; }
                    else { bf16_t* img = ((wc < 2) ? KS : KW) + (size_t)(b * 2 + (wc & 1)) * SEQ * 64; const int t = (int)r & (SEQ - 1);
                        *(u32x4*)(img + kfrag_off(t, fq)) = w1; *(u32x4*)(img + kfrag_off(t, 4 + fq)) = w2; }
                    nsq = kg_sum(nsq); nmax = fmaxf(nmax, nsq); }
            if (pn == 7) {
#pragma unroll
                for (int o = 1; o < 16; o <<= 1) nmax = fmaxf(nmax, __shfl_xor(nmax, o));
                if ((threadIdx.x & 63) == 0) atomicMax(kmax + ((wc < 2) ? 0 : 8) + b * 2 + (wc & 1), __float_as_uint(nmax * 1.02f));
            }
        } else if (pn == 8) {
            const int g = wc >> 1; float vmx = 0.f;
#pragma unroll
            for (int ai = 0; ai < 2; ++ai)
#pragma unroll
                for (int m = 0; m < 4; ++m) { const int r = row0 + ai * 128 + m * 16; const int s = r & (SEQ - 1);
#pragma unroll
                    for (int bj = 0; bj < 2; ++bj) { bf16_t* img = (bj ? VWT : VST) + (size_t)(b * 2 + g) * SEQ * 64;
#pragma unroll
                        for (int n = 0; n < 2; ++n)
#pragma unroll
                            for (int i = 0; i < 4; ++i) { img[vfrag_off(s, (wc & 1) * 32 + fq * 8 + n * 4 + i)] = (bf16_t)(cvtpk(acc[ai][bj][m][n][i], 0.f) & 0xffffu); if (bj == 0) vmx = fmaxf(vmx, fabsf(acc[ai][0][m][n][i])); } } }
#pragma unroll
            for (int o = 1; o < 64; o <<= 1) vmx = fmaxf(vmx, __shfl_xor(vmx, o));
            if ((threadIdx.x & 63) == 0) atomicMax(kmax + 4 + b * 2 + g, __float_as_uint(vmx * 1.01f));
        } else {
            if (wc == 0 && fq < 3) {
#pragma unroll
                for (int ai = 0; ai < 2; ++ai)
#pragma unroll
                    for (int m = 0; m < 4; ++m) { const size_t r = (size_t)(row0 + ai * 128 + m * 16);
#pragma unroll
                        for (int n = 0; n < 2; ++n) { f32x4 v = acc[ai][0][m][n];
#pragma unroll
                            for (int i = 0; i < 4; ++i) v[i] = sigmoidf_(v[i]);
                            *(f32x4*)(GATES + r * 24 + fq * 8 + n * 4) = v; } }
            }
        }
    }
};
struct EpiOut {
    static constexpr bool PERM = false;
    const float* xin; float* xout; const float* g1;
    __device__ __forceinline__ void operator()(const f32x4 (&acc)[2][2][4][2], const pg8::Unit& u, int wr, int wc, int fr, int fq) const {
        const int row0 = u.pm * 256 + wr * 64 + fr; const int b = u.pm >> 5; const int col0 = u.pn * 256 + wc * 32 + fq * 4;
        const float* gb = g1 + (size_t)b * 6144 + 2048;
        f32x4 gv[2][2];
#pragma unroll
        for (int bj = 0; bj < 2; ++bj)
#pragma unroll
            for (int n = 0; n < 2; ++n) gv[bj][n] = *(const f32x4*)(gb + col0 + bj * 128 + n * 16);
#pragma unroll
        for (int ai = 0; ai < 2; ++ai)
#pragma unroll
            for (int m = 0; m < 4; ++m) { const size_t off = (size_t)(row0 + ai * 128 + m * 16) * DM + col0;
#pragma unroll
                for (int bj = 0; bj < 2; ++bj)
#pragma unroll
                    for (int n = 0; n < 2; ++n) { const f32x4 xi = *(const f32x4*)(xin + off + bj * 128 + n * 16); *(f32x4*)(xout + off + bj * 128 + n * 16) = xi + gv[bj][n] * acc[ai][bj][m][n]; } }
    }
};
struct EpiSwiglu {
    static constexpr bool PERM = true;
    unsigned char* ACT; const float* b1;
    __device__ __forceinline__ void operator()(const f32x4 (&acc)[2][2][4][2], const pg8::Unit& u, int wr, int wc, int fr, int fq) const {
        const int row0 = u.pm * 256 + wr * 64 + fr; const int j0 = u.pnl * 128 + wc * 32 + fq * 8;
        const float* bb = b1 + (size_t)u.e * 2048 + j0;
        f32x4 bg[2], bl[2];
#pragma unroll
        for (int n = 0; n < 2; ++n) { bg[n] = *(const f32x4*)(bb + n * 4); bl[n] = *(const f32x4*)(bb + 1024 + n * 4); }
#pragma unroll
        for (int ai = 0; ai < 2; ++ai)
#pragma unroll
            for (int m = 0; m < 4; ++m) { float o[8];
#pragma unroll
                for (int n = 0; n < 2; ++n) { const f32x4 gl = acc[ai][0][m][n] + bg[n], ln = acc[ai][1][m][n] + bl[n];
#pragma unroll
                    for (int i = 0; i < 4; ++i) { const float gg = fminf(gl[i], 7.f), ll = fminf(fmaxf(ln[i], -7.f), 7.f); o[n * 4 + i] = gg * sigmoidf_(1.702f * gg) * (ll + 1.f); } }
                u32x2 w; w.x = cvt4_fp8(o[0], o[1], o[2], o[3]); w.y = cvt4_fp8(o[4], o[5], o[6], o[7]);
                *(u32x2*)(ACT + (size_t)(row0 + ai * 128 + m * 16) * FF + j0) = w; }
    }
};
struct EpiDown {
    static constexpr bool PERM = true;
    bf16_t* YR; const float* b2;
    __device__ __forceinline__ void operator()(const f32x4 (&acc)[2][2][4][2], const pg8::Unit& u, int wr, int wc, int fr, int fq) const {
        const int row0 = u.pm * 256 + wr * 64 + fr; const int c0 = u.pnl * 256 + wc * 32 + fq * 8;
        const float* bb = b2 + (size_t)u.e * 1024 + c0;
        f32x4 bv[2][2];
#pragma unroll
        for (int bj = 0; bj < 2; ++bj)
#pragma unroll
            for (int n = 0; n < 2; ++n) bv[bj][n] = *(const f32x4*)(bb + bj * 128 + n * 4);
#pragma unroll
        for (int ai = 0; ai < 2; ++ai)
#pragma unroll
            for (int m = 0; m < 4; ++m)
#pragma unroll
                for (int bj = 0; bj < 2; ++bj) { const f32x4 v0 = acc[ai][bj][m][0] + bv[bj][0], v1 = acc[ai][bj][m][1] + bv[bj][1];
                    u32x4 w; w.x = cvtpk(v0[0], v0[1]); w.y = cvtpk(v0[2], v0[3]); w.z = cvtpk(v1[0], v1[1]); w.w = cvtpk(v1[2], v1[3]);
                    *(u32x4*)(YR + (size_t)(row0 + ai * 128 + m * 16) * DM + c0 + bj * 128) = w; }
    }
};

__device__ __forceinline__ void tr_item(const float* W, int ldn, int k0, int c0, int nvalid, bf16_t* WT, int K, int drow0, LAS float* scr, int lane) {
    const int nn = lane & 31;
#pragma unroll 8
    for (int i = 0; i < 32; ++i) { const int kk = 2 * i + (lane >> 5); scr[kk * 33 + nn] = (nn < nvalid) ? W[(size_t)(k0 + kk) * ldn + c0 + nn] : 0.f; }
    LDS_WAIT(); asm volatile("" ::: "memory");
    const int c = lane & 7;
#pragma unroll
    for (int j = 0; j < 4; ++j) { const int n = (lane >> 3) + 8 * j; const LAS float* s = scr + (8 * c) * 33 + n;
        u32x4 o; o.x = cvtpk(s[0 * 33], s[1 * 33]); o.y = cvtpk(s[2 * 33], s[3 * 33]); o.z = cvtpk(s[4 * 33], s[5 * 33]); o.w = cvtpk(s[6 * 33], s[7 * 33]);
        *(u32x4*)(WT + (size_t)(drow0 + n) * K + k0 + 8 * c) = o; }
    LDS_WAIT(); asm volatile("" ::: "memory");
}
template <bool NTS> __device__ __forceinline__ void tr_item8(const float* W, int ldn, int k0, int c0, unsigned char* W8, int K, int drow0, LAS float* scr, int lane) {
    const int nn = lane & 31;
#pragma unroll 8
    for (int i = 0; i < 32; ++i) { const int kk = 2 * i + (lane >> 5); scr[kk * 33 + nn] = __builtin_nontemporal_load(W + (size_t)(k0 + kk) * ldn + c0 + nn) * W8SCALE; }
    LDS_WAIT(); asm volatile("" ::: "memory");
    const int c = lane & 3;
#pragma unroll
    for (int j = 0; j < 2; ++j) { const int n = (lane >> 2) + 16 * j; const LAS float* s = scr + (16 * c) * 33 + n;
        u32x4 o; o.x = cvt4_fp8(s[0 * 33], s[1 * 33], s[2 * 33], s[3 * 33]); o.y = cvt4_fp8(s[4 * 33], s[5 * 33], s[6 * 33], s[7 * 33]);
        o.z = cvt4_fp8(s[8 * 33], s[9 * 33], s[10 * 33], s[11 * 33]); o.w = cvt4_fp8(s[12 * 33], s[13 * 33], s[14 * 33], s[15 * 33]);
        if (NTS) __builtin_nontemporal_store(o, (u32x4*)(W8 + (size_t)(drow0 + n) * K + k0 + 16 * c)); else *(u32x4*)(W8 + (size_t)(drow0 + n) * K + k0 + 16 * c) = o; }
    LDS_WAIT(); asm volatile("" ::: "memory");
}
__device__ __forceinline__ void win_src(int p, int& c0, int& nvalid) {
    const int pn = p >> 8; nvalid = 32;
    if (pn < 4 || pn == 6) { c0 = p; }
    else if (pn == 4 || pn == 5) { const int pp = p - 1024 - 256 * (pn - 4), bj = pp >> 7, j = pp & 127; c0 = 1024 + (4 * (pn - 4) + (j >> 5)) * 64 + bj * 32; }
    else if (pn == 7) { const int pp = p - 1792, bj = pp >> 7, j = pp & 127, which = j >> 6, g = (j >> 5) & 1; c0 = (which ? 2048 : 1792) + g * 64 + bj * 32; }
    else if (pn == 8) { const int pp = p - 2048, bj = pp >> 7, j = pp & 127; c0 = (bj ? 2176 : 1920) + j; }
    else { const int pp = p - 2304; c0 = 2304 + pp; nvalid = 24 - pp; nvalid = nvalid < 0 ? 0 : (nvalid > 32 ? 32 : nvalid); if (nvalid == 0) c0 = 0; }
}
__device__ __forceinline__ void phase_prologue(Frame& F, const Args& a) {
    LAS float* scr = (LAS float*)(F.lds + F.wave * 8704);
    const int gw = F.vcu * NWAVES + F.wave, NGW = F.G * NWAVES; const int lane = F.lane;
    {
        const float* c = (const float*)a.in[I_C]; const float* adaw = (const float*)a.in[I_ADAW]; const float* adab = (const float*)a.in[I_ADAB];
        float* mod = (float*)(F.ctl + CW_MOD);
        LAS float* red = (LAS float*)(F.lds + 8 * 8704);
        for (int it = F.vcu; it < 2 * 24; it += F.G) {
            const int l = it / 24, nb = it % 24;
            const float* wp = adaw + ((size_t)l * 1024 + F.wave * 128) * 6144 + nb * 256 + lane * 4;
            f32x4 a0 = {0.f, 0.f, 0.f, 0.f}, a1 = a0;
#pragma unroll 4
            for (int k = 0; k < 128; ++k) { const f32x4 w = __builtin_nontemporal_load((const f32x4*)(wp + (size_t)k * 6144));
                const float c0 = c[F.wave * 128 + k], c1 = c[1024 + F.wave * 128 + k]; const float s0 = c0 * sigmoidf_(c0), s1 = c1 * sigmoidf_(c1);
                a0 += w * s0; a1 += w * s1; }
            *(LAS f32x4*)(red + (F.wave * 2 + 0) * 256 + lane * 4) = a0; *(LAS f32x4*)(red + (F.wave * 2 + 1) * 256 + lane * 4) = a1;
            __syncthreads();
            { const int b = F.tid >> 8, col = F.tid & 255; float sum = adab[(size_t)l * 6144 + nb * 256 + col];
#pragma unroll
              for (int ww = 0; ww < 8; ++ww) sum += red[(ww * 2 + b) * 256 + col];
              mod[((size_t)l * 2 + b) * 6144 + nb * 256 + col] = sum; }
            __syncthreads();
        }
    }
    {
        const float* win = (const float*)a.in[I_WIN]; bf16_t* WinT = WSP(bf16_t, WS_WIN);
        for (int it = gw; it < 2 * 16 * 80; it += NGW) { const int l = it / 1280, kb = (it % 1280) / 80, nb = it % 80; int c0, nv; win_src(nb * 32, c0, nv);
            tr_item(win + (size_t)l * 1024 * PIN, PIN, kb * 64, c0, nv, WinT + (size_t)l * PINP * 1024, 1024, nb * 32, scr, lane); }
        const float* wout = (const float*)a.in[I_WOUT]; bf16_t* WoutT = WSP(bf16_t, WS_WOUT);
        for (int it = gw; it < 2 * 16 * 32; it += NGW) { const int l = it / 512, kb = (it % 512) / 32, nb = it % 32;
            tr_item(wout + (size_t)l * 1024 * 1024, 1024, kb * 64, nb * 32, 32, WoutT + (size_t)l * 1024 * 1024, 1024, nb * 32, scr, lane); }
        bf16_t* CW1 = WSP(bf16_t, WS_CW1);
        for (int it = gw; it < 2 * 2 * 32 * 2; it += NGW) { const int l = it / 128, which = (it / 64) & 1, kb = (it % 64) / 2, nb = it & 1;
            const float* src = (const float*)a.in[which ? I_CW1V : I_CW1K] + (size_t)l * 2048 * 64;
            tr_item(src, 64, kb * 64, nb * 32, 32, CW1 + (size_t)(l * 2 + which) * 64 * 2048, 2048, nb * 32, scr, lane); }
        const float* ew1 = (const float*)a.in[I_EW1]; unsigned char* W1T = WSP(unsigned char, WS_W1T);
        for (int it = gw; it < 2 * 32 * 16 * 64; it += NGW) { const int le = it >> 10, kb = (it >> 6) & 15, nb = it & 63; const int p = nb * 32, tile = p >> 8, bj = (p >> 7) & 1, j = p & 127;
            if (le < 32) tr_item8<false>(ew1 + (size_t)le * 1024 * 2048, 2048, kb * 64, bj * 1024 + tile * 128 + j, W1T + (size_t)le * 2048 * 1024, 1024, p, scr, lane);
            else tr_item8<true>(ew1 + (size_t)le * 1024 * 2048, 2048, kb * 64, bj * 1024 + tile * 128 + j, W1T + (size_t)le * 2048 * 1024, 1024, p, scr, lane); }
        const float* ew2 = (const float*)a.in[I_EW2]; unsigned char* W2T = WSP(unsigned char, WS_W2T);
        for (int it = gw; it < 2 * 32 * 16 * 32; it += NGW) { const int le = it >> 9, kb = (it >> 5) & 15, nb = it & 31;
            if (le < 32) tr_item8<false>(ew2 + (size_t)le * 1024 * 1024, 1024, kb * 64, nb * 32, W2T + (size_t)le * 1024 * 1024, 1024, nb * 32, scr, lane);
            else tr_item8<true>(ew2 + (size_t)le * 1024 * 1024, 1024, kb * 64, nb * 32, W2T + (size_t)le * 1024 * 1024, 1024, nb * 32, scr, lane); }
    }
    {
        const int gt = (F.vcu * NWAVES + F.wave) * 64 + lane, NGT = NGW * 64;
        const float* sgw = (const float*)a.in[I_SGW]; bf16_t* SGW = WSP(bf16_t, WS_SGW);
        for (int i = gt; i < 2 * 8 * 128 * 128; i += NGT) { const int s = i & 127, t = (i >> 7) & 127; SGW[i] = (bf16_t)(cvtpk(s <= t ? sgw[i] : 0.f, 0.f) & 0xffffu); }
        const int* pos = (const int*)a.in[I_POS]; float* rope = WSP(float, WS_ROPE);
        for (int i = gt; i < T * 32; i += NGT) { const int tok = i >> 5, d = i & 31;
            const double inv = exp2(-(double)d * (13.287712379549449 / 32.0));
            const double rv = (double)pos[tok] * inv * 0.15915494309189535; const float fr = (float)(rv - __builtin_rint(rv));
            rope[2 * i] = __builtin_amdgcn_cosf(fr); rope[2 * i + 1] = __builtin_amdgcn_sinf(fr); }
        bf16_t* H = WSP(bf16_t, WS_H);
        for (int i = gt; i < 1024; i += NGT) { H[(size_t)T * 1024 + i] = 0; WSP(unsigned char, WS_H8)[(size_t)T * 1024 + i] = 0; }
        bf16_t* KCMP = WSP(bf16_t, WS_KCMP); bf16_t* VCT = WSP(bf16_t, WS_VCT);
        for (int i = gt; i < 2 * 2 * 64; i += NGT) { const int b = i >> 7, g = (i >> 6) & 1, d = i & 63; KCMP[(size_t)(b * 2 + g) * 512 * 64 + kfrag_off(511, d >> 3) + (d & 7)] = 0; VCT[(size_t)(b * 2 + g) * 512 * 64 + vfrag_off(511, d)] = 0; }
    }
    {
        float* cb = WSP(float, WS_MISC);
        for (int it = gw; it < 2 * 2 * 64; it += NGW) { const int l = it >> 7, which = (it >> 6) & 1, n = it & 63;
            const float* pe = (const float*)a.in[which ? I_PEV : I_PEK] + (size_t)l * 2048; const float* w1 = (const float*)a.in[which ? I_CW1V : I_CW1K] + (size_t)l * 2048 * 64;
            float s = 0.f; for (int k = lane; k < 2048; k += 64) s += pe[k] * w1[(size_t)k * 64 + n];
            s = wave_sum(s); if (lane == 0) cb[it] = s; }
    }
}

struct RowV { f32x4 v[4]; };
__device__ __forceinline__ RowV row_load(const float* p, int lane) { RowV r; const f32x4* q = (const f32x4*)p + lane;
#pragma unroll
    for (int j = 0; j < 4; ++j) r.v[j] = q[64 * j]; return r; }
__device__ __forceinline__ float row_ssq(const RowV& r) { float s = 0.f;
#pragma unroll
    for (int j = 0; j < 4; ++j) s += (r.v[j].x * r.v[j].x + r.v[j].y * r.v[j].y) + (r.v[j].z * r.v[j].z + r.v[j].w * r.v[j].w); return wave_sum(s); }
__device__ __forceinline__ void row_norm_store(const RowV& x, float rstd, const float* g, const float* sc, const float* sh, bf16_t* orow, int lane) {
    u32x2* o8 = (u32x2*)orow + lane;
#pragma unroll
    for (int j = 0; j < 4; ++j) { const f32x4 gg = ((const f32x4*)g)[lane + 64 * j], ss = ((const f32x4*)sc)[lane + 64 * j], hh = ((const f32x4*)sh)[lane + 64 * j];
        const f32x4 y = x.v[j] * rstd * gg * (ss + 1.f) + hh; u32x2 w; w.x = cvtpk(y.x, y.y); w.y = cvtpk(y.z, y.w); o8[64 * j] = w; }
}
__device__ __forceinline__ void row_norm_store8(const RowV& x, float rstd, const float* g, const float* sc, const float* sh, unsigned char* orow, int lane) {
    unsigned* o4 = (unsigned*)orow + lane;
#pragma unroll
    for (int j = 0; j < 4; ++j) { const f32x4 gg = ((const f32x4*)g)[lane + 64 * j], ss = ((const f32x4*)sc)[lane + 64 * j], hh = ((const f32x4*)sh)[lane + 64 * j];
        const f32x4 y = x.v[j] * rstd * gg * (ss + 1.f) + hh; o4[64 * j] = cvt4_fp8(y.x, y.y, y.z, y.w); }
}
__device__ __forceinline__ int expert_block_prefix(const unsigned* cnt, int lane) {
    int nb = (lane < NE) ? (int)((cnt[lane] + 255u) >> 8) : 0; int inc = nb;
#pragma unroll
    for (int o = 1; o < 32; o <<= 1) { const int t = __shfl_up(inc, o); if ((lane & 31) >= o) inc += t; }
    return inc - nb;
}
__device__ __forceinline__ void phase_n1_first(Frame& F, const Args& a) {
    const int gw = F.vcu * NWAVES + F.wave, NGW = F.G * NWAVES; const int lane = F.lane;
    const float* x = (const float*)a.in[I_X]; const float* g = (const float*)a.in[I_N1G]; bf16_t* H = WSP(bf16_t, WS_H);
    for (int m = gw; m < T; m += 2 * NGW) { const int m2 = m + NGW; const int b = m >> 13, b2 = m2 >> 13;
        const RowV r = row_load(x + (size_t)m * DM, lane); const RowV r2 = row_load(x + (size_t)m2 * DM, lane);
        const float rstd = 1.f / sqrtf(row_ssq(r) * (1.f / DM) + NORM_EPS), rstd2 = 1.f / sqrtf(row_ssq(r2) * (1.f / DM) + NORM_EPS);
        row_norm_store(r, rstd, g, MODP(0, b, 1), MODP(0, b, 0), H + (size_t)m * DM, lane);
        row_norm_store(r2, rstd2, g, MODP(0, b2, 1), MODP(0, b2, 0), H + (size_t)m2 * DM, lane); }
    float* RWP = WSP(float, WS_RWP); float* RBP = WSP(float, WS_MISC + 4096);
    const float* rw = (const float*)a.in[I_RW]; const float* rb = (const float*)a.in[I_RB]; const float* n2g = (const float*)a.in[I_N2G];
    const int gt = gw * 64 + lane, NGT = NGW * 64;
    for (int i = gt; i < 2 * 2 * 1024 * 32; i += NGT) { const int l = i >> 16, b = (i >> 15) & 1, k = (i >> 5) & 1023, e = i & 31;
        RWP[i] = n2g[l * 1024 + k] * (1.f + MODP(l, b, 4)[k]) * rw[((size_t)l * 1024 + k) * 32 + e]; }
    for (int it = gw; it < 2 * 2 * 32; it += NGW) { const int l = it >> 6, b = (it >> 5) & 1, e = it & 31; float s = 0.f;
        for (int k = lane; k < 1024; k += 64) s += MODP(l, b, 3)[k] * rw[((size_t)l * 1024 + k) * 32 + e];
        s = wave_sum(s); if (lane == 0) RBP[it] = s + rb[l * 32 + e]; }
}
__device__ __forceinline__ void phase_combine(Frame& F, const Args& a, int l) {
    const int gw = F.vcu * NWAVES + F.wave, NGW = F.G * NWAVES; const int lane = F.lane;
    float* XR = WSP(float, WS_XR); bf16_t* H = WSP(bf16_t, WS_H); const bf16_t* YR = WSP(bf16_t, WS_YROWS);
    const int* ASG = WSP(int, WS_ASG); const float* G4 = WSP(float, WS_GATE4);
    const int myprefix = expert_block_prefix(F.ctl + CW_CNT + l * 32, lane);
    const bool last = (l == DEPTH - 1);
    const float* g = last ? (const float*)a.in[I_FING] : (const float*)a.in[I_N1G] + (l + 1) * 1024;
#define COMB_LOAD(R_, WV_, GT_, M_) do { const int4 as4_ = *(const int4*)(ASG + (M_) * 4); const f32x4 gt4_ = *(const f32x4*)(G4 + (M_) * 4); \
        R_ = row_load(XR + (size_t)(M_) * DM, lane); const int asv_[4] = {as4_.x, as4_.y, as4_.z, as4_.w}; GT_[0] = gt4_.x; GT_[1] = gt4_.y; GT_[2] = gt4_.z; GT_[3] = gt4_.w; \
        _Pragma("unroll") for (int k = 0; k < 4; ++k) { const int e = asv_[k] >> 16, slot = asv_[k] & 0xffff; const int blk = __shfl(myprefix, e); \
            const u32x2* yr = (const u32x2*)(YR + ((size_t)blk * 256 + slot) * DM) + lane; _Pragma("unroll") for (int j = 0; j < 4; ++j) WV_[k][j] = __builtin_nontemporal_load(yr + 64 * j); } } while (0)
#define COMB_FINISH(R_, WV_, GT_, M_) do { const int b = (M_) >> 13; f32x4 y[4]; \
        _Pragma("unroll") for (int j = 0; j < 4; ++j) y[j] = (f32x4){0.f, 0.f, 0.f, 0.f}; \
        _Pragma("unroll") for (int k = 0; k < 4; ++k) _Pragma("unroll") for (int j = 0; j < 4; ++j) { const u32x2 w = WV_[k][j]; y[j] += (f32x4){bflo(w.x), bfhi(w.x), bflo(w.y), bfhi(w.y)} * GT_[k]; } \
        const float* g2 = MODP(l, b, 5); \
        _Pragma("unroll") for (int j = 0; j < 4; ++j) R_.v[j] += ((const f32x4*)g2)[lane + 64 * j] * y[j]; \
        const float rstd = 1.f / sqrtf(row_ssq(R_) * (1.f / DM) + NORM_EPS); \
        if (last) { f32x4* o = (f32x4*)(a.out + (size_t)(M_) * DM) + lane; _Pragma("unroll") for (int j = 0; j < 4; ++j) o[64 * j] = R_.v[j] * rstd * ((const f32x4*)g)[lane + 64 * j]; } \
        else { f32x4* xo = (f32x4*)(XR + (size_t)(M_) * DM) + lane; _Pragma("unroll") for (int j = 0; j < 4; ++j) xo[64 * j] = R_.v[j]; \
            row_norm_store(R_, rstd, g, MODP(l + 1, b, 1), MODP(l + 1, b, 0), H + (size_t)(M_) * DM, lane); } } while (0)
    for (int m = gw; m < T; m += 2 * NGW) { const int m2 = m + NGW;
        RowV rA, rB; u32x2 wA[4][4], wB[4][4]; float gA[4], gB[4];
        COMB_LOAD(rA, wA, gA, m); COMB_LOAD(rB, wB, gB, m2);
        COMB_FINISH(rA, wA, gA, m); COMB_FINISH(rB, wB, gB, m2);
    }
#undef COMB_LOAD
#undef COMB_FINISH
}
__device__ __forceinline__ void compress_item(Frame& F, const Args& a, int l, int item) {
    const int which = item >> 7, b = (item >> 6) & 1, g = (item >> 5) & 1, n0 = (item & 31) * 16;
    const int lane = F.lane, w = F.wave, r16 = lane & 15, kg = lane >> 4;
    const bf16_t* src = WSP(bf16_t, which ? WS_VC : WS_KC);
    const bf16_t* W1 = WSP(bf16_t, WS_CW1) + (size_t)(l * 2 + which) * 64 * 2048;
    LAS float* red = (LAS float*)F.lds;
    LAS float* hid = (LAS float*)(F.lds + 32768);
    f32x4 acc[4];
#pragma unroll
    for (int i = 0; i < 4; ++i) acc[i] = (f32x4){0.f, 0.f, 0.f, 0.f};
    const int n = n0 + r16; const bool nval = n < NCMP;
#pragma unroll 2
    for (int ks = 0; ks < 8; ++ks) { const int k = 256 * w + 32 * ks + 8 * kg; const int li = k >> 6, d = k & 63;
        bf16x8 af = (bf16x8){0, 0, 0, 0, 0, 0, 0, 0};
        if (nval) af = *(const bf16x8*)(src + ((size_t)b * SEQ + 16 * n + li) * 128 + g * 64 + d);
#pragma unroll
        for (int nt = 0; nt < 4; ++nt) { const bf16x8 bf = *(const bf16x8*)(W1 + (size_t)(nt * 16 + r16) * 2048 + k); acc[nt] = __builtin_amdgcn_mfma_f32_16x16x32_bf16(af, bf, acc[nt], 0, 0, 0); } }
#pragma unroll
    for (int nt = 0; nt < 4; ++nt)
#pragma unroll
        for (int i = 0; i < 4; ++i) red[(w * 16 + 4 * kg + i) * 64 + nt * 16 + r16] = acc[nt][i];
    __syncthreads();
    const float* cb = WSP(float, WS_MISC) + (l * 2 + which) * 64;
    for (int i = F.tid; i < 1024; i += NTHREADS) { float s = cb[i & 63];
#pragma unroll
        for (int ww = 0; ww < 8; ++ww) s += red[ww * 1024 + i];
        hid[i] = gelu_tanh(s); }
    { const float* w2 = (const float*)a.in[which ? I_CW2V : I_CW2K] + (size_t)l * 4096; LAS f32x4* w2s4 = (LAS f32x4*)(F.lds + 40960);
      for (int i = F.tid; i < 1024; i += NTHREADS) w2s4[i] = ((const f32x4*)w2)[i]; }
    __syncthreads();
    {
        const int nn = F.tid >> 5, c = F.tid & 31; LAS float* w2s = (LAS float*)(F.lds + 40960);
        float o1 = 0.f, o2 = 0.f;
#pragma unroll 16
        for (int k = 0; k < 64; ++k) { const float h = hid[nn * 64 + k]; o1 += h * w2s[k * 64 + c]; o2 += h * w2s[k * 64 + c + 32]; }
        const int np = n0 + nn; float nsq_ = 0.f;
        if (np < NCMP) {
            if (!which) { const float* cs = WSP(float, WS_ROPE) + (((size_t)b * SEQ + 16 * np + 31) * 32 + c) * 2; const float cc = cs[0], ss = cs[1];
                const float r1 = o1 * cc - o2 * ss, r2 = o2 * cc + o1 * ss;
                bf16_t* img = WSP(bf16_t, WS_KCMP) + (size_t)(b * 2 + g) * 512 * 64; img[kfrag_off(np, c >> 3) + (c & 7)] = (bf16_t)(cvtpk(r1, 0.f) & 0xffffu); img[kfrag_off(np, 4 + (c >> 3)) + (c & 7)] = (bf16_t)(cvtpk(r2, 0.f) & 0xffffu);
                nsq_ = r1 * r1 + r2 * r2;
            } else { bf16_t* img = WSP(bf16_t, WS_VCT) + (size_t)(b * 2 + g) * 512 * 64; img[vfrag_off(np, c)] = (bf16_t)(cvtpk(o1, 0.f) & 0xffffu); img[vfrag_off(np, c + 32)] = (bf16_t)(cvtpk(o2, 0.f) & 0xffffu); }
        }
        if (!which) {
            float mx = quad_sum(nsq_);
            mx += __uint_as_float(__builtin_amdgcn_update_dpp(0u, __float_as_uint(mx), 0x141, 0xF, 0xF, true)); mx += __uint_as_float(__builtin_amdgcn_update_dpp(0u, __float_as_uint(mx), 0x140, 0xF, 0xF, true));
            mx = x16_sum(mx);
            mx = x32_max(mx);
            if (F.lane == 0) atomicMax(F.ctl + CW_KMAX + l * 16 + 12 + b * 2 + g, __float_as_uint(mx * 1.02f));
        }
    }
    __syncthreads();
}
__device__ __forceinline__ void sgu_item(Frame& F, const Args& a, int l, int item) {
    const int hh = item & 1, ch = item >> 1;
    const size_t tok0 = (size_t)ch * 128;
    const int lane = F.lane, w = F.wave, r16 = lane & 15, kg = lane >> 4;
    const bf16_t* VG = WSP(bf16_t, WS_VG); const bf16_t* UG = WSP(bf16_t, WS_UG); bf16_t* Y = WSP(bf16_t, WS_Y);
    LAS float* stats = (LAS float*)F.lds;
    LAS bf16_t* vnT = (LAS bf16_t*)(F.lds + 1024);
    constexpr int VP = 136;
    for (int tt = 0; tt < 16; ++tt) { const int s = 16 * w + tt; const u32x4 v = *(const u32x4*)(VG + (tok0 + s) * 512 + lane * 8);
        const float f[8] = {bflo(v.x), bfhi(v.x), bflo(v.y), bfhi(v.y), bflo(v.z), bfhi(v.z), bflo(v.w), bfhi(v.w)};
        float sm = 0.f;
#pragma unroll
        for (int i = 0; i < 8; ++i) sm += f[i];
        const float mu = wave_sum(sm) * (1.f / 512.f); float q = 0.f;
#pragma unroll
        for (int i = 0; i < 8; ++i) q += (f[i] - mu) * (f[i] - mu);
        const float var = wave_sum(q) * (1.f / 512.f);
        if (lane == 0) { stats[2 * s] = mu; stats[2 * s + 1] = 1.f / sqrtf(var + NORM_EPS); } }
    __syncthreads();
    {
        const int s = F.tid & 127, hl = F.tid >> 7; const float mu = stats[2 * s], rs = stats[2 * s + 1];
        const int cbase = (4 * hh + hl) * 64; const float* lg = (const float*)a.in[I_SGLNG] + l * 512 + cbase; const float* lb = (const float*)a.in[I_SGLNB] + l * 512 + cbase;
#pragma unroll 2
        for (int d0 = 0; d0 < 64; d0 += 8) { const u32x4 v = *(const u32x4*)(VG + (tok0 + s) * 512 + cbase + d0);
            const float f[8] = {bflo(v.x), bfhi(v.x), bflo(v.y), bfhi(v.y), bflo(v.z), bfhi(v.z), bflo(v.w), bfhi(v.w)};
#pragma unroll
            for (int i = 0; i < 8; ++i) vnT[(hl * 64 + d0 + i) * VP + s] = (bf16_t)(cvtpk((f[i] - mu) * rs * lg[d0 + i] + lb[d0 + i], 0.f) & 0xffffu); }
    }
    __syncthreads();
    {
        const int hl = w & 3, th = w >> 2, h = 4 * hh + hl;
        const bf16_t* Wm = WSP(bf16_t, WS_SGW) + (size_t)(l * 8 + h) * 128 * 128; const float* bs = (const float*)a.in[I_SGB] + (size_t)(l * 8 + h) * 128;
        for (int tt = 4 * th; tt < 4 * th + 4; ++tt) {
            f32x4 acc[4];
#pragma unroll
            for (int i = 0; i < 4; ++i) acc[i] = (f32x4){0.f, 0.f, 0.f, 0.f};
            const int nks = (16 * tt + 15) / 32 + 1;
            for (int ks = 0; ks < nks; ++ks) { const bf16x8 bfr = *(const bf16x8*)(Wm + (size_t)(16 * tt + r16) * 128 + 32 * ks + 8 * kg);
#pragma unroll
                for (int dt = 0; dt < 4; ++dt) { const bf16x8 afr = *(const LAS bf16x8*)(vnT + (hl * 64 + dt * 16 + r16) * VP + 32 * ks + 8 * kg); acc[dt] = __builtin_amdgcn_mfma_f32_16x16x32_bf16(afr, bfr, acc[dt], 0, 0, 0); } }
            const int t = 16 * tt + r16; const float bb = bs[t];
#pragma unroll
            for (int dt = 0; dt < 4; ++dt) { const size_t off = (tok0 + t) * 512 + h * 64 + dt * 16 + 4 * kg; const u32x2 uu = *(const u32x2*)(UG + off);
                u32x2 o; o.x = cvtpk(bflo(uu.x) * (acc[dt][0] + bb), bfhi(uu.x) * (acc[dt][1] + bb)); o.y = cvtpk(bflo(uu.y) * (acc[dt][2] + bb), bfhi(uu.y) * (acc[dt][3] + bb));
                *(u32x2*)(Y + (tok0 + t) * 1024 + h * 64 + dt * 16 + 4 * kg) = o; }
        }
    }
    __syncthreads();
}

namespace att {
constexpr int OSP = 65;
constexpr int L_OH = 0;
constexpr int L_OL = 66560;
constexpr int L_LS = 133120;
constexpr int L_MREF = L_LS + 2048;
constexpr int USP = 129;
constexpr int L_SEL = L_MREF + 1024;
constexpr int L_CNT = L_SEL + 1024;
constexpr int L_LIST = L_CNT + 512;
constexpr int L_WCTR = L_LIST + 8192;
static_assert(L_WCTR + 16 <= ATT_LDS_BYTES, "attention LDS map");

struct Ptrs { const bf16_t *Q, *KS, *KW, *VST, *VWT, *KCMP, *VCT; const float* GATES; bf16_t* Y; float* YPART; float kmax, vmax, kwmax, kcmax; };

#define MFMA16(a, b, c) __builtin_amdgcn_mfma_f32_16x16x32_bf16(a, b, c, 0, 0, 0)

__device__ __forceinline__ void attn_unit(Frame& F, const Ptrs& P, int b, int g, int qb) {
    LAS unsigned char* lds = F.lds;
    const int tid = F.tid, lane = F.lane, w = F.wave, r16 = lane & 15, kg = lane >> 4;
    LAS int* Oh = (LAS int*)(lds + L_OH); LAS int* Ol = (LAS int*)(lds + L_OL); LAS float* imp = (LAS float*)(lds + L_OH);
    LAS int* lsel = (LAS int*)(lds + L_LS); LAS float* mref = (LAS float*)(lds + L_MREF);
    LAS unsigned* selm = (LAS unsigned*)(lds + L_SEL); LAS int* cnts = (LAS int*)(lds + L_CNT); LAS unsigned char* lists = lds + L_LIST; LAS int* wctr = (LAS int*)(lds + L_WCTR);
    const size_t tokb = (size_t)b * SEQ; const int t0 = qb * 64;
    const bf16_t* Qg = P.Q + (tokb + t0) * 512 + g * 256;
    LAS float* U = (LAS float*)(lds + L_OH); LAS float* linvc = (LAS float*)(lds + L_LS);
    {
        const int q = tid >> 3, part = tid & 7, hd = part >> 1, hf = part & 1;
        const u32x4* src = (const u32x4*)(Qg + (size_t)q * 512 + part * 32);
        float ss = 0.f;
#pragma unroll
        for (int i = 0; i < 4; ++i) { const u32x4 v = src[i]; const float f[8] = {bflo(v.x), bfhi(v.x), bflo(v.y), bfhi(v.y), bflo(v.z), bfhi(v.z), bflo(v.w), bfhi(v.w)};
#pragma unroll
            for (int k = 0; k < 8; ++k) ss += f[k] * f[k]; }
        ss += __uint_as_float(__builtin_amdgcn_update_dpp(0u, __float_as_uint(ss), 0xB1, 0xF, 0xF, true));
        if (hf == 0) mref[q * 4 + hd] = sqrtf(ss);
        for (int i = tid; i < 256 * USP; i += NTHREADS) U[i] = 0.f;
    }
    __syncthreads();
    const int hl = r16 & 3;
#define ATT_LDK(dst, base, key0) do { const char* kb_ = (const char*)(base) + (size_t)(key0) * 128; _Pragma("unroll") for (int u_ = 0; u_ < 2; ++u_) _Pragma("unroll") for (int ks_ = 0; ks_ < 2; ++ks_) \
        dst[u_][ks_] = *(const bf16x8*)(kb_ + koff + (u_ * 2 + ks_) * 1024); } while (0)
#define ATT_LDV(dst, vbase, LEN, key0) do { const char* vb_ = (const char*)(vbase) + (size_t)(key0) * 128; _Pragma("unroll") for (int dt_ = 0; dt_ < 4; ++dt_) \
        dst[dt_] = *(const bf16x8*)(vb_ + koff + dt_ * 1024); } while (0)
#define ATT_SHADOW() int ln_ = F.lane; asm volatile("" : "+v"(ln_)); const int r16 = ln_ & 15, kg = ln_ >> 4, hl = r16 & 3; const unsigned koff = (unsigned)ln_ * 16u
    {
        ATT_SHADOW();
        bf16x8 qf[2][2]; float mrc[2], lpart[2], carry[2] = {0.f, 0.f}; int nlim[2]; f32x4 o[2][4];
#pragma unroll
        for (int rt = 0; rt < 2; ++rt) { const int q = 8 * w + 4 * rt + (r16 >> 2);
#pragma unroll
            for (int ks = 0; ks < 2; ++ks) qf[rt][ks] = *(const bf16x8*)(Qg + (size_t)q * 512 + hl * 64 + ks * 32 + kg * 8);
            mrc[rt] = mref[q * 4 + hl] * P.kcmax; lpart[rt] = 0.f; nlim[rt] = (t0 + q - 31) >> 4;
#pragma unroll
            for (int dt = 0; dt < 4; ++dt) o[rt][dt] = (f32x4){0.f, 0.f, 0.f, 0.f}; }
        const int nkeys = 4 * qb + 3, NP = (nkeys + 31) >> 5;
        const int nlim_min = (t0 + 8 * w - 31) >> 4;
        const bf16_t* Kc = P.KCMP + (size_t)(b * 2 + g) * 512 * 64; const bf16_t* Vc = P.VCT + (size_t)(b * 2 + g) * 64 * 512;
#define ATT_S1_STEP(KF, VF, s_) do { _Pragma("unroll") for (int rt = 0; rt < 2; ++rt) { \
            f32x4 st[2]; float p[2][4]; \
            _Pragma("unroll") for (int u = 0; u < 2; ++u) { st[u] = MFMA16(KF[u][0], qf[rt][0], ((f32x4){0.f, 0.f, 0.f, 0.f})); st[u] = MFMA16(KF[u][1], qf[rt][1], st[u]); } \
            _Pragma("unroll") for (int u = 0; u < 2; ++u) _Pragma("unroll") for (int i = 0; i < 4; ++i) p[u][i] = fast_exp2(st[u][i] - mrc[rt]); \
            if (32 * (s_) + 31 > nlim_min) { _Pragma("unroll") for (int u = 0; u < 2; ++u) _Pragma("unroll") for (int i = 0; i < 4; ++i) { const int n = 32 * (s_) + 8 * kg + 4 * u + i; if (n > nlim[rt]) p[u][i] = 0.f; } } \
            const float s01 = (p[0][0] + p[0][1]) + (p[0][2] + p[0][3]), s11 = (p[1][0] + p[1][1]) + (p[1][2] + p[1][3]); lpart[rt] += s01 + s11; \
            {   \
                \
              const unsigned x_ = __float_as_uint(p[1][3]); const auto s16_ = __builtin_amdgcn_permlane16_swap(x_, x_, false, false); const auto s32_ = __builtin_amdgcn_permlane32_swap(s16_[1], s16_[1], false, false); \
              const float inc_ = (kg & 1) ? __uint_as_float(s16_[0]) : ((kg == 2) ? __uint_as_float(s32_[0]) : carry[rt]); carry[rt] = __uint_as_float(s32_[1]); \
              LAS float* ur = U + ((8 * w + 4 * rt + (r16 >> 2)) * 4 + hl) * USP + 8 * (s_) + 2 * kg; \
              ur[0] += (2.f * s01 - p[0][3]) + inc_; ur[1] += (2.f * s11 - p[1][3]) + p[0][3]; } \
            u32x4 pw; pw.x = cvtpk(p[0][0], p[0][1]); pw.y = cvtpk(p[0][2], p[0][3]); pw.z = cvtpk(p[1][0], p[1][1]); pw.w = cvtpk(p[1][2], p[1][3]); \
            const bf16x8 pf = __builtin_bit_cast(bf16x8, pw); \
            _Pragma("unroll") for (int dt = 0; dt < 4; ++dt) o[rt][dt] = MFMA16(VF[dt], pf, o[rt][dt]); } } while (0)
        {
            bf16x8 kA[2][2], vA[4], kB[2][2], vB[4];
            ATT_LDK(kA, Kc, 0); ATT_LDV(vA, Vc, 512, 0); if (NP > 1) { ATT_LDK(kB, Kc, 32); ATT_LDV(vB, Vc, 512, 32); }
#pragma nounroll
            for (int s2 = 0; s2 < NP; s2 += 2) {
                ATT_S1_STEP(kA, vA, s2);
                if (s2 + 2 < NP) { ATT_LDK(kA, Kc, 32 * (s2 + 2)); ATT_LDV(vA, Vc, 512, 32 * (s2 + 2)); }
                if (s2 + 1 < NP) { ATT_S1_STEP(kB, vB, s2 + 1);
                    if (s2 + 3 < NP) { ATT_LDK(kB, Kc, 32 * (s2 + 3)); ATT_LDV(vB, Vc, 512, 32 * (s2 + 3)); } }
            }
        }
#undef ATT_S1_STEP
#pragma unroll
        for (int rt = 0; rt < 2; ++rt) { const int q = 8 * w + 4 * rt + (r16 >> 2); const float lrow = kg_sum(lpart[rt]); const float linv = lrow > 0.f ? 1.f / lrow : 0.f;
            if (kg == 0) linvc[q * 4 + hl] = linv;
            const float gc = P.GATES[(tokb + t0 + q) * 24 + (g * 4 + hl) * 3 + 0] * linv;
            float* yp = P.YPART + (tokb + t0 + q) * 512 + (g * 4 + hl) * 64 + 4 * kg;
#pragma unroll
            for (int dt = 0; dt < 4; ++dt) *(f32x4*)(yp + dt * 16) = o[rt][dt] * gc; }
    }
    LDS_WAIT();
#pragma nounroll
    for (int qg = 0; qg < 2; ++qg) {
        if (qb <= 15) {
            if (lane < 4) { const int q = 8 * w + 4 * qg + lane; const unsigned long long m0 = (1ull << (qb + 1)) - 1ull;
                selm[q * 4 + 0] = (unsigned)m0; selm[q * 4 + 1] = (unsigned)(m0 >> 32); selm[q * 4 + 2] = 0u; selm[q * 4 + 3] = 0u; }
        } else {
            const int j0 = lane, j1 = lane + 64; int v0[4], v1[4], thr[4];
#pragma unroll
            for (int k = 0; k < 4; ++k) { const int q = 8 * w + 4 * qg + k; const LAS float* ur = U + (q * 4) * USP; const LAS float* li = linvc + q * 4;
                float i0 = 0.f, i1 = 0.f;
#pragma unroll
                for (int h = 0; h < 4; ++h) { i0 += ur[h * USP + j0] * li[h]; i1 += ur[h * USP + j1] * li[h]; }
                v0[k] = (j0 >= 1 && j0 <= qb - 2) ? (int)__float_as_uint(i0) : -1;
                v1[k] = (j1 <= qb - 2) ? (int)__float_as_uint(i1) : -1; thr[k] = 0; }
#pragma nounroll
            for (int bit = 30; bit >= 0; --bit) {
#pragma unroll
                for (int k = 0; k < 4; ++k) { const int cand = thr[k] | (1 << bit);
                    const int c = __popcll(__ballot(v0[k] >= cand)) + __popcll(__ballot(v1[k] >= cand)); if (c >= 13) thr[k] = cand; } }
            const unsigned long long below = (1ull << lane) - 1ull;
#pragma nounroll
            for (int k = 0; k < 4; ++k) {
                const int vv0 = (k == 0) ? v0[0] : (k == 1) ? v0[1] : (k == 2) ? v0[2] : v0[3], vv1 = (k == 0) ? v1[0] : (k == 1) ? v1[1] : (k == 2) ? v1[2] : v1[3];
                const int th = (k == 0) ? thr[0] : (k == 1) ? thr[1] : (k == 2) ? thr[2] : thr[3];
                const bool gt0 = vv0 > th, gt1 = vv1 > th, eq0 = vv0 == th, eq1 = vv1 == th;
                const int need = 13 - (__popcll(__ballot(gt0)) + __popcll(__ballot(gt1)));
                const unsigned long long B0 = __ballot(eq0), B1 = __ballot(eq1);
                const int rk0 = __popcll(B0 & below), rk1 = __popcll(B0) + __popcll(B1 & below);
                unsigned long long m0 = __ballot(gt0 || (eq0 && rk0 < need)), m1 = __ballot(gt1 || (eq1 && rk1 < need));
                m0 |= 1ull;
                if (qb < 64) m0 |= (1ull << qb); else m1 |= (1ull << (qb - 64));
                if (qb - 1 < 64) m0 |= (1ull << (qb - 1)); else m1 |= (1ull << (qb - 65));
                if (lane == 0) { const int q = 8 * w + 4 * qg + k; selm[q * 4 + 0] = (unsigned)m0; selm[q * 4 + 1] = (unsigned)(m0 >> 32); selm[q * 4 + 2] = (unsigned)m1; selm[q * 4 + 3] = (unsigned)(m1 >> 32); } }
        }
    }
    __syncthreads();
    for (int i = tid; i < 2 * 256 * OSP; i += NTHREADS) Oh[i] = 0;
    lsel[tid] = 0;
    if (tid == 0) wctr[0] = 0;
    if (tid < 128) { const int j = tid; int c = 0;
        if (j <= qb) for (int q = 0; q < 64; ++q) { if ((selm[q * 4 + (j >> 5)] >> (j & 31)) & 1u) { lists[j * 64 + c] = (unsigned char)q; ++c; } }
        cnts[j] = c; }
    __syncthreads();
    for (int rep5 = 0; rep5 < ((ATTREP & 8) ? NREP : 1); ++rep5)
    {
        if (rep5 > 0) { __syncthreads(); if (tid == 0) wctr[0] = 0; __syncthreads(); }
        ATT_SHADOW();
        const bf16_t* Ks = P.KS + (size_t)(b * 2 + g) * SEQ * 64; const bf16_t* Vs = P.VST + (size_t)(b * 2 + g) * 64 * SEQ;
        const float S1 = 1048576.f / fmaxf(P.vmax, 1e-30f);
#define ATT_FETCH(idx_) do { int i_ = 0; if (lane == 0) i_ = __hip_atomic_fetch_add(wctr, 1, __ATOMIC_RELAXED, __HIP_MEMORY_SCOPE_WORKGROUP); idx_ = __builtin_amdgcn_readfirstlane(i_); } while (0)
#define ATT_JOF(idx_) (((idx_) == 0) ? 0 : (((idx_) == 1) ? qb : (((idx_) == 2) ? qb - 1 : (idx_) - 2)))
        bf16x8 kn[2][2][2], vn[2][4];
        int idx; ATT_FETCH(idx);
        if (idx <= qb) { const int j = ATT_JOF(idx); ATT_LDK(kn[0], Ks, 64 * j); ATT_LDK(kn[1], Ks, 64 * j + 32); ATT_LDV(vn[0], Vs, SEQ, 64 * j); ATT_LDV(vn[1], Vs, SEQ, 64 * j + 32); }
#pragma nounroll
        while (idx <= qb) {
            const int j = ATT_JOF(idx);
            bf16x8 kf[2][2][2], vf[2][4];
#pragma unroll
            for (int sp = 0; sp < 2; ++sp) {
#pragma unroll
                for (int u = 0; u < 2; ++u) { kf[sp][u][0] = kn[sp][u][0]; kf[sp][u][1] = kn[sp][u][1]; }
#pragma unroll
                for (int dt = 0; dt < 4; ++dt) vf[sp][dt] = vn[sp][dt]; }
            int idx2; ATT_FETCH(idx2);
            if (idx2 <= qb) { const int j2 = ATT_JOF(idx2); ATT_LDK(kn[0], Ks, 64 * j2); ATT_LDK(kn[1], Ks, 64 * j2 + 32); ATT_LDV(vn[0], Vs, SEQ, 64 * j2); ATT_LDV(vn[1], Vs, SEQ, 64 * j2 + 32); }
            const int cnt = cnts[j];
            const int nch = (cnt + 3) >> 2;
            bf16x8 qn0, qn1; int qnx; bool vnx;
            { const int qs = (r16 >> 2); vnx = qs < cnt; qnx = lists[j * 64 + (vnx ? qs : (cnt > 0 ? cnt - 1 : 0))];
              const bf16_t* qp = Qg + (size_t)qnx * 512 + hl * 64 + kg * 8; qn0 = *(const bf16x8*)qp; qn1 = *(const bf16x8*)(qp + 32); }
#pragma nounroll
            for (int c = 0; c < nch; ++c) {
                const bool valid = vnx; const int q = qnx; const int row = q * 4 + hl; const bf16x8 q0 = qn0, q1 = qn1;
                if (c + 1 < nch) { const int qs = 4 * (c + 1) + (r16 >> 2); vnx = qs < cnt; qnx = lists[j * 64 + (vnx ? qs : cnt - 1)];
                    const bf16_t* qp = Qg + (size_t)qnx * 512 + hl * 64 + kg * 8; qn0 = *(const bf16x8*)qp; qn1 = *(const bf16x8*)(qp + 32); }
                const float mr = mref[row] * P.kmax;
                f32x4 o[4];
                float ps = 0.f;
                const bool slow = (j == qb) || (4 * c + 4 > cnt);
#define ATT_CHUNK(MASKED) \
                _Pragma("unroll") for (int sp = 0; sp < 2; ++sp) { \
                    f32x4 st[2]; float p[2][4]; \
                    _Pragma("unroll") for (int u = 0; u < 2; ++u) { st[u] = MFMA16(kf[sp][u][0], q0, ((f32x4){0.f, 0.f, 0.f, 0.f})); st[u] = MFMA16(kf[sp][u][1], q1, st[u]); } \
                    _Pragma("unroll") for (int u = 0; u < 2; ++u) _Pragma("unroll") for (int i = 0; i < 4; ++i) { float e = fast_exp2(st[u][i] - mr); \
                        if (MASKED) { const int kk = 32 * sp + 8 * kg + 4 * u + i; if (!valid || (j == qb && kk > q)) e = 0.f; } p[u][i] = e; ps += e; } \
                    u32x4 pw; pw.x = cvtpk(p[0][0], p[0][1]); pw.y = cvtpk(p[0][2], p[0][3]); pw.z = cvtpk(p[1][0], p[1][1]); pw.w = cvtpk(p[1][2], p[1][3]); \
                    const bf16x8 pf = __builtin_bit_cast(bf16x8, pw); \
                    _Pragma("unroll") for (int dt = 0; dt < 4; ++dt) o[dt] = (sp == 0) ? MFMA16(vf[0][dt], pf, ((f32x4){0.f, 0.f, 0.f, 0.f})) : MFMA16(vf[1][dt], pf, o[dt]); }
                if (slow) { ATT_CHUNK(true) } else { ATT_CHUNK(false) }
#undef ATT_CHUNK
                ps = kg_sum(ps);
                if (valid) {
                    if (kg == 0) { const float xs = ps * 1048576.f, hf_ = __builtin_rintf(xs); __hip_atomic_fetch_add(lsel + row, (int)hf_, __ATOMIC_RELAXED, __HIP_MEMORY_SCOPE_WORKGROUP);
                        __hip_atomic_fetch_add(lsel + 256 + row, (int)((xs - hf_) * 1048576.f), __ATOMIC_RELAXED, __HIP_MEMORY_SCOPE_WORKGROUP); }
#pragma unroll
                    for (int dt = 0; dt < 4; ++dt)
#pragma unroll
                        for (int i = 0; i < 4; ++i) { const float xs = o[dt][i] * S1, hf_ = __builtin_rintf(xs); const int off = row * OSP + dt * 16 + 4 * kg + i;
                            __hip_atomic_fetch_add(Oh + off, (int)hf_, __ATOMIC_RELAXED, __HIP_MEMORY_SCOPE_WORKGROUP);
                            __hip_atomic_fetch_add(Ol + off, (int)((xs - hf_) * 1048576.f), __ATOMIC_RELAXED, __HIP_MEMORY_SCOPE_WORKGROUP); }
                }
            }
            idx = idx2;
        }
    }
    f32x4 yacc[2][4];
    {
        ATT_SHADOW();
        bf16x8 qf[2][2]; float mrw[2], lpart[2]; f32x4 o[2][4];
#pragma unroll
        for (int rt = 0; rt < 2; ++rt) { const int q = 8 * w + 4 * rt + (r16 >> 2);
#pragma unroll
            for (int ks = 0; ks < 2; ++ks) qf[rt][ks] = *(const bf16x8*)(Qg + (size_t)q * 512 + hl * 64 + ks * 32 + kg * 8);
            mrw[rt] = mref[q * 4 + hl] * P.kwmax; lpart[rt] = 0.f;
#pragma unroll
            for (int dt = 0; dt < 4; ++dt) o[rt][dt] = (f32x4){0.f, 0.f, 0.f, 0.f}; }
        const bf16_t* Kw = P.KW + (size_t)(b * 2 + g) * SEQ * 64; const bf16_t* Vw = P.VWT + (size_t)(b * 2 + g) * 64 * SEQ;
        const int jlo = qb >= 8 ? qb - 8 : 0; const int nit = 2 * (qb - jlo + 1);
#define ATT_S4_STEP(KF, VF, it_) do { const int jw_ = jlo + ((it_) >> 1), sp_ = (it_) & 1; const int mode_ = (jw_ == qb) ? 1 : ((jw_ == qb - 8) ? 2 : 0); \
        _Pragma("unroll") for (int rt = 0; rt < 2; ++rt) { \
            f32x4 st[2]; float p[2][4]; \
            _Pragma("unroll") for (int u = 0; u < 2; ++u) { st[u] = MFMA16(KF[u][0], qf[rt][0], ((f32x4){0.f, 0.f, 0.f, 0.f})); st[u] = MFMA16(KF[u][1], qf[rt][1], st[u]); } \
            _Pragma("unroll") for (int u = 0; u < 2; ++u) _Pragma("unroll") for (int i = 0; i < 4; ++i) p[u][i] = fast_exp2(st[u][i] - mrw[rt]); \
            if (mode_) { const int tq = 8 * w + 4 * rt + (r16 >> 2); \
                _Pragma("unroll") for (int u = 0; u < 2; ++u) _Pragma("unroll") for (int i = 0; i < 4; ++i) { const int kk = 32 * sp_ + 8 * kg + 4 * u + i; const bool vis = (mode_ == 1) ? (kk <= tq) : (kk > tq); if (!vis) p[u][i] = 0.f; } } \
            lpart[rt] += ((p[0][0] + p[0][1]) + (p[0][2] + p[0][3])) + ((p[1][0] + p[1][1]) + (p[1][2] + p[1][3])); \
            u32x4 pw; pw.x = cvtpk(p[0][0], p[0][1]); pw.y = cvtpk(p[0][2], p[0][3]); pw.z = cvtpk(p[1][0], p[1][1]); pw.w = cvtpk(p[1][2], p[1][3]); \
            const bf16x8 pf = __builtin_bit_cast(bf16x8, pw); \
            _Pragma("unroll") for (int dt = 0; dt < 4; ++dt) o[rt][dt] = MFMA16(VF[dt], pf, o[rt][dt]); } } while (0)
        {
            bf16x8 kA[2][2], vA[4], kB[2][2], vB[4];
            ATT_LDK(kA, Kw, 64 * jlo); ATT_LDV(vA, Vw, SEQ, 64 * jlo); ATT_LDK(kB, Kw, 64 * jlo + 32); ATT_LDV(vB, Vw, SEQ, 64 * jlo + 32);
#pragma nounroll
            for (int it = 0; it < nit; it += 2) {
                ATT_S4_STEP(kA, vA, it);
                if (it + 2 < nit) { ATT_LDK(kA, Kw, 64 * jlo + 32 * (it + 2)); ATT_LDV(vA, Vw, SEQ, 64 * jlo + 32 * (it + 2)); }
                ATT_S4_STEP(kB, vB, it + 1);
                if (it + 3 < nit) { ATT_LDK(kB, Kw, 64 * jlo + 32 * (it + 3)); ATT_LDV(vB, Vw, SEQ, 64 * jlo + 32 * (it + 3)); }
            }
        }
#undef ATT_S4_STEP
#pragma unroll
        for (int rt = 0; rt < 2; ++rt) { const int q = 8 * w + 4 * rt + (r16 >> 2); const float lw_ = kg_sum(lpart[rt]); const float sc = lw_ > 0.f ? P.GATES[(tokb + t0 + q) * 24 + (g * 4 + hl) * 3 + 2] / lw_ : 0.f;
#pragma unroll
            for (int dt = 0; dt < 4; ++dt) yacc[rt][dt] = o[rt][dt] * sc; }
    }
    __syncthreads();
#pragma unroll
    for (int rt = 0; rt < 2; ++rt) { const int q = 8 * w + 4 * rt + (r16 >> 2), row = q * 4 + hl;
        const float lrow = (float)lsel[row] * (1.f / 1048576.f) + (float)lsel[256 + row] * (1.f / 1099511627776.f);
        const float invS1 = fmaxf(P.vmax, 1e-30f) * (1.f / 1048576.f);
        const float sc = lrow > 0.f ? P.GATES[(tokb + t0 + q) * 24 + (g * 4 + hl) * 3 + 1] / lrow * invS1 : 0.f;
        bf16_t* dst = P.Y + (tokb + t0 + q) * 1024 + 512 + (g * 4 + hl) * 64 + 4 * kg;
        const float* yp = P.YPART + (tokb + t0 + q) * 512 + (g * 4 + hl) * 64 + 4 * kg;
#pragma unroll
        for (int dt = 0; dt < 4; ++dt) { const LAS int* oh = Oh + row * OSP + dt * 16 + 4 * kg; const LAS int* ol = Ol + row * OSP + dt * 16 + 4 * kg;
            const f32x4 osel = (f32x4){(float)oh[0] + (float)ol[0] * (1.f / 1048576.f), (float)oh[1] + (float)ol[1] * (1.f / 1048576.f), (float)oh[2] + (float)ol[2] * (1.f / 1048576.f), (float)oh[3] + (float)ol[3] * (1.f / 1048576.f)};
            const f32x4 v = yacc[rt][dt] + *(const f32x4*)(yp + dt * 16) + osel * sc;
            u32x2 o; o.x = cvtpk(v[0], v[1]); o.y = cvtpk(v[2], v[3]); *(u32x2*)(dst + dt * 16) = o; } }
    __syncthreads();
}
#undef MFMA16
#undef ATT_LDK
#undef ATT_LDV
#undef ATT_SHADOW
#undef ATT_FETCH
#undef ATT_JOF
}

__device__ __forceinline__ void phase_n2(Frame& F, const Args& a, int l) {
    const int lane = F.lane, w = F.wave;
    const float* XR = WSP(float, WS_XR); unsigned char* H8 = WSP(unsigned char, WS_H8);
    const float* g = (const float*)a.in[I_N2G] + l * 1024;
    LAS float* part = (LAS float*)F.lds;
    LAS float* ssqp = (LAS float*)(F.lds + 32768);
    LAS float* lg = (LAS float*)(F.lds + 32768 + 1024);
    int* CNTI = WSP(int, WS_CNTI); int* ASG = WSP(int, WS_ASG); float* G4 = WSP(float, WS_GATE4);
    for (int item = F.vcu; item < T / 64; item += F.G) {
        const int tk0 = item * 64, b = tk0 >> 13; const int tt = w & 1, kq = w >> 1;
        const float* rwp = WSP(float, WS_RWP) + (size_t)(l * 2 + b) * 1024 * 32; const float* rbp = WSP(float, WS_MISC + 4096) + (l * 2 + b) * 32;
        const int i31 = lane & 31, hf = lane >> 5;
        {
            const float* xp = XR + (size_t)(tk0 + tt * 32 + i31) * DM + kq * 256 + 4 * hf; const float* wp = rwp + (size_t)(kq * 256 + 4 * hf) * 32 + i31;
            f32x16 acc;
#pragma unroll
            for (int r = 0; r < 16; ++r) acc[r] = 0.f;
            float ssq = 0.f;
#pragma nounroll
            for (int bt = 0; bt < 4; ++bt) {
                f32x4 xv[8]; float wv[8][4];
#pragma unroll
                for (int s = 0; s < 8; ++s) { xv[s] = *(const f32x4*)(xp + 8 * (bt * 8 + s)); const float* wq = wp + (size_t)(8 * (bt * 8 + s)) * 32;
                    wv[s][0] = wq[0]; wv[s][1] = wq[32]; wv[s][2] = wq[64]; wv[s][3] = wq[96]; }
#pragma unroll
                for (int s = 0; s < 8; ++s) { ssq += (xv[s].x * xv[s].x + xv[s].y * xv[s].y) + (xv[s].z * xv[s].z + xv[s].w * xv[s].w);
                    acc = __builtin_amdgcn_mfma_f32_32x32x2f32(xv[s].x, wv[s][0], acc, 0, 0, 0); acc = __builtin_amdgcn_mfma_f32_32x32x2f32(xv[s].y, wv[s][1], acc, 0, 0, 0);
                    acc = __builtin_amdgcn_mfma_f32_32x32x2f32(xv[s].z, wv[s][2], acc, 0, 0, 0); acc = __builtin_amdgcn_mfma_f32_32x32x2f32(xv[s].w, wv[s][3], acc, 0, 0, 0); }
            }
            ssq += __shfl_xor(ssq, 32);
            if (hf == 0) ssqp[kq * 64 + tt * 32 + i31] = ssq;
#pragma unroll
            for (int r = 0; r < 16; ++r) { const int tk = (r & 3) + 8 * (r >> 2) + 4 * hf; part[(w * 32 + tk) * 32 + i31] = acc[r]; }
        }
        __syncthreads();
        for (int i = F.tid; i < 64 * 32; i += NTHREADS) { const int tk = i >> 5, e = i & 31, t2 = tk >> 5, tl = tk & 31;
            const float sq = (ssqp[tk] + ssqp[64 + tk]) + (ssqp[128 + tk] + ssqp[192 + tk]); const float rstd = 1.f / sqrtf(sq * (1.f / DM) + NORM_EPS);
            const float v = (part[((0 * 2 + t2) * 32 + tl) * 32 + e] + part[((1 * 2 + t2) * 32 + tl) * 32 + e]) + (part[((2 * 2 + t2) * 32 + tl) * 32 + e] + part[((3 * 2 + t2) * 32 + tl) * 32 + e]);
            lg[tk * 33 + e] = v * rstd + rbp[e]; }
        __syncthreads();
        if (w < 2) {
            const int it = item * 2 + w;
            float v0 = -INFINITY, v1 = -INFINITY, v2 = -INFINITY, v3 = -INFINITY; int i0 = -1, i1 = -1, i2 = -1, i3 = -1;
            if (lane < 32) {
#pragma unroll 8
                for (int e = 0; e < 32; ++e) { const float v = lg[(w * 32 + lane) * 33 + e];
                    if (v > v3) { if (v > v2) { v3 = v2; i3 = i2; if (v > v1) { v2 = v1; i2 = i1; if (v > v0) { v1 = v0; i1 = i0; v0 = v; i0 = e; } else { v1 = v; i1 = e; } } else { v2 = v; i2 = e; } } else { v3 = v; i3 = e; } } }
            }
            const float e1 = __expf(v1 - v0), e2 = __expf(v2 - v0), e3 = __expf(v3 - v0); const float inv = 1.f / (1.f + e1 + e2 + e3);
            int r0 = 0, r1 = 0, r2 = 0, r3 = 0, mycnt = 0;
            for (int e = 0; e < 32; ++e) { const bool hit = (i0 == e) | (i1 == e) | (i2 == e) | (i3 == e); const unsigned long long U = __ballot(hit);
                const int rk = __popcll(U & ((1ull << lane) - 1ull));
                if (i0 == e) r0 = rk; if (i1 == e) r1 = rk; if (i2 == e) r2 = rk; if (i3 == e) r3 = rk;
                if (lane == e) mycnt = __popcll(U); }
            if (lane < 32) { const int tk = tk0 + w * 32 + lane; CNTI[it * 32 + lane] = mycnt;
                if (mycnt > 0) { atomicAdd(F.ctl + CW_GCNT + (l * 32 + (it >> 4)) * 32 + lane, (unsigned)mycnt); atomicAdd(F.ctl + CW_CNT + l * 32 + lane, (unsigned)mycnt); }
                *(int4*)(ASG + tk * 4) = make_int4((i0 << 16) | r0, (i1 << 16) | r1, (i2 << 16) | r2, (i3 << 16) | r3);
                *(f32x4*)(G4 + tk * 4) = (f32x4){inv, e1 * inv, e2 * inv, e3 * inv}; }
        }
#pragma unroll 2
        for (int rr = 0; rr < 8; ++rr) { const int m = tk0 + w * 8 + rr; const RowV r = row_load(XR + (size_t)m * DM, lane);
            const float rstd = 1.f / sqrtf(row_ssq(r) * (1.f / DM) + NORM_EPS);
            row_norm_store8(r, rstd, g, MODP(l, b, 4), MODP(l, b, 3), H8 + (size_t)m * DM, lane); }
        __syncthreads();
    }
}

__device__ __forceinline__ void phase_n2b(Frame& F, int l) {
    const int gw = F.vcu * NWAVES + F.wave, NGW = F.G * NWAVES; const int lane = F.lane;
    const int* CNTI = WSP(int, WS_CNTI); int* TOK = WSP(int, WS_TOK); int* ASG = WSP(int, WS_ASG); unsigned* cnt = F.ctl + CW_CNT + l * 32;
    for (int it = gw; it < T / 32; it += NGW) {
        int base = 0;
        {
            const unsigned* gc = F.ctl + CW_GCNT + l * 1024; const int grp = it >> 4, e = lane & 31; int s0 = 0, s1 = 0;
#pragma unroll
            for (int gI = 0; gI < 32; ++gI) { const int v = (int)gc[gI * 32 + e]; s0 += (gI < grp) ? v : 0; }
#pragma unroll
            for (int i = 0; i < 16; ++i) { const int v = CNTI[((grp << 4) + i) * 32 + e]; s1 += (((grp << 4) + i) < it) ? v : 0; }
            base = s0 + s1; }
        { const int tk = it * 32 + (lane & 31); const int4 as = *(const int4*)(ASG + tk * 4); int v[4] = {as.x, as.y, as.z, as.w};
#pragma unroll
            for (int k = 0; k < 4; ++k) { const int e = v[k] >> 16, rk = v[k] & 0xffff; const int sl = __shfl(base, e & 31) + rk; if (lane < 32) TOK[e * 16384 + sl] = tk; v[k] = (e << 16) | sl; }
            if (lane < 32) *(int4*)(ASG + tk * 4) = make_int4(v[0], v[1], v[2], v[3]); }
    }
}

__device__ __forceinline__ void moe_tables(Frame& F, int l, int NT, int& total) {
    LAS int* ust = (LAS int*)(F.lds + MOE_OFF); LAS int* bst = ust + 33; LAS int* cn = bst + 33;
    if (F.tid < 64) { const unsigned* cnt = F.ctl + CW_CNT + l * 32; const int lane = F.tid;
        const int c = (lane < NE) ? (int)cnt[lane] : 0; const int nb = (c + 255) >> 8; int inc = nb;
#pragma unroll
        for (int o = 1; o < 32; o <<= 1) { const int t = __shfl_up(inc, o); if ((lane & 31) >= o) inc += t; }
        if (lane < NE) { bst[lane] = inc - nb; ust[lane] = (inc - nb) * NT; cn[lane] = c; if (lane == NE - 1) { bst[NE] = inc; ust[NE] = inc * NT; } } }
    __syncthreads();
    total = ust[NE];
}

constexpr int PH_PROLOGUE = 0, PH_N1 = 1, PH_LAYER0 = 2, PH_PER_LAYER = 9, NPHASES = PH_LAYER0 + DEPTH * PH_PER_LAYER;
__global__ void __launch_bounds__(NTHREADS, 2) fwd_kernel(Args args) {
    extern __shared__ __attribute__((aligned(16))) unsigned char lds_raw[];
    Frame F;
    F.lds = (LAS unsigned char*)lds_raw; F.ws = args.ws; F.ctl = (unsigned*)(args.ws + WS_CTL);
    F.tid = threadIdx.x; F.lane = F.tid & 63; F.wave = __builtin_amdgcn_readfirstlane(F.tid >> 6);
    F.G = gridDim.x; { const int bx = blockIdx.x; F.vcu = (F.G % 8 == 0) ? (bx % 8) * (F.G / 8) + bx / 8 : bx; }
    for (int u = F.tid; u < (LDS_BYTES - LDSCTL_OFF) / 4; u += NTHREADS) ((LAS unsigned*)(F.lds + LDSCTL_OFF))[u] = 0u;
    __syncthreads();
    volatile LAS unsigned* MISC = (volatile LAS unsigned*)(F.lds + MISC_OFF);
    XcdBarrier bar; bar.bar = F.ctl + CW_BAR; bar.x = 0; bar.st = nullptr;
#if !MK_PER_PHASE
    bar = xcd_barrier_post(F.ctl + CW_BAR, MISC + 8);
#endif
    const int lo = args.ph_lo, hi = args.ph_hi;
#define IN(k) (lo <= (k) && (k) < hi)
#define REFRESH() do { int t_ = threadIdx.x; asm volatile("" : "+v"(t_)); F.tid = t_; F.lane = t_ & 63; F.wave = __builtin_amdgcn_readfirstlane(t_ >> 6); } while (0)
#define SEAM(k) do { if (IN(k) && IN((k) + 1)) xcd_barrier(bar); } while (0)
#define REPS(bit, idem) (((REPMASK & (bit)) && (idem)) ? NREP : 1)

    if (IN(PH_PROLOGUE) && !(SKIPMASK & 1)) for (int rep = 0; rep < REPS(1, true); ++rep) { REFRESH(); phase_prologue(F, args); } SEAM(PH_PROLOGUE);
    if (IN(PH_N1) && !(SKIPMASK & 2)) for (int rep = 0; rep < REPS(2, true); ++rep) { REFRESH(); phase_n1_first(F, args); } SEAM(PH_N1);
    for (int l = 0; l < DEPTH; ++l) {
        const int p0 = PH_LAYER0 + l * PH_PER_LAYER;
        if (IN(p0 + 0) && !(SKIPMASK & 4)) for (int rep = 0; rep < REPS(4, l == 0); ++rep) {
            pg8::DenseOrder S; S.init(T, PINP, F.G, (int)blockIdx.x);
            EpiProj E{WSP(bf16_t, WS_UG), WSP(bf16_t, WS_VG), WSP(bf16_t, WS_Q), WSP(bf16_t, WS_KC), WSP(bf16_t, WS_VC), WSP(bf16_t, WS_KS), WSP(bf16_t, WS_KW), WSP(bf16_t, WS_VST), WSP(bf16_t, WS_VWT),
                      WSP(float, WS_GATES), WSP(float, WS_ROPE), F.ctl + CW_KMAX + l * 16};
            pg8::gemm_phase<EpiProj, pg8::DenseOrder, false, true>(F.lds, WSP(bf16_t, WS_H), WSP(bf16_t, WS_WIN) + (size_t)l * PINP * 1024, 1024, S, E);
        }
        SEAM(p0 + 0);
        if (IN(p0 + 1) && !(SKIPMASK & 8)) for (int rep = 0; rep < REPS(8, l == 0); ++rep) { REFRESH();
            for (int it = F.vcu; it < 256 + 256; it += F.G) { if (it < 256) compress_item(F, args, l, it); else sgu_item(F, args, l, it - 256); }
        }
        SEAM(p0 + 1);
        if (IN(p0 + 2) && !(SKIPMASK & 16)) for (int rep = 0; rep < REPS(16, l == 0); ++rep) { REFRESH();
            att::Ptrs P{WSP(bf16_t, WS_Q), WSP(bf16_t, WS_KS), WSP(bf16_t, WS_KW), WSP(bf16_t, WS_VST), WSP(bf16_t, WS_VWT), WSP(bf16_t, WS_KCMP), WSP(bf16_t, WS_VCT), WSP(float, WS_GATES), WSP(bf16_t, WS_Y), WSP(float, WS_YPART), 0.f};
            for (int it = F.vcu; it < 512; it += F.G) {
                const int uu = (it < 256) ? it : (767 - it);
                const int bg = uu >> 7, qb = uu & 127;
                const unsigned* km = F.ctl + CW_KMAX + l * 16 + bg;
                P.kmax = sqrtf(__uint_as_float(__hip_atomic_load(km, __ATOMIC_RELAXED, __HIP_MEMORY_SCOPE_AGENT)));
                P.vmax = __uint_as_float(__hip_atomic_load(km + 4, __ATOMIC_RELAXED, __HIP_MEMORY_SCOPE_AGENT));
                P.kwmax = sqrtf(__uint_as_float(__hip_atomic_load(km + 8, __ATOMIC_RELAXED, __HIP_MEMORY_SCOPE_AGENT)));
                P.kcmax = sqrtf(__uint_as_float(__hip_atomic_load(km + 12, __ATOMIC_RELAXED, __HIP_MEMORY_SCOPE_AGENT)));
                att::attn_unit(F, P, bg >> 1, bg & 1, qb);
            }
        }
        SEAM(p0 + 2);
        if (IN(p0 + 3) && !(SKIPMASK & 32)) for (int rep = 0; rep < REPS(32, l == 0); ++rep) {
            pg8::DenseOrder S; S.init(T, DM, F.G, (int)blockIdx.x);
            EpiOut E{l == 0 ? (const float*)args.in[I_X] : WSP(float, WS_XR), WSP(float, WS_XR), (const float*)(F.ctl + CW_MOD) + (size_t)l * 2 * 6144};
            pg8::gemm_phase<EpiOut, pg8::DenseOrder, false, true>(F.lds, WSP(bf16_t, WS_Y), WSP(bf16_t, WS_WOUT) + (size_t)l * 1024 * 1024, 1024, S, E);
        }
        SEAM(p0 + 3);
        if (IN(p0 + 4) && !(SKIPMASK & 64)) for (int rep = 0; rep < REPS(64, l == 0); ++rep) { REFRESH(); phase_n2(F, args, l); }
        SEAM(p0 + 4);
        if (IN(p0 + 5) && !(SKIPMASK & 64)) for (int rep = 0; rep < REPS(1024, l == 0); ++rep) { REFRESH(); phase_n2b(F, l); }
        SEAM(p0 + 5);
        if (IN(p0 + 6) && !(SKIPMASK & 128)) for (int rep = 0; rep < REPS(128, l == 0); ++rep) { REFRESH();
            int total; moe_tables(F, l, 8, total);
            LAS int* ust = (LAS int*)(F.lds + MOE_OFF);
            pg8::MoeOrder S{ust, ust + 33, ust + 66, WSP(int, WS_TOK), 8, F.G, F.vcu, total, 1024};
            EpiSwiglu E{WSP(unsigned char, WS_ACT), (const float*)args.in[I_EB1] + (size_t)l * NE * 2048};
            pg8::gemm_phase<EpiSwiglu, pg8::MoeOrder, true, true, true>(F.lds, WSP(bf16_t, WS_H8), (const bf16_t*)(WSP(unsigned char, WS_W1T) + (size_t)l * NE * 2048 * 1024), 512, S, E);
        }
        SEAM(p0 + 6);
        if (IN(p0 + 7) && !(SKIPMASK & 256)) for (int rep = 0; rep < REPS(256, l == 0); ++rep) { REFRESH();
            int total; moe_tables(F, l, 4, total);
            LAS int* ust = (LAS int*)(F.lds + MOE_OFF);
            pg8::MoeOrder S{ust, ust + 33, ust + 66, WSP(int, WS_TOK), 4, F.G, F.vcu, total, 1024};
            EpiDown E{WSP(bf16_t, WS_YROWS), (const float*)args.in[I_EB2] + (size_t)l * NE * 1024};
            pg8::gemm_phase<EpiDown, pg8::MoeOrder, false, true, true>(F.lds, WSP(bf16_t, WS_ACT), (const bf16_t*)(WSP(unsigned char, WS_W2T) + (size_t)l * NE * 1024 * 1024), 512, S, E);
        }
        SEAM(p0 + 7);
        if (IN(p0 + 8) && !(SKIPMASK & 512)) for (int rep = 0; rep < REPS(512, l == DEPTH - 1); ++rep) { REFRESH(); phase_combine(F, args, l); }
        if (l + 1 < DEPTH) SEAM(p0 + 8);
    }
#undef IN
#undef SEAM
}

extern "C" void kernel_launch(void* const* d_in, const int* in_sizes, int n_in, void* d_out, int out_size, void* d_ws, size_t ws_size, hipStream_t stream) {
    static int grid = 0;
    if (grid == 0) {
        if (n_in != 26 || out_size != T * DM || ws_size < WS_END) { fprintf(stderr, "kernel_launch: unexpected problem (n_in %d, out %d, ws %zu; need ws >= %zu)\n", n_in, out_size, ws_size, (size_t)WS_END); grid = -1; return; }
        int dev = 0, cus = 0, per_cu = 0;
        if (hipGetDevice(&dev) != hipSuccess || hipDeviceGetAttribute(&cus, hipDeviceAttributeMultiprocessorCount, dev) != hipSuccess) { grid = -1; return; }
        if (hipFuncSetAttribute((const void*)fwd_kernel, hipFuncAttributeMaxDynamicSharedMemorySize, LDS_BYTES) != hipSuccess) { fprintf(stderr, "kernel_launch: hipFuncSetAttribute failed\n"); grid = -1; return; }
        if (hipOccupancyMaxActiveBlocksPerMultiprocessor(&per_cu, (const void*)fwd_kernel, NTHREADS, LDS_BYTES) != hipSuccess || per_cu < 1) { fprintf(stderr, "kernel_launch: occupancy query says %d\n", per_cu); (void)hipGetLastError(); per_cu = 1; }
        grid = cus;
    }
    if (grid < 0) return;
    if (hipMemsetAsync((char*)d_ws + WS_CTL, 0, CTL_ZERO_BYTES, stream) != hipSuccess) { fprintf(stderr, "kernel_launch: memset failed\n"); return; }
    Args a{};
    for (int i = 0; i < 26; ++i) a.in[i] = d_in[i];
    a.out = (float*)d_out; a.ws = (unsigned char*)d_ws;
#if MK_PER_PHASE
    for (int p = 0; p < NPHASES; ++p) { a.ph_lo = p; a.ph_hi = p + 1; a.li = 0;
        hipLaunchKernelGGL(fwd_kernel, dim3(grid), dim3(NTHREADS), LDS_BYTES, stream, a); }
#else
    a.ph_lo = 0; a.ph_hi = NPHASES; a.li = 0;
    void* kargs[] = {&a};
    hipError_t e = hipLaunchCooperativeKernel((const void*)fwd_kernel, dim3(grid), dim3(NTHREADS), kargs, LDS_BYTES, stream);
    if (e != hipSuccess) fprintf(stderr, "kernel_launch: cooperative launch failed: %s (grid %d)\n", hipGetErrorString(e), grid);
#endif
}
```

```cpp
#include <hip/hip_runtime.h>
#include <cstdio>
#include <cstdint>

#ifndef SKIPMASK
#define SKIPMASK 0
#endif
#ifndef REPMASK
#define REPMASK 0
#endif
#ifndef NREP
#define NREP 3
#endif
#ifndef DUMMYINT
#define DUMMYINT 0
#endif
#ifndef ATTREP
#define ATTREP 0
#endif
#ifndef MK_PER_PHASE
#define MK_PER_PHASE 0
#endif

#define LAS __attribute__((address_space(3)))
typedef unsigned short bf16_t;
typedef short bf16x8 __attribute__((ext_vector_type(8)));
typedef float f32x4 __attribute__((ext_vector_type(4)));
typedef float f32x2 __attribute__((ext_vector_type(2)));
typedef float f32x16 __attribute__((ext_vector_type(16)));
typedef unsigned u32x4 __attribute__((ext_vector_type(4)));
typedef unsigned u32x2 __attribute__((ext_vector_type(2)));
typedef __bf16 bf16x2_t __attribute__((ext_vector_type(2)));
typedef int i32x4 __attribute__((ext_vector_type(4)));
typedef int i32x8 __attribute__((ext_vector_type(8)));

constexpr int BATCH = 2, SEQ = 8192, DM = 1024, T = BATCH * SEQ, DEPTH = 2;
constexpr int PIN = 2328, PINP = 2560;
constexpr int NE = 32, FF = 1024, TOPK = 4;
constexpr int NCMP = 511, NCMPP = 512;
constexpr float NORM_EPS = 1e-6f;
constexpr float W8SCALE = 64.f;
constexpr int W8_E8M0 = 0x79797979, ONE_E8M0 = 0x7f7f7f7f;
constexpr float QSCALE = 0.125f * 1.4426950408889634f;
constexpr int NWAVES = 8, NTHREADS = 512;

constexpr size_t MiB = 1u << 20;
constexpr size_t WS_CTL = 0, CTL_ZERO_BYTES = 1 * MiB;
constexpr size_t WS_WIN = 1 * MiB;
constexpr size_t WS_WOUT = 11 * MiB;
constexpr size_t WS_SGW = 15 * MiB;
constexpr size_t WS_CW1 = 15 * MiB + 512 * 1024;
constexpr size_t WS_ROPE = 17 * MiB;
constexpr size_t WS_RWP = 21 * MiB;
constexpr size_t WS_MISC = 21 * MiB + 512 * 1024;
constexpr size_t WS_W1T = 32 * MiB;
constexpr size_t WS_W2T = 288 * MiB;
constexpr size_t WS_XR = 416 * MiB;
constexpr size_t WS_H = 480 * MiB;
constexpr size_t WS_UG = 513 * MiB, WS_VG = 529 * MiB, WS_Q = 545 * MiB;
constexpr size_t WS_KC = 561 * MiB, WS_VC = 565 * MiB, WS_KS = 569 * MiB, WS_KW = 573 * MiB;
constexpr size_t WS_VST = 577 * MiB, WS_VWT = 581 * MiB;
constexpr size_t WS_GATES = 585 * MiB;
constexpr size_t WS_KCMP = 587 * MiB;
constexpr size_t WS_VCT = 587 * MiB + 512 * 1024;
constexpr size_t WS_Y = 588 * MiB;
constexpr size_t WS_TOK = 620 * MiB;
constexpr size_t WS_ASG = 622 * MiB;
constexpr size_t WS_GATE4 = 622 * MiB + 512 * 1024;
constexpr size_t WS_YPART = 912 * MiB;
constexpr size_t WS_CNTI = 623 * MiB;
constexpr size_t WS_ACT = 624 * MiB;
constexpr size_t WS_YROWS = 768 * MiB;
constexpr size_t WS_H8 = 944 * MiB;
constexpr size_t WS_END = 962 * MiB;
constexpr int CW_BAR = 4096;
constexpr int CW_MOD = 16384;
constexpr int CW_CNT = 40960;
constexpr int CW_KMAX = 41088;
constexpr int CW_GCNT = 41216;

__device__ __forceinline__ unsigned cvtpk(float lo, float hi) { f32x2 v = {lo, hi}; bf16x2_t b = __builtin_convertvector(v, bf16x2_t); return __builtin_bit_cast(unsigned, b); }
__device__ __forceinline__ unsigned cvt4_fp8(float a, float b, float c, float d) { int w = 0; w = __builtin_amdgcn_cvt_pk_fp8_f32(a, b, w, false); w = __builtin_amdgcn_cvt_pk_fp8_f32(c, d, w, true); return (unsigned)w; }
__device__ __forceinline__ float bf2f(unsigned short b) { return __uint_as_float((unsigned)b << 16); }
__device__ __forceinline__ float bflo(unsigned w) { return __uint_as_float(w << 16); }
__device__ __forceinline__ float bfhi(unsigned w) { return __uint_as_float(w & 0xffff0000u); }
__device__ __forceinline__ float fast_exp2(float x) { return __builtin_amdgcn_exp2f(x); }
__device__ __forceinline__ float fast_rcp(float x) { return __builtin_amdgcn_rcpf(x); }
__device__ __forceinline__ float sigmoidf_(float x) { return fast_rcp(1.f + fast_exp2(-1.4426950408889634f * x)); }
__device__ __forceinline__ float gelu_tanh(float x) { const float u = 0.7978845608028654f * (x + 0.044715f * x * x * x); return x * fast_rcp(1.f + fast_exp2(-2.885390081777927f * u)); }

__device__ __forceinline__ float x16_sum(float x) { auto r = __builtin_amdgcn_permlane16_swap(__float_as_uint(x), __float_as_uint(x), false, false); return __uint_as_float(r[0]) + __uint_as_float(r[1]); }
__device__ __forceinline__ float x32_sum(float x) { auto r = __builtin_amdgcn_permlane32_swap(__float_as_uint(x), __float_as_uint(x), false, false); return __uint_as_float(r[0]) + __uint_as_float(r[1]); }
__device__ __forceinline__ float x16_max(float x) { auto r = __builtin_amdgcn_permlane16_swap(__float_as_uint(x), __float_as_uint(x), false, false); return fmaxf(__uint_as_float(r[0]), __uint_as_float(r[1])); }
__device__ __forceinline__ float x32_max(float x) { auto r = __builtin_amdgcn_permlane32_swap(__float_as_uint(x), __float_as_uint(x), false, false); return fmaxf(__uint_as_float(r[0]), __uint_as_float(r[1])); }
__device__ __forceinline__ float kg_sum(float x) { return x32_sum(x16_sum(x)); }
__device__ __forceinline__ float kg_max(float x) { return x32_max(x16_max(x)); }
__device__ __forceinline__ float quad_sum(float x) { x += __uint_as_float(__builtin_amdgcn_update_dpp(0u, __float_as_uint(x), 0xB1, 0xF, 0xF, true)); x += __uint_as_float(__builtin_amdgcn_update_dpp(0u, __float_as_uint(x), 0x4E, 0xF, 0xF, true)); return x; }
__device__ __forceinline__ float wave_sum(float v) {
    v = quad_sum(v);
    v += __uint_as_float(__builtin_amdgcn_update_dpp(0u, __float_as_uint(v), 0x141, 0xF, 0xF, true));
    v += __uint_as_float(__builtin_amdgcn_update_dpp(0u, __float_as_uint(v), 0x140, 0xF, 0xF, true));
    return x32_sum(x16_sum(v));
}
#define LDS_WAIT() asm volatile("s_waitcnt lgkmcnt(0)" ::: "memory")
#define VM_WAIT() asm volatile("s_waitcnt vmcnt(0)" ::: "memory")

__device__ __forceinline__ int kfrag_off(int key, int c8) {
    const int s = key >> 5, ko = key & 31, u = (ko >> 2) & 1, r16 = ((ko >> 3) << 2) | (ko & 3), ks = c8 >> 2, kg = c8 & 3;
    return s * 2048 + (u * 2 + ks) * 512 + (kg * 16 + r16) * 8;
}
__device__ __forceinline__ int vfrag_off(int key, int d) {
    const int s = key >> 5, ko = key & 31;
    return s * 2048 + (d >> 4) * 512 + ((ko >> 3) * 16 + (d & 15)) * 8 + (ko & 7);
}
namespace pg8 {
constexpr int BM = 256, BK = 64, HALF = 128, HTB = HALF * BK * 2, STAGE_BYTES = 8 * HTB, NXCD = 8, WGM = 8;
__host__ __device__ __forceinline__ int lds_byte(int r, int c) { const int st = (r >> 4) * 2 + (c >> 5), rr = r & 15, cc = c & 31, ob = rr * 64 + cc * 2; return st * 1024 + (ob ^ (((ob >> 9) & 1) << 5)); }
__host__ __device__ __forceinline__ void stage_rc(int b, int& R, int& C) { const int st = b / 1024, sb = b % 1024, swz = sb ^ (((sb >> 9) & 1) << 5); R = (st >> 1) * 16 + swz / 64; C = (st & 1) * 32 + (swz % 64) / 2; }
__host__ __device__ __forceinline__ int perm32(int rho) { const int n = rho >> 4, i = rho & 15; return 8 * (i >> 2) + 4 * n + (i & 3); }

struct Unit { int pm, pn, e, pnl, rloc; };

struct DenseOrder {
    int nM, nN, nwg, G, c;
    __device__ void init(int M, int N, int G_, int c_) { nM = M / BM; nN = N / BM; nwg = nM * nN; G = G_; c = c_; }
    __device__ bool next(int i, Unit& u) const {
        const long L = (long)i * G + c; if (L >= nwg) return false;
        int wgid = (int)L; { const int q = nwg / NXCD, r = nwg % NXCD, xcd = wgid % NXCD, off = wgid / NXCD; wgid = (xcd < r ? xcd * (q + 1) : r * (q + 1) + (xcd - r) * q) + off; }
        const int nig = WGM * nN, gid = wgid / nig, fm = gid * WGM, gsz = (nM - fm) < WGM ? (nM - fm) : WGM;
        u.pm = fm + ((wgid % nig) % gsz); u.pn = (wgid % nig) / gsz; u.e = 0; u.pnl = u.pn; u.rloc = 0; return true;
    }
    __device__ __forceinline__ unsigned rowoff(const Unit&, int) const { return 0u; }
};

struct MoeOrder {
    const LAS int* ust;
    const LAS int* bst;
    const LAS int* cnt;
    const int* tok;
    int NT, G, c, total, rowbytes;
    __device__ bool next(int i, Unit& u) const {
        const int L = i * G + c; if (L >= total) return false;
        int e = 0;
        for (int k = 1; k < NE; ++k) e += (L >= ust[k]) ? 1 : 0;
        e = __builtin_amdgcn_readfirstlane(e);
        const int loc = __builtin_amdgcn_readfirstlane(L - ust[e]), b0 = __builtin_amdgcn_readfirstlane(bst[e]), nb = __builtin_amdgcn_readfirstlane(bst[e + 1]) - b0;
        u.e = e; u.pnl = loc / nb; u.rloc = loc - u.pnl * nb; u.pm = b0 + u.rloc; u.pn = e * NT + u.pnl; return true;
    }
    __device__ __forceinline__ unsigned rowoff(const Unit& u, int r) const {
        const int slot = u.rloc * 256 + r; const int tk = slot < cnt[u.e] ? tok[u.e * 16384 + slot] : T;
        return (unsigned)tk * (unsigned)rowbytes;
    }
};

template <class Epi, class Sched, bool GATHER, bool ALIGN_EPI, bool FP8 = false>
__device__ __forceinline__ void gemm_phase(LAS unsigned char* lds, const bf16_t* A, const bf16_t* Bt, const int K, const Sched& S, const Epi& E) {
    int tid_ = threadIdx.x; asm volatile("" : "+v"(tid_));
    const int tid = tid_, wid = __builtin_amdgcn_readfirstlane(tid >> 6), lane = tid & 63, wr = wid >> 2, wc = wid & 3, fr = lane & 15, fq = lane >> 4;
    const int nt = K / BK;
    int Rr[2], Cc[2]; unsigned voffB[2];
#pragma unroll
    for (int i = 0; i < 2; ++i) { int R, C; stage_rc(tid * 16 + i * 8192, R, C); Rr[i] = R; Cc[i] = C; const int Rb = Epi::PERM ? ((R & ~31) + perm32(R & 31)) : R; voffB[i] = (unsigned)(Rb * K + C) * 2u; }
    const size_t kstep = (size_t)(BK * 2);
    const size_t hstep = (size_t)HALF * K * 2;
    const size_t tstep = 2 * hstep;
    const unsigned ldsw = (unsigned)wid * 1024u;
    const int aoff = lds_byte(wr * 64 + fr, fq * 8), boff = lds_byte(wc * 32 + fr, fq * 8);
#define PG8_SA(b, h) (((b) * 2 + (h)) * HTB)
#define PG8_SB(b, h) ((4 + (b) * 2 + (h)) * HTB)
#define PG8_STAGE(bufoff, gbase, v0, v1) do { \
        __builtin_amdgcn_global_load_lds((const unsigned*)((const char*)(gbase) + (v0)), (LAS unsigned*)(lds + (bufoff) + ldsw), 16, 0, 0); \
        __builtin_amdgcn_global_load_lds((const unsigned*)((const char*)(gbase) + (v1)), (LAS unsigned*)(lds + (bufoff) + ldsw + 8192), 16, 0, 0); } while (0)
#define PG8_STAGEB(bufoff, gbase) PG8_STAGE(bufoff, gbase, voffB[0], voffB[1])
#define PG8_CAT8(x0, x1) __builtin_shufflevector(x0, x1, 0, 1, 2, 3, 4, 5, 6, 7)
#define PG8_RD4(off) (*(const LAS i32x4*)(lds + (off)))
#define PG8_LDA(dst, b, h) do { if constexpr (FP8) { _Pragma("unroll") for (int m = 0; m < 4; ++m) dst##8[m] = PG8_CAT8(PG8_RD4(PG8_SA(b, h) + aoff + m * 2048), PG8_RD4(PG8_SA(b, h) + aoff + m * 2048 + 1024)); } \
        else { _Pragma("unroll") for (int m = 0; m < 4; ++m) _Pragma("unroll") for (int k = 0; k < 2; ++k) dst[m][k] = *(const LAS bf16x8*)(lds + PG8_SA(b, h) + aoff + m * 2048 + k * 1024); } } while (0)
#define PG8_LDB(dst, b, h) do { if constexpr (FP8) { _Pragma("unroll") for (int n = 0; n < 2; ++n) dst##8[n] = PG8_CAT8(PG8_RD4(PG8_SB(b, h) + boff + n * 2048), PG8_RD4(PG8_SB(b, h) + boff + n * 2048 + 1024)); } \
        else { _Pragma("unroll") for (int n = 0; n < 2; ++n) _Pragma("unroll") for (int k = 0; k < 2; ++k) dst[n][k] = *(const LAS bf16x8*)(lds + PG8_SB(b, h) + boff + n * 2048 + k * 1024); } } while (0)
#define PG8_MMA(ai, bj, At, Bt_) do { __builtin_amdgcn_s_setprio(1); _Pragma("unroll") for (int m = 0; m < 4; ++m) _Pragma("unroll") for (int n = 0; n < 2; ++n) { \
        if constexpr (FP8) { asm volatile("v_mfma_scale_f32_16x16x128_f8f6f4 %0, %1, %2, %0, %3, %4 op_sel_hi:[0,0,0]" : "+v"(acc[ai][bj][m][n]) : "v"(Bt_##8[n]), "v"(At##8[m]), "v"(sc_w), "v"(sc_x)); } \
        else { _Pragma("unroll") for (int k = 0; k < 2; ++k) acc[ai][bj][m][n] = __builtin_amdgcn_mfma_f32_16x16x32_bf16(Bt_[n][k], At[m][k], acc[ai][bj][m][n], 0, 0, 0); } } \
        __builtin_amdgcn_s_setprio(0); } while (0)
#define PG8_WAIT_V(n) asm volatile("s_waitcnt vmcnt(" #n ")" ::: "memory")
#define PG8_WAIT_L(n) asm volatile("s_waitcnt lgkmcnt(" #n ")" ::: "memory")
#define PG8_BAR __builtin_amdgcn_s_barrier()
#define PG8_SCHED __builtin_amdgcn_sched_barrier(0)
#define PG8_SETV(v, u) do { _Pragma("unroll") for (int h_ = 0; h_ < 2; ++h_) _Pragma("unroll") for (int i_ = 0; i_ < 2; ++i_) \
        v[h_][i_] = GATHER ? (S.rowoff(u, Rr[i_] + HALF * h_) + (unsigned)Cc[i_] * 2u) : (unsigned)((Rr[i_] + HALF * h_) * K + Cc[i_]) * 2u; } while (0)
    Unit cur, nxt; int ui = 0;
    if (!S.next(0, cur)) return;
    unsigned vc[2][2], vn[2][2];
    PG8_SETV(vc, cur);
    f32x4 acc[2][2][4][2];
#pragma unroll
    for (int a = 0; a < 2; ++a)
#pragma unroll
        for (int b = 0; b < 2; ++b)
#pragma unroll
            for (int m = 0; m < 4; ++m)
#pragma unroll
                for (int n = 0; n < 2; ++n) acc[a][b][m][n] = (f32x4){0.f, 0.f, 0.f, 0.f};
    bf16x8 At[4][2], B0[2][2], B1[2][2]; i32x8 At8[4], B08[2], B18[2];
    int sc_w = W8_E8M0, sc_x = ONE_E8M0; asm volatile("" : "+v"(sc_w), "+v"(sc_x));
    const char* cA = GATHER ? (const char*)A : (const char*)A + (size_t)cur.pm * tstep;
    const char* cB = (const char*)Bt + (size_t)cur.pn * tstep;
    PG8_STAGEB(PG8_SB(0, 0), cB); PG8_STAGEB(PG8_SB(0, 1), cB + hstep); PG8_STAGE(PG8_SA(0, 0), cA, vc[0][0], vc[0][1]); PG8_STAGE(PG8_SA(0, 1), cA, vc[1][0], vc[1][1]);
    if (wr == 1) PG8_BAR;
    PG8_WAIT_V(2); PG8_BAR;
    PG8_STAGEB(PG8_SB(1, 0), cB + kstep); PG8_STAGE(PG8_SA(1, 0), cA + kstep, vc[0][0], vc[0][1]); PG8_STAGEB(PG8_SB(1, 1), cB + hstep + kstep);
    PG8_WAIT_V(6); PG8_BAR;
    for (;;) {
        const bool has_next = S.next(ui + 1, nxt);
        const char* nA = GATHER ? (const char*)A : (has_next ? (const char*)A + (size_t)nxt.pm * tstep : cA);
        const char* nB = has_next ? (const char*)Bt + (size_t)nxt.pn * tstep : cB;
        if constexpr (GATHER) { if (has_next) { PG8_SETV(vn, nxt); } else {
#pragma unroll
            for (int h_ = 0; h_ < 2; ++h_)
#pragma unroll
                for (int i_ = 0; i_ < 2; ++i_) vn[h_][i_] = vc[h_][i_]; } }
#pragma nounroll
        for (int t = 0; t < nt; t += 2) {
            const bool last = (t == nt - 2);
            const char* a1 = cA + (size_t)(t + 1) * kstep;
            const char* a2 = last ? nA : cA + (size_t)(t + 2) * kstep; const char* b2 = last ? nB : cB + (size_t)(t + 2) * kstep;
            const char* a3 = a2 + kstep; const char* b3 = b2 + kstep;
            const unsigned w00 = (GATHER && last) ? vn[0][0] : vc[0][0], w01 = (GATHER && last) ? vn[0][1] : vc[0][1], w10 = (GATHER && last) ? vn[1][0] : vc[1][0], w11 = (GATHER && last) ? vn[1][1] : vc[1][1];
            PG8_LDB(B0, 0, 0); PG8_LDB(B1, 0, 1); PG8_SCHED; PG8_LDA(At, 0, 0); PG8_STAGE(PG8_SA(1, 1), a1, vc[1][0], vc[1][1]);
            PG8_WAIT_V(8); PG8_WAIT_L(0); PG8_BAR; PG8_MMA(0, 0, At, B0); PG8_MMA(0, 1, At, B1); PG8_BAR; PG8_SCHED;
            PG8_LDA(At, 0, 1); PG8_STAGEB(PG8_SB(0, 0), b2); PG8_STAGEB(PG8_SB(0, 1), b2 + hstep); PG8_STAGE(PG8_SA(0, 0), a2, w00, w01);
            PG8_WAIT_V(8); PG8_WAIT_L(0); PG8_BAR; PG8_MMA(1, 0, At, B0); PG8_MMA(1, 1, At, B1); PG8_BAR; PG8_SCHED;
            PG8_LDB(B0, 1, 0); PG8_LDB(B1, 1, 1); PG8_SCHED; PG8_LDA(At, 1, 0); PG8_STAGE(PG8_SA(0, 1), a2, w10, w11);
            PG8_WAIT_V(8); PG8_WAIT_L(0); PG8_BAR; PG8_MMA(0, 0, At, B0); PG8_MMA(0, 1, At, B1); PG8_BAR; PG8_SCHED;
            PG8_LDA(At, 1, 1); PG8_STAGEB(PG8_SB(1, 0), b3); PG8_STAGEB(PG8_SB(1, 1), b3 + hstep); PG8_STAGE(PG8_SA(1, 0), a3, w00, w01);
            PG8_WAIT_V(8); PG8_WAIT_L(0); PG8_BAR; PG8_MMA(1, 0, At, B0); PG8_MMA(1, 1, At, B1); PG8_BAR; PG8_SCHED;
        }
        if constexpr (FP8) { asm volatile("s_nop 15\n\ts_nop 15" ::: "memory"); }
        if constexpr (ALIGN_EPI) { if (wr == 0) PG8_BAR; }
        E(acc, cur, wr, wc, fr, fq);
        if (!has_next) break;
#pragma unroll
        for (int a = 0; a < 2; ++a)
#pragma unroll
            for (int b = 0; b < 2; ++b)
#pragma unroll
                for (int m = 0; m < 4; ++m)
#pragma unroll
                    for (int n = 0; n < 2; ++n) acc[a][b][m][n] = (f32x4){0.f, 0.f, 0.f, 0.f};
        cur = nxt; cA = nA; cB = nB; ++ui;
        if constexpr (GATHER) {
#pragma unroll
        for (int h_ = 0; h_ < 2; ++h_)
#pragma unroll
            for (int i_ = 0; i_ < 2; ++i_) vc[h_][i_] = vn[h_][i_]; }
        if constexpr (ALIGN_EPI) { if (wr == 1) PG8_BAR; }
    }
    PG8_WAIT_V(0);
    if constexpr (!ALIGN_EPI) { if (wr == 0) PG8_BAR; }
    PG8_BAR;
#undef PG8_SA
#undef PG8_SB
#undef PG8_STAGE
#undef PG8_STAGEB
#undef PG8_LDA
#undef PG8_LDB
#undef PG8_MMA
#undef PG8_CAT8
#undef PG8_RD4
#undef PG8_WAIT_V
#undef PG8_WAIT_L
#undef PG8_BAR
#undef PG8_SCHED
#undef PG8_SETV
}
}

#define XB_TMO      128
#define XB_XCNT(j)  (256  + 64 * (j))
#define XB_XSUB(j)  (1280 + 64 * (j))
#define XB_XGEN(j)  (2304 + 64 * (j))
#define XB_TOP      3328
#define XB_TOPGEN   3392
#define XCD_BAR_WORDS 3456
#define XB_SPIN_CAP (1u << 22)
__device__ __forceinline__ unsigned xb_ld(unsigned* p)              { return __hip_atomic_load(p, __ATOMIC_RELAXED, __HIP_MEMORY_SCOPE_AGENT); }
__device__ __forceinline__ unsigned xb_add(unsigned* p, unsigned v) { return __hip_atomic_fetch_add(p, v, __ATOMIC_RELAXED, __HIP_MEMORY_SCOPE_AGENT); }
__device__ __forceinline__ unsigned xb_xcc_id() { return (unsigned)__builtin_amdgcn_s_getreg((3 << 11) | 20) & 0xFu; }
#define XB_SPIN(cond, bar) do { unsigned _sp = 0; while (cond) { __builtin_amdgcn_s_sleep(1); \
    if ((++_sp & 255u) == 0u) { if (xb_ld(&(bar)[XB_TMO])) break; if (_sp > XB_SPIN_CAP) { atomicAdd(&(bar)[XB_TMO], 1u); break; } } } } while (0)
struct XcdBarrier { unsigned* bar; unsigned x; volatile LAS unsigned* st; };
__device__ __forceinline__ XcdBarrier xcd_barrier_post(unsigned* bar, volatile LAS unsigned* st) {
    XcdBarrier b; b.bar = bar; b.x = xb_xcc_id(); b.st = st;
    if (threadIdx.x == 0) (void)xb_add(&bar[XB_XCNT(b.x)], 1u);
    return b;
}
__device__ __forceinline__ void xcd_barrier_complete(unsigned* bar, unsigned x, unsigned& nloc, unsigned& nx) {
    const unsigned G = gridDim.x * gridDim.y * gridDim.z;
    unsigned sum, cnt, mine, sp = 0u;
    for (;;) {
        sum = 0u; cnt = 0u; mine = 0u;
#pragma unroll
        for (unsigned j = 0; j < 16; ++j) { const unsigned c = xb_ld(&bar[XB_XCNT(j)]); sum += c; cnt += (c > 0u) ? 1u : 0u; mine = (j == x) ? c : mine; }
        if (sum == G) break;
        __builtin_amdgcn_s_sleep(1);
        if ((++sp & 255u) == 0u) { if (xb_ld(&bar[XB_TMO])) break; if (sp > XB_SPIN_CAP) { atomicAdd(&bar[XB_TMO], 1u); break; } }
    }
    nloc = mine > 0u ? mine : 1u; nx = cnt > 0u ? cnt : 1u;
}
__device__ __forceinline__ void xcd_barrier(const XcdBarrier& b) {
    asm volatile("s_waitcnt vmcnt(0)" ::: "memory");
    __syncthreads();
    if (threadIdx.x == 0) {
        unsigned* bar = b.bar;
        __builtin_amdgcn_s_waitcnt(0);
        unsigned nloc = b.st[0], nx = b.st[1];
        if (nloc == 0u) { xcd_barrier_complete(bar, b.x, nloc, nx); b.st[0] = nloc; b.st[1] = nx; }
        const unsigned old = xb_add(&bar[XB_XSUB(b.x)], 1u);
        const unsigned gen = old / nloc;
        if (old + 1u == (gen + 1u) * nloc) {
            __builtin_amdgcn_fence(__ATOMIC_RELEASE, "agent");
            asm volatile("s_waitcnt vmcnt(0)" ::: "memory");
            const unsigned og = xb_add(&bar[XB_TOP], 1u);
            const unsigned tg = og / nx;
            if (og + 1u == (tg + 1u) * nx) xb_add(&bar[XB_TOPGEN], 1u);
            else XB_SPIN(xb_ld(&bar[XB_TOPGEN]) == tg, bar);
            __builtin_amdgcn_fence(__ATOMIC_ACQUIRE, "agent");
            xb_add(&bar[XB_XGEN(b.x)], 1u);
            asm volatile("s_waitcnt vmcnt(0)" ::: "memory");
        } else {
            XB_SPIN(xb_ld(&bar[XB_XGEN(b.x)]) == gen, bar);
            __builtin_amdgcn_fence(__ATOMIC_ACQUIRE, "agent");
            asm volatile("s_waitcnt vmcnt(0)" ::: "memory");
        }
    }
    __syncthreads();
}

struct Args { const void* in[26]; float* out; unsigned char* ws; int ph_lo, ph_hi, li, pad; };
enum { I_X = 0, I_C, I_POS, I_ADAW, I_ADAB, I_N1G, I_N2G, I_WIN, I_WOUT, I_SGLNG, I_SGLNB, I_SGW, I_SGB, I_PEK, I_PEV, I_CW1K, I_CW2K, I_CW1V, I_CW2V, I_RW, I_RB, I_EW1, I_EB1, I_EW2, I_EB2, I_FING };

struct Frame {
    LAS unsigned char* lds;
    unsigned* ctl;
    unsigned char* ws;
    int tid, lane, wave, vcu, G;
};
#define WSP(type, off) ((type*)(F.ws + (off)))
#define MODP(l, b, part) ((const float*)(F.ctl + CW_MOD) + ((size_t)((l) * 2 + (b)) * 6 + (part)) * 1024)

constexpr int RING_BYTES = 131072;
constexpr int ATT_LDS_BYTES = 147456;
constexpr int LDSCTL_OFF = ATT_LDS_BYTES;
constexpr int MISC_OFF = LDSCTL_OFF + 320;
constexpr int MOE_OFF = MISC_OFF + 128;
constexpr int LDS_BYTES = 163840;

struct EpiProj {
    static constexpr bool PERM = true;
    bf16_t *UG, *VG, *Q, *KC, *VC, *KS, *KW, *VST, *VWT; float* GATES; const float* ROPE; unsigned* kmax;
    __device__ __forceinline__ void operator()(const f32x4 (&acc)[2][2][4][2], const pg8::Unit& u, int wr, int wc, int fr, int fq) const {
        const int pn = u.pn; const int row0 = u.pm * 256 + wr * 64 + fr; const int b = u.pm >> 5;
        if (pn < 4 || pn == 6) {
#pragma unroll
            for (int ai = 0; ai < 2; ++ai)
#pragma unroll
                for (int m = 0; m < 4; ++m) { const size_t r = (size_t)(row0 + ai * 128 + m * 16);
#pragma unroll
                    for (int bj = 0; bj < 2; ++bj) { f32x4 v0 = acc[ai][bj][m][0], v1 = acc[ai][bj][m][1];
                        if (pn < 4) {
#pragma unroll
                            for (int i = 0; i < 4; ++i) { v0[i] = gelu_tanh(v0[i]); v1[i] = gelu_tanh(v1[i]); } }
                        u32x4 w; w.x = cvtpk(v0[0], v0[1]); w.y = cvtpk(v0[2], v0[3]); w.z = cvtpk(v1[0], v1[1]); w.w = cvtpk(v1[2], v1[3]);
                        bf16_t* dst;
                        if (pn < 2) dst = UG + r * 512 + pn * 256 + bj * 128 + wc * 32 + fq * 8;
                        else if (pn < 4) dst = VG + r * 512 + (pn - 2) * 256 + bj * 128 + wc * 32 + fq * 8;
                        else dst = (bj ? VC : KC) + r * 128 + wc * 32 + fq * 8;
                        *(u32x4*)dst = w; } }
        } else if (pn == 4 || pn == 5 || pn == 7) {
            const float sc = (pn == 7) ? 1.f : QSCALE; float nmax = 0.f;
#pragma unroll
            for (int ai = 0; ai < 2; ++ai)
#pragma unroll
                for (int m = 0; m < 4; ++m) { const size_t r = (size_t)(row0 + ai * 128 + m * 16);
                    const f32x4* cs = (const f32x4*)(ROPE + (r * 32 + fq * 8) * 2);
                    float o1[8], o2[8], nsq = 0.f;
#pragma unroll
                    for (int n = 0; n < 2; ++n) { const f32x4 c0 = cs[2 * n], c1 = cs[2 * n + 1]; const f32x4 x1 = acc[ai][0][m][n], x2 = acc[ai][1][m][n];
                        const float cc[4] = {c0[0], c0[2], c1[0], c1[2]}, ss[4] = {c0[1], c0[3], c1[1], c1[3]};
#pragma unroll
                        for (int i = 0; i < 4; ++i) { o1[4 * n + i] = (x1[i] * cc[i] - x2[i] * ss[i]) * sc; o2[4 * n + i] = (x2[i] * cc[i] + x1[i] * ss[i]) * sc; nsq += x1[i] * x1[i] + x2[i] * x2[i]; } }
                    u32x4 w1, w2; w1.x = cvtpk(o1[0], o1[1]); w1.y = cvtpk(o1[2], o1[3]); w1.z = cvtpk(o1[4], o1[5]); w1.w = cvtpk(o1[6], o1[7]);
                    w2.x = cvtpk(o2[0], o2[1]); w2.y = cvtpk(o2[2], o2[3]); w2.z = cvtpk(o2[4], o2[5]); w2.w = cvtpk(o2[6], o2[7]);
                    if (pn != 7) { bf16_t* dst = Q + r * 512 + (4 * (pn - 4) + wc) * 64 + fq * 8; *(u32x4*)dst = w1; *(u32x4*)(dst + 32) = w2; }
                    else { bf16_t* img = ((wc < 2) ? KS : KW) + (size_t)(b * 2 + (wc & 1)) * SEQ * 64; const int t = (int)r & (SEQ - 1);
                        *(u32x4*)(img + kfrag_off(t, fq)) = w1; *(u32x4*)(img + kfrag_off(t, 4 + fq)) = w2; }
                    nsq = kg_sum(nsq); nmax = fmaxf(nmax, nsq); }
            if (pn == 7) {
#pragma unroll
                for (int o = 1; o < 16; o <<= 1) nmax = fmaxf(nmax, __shfl_xor(nmax, o));
                if ((threadIdx.x & 63) == 0) atomicMax(kmax + ((wc < 2) ? 0 : 8) + b * 2 + (wc & 1), __float_as_uint(nmax * 1.02f));
            }
        } else if (pn == 8) {
            const int g = wc >> 1; float vmx = 0.f;
#pragma unroll
            for (int ai = 0; ai < 2; ++ai)
#pragma unroll
                for (int m = 0; m < 4; ++m) { const int r = row0 + ai * 128 + m * 16; const int s = r & (SEQ - 1);
#pragma unroll
                    for (int bj = 0; bj < 2; ++bj) { bf16_t* img = (bj ? VWT : VST) + (size_t)(b * 2 + g) * SEQ * 64;
#pragma unroll
                        for (int n = 0; n < 2; ++n)
#pragma unroll
                            for (int i = 0; i < 4; ++i) { img[vfrag_off(s, (wc & 1) * 32 + fq * 8 + n * 4 + i)] = (bf16_t)(cvtpk(acc[ai][bj][m][n][i], 0.f) & 0xffffu); if (bj == 0) vmx = fmaxf(vmx, fabsf(acc[ai][0][m][n][i])); } } }
#pragma unroll
            for (int o = 1; o < 64; o <<= 1) vmx = fmaxf(vmx, __shfl_xor(vmx, o));
            if ((threadIdx.x & 63) == 0) atomicMax(kmax + 4 + b * 2 + g, __float_as_uint(vmx * 1.01f));
        } else {
            if (wc == 0 && fq < 3) {
#pragma unroll
                for (int ai = 0; ai < 2; ++ai)
#pragma unroll
                    for (int m = 0; m < 4; ++m) { const size_t r = (size_t)(row0 + ai * 128 + m * 16);
#pragma unroll
                        for (int n = 0; n < 2; ++n) { f32x4 v = acc[ai][0][m][n];
#pragma unroll
                            for (int i = 0; i < 4; ++i) v[i] = sigmoidf_(v[i]);
                            *(f32x4*)(GATES + r * 24 + fq * 8 + n * 4) = v; } }
            }
        }
    }
};
struct EpiOut {
    static constexpr bool PERM = false;
    const float* xin; float* xout; const float* g1;
    __device__ __forceinline__ void operator()(const f32x4 (&acc)[2][2][4][2], const pg8::Unit& u, int wr, int wc, int fr, int fq) const {
        const int row0 = u.pm * 256 + wr * 64 + fr; const int b = u.pm >> 5; const int col0 = u.pn * 256 + wc * 32 + fq * 4;
        const float* gb = g1 + (size_t)b * 6144 + 2048;
        f32x4 gv[2][2];
#pragma unroll
        for (int bj = 0; bj < 2; ++bj)
#pragma unroll
            for (int n = 0; n < 2; ++n) gv[bj][n] = *(const f32x4*)(gb + col0 + bj * 128 + n * 16);
#pragma unroll
        for (int ai = 0; ai < 2; ++ai)
#pragma unroll
            for (int m = 0; m < 4; ++m) { const size_t off = (size_t)(row0 + ai * 128 + m * 16) * DM + col0;
#pragma unroll
                for (int bj = 0; bj < 2; ++bj)
#pragma unroll
                    for (int n = 0; n < 2; ++n) { const f32x4 xi = *(const f32x4*)(xin + off + bj * 128 + n * 16); *(f32x4*)(xout + off + bj * 128 + n * 16) = xi + gv[bj][n] * acc[ai][bj][m][n]; } }
    }
};
struct EpiSwiglu {
    static constexpr bool PERM = true;
    unsigned char* ACT; const float* b1;
    __device__ __forceinline__ void operator()(const f32x4 (&acc)[2][2][4][2], const pg8::Unit& u, int wr, int wc, int fr, int fq) const {
        const int row0 = u.pm * 256 + wr * 64 + fr; const int j0 = u.pnl * 128 + wc * 32 + fq * 8;
        const float* bb = b1 + (size_t)u.e * 2048 + j0;
        f32x4 bg[2], bl[2];
#pragma unroll
        for (int n = 0; n < 2; ++n) { bg[n] = *(const f32x4*)(bb + n * 4); bl[n] = *(const f32x4*)(bb + 1024 + n * 4); }
#pragma unroll
        for (int ai = 0; ai < 2; ++ai)
#pragma unroll
            for (int m = 0; m < 4; ++m) { float o[8];
#pragma unroll
                for (int n = 0; n < 2; ++n) { const f32x4 gl = acc[ai][0][m][n] + bg[n], ln = acc[ai][1][m][n] + bl[n];
#pragma unroll
                    for (int i = 0; i < 4; ++i) { const float gg = fminf(gl[i], 7.f), ll = fminf(fmaxf(ln[i], -7.f), 7.f); o[n * 4 + i] = gg * sigmoidf_(1.702f * gg) * (ll + 1.f); } }
                u32x2 w; w.x = cvt4_fp8(o[0], o[1], o[2], o[3]); w.y = cvt4_fp8(o[4], o[5], o[6], o[7]);
                *(u32x2*)(ACT + (size_t)(row0 + ai * 128 + m * 16) * FF + j0) = w; }
    }
};
struct EpiDown {
    static constexpr bool PERM = true;
    bf16_t* YR; const float* b2;
    __device__ __forceinline__ void operator()(const f32x4 (&acc)[2][2][4][2], const pg8::Unit& u, int wr, int wc, int fr, int fq) const {
        const int row0 = u.pm * 256 + wr * 64 + fr; const int c0 = u.pnl * 256 + wc * 32 + fq * 8;
        const float* bb = b2 + (size_t)u.e * 1024 + c0;
        f32x4 bv[2][2];
#pragma unroll
        for (int bj = 0; bj < 2; ++bj)
#pragma unroll
            for (int n = 0; n < 2; ++n) bv[bj][n] = *(const f32x4*)(bb + bj * 128 + n * 4);
#pragma unroll
        for (int ai = 0; ai < 2; ++ai)
#pragma unroll
            for (int m = 0; m < 4; ++m)
#pragma unroll
                for (int bj = 0; bj < 2; ++bj) { const f32x4 v0 = acc[ai][bj][m][0] + bv[bj][0], v1 = acc[ai][bj][m][1] + bv[bj][1];
                    u32x4 w; w.x = cvtpk(v0[0], v0[1]); w.y = cvtpk(v0[2], v0[3]); w.z = cvtpk(v1[0], v1[1]); w.w = cvtpk(v1[2], v1[3]);
                    *(u32x4*)(YR + (size_t)(row0 + ai * 128 + m * 16) * DM + c0 + bj * 128) = w; }
    }
};

__device__ __forceinline__ void tr_item(const float* W, int ldn, int k0, int c0, int nvalid, bf16_t* WT, int K, int drow0, LAS float* scr, int lane) {
    const int nn = lane & 31;
#pragma unroll 8
    for (int i = 0; i < 32; ++i) { const int kk = 2 * i + (lane >> 5); scr[kk * 33 + nn] = (nn < nvalid) ? W[(size_t)(k0 + kk) * ldn + c0 + nn] : 0.f; }
    LDS_WAIT(); asm volatile("" ::: "memory");
    const int c = lane & 7;
#pragma unroll
    for (int j = 0; j < 4; ++j) { const int n = (lane >> 3) + 8 * j; const LAS float* s = scr + (8 * c) * 33 + n;
        u32x4 o; o.x = cvtpk(s[0 * 33], s[1 * 33]); o.y = cvtpk(s[2 * 33], s[3 * 33]); o.z = cvtpk(s[4 * 33], s[5 * 33]); o.w = cvtpk(s[6 * 33], s[7 * 33]);
        *(u32x4*)(WT + (size_t)(drow0 + n) * K + k0 + 8 * c) = o; }
    LDS_WAIT(); asm volatile("" ::: "memory");
}
template <bool NTS> __device__ __forceinline__ void tr_item8(const float* W, int ldn, int k0, int c0, unsigned char* W8, int K, int drow0, LAS float* scr, int lane) {
    const int nn = lane & 31;
#pragma unroll 8
    for (int i = 0; i < 32; ++i) { const int kk = 2 * i + (lane >> 5); scr[kk * 33 + nn] = __builtin_nontemporal_load(W + (size_t)(k0 + kk) * ldn + c0 + nn) * W8SCALE; }
    LDS_WAIT(); asm volatile("" ::: "memory");
    const int c = lane & 3;
#pragma unroll
    for (int j = 0; j < 2; ++j) { const int n = (lane >> 2) + 16 * j; const LAS float* s = scr + (16 * c) * 33 + n;
        u32x4 o; o.x = cvt4_fp8(s[0 * 33], s[1 * 33], s[2 * 33], s[3 * 33]); o.y = cvt4_fp8(s[4 * 33], s[5 * 33], s[6 * 33], s[7 * 33]);
        o.z = cvt4_fp8(s[8 * 33], s[9 * 33], s[10 * 33], s[11 * 33]); o.w = cvt4_fp8(s[12 * 33], s[13 * 33], s[14 * 33], s[15 * 33]);
        if (NTS) __builtin_nontemporal_store(o, (u32x4*)(W8 + (size_t)(drow0 + n) * K + k0 + 16 * c)); else *(u32x4*)(W8 + (size_t)(drow0 + n) * K + k0 + 16 * c) = o; }
    LDS_WAIT(); asm volatile("" ::: "memory");
}
__device__ __forceinline__ void win_src(int p, int& c0, int& nvalid) {
    const int pn = p >> 8; nvalid = 32;
    if (pn < 4 || pn == 6) { c0 = p; }
    else if (pn == 4 || pn == 5) { const int pp = p - 1024 - 256 * (pn - 4), bj = pp >> 7, j = pp & 127; c0 = 1024 + (4 * (pn - 4) + (j >> 5)) * 64 + bj * 32; }
    else if (pn == 7) { const int pp = p - 1792, bj = pp >> 7, j = pp & 127, which = j >> 6, g = (j >> 5) & 1; c0 = (which ? 2048 : 1792) + g * 64 + bj * 32; }
    else if (pn == 8) { const int pp = p - 2048, bj = pp >> 7, j = pp & 127; c0 = (bj ? 2176 : 1920) + j; }
    else { const int pp = p - 2304; c0 = 2304 + pp; nvalid = 24 - pp; nvalid = nvalid < 0 ? 0 : (nvalid > 32 ? 32 : nvalid); if (nvalid == 0) c0 = 0; }
}
__device__ __forceinline__ void phase_prologue(Frame& F, const Args& a) {
    LAS float* scr = (LAS float*)(F.lds + F.wave * 8704);
    const int gw = F.vcu * NWAVES + F.wave, NGW = F.G * NWAVES; const int lane = F.lane;
    {
        const float* c = (const float*)a.in[I_C]; const float* adaw = (const float*)a.in[I_ADAW]; const float* adab = (const float*)a.in[I_ADAB];
        float* mod = (float*)(F.ctl + CW_MOD);
        LAS float* red = (LAS float*)(F.lds + 8 * 8704);
        for (int it = F.vcu; it < 2 * 24; it += F.G) {
            const int l = it / 24, nb = it % 24;
            const float* wp = adaw + ((size_t)l * 1024 + F.wave * 128) * 6144 + nb * 256 + lane * 4;
            f32x4 a0 = {0.f, 0.f, 0.f, 0.f}, a1 = a0;
#pragma unroll 4
            for (int k = 0; k < 128; ++k) { const f32x4 w = __builtin_nontemporal_load((const f32x4*)(wp + (size_t)k * 6144));
                const float c0 = c[F.wave * 128 + k], c1 = c[1024 + F.wave * 128 + k]; const float s0 = c0 * sigmoidf_(c0), s1 = c1 * sigmoidf_(c1);
                a0 += w * s0; a1 += w * s1; }
            *(LAS f32x4*)(red + (F.wave * 2 + 0) * 256 + lane * 4) = a0; *(LAS f32x4*)(red + (F.wave * 2 + 1) * 256 + lane * 4) = a1;
            __syncthreads();
            { const int b = F.tid >> 8, col = F.tid & 255; float sum = adab[(size_t)l * 6144 + nb * 256 + col];
#pragma unroll
              for (int ww = 0; ww < 8; ++ww) sum += red[(ww * 2 + b) * 256 + col];
              mod[((size_t)l * 2 + b) * 6144 + nb * 256 + col] = sum; }
            __syncthreads();
        }
    }
    {
        const float* win = (const float*)a.in[I_WIN]; bf16_t* WinT = WSP(bf16_t, WS_WIN);
        for (int it = gw; it < 2 * 16 * 80; it += NGW) { const int l = it / 1280, kb = (it % 1280) / 80, nb = it % 80; int c0, nv; win_src(nb * 32, c0, nv);
            tr_item(win + (size_t)l * 1024 * PIN, PIN, kb * 64, c0, nv, WinT + (size_t)l * PINP * 1024, 1024, nb * 32, scr, lane); }
        const float* wout = (const float*)a.in[I_WOUT]; bf16_t* WoutT = WSP(bf16_t, WS_WOUT);
        for (int it = gw; it < 2 * 16 * 32; it += NGW) { const int l = it / 512, kb = (it % 512) / 32, nb = it % 32;
            tr_item(wout + (size_t)l * 1024 * 1024, 1024, kb * 64, nb * 32, 32, WoutT + (size_t)l * 1024 * 1024, 1024, nb * 32, scr, lane); }
        bf16_t* CW1 = WSP(bf16_t, WS_CW1);
        for (int it = gw; it < 2 * 2 * 32 * 2; it += NGW) { const int l = it / 128, which = (it / 64) & 1, kb = (it % 64) / 2, nb = it & 1;
            const float* src = (const float*)a.in[which ? I_CW1V : I_CW1K] + (size_t)l * 2048 * 64;
            tr_item(src, 64, kb * 64, nb * 32, 32, CW1 + (size_t)(l * 2 + which) * 64 * 2048, 2048, nb * 32, scr, lane); }
        const float* ew1 = (const float*)a.in[I_EW1]; unsigned char* W1T = WSP(unsigned char, WS_W1T);
        for (int it = gw; it < 2 * 32 * 16 * 64; it += NGW) { const int le = it >> 10, kb = (it >> 6) & 15, nb = it & 63; const int p = nb * 32, tile = p >> 8, bj = (p >> 7) & 1, j = p & 127;
            if (le < 32) tr_item8<false>(ew1 + (size_t)le * 1024 * 2048, 2048, kb * 64, bj * 1024 + tile * 128 + j, W1T + (size_t)le * 2048 * 1024, 1024, p, scr, lane);
            else tr_item8<true>(ew1 + (size_t)le * 1024 * 2048, 2048, kb * 64, bj * 1024 + tile * 128 + j, W1T + (size_t)le * 2048 * 1024, 1024, p, scr, lane); }
        const float* ew2 = (const float*)a.in[I_EW2]; unsigned char* W2T = WSP(unsigned char, WS_W2T);
        for (int it = gw; it < 2 * 32 * 16 * 32; it += NGW) { const int le = it >> 9, kb = (it >> 5) & 15, nb = it & 31;
            if (le < 32) tr_item8<false>(ew2 + (size_t)le * 1024 * 1024, 1024, kb * 64, nb * 32, W2T + (size_t)le * 1024 * 1024, 1024, nb * 32, scr, lane);
            else tr_item8<true>(ew2 + (size_t)le * 1024 * 1024, 1024, kb * 64, nb * 32, W2T + (size_t)le * 1024 * 1024, 1024, nb * 32, scr, lane); }
    }
    {
        const int gt = (F.vcu * NWAVES + F.wave) * 64 + lane, NGT = NGW * 64;
        const float* sgw = (const float*)a.in[I_SGW]; bf16_t* SGW = WSP(bf16_t, WS_SGW);
        for (int i = gt; i < 2 * 8 * 128 * 128; i += NGT) { const int s = i & 127, t = (i >> 7) & 127; SGW[i] = (bf16_t)(cvtpk(s <= t ? sgw[i] : 0.f, 0.f) & 0xffffu); }
        const int* pos = (const int*)a.in[I_POS]; float* rope = WSP(float, WS_ROPE);
        for (int i = gt; i < T * 32; i += NGT) { const int tok = i >> 5, d = i & 31;
            const double inv = exp2(-(double)d * (13.287712379549449 / 32.0));
            const double rv = (double)pos[tok] * inv * 0.15915494309189535; const float fr = (float)(rv - __builtin_rint(rv));
            rope[2 * i] = __builtin_amdgcn_cosf(fr); rope[2 * i + 1] = __builtin_amdgcn_sinf(fr); }
        bf16_t* H = WSP(bf16_t, WS_H);
        for (int i = gt; i < 1024; i += NGT) { H[(size_t)T * 1024 + i] = 0; WSP(unsigned char, WS_H8)[(size_t)T * 1024 + i] = 0; }
        bf16_t* KCMP = WSP(bf16_t, WS_KCMP); bf16_t* VCT = WSP(bf16_t, WS_VCT);
        for (int i = gt; i < 2 * 2 * 64; i += NGT) { const int b = i >> 7, g = (i >> 6) & 1, d = i & 63; KCMP[(size_t)(b * 2 + g) * 512 * 64 + kfrag_off(511, d >> 3) + (d & 7)] = 0; VCT[(size_t)(b * 2 + g) * 512 * 64 + vfrag_off(511, d)] = 0; }
    }
    {
        float* cb = WSP(float, WS_MISC);
        for (int it = gw; it < 2 * 2 * 64; it += NGW) { const int l = it >> 7, which = (it >> 6) & 1, n = it & 63;
            const float* pe = (const float*)a.in[which ? I_PEV : I_PEK] + (size_t)l * 2048; const float* w1 = (const float*)a.in[which ? I_CW1V : I_CW1K] + (size_t)l * 2048 * 64;
            float s = 0.f; for (int k = lane; k < 2048; k += 64) s += pe[k] * w1[(size_t)k * 64 + n];
            s = wave_sum(s); if (lane == 0) cb[it] = s; }
    }
}

struct RowV { f32x4 v[4]; };
__device__ __forceinline__ RowV row_load(const float* p, int lane) { RowV r; const f32x4* q = (const f32x4*)p + lane;
#pragma unroll
    for (int j = 0; j < 4; ++j) r.v[j] = q[64 * j]; return r; }
__device__ __forceinline__ float row_ssq(const RowV& r) { float s = 0.f;
#pragma unroll
    for (int j = 0; j < 4; ++j) s += (r.v[j].x * r.v[j].x + r.v[j].y * r.v[j].y) + (r.v[j].z * r.v[j].z + r.v[j].w * r.v[j].w); return wave_sum(s); }
__device__ __forceinline__ void row_norm_store(const RowV& x, float rstd, const float* g, const float* sc, const float* sh, bf16_t* orow, int lane) {
    u32x2* o8 = (u32x2*)orow + lane;
#pragma unroll
    for (int j = 0; j < 4; ++j) { const f32x4 gg = ((const f32x4*)g)[lane + 64 * j], ss = ((const f32x4*)sc)[lane + 64 * j], hh = ((const f32x4*)sh)[lane + 64 * j];
        const f32x4 y = x.v[j] * rstd * gg * (ss + 1.f) + hh; u32x2 w; w.x = cvtpk(y.x, y.y); w.y = cvtpk(y.z, y.w); o8[64 * j] = w; }
}
__device__ __forceinline__ void row_norm_store8(const RowV& x, float rstd, const float* g, const float* sc, const float* sh, unsigned char* orow, int lane) {
    unsigned* o4 = (unsigned*)orow + lane;
#pragma unroll
    for (int j = 0; j < 4; ++j) { const f32x4 gg = ((const f32x4*)g)[lane + 64 * j], ss = ((const f32x4*)sc)[lane + 64 * j], hh = ((const f32x4*)sh)[lane + 64 * j];
        const f32x4 y = x.v[j] * rstd * gg * (ss + 1.f) + hh; o4[64 * j] = cvt4_fp8(y.x, y.y, y.z, y.w); }
}
__device__ __forceinline__ int expert_block_prefix(const unsigned* cnt, int lane) {
    int nb = (lane < NE) ? (int)((cnt[lane] + 255u) >> 8) : 0; int inc = nb;
#pragma unroll
    for (int o = 1; o < 32; o <<= 1) { const int t = __shfl_up(inc, o); if ((lane & 31) >= o) inc += t; }
    return inc - nb;
}
__device__ __forceinline__ void phase_n1_first(Frame& F, const Args& a) {
    const int gw = F.vcu * NWAVES + F.wave, NGW = F.G * NWAVES; const int lane = F.lane;
    const float* x = (const float*)a.in[I_X]; const float* g = (const float*)a.in[I_N1G]; bf16_t* H = WSP(bf16_t, WS_H);
    for (int m = gw; m < T; m += 2 * NGW) { const int m2 = m + NGW; const int b = m >> 13, b2 = m2 >> 13;
        const RowV r = row_load(x + (size_t)m * DM, lane); const RowV r2 = row_load(x + (size_t)m2 * DM, lane);
        const float rstd = 1.f / sqrtf(row_ssq(r) * (1.f / DM) + NORM_EPS), rstd2 = 1.f / sqrtf(row_ssq(r2) * (1.f / DM) + NORM_EPS);
        row_norm_store(r, rstd, g, MODP(0, b, 1), MODP(0, b, 0), H + (size_t)m * DM, lane);
        row_norm_store(r2, rstd2, g, MODP(0, b2, 1), MODP(0, b2, 0), H + (size_t)m2 * DM, lane); }
    float* RWP = WSP(float, WS_RWP); float* RBP = WSP(float, WS_MISC + 4096);
    const float* rw = (const float*)a.in[I_RW]; const float* rb = (const float*)a.in[I_RB]; const float* n2g = (const float*)a.in[I_N2G];
    const int gt = gw * 64 + lane, NGT = NGW * 64;
    for (int i = gt; i < 2 * 2 * 1024 * 32; i += NGT) { const int l = i >> 16, b = (i >> 15) & 1, k = (i >> 5) & 1023, e = i & 31;
        RWP[i] = n2g[l * 1024 + k] * (1.f + MODP(l, b, 4)[k]) * rw[((size_t)l * 1024 + k) * 32 + e]; }
    for (int it = gw; it < 2 * 2 * 32; it += NGW) { const int l = it >> 6, b = (it >> 5) & 1, e = it & 31; float s = 0.f;
        for (int k = lane; k < 1024; k += 64) s += MODP(l, b, 3)[k] * rw[((size_t)l * 1024 + k) * 32 + e];
        s = wave_sum(s); if (lane == 0) RBP[it] = s + rb[l * 32 + e]; }
}
__device__ __forceinline__ void phase_combine(Frame& F, const Args& a, int l) {
    const int gw = F.vcu * NWAVES + F.wave, NGW = F.G * NWAVES; const int lane = F.lane;
    float* XR = WSP(float, WS_XR); bf16_t* H = WSP(bf16_t, WS_H); const bf16_t* YR = WSP(bf16_t, WS_YROWS);
    const int* ASG = WSP(int, WS_ASG); const float* G4 = WSP(float, WS_GATE4);
    const int myprefix = expert_block_prefix(F.ctl + CW_CNT + l * 32, lane);
    const bool last = (l == DEPTH - 1);
    const float* g = last ? (const float*)a.in[I_FING] : (const float*)a.in[I_N1G] + (l + 1) * 1024;
#define COMB_LOAD(R_, WV_, GT_, M_) do { const int4 as4_ = *(const int4*)(ASG + (M_) * 4); const f32x4 gt4_ = *(const f32x4*)(G4 + (M_) * 4); \
        R_ = row_load(XR + (size_t)(M_) * DM, lane); const int asv_[4] = {as4_.x, as4_.y, as4_.z, as4_.w}; GT_[0] = gt4_.x; GT_[1] = gt4_.y; GT_[2] = gt4_.z; GT_[3] = gt4_.w; \
        _Pragma("unroll") for (int k = 0; k < 4; ++k) { const int e = asv_[k] >> 16, slot = asv_[k] & 0xffff; const int blk = __shfl(myprefix, e); \
            const u32x2* yr = (const u32x2*)(YR + ((size_t)blk * 256 + slot) * DM) + lane; _Pragma("unroll") for (int j = 0; j < 4; ++j) WV_[k][j] = __builtin_nontemporal_load(yr + 64 * j); } } while (0)
#define COMB_FINISH(R_, WV_, GT_, M_) do { const int b = (M_) >> 13; f32x4 y[4]; \
        _Pragma("unroll") for (int j = 0; j < 4; ++j) y[j] = (f32x4){0.f, 0.f, 0.f, 0.f}; \
        _Pragma("unroll") for (int k = 0; k < 4; ++k) _Pragma("unroll") for (int j = 0; j < 4; ++j) { const u32x2 w = WV_[k][j]; y[j] += (f32x4){bflo(w.x), bfhi(w.x), bflo(w.y), bfhi(w.y)} * GT_[k]; } \
        const float* g2 = MODP(l, b, 5); \
        _Pragma("unroll") for (int j = 0; j < 4; ++j) R_.v[j] += ((const f32x4*)g2)[lane + 64 * j] * y[j]; \
        const float rstd = 1.f / sqrtf(row_ssq(R_) * (1.f / DM) + NORM_EPS); \
        if (last) { f32x4* o = (f32x4*)(a.out + (size_t)(M_) * DM) + lane; _Pragma("unroll") for (int j = 0; j < 4; ++j) o[64 * j] = R_.v[j] * rstd * ((const f32x4*)g)[lane + 64 * j]; } \
        else { f32x4* xo = (f32x4*)(XR + (size_t)(M_) * DM) + lane; _Pragma("unroll") for (int j = 0; j < 4; ++j) xo[64 * j] = R_.v[j]; \
            row_norm_store(R_, rstd, g, MODP(l + 1, b, 1), MODP(l + 1, b, 0), H + (size_t)(M_) * DM, lane); } } while (0)
    for (int m = gw; m < T; m += 2 * NGW) { const int m2 = m + NGW;
        RowV rA, rB; u32x2 wA[4][4], wB[4][4]; float gA[4], gB[4];
        COMB_LOAD(rA, wA, gA, m); COMB_LOAD(rB, wB, gB, m2);
        COMB_FINISH(rA, wA, gA, m); COMB_FINISH(rB, wB, gB, m2);
    }
#undef COMB_LOAD
#undef COMB_FINISH
}
__device__ __forceinline__ void compress_item(Frame& F, const Args& a, int l, int item) {
    const int which = item >> 7, b = (item >> 6) & 1, g = (item >> 5) & 1, n0 = (item & 31) * 16;
    const int lane = F.lane, w = F.wave, r16 = lane & 15, kg = lane >> 4;
    const bf16_t* src = WSP(bf16_t, which ? WS_VC : WS_KC);
    const bf16_t* W1 = WSP(bf16_t, WS_CW1) + (size_t)(l * 2 + which) * 64 * 2048;
    LAS float* red = (LAS float*)F.lds;
    LAS float* hid = (LAS float*)(F.lds + 32768);
    f32x4 acc[4];
#pragma unroll
    for (int i = 0; i < 4; ++i) acc[i] = (f32x4){0.f, 0.f, 0.f, 0.f};
    const int n = n0 + r16; const bool nval = n < NCMP;
#pragma unroll 2
    for (int ks = 0; ks < 8; ++ks) { const int k = 256 * w + 32 * ks + 8 * kg; const int li = k >> 6, d = k & 63;
        bf16x8 af = (bf16x8){0, 0, 0, 0, 0, 0, 0, 0};
        if (nval) af = *(const bf16x8*)(src + ((size_t)b * SEQ + 16 * n + li) * 128 + g * 64 + d);
#pragma unroll
        for (int nt = 0; nt < 4; ++nt) { const bf16x8 bf = *(const bf16x8*)(W1 + (size_t)(nt * 16 + r16) * 2048 + k); acc[nt] = __builtin_amdgcn_mfma_f32_16x16x32_bf16(af, bf, acc[nt], 0, 0, 0); } }
#pragma unroll
    for (int nt = 0; nt < 4; ++nt)
#pragma unroll
        for (int i = 0; i < 4; ++i) red[(w * 16 + 4 * kg + i) * 64 + nt * 16 + r16] = acc[nt][i];
    __syncthreads();
    const float* cb = WSP(float, WS_MISC) + (l * 2 + which) * 64;
    for (int i = F.tid; i < 1024; i += NTHREADS) { float s = cb[i & 63];
#pragma unroll
        for (int ww = 0; ww < 8; ++ww) s += red[ww * 1024 + i];
        hid[i] = gelu_tanh(s); }
    { const float* w2 = (const float*)a.in[which ? I_CW2V : I_CW2K] + (size_t)l * 4096; LAS f32x4* w2s4 = (LAS f32x4*)(F.lds + 40960);
      for (int i = F.tid; i < 1024; i += NTHREADS) w2s4[i] = ((const f32x4*)w2)[i]; }
    __syncthreads();
    {
        const int nn = F.tid >> 5, c = F.tid & 31; LAS float* w2s = (LAS float*)(F.lds + 40960);
        float o1 = 0.f, o2 = 0.f;
#pragma unroll 16
        for (int k = 0; k < 64; ++k) { const float h = hid[nn * 64 + k]; o1 += h * w2s[k * 64 + c]; o2 += h * w2s[k * 64 + c + 32]; }
        const int np = n0 + nn; float nsq_ = 0.f;
        if (np < NCMP) {
            if (!which) { const float* cs = WSP(float, WS_ROPE) + (((size_t)b * SEQ + 16 * np + 31) * 32 + c) * 2; const float cc = cs[0], ss = cs[1];
                const float r1 = o1 * cc - o2 * ss, r2 = o2 * cc + o1 * ss;
                bf16_t* img = WSP(bf16_t, WS_KCMP) + (size_t)(b * 2 + g) * 512 * 64; img[kfrag_off(np, c >> 3) + (c & 7)] = (bf16_t)(cvtpk(r1, 0.f) & 0xffffu); img[kfrag_off(np, 4 + (c >> 3)) + (c & 7)] = (bf16_t)(cvtpk(r2, 0.f) & 0xffffu);
                nsq_ = r1 * r1 + r2 * r2;
            } else { bf16_t* img = WSP(bf16_t, WS_VCT) + (size_t)(b * 2 + g) * 512 * 64; img[vfrag_off(np, c)] = (bf16_t)(cvtpk(o1, 0.f) & 0xffffu); img[vfrag_off(np, c + 32)] = (bf16_t)(cvtpk(o2, 0.f) & 0xffffu); }
        }
        if (!which) {
            float mx = quad_sum(nsq_);
            mx += __uint_as_float(__builtin_amdgcn_update_dpp(0u, __float_as_uint(mx), 0x141, 0xF, 0xF, true)); mx += __uint_as_float(__builtin_amdgcn_update_dpp(0u, __float_as_uint(mx), 0x140, 0xF, 0xF, true));
            mx = x16_sum(mx);
            mx = x32_max(mx);
            if (F.lane == 0) atomicMax(F.ctl + CW_KMAX + l * 16 + 12 + b * 2 + g, __float_as_uint(mx * 1.02f));
        }
    }
    __syncthreads();
}
__device__ __forceinline__ void sgu_item(Frame& F, const Args& a, int l, int ch) {
    const size_t tok0 = (size_t)ch * 128;
    const int lane = F.lane, w = F.wave, r16 = lane & 15, kg = lane >> 4;
    const bf16_t* VG = WSP(bf16_t, WS_VG); const bf16_t* UG = WSP(bf16_t, WS_UG); bf16_t* Y = WSP(bf16_t, WS_Y);
    LAS float* stats = (LAS float*)F.lds;
    LAS bf16_t* vnT = (LAS bf16_t*)(F.lds + 1024);
    constexpr int VP = 136;
    static_assert(1024 + 8 * 64 * 136 * 2 <= ATT_LDS_BYTES, "SGU LDS map");
    {
        u32x4 vrow[16];
#pragma unroll
        for (int tt = 0; tt < 16; ++tt) vrow[tt] = *(const u32x4*)(VG + (tok0 + 16 * w + tt) * 512 + lane * 8);
#pragma unroll
        for (int tt = 0; tt < 16; ++tt) { const int s = 16 * w + tt; const u32x4 v = vrow[tt];
            const float f[8] = {bflo(v.x), bfhi(v.x), bflo(v.y), bfhi(v.y), bflo(v.z), bfhi(v.z), bflo(v.w), bfhi(v.w)};
            float sm = 0.f;
#pragma unroll
            for (int i = 0; i < 8; ++i) sm += f[i];
            const float mu = wave_sum(sm) * (1.f / 512.f); float q = 0.f;
#pragma unroll
            for (int i = 0; i < 8; ++i) q += (f[i] - mu) * (f[i] - mu);
            const float var = wave_sum(q) * (1.f / 512.f);
            if (lane == 0) { stats[2 * s] = mu; stats[2 * s + 1] = 1.f / sqrtf(var + NORM_EPS); } }
    }
    __syncthreads();
    {
        const int s = F.tid & 127, hq = F.tid >> 7; const float mu = stats[2 * s], rs = stats[2 * s + 1];
#pragma unroll
        for (int hp = 0; hp < 2; ++hp) { const int h = hq + 4 * hp; const int cbase = h * 64;
            const float* lg = (const float*)a.in[I_SGLNG] + l * 512 + cbase; const float* lb = (const float*)a.in[I_SGLNB] + l * 512 + cbase;
#pragma unroll 2
            for (int d0 = 0; d0 < 64; d0 += 8) { const u32x4 v = *(const u32x4*)(VG + (tok0 + s) * 512 + cbase + d0);
                const float f[8] = {bflo(v.x), bfhi(v.x), bflo(v.y), bfhi(v.y), bflo(v.z), bfhi(v.z), bflo(v.w), bfhi(v.w)};
#pragma unroll
                for (int i = 0; i < 8; ++i) vnT[(h * 64 + d0 + i) * VP + s] = (bf16_t)(cvtpk((f[i] - mu) * rs * lg[d0 + i] + lb[d0 + i], 0.f) & 0xffffu); } }
    }
    __syncthreads();
    {
        const int h = w;
        const bf16_t* Wm = WSP(bf16_t, WS_SGW) + (size_t)(l * 8 + h) * 128 * 128; const float* bs = (const float*)a.in[I_SGB] + (size_t)(l * 8 + h) * 128;
#pragma nounroll
        for (int tt = 0; tt < 8; ++tt) {
            const int t = 16 * tt + r16; const float bb = bs[t];
            bf16x8 bw[4]; u32x2 ugv[4];
#pragma unroll
            for (int ks = 0; ks < 4; ++ks) bw[ks] = *(const bf16x8*)(Wm + (size_t)t * 128 + 32 * ks + 8 * kg);
#pragma unroll
            for (int dt = 0; dt < 4; ++dt) ugv[dt] = *(const u32x2*)(UG + (tok0 + t) * 512 + h * 64 + dt * 16 + 4 * kg);
            f32x4 acc[4];
#pragma unroll
            for (int i = 0; i < 4; ++i) acc[i] = (f32x4){0.f, 0.f, 0.f, 0.f};
            const int nks = (16 * tt + 15) / 32 + 1;
#pragma unroll
            for (int ks = 0; ks < 4; ++ks) { if (ks < nks) {
#pragma unroll
                for (int dt = 0; dt < 4; ++dt) { const bf16x8 afr = *(const LAS bf16x8*)(vnT + (h * 64 + dt * 16 + r16) * VP + 32 * ks + 8 * kg); acc[dt] = __builtin_amdgcn_mfma_f32_16x16x32_bf16(afr, bw[ks], acc[dt], 0, 0, 0); } } }
#pragma unroll
            for (int dt = 0; dt < 4; ++dt) { const u32x2 uu = ugv[dt];
                u32x2 o; o.x = cvtpk(bflo(uu.x) * (acc[dt][0] + bb), bfhi(uu.x) * (acc[dt][1] + bb)); o.y = cvtpk(bflo(uu.y) * (acc[dt][2] + bb), bfhi(uu.y) * (acc[dt][3] + bb));
                *(u32x2*)(Y + (tok0 + t) * 1024 + h * 64 + dt * 16 + 4 * kg) = o; }
        }
    }
    __syncthreads();
}
namespace att {
constexpr int OSP = 65;
constexpr int L_OH = 0;
constexpr int L_OL = 66560;
constexpr int L_LS = 133120;
constexpr int L_MREF = L_LS + 2048;
constexpr int USP = 129;
constexpr int L_SEL = L_MREF + 1024;
constexpr int L_CNT = L_SEL + 1024;
constexpr int L_LIST = L_CNT + 512;
constexpr int L_WCTR = L_LIST + 8192;
static_assert(L_WCTR + 16 <= ATT_LDS_BYTES, "attention LDS map");

struct Ptrs { const bf16_t *Q, *KS, *KW, *VST, *VWT, *KCMP, *VCT; const float* GATES; bf16_t* Y; float* YPART; float kmax, vmax, kwmax, kcmax; };

#define MFMA16(a, b, c) __builtin_amdgcn_mfma_f32_16x16x32_bf16(a, b, c, 0, 0, 0)

__device__ __forceinline__ void attn_unit(Frame& F, const Ptrs& P, int b, int g, int qb) {
    LAS unsigned char* lds = F.lds;
    const int tid = F.tid, lane = F.lane, w = F.wave, r16 = lane & 15, kg = lane >> 4;
    LAS int* Oh = (LAS int*)(lds + L_OH); LAS int* Ol = (LAS int*)(lds + L_OL); LAS float* imp = (LAS float*)(lds + L_OH);
    LAS int* lsel = (LAS int*)(lds + L_LS); LAS float* mref = (LAS float*)(lds + L_MREF);
    LAS unsigned* selm = (LAS unsigned*)(lds + L_SEL); LAS int* cnts = (LAS int*)(lds + L_CNT); LAS unsigned char* lists = lds + L_LIST; LAS int* wctr = (LAS int*)(lds + L_WCTR);
    const size_t tokb = (size_t)b * SEQ; const int t0 = qb * 64;
    const bf16_t* Qg = P.Q + (tokb + t0) * 512 + g * 256;
    LAS float* U = (LAS float*)(lds + L_OH); LAS float* linvc = (LAS float*)(lds + L_LS);
    {
        const int q = tid >> 3, part = tid & 7, hd = part >> 1, hf = part & 1;
        const u32x4* src = (const u32x4*)(Qg + (size_t)q * 512 + part * 32);
        float ss = 0.f;
#pragma unroll
        for (int i = 0; i < 4; ++i) { const u32x4 v = src[i]; const float f[8] = {bflo(v.x), bfhi(v.x), bflo(v.y), bfhi(v.y), bflo(v.z), bfhi(v.z), bflo(v.w), bfhi(v.w)};
#pragma unroll
            for (int k = 0; k < 8; ++k) ss += f[k] * f[k]; }
        ss += __uint_as_float(__builtin_amdgcn_update_dpp(0u, __float_as_uint(ss), 0xB1, 0xF, 0xF, true));
        if (hf == 0) mref[q * 4 + hd] = sqrtf(ss);
        for (int i = tid; i < 256 * USP; i += NTHREADS) U[i] = 0.f;
    }
    __syncthreads();
    const int hl = r16 & 3;
#define ATT_LDK(dst, base, key0) do { const char* kb_ = (const char*)(base) + (size_t)(key0) * 128; _Pragma("unroll") for (int u_ = 0; u_ < 2; ++u_) _Pragma("unroll") for (int ks_ = 0; ks_ < 2; ++ks_) \
        dst[u_][ks_] = *(const bf16x8*)(kb_ + koff + (u_ * 2 + ks_) * 1024); } while (0)
#define ATT_LDV(dst, vbase, LEN, key0) do { const char* vb_ = (const char*)(vbase) + (size_t)(key0) * 128; _Pragma("unroll") for (int dt_ = 0; dt_ < 4; ++dt_) \
        dst[dt_] = *(const bf16x8*)(vb_ + koff + dt_ * 1024); } while (0)
#define ATT_SHADOW() int ln_ = F.lane; asm volatile("" : "+v"(ln_)); const int r16 = ln_ & 15, kg = ln_ >> 4, hl = r16 & 3; const unsigned koff = (unsigned)ln_ * 16u
    {
        ATT_SHADOW();
        bf16x8 qf[2][2]; float mrc[2], lpart[2], carry[2] = {0.f, 0.f}; int nlim[2]; f32x4 o[2][4];
#pragma unroll
        for (int rt = 0; rt < 2; ++rt) { const int q = 8 * w + 4 * rt + (r16 >> 2);
#pragma unroll
            for (int ks = 0; ks < 2; ++ks) qf[rt][ks] = *(const bf16x8*)(Qg + (size_t)q * 512 + hl * 64 + ks * 32 + kg * 8);
            mrc[rt] = mref[q * 4 + hl] * P.kcmax; lpart[rt] = 0.f; nlim[rt] = (t0 + q - 31) >> 4;
#pragma unroll
            for (int dt = 0; dt < 4; ++dt) o[rt][dt] = (f32x4){0.f, 0.f, 0.f, 0.f}; }
        const int nkeys = 4 * qb + 3, NP = (nkeys + 31) >> 5;
        const int nlim_min = (t0 + 8 * w - 31) >> 4;
        const bf16_t* Kc = P.KCMP + (size_t)(b * 2 + g) * 512 * 64; const bf16_t* Vc = P.VCT + (size_t)(b * 2 + g) * 64 * 512;
#define ATT_S1_STEP(KF, VF, s_) do { _Pragma("unroll") for (int rt = 0; rt < 2; ++rt) { \
            f32x4 st[2]; float p[2][4]; \
            _Pragma("unroll") for (int u = 0; u < 2; ++u) { st[u] = MFMA16(KF[u][0], qf[rt][0], ((f32x4){0.f, 0.f, 0.f, 0.f})); st[u] = MFMA16(KF[u][1], qf[rt][1], st[u]); } \
            _Pragma("unroll") for (int u = 0; u < 2; ++u) _Pragma("unroll") for (int i = 0; i < 4; ++i) p[u][i] = fast_exp2(st[u][i] - mrc[rt]); \
            if (32 * (s_) + 31 > nlim_min) { _Pragma("unroll") for (int u = 0; u < 2; ++u) _Pragma("unroll") for (int i = 0; i < 4; ++i) { const int n = 32 * (s_) + 8 * kg + 4 * u + i; if (n > nlim[rt]) p[u][i] = 0.f; } } \
            const float s01 = (p[0][0] + p[0][1]) + (p[0][2] + p[0][3]), s11 = (p[1][0] + p[1][1]) + (p[1][2] + p[1][3]); lpart[rt] += s01 + s11; \
            {   \
                \
              const unsigned x_ = __float_as_uint(p[1][3]); const auto s16_ = __builtin_amdgcn_permlane16_swap(x_, x_, false, false); const auto s32_ = __builtin_amdgcn_permlane32_swap(s16_[1], s16_[1], false, false); \
              const float inc_ = (kg & 1) ? __uint_as_float(s16_[0]) : ((kg == 2) ? __uint_as_float(s32_[0]) : carry[rt]); carry[rt] = __uint_as_float(s32_[1]); \
              LAS float* ur = U + ((8 * w + 4 * rt + (r16 >> 2)) * 4 + hl) * USP + 8 * (s_) + 2 * kg; \
              ur[0] += (2.f * s01 - p[0][3]) + inc_; ur[1] += (2.f * s11 - p[1][3]) + p[0][3]; } \
            u32x4 pw; pw.x = cvtpk(p[0][0], p[0][1]); pw.y = cvtpk(p[0][2], p[0][3]); pw.z = cvtpk(p[1][0], p[1][1]); pw.w = cvtpk(p[1][2], p[1][3]); \
            const bf16x8 pf = __builtin_bit_cast(bf16x8, pw); \
            _Pragma("unroll") for (int dt = 0; dt < 4; ++dt) o[rt][dt] = MFMA16(VF[dt], pf, o[rt][dt]); } } while (0)
        {
            bf16x8 kA[2][2], vA[4], kB[2][2], vB[4];
            ATT_LDK(kA, Kc, 0); ATT_LDV(vA, Vc, 512, 0); if (NP > 1) { ATT_LDK(kB, Kc, 32); ATT_LDV(vB, Vc, 512, 32); }
#pragma nounroll
            for (int s2 = 0; s2 < NP; s2 += 2) {
                ATT_S1_STEP(kA, vA, s2);
                if (s2 + 2 < NP) { ATT_LDK(kA, Kc, 32 * (s2 + 2)); ATT_LDV(vA, Vc, 512, 32 * (s2 + 2)); }
                if (s2 + 1 < NP) { ATT_S1_STEP(kB, vB, s2 + 1);
                    if (s2 + 3 < NP) { ATT_LDK(kB, Kc, 32 * (s2 + 3)); ATT_LDV(vB, Vc, 512, 32 * (s2 + 3)); } }
            }
        }
#undef ATT_S1_STEP
#pragma unroll
        for (int rt = 0; rt < 2; ++rt) { const int q = 8 * w + 4 * rt + (r16 >> 2); const float lrow = kg_sum(lpart[rt]); const float linv = lrow > 0.f ? 1.f / lrow : 0.f;
            if (kg == 0) linvc[q * 4 + hl] = linv;
            const float gc = P.GATES[(tokb + t0 + q) * 24 + (g * 4 + hl) * 3 + 0] * linv;
            float* yp = P.YPART + (tokb + t0 + q) * 512 + (g * 4 + hl) * 64 + 4 * kg;
#pragma unroll
            for (int dt = 0; dt < 4; ++dt) *(f32x4*)(yp + dt * 16) = o[rt][dt] * gc; }
    }
    LDS_WAIT();
#pragma nounroll
    for (int qg = 0; qg < 2; ++qg) {
        if (qb <= 15) {
            if (lane < 4) { const int q = 8 * w + 4 * qg + lane; const unsigned long long m0 = (1ull << (qb + 1)) - 1ull;
                selm[q * 4 + 0] = (unsigned)m0; selm[q * 4 + 1] = (unsigned)(m0 >> 32); selm[q * 4 + 2] = 0u; selm[q * 4 + 3] = 0u; }
        } else {
            const int j0 = lane, j1 = lane + 64; int v0[4], v1[4], thr[4];
#pragma unroll
            for (int k = 0; k < 4; ++k) { const int q = 8 * w + 4 * qg + k; const LAS float* ur = U + (q * 4) * USP; const LAS float* li = linvc + q * 4;
                float i0 = 0.f, i1 = 0.f;
#pragma unroll
                for (int h = 0; h < 4; ++h) { i0 += ur[h * USP + j0] * li[h]; i1 += ur[h * USP + j1] * li[h]; }
                v0[k] = (j0 >= 1 && j0 <= qb - 2) ? (int)__float_as_uint(i0) : -1;
                v1[k] = (j1 <= qb - 2) ? (int)__float_as_uint(i1) : -1; thr[k] = 0; }
#pragma nounroll
            for (int bit = 30; bit >= 0; --bit) {
#pragma unroll
                for (int k = 0; k < 4; ++k) { const int cand = thr[k] | (1 << bit);
                    const int c = __popcll(__ballot(v0[k] >= cand)) + __popcll(__ballot(v1[k] >= cand)); if (c >= 13) thr[k] = cand; } }
            const unsigned long long below = (1ull << lane) - 1ull;
#pragma nounroll
            for (int k = 0; k < 4; ++k) {
                const int vv0 = (k == 0) ? v0[0] : (k == 1) ? v0[1] : (k == 2) ? v0[2] : v0[3], vv1 = (k == 0) ? v1[0] : (k == 1) ? v1[1] : (k == 2) ? v1[2] : v1[3];
                const int th = (k == 0) ? thr[0] : (k == 1) ? thr[1] : (k == 2) ? thr[2] : thr[3];
                const bool gt0 = vv0 > th, gt1 = vv1 > th, eq0 = vv0 == th, eq1 = vv1 == th;
                const int need = 13 - (__popcll(__ballot(gt0)) + __popcll(__ballot(gt1)));
                const unsigned long long B0 = __ballot(eq0), B1 = __ballot(eq1);
                const int rk0 = __popcll(B0 & below), rk1 = __popcll(B0) + __popcll(B1 & below);
                unsigned long long m0 = __ballot(gt0 || (eq0 && rk0 < need)), m1 = __ballot(gt1 || (eq1 && rk1 < need));
                m0 |= 1ull;
                if (qb < 64) m0 |= (1ull << qb); else m1 |= (1ull << (qb - 64));
                if (qb - 1 < 64) m0 |= (1ull << (qb - 1)); else m1 |= (1ull << (qb - 65));
                if (lane == 0) { const int q = 8 * w + 4 * qg + k; selm[q * 4 + 0] = (unsigned)m0; selm[q * 4 + 1] = (unsigned)(m0 >> 32); selm[q * 4 + 2] = (unsigned)m1; selm[q * 4 + 3] = (unsigned)(m1 >> 32); } }
        }
    }
    __syncthreads();
    for (int i = tid; i < 2 * 256 * OSP; i += NTHREADS) Oh[i] = 0;
    lsel[tid] = 0;
    if (tid == 0) wctr[0] = 0;
    if (tid < 128) { const int j = tid; int c = 0;
        if (j <= qb) for (int q = 0; q < 64; ++q) { if ((selm[q * 4 + (j >> 5)] >> (j & 31)) & 1u) { lists[j * 64 + c] = (unsigned char)q; ++c; } }
        cnts[j] = c; }
    __syncthreads();
    for (int rep5 = 0; rep5 < ((ATTREP & 8) ? NREP : 1); ++rep5)
    {
        if (rep5 > 0) { __syncthreads(); if (tid == 0) wctr[0] = 0; __syncthreads(); }
        ATT_SHADOW();
        const bf16_t* Ks = P.KS + (size_t)(b * 2 + g) * SEQ * 64; const bf16_t* Vs = P.VST + (size_t)(b * 2 + g) * 64 * SEQ;
        const float S1 = 1048576.f / fmaxf(P.vmax, 1e-30f);
#define ATT_FETCH(idx_) do { int i_ = 0; if (lane == 0) i_ = __hip_atomic_fetch_add(wctr, 1, __ATOMIC_RELAXED, __HIP_MEMORY_SCOPE_WORKGROUP); idx_ = __builtin_amdgcn_readfirstlane(i_); } while (0)
#define ATT_JOF(idx_) (((idx_) == 0) ? 0 : (((idx_) == 1) ? qb : (((idx_) == 2) ? qb - 1 : (idx_) - 2)))
        bf16x8 kn[2][2][2], vn[2][4];
        int idx; ATT_FETCH(idx);
        if (idx <= qb) { const int j = ATT_JOF(idx); ATT_LDK(kn[0], Ks, 64 * j); ATT_LDK(kn[1], Ks, 64 * j + 32); ATT_LDV(vn[0], Vs, SEQ, 64 * j); ATT_LDV(vn[1], Vs, SEQ, 64 * j + 32); }
#pragma nounroll
        while (idx <= qb) {
            const int j = ATT_JOF(idx);
            bf16x8 kf[2][2][2], vf[2][4];
#pragma unroll
            for (int sp = 0; sp < 2; ++sp) {
#pragma unroll
                for (int u = 0; u < 2; ++u) { kf[sp][u][0] = kn[sp][u][0]; kf[sp][u][1] = kn[sp][u][1]; }
#pragma unroll
                for (int dt = 0; dt < 4; ++dt) vf[sp][dt] = vn[sp][dt]; }
            int idx2; ATT_FETCH(idx2);
            if (idx2 <= qb) { const int j2 = ATT_JOF(idx2); ATT_LDK(kn[0], Ks, 64 * j2); ATT_LDK(kn[1], Ks, 64 * j2 + 32); ATT_LDV(vn[0], Vs, SEQ, 64 * j2); ATT_LDV(vn[1], Vs, SEQ, 64 * j2 + 32); }
            const int cnt = cnts[j];
            const int nch = (cnt + 3) >> 2;
            bf16x8 qn0, qn1; int qnx; bool vnx;
            { const int qs = (r16 >> 2); vnx = qs < cnt; qnx = lists[j * 64 + (vnx ? qs : (cnt > 0 ? cnt - 1 : 0))];
              const bf16_t* qp = Qg + (size_t)qnx * 512 + hl * 64 + kg * 8; qn0 = *(const bf16x8*)qp; qn1 = *(const bf16x8*)(qp + 32); }
#pragma nounroll
            for (int c = 0; c < nch; ++c) {
                const bool valid = vnx; const int q = qnx; const int row = q * 4 + hl; const bf16x8 q0 = qn0, q1 = qn1;
                if (c + 1 < nch) { const int qs = 4 * (c + 1) + (r16 >> 2); vnx = qs < cnt; qnx = lists[j * 64 + (vnx ? qs : cnt - 1)];
                    const bf16_t* qp = Qg + (size_t)qnx * 512 + hl * 64 + kg * 8; qn0 = *(const bf16x8*)qp; qn1 = *(const bf16x8*)(qp + 32); }
                const float mr = mref[row] * P.kmax;
                f32x4 o[4];
                float ps = 0.f;
                const bool slow = (j == qb) || (4 * c + 4 > cnt);
#define ATT_CHUNK(MASKED) \
                _Pragma("unroll") for (int sp = 0; sp < 2; ++sp) { \
                    f32x4 st[2]; float p[2][4]; \
                    _Pragma("unroll") for (int u = 0; u < 2; ++u) { st[u] = MFMA16(kf[sp][u][0], q0, ((f32x4){0.f, 0.f, 0.f, 0.f})); st[u] = MFMA16(kf[sp][u][1], q1, st[u]); } \
                    _Pragma("unroll") for (int u = 0; u < 2; ++u) _Pragma("unroll") for (int i = 0; i < 4; ++i) { float e = fast_exp2(st[u][i] - mr); \
                        if (MASKED) { const int kk = 32 * sp + 8 * kg + 4 * u + i; if (!valid || (j == qb && kk > q)) e = 0.f; } p[u][i] = e; ps += e; } \
                    u32x4 pw; pw.x = cvtpk(p[0][0], p[0][1]); pw.y = cvtpk(p[0][2], p[0][3]); pw.z = cvtpk(p[1][0], p[1][1]); pw.w = cvtpk(p[1][2], p[1][3]); \
                    const bf16x8 pf = __builtin_bit_cast(bf16x8, pw); \
                    _Pragma("unroll") for (int dt = 0; dt < 4; ++dt) o[dt] = (sp == 0) ? MFMA16(vf[0][dt], pf, ((f32x4){0.f, 0.f, 0.f, 0.f})) : MFMA16(vf[1][dt], pf, o[dt]); }
                if (slow) { ATT_CHUNK(true) } else { ATT_CHUNK(false) }
#undef ATT_CHUNK
                ps = kg_sum(ps);
                if (valid) {
                    if (kg == 0) { const float xs = ps * 1048576.f, hf_ = __builtin_rintf(xs); __hip_atomic_fetch_add(lsel + row, (int)hf_, __ATOMIC_RELAXED, __HIP_MEMORY_SCOPE_WORKGROUP);
                        __hip_atomic_fetch_add(lsel + 256 + row, (int)((xs - hf_) * 1048576.f), __ATOMIC_RELAXED, __HIP_MEMORY_SCOPE_WORKGROUP); }
#pragma unroll
                    for (int dt = 0; dt < 4; ++dt)
#pragma unroll
                        for (int i = 0; i < 4; ++i) { const float xs = o[dt][i] * S1, hf_ = __builtin_rintf(xs); const int off = row * OSP + dt * 16 + 4 * kg + i;
                            __hip_atomic_fetch_add(Oh + off, (int)hf_, __ATOMIC_RELAXED, __HIP_MEMORY_SCOPE_WORKGROUP);
                            __hip_atomic_fetch_add(Ol + off, (int)((xs - hf_) * 1048576.f), __ATOMIC_RELAXED, __HIP_MEMORY_SCOPE_WORKGROUP); }
                }
            }
            idx = idx2;
        }
    }
    f32x4 yacc[2][4];
    {
        ATT_SHADOW();
        bf16x8 qf[2][2]; float mrw[2], lpart[2]; f32x4 o[2][4];
#pragma unroll
        for (int rt = 0; rt < 2; ++rt) { const int q = 8 * w + 4 * rt + (r16 >> 2);
#pragma unroll
            for (int ks = 0; ks < 2; ++ks) qf[rt][ks] = *(const bf16x8*)(Qg + (size_t)q * 512 + hl * 64 + ks * 32 + kg * 8);
            mrw[rt] = mref[q * 4 + hl] * P.kwmax; lpart[rt] = 0.f;
#pragma unroll
            for (int dt = 0; dt < 4; ++dt) o[rt][dt] = (f32x4){0.f, 0.f, 0.f, 0.f}; }
        const bf16_t* Kw = P.KW + (size_t)(b * 2 + g) * SEQ * 64; const bf16_t* Vw = P.VWT + (size_t)(b * 2 + g) * 64 * SEQ;
        const int jlo = qb >= 8 ? qb - 8 : 0; const int nit = 2 * (qb - jlo + 1);
#define ATT_S4_STEP(KF, VF, it_) do { const int jw_ = jlo + ((it_) >> 1), sp_ = (it_) & 1; const int mode_ = (jw_ == qb) ? 1 : ((jw_ == qb - 8) ? 2 : 0); \
        _Pragma("unroll") for (int rt = 0; rt < 2; ++rt) { \
            f32x4 st[2]; float p[2][4]; \
            _Pragma("unroll") for (int u = 0; u < 2; ++u) { st[u] = MFMA16(KF[u][0], qf[rt][0], ((f32x4){0.f, 0.f, 0.f, 0.f})); st[u] = MFMA16(KF[u][1], qf[rt][1], st[u]); } \
            _Pragma("unroll") for (int u = 0; u < 2; ++u) _Pragma("unroll") for (int i = 0; i < 4; ++i) p[u][i] = fast_exp2(st[u][i] - mrw[rt]); \
            if (mode_) { const int tq = 8 * w + 4 * rt + (r16 >> 2); \
                _Pragma("unroll") for (int u = 0; u < 2; ++u) _Pragma("unroll") for (int i = 0; i < 4; ++i) { const int kk = 32 * sp_ + 8 * kg + 4 * u + i; const bool vis = (mode_ == 1) ? (kk <= tq) : (kk > tq); if (!vis) p[u][i] = 0.f; } } \
            lpart[rt] += ((p[0][0] + p[0][1]) + (p[0][2] + p[0][3])) + ((p[1][0] + p[1][1]) + (p[1][2] + p[1][3])); \
            u32x4 pw; pw.x = cvtpk(p[0][0], p[0][1]); pw.y = cvtpk(p[0][2], p[0][3]); pw.z = cvtpk(p[1][0], p[1][1]); pw.w = cvtpk(p[1][2], p[1][3]); \
            const bf16x8 pf = __builtin_bit_cast(bf16x8, pw); \
            _Pragma("unroll") for (int dt = 0; dt < 4; ++dt) o[rt][dt] = MFMA16(VF[dt], pf, o[rt][dt]); } } while (0)
        {
            bf16x8 kA[2][2], vA[4], kB[2][2], vB[4];
            ATT_LDK(kA, Kw, 64 * jlo); ATT_LDV(vA, Vw, SEQ, 64 * jlo); ATT_LDK(kB, Kw, 64 * jlo + 32); ATT_LDV(vB, Vw, SEQ, 64 * jlo + 32);
#pragma nounroll
            for (int it = 0; it < nit; it += 2) {
                ATT_S4_STEP(kA, vA, it);
                if (it + 2 < nit) { ATT_LDK(kA, Kw, 64 * jlo + 32 * (it + 2)); ATT_LDV(vA, Vw, SEQ, 64 * jlo + 32 * (it + 2)); }
                ATT_S4_STEP(kB, vB, it + 1);
                if (it + 3 < nit) { ATT_LDK(kB, Kw, 64 * jlo + 32 * (it + 3)); ATT_LDV(vB, Vw, SEQ, 64 * jlo + 32 * (it + 3)); }
            }
        }
#undef ATT_S4_STEP
#pragma unroll
        for (int rt = 0; rt < 2; ++rt) { const int q = 8 * w + 4 * rt + (r16 >> 2); const float lw_ = kg_sum(lpart[rt]); const float sc = lw_ > 0.f ? P.GATES[(tokb + t0 + q) * 24 + (g * 4 + hl) * 3 + 2] / lw_ : 0.f;
#pragma unroll
            for (int dt = 0; dt < 4; ++dt) yacc[rt][dt] = o[rt][dt] * sc; }
    }
    __syncthreads();
#pragma unroll
    for (int rt = 0; rt < 2; ++rt) { const int q = 8 * w + 4 * rt + (r16 >> 2), row = q * 4 + hl;
        const float lrow = (float)lsel[row] * (1.f / 1048576.f) + (float)lsel[256 + row] * (1.f / 1099511627776.f);
        const float invS1 = fmaxf(P.vmax, 1e-30f) * (1.f / 1048576.f);
        const float sc = lrow > 0.f ? P.GATES[(tokb + t0 + q) * 24 + (g * 4 + hl) * 3 + 1] / lrow * invS1 : 0.f;
        bf16_t* dst = P.Y + (tokb + t0 + q) * 1024 + 512 + (g * 4 + hl) * 64 + 4 * kg;
        const float* yp = P.YPART + (tokb + t0 + q) * 512 + (g * 4 + hl) * 64 + 4 * kg;
#pragma unroll
        for (int dt = 0; dt < 4; ++dt) { const LAS int* oh = Oh + row * OSP + dt * 16 + 4 * kg; const LAS int* ol = Ol + row * OSP + dt * 16 + 4 * kg;
            const f32x4 osel = (f32x4){(float)oh[0] + (float)ol[0] * (1.f / 1048576.f), (float)oh[1] + (float)ol[1] * (1.f / 1048576.f), (float)oh[2] + (float)ol[2] * (1.f / 1048576.f), (float)oh[3] + (float)ol[3] * (1.f / 1048576.f)};
            const f32x4 v = yacc[rt][dt] + *(const f32x4*)(yp + dt * 16) + osel * sc;
            u32x2 o; o.x = cvtpk(v[0], v[1]); o.y = cvtpk(v[2], v[3]); *(u32x2*)(dst + dt * 16) = o; } }
    __syncthreads();
}
#undef MFMA16
#undef ATT_LDK
#undef ATT_LDV
#undef ATT_SHADOW
#undef ATT_FETCH
#undef ATT_JOF
}

__device__ __forceinline__ void phase_n2(Frame& F, const Args& a, int l) {
    const int lane = F.lane, w = F.wave;
    const float* XR = WSP(float, WS_XR); unsigned char* H8 = WSP(unsigned char, WS_H8);
    const float* g = (const float*)a.in[I_N2G] + l * 1024;
    LAS float* part = (LAS float*)F.lds;
    LAS float* ssqp = (LAS float*)(F.lds + 32768);
    LAS float* lg = (LAS float*)(F.lds + 32768 + 1024);
    int* CNTI = WSP(int, WS_CNTI); int* ASG = WSP(int, WS_ASG); float* G4 = WSP(float, WS_GATE4);
    for (int item = F.vcu; item < T / 64; item += F.G) {
        const int tk0 = item * 64, b = tk0 >> 13; const int tt = w & 1, kq = w >> 1;
        const float* rwp = WSP(float, WS_RWP) + (size_t)(l * 2 + b) * 1024 * 32; const float* rbp = WSP(float, WS_MISC + 4096) + (l * 2 + b) * 32;
        const int i31 = lane & 31, hf = lane >> 5;
        {
            const float* xp = XR + (size_t)(tk0 + tt * 32 + i31) * DM + kq * 256 + 4 * hf; const float* wp = rwp + (size_t)(kq * 256 + 4 * hf) * 32 + i31;
            f32x16 acc;
#pragma unroll
            for (int r = 0; r < 16; ++r) acc[r] = 0.f;
            float ssq = 0.f;
#pragma nounroll
            for (int bt = 0; bt < 4; ++bt) {
                f32x4 xv[8]; float wv[8][4];
#pragma unroll
                for (int s = 0; s < 8; ++s) { xv[s] = *(const f32x4*)(xp + 8 * (bt * 8 + s)); const float* wq = wp + (size_t)(8 * (bt * 8 + s)) * 32;
                    wv[s][0] = wq[0]; wv[s][1] = wq[32]; wv[s][2] = wq[64]; wv[s][3] = wq[96]; }
#pragma unroll
                for (int s = 0; s < 8; ++s) { ssq += (xv[s].x * xv[s].x + xv[s].y * xv[s].y) + (xv[s].z * xv[s].z + xv[s].w * xv[s].w);
                    acc = __builtin_amdgcn_mfma_f32_32x32x2f32(xv[s].x, wv[s][0], acc, 0, 0, 0); acc = __builtin_amdgcn_mfma_f32_32x32x2f32(xv[s].y, wv[s][1], acc, 0, 0, 0);
                    acc = __builtin_amdgcn_mfma_f32_32x32x2f32(xv[s].z, wv[s][2], acc, 0, 0, 0); acc = __builtin_amdgcn_mfma_f32_32x32x2f32(xv[s].w, wv[s][3], acc, 0, 0, 0); }
            }
            ssq += __shfl_xor(ssq, 32);
            if (hf == 0) ssqp[kq * 64 + tt * 32 + i31] = ssq;
#pragma unroll
            for (int r = 0; r < 16; ++r) { const int tk = (r & 3) + 8 * (r >> 2) + 4 * hf; part[(w * 32 + tk) * 32 + i31] = acc[r]; }
        }
        __syncthreads();
        for (int i = F.tid; i < 64 * 32; i += NTHREADS) { const int tk = i >> 5, e = i & 31, t2 = tk >> 5, tl = tk & 31;
            const float sq = (ssqp[tk] + ssqp[64 + tk]) + (ssqp[128 + tk] + ssqp[192 + tk]); const float rstd = 1.f / sqrtf(sq * (1.f / DM) + NORM_EPS);
            const float v = (part[((0 * 2 + t2) * 32 + tl) * 32 + e] + part[((1 * 2 + t2) * 32 + tl) * 32 + e]) + (part[((2 * 2 + t2) * 32 + tl) * 32 + e] + part[((3 * 2 + t2) * 32 + tl) * 32 + e]);
            lg[tk * 33 + e] = v * rstd + rbp[e]; }
        __syncthreads();
        if (w < 2) {
            const int it = item * 2 + w;
            float v0 = -INFINITY, v1 = -INFINITY, v2 = -INFINITY, v3 = -INFINITY; int i0 = -1, i1 = -1, i2 = -1, i3 = -1;
            if (lane < 32) {
#pragma unroll 8
                for (int e = 0; e < 32; ++e) { const float v = lg[(w * 32 + lane) * 33 + e];
                    if (v > v3) { if (v > v2) { v3 = v2; i3 = i2; if (v > v1) { v2 = v1; i2 = i1; if (v > v0) { v1 = v0; i1 = i0; v0 = v; i0 = e; } else { v1 = v; i1 = e; } } else { v2 = v; i2 = e; } } else { v3 = v; i3 = e; } } }
            }
            const float e1 = __expf(v1 - v0), e2 = __expf(v2 - v0), e3 = __expf(v3 - v0); const float inv = 1.f / (1.f + e1 + e2 + e3);
            int r0 = 0, r1 = 0, r2 = 0, r3 = 0, mycnt = 0;
            for (int e = 0; e < 32; ++e) { const bool hit = (i0 == e) | (i1 == e) | (i2 == e) | (i3 == e); const unsigned long long U = __ballot(hit);
                const int rk = __popcll(U & ((1ull << lane) - 1ull));
                if (i0 == e) r0 = rk; if (i1 == e) r1 = rk; if (i2 == e) r2 = rk; if (i3 == e) r3 = rk;
                if (lane == e) mycnt = __popcll(U); }
            if (lane < 32) { const int tk = tk0 + w * 32 + lane; CNTI[it * 32 + lane] = mycnt;
                if (mycnt > 0) { atomicAdd(F.ctl + CW_GCNT + (l * 32 + (it >> 4)) * 32 + lane, (unsigned)mycnt); atomicAdd(F.ctl + CW_CNT + l * 32 + lane, (unsigned)mycnt); }
                *(int4*)(ASG + tk * 4) = make_int4((i0 << 16) | r0, (i1 << 16) | r1, (i2 << 16) | r2, (i3 << 16) | r3);
                *(f32x4*)(G4 + tk * 4) = (f32x4){inv, e1 * inv, e2 * inv, e3 * inv}; }
        }
#pragma unroll 2
        for (int rr = 0; rr < 8; ++rr) { const int m = tk0 + w * 8 + rr; const RowV r = row_load(XR + (size_t)m * DM, lane);
            const float rstd = 1.f / sqrtf(row_ssq(r) * (1.f / DM) + NORM_EPS);
            row_norm_store8(r, rstd, g, MODP(l, b, 4), MODP(l, b, 3), H8 + (size_t)m * DM, lane); }
        __syncthreads();
    }
}

__device__ __forceinline__ void phase_n2b(Frame& F, int l) {
    const int gw = F.vcu * NWAVES + F.wave, NGW = F.G * NWAVES; const int lane = F.lane;
    const int* CNTI = WSP(int, WS_CNTI); int* TOK = WSP(int, WS_TOK); int* ASG = WSP(int, WS_ASG); unsigned* cnt = F.ctl + CW_CNT + l * 32;
    for (int it = gw; it < T / 32; it += NGW) {
        int base = 0;
        {
            const unsigned* gc = F.ctl + CW_GCNT + l * 1024; const int grp = it >> 4, e = lane & 31; int s0 = 0, s1 = 0;
#pragma unroll
            for (int gI = 0; gI < 32; ++gI) { const int v = (int)gc[gI * 32 + e]; s0 += (gI < grp) ? v : 0; }
#pragma unroll
            for (int i = 0; i < 16; ++i) { const int v = CNTI[((grp << 4) + i) * 32 + e]; s1 += (((grp << 4) + i) < it) ? v : 0; }
            base = s0 + s1; }
        { const int tk = it * 32 + (lane & 31); const int4 as = *(const int4*)(ASG + tk * 4); int v[4] = {as.x, as.y, as.z, as.w};
#pragma unroll
            for (int k = 0; k < 4; ++k) { const int e = v[k] >> 16, rk = v[k] & 0xffff; const int sl = __shfl(base, e & 31) + rk; if (lane < 32) TOK[e * 16384 + sl] = tk; v[k] = (e << 16) | sl; }
            if (lane < 32) *(int4*)(ASG + tk * 4) = make_int4(v[0], v[1], v[2], v[3]); }
    }
}

__device__ __forceinline__ void moe_tables(Frame& F, int l, int NT, int& total) {
    LAS int* ust = (LAS int*)(F.lds + MOE_OFF); LAS int* bst = ust + 33; LAS int* cn = bst + 33;
    if (F.tid < 64) { const unsigned* cnt = F.ctl + CW_CNT + l * 32; const int lane = F.tid;
        const int c = (lane < NE) ? (int)cnt[lane] : 0; const int nb = (c + 255) >> 8; int inc = nb;
#pragma unroll
        for (int o = 1; o < 32; o <<= 1) { const int t = __shfl_up(inc, o); if ((lane & 31) >= o) inc += t; }
        if (lane < NE) { bst[lane] = inc - nb; ust[lane] = (inc - nb) * NT; cn[lane] = c; if (lane == NE - 1) { bst[NE] = inc; ust[NE] = inc * NT; } } }
    __syncthreads();
    total = ust[NE];
}

constexpr int PH_PROLOGUE = 0, PH_N1 = 1, PH_LAYER0 = 2, PH_PER_LAYER = 9, NPHASES = PH_LAYER0 + DEPTH * PH_PER_LAYER;
__global__ void __launch_bounds__(NTHREADS, 2) fwd_kernel(Args args) {
    extern __shared__ __attribute__((aligned(16))) unsigned char lds_raw[];
    Frame F;
    F.lds = (LAS unsigned char*)lds_raw; F.ws = args.ws; F.ctl = (unsigned*)(args.ws + WS_CTL);
    F.tid = threadIdx.x; F.lane = F.tid & 63; F.wave = __builtin_amdgcn_readfirstlane(F.tid >> 6);
    F.G = gridDim.x; { const int bx = blockIdx.x; F.vcu = (F.G % 8 == 0) ? (bx % 8) * (F.G / 8) + bx / 8 : bx; }
    for (int u = F.tid; u < (LDS_BYTES - LDSCTL_OFF) / 4; u += NTHREADS) ((LAS unsigned*)(F.lds + LDSCTL_OFF))[u] = 0u;
    __syncthreads();
    volatile LAS unsigned* MISC = (volatile LAS unsigned*)(F.lds + MISC_OFF);
    XcdBarrier bar; bar.bar = F.ctl + CW_BAR; bar.x = 0; bar.st = nullptr;
#if !MK_PER_PHASE
    bar = xcd_barrier_post(F.ctl + CW_BAR, MISC + 8);
#endif
    const int lo = args.ph_lo, hi = args.ph_hi;
#define IN(k) (lo <= (k) && (k) < hi)
#define REFRESH() do { int t_ = threadIdx.x; asm volatile("" : "+v"(t_)); F.tid = t_; F.lane = t_ & 63; F.wave = __builtin_amdgcn_readfirstlane(t_ >> 6); } while (0)
#define SEAM(k) do { if (IN(k) && IN((k) + 1)) xcd_barrier(bar); } while (0)
#define REPS(bit, idem) (((REPMASK & (bit)) && (idem)) ? NREP : 1)

    if (IN(PH_PROLOGUE) && !(SKIPMASK & 1)) for (int rep = 0; rep < REPS(1, true); ++rep) { REFRESH(); phase_prologue(F, args); } SEAM(PH_PROLOGUE);
    if (IN(PH_N1) && !(SKIPMASK & 2)) for (int rep = 0; rep < REPS(2, true); ++rep) { REFRESH(); phase_n1_first(F, args); } SEAM(PH_N1);
    for (int l = 0; l < DEPTH; ++l) {
        const int p0 = PH_LAYER0 + l * PH_PER_LAYER;
        if (IN(p0 + 0) && !(SKIPMASK & 4)) for (int rep = 0; rep < REPS(4, l == 0); ++rep) {
            pg8::DenseOrder S; S.init(T, PINP, F.G, (int)blockIdx.x);
            EpiProj E{WSP(bf16_t, WS_UG), WSP(bf16_t, WS_VG), WSP(bf16_t, WS_Q), WSP(bf16_t, WS_KC), WSP(bf16_t, WS_VC), WSP(bf16_t, WS_KS), WSP(bf16_t, WS_KW), WSP(bf16_t, WS_VST), WSP(bf16_t, WS_VWT),
                      WSP(float, WS_GATES), WSP(float, WS_ROPE), F.ctl + CW_KMAX + l * 16};
            pg8::gemm_phase<EpiProj, pg8::DenseOrder, false, true>(F.lds, WSP(bf16_t, WS_H), WSP(bf16_t, WS_WIN) + (size_t)l * PINP * 1024, 1024, S, E);
        }
        SEAM(p0 + 0);
        if (IN(p0 + 1) && !(SKIPMASK & 8)) for (int rep = 0; rep < REPS(8, l == 0); ++rep) { REFRESH();
            for (int it = F.vcu; it < 256; it += F.G) { if (it < 128) sgu_item(F, args, l, it); else { compress_item(F, args, l, 2 * (it - 128)); compress_item(F, args, l, 2 * (it - 128) + 1); } }
        }
        SEAM(p0 + 1);
        if (IN(p0 + 2) && !(SKIPMASK & 16)) for (int rep = 0; rep < REPS(16, l == 0); ++rep) { REFRESH();
            att::Ptrs P{WSP(bf16_t, WS_Q), WSP(bf16_t, WS_KS), WSP(bf16_t, WS_KW), WSP(bf16_t, WS_VST), WSP(bf16_t, WS_VWT), WSP(bf16_t, WS_KCMP), WSP(bf16_t, WS_VCT), WSP(float, WS_GATES), WSP(bf16_t, WS_Y), WSP(float, WS_YPART), 0.f};
            for (int it = F.vcu; it < 512; it += F.G) {
                const int uu = (it < 256) ? it : (767 - it);
                const int bg = uu >> 7, qb = uu & 127;
                const unsigned* km = F.ctl + CW_KMAX + l * 16 + bg;
                P.kmax = sqrtf(__uint_as_float(__hip_atomic_load(km, __ATOMIC_RELAXED, __HIP_MEMORY_SCOPE_AGENT)));
                P.vmax = __uint_as_float(__hip_atomic_load(km + 4, __ATOMIC_RELAXED, __HIP_MEMORY_SCOPE_AGENT));
                P.kwmax = sqrtf(__uint_as_float(__hip_atomic_load(km + 8, __ATOMIC_RELAXED, __HIP_MEMORY_SCOPE_AGENT)));
                P.kcmax = sqrtf(__uint_as_float(__hip_atomic_load(km + 12, __ATOMIC_RELAXED, __HIP_MEMORY_SCOPE_AGENT)));
                att::attn_unit(F, P, bg >> 1, bg & 1, qb);
            }
        }
        SEAM(p0 + 2);
        if (IN(p0 + 3) && !(SKIPMASK & 32)) for (int rep = 0; rep < REPS(32, l == 0); ++rep) {
            pg8::DenseOrder S; S.init(T, DM, F.G, (int)blockIdx.x);
            EpiOut E{l == 0 ? (const float*)args.in[I_X] : WSP(float, WS_XR), WSP(float, WS_XR), (const float*)(F.ctl + CW_MOD) + (size_t)l * 2 * 6144};
            pg8::gemm_phase<EpiOut, pg8::DenseOrder, false, true>(F.lds, WSP(bf16_t, WS_Y), WSP(bf16_t, WS_WOUT) + (size_t)l * 1024 * 1024, 1024, S, E);
        }
        SEAM(p0 + 3);
        if (IN(p0 + 4) && !(SKIPMASK & 64)) for (int rep = 0; rep < REPS(64, l == 0); ++rep) { REFRESH(); phase_n2(F, args, l); }
        SEAM(p0 + 4);
        if (IN(p0 + 5) && !(SKIPMASK & 64)) for (int rep = 0; rep < REPS(1024, l == 0); ++rep) { REFRESH(); phase_n2b(F, l); }
        SEAM(p0 + 5);
        if (IN(p0 + 6) && !(SKIPMASK & 128)) for (int rep = 0; rep < REPS(128, l == 0); ++rep) { REFRESH();
            int total; moe_tables(F, l, 8, total);
            LAS int* ust = (LAS int*)(F.lds + MOE_OFF);
            pg8::MoeOrder S{ust, ust + 33, ust + 66, WSP(int, WS_TOK), 8, F.G, F.vcu, total, 1024};
            EpiSwiglu E{WSP(unsigned char, WS_ACT), (const float*)args.in[I_EB1] + (size_t)l * NE * 2048};
            pg8::gemm_phase<EpiSwiglu, pg8::MoeOrder, true, true, true>(F.lds, WSP(bf16_t, WS_H8), (const bf16_t*)(WSP(unsigned char, WS_W1T) + (size_t)l * NE * 2048 * 1024), 512, S, E);
        }
        SEAM(p0 + 6);
        if (IN(p0 + 7) && !(SKIPMASK & 256)) for (int rep = 0; rep < REPS(256, l == 0); ++rep) { REFRESH();
            int total; moe_tables(F, l, 4, total);
            LAS int* ust = (LAS int*)(F.lds + MOE_OFF);
            pg8::MoeOrder S{ust, ust + 33, ust + 66, WSP(int, WS_TOK), 4, F.G, F.vcu, total, 1024};
            EpiDown E{WSP(bf16_t, WS_YROWS), (const float*)args.in[I_EB2] + (size_t)l * NE * 1024};
            pg8::gemm_phase<EpiDown, pg8::MoeOrder, false, true, true>(F.lds, WSP(bf16_t, WS_ACT), (const bf16_t*)(WSP(unsigned char, WS_W2T) + (size_t)l * NE * 1024 * 1024), 512, S, E);
        }
        SEAM(p0 + 7);
        if (IN(p0 + 8) && !(SKIPMASK & 512)) for (int rep = 0; rep < REPS(512, l == DEPTH - 1); ++rep) { REFRESH(); phase_combine(F, args, l); }
        if (l + 1 < DEPTH) SEAM(p0 + 8);
    }
#undef IN
#undef SEAM
}

extern "C" void kernel_launch(void* const* d_in, const int* in_sizes, int n_in, void* d_out, int out_size, void* d_ws, size_t ws_size, hipStream_t stream) {
    static int grid = 0;
    if (grid == 0) {
        if (n_in != 26 || out_size != T * DM || ws_size < WS_END) { fprintf(stderr, "kernel_launch: unexpected problem (n_in %d, out %d, ws %zu; need ws >= %zu)\n", n_in, out_size, ws_size, (size_t)WS_END); grid = -1; return; }
        int dev = 0, cus = 0, per_cu = 0;
        if (hipGetDevice(&dev) != hipSuccess || hipDeviceGetAttribute(&cus, hipDeviceAttributeMultiprocessorCount, dev) != hipSuccess) { grid = -1; return; }
        if (hipFuncSetAttribute((const void*)fwd_kernel, hipFuncAttributeMaxDynamicSharedMemorySize, LDS_BYTES) != hipSuccess) { fprintf(stderr, "kernel_launch: hipFuncSetAttribute failed\n"); grid = -1; return; }
        if (hipOccupancyMaxActiveBlocksPerMultiprocessor(&per_cu, (const void*)fwd_kernel, NTHREADS, LDS_BYTES) != hipSuccess || per_cu < 1) { fprintf(stderr, "kernel_launch: occupancy query says %d\n", per_cu); (void)hipGetLastError(); per_cu = 1; }
        grid = cus;
    }
    if (grid < 0) return;
    if (hipMemsetAsync((char*)d_ws + WS_CTL, 0, CTL_ZERO_BYTES, stream) != hipSuccess) { fprintf(stderr, "kernel_launch: memset failed\n"); return; }
    Args a{};
    for (int i = 0; i < 26; ++i) a.in[i] = d_in[i];
    a.out = (float*)d_out; a.ws = (unsigned char*)d_ws;
#if MK_PER_PHASE
    for (int p = 0; p < NPHASES; ++p) { a.ph_lo = p; a.ph_hi = p + 1; a.li = 0;
        hipLaunchKernelGGL(fwd_kernel, dim3(grid), dim3(NTHREADS), LDS_BYTES, stream, a); }
#else
    a.ph_lo = 0; a.ph_hi = NPHASES; a.li = 0;
    void* kargs[] = {&a};
    hipError_t e = hipLaunchCooperativeKernel((const void*)fwd_kernel, dim3(grid), dim3(NTHREADS), kargs, LDS_BYTES, stream);
    if (e != hipSuccess) fprintf(stderr, "kernel_launch: cooperative launch failed: %s (grid %d)\n", hipGetErrorString(e), grid);
#endif
}
```

```cpp
#include <hip/hip_runtime.h>
#include <cstdio>
#include <cstdint>

#ifndef SKIPMASK
#define SKIPMASK 0
#endif
#ifndef REPMASK
#define REPMASK 0
#endif
#ifndef NREP
#define NREP 3
#endif
#ifndef DUMMYINT
#define DUMMYINT 0
#endif
#ifndef ATTREP
#define ATTREP 0
#endif
#ifndef MK_PER_PHASE
#define MK_PER_PHASE 0
#endif

#define LAS __attribute__((address_space(3)))
typedef unsigned short bf16_t;
typedef short bf16x8 __attribute__((ext_vector_type(8)));
typedef float f32x4 __attribute__((ext_vector_type(4)));
typedef float f32x2 __attribute__((ext_vector_type(2)));
typedef float f32x16 __attribute__((ext_vector_type(16)));
typedef unsigned u32x4 __attribute__((ext_vector_type(4)));
typedef unsigned u32x2 __attribute__((ext_vector_type(2)));
typedef __bf16 bf16x2_t __attribute__((ext_vector_type(2)));
typedef int i32x4 __attribute__((ext_vector_type(4)));
typedef int i32x8 __attribute__((ext_vector_type(8)));

constexpr int BATCH = 2, SEQ = 8192, DM = 1024, T = BATCH * SEQ, DEPTH = 2;
constexpr int PIN = 2328, PINP = 2560;
constexpr int NE = 32, FF = 1024, TOPK = 4;
constexpr int NCMP = 511, NCMPP = 512;
constexpr float NORM_EPS = 1e-6f;
constexpr float W8SCALE = 64.f;
constexpr int W8_E8M0 = 0x79797979, ONE_E8M0 = 0x7f7f7f7f;
constexpr float QSCALE = 0.125f * 1.4426950408889634f;
constexpr int NWAVES = 8, NTHREADS = 512;

constexpr size_t MiB = 1u << 20;
constexpr size_t WS_CTL = 0, CTL_ZERO_BYTES = 1 * MiB;
constexpr size_t WS_WIN = 1 * MiB;
constexpr size_t WS_WOUT = 11 * MiB;
constexpr size_t WS_SGW = 15 * MiB;
constexpr size_t WS_CW1 = 15 * MiB + 512 * 1024;
constexpr size_t WS_ROPE = 17 * MiB;
constexpr size_t WS_RWP = 21 * MiB;
constexpr size_t WS_MISC = 21 * MiB + 512 * 1024;
constexpr size_t WS_W1T = 32 * MiB;
constexpr size_t WS_W2T = 288 * MiB;
constexpr size_t WS_XR = 416 * MiB;
constexpr size_t WS_H = 480 * MiB;
constexpr size_t WS_UG = 513 * MiB, WS_VG = 529 * MiB, WS_Q = 545 * MiB;
constexpr size_t WS_KC = 561 * MiB, WS_VC = 565 * MiB, WS_KS = 569 * MiB, WS_KW = 573 * MiB;
constexpr size_t WS_VST = 577 * MiB, WS_VWT = 581 * MiB;
constexpr size_t WS_GATES = 585 * MiB;
constexpr size_t WS_KCMP = 587 * MiB;
constexpr size_t WS_VCT = 587 * MiB + 512 * 1024;
constexpr size_t WS_Y = 588 * MiB;
constexpr size_t WS_TOK = 620 * MiB;
constexpr size_t WS_ASG = 622 * MiB;
constexpr size_t WS_GATE4 = 622 * MiB + 512 * 1024;
constexpr size_t WS_YPART = 912 * MiB;
constexpr size_t WS_CNTI = 623 * MiB;
constexpr size_t WS_ACT = 624 * MiB;
constexpr size_t WS_YROWS = 768 * MiB;
constexpr size_t WS_H8 = 944 * MiB;
constexpr size_t WS_END = 962 * MiB;
constexpr int CW_BAR = 4096;
constexpr int CW_MOD = 16384;
constexpr int CW_CNT = 40960;
constexpr int CW_KMAX = 41088;
constexpr int CW_GCNT = 41216;

__device__ __forceinline__ unsigned cvtpk(float lo, float hi) { f32x2 v = {lo, hi}; bf16x2_t b = __builtin_convertvector(v, bf16x2_t); return __builtin_bit_cast(unsigned, b); }
__device__ __forceinline__ unsigned cvt4_fp8(float a, float b, float c, float d) { int w = 0; w = __builtin_amdgcn_cvt_pk_fp8_f32(a, b, w, false); w = __builtin_amdgcn_cvt_pk_fp8_f32(c, d, w, true); return (unsigned)w; }
__device__ __forceinline__ float bf2f(unsigned short b) { return __uint_as_float((unsigned)b << 16); }
__device__ __forceinline__ float bflo(unsigned w) { return __uint_as_float(w << 16); }
__device__ __forceinline__ float bfhi(unsigned w) { return __uint_as_float(w & 0xffff0000u); }
__device__ __forceinline__ float fast_exp2(float x) { return __builtin_amdgcn_exp2f(x); }
__device__ __forceinline__ float fast_rcp(float x) { return __builtin_amdgcn_rcpf(x); }
__device__ __forceinline__ float sigmoidf_(float x) { return fast_rcp(1.f + fast_exp2(-1.4426950408889634f * x)); }
__device__ __forceinline__ float gelu_tanh(float x) { const float u = 0.7978845608028654f * (x + 0.044715f * x * x * x); return x * fast_rcp(1.f + fast_exp2(-2.885390081777927f * u)); }

__device__ __forceinline__ float x16_sum(float x) { auto r = __builtin_amdgcn_permlane16_swap(__float_as_uint(x), __float_as_uint(x), false, false); return __uint_as_float(r[0]) + __uint_as_float(r[1]); }
__device__ __forceinline__ float x32_sum(float x) { auto r = __builtin_amdgcn_permlane32_swap(__float_as_uint(x), __float_as_uint(x), false, false); return __uint_as_float(r[0]) + __uint_as_float(r[1]); }
__device__ __forceinline__ float x16_max(float x) { auto r = __builtin_amdgcn_permlane16_swap(__float_as_uint(x), __float_as_uint(x), false, false); return fmaxf(__uint_as_float(r[0]), __uint_as_float(r[1])); }
__device__ __forceinline__ float x32_max(float x) { auto r = __builtin_amdgcn_permlane32_swap(__float_as_uint(x), __float_as_uint(x), false, false); return fmaxf(__uint_as_float(r[0]), __uint_as_float(r[1])); }
__device__ __forceinline__ float kg_sum(float x) { return x32_sum(x16_sum(x)); }
__device__ __forceinline__ float kg_max(float x) { return x32_max(x16_max(x)); }
__device__ __forceinline__ float quad_sum(float x) { x += __uint_as_float(__builtin_amdgcn_update_dpp(0u, __float_as_uint(x), 0xB1, 0xF, 0xF, true)); x += __uint_as_float(__builtin_amdgcn_update_dpp(0u, __float_as_uint(x), 0x4E, 0xF, 0xF, true)); return x; }
__device__ __forceinline__ float wave_sum(float v) {
    v = quad_sum(v);
    v += __uint_as_float(__builtin_amdgcn_update_dpp(0u, __float_as_uint(v), 0x141, 0xF, 0xF, true));
    v += __uint_as_float(__builtin_amdgcn_update_dpp(0u, __float_as_uint(v), 0x140, 0xF, 0xF, true));
    return x32_sum(x16_sum(v));
}
#define LDS_WAIT() asm volatile("s_waitcnt lgkmcnt(0)" ::: "memory")
#define VM_WAIT() asm volatile("s_waitcnt vmcnt(0)" ::: "memory")

__device__ __forceinline__ int kfrag_off(int key, int c8) {
    const int s = key >> 5, ko = key & 31, u = (ko >> 2) & 1, r16 = ((ko >> 3) << 2) | (ko & 3), ks = c8 >> 2, kg = c8 & 3;
    return s * 2048 + (u * 2 + ks) * 512 + (kg * 16 + r16) * 8;
}
__device__ __forceinline__ int vfrag_off(int key, int d) {
    const int s = key >> 5, ko = key & 31;
    return s * 2048 + (d >> 4) * 512 + ((ko >> 3) * 16 + (d & 15)) * 8 + (ko & 7);
}
namespace pg8 {
constexpr int BM = 256, BK = 64, HALF = 128, HTB = HALF * BK * 2, STAGE_BYTES = 8 * HTB, NXCD = 8, WGM = 8;
__host__ __device__ __forceinline__ int lds_byte(int r, int c) { const int st = (r >> 4) * 2 + (c >> 5), rr = r & 15, cc = c & 31, ob = rr * 64 + cc * 2; return st * 1024 + (ob ^ (((ob >> 9) & 1) << 5)); }
__host__ __device__ __forceinline__ void stage_rc(int b, int& R, int& C) { const int st = b / 1024, sb = b % 1024, swz = sb ^ (((sb >> 9) & 1) << 5); R = (st >> 1) * 16 + swz / 64; C = (st & 1) * 32 + (swz % 64) / 2; }
__host__ __device__ __forceinline__ int perm32(int rho) { const int n = rho >> 4, i = rho & 15; return 8 * (i >> 2) + 4 * n + (i & 3); }

struct Unit { int pm, pn, e, pnl, rloc; };

struct DenseOrder {
    int nM, nN, nwg, G, c;
    __device__ void init(int M, int N, int G_, int c_) { nM = M / BM; nN = N / BM; nwg = nM * nN; G = G_; c = c_; }
    __device__ bool next(int i, Unit& u) const {
        const long L = (long)i * G + c; if (L >= nwg) return false;
        int wgid = (int)L; { const int q = nwg / NXCD, r = nwg % NXCD, xcd = wgid % NXCD, off = wgid / NXCD; wgid = (xcd < r ? xcd * (q + 1) : r * (q + 1) + (xcd - r) * q) + off; }
        const int nig = WGM * nN, gid = wgid / nig, fm = gid * WGM, gsz = (nM - fm) < WGM ? (nM - fm) : WGM;
        u.pm = fm + ((wgid % nig) % gsz); u.pn = (wgid % nig) / gsz; u.e = 0; u.pnl = u.pn; u.rloc = 0; return true;
    }
    __device__ __forceinline__ unsigned rowoff(const Unit&, int) const { return 0u; }
};

struct MoeOrder {
    const LAS int* ust;
    const LAS int* bst;
    const LAS int* cnt;
    const int* tok;
    int NT, G, c, total, rowbytes;
    __device__ bool next(int i, Unit& u) const {
        const int L = i * G + c; if (L >= total) return false;
        int e = 0;
        for (int k = 1; k < NE; ++k) e += (L >= ust[k]) ? 1 : 0;
        e = __builtin_amdgcn_readfirstlane(e);
        const int loc = __builtin_amdgcn_readfirstlane(L - ust[e]), b0 = __builtin_amdgcn_readfirstlane(bst[e]), nb = __builtin_amdgcn_readfirstlane(bst[e + 1]) - b0;
        u.e = e; u.pnl = loc / nb; u.rloc = loc - u.pnl * nb; u.pm = b0 + u.rloc; u.pn = e * NT + u.pnl; return true;
    }
    __device__ __forceinline__ unsigned rowoff(const Unit& u, int r) const {
        const int slot = u.rloc * 256 + r; const int tk = slot < cnt[u.e] ? tok[u.e * 16384 + slot] : T;
        return (unsigned)tk * (unsigned)rowbytes;
    }
};

template <class Epi, class Sched, bool GATHER, bool ALIGN_EPI, bool FP8 = false>
__device__ __forceinline__ void gemm_phase(LAS unsigned char* lds, const bf16_t* A, const bf16_t* Bt, const int K, const Sched& S, const Epi& E) {
    int tid_ = threadIdx.x; asm volatile("" : "+v"(tid_));
    const int tid = tid_, wid = __builtin_amdgcn_readfirstlane(tid >> 6), lane = tid & 63, wr = wid >> 2, wc = wid & 3, fr = lane & 15, fq = lane >> 4;
    const int nt = K / BK;
    unsigned voffB[2];
#pragma unroll
    for (int i = 0; i < 2; ++i) { int R, C; stage_rc(tid * 16 + i * 8192, R, C); const int Rb = Epi::PERM ? ((R & ~31) + perm32(R & 31)) : R; voffB[i] = (unsigned)(Rb * K + C) * 2u; }
    const size_t kstep = (size_t)(BK * 2);
    const size_t hstep = (size_t)HALF * K * 2;
    const size_t tstep = 2 * hstep;
    const unsigned ldsw = (unsigned)wid * 1024u;
    const int aoff = lds_byte(wr * 64 + fr, fq * 8), boff = lds_byte(wc * 32 + fr, fq * 8);
#define PG8_SA(b, h) (((b) * 2 + (h)) * HTB)
#define PG8_SB(b, h) ((4 + (b) * 2 + (h)) * HTB)
#define PG8_STAGE(bufoff, gbase, v0, v1) do { \
        __builtin_amdgcn_global_load_lds((const unsigned*)((const char*)(gbase) + (v0)), (LAS unsigned*)(lds + (bufoff) + ldsw), 16, 0, 0); \
        __builtin_amdgcn_global_load_lds((const unsigned*)((const char*)(gbase) + (v1)), (LAS unsigned*)(lds + (bufoff) + ldsw + 8192), 16, 0, 0); } while (0)
#define PG8_STAGEB(bufoff, gbase) PG8_STAGE(bufoff, gbase, voffB[0], voffB[1])
#define PG8_CAT8(x0, x1) __builtin_shufflevector(x0, x1, 0, 1, 2, 3, 4, 5, 6, 7)
#define PG8_RD4(off) (*(const LAS i32x4*)(lds + (off)))
#define PG8_LDA(dst, b, h) do { if constexpr (FP8) { _Pragma("unroll") for (int m = 0; m < 4; ++m) dst##8[m] = PG8_CAT8(PG8_RD4(PG8_SA(b, h) + aoff + m * 2048), PG8_RD4(PG8_SA(b, h) + aoff + m * 2048 + 1024)); } \
        else { _Pragma("unroll") for (int m = 0; m < 4; ++m) _Pragma("unroll") for (int k = 0; k < 2; ++k) dst[m][k] = *(const LAS bf16x8*)(lds + PG8_SA(b, h) + aoff + m * 2048 + k * 1024); } } while (0)
#define PG8_LDB(dst, b, h) do { if constexpr (FP8) { _Pragma("unroll") for (int n = 0; n < 2; ++n) dst##8[n] = PG8_CAT8(PG8_RD4(PG8_SB(b, h) + boff + n * 2048), PG8_RD4(PG8_SB(b, h) + boff + n * 2048 + 1024)); } \
        else { _Pragma("unroll") for (int n = 0; n < 2; ++n) _Pragma("unroll") for (int k = 0; k < 2; ++k) dst[n][k] = *(const LAS bf16x8*)(lds + PG8_SB(b, h) + boff + n * 2048 + k * 1024); } } while (0)
#define PG8_MMA(ai, bj, At, Bt_) do { __builtin_amdgcn_s_setprio(1); _Pragma("unroll") for (int m = 0; m < 4; ++m) _Pragma("unroll") for (int n = 0; n < 2; ++n) { \
        if constexpr (FP8) { asm volatile("v_mfma_scale_f32_16x16x128_f8f6f4 %0, %1, %2, %0, %3, %4 op_sel_hi:[0,0,0]" : "+v"(acc[ai][bj][m][n]) : "v"(Bt_##8[n]), "v"(At##8[m]), "v"(sc_w), "v"(sc_x)); } \
        else { _Pragma("unroll") for (int k = 0; k < 2; ++k) acc[ai][bj][m][n] = __builtin_amdgcn_mfma_f32_16x16x32_bf16(Bt_[n][k], At[m][k], acc[ai][bj][m][n], 0, 0, 0); } } \
        __builtin_amdgcn_s_setprio(0); } while (0)
#define PG8_WAIT_V(n) asm volatile("s_waitcnt vmcnt(" #n ")" ::: "memory")
#define PG8_WAIT_L(n) asm volatile("s_waitcnt lgkmcnt(" #n ")" ::: "memory")
#define PG8_BAR __builtin_amdgcn_s_barrier()
#define PG8_SCHED __builtin_amdgcn_sched_barrier(0)
#define PG8_SETV(v, u) do { int t2_ = tid; asm volatile("" : "+v"(t2_)); _Pragma("unroll") for (int i_ = 0; i_ < 2; ++i_) { int R_, C_; stage_rc(t2_ * 16 + i_ * 8192, R_, C_); _Pragma("unroll") for (int h_ = 0; h_ < 2; ++h_) \
        v[h_][i_] = GATHER ? (S.rowoff(u, R_ + HALF * h_) + (unsigned)C_ * 2u) : (unsigned)((R_ + HALF * h_) * K + C_) * 2u; } } while (0)
    Unit cur, nxt; int ui = 0;
    if (!S.next(0, cur)) return;
    unsigned vc[2][2], vn[2][2];
    PG8_SETV(vc, cur);
    f32x4 acc[2][2][4][2];
#pragma unroll
    for (int a = 0; a < 2; ++a)
#pragma unroll
        for (int b = 0; b < 2; ++b)
#pragma unroll
            for (int m = 0; m < 4; ++m)
#pragma unroll
                for (int n = 0; n < 2; ++n) acc[a][b][m][n] = (f32x4){0.f, 0.f, 0.f, 0.f};
    bf16x8 At[4][2], B0[2][2], B1[2][2]; i32x8 At8[4], B08[2], B18[2];
    int sc_w = W8_E8M0, sc_x = ONE_E8M0; asm volatile("" : "+v"(sc_w), "+v"(sc_x));
    const char* cA = GATHER ? (const char*)A : (const char*)A + (size_t)cur.pm * tstep;
    const char* cB = (const char*)Bt + (size_t)cur.pn * tstep;
    PG8_STAGEB(PG8_SB(0, 0), cB); PG8_STAGEB(PG8_SB(0, 1), cB + hstep); PG8_STAGE(PG8_SA(0, 0), cA, vc[0][0], vc[0][1]); PG8_STAGE(PG8_SA(0, 1), cA, vc[1][0], vc[1][1]);
    if (wr == 1) PG8_BAR;
    PG8_WAIT_V(2); PG8_BAR;
    PG8_STAGEB(PG8_SB(1, 0), cB + kstep); PG8_STAGE(PG8_SA(1, 0), cA + kstep, vc[0][0], vc[0][1]); PG8_STAGEB(PG8_SB(1, 1), cB + hstep + kstep);
    PG8_WAIT_V(6); PG8_BAR;
    for (;;) {
        const bool has_next = S.next(ui + 1, nxt);
        const char* nA = GATHER ? (const char*)A : (has_next ? (const char*)A + (size_t)nxt.pm * tstep : cA);
        const char* nB = has_next ? (const char*)Bt + (size_t)nxt.pn * tstep : cB;
        if constexpr (GATHER) { if (has_next) { PG8_SETV(vn, nxt); } else {
#pragma unroll
            for (int h_ = 0; h_ < 2; ++h_)
#pragma unroll
                for (int i_ = 0; i_ < 2; ++i_) vn[h_][i_] = vc[h_][i_]; } }
#pragma nounroll
        for (int t = 0; t < nt; t += 2) {
            const bool last = (t == nt - 2);
            const char* a1 = cA + (size_t)(t + 1) * kstep;
            const char* a2 = last ? nA : cA + (size_t)(t + 2) * kstep; const char* b2 = last ? nB : cB + (size_t)(t + 2) * kstep;
            const char* a3 = a2 + kstep; const char* b3 = b2 + kstep;
            const unsigned w00 = (GATHER && last) ? vn[0][0] : vc[0][0], w01 = (GATHER && last) ? vn[0][1] : vc[0][1], w10 = (GATHER && last) ? vn[1][0] : vc[1][0], w11 = (GATHER && last) ? vn[1][1] : vc[1][1];
            PG8_LDB(B0, 0, 0); PG8_LDB(B1, 0, 1); PG8_SCHED; PG8_LDA(At, 0, 0); PG8_STAGE(PG8_SA(1, 1), a1, vc[1][0], vc[1][1]);
            PG8_WAIT_V(8); PG8_WAIT_L(0); PG8_BAR; PG8_MMA(0, 0, At, B0); PG8_MMA(0, 1, At, B1); PG8_BAR; PG8_SCHED;
            PG8_LDA(At, 0, 1); PG8_STAGEB(PG8_SB(0, 0), b2); PG8_STAGEB(PG8_SB(0, 1), b2 + hstep); PG8_STAGE(PG8_SA(0, 0), a2, w00, w01);
            PG8_WAIT_V(8); PG8_WAIT_L(0); PG8_BAR; PG8_MMA(1, 0, At, B0); PG8_MMA(1, 1, At, B1); PG8_BAR; PG8_SCHED;
            PG8_LDB(B0, 1, 0); PG8_LDB(B1, 1, 1); PG8_SCHED; PG8_LDA(At, 1, 0); PG8_STAGE(PG8_SA(0, 1), a2, w10, w11);
            PG8_WAIT_V(8); PG8_WAIT_L(0); PG8_BAR; PG8_MMA(0, 0, At, B0); PG8_MMA(0, 1, At, B1); PG8_BAR; PG8_SCHED;
            PG8_LDA(At, 1, 1); PG8_STAGEB(PG8_SB(1, 0), b3); PG8_STAGEB(PG8_SB(1, 1), b3 + hstep); PG8_STAGE(PG8_SA(1, 0), a3, w00, w01);
            PG8_WAIT_V(8); PG8_WAIT_L(0); PG8_BAR; PG8_MMA(1, 0, At, B0); PG8_MMA(1, 1, At, B1); PG8_BAR; PG8_SCHED;
        }
        if constexpr (FP8) { asm volatile("s_nop 15\n\ts_nop 15" ::: "memory"); }
        if constexpr (ALIGN_EPI) { if (wr == 0) PG8_BAR; }
        E(acc, cur, wr, wc, fr, fq);
        if (!has_next) break;
#pragma unroll
        for (int a = 0; a < 2; ++a)
#pragma unroll
            for (int b = 0; b < 2; ++b)
#pragma unroll
                for (int m = 0; m < 4; ++m)
#pragma unroll
                    for (int n = 0; n < 2; ++n) acc[a][b][m][n] = (f32x4){0.f, 0.f, 0.f, 0.f};
        cur = nxt; cA = nA; cB = nB; ++ui;
        if constexpr (GATHER) {
#pragma unroll
        for (int h_ = 0; h_ < 2; ++h_)
#pragma unroll
            for (int i_ = 0; i_ < 2; ++i_) vc[h_][i_] = vn[h_][i_]; }
        if constexpr (ALIGN_EPI) { if (wr == 1) PG8_BAR; }
    }
    PG8_WAIT_V(0);
    if constexpr (!ALIGN_EPI) { if (wr == 0) PG8_BAR; }
    PG8_BAR;
#undef PG8_SA
#undef PG8_SB
#undef PG8_STAGE
#undef PG8_STAGEB
#undef PG8_LDA
#undef PG8_LDB
#undef PG8_MMA
#undef PG8_CAT8
#undef PG8_RD4
#undef PG8_WAIT_V
#undef PG8_WAIT_L
#undef PG8_BAR
#undef PG8_SCHED
#undef PG8_SETV
}
}

#define XB_TMO      128
#define XB_XCNT(j)  (256  + 64 * (j))
#define XB_XSUB(j)  (1280 + 64 * (j))
#define XB_XGEN(j)  (2304 + 64 * (j))
#define XB_TOP      3328
#define XB_TOPGEN   3392
#define XCD_BAR_WORDS 3456
#define XB_SPIN_CAP (1u << 22)
__device__ __forceinline__ unsigned xb_ld(unsigned* p)              { return __hip_atomic_load(p, __ATOMIC_RELAXED, __HIP_MEMORY_SCOPE_AGENT); }
__device__ __forceinline__ unsigned xb_add(unsigned* p, unsigned v) { return __hip_atomic_fetch_add(p, v, __ATOMIC_RELAXED, __HIP_MEMORY_SCOPE_AGENT); }
__device__ __forceinline__ unsigned xb_xcc_id() { return (unsigned)__builtin_amdgcn_s_getreg((3 << 11) | 20) & 0xFu; }
#define XB_SPIN(cond, bar) do { unsigned _sp = 0; while (cond) { __builtin_amdgcn_s_sleep(1); \
    if ((++_sp & 255u) == 0u) { if (xb_ld(&(bar)[XB_TMO])) break; if (_sp > XB_SPIN_CAP) { atomicAdd(&(bar)[XB_TMO], 1u); break; } } } } while (0)
struct XcdBarrier { unsigned* bar; unsigned x; volatile LAS unsigned* st; };
__device__ __forceinline__ XcdBarrier xcd_barrier_post(unsigned* bar, volatile LAS unsigned* st) {
    XcdBarrier b; b.bar = bar; b.x = xb_xcc_id(); b.st = st;
    if (threadIdx.x == 0) (void)xb_add(&bar[XB_XCNT(b.x)], 1u);
    return b;
}
__device__ __forceinline__ void xcd_barrier_complete(unsigned* bar, unsigned x, unsigned& nloc, unsigned& nx) {
    const unsigned G = gridDim.x * gridDim.y * gridDim.z;
    unsigned sum, cnt, mine, sp = 0u;
    for (;;) {
        sum = 0u; cnt = 0u; mine = 0u;
#pragma unroll
        for (unsigned j = 0; j < 16; ++j) { const unsigned c = xb_ld(&bar[XB_XCNT(j)]); sum += c; cnt += (c > 0u) ? 1u : 0u; mine = (j == x) ? c : mine; }
        if (sum == G) break;
        __builtin_amdgcn_s_sleep(1);
        if ((++sp & 255u) == 0u) { if (xb_ld(&bar[XB_TMO])) break; if (sp > XB_SPIN_CAP) { atomicAdd(&bar[XB_TMO], 1u); break; } }
    }
    nloc = mine > 0u ? mine : 1u; nx = cnt > 0u ? cnt : 1u;
}
__device__ __forceinline__ void xcd_barrier(const XcdBarrier& b) {
    asm volatile("s_waitcnt vmcnt(0)" ::: "memory");
    __syncthreads();
    if (threadIdx.x == 0) {
        unsigned* bar = b.bar;
        __builtin_amdgcn_s_waitcnt(0);
        unsigned nloc = b.st[0], nx = b.st[1];
        if (nloc == 0u) { xcd_barrier_complete(bar, b.x, nloc, nx); b.st[0] = nloc; b.st[1] = nx; }
        const unsigned old = xb_add(&bar[XB_XSUB(b.x)], 1u);
        const unsigned gen = old / nloc;
        if (old + 1u == (gen + 1u) * nloc) {
            __builtin_amdgcn_fence(__ATOMIC_RELEASE, "agent");
            asm volatile("s_waitcnt vmcnt(0)" ::: "memory");
            const unsigned og = xb_add(&bar[XB_TOP], 1u);
            const unsigned tg = og / nx;
            if (og + 1u == (tg + 1u) * nx) xb_add(&bar[XB_TOPGEN], 1u);
            else XB_SPIN(xb_ld(&bar[XB_TOPGEN]) == tg, bar);
            __builtin_amdgcn_fence(__ATOMIC_ACQUIRE, "agent");
            xb_add(&bar[XB_XGEN(b.x)], 1u);
            asm volatile("s_waitcnt vmcnt(0)" ::: "memory");
        } else {
            XB_SPIN(xb_ld(&bar[XB_XGEN(b.x)]) == gen, bar);
            __builtin_amdgcn_fence(__ATOMIC_ACQUIRE, "agent");
            asm volatile("s_waitcnt vmcnt(0)" ::: "memory");
        }
    }
    __syncthreads();
}

struct Args { const void* in[26]; float* out; unsigned char* ws; int ph_lo, ph_hi, li, pad; };
enum { I_X = 0, I_C, I_POS, I_ADAW, I_ADAB, I_N1G, I_N2G, I_WIN, I_WOUT, I_SGLNG, I_SGLNB, I_SGW, I_SGB, I_PEK, I_PEV, I_CW1K, I_CW2K, I_CW1V, I_CW2V, I_RW, I_RB, I_EW1, I_EB1, I_EW2, I_EB2, I_FING };

#define GAS1 __attribute__((address_space(1)))
#define INP(A_, T_, i_) ({ int ix_ = (i_); asm volatile("" : "+s"(ix_)); (const T_*)(const GAS1 T_*)(A_).in[ix_]; })
struct Frame {
    LAS unsigned char* lds;
    unsigned* ctl;
    unsigned char* ws;
    int tid, lane, wave, vcu, G;
};
#define WSP(type, off) ((type*)(F.ws + (off)))
#define MODP(l, b, part) ((const float*)(F.ctl + CW_MOD) + ((size_t)((l) * 2 + (b)) * 6 + (part)) * 1024)

constexpr int RING_BYTES = 131072;
constexpr int ATT_LDS_BYTES = 147456;
constexpr int LDSCTL_OFF = ATT_LDS_BYTES;
constexpr int MISC_OFF = LDSCTL_OFF + 320;
constexpr int MOE_OFF = MISC_OFF + 128;
constexpr int LDS_BYTES = 163840;

struct EpiProj {
    static constexpr bool PERM = true;
    bf16_t *UG, *VG, *Q, *KC, *VC, *KS, *KW, *VST, *VWT; float* GATES; const float* ROPE; unsigned* kmax;
    __device__ __forceinline__ void operator()(const f32x4 (&acc)[2][2][4][2], const pg8::Unit& u, int wr, int wc, int fr, int fq) const {
        const int pn = u.pn; const int row0 = u.pm * 256 + wr * 64 + fr; const int b = u.pm >> 5;
        if (pn < 4 || pn == 6) {
#pragma unroll
            for (int ai = 0; ai < 2; ++ai)
#pragma unroll
                for (int m = 0; m < 4; ++m) { const size_t r = (size_t)(row0 + ai * 128 + m * 16);
#pragma unroll
                    for (int bj = 0; bj < 2; ++bj) { f32x4 v0 = acc[ai][bj][m][0], v1 = acc[ai][bj][m][1];
                        if (pn < 4) {
#pragma unroll
                            for (int i = 0; i < 4; ++i) { v0[i] = gelu_tanh(v0[i]); v1[i] = gelu_tanh(v1[i]); } }
                        u32x4 w; w.x = cvtpk(v0[0], v0[1]); w.y = cvtpk(v0[2], v0[3]); w.z = cvtpk(v1[0], v1[1]); w.w = cvtpk(v1[2], v1[3]);
                        bf16_t* dst;
                        if (pn < 2) dst = UG + r * 512 + pn * 256 + bj * 128 + wc * 32 + fq * 8;
                        else if (pn < 4) dst = VG + r * 512 + (pn - 2) * 256 + bj * 128 + wc * 32 + fq * 8;
                        else dst = (bj ? VC : KC) + r * 128 + wc * 32 + fq * 8;
                        *(u32x4*)dst = w; } }
        } else if (pn == 4 || pn == 5 || pn == 7) {
            const float sc = (pn == 7) ? 1.f : QSCALE; float nmax = 0.f;
#pragma unroll
            for (int ai = 0; ai < 2; ++ai)
#pragma unroll
                for (int m = 0; m < 4; ++m) { const size_t r = (size_t)(row0 + ai * 128 + m * 16);
                    const f32x4* cs = (const f32x4*)(ROPE + (r * 32 + fq * 8) * 2);
                    float o1[8], o2[8], nsq = 0.f;
#pragma unroll
                    for (int n = 0; n < 2; ++n) { const f32x4 c0 = cs[2 * n], c1 = cs[2 * n + 1]; const f32x4 x1 = acc[ai][0][m][n], x2 = acc[ai][1][m][n];
                        const float cc[4] = {c0[0], c0[2], c1[0], c1[2]}, ss[4] = {c0[1], c0[3], c1[1], c1[3]};
#pragma unroll
                        for (int i = 0; i < 4; ++i) { o1[4 * n + i] = (x1[i] * cc[i] - x2[i] * ss[i]) * sc; o2[4 * n + i] = (x2[i] * cc[i] + x1[i] * ss[i]) * sc; nsq += x1[i] * x1[i] + x2[i] * x2[i]; } }
                    u32x4 w1, w2; w1.x = cvtpk(o1[0], o1[1]); w1.y = cvtpk(o1[2], o1[3]); w1.z = cvtpk(o1[4], o1[5]); w1.w = cvtpk(o1[6], o1[7]);
                    w2.x = cvtpk(o2[0], o2[1]); w2.y = cvtpk(o2[2], o2[3]); w2.z = cvtpk(o2[4], o2[5]); w2.w = cvtpk(o2[6], o2[7]);
                    if (pn != 7) { bf16_t* dst = Q + r * 512 + (4 * (pn - 4) + wc) * 64 + fq * 8; *(u32x4*)dst = w1; *(u32x4*)(dst + 32) = w2; }
                    else { bf16_t* img = ((wc < 2) ? KS : KW) + (size_t)(b * 2 + (wc & 1)) * SEQ * 64; const int t = (int)r & (SEQ - 1);
                        *(u32x4*)(img + kfrag_off(t, fq)) = w1; *(u32x4*)(img + kfrag_off(t, 4 + fq)) = w2; }
                    nsq = kg_sum(nsq); nmax = fmaxf(nmax, nsq); }
            if (pn == 7) {
#pragma unroll
                for (int o = 1; o < 16; o <<= 1) nmax = fmaxf(nmax, __shfl_xor(nmax, o));
                if ((threadIdx.x & 63) == 0) atomicMax(kmax + ((wc < 2) ? 0 : 8) + b * 2 + (wc & 1), __float_as_uint(nmax * 1.02f));
            }
        } else if (pn == 8) {
            const int g = wc >> 1; float vmx = 0.f;
#pragma unroll
            for (int ai = 0; ai < 2; ++ai)
#pragma unroll
                for (int m = 0; m < 4; ++m) { const int r = row0 + ai * 128 + m * 16; const int s = r & (SEQ - 1);
#pragma unroll
                    for (int bj = 0; bj < 2; ++bj) { bf16_t* img = (bj ? VWT : VST) + (size_t)(b * 2 + g) * SEQ * 64;
#pragma unroll
                        for (int n = 0; n < 2; ++n)
#pragma unroll
                            for (int i = 0; i < 4; ++i) { img[vfrag_off(s, (wc & 1) * 32 + fq * 8 + n * 4 + i)] = (bf16_t)(cvtpk(acc[ai][bj][m][n][i], 0.f) & 0xffffu); if (bj == 0) vmx = fmaxf(vmx, fabsf(acc[ai][0][m][n][i])); } } }
#pragma unroll
            for (int o = 1; o < 64; o <<= 1) vmx = fmaxf(vmx, __shfl_xor(vmx, o));
            if ((threadIdx.x & 63) == 0) atomicMax(kmax + 4 + b * 2 + g, __float_as_uint(vmx * 1.01f));
        } else {
            if (wc == 0 && fq < 3) {
#pragma unroll
                for (int ai = 0; ai < 2; ++ai)
#pragma unroll
                    for (int m = 0; m < 4; ++m) { const size_t r = (size_t)(row0 + ai * 128 + m * 16);
#pragma unroll
                        for (int n = 0; n < 2; ++n) { f32x4 v = acc[ai][0][m][n];
#pragma unroll
                            for (int i = 0; i < 4; ++i) v[i] = sigmoidf_(v[i]);
                            *(f32x4*)(GATES + r * 24 + fq * 8 + n * 4) = v; } }
            }
        }
    }
};
struct EpiOut {
    static constexpr bool PERM = false;
    const float* xin; float* xout; const float* g1;
    __device__ __forceinline__ void operator()(const f32x4 (&acc)[2][2][4][2], const pg8::Unit& u, int wr, int wc, int fr, int fq) const {
        const int row0 = u.pm * 256 + wr * 64 + fr; const int b = u.pm >> 5; const int col0 = u.pn * 256 + wc * 32 + fq * 4;
        const float* gb = g1 + (size_t)b * 6144 + 2048;
        f32x4 gv[2][2];
#pragma unroll
        for (int bj = 0; bj < 2; ++bj)
#pragma unroll
            for (int n = 0; n < 2; ++n) gv[bj][n] = *(const f32x4*)(gb + col0 + bj * 128 + n * 16);
#pragma unroll
        for (int ai = 0; ai < 2; ++ai)
#pragma unroll
            for (int m = 0; m < 4; ++m) { const size_t off = (size_t)(row0 + ai * 128 + m * 16) * DM + col0;
#pragma unroll
                for (int bj = 0; bj < 2; ++bj)
#pragma unroll
                    for (int n = 0; n < 2; ++n) { const f32x4 xi = *(const f32x4*)(xin + off + bj * 128 + n * 16); *(f32x4*)(xout + off + bj * 128 + n * 16) = xi + gv[bj][n] * acc[ai][bj][m][n]; } }
    }
};
struct EpiSwiglu {
    static constexpr bool PERM = true;
    unsigned char* ACT; const float* b1;
    __device__ __forceinline__ void operator()(const f32x4 (&acc)[2][2][4][2], const pg8::Unit& u, int wr, int wc, int fr, int fq) const {
        const int row0 = u.pm * 256 + wr * 64 + fr; const int j0 = u.pnl * 128 + wc * 32 + fq * 8;
        const float* bb = b1 + (size_t)u.e * 2048 + j0;
        f32x4 bg[2], bl[2];
#pragma unroll
        for (int n = 0; n < 2; ++n) { bg[n] = *(const f32x4*)(bb + n * 4); bl[n] = *(const f32x4*)(bb + 1024 + n * 4); }
#pragma unroll
        for (int ai = 0; ai < 2; ++ai)
#pragma unroll
            for (int m = 0; m < 4; ++m) { float o[8];
#pragma unroll
                for (int n = 0; n < 2; ++n) { const f32x4 gl = acc[ai][0][m][n] + bg[n], ln = acc[ai][1][m][n] + bl[n];
#pragma unroll
                    for (int i = 0; i < 4; ++i) { const float gg = fminf(gl[i], 7.f), ll = fminf(fmaxf(ln[i], -7.f), 7.f); o[n * 4 + i] = gg * sigmoidf_(1.702f * gg) * (ll + 1.f); } }
                u32x2 w; w.x = cvt4_fp8(o[0], o[1], o[2], o[3]); w.y = cvt4_fp8(o[4], o[5], o[6], o[7]);
                *(u32x2*)(ACT + (size_t)(row0 + ai * 128 + m * 16) * FF + j0) = w; }
    }
};
struct EpiDown {
    static constexpr bool PERM = true;
    bf16_t* YR; const float* b2;
    __device__ __forceinline__ void operator()(const f32x4 (&acc)[2][2][4][2], const pg8::Unit& u, int wr, int wc, int fr, int fq) const {
        const int row0 = u.pm * 256 + wr * 64 + fr; const int c0 = u.pnl * 256 + wc * 32 + fq * 8;
        const float* bb = b2 + (size_t)u.e * 1024 + c0;
        f32x4 bv[2][2];
#pragma unroll
        for (int bj = 0; bj < 2; ++bj)
#pragma unroll
            for (int n = 0; n < 2; ++n) bv[bj][n] = *(const f32x4*)(bb + bj * 128 + n * 4);
#pragma unroll
        for (int ai = 0; ai < 2; ++ai)
#pragma unroll
            for (int m = 0; m < 4; ++m)
#pragma unroll
                for (int bj = 0; bj < 2; ++bj) { const f32x4 v0 = acc[ai][bj][m][0] + bv[bj][0], v1 = acc[ai][bj][m][1] + bv[bj][1];
                    u32x4 w; w.x = cvtpk(v0[0], v0[1]); w.y = cvtpk(v0[2], v0[3]); w.z = cvtpk(v1[0], v1[1]); w.w = cvtpk(v1[2], v1[3]);
                    *(u32x4*)(YR + (size_t)(row0 + ai * 128 + m * 16) * DM + c0 + bj * 128) = w; }
    }
};

__device__ __forceinline__ void tr_item(const float* W, int ldn, int k0, int c0, int nvalid, bf16_t* WT, int K, int drow0, LAS float* scr, int lane) {
    const int nn = lane & 31;
#pragma unroll 8
    for (int i = 0; i < 32; ++i) { const int kk = 2 * i + (lane >> 5); scr[kk * 33 + nn] = (nn < nvalid) ? W[(size_t)(k0 + kk) * ldn + c0 + nn] : 0.f; }
    LDS_WAIT(); asm volatile("" ::: "memory");
    const int c = lane & 7;
#pragma unroll
    for (int j = 0; j < 4; ++j) { const int n = (lane >> 3) + 8 * j; const LAS float* s = scr + (8 * c) * 33 + n;
        u32x4 o; o.x = cvtpk(s[0 * 33], s[1 * 33]); o.y = cvtpk(s[2 * 33], s[3 * 33]); o.z = cvtpk(s[4 * 33], s[5 * 33]); o.w = cvtpk(s[6 * 33], s[7 * 33]);
        *(u32x4*)(WT + (size_t)(drow0 + n) * K + k0 + 8 * c) = o; }
    LDS_WAIT(); asm volatile("" ::: "memory");
}
template <bool NTS> __device__ __forceinline__ void tr_item8(const float* W, int ldn, int k0, int c0, unsigned char* W8, int K, int drow0, LAS float* scr, int lane) {
    const int nn = lane & 31;
#pragma unroll 8
    for (int i = 0; i < 32; ++i) { const int kk = 2 * i + (lane >> 5); scr[kk * 33 + nn] = __builtin_nontemporal_load(W + (size_t)(k0 + kk) * ldn + c0 + nn) * W8SCALE; }
    LDS_WAIT(); asm volatile("" ::: "memory");
    const int c = lane & 3;
#pragma unroll
    for (int j = 0; j < 2; ++j) { const int n = (lane >> 2) + 16 * j; const LAS float* s = scr + (16 * c) * 33 + n;
        u32x4 o; o.x = cvt4_fp8(s[0 * 33], s[1 * 33], s[2 * 33], s[3 * 33]); o.y = cvt4_fp8(s[4 * 33], s[5 * 33], s[6 * 33], s[7 * 33]);
        o.z = cvt4_fp8(s[8 * 33], s[9 * 33], s[10 * 33], s[11 * 33]); o.w = cvt4_fp8(s[12 * 33], s[13 * 33], s[14 * 33], s[15 * 33]);
        if (NTS) __builtin_nontemporal_store(o, (u32x4*)(W8 + (size_t)(drow0 + n) * K + k0 + 16 * c)); else *(u32x4*)(W8 + (size_t)(drow0 + n) * K + k0 + 16 * c) = o; }
    LDS_WAIT(); asm volatile("" ::: "memory");
}
__device__ __forceinline__ void win_src(int p, int& c0, int& nvalid) {
    const int pn = p >> 8; nvalid = 32;
    if (pn < 4 || pn == 6) { c0 = p; }
    else if (pn == 4 || pn == 5) { const int pp = p - 1024 - 256 * (pn - 4), bj = pp >> 7, j = pp & 127; c0 = 1024 + (4 * (pn - 4) + (j >> 5)) * 64 + bj * 32; }
    else if (pn == 7) { const int pp = p - 1792, bj = pp >> 7, j = pp & 127, which = j >> 6, g = (j >> 5) & 1; c0 = (which ? 2048 : 1792) + g * 64 + bj * 32; }
    else if (pn == 8) { const int pp = p - 2048, bj = pp >> 7, j = pp & 127; c0 = (bj ? 2176 : 1920) + j; }
    else { const int pp = p - 2304; c0 = 2304 + pp; nvalid = 24 - pp; nvalid = nvalid < 0 ? 0 : (nvalid > 32 ? 32 : nvalid); if (nvalid == 0) c0 = 0; }
}
__device__ __forceinline__ void phase_prologue(Frame& F, const Args& a) {
    LAS float* scr = (LAS float*)(F.lds + F.wave * 8704);
    const int gw = F.vcu * NWAVES + F.wave, NGW = F.G * NWAVES; const int lane = F.lane;
    {
        const float* c = INP(a, float, I_C); const float* adaw = INP(a, float, I_ADAW); const float* adab = INP(a, float, I_ADAB);
        float* mod = (float*)(F.ctl + CW_MOD);
        LAS float* red = (LAS float*)(F.lds + 8 * 8704);
        for (int it = F.vcu; it < 2 * 24; it += F.G) {
            const int l = it / 24, nb = it % 24;
            const float* wp = adaw + ((size_t)l * 1024 + F.wave * 128) * 6144 + nb * 256 + lane * 4;
            f32x4 a0 = {0.f, 0.f, 0.f, 0.f}, a1 = a0;
#pragma unroll 4
            for (int k = 0; k < 128; ++k) { const f32x4 w = __builtin_nontemporal_load((const f32x4*)(wp + (size_t)k * 6144));
                const float c0 = c[F.wave * 128 + k], c1 = c[1024 + F.wave * 128 + k]; const float s0 = c0 * sigmoidf_(c0), s1 = c1 * sigmoidf_(c1);
                a0 += w * s0; a1 += w * s1; }
            *(LAS f32x4*)(red + (F.wave * 2 + 0) * 256 + lane * 4) = a0; *(LAS f32x4*)(red + (F.wave * 2 + 1) * 256 + lane * 4) = a1;
            __syncthreads();
            { const int b = F.tid >> 8, col = F.tid & 255; float sum = adab[(size_t)l * 6144 + nb * 256 + col];
#pragma unroll
              for (int ww = 0; ww < 8; ++ww) sum += red[(ww * 2 + b) * 256 + col];
              mod[((size_t)l * 2 + b) * 6144 + nb * 256 + col] = sum; }
            __syncthreads();
        }
    }
    {
        const float* win = INP(a, float, I_WIN); bf16_t* WinT = WSP(bf16_t, WS_WIN);
        for (int it = gw; it < 2 * 16 * 80; it += NGW) { const int l = it / 1280, kb = (it % 1280) / 80, nb = it % 80; int c0, nv; win_src(nb * 32, c0, nv);
            tr_item(win + (size_t)l * 1024 * PIN, PIN, kb * 64, c0, nv, WinT + (size_t)l * PINP * 1024, 1024, nb * 32, scr, lane); }
        const float* wout = INP(a, float, I_WOUT); bf16_t* WoutT = WSP(bf16_t, WS_WOUT);
        for (int it = gw; it < 2 * 16 * 32; it += NGW) { const int l = it / 512, kb = (it % 512) / 32, nb = it % 32;
            tr_item(wout + (size_t)l * 1024 * 1024, 1024, kb * 64, nb * 32, 32, WoutT + (size_t)l * 1024 * 1024, 1024, nb * 32, scr, lane); }
        bf16_t* CW1 = WSP(bf16_t, WS_CW1);
        for (int it = gw; it < 2 * 2 * 32 * 2; it += NGW) { const int l = it / 128, which = (it / 64) & 1, kb = (it % 64) / 2, nb = it & 1;
            const float* src = INP(a, float, which ? I_CW1V : I_CW1K) + (size_t)l * 2048 * 64;
            tr_item(src, 64, kb * 64, nb * 32, 32, CW1 + (size_t)(l * 2 + which) * 64 * 2048, 2048, nb * 32, scr, lane); }
        const float* ew1 = INP(a, float, I_EW1); unsigned char* W1T = WSP(unsigned char, WS_W1T);
        for (int it = gw; it < 2 * 32 * 16 * 64; it += NGW) { const int le = it >> 10, kb = (it >> 6) & 15, nb = it & 63; const int p = nb * 32, tile = p >> 8, bj = (p >> 7) & 1, j = p & 127;
            if (le < 32) tr_item8<false>(ew1 + (size_t)le * 1024 * 2048, 2048, kb * 64, bj * 1024 + tile * 128 + j, W1T + (size_t)le * 2048 * 1024, 1024, p, scr, lane);
            else tr_item8<true>(ew1 + (size_t)le * 1024 * 2048, 2048, kb * 64, bj * 1024 + tile * 128 + j, W1T + (size_t)le * 2048 * 1024, 1024, p, scr, lane); }
        const float* ew2 = INP(a, float, I_EW2); unsigned char* W2T = WSP(unsigned char, WS_W2T);
        for (int it = gw; it < 2 * 32 * 16 * 32; it += NGW) { const int le = it >> 9, kb = (it >> 5) & 15, nb = it & 31;
            if (le < 32) tr_item8<false>(ew2 + (size_t)le * 1024 * 1024, 1024, kb * 64, nb * 32, W2T + (size_t)le * 1024 * 1024, 1024, nb * 32, scr, lane);
            else tr_item8<true>(ew2 + (size_t)le * 1024 * 1024, 1024, kb * 64, nb * 32, W2T + (size_t)le * 1024 * 1024, 1024, nb * 32, scr, lane); }
    }
    {
        const int gt = (F.vcu * NWAVES + F.wave) * 64 + lane, NGT = NGW * 64;
        const float* sgw = INP(a, float, I_SGW); bf16_t* SGW = WSP(bf16_t, WS_SGW);
        for (int i = gt; i < 2 * 8 * 128 * 128; i += NGT) { const int s = i & 127, t = (i >> 7) & 127; SGW[i] = (bf16_t)(cvtpk(s <= t ? sgw[i] : 0.f, 0.f) & 0xffffu); }
        const int* pos = INP(a, int, I_POS); float* rope = WSP(float, WS_ROPE);
        for (int i = gt; i < T * 32; i += NGT) { const int tok = i >> 5, d = i & 31;
            const double inv = exp2(-(double)d * (13.287712379549449 / 32.0));
            const double rv = (double)pos[tok] * inv * 0.15915494309189535; const float fr = (float)(rv - __builtin_rint(rv));
            rope[2 * i] = __builtin_amdgcn_cosf(fr); rope[2 * i + 1] = __builtin_amdgcn_sinf(fr); }
        bf16_t* H = WSP(bf16_t, WS_H);
        for (int i = gt; i < 1024; i += NGT) { H[(size_t)T * 1024 + i] = 0; WSP(unsigned char, WS_H8)[(size_t)T * 1024 + i] = 0; }
        bf16_t* KCMP = WSP(bf16_t, WS_KCMP); bf16_t* VCT = WSP(bf16_t, WS_VCT);
        for (int i = gt; i < 2 * 2 * 64; i += NGT) { const int b = i >> 7, g = (i >> 6) & 1, d = i & 63; KCMP[(size_t)(b * 2 + g) * 512 * 64 + kfrag_off(511, d >> 3) + (d & 7)] = 0; VCT[(size_t)(b * 2 + g) * 512 * 64 + vfrag_off(511, d)] = 0; }
    }
    {
        float* cb = WSP(float, WS_MISC);
        for (int it = gw; it < 2 * 2 * 64; it += NGW) { const int l = it >> 7, which = (it >> 6) & 1, n = it & 63;
            const float* pe = INP(a, float, which ? I_PEV : I_PEK) + (size_t)l * 2048; const float* w1 = INP(a, float, which ? I_CW1V : I_CW1K) + (size_t)l * 2048 * 64;
            float s = 0.f; for (int k = lane; k < 2048; k += 64) s += pe[k] * w1[(size_t)k * 64 + n];
            s = wave_sum(s); if (lane == 0) cb[it] = s; }
    }
}

struct RowV { f32x4 v[4]; };
__device__ __forceinline__ RowV row_load(const float* p, int lane) { RowV r; const f32x4* q = (const f32x4*)p + lane;
#pragma unroll
    for (int j = 0; j < 4; ++j) r.v[j] = q[64 * j]; return r; }
__device__ __forceinline__ float row_ssq(const RowV& r) { float s = 0.f;
#pragma unroll
    for (int j = 0; j < 4; ++j) s += (r.v[j].x * r.v[j].x + r.v[j].y * r.v[j].y) + (r.v[j].z * r.v[j].z + r.v[j].w * r.v[j].w); return wave_sum(s); }
__device__ __forceinline__ void row_norm_store(const RowV& x, float rstd, const float* g, const float* sc, const float* sh, bf16_t* orow, int lane) {
    u32x2* o8 = (u32x2*)orow + lane;
#pragma unroll
    for (int j = 0; j < 4; ++j) { const f32x4 gg = ((const f32x4*)g)[lane + 64 * j], ss = ((const f32x4*)sc)[lane + 64 * j], hh = ((const f32x4*)sh)[lane + 64 * j];
        const f32x4 y = x.v[j] * rstd * gg * (ss + 1.f) + hh; u32x2 w; w.x = cvtpk(y.x, y.y); w.y = cvtpk(y.z, y.w); o8[64 * j] = w; }
}
__device__ __forceinline__ void row_norm_store8(const RowV& x, float rstd, const float* g, const float* sc, const float* sh, unsigned char* orow, int lane) {
    unsigned* o4 = (unsigned*)orow + lane;
#pragma unroll
    for (int j = 0; j < 4; ++j) { const f32x4 gg = ((const f32x4*)g)[lane + 64 * j], ss = ((const f32x4*)sc)[lane + 64 * j], hh = ((const f32x4*)sh)[lane + 64 * j];
        const f32x4 y = x.v[j] * rstd * gg * (ss + 1.f) + hh; o4[64 * j] = cvt4_fp8(y.x, y.y, y.z, y.w); }
}
__device__ __forceinline__ int expert_block_prefix(const unsigned* cnt, int lane) {
    int nb = (lane < NE) ? (int)((cnt[lane] + 255u) >> 8) : 0; int inc = nb;
#pragma unroll
    for (int o = 1; o < 32; o <<= 1) { const int t = __shfl_up(inc, o); if ((lane & 31) >= o) inc += t; }
    return inc - nb;
}
__device__ __forceinline__ void phase_n1_first(Frame& F, const Args& a) {
    const int gw = F.vcu * NWAVES + F.wave, NGW = F.G * NWAVES; const int lane = F.lane;
    const float* x = INP(a, float, I_X); const float* g = INP(a, float, I_N1G); bf16_t* H = WSP(bf16_t, WS_H);
    for (int m = gw; m < T; m += 2 * NGW) { const int m2 = m + NGW; const int b = m >> 13, b2 = m2 >> 13;
        const RowV r = row_load(x + (size_t)m * DM, lane); const RowV r2 = row_load(x + (size_t)m2 * DM, lane);
        const float rstd = 1.f / sqrtf(row_ssq(r) * (1.f / DM) + NORM_EPS), rstd2 = 1.f / sqrtf(row_ssq(r2) * (1.f / DM) + NORM_EPS);
        row_norm_store(r, rstd, g, MODP(0, b, 1), MODP(0, b, 0), H + (size_t)m * DM, lane);
        row_norm_store(r2, rstd2, g, MODP(0, b2, 1), MODP(0, b2, 0), H + (size_t)m2 * DM, lane); }
    float* RWP = WSP(float, WS_RWP); float* RBP = WSP(float, WS_MISC + 4096);
    const float* rw = INP(a, float, I_RW); const float* rb = INP(a, float, I_RB); const float* n2g = INP(a, float, I_N2G);
    const int gt = gw * 64 + lane, NGT = NGW * 64;
    for (int i = gt; i < 2 * 2 * 1024 * 32; i += NGT) { const int l = i >> 16, b = (i >> 15) & 1, k = (i >> 5) & 1023, e = i & 31;
        RWP[i] = n2g[l * 1024 + k] * (1.f + MODP(l, b, 4)[k]) * rw[((size_t)l * 1024 + k) * 32 + e]; }
    for (int it = gw; it < 2 * 2 * 32; it += NGW) { const int l = it >> 6, b = (it >> 5) & 1, e = it & 31; float s = 0.f;
        for (int k = lane; k < 1024; k += 64) s += MODP(l, b, 3)[k] * rw[((size_t)l * 1024 + k) * 32 + e];
        s = wave_sum(s); if (lane == 0) RBP[it] = s + rb[l * 32 + e]; }
}
__device__ __forceinline__ void phase_combine(Frame& F, const Args& a, int l) {
    const int gw = F.vcu * NWAVES + F.wave, NGW = F.G * NWAVES; const int lane = F.lane;
    float* XR = WSP(float, WS_XR); bf16_t* H = WSP(bf16_t, WS_H); const bf16_t* YR = WSP(bf16_t, WS_YROWS);
    const int* ASG = WSP(int, WS_ASG); const float* G4 = WSP(float, WS_GATE4);
    const int myprefix = expert_block_prefix(F.ctl + CW_CNT + l * 32, lane);
    const bool last = (l == DEPTH - 1);
    const float* g = last ? INP(a, float, I_FING) : INP(a, float, I_N1G) + (l + 1) * 1024;
#define COMB_LOAD(R_, WV_, GT_, M_) do { const int4 as4_ = *(const int4*)(ASG + (M_) * 4); const f32x4 gt4_ = *(const f32x4*)(G4 + (M_) * 4); \
        R_ = row_load(XR + (size_t)(M_) * DM, lane); const int asv_[4] = {as4_.x, as4_.y, as4_.z, as4_.w}; GT_[0] = gt4_.x; GT_[1] = gt4_.y; GT_[2] = gt4_.z; GT_[3] = gt4_.w; \
        _Pragma("unroll") for (int k = 0; k < 4; ++k) { const int e = asv_[k] >> 16, slot = asv_[k] & 0xffff; const int blk = __shfl(myprefix, e); \
            const u32x2* yr = (const u32x2*)(YR + ((size_t)blk * 256 + slot) * DM) + lane; _Pragma("unroll") for (int j = 0; j < 4; ++j) WV_[k][j] = __builtin_nontemporal_load(yr + 64 * j); } } while (0)
#define COMB_FINISH(R_, WV_, GT_, M_) do { const int b = (M_) >> 13; f32x4 y[4]; \
        _Pragma("unroll") for (int j = 0; j < 4; ++j) y[j] = (f32x4){0.f, 0.f, 0.f, 0.f}; \
        _Pragma("unroll") for (int k = 0; k < 4; ++k) _Pragma("unroll") for (int j = 0; j < 4; ++j) { const u32x2 w = WV_[k][j]; y[j] += (f32x4){bflo(w.x), bfhi(w.x), bflo(w.y), bfhi(w.y)} * GT_[k]; } \
        const float* g2 = MODP(l, b, 5); \
        _Pragma("unroll") for (int j = 0; j < 4; ++j) R_.v[j] += ((const f32x4*)g2)[lane + 64 * j] * y[j]; \
        const float rstd = 1.f / sqrtf(row_ssq(R_) * (1.f / DM) + NORM_EPS); \
        if (last) { f32x4* o = (f32x4*)(a.out + (size_t)(M_) * DM) + lane; _Pragma("unroll") for (int j = 0; j < 4; ++j) o[64 * j] = R_.v[j] * rstd * ((const f32x4*)g)[lane + 64 * j]; } \
        else { f32x4* xo = (f32x4*)(XR + (size_t)(M_) * DM) + lane; _Pragma("unroll") for (int j = 0; j < 4; ++j) xo[64 * j] = R_.v[j]; \
            row_norm_store(R_, rstd, g, MODP(l + 1, b, 1), MODP(l + 1, b, 0), H + (size_t)(M_) * DM, lane); } } while (0)
    for (int m = gw; m < T; m += 2 * NGW) { const int m2 = m + NGW;
        RowV rA, rB; u32x2 wA[4][4], wB[4][4]; float gA[4], gB[4];
        COMB_LOAD(rA, wA, gA, m); COMB_LOAD(rB, wB, gB, m2);
        COMB_FINISH(rA, wA, gA, m); COMB_FINISH(rB, wB, gB, m2);
    }
#undef COMB_LOAD
#undef COMB_FINISH
}
__device__ __forceinline__ void compress_item(Frame& F, const Args& a, int l, int item) {
    const int which = item >> 7, b = (item >> 6) & 1, g = (item >> 5) & 1, n0 = (item & 31) * 16;
    const int lane = F.lane, w = F.wave, r16 = lane & 15, kg = lane >> 4;
    const bf16_t* src = WSP(bf16_t, which ? WS_VC : WS_KC);
    const bf16_t* W1 = WSP(bf16_t, WS_CW1) + (size_t)(l * 2 + which) * 64 * 2048;
    LAS float* red = (LAS float*)F.lds;
    LAS float* hid = (LAS float*)(F.lds + 32768);
    f32x4 acc[4];
#pragma unroll
    for (int i = 0; i < 4; ++i) acc[i] = (f32x4){0.f, 0.f, 0.f, 0.f};
    const int n = n0 + r16; const bool nval = n < NCMP;
#pragma unroll 2
    for (int ks = 0; ks < 8; ++ks) { const int k = 256 * w + 32 * ks + 8 * kg; const int li = k >> 6, d = k & 63;
        bf16x8 af = (bf16x8){0, 0, 0, 0, 0, 0, 0, 0};
        if (nval) af = *(const bf16x8*)(src + ((size_t)b * SEQ + 16 * n + li) * 128 + g * 64 + d);
#pragma unroll
        for (int nt = 0; nt < 4; ++nt) { const bf16x8 bf = *(const bf16x8*)(W1 + (size_t)(nt * 16 + r16) * 2048 + k); acc[nt] = __builtin_amdgcn_mfma_f32_16x16x32_bf16(af, bf, acc[nt], 0, 0, 0); } }
#pragma unroll
    for (int nt = 0; nt < 4; ++nt)
#pragma unroll
        for (int i = 0; i < 4; ++i) red[(w * 16 + 4 * kg + i) * 64 + nt * 16 + r16] = acc[nt][i];
    __syncthreads();
    const float* cb = WSP(float, WS_MISC) + (l * 2 + which) * 64;
    for (int i = F.tid; i < 1024; i += NTHREADS) { float s = cb[i & 63];
#pragma unroll
        for (int ww = 0; ww < 8; ++ww) s += red[ww * 1024 + i];
        hid[i] = gelu_tanh(s); }
    { const float* w2 = INP(a, float, which ? I_CW2V : I_CW2K) + (size_t)l * 4096; LAS f32x4* w2s4 = (LAS f32x4*)(F.lds + 40960);
      for (int i = F.tid; i < 1024; i += NTHREADS) w2s4[i] = ((const f32x4*)w2)[i]; }
    __syncthreads();
    {
        const int nn = F.tid >> 5, c = F.tid & 31; LAS float* w2s = (LAS float*)(F.lds + 40960);
        float o1 = 0.f, o2 = 0.f;
#pragma unroll 16
        for (int k = 0; k < 64; ++k) { const float h = hid[nn * 64 + k]; o1 += h * w2s[k * 64 + c]; o2 += h * w2s[k * 64 + c + 32]; }
        const int np = n0 + nn; float nsq_ = 0.f;
        if (np < NCMP) {
            if (!which) { const float* cs = WSP(float, WS_ROPE) + (((size_t)b * SEQ + 16 * np + 31) * 32 + c) * 2; const float cc = cs[0], ss = cs[1];
                const float r1 = o1 * cc - o2 * ss, r2 = o2 * cc + o1 * ss;
                bf16_t* img = WSP(bf16_t, WS_KCMP) + (size_t)(b * 2 + g) * 512 * 64; img[kfrag_off(np, c >> 3) + (c & 7)] = (bf16_t)(cvtpk(r1, 0.f) & 0xffffu); img[kfrag_off(np, 4 + (c >> 3)) + (c & 7)] = (bf16_t)(cvtpk(r2, 0.f) & 0xffffu);
                nsq_ = r1 * r1 + r2 * r2;
            } else { bf16_t* img = WSP(bf16_t, WS_VCT) + (size_t)(b * 2 + g) * 512 * 64; img[vfrag_off(np, c)] = (bf16_t)(cvtpk(o1, 0.f) & 0xffffu); img[vfrag_off(np, c + 32)] = (bf16_t)(cvtpk(o2, 0.f) & 0xffffu); }
        }
        if (!which) {
            float mx = quad_sum(nsq_);
            mx += __uint_as_float(__builtin_amdgcn_update_dpp(0u, __float_as_uint(mx), 0x141, 0xF, 0xF, true)); mx += __uint_as_float(__builtin_amdgcn_update_dpp(0u, __float_as_uint(mx), 0x140, 0xF, 0xF, true));
            mx = x16_sum(mx);
            mx = x32_max(mx);
            if (F.lane == 0) atomicMax(F.ctl + CW_KMAX + l * 16 + 12 + b * 2 + g, __float_as_uint(mx * 1.02f));
        }
    }
    __syncthreads();
}
__device__ __forceinline__ void sgu_item(Frame& F, const Args& a, int l, int ch) {
    const size_t tok0 = (size_t)ch * 128;
    const int lane = F.lane, w = F.wave, r16 = lane & 15, kg = lane >> 4;
    const bf16_t* VG = WSP(bf16_t, WS_VG); const bf16_t* UG = WSP(bf16_t, WS_UG); bf16_t* Y = WSP(bf16_t, WS_Y);
    LAS float* stats = (LAS float*)F.lds;
    LAS bf16_t* vnT = (LAS bf16_t*)(F.lds + 1024);
    constexpr int VP = 136;
    static_assert(1024 + 8 * 64 * 136 * 2 <= ATT_LDS_BYTES, "SGU LDS map");
    {
        u32x4 vrow[16];
#pragma unroll
        for (int tt = 0; tt < 16; ++tt) vrow[tt] = *(const u32x4*)(VG + (tok0 + 16 * w + tt) * 512 + lane * 8);
#pragma unroll
        for (int tt = 0; tt < 16; ++tt) { const int s = 16 * w + tt; const u32x4 v = vrow[tt];
            const float f[8] = {bflo(v.x), bfhi(v.x), bflo(v.y), bfhi(v.y), bflo(v.z), bfhi(v.z), bflo(v.w), bfhi(v.w)};
            float sm = 0.f;
#pragma unroll
            for (int i = 0; i < 8; ++i) sm += f[i];
            const float mu = wave_sum(sm) * (1.f / 512.f); float q = 0.f;
#pragma unroll
            for (int i = 0; i < 8; ++i) q += (f[i] - mu) * (f[i] - mu);
            const float var = wave_sum(q) * (1.f / 512.f);
            if (lane == 0) { stats[2 * s] = mu; stats[2 * s + 1] = 1.f / sqrtf(var + NORM_EPS); } }
    }
    __syncthreads();
    {
        const int s = F.tid & 127, hq = F.tid >> 7; const float mu = stats[2 * s], rs = stats[2 * s + 1];
#pragma unroll
        for (int hp = 0; hp < 2; ++hp) { const int h = hq + 4 * hp; const int cbase = h * 64;
            const float* lg = INP(a, float, I_SGLNG) + l * 512 + cbase; const float* lb = INP(a, float, I_SGLNB) + l * 512 + cbase;
#pragma unroll 2
            for (int d0 = 0; d0 < 64; d0 += 8) { const u32x4 v = *(const u32x4*)(VG + (tok0 + s) * 512 + cbase + d0);
                const float f[8] = {bflo(v.x), bfhi(v.x), bflo(v.y), bfhi(v.y), bflo(v.z), bfhi(v.z), bflo(v.w), bfhi(v.w)};
#pragma unroll
                for (int i = 0; i < 8; ++i) vnT[(h * 64 + d0 + i) * VP + s] = (bf16_t)(cvtpk((f[i] - mu) * rs * lg[d0 + i] + lb[d0 + i], 0.f) & 0xffffu); } }
    }
    __syncthreads();
    {
        const int h = w;
        const bf16_t* Wm = WSP(bf16_t, WS_SGW) + (size_t)(l * 8 + h) * 128 * 128; const float* bs = INP(a, float, I_SGB) + (size_t)(l * 8 + h) * 128;
#pragma nounroll
        for (int tt = 0; tt < 8; ++tt) {
            const int t = 16 * tt + r16; const float bb = bs[t];
            bf16x8 bw[4]; u32x2 ugv[4];
#pragma unroll
            for (int ks = 0; ks < 4; ++ks) bw[ks] = *(const bf16x8*)(Wm + (size_t)t * 128 + 32 * ks + 8 * kg);
#pragma unroll
            for (int dt = 0; dt < 4; ++dt) ugv[dt] = *(const u32x2*)(UG + (tok0 + t) * 512 + h * 64 + dt * 16 + 4 * kg);
            f32x4 acc[4];
#pragma unroll
            for (int i = 0; i < 4; ++i) acc[i] = (f32x4){0.f, 0.f, 0.f, 0.f};
            const int nks = (16 * tt + 15) / 32 + 1;
#pragma unroll
            for (int ks = 0; ks < 4; ++ks) { if (ks < nks) {
#pragma unroll
                for (int dt = 0; dt < 4; ++dt) { const bf16x8 afr = *(const LAS bf16x8*)(vnT + (h * 64 + dt * 16 + r16) * VP + 32 * ks + 8 * kg); acc[dt] = __builtin_amdgcn_mfma_f32_16x16x32_bf16(afr, bw[ks], acc[dt], 0, 0, 0); } } }
#pragma unroll
            for (int dt = 0; dt < 4; ++dt) { const u32x2 uu = ugv[dt];
                u32x2 o; o.x = cvtpk(bflo(uu.x) * (acc[dt][0] + bb), bfhi(uu.x) * (acc[dt][1] + bb)); o.y = cvtpk(bflo(uu.y) * (acc[dt][2] + bb), bfhi(uu.y) * (acc[dt][3] + bb));
                *(u32x2*)(Y + (tok0 + t) * 1024 + h * 64 + dt * 16 + 4 * kg) = o; }
        }
    }
    __syncthreads();
}
namespace att {
constexpr int OSP = 65;
constexpr int L_OH = 0;
constexpr int L_OL = 66560;
constexpr int L_LS = 133120;
constexpr int L_MREF = L_LS + 2048;
constexpr int USP = 129;
constexpr int L_SEL = L_MREF + 1024;
constexpr int L_CNT = L_SEL + 1024;
constexpr int L_LIST = L_CNT + 512;
constexpr int L_WCTR = L_LIST + 8192;
static_assert(L_WCTR + 16 <= ATT_LDS_BYTES, "attention LDS map");

struct Ptrs { const bf16_t *Q, *KS, *KW, *VST, *VWT, *KCMP, *VCT; const float* GATES; bf16_t* Y; float* YPART; float kmax, vmax, kwmax, kcmax; };

#define MFMA16(a, b, c) __builtin_amdgcn_mfma_f32_16x16x32_bf16(a, b, c, 0, 0, 0)

__device__ __forceinline__ void attn_unit(Frame& F, const Ptrs& P, int b, int g, int qb) {
    LAS unsigned char* lds = F.lds;
    const int tid = F.tid, lane = F.lane, w = F.wave, r16 = lane & 15, kg = lane >> 4;
    LAS int* Oh = (LAS int*)(lds + L_OH); LAS int* Ol = (LAS int*)(lds + L_OL); LAS float* imp = (LAS float*)(lds + L_OH);
    LAS int* lsel = (LAS int*)(lds + L_LS); LAS float* mref = (LAS float*)(lds + L_MREF);
    LAS unsigned* selm = (LAS unsigned*)(lds + L_SEL); LAS int* cnts = (LAS int*)(lds + L_CNT); LAS unsigned char* lists = lds + L_LIST; LAS int* wctr = (LAS int*)(lds + L_WCTR);
    const size_t tokb = (size_t)b * SEQ; const int t0 = qb * 64;
    const bf16_t* Qg = P.Q + (tokb + t0) * 512 + g * 256;
    LAS float* U = (LAS float*)(lds + L_OH); LAS float* linvc = (LAS float*)(lds + L_LS);
    {
        const int q = tid >> 3, part = tid & 7, hd = part >> 1, hf = part & 1;
        const u32x4* src = (const u32x4*)(Qg + (size_t)q * 512 + part * 32);
        float ss = 0.f;
#pragma unroll
        for (int i = 0; i < 4; ++i) { const u32x4 v = src[i]; const float f[8] = {bflo(v.x), bfhi(v.x), bflo(v.y), bfhi(v.y), bflo(v.z), bfhi(v.z), bflo(v.w), bfhi(v.w)};
#pragma unroll
            for (int k = 0; k < 8; ++k) ss += f[k] * f[k]; }
        ss += __uint_as_float(__builtin_amdgcn_update_dpp(0u, __float_as_uint(ss), 0xB1, 0xF, 0xF, true));
        if (hf == 0) mref[q * 4 + hd] = sqrtf(ss);
        { LAS u32x4* z4 = (LAS u32x4*)U; for (int i = tid; i < (256 * USP) / 4; i += NTHREADS) z4[i] = (u32x4){0u, 0u, 0u, 0u}; }
    }
    __syncthreads();
    const int hl = r16 & 3;
#define ATT_LDK(dst, base, key0) do { const char* kb_ = (const char*)(base) + (size_t)(key0) * 128; _Pragma("unroll") for (int u_ = 0; u_ < 2; ++u_) _Pragma("unroll") for (int ks_ = 0; ks_ < 2; ++ks_) \
        dst[u_][ks_] = *(const bf16x8*)(kb_ + koff + (u_ * 2 + ks_) * 1024); } while (0)
#define ATT_LDV(dst, vbase, LEN, key0) do { const char* vb_ = (const char*)(vbase) + (size_t)(key0) * 128; _Pragma("unroll") for (int dt_ = 0; dt_ < 4; ++dt_) \
        dst[dt_] = *(const bf16x8*)(vb_ + koff + dt_ * 1024); } while (0)
#define ATT_SHADOW() int ln_ = F.lane; asm volatile("" : "+v"(ln_)); const int r16 = ln_ & 15, kg = ln_ >> 4, hl = r16 & 3; const unsigned koff = (unsigned)ln_ * 16u
    {
        ATT_SHADOW();
        bf16x8 qf[2][2]; float mrc[2], lpart[2], carry[2] = {0.f, 0.f}; int nlim[2]; f32x4 o[2][4];
#pragma unroll
        for (int rt = 0; rt < 2; ++rt) { const int q = 8 * w + 4 * rt + (r16 >> 2);
#pragma unroll
            for (int ks = 0; ks < 2; ++ks) qf[rt][ks] = *(const bf16x8*)(Qg + (size_t)q * 512 + hl * 64 + ks * 32 + kg * 8);
            mrc[rt] = mref[q * 4 + hl] * P.kcmax; lpart[rt] = 0.f; nlim[rt] = (t0 + q - 31) >> 4;
#pragma unroll
            for (int dt = 0; dt < 4; ++dt) o[rt][dt] = (f32x4){0.f, 0.f, 0.f, 0.f}; }
        const int nkeys = 4 * qb + 3, NP = (nkeys + 31) >> 5;
        const int nlim_min = (t0 + 8 * w - 31) >> 4;
        const bf16_t* Kc = P.KCMP + (size_t)(b * 2 + g) * 512 * 64; const bf16_t* Vc = P.VCT + (size_t)(b * 2 + g) * 64 * 512;
#define ATT_S1_STEP(KF, VF, s_) do { _Pragma("unroll") for (int rt = 0; rt < 2; ++rt) { \
            f32x4 st[2]; float p[2][4]; \
            _Pragma("unroll") for (int u = 0; u < 2; ++u) { st[u] = MFMA16(KF[u][0], qf[rt][0], ((f32x4){0.f, 0.f, 0.f, 0.f})); st[u] = MFMA16(KF[u][1], qf[rt][1], st[u]); } \
            _Pragma("unroll") for (int u = 0; u < 2; ++u) _Pragma("unroll") for (int i = 0; i < 4; ++i) p[u][i] = fast_exp2(st[u][i] - mrc[rt]); \
            if (32 * (s_) + 31 > nlim_min) { _Pragma("unroll") for (int u = 0; u < 2; ++u) _Pragma("unroll") for (int i = 0; i < 4; ++i) { const int n = 32 * (s_) + 8 * kg + 4 * u + i; if (n > nlim[rt]) p[u][i] = 0.f; } } \
            const float s01 = (p[0][0] + p[0][1]) + (p[0][2] + p[0][3]), s11 = (p[1][0] + p[1][1]) + (p[1][2] + p[1][3]); lpart[rt] += s01 + s11; \
            {   \
                \
              const unsigned x_ = __float_as_uint(p[1][3]); const auto s16_ = __builtin_amdgcn_permlane16_swap(x_, x_, false, false); const auto s32_ = __builtin_amdgcn_permlane32_swap(s16_[1], s16_[1], false, false); \
              const float inc_ = (kg & 1) ? __uint_as_float(s16_[0]) : ((kg == 2) ? __uint_as_float(s32_[0]) : carry[rt]); carry[rt] = __uint_as_float(s32_[1]); \
              LAS float* ur = U + ((8 * w + 4 * rt + (r16 >> 2)) * 4 + hl) * USP + 8 * (s_) + 2 * kg; \
              ur[0] += (2.f * s01 - p[0][3]) + inc_; ur[1] += (2.f * s11 - p[1][3]) + p[0][3]; } \
            u32x4 pw; pw.x = cvtpk(p[0][0], p[0][1]); pw.y = cvtpk(p[0][2], p[0][3]); pw.z = cvtpk(p[1][0], p[1][1]); pw.w = cvtpk(p[1][2], p[1][3]); \
            const bf16x8 pf = __builtin_bit_cast(bf16x8, pw); \
            _Pragma("unroll") for (int dt = 0; dt < 4; ++dt) o[rt][dt] = MFMA16(VF[dt], pf, o[rt][dt]); } } while (0)
        {
            bf16x8 kA[2][2], vA[4], kB[2][2], vB[4];
            ATT_LDK(kA, Kc, 0); ATT_LDV(vA, Vc, 512, 0); if (NP > 1) { ATT_LDK(kB, Kc, 32); ATT_LDV(vB, Vc, 512, 32); }
#pragma nounroll
            for (int s2 = 0; s2 < NP; s2 += 2) {
                ATT_S1_STEP(kA, vA, s2);
                if (s2 + 2 < NP) { ATT_LDK(kA, Kc, 32 * (s2 + 2)); ATT_LDV(vA, Vc, 512, 32 * (s2 + 2)); }
                if (s2 + 1 < NP) { ATT_S1_STEP(kB, vB, s2 + 1);
                    if (s2 + 3 < NP) { ATT_LDK(kB, Kc, 32 * (s2 + 3)); ATT_LDV(vB, Vc, 512, 32 * (s2 + 3)); } }
            }
        }
#undef ATT_S1_STEP
#pragma unroll
        for (int rt = 0; rt < 2; ++rt) { const int q = 8 * w + 4 * rt + (r16 >> 2); const float lrow = kg_sum(lpart[rt]); const float linv = lrow > 0.f ? 1.f / lrow : 0.f;
            if (kg == 0) linvc[q * 4 + hl] = linv;
            const float gc = P.GATES[(tokb + t0 + q) * 24 + (g * 4 + hl) * 3 + 0] * linv;
            float* yp = P.YPART + (tokb + t0 + q) * 512 + (g * 4 + hl) * 64 + 4 * kg;
#pragma unroll
            for (int dt = 0; dt < 4; ++dt) *(f32x4*)(yp + dt * 16) = o[rt][dt] * gc; }
    }
    LDS_WAIT();
#pragma nounroll
    for (int qg = 0; qg < 2; ++qg) {
        if (qb <= 15) {
            if (lane < 4) { const int q = 8 * w + 4 * qg + lane; const unsigned long long m0 = (1ull << (qb + 1)) - 1ull;
                selm[q * 4 + 0] = (unsigned)m0; selm[q * 4 + 1] = (unsigned)(m0 >> 32); selm[q * 4 + 2] = 0u; selm[q * 4 + 3] = 0u; }
        } else {
            const int j0 = lane, j1 = lane + 64; int v0[4], v1[4], thr[4];
#pragma unroll
            for (int k = 0; k < 4; ++k) { const int q = 8 * w + 4 * qg + k; const LAS float* ur = U + (q * 4) * USP; const LAS float* li = linvc + q * 4;
                float i0 = 0.f, i1 = 0.f;
#pragma unroll
                for (int h = 0; h < 4; ++h) { i0 += ur[h * USP + j0] * li[h]; i1 += ur[h * USP + j1] * li[h]; }
                v0[k] = (j0 >= 1 && j0 <= qb - 2) ? (int)__float_as_uint(i0) : -1;
                v1[k] = (j1 <= qb - 2) ? (int)__float_as_uint(i1) : -1; thr[k] = 0; }
#pragma nounroll
            for (int bit = 30; bit >= 0; --bit) {
                const int c0_ = thr[0] | (1 << bit), c1_ = thr[1] | (1 << bit), c2_ = thr[2] | (1 << bit), c3_ = thr[3] | (1 << bit);
                const unsigned long long a0_ = __ballot(v0[0] >= c0_), a1_ = __ballot(v0[1] >= c1_), a2_ = __ballot(v0[2] >= c2_), a3_ = __ballot(v0[3] >= c3_);
                const unsigned long long b0_ = __ballot(v1[0] >= c0_), b1_ = __ballot(v1[1] >= c1_), b2_ = __ballot(v1[2] >= c2_), b3_ = __ballot(v1[3] >= c3_);
                asm volatile("" :: "s"(a0_), "s"(a1_), "s"(a2_), "s"(a3_), "s"(b0_), "s"(b1_), "s"(b2_), "s"(b3_));
                if (__popcll(a0_) + __popcll(b0_) >= 13) thr[0] = c0_;
                if (__popcll(a1_) + __popcll(b1_) >= 13) thr[1] = c1_;
                if (__popcll(a2_) + __popcll(b2_) >= 13) thr[2] = c2_;
                if (__popcll(a3_) + __popcll(b3_) >= 13) thr[3] = c3_; }
            const unsigned long long below = (1ull << lane) - 1ull;
#pragma nounroll
            for (int k = 0; k < 4; ++k) {
                const int vv0 = (k == 0) ? v0[0] : (k == 1) ? v0[1] : (k == 2) ? v0[2] : v0[3], vv1 = (k == 0) ? v1[0] : (k == 1) ? v1[1] : (k == 2) ? v1[2] : v1[3];
                const int th = (k == 0) ? thr[0] : (k == 1) ? thr[1] : (k == 2) ? thr[2] : thr[3];
                const bool gt0 = vv0 > th, gt1 = vv1 > th, eq0 = vv0 == th, eq1 = vv1 == th;
                const int need = 13 - (__popcll(__ballot(gt0)) + __popcll(__ballot(gt1)));
                const unsigned long long B0 = __ballot(eq0), B1 = __ballot(eq1);
                const int rk0 = __popcll(B0 & below), rk1 = __popcll(B0) + __popcll(B1 & below);
                unsigned long long m0 = __ballot(gt0 || (eq0 && rk0 < need)), m1 = __ballot(gt1 || (eq1 && rk1 < need));
                m0 |= 1ull;
                if (qb < 64) m0 |= (1ull << qb); else m1 |= (1ull << (qb - 64));
                if (qb - 1 < 64) m0 |= (1ull << (qb - 1)); else m1 |= (1ull << (qb - 65));
                if (lane == 0) { const int q = 8 * w + 4 * qg + k; selm[q * 4 + 0] = (unsigned)m0; selm[q * 4 + 1] = (unsigned)(m0 >> 32); selm[q * 4 + 2] = (unsigned)m1; selm[q * 4 + 3] = (unsigned)(m1 >> 32); } }
        }
    }
    __syncthreads();
    { LAS u32x4* z4 = (LAS u32x4*)Oh; for (int i = tid; i < (2 * 256 * OSP) / 4; i += NTHREADS) z4[i] = (u32x4){0u, 0u, 0u, 0u}; }
    lsel[tid] = 0;
    if (tid == 0) wctr[0] = 0;
    { const unsigned m0 = selm[lane * 4 + (w >> 1)];
#pragma nounroll
      for (int jj = 0; jj < 16; ++jj) { const int j = 16 * w + jj; const bool hit = (j <= qb) && ((m0 >> (16 * (w & 1) + jj)) & 1u);
          const unsigned long long mk = __ballot(hit); if (hit) lists[j * 64 + __popcll(mk & ((1ull << lane) - 1ull))] = (unsigned char)lane;
          if (lane == 0) cnts[j] = __popcll(mk); } }
    __syncthreads();
    for (int rep5 = 0; rep5 < ((ATTREP & 8) ? NREP : 1); ++rep5)
    {
        if (rep5 > 0) { __syncthreads(); if (tid == 0) wctr[0] = 0; __syncthreads(); }
        ATT_SHADOW();
        const bf16_t* Ks = P.KS + (size_t)(b * 2 + g) * SEQ * 64; const bf16_t* Vs = P.VST + (size_t)(b * 2 + g) * 64 * SEQ;
        const float S1 = 1048576.f / fmaxf(P.vmax, 1e-30f);
#define ATT_FETCH(idx_) do { int i_ = 0; if (lane == 0) i_ = __hip_atomic_fetch_add(wctr, 1, __ATOMIC_RELAXED, __HIP_MEMORY_SCOPE_WORKGROUP); idx_ = __builtin_amdgcn_readfirstlane(i_); } while (0)
#define ATT_JOF(idx_) (((idx_) == 0) ? 0 : (((idx_) == 1) ? qb : (((idx_) == 2) ? qb - 1 : (idx_) - 2)))
        bf16x8 kn[2][2][2];
        int idx; ATT_FETCH(idx);
        if (idx <= qb) { const int j = ATT_JOF(idx); ATT_LDK(kn[0], Ks, 64 * j); ATT_LDK(kn[1], Ks, 64 * j + 32); }
#pragma nounroll
        while (idx <= qb) {
            const int j = ATT_JOF(idx);
            bf16x8 kf[2][2][2], vf[2][4];
#pragma unroll
            for (int sp = 0; sp < 2; ++sp) {
#pragma unroll
                for (int u = 0; u < 2; ++u) { kf[sp][u][0] = kn[sp][u][0]; kf[sp][u][1] = kn[sp][u][1]; } }
            ATT_LDV(vf[0], Vs, SEQ, 64 * j); ATT_LDV(vf[1], Vs, SEQ, 64 * j + 32);
            int idx2; ATT_FETCH(idx2);
            if (idx2 <= qb) { const int j2 = ATT_JOF(idx2); ATT_LDK(kn[0], Ks, 64 * j2); ATT_LDK(kn[1], Ks, 64 * j2 + 32); }
            const int cnt = cnts[j];
            const int nch = (cnt + 3) >> 2;
            bf16x8 qn0, qn1; int qnx; bool vnx;
            { const int qs = (r16 >> 2); vnx = qs < cnt; qnx = lists[j * 64 + (vnx ? qs : (cnt > 0 ? cnt - 1 : 0))];
              const bf16_t* qp = Qg + (size_t)qnx * 512 + hl * 64 + kg * 8; qn0 = *(const bf16x8*)qp; qn1 = *(const bf16x8*)(qp + 32); }
#pragma nounroll
            for (int c = 0; c < nch; ++c) {
                const bool valid = vnx; const int q = qnx; const int row = q * 4 + hl; const bf16x8 q0 = qn0, q1 = qn1;
                if (c + 1 < nch) { const int qs = 4 * (c + 1) + (r16 >> 2); vnx = qs < cnt; qnx = lists[j * 64 + (vnx ? qs : cnt - 1)];
                    const bf16_t* qp = Qg + (size_t)qnx * 512 + hl * 64 + kg * 8; qn0 = *(const bf16x8*)qp; qn1 = *(const bf16x8*)(qp + 32); }
                const float mr = mref[row] * P.kmax;
                f32x4 o[4];
                float ps = 0.f;
                const bool slow = (j == qb) || (4 * c + 4 > cnt);
#define ATT_CHUNK(MASKED) \
                _Pragma("unroll") for (int sp = 0; sp < 2; ++sp) { \
                    f32x4 st[2]; float p[2][4]; \
                    _Pragma("unroll") for (int u = 0; u < 2; ++u) { st[u] = MFMA16(kf[sp][u][0], q0, ((f32x4){0.f, 0.f, 0.f, 0.f})); st[u] = MFMA16(kf[sp][u][1], q1, st[u]); } \
                    _Pragma("unroll") for (int u = 0; u < 2; ++u) _Pragma("unroll") for (int i = 0; i < 4; ++i) { float e = fast_exp2(st[u][i] - mr); \
                        if (MASKED) { const int kk = 32 * sp + 8 * kg + 4 * u + i; if (!valid || (j == qb && kk > q)) e = 0.f; } p[u][i] = e; ps += e; } \
                    u32x4 pw; pw.x = cvtpk(p[0][0], p[0][1]); pw.y = cvtpk(p[0][2], p[0][3]); pw.z = cvtpk(p[1][0], p[1][1]); pw.w = cvtpk(p[1][2], p[1][3]); \
                    const bf16x8 pf = __builtin_bit_cast(bf16x8, pw); \
                    _Pragma("unroll") for (int dt = 0; dt < 4; ++dt) o[dt] = (sp == 0) ? MFMA16(vf[0][dt], pf, ((f32x4){0.f, 0.f, 0.f, 0.f})) : MFMA16(vf[1][dt], pf, o[dt]); }
                if (slow) { ATT_CHUNK(true) } else { ATT_CHUNK(false) }
#undef ATT_CHUNK
                ps = kg_sum(ps);
                if (valid) {
                    if (kg == 0) { const float xs = ps * 1048576.f, hf_ = __builtin_rintf(xs); __hip_atomic_fetch_add(lsel + row, (int)hf_, __ATOMIC_RELAXED, __HIP_MEMORY_SCOPE_WORKGROUP);
                        __hip_atomic_fetch_add(lsel + 256 + row, (int)((xs - hf_) * 1048576.f), __ATOMIC_RELAXED, __HIP_MEMORY_SCOPE_WORKGROUP); }
#pragma unroll
                    for (int dt = 0; dt < 4; ++dt)
#pragma unroll
                        for (int i = 0; i < 4; ++i) { const float xs = o[dt][i] * S1, hf_ = __builtin_rintf(xs); const int off = row * OSP + dt * 16 + 4 * kg + i;
                            __hip_atomic_fetch_add(Oh + off, (int)hf_, __ATOMIC_RELAXED, __HIP_MEMORY_SCOPE_WORKGROUP);
                            __hip_atomic_fetch_add(Ol + off, (int)((xs - hf_) * 1048576.f), __ATOMIC_RELAXED, __HIP_MEMORY_SCOPE_WORKGROUP); }
                }
            }
            idx = idx2;
        }
    }
    f32x4 yacc[2][4];
    {
        ATT_SHADOW();
        bf16x8 qf[2][2]; float mrw[2], lpart[2]; f32x4 o[2][4];
#pragma unroll
        for (int rt = 0; rt < 2; ++rt) { const int q = 8 * w + 4 * rt + (r16 >> 2);
#pragma unroll
            for (int ks = 0; ks < 2; ++ks) qf[rt][ks] = *(const bf16x8*)(Qg + (size_t)q * 512 + hl * 64 + ks * 32 + kg * 8);
            mrw[rt] = mref[q * 4 + hl] * P.kwmax; lpart[rt] = 0.f;
#pragma unroll
            for (int dt = 0; dt < 4; ++dt) o[rt][dt] = (f32x4){0.f, 0.f, 0.f, 0.f}; }
        const bf16_t* Kw = P.KW + (size_t)(b * 2 + g) * SEQ * 64; const bf16_t* Vw = P.VWT + (size_t)(b * 2 + g) * 64 * SEQ;
        const int jlo = qb >= 8 ? qb - 8 : 0; const int nit = 2 * (qb - jlo + 1);
#define ATT_S4_STEP(KF, VF, it_) do { const int jw_ = jlo + ((it_) >> 1), sp_ = (it_) & 1; const int mode_ = (jw_ == qb) ? 1 : ((jw_ == qb - 8) ? 2 : 0); \
        _Pragma("unroll") for (int rt = 0; rt < 2; ++rt) { \
            f32x4 st[2]; float p[2][4]; \
            _Pragma("unroll") for (int u = 0; u < 2; ++u) { st[u] = MFMA16(KF[u][0], qf[rt][0], ((f32x4){0.f, 0.f, 0.f, 0.f})); st[u] = MFMA16(KF[u][1], qf[rt][1], st[u]); } \
            _Pragma("unroll") for (int u = 0; u < 2; ++u) _Pragma("unroll") for (int i = 0; i < 4; ++i) p[u][i] = fast_exp2(st[u][i] - mrw[rt]); \
            if (mode_) { const int tq = 8 * w + 4 * rt + (r16 >> 2); \
                _Pragma("unroll") for (int u = 0; u < 2; ++u) _Pragma("unroll") for (int i = 0; i < 4; ++i) { const int kk = 32 * sp_ + 8 * kg + 4 * u + i; const bool vis = (mode_ == 1) ? (kk <= tq) : (kk > tq); if (!vis) p[u][i] = 0.f; } } \
            lpart[rt] += ((p[0][0] + p[0][1]) + (p[0][2] + p[0][3])) + ((p[1][0] + p[1][1]) + (p[1][2] + p[1][3])); \
            u32x4 pw; pw.x = cvtpk(p[0][0], p[0][1]); pw.y = cvtpk(p[0][2], p[0][3]); pw.z = cvtpk(p[1][0], p[1][1]); pw.w = cvtpk(p[1][2], p[1][3]); \
            const bf16x8 pf = __builtin_bit_cast(bf16x8, pw); \
            _Pragma("unroll") for (int dt = 0; dt < 4; ++dt) o[rt][dt] = MFMA16(VF[dt], pf, o[rt][dt]); } } while (0)
        {
            bf16x8 kA[2][2], vA[4], kB[2][2], vB[4];
            ATT_LDK(kA, Kw, 64 * jlo); ATT_LDV(vA, Vw, SEQ, 64 * jlo); ATT_LDK(kB, Kw, 64 * jlo + 32); ATT_LDV(vB, Vw, SEQ, 64 * jlo + 32);
#pragma nounroll
            for (int it = 0; it < nit; it += 2) {
                ATT_S4_STEP(kA, vA, it);
                if (it + 2 < nit) { ATT_LDK(kA, Kw, 64 * jlo + 32 * (it + 2)); ATT_LDV(vA, Vw, SEQ, 64 * jlo + 32 * (it + 2)); }
                ATT_S4_STEP(kB, vB, it + 1);
                if (it + 3 < nit) { ATT_LDK(kB, Kw, 64 * jlo + 32 * (it + 3)); ATT_LDV(vB, Vw, SEQ, 64 * jlo + 32 * (it + 3)); }
            }
        }
#undef ATT_S4_STEP
#pragma unroll
        for (int rt = 0; rt < 2; ++rt) { const int q = 8 * w + 4 * rt + (r16 >> 2); const float lw_ = kg_sum(lpart[rt]); const float sc = lw_ > 0.f ? P.GATES[(tokb + t0 + q) * 24 + (g * 4 + hl) * 3 + 2] / lw_ : 0.f;
#pragma unroll
            for (int dt = 0; dt < 4; ++dt) yacc[rt][dt] = o[rt][dt] * sc; }
    }
    __syncthreads();
#pragma unroll
    for (int rt = 0; rt < 2; ++rt) { const int q = 8 * w + 4 * rt + (r16 >> 2), row = q * 4 + hl;
        const float lrow = (float)lsel[row] * (1.f / 1048576.f) + (float)lsel[256 + row] * (1.f / 1099511627776.f);
        const float invS1 = fmaxf(P.vmax, 1e-30f) * (1.f / 1048576.f);
        const float sc = lrow > 0.f ? P.GATES[(tokb + t0 + q) * 24 + (g * 4 + hl) * 3 + 1] / lrow * invS1 : 0.f;
        bf16_t* dst = P.Y + (tokb + t0 + q) * 1024 + 512 + (g * 4 + hl) * 64 + 4 * kg;
        const float* yp = P.YPART + (tokb + t0 + q) * 512 + (g * 4 + hl) * 64 + 4 * kg;
#pragma unroll
        for (int dt = 0; dt < 4; ++dt) { const LAS int* oh = Oh + row * OSP + dt * 16 + 4 * kg; const LAS int* ol = Ol + row * OSP + dt * 16 + 4 * kg;
            const f32x4 osel = (f32x4){(float)oh[0] + (float)ol[0] * (1.f / 1048576.f), (float)oh[1] + (float)ol[1] * (1.f / 1048576.f), (float)oh[2] + (float)ol[2] * (1.f / 1048576.f), (float)oh[3] + (float)ol[3] * (1.f / 1048576.f)};
            const f32x4 v = yacc[rt][dt] + *(const f32x4*)(yp + dt * 16) + osel * sc;
            u32x2 o; o.x = cvtpk(v[0], v[1]); o.y = cvtpk(v[2], v[3]); *(u32x2*)(dst + dt * 16) = o; } }
    __syncthreads();
}
#undef MFMA16
#undef ATT_LDK
#undef ATT_LDV
#undef ATT_SHADOW
#undef ATT_FETCH
#undef ATT_JOF
}

__device__ __forceinline__ void phase_n2(Frame& F, const Args& a, int l) {
    const int lane = F.lane, w = F.wave;
    const float* XR = WSP(float, WS_XR); unsigned char* H8 = WSP(unsigned char, WS_H8);
    const float* g = INP(a, float, I_N2G) + l * 1024;
    LAS float* part = (LAS float*)F.lds;
    LAS float* ssqp = (LAS float*)(F.lds + 32768);
    LAS float* lg = (LAS float*)(F.lds + 32768 + 1024);
    int* CNTI = WSP(int, WS_CNTI); int* ASG = WSP(int, WS_ASG); float* G4 = WSP(float, WS_GATE4);
    for (int item = F.vcu; item < T / 64; item += F.G) {
        const int tk0 = item * 64, b = tk0 >> 13; const int tt = w & 1, kq = w >> 1;
        const float* rwp = WSP(float, WS_RWP) + (size_t)(l * 2 + b) * 1024 * 32; const float* rbp = WSP(float, WS_MISC + 4096) + (l * 2 + b) * 32;
        const int i31 = lane & 31, hf = lane >> 5;
        {
            const float* xp = XR + (size_t)(tk0 + tt * 32 + i31) * DM + kq * 256 + 4 * hf; const float* wp = rwp + (size_t)(kq * 256 + 4 * hf) * 32 + i31;
            f32x16 acc;
#pragma unroll
            for (int r = 0; r < 16; ++r) acc[r] = 0.f;
            float ssq = 0.f;
#pragma nounroll
            for (int bt = 0; bt < 4; ++bt) {
                f32x4 xv[8]; float wv[8][4];
#pragma unroll
                for (int s = 0; s < 8; ++s) { xv[s] = *(const f32x4*)(xp + 8 * (bt * 8 + s)); const float* wq = wp + (size_t)(8 * (bt * 8 + s)) * 32;
                    wv[s][0] = wq[0]; wv[s][1] = wq[32]; wv[s][2] = wq[64]; wv[s][3] = wq[96]; }
#pragma unroll
                for (int s = 0; s < 8; ++s) { ssq += (xv[s].x * xv[s].x + xv[s].y * xv[s].y) + (xv[s].z * xv[s].z + xv[s].w * xv[s].w);
                    acc = __builtin_amdgcn_mfma_f32_32x32x2f32(xv[s].x, wv[s][0], acc, 0, 0, 0); acc = __builtin_amdgcn_mfma_f32_32x32x2f32(xv[s].y, wv[s][1], acc, 0, 0, 0);
                    acc = __builtin_amdgcn_mfma_f32_32x32x2f32(xv[s].z, wv[s][2], acc, 0, 0, 0); acc = __builtin_amdgcn_mfma_f32_32x32x2f32(xv[s].w, wv[s][3], acc, 0, 0, 0); }
            }
            ssq += __shfl_xor(ssq, 32);
            if (hf == 0) ssqp[kq * 64 + tt * 32 + i31] = ssq;
#pragma unroll
            for (int r = 0; r < 16; ++r) { const int tk = (r & 3) + 8 * (r >> 2) + 4 * hf; part[(w * 32 + tk) * 32 + i31] = acc[r]; }
        }
        __syncthreads();
        for (int i = F.tid; i < 64 * 32; i += NTHREADS) { const int tk = i >> 5, e = i & 31, t2 = tk >> 5, tl = tk & 31;
            const float sq = (ssqp[tk] + ssqp[64 + tk]) + (ssqp[128 + tk] + ssqp[192 + tk]); const float rstd = 1.f / sqrtf(sq * (1.f / DM) + NORM_EPS);
            const float v = (part[((0 * 2 + t2) * 32 + tl) * 32 + e] + part[((1 * 2 + t2) * 32 + tl) * 32 + e]) + (part[((2 * 2 + t2) * 32 + tl) * 32 + e] + part[((3 * 2 + t2) * 32 + tl) * 32 + e]);
            lg[tk * 33 + e] = v * rstd + rbp[e]; }
        __syncthreads();
        if (w < 2) {
            const int it = item * 2 + w;
            float v0 = -INFINITY, v1 = -INFINITY, v2 = -INFINITY, v3 = -INFINITY; int i0 = -1, i1 = -1, i2 = -1, i3 = -1;
            if (lane < 32) {
#pragma unroll 8
                for (int e = 0; e < 32; ++e) { const float v = lg[(w * 32 + lane) * 33 + e];
                    if (v > v3) { if (v > v2) { v3 = v2; i3 = i2; if (v > v1) { v2 = v1; i2 = i1; if (v > v0) { v1 = v0; i1 = i0; v0 = v; i0 = e; } else { v1 = v; i1 = e; } } else { v2 = v; i2 = e; } } else { v3 = v; i3 = e; } } }
            }
            const float e1 = __expf(v1 - v0), e2 = __expf(v2 - v0), e3 = __expf(v3 - v0); const float inv = 1.f / (1.f + e1 + e2 + e3);
            int r0 = 0, r1 = 0, r2 = 0, r3 = 0, mycnt = 0;
            for (int e = 0; e < 32; ++e) { const bool hit = (i0 == e) | (i1 == e) | (i2 == e) | (i3 == e); const unsigned long long U = __ballot(hit);
                const int rk = __popcll(U & ((1ull << lane) - 1ull));
                if (i0 == e) r0 = rk; if (i1 == e) r1 = rk; if (i2 == e) r2 = rk; if (i3 == e) r3 = rk;
                if (lane == e) mycnt = __popcll(U); }
            if (lane < 32) { const int tk = tk0 + w * 32 + lane; CNTI[it * 32 + lane] = mycnt;
                if (mycnt > 0) { atomicAdd(F.ctl + CW_GCNT + (l * 32 + (it >> 4)) * 32 + lane, (unsigned)mycnt); atomicAdd(F.ctl + CW_CNT + l * 32 + lane, (unsigned)mycnt); }
                *(int4*)(ASG + tk * 4) = make_int4((i0 << 16) | r0, (i1 << 16) | r1, (i2 << 16) | r2, (i3 << 16) | r3);
                *(f32x4*)(G4 + tk * 4) = (f32x4){inv, e1 * inv, e2 * inv, e3 * inv}; }
        }
#pragma unroll 2
        for (int rr = 0; rr < 8; ++rr) { const int m = tk0 + w * 8 + rr; const RowV r = row_load(XR + (size_t)m * DM, lane);
            const float rstd = 1.f / sqrtf(row_ssq(r) * (1.f / DM) + NORM_EPS);
            row_norm_store8(r, rstd, g, MODP(l, b, 4), MODP(l, b, 3), H8 + (size_t)m * DM, lane); }
        __syncthreads();
    }
}

__device__ __forceinline__ void phase_n2b(Frame& F, int l) {
    const int gw = F.vcu * NWAVES + F.wave, NGW = F.G * NWAVES; const int lane = F.lane;
    const int* CNTI = WSP(int, WS_CNTI); int* TOK = WSP(int, WS_TOK); int* ASG = WSP(int, WS_ASG); unsigned* cnt = F.ctl + CW_CNT + l * 32;
    for (int it = gw; it < T / 32; it += NGW) {
        int base = 0;
        {
            const unsigned* gc = F.ctl + CW_GCNT + l * 1024; const int grp = it >> 4, e = lane & 31; int s0 = 0, s1 = 0;
#pragma unroll
            for (int gI = 0; gI < 32; ++gI) { const int v = (int)gc[gI * 32 + e]; s0 += (gI < grp) ? v : 0; }
#pragma unroll
            for (int i = 0; i < 16; ++i) { const int v = CNTI[((grp << 4) + i) * 32 + e]; s1 += (((grp << 4) + i) < it) ? v : 0; }
            base = s0 + s1; }
        { const int tk = it * 32 + (lane & 31); const int4 as = *(const int4*)(ASG + tk * 4); int v[4] = {as.x, as.y, as.z, as.w};
#pragma unroll
            for (int k = 0; k < 4; ++k) { const int e = v[k] >> 16, rk = v[k] & 0xffff; const int sl = __shfl(base, e & 31) + rk; if (lane < 32) TOK[e * 16384 + sl] = tk; v[k] = (e << 16) | sl; }
            if (lane < 32) *(int4*)(ASG + tk * 4) = make_int4(v[0], v[1], v[2], v[3]); }
    }
}

__device__ __forceinline__ void moe_tables(Frame& F, int l, int NT, int& total) {
    LAS int* ust = (LAS int*)(F.lds + MOE_OFF); LAS int* bst = ust + 33; LAS int* cn = bst + 33;
    if (F.tid < 64) { const unsigned* cnt = F.ctl + CW_CNT + l * 32; const int lane = F.tid;
        const int c = (lane < NE) ? (int)cnt[lane] : 0; const int nb = (c + 255) >> 8; int inc = nb;
#pragma unroll
        for (int o = 1; o < 32; o <<= 1) { const int t = __shfl_up(inc, o); if ((lane & 31) >= o) inc += t; }
        if (lane < NE) { bst[lane] = inc - nb; ust[lane] = (inc - nb) * NT; cn[lane] = c; if (lane == NE - 1) { bst[NE] = inc; ust[NE] = inc * NT; } } }
    __syncthreads();
    total = ust[NE];
}

constexpr int PH_PROLOGUE = 0, PH_N1 = 1, PH_LAYER0 = 2, PH_PER_LAYER = 9, NPHASES = PH_LAYER0 + DEPTH * PH_PER_LAYER;
__global__ void __launch_bounds__(NTHREADS, 2) fwd_kernel(Args args) {
    extern __shared__ __attribute__((aligned(16))) unsigned char lds_raw[];
    Frame F;
    F.lds = (LAS unsigned char*)lds_raw; F.ws = args.ws; F.ctl = (unsigned*)(args.ws + WS_CTL);
    F.tid = threadIdx.x; F.lane = F.tid & 63; F.wave = __builtin_amdgcn_readfirstlane(F.tid >> 6);
    F.G = gridDim.x; { const int bx = blockIdx.x; F.vcu = (F.G % 8 == 0) ? (bx % 8) * (F.G / 8) + bx / 8 : bx; }
    for (int u = F.tid; u < (LDS_BYTES - LDSCTL_OFF) / 4; u += NTHREADS) ((LAS unsigned*)(F.lds + LDSCTL_OFF))[u] = 0u;
    __syncthreads();
    volatile LAS unsigned* MISC = (volatile LAS unsigned*)(F.lds + MISC_OFF);
    XcdBarrier bar; bar.bar = F.ctl + CW_BAR; bar.x = 0; bar.st = nullptr;
#if !MK_PER_PHASE
    bar = xcd_barrier_post(F.ctl + CW_BAR, MISC + 8);
#endif
    const int lo = args.ph_lo, hi = args.ph_hi;
#define IN(k) (lo <= (k) && (k) < hi)
#define REFRESH() do { int t_ = threadIdx.x; asm volatile("" : "+v"(t_)); F.tid = t_; F.lane = t_ & 63; F.wave = __builtin_amdgcn_readfirstlane(t_ >> 6); } while (0)
#define SEAM(k) do { if (IN(k) && IN((k) + 1)) xcd_barrier(bar); } while (0)
#define REPS(bit, idem) (((REPMASK & (bit)) && (idem)) ? NREP : 1)

    if (IN(PH_PROLOGUE) && !(SKIPMASK & 1)) for (int rep = 0; rep < REPS(1, true); ++rep) { REFRESH(); phase_prologue(F, args); } SEAM(PH_PROLOGUE);
    if (IN(PH_N1) && !(SKIPMASK & 2)) for (int rep = 0; rep < REPS(2, true); ++rep) { REFRESH(); phase_n1_first(F, args); } SEAM(PH_N1);
    for (int l = 0; l < DEPTH; ++l) {
        const int p0 = PH_LAYER0 + l * PH_PER_LAYER;
        if (IN(p0 + 0) && !(SKIPMASK & 4)) for (int rep = 0; rep < REPS(4, l == 0); ++rep) {
            pg8::DenseOrder S; S.init(T, PINP, F.G, (int)blockIdx.x);
            EpiProj E{WSP(bf16_t, WS_UG), WSP(bf16_t, WS_VG), WSP(bf16_t, WS_Q), WSP(bf16_t, WS_KC), WSP(bf16_t, WS_VC), WSP(bf16_t, WS_KS), WSP(bf16_t, WS_KW), WSP(bf16_t, WS_VST), WSP(bf16_t, WS_VWT),
                      WSP(float, WS_GATES), WSP(float, WS_ROPE), F.ctl + CW_KMAX + l * 16};
            pg8::gemm_phase<EpiProj, pg8::DenseOrder, false, true>(F.lds, WSP(bf16_t, WS_H), WSP(bf16_t, WS_WIN) + (size_t)l * PINP * 1024, 1024, S, E);
        }
        SEAM(p0 + 0);
        if (IN(p0 + 1) && !(SKIPMASK & 8)) for (int rep = 0; rep < REPS(8, l == 0); ++rep) { REFRESH();
            for (int it = F.vcu; it < 256; it += F.G) { if (it < 128) sgu_item(F, args, l, it); else { compress_item(F, args, l, 2 * (it - 128)); compress_item(F, args, l, 2 * (it - 128) + 1); } }
        }
        SEAM(p0 + 1);
        if (IN(p0 + 2) && !(SKIPMASK & 16)) for (int rep = 0; rep < REPS(16, l == 0); ++rep) { REFRESH();
            att::Ptrs P{WSP(bf16_t, WS_Q), WSP(bf16_t, WS_KS), WSP(bf16_t, WS_KW), WSP(bf16_t, WS_VST), WSP(bf16_t, WS_VWT), WSP(bf16_t, WS_KCMP), WSP(bf16_t, WS_VCT), WSP(float, WS_GATES), WSP(bf16_t, WS_Y), WSP(float, WS_YPART), 0.f};
            for (int it = F.vcu; it < 512; it += F.G) {
                const int uu = (it < 256) ? it : (767 - it);
                const int bg = uu >> 7, qb = uu & 127;
                const unsigned* km = F.ctl + CW_KMAX + l * 16 + bg;
                P.kmax = sqrtf(__uint_as_float(__hip_atomic_load(km, __ATOMIC_RELAXED, __HIP_MEMORY_SCOPE_AGENT)));
                P.vmax = __uint_as_float(__hip_atomic_load(km + 4, __ATOMIC_RELAXED, __HIP_MEMORY_SCOPE_AGENT));
                P.kwmax = sqrtf(__uint_as_float(__hip_atomic_load(km + 8, __ATOMIC_RELAXED, __HIP_MEMORY_SCOPE_AGENT)));
                P.kcmax = sqrtf(__uint_as_float(__hip_atomic_load(km + 12, __ATOMIC_RELAXED, __HIP_MEMORY_SCOPE_AGENT)));
                att::attn_unit(F, P, bg >> 1, bg & 1, qb);
            }
        }
        SEAM(p0 + 2);
        if (IN(p0 + 3) && !(SKIPMASK & 32)) for (int rep = 0; rep < REPS(32, l == 0); ++rep) {
            pg8::DenseOrder S; S.init(T, DM, F.G, (int)blockIdx.x);
            EpiOut E{l == 0 ? INP(args, float, I_X) : WSP(float, WS_XR), WSP(float, WS_XR), (const float*)(F.ctl + CW_MOD) + (size_t)l * 2 * 6144};
            pg8::gemm_phase<EpiOut, pg8::DenseOrder, false, true>(F.lds, WSP(bf16_t, WS_Y), WSP(bf16_t, WS_WOUT) + (size_t)l * 1024 * 1024, 1024, S, E);
        }
        SEAM(p0 + 3);
        if (IN(p0 + 4) && !(SKIPMASK & 64)) for (int rep = 0; rep < REPS(64, l == 0); ++rep) { REFRESH(); phase_n2(F, args, l); }
        SEAM(p0 + 4);
        if (IN(p0 + 5) && !(SKIPMASK & 64)) for (int rep = 0; rep < REPS(1024, l == 0); ++rep) { REFRESH(); phase_n2b(F, l); }
        SEAM(p0 + 5);
        if (IN(p0 + 6) && !(SKIPMASK & 128)) for (int rep = 0; rep < REPS(128, l == 0); ++rep) { REFRESH();
            int total; moe_tables(F, l, 8, total);
            LAS int* ust = (LAS int*)(F.lds + MOE_OFF);
            pg8::MoeOrder S{ust, ust + 33, ust + 66, WSP(int, WS_TOK), 8, F.G, F.vcu, total, 1024};
            EpiSwiglu E{WSP(unsigned char, WS_ACT), INP(args, float, I_EB1) + (size_t)l * NE * 2048};
            pg8::gemm_phase<EpiSwiglu, pg8::MoeOrder, true, true, true>(F.lds, WSP(bf16_t, WS_H8), (const bf16_t*)(WSP(unsigned char, WS_W1T) + (size_t)l * NE * 2048 * 1024), 512, S, E);
        }
        SEAM(p0 + 6);
        if (IN(p0 + 7) && !(SKIPMASK & 256)) for (int rep = 0; rep < REPS(256, l == 0); ++rep) { REFRESH();
            int total; moe_tables(F, l, 4, total);
            LAS int* ust = (LAS int*)(F.lds + MOE_OFF);
            pg8::MoeOrder S{ust, ust + 33, ust + 66, WSP(int, WS_TOK), 4, F.G, F.vcu, total, 1024};
            EpiDown E{WSP(bf16_t, WS_YROWS), INP(args, float, I_EB2) + (size_t)l * NE * 1024};
            pg8::gemm_phase<EpiDown, pg8::MoeOrder, false, true, true>(F.lds, WSP(bf16_t, WS_ACT), (const bf16_t*)(WSP(unsigned char, WS_W2T) + (size_t)l * NE * 1024 * 1024), 512, S, E);
        }
        SEAM(p0 + 7);
        if (IN(p0 + 8) && !(SKIPMASK & 512)) for (int rep = 0; rep < REPS(512, l == DEPTH - 1); ++rep) { REFRESH(); phase_combine(F, args, l); }
        if (l + 1 < DEPTH) SEAM(p0 + 8);
    }
#undef IN
#undef SEAM
}

extern "C" void kernel_launch(void* const* d_in, const int* in_sizes, int n_in, void* d_out, int out_size, void* d_ws, size_t ws_size, hipStream_t stream) {
    static int grid = 0;
    if (grid == 0) {
        if (n_in != 26 || out_size != T * DM || ws_size < WS_END) { fprintf(stderr, "kernel_launch: unexpected problem (n_in %d, out %d, ws %zu; need ws >= %zu)\n", n_in, out_size, ws_size, (size_t)WS_END); grid = -1; return; }
        int dev = 0, cus = 0, per_cu = 0;
        if (hipGetDevice(&dev) != hipSuccess || hipDeviceGetAttribute(&cus, hipDeviceAttributeMultiprocessorCount, dev) != hipSuccess) { grid = -1; return; }
        if (hipFuncSetAttribute((const void*)fwd_kernel, hipFuncAttributeMaxDynamicSharedMemorySize, LDS_BYTES) != hipSuccess) { fprintf(stderr, "kernel_launch: hipFuncSetAttribute failed\n"); grid = -1; return; }
        if (hipOccupancyMaxActiveBlocksPerMultiprocessor(&per_cu, (const void*)fwd_kernel, NTHREADS, LDS_BYTES) != hipSuccess || per_cu < 1) { fprintf(stderr, "kernel_launch: occupancy query says %d\n", per_cu); (void)hipGetLastError(); per_cu = 1; }
        grid = cus;
    }
    if (grid < 0) return;
    if (hipMemsetAsync((char*)d_ws + WS_CTL, 0, CTL_ZERO_BYTES, stream) != hipSuccess) { fprintf(stderr, "kernel_launch: memset failed\n"); return; }
    Args a{};
    for (int i = 0; i < 26; ++i) a.in[i] = d_in[i];
    a.out = (float*)d_out; a.ws = (unsigned char*)d_ws;
#if MK_PER_PHASE
    for (int p = 0; p < NPHASES; ++p) { a.ph_lo = p; a.ph_hi = p + 1; a.li = 0;
        hipLaunchKernelGGL(fwd_kernel, dim3(grid), dim3(NTHREADS), LDS_BYTES, stream, a); }
#else
    a.ph_lo = 0; a.ph_hi = NPHASES; a.li = 0;
    void* kargs[] = {&a};
    hipError_t e = hipLaunchCooperativeKernel((const void*)fwd_kernel, dim3(grid), dim3(NTHREADS), kargs, LDS_BYTES, stream);
    if (e != hipSuccess) fprintf(stderr, "kernel_launch: cooperative launch failed: %s (grid %d)\n", hipGetErrorString(e), grid);
#endif
}
```

```cpp
#include <hip/hip_runtime.h>
#include <cstdio>
#include <cstdint>

#ifndef SKIPMASK
#define SKIPMASK 0
#endif
#ifndef REPMASK
#define REPMASK 0
#endif
#ifndef NREP
#define NREP 3
#endif
#ifndef DUMMYINT
#define DUMMYINT 0
#endif
#ifndef ATTREP
#define ATTREP 0
#endif
#ifndef MK_PER_PHASE
#define MK_PER_PHASE 0
#endif

#define LAS __attribute__((address_space(3)))
typedef unsigned short bf16_t;
typedef short bf16x8 __attribute__((ext_vector_type(8)));
typedef float f32x4 __attribute__((ext_vector_type(4)));
typedef float f32x2 __attribute__((ext_vector_type(2)));
typedef float f32x16 __attribute__((ext_vector_type(16)));
typedef unsigned u32x4 __attribute__((ext_vector_type(4)));
typedef unsigned u32x2 __attribute__((ext_vector_type(2)));
typedef __bf16 bf16x2_t __attribute__((ext_vector_type(2)));
typedef int i32x4 __attribute__((ext_vector_type(4)));
typedef int i32x8 __attribute__((ext_vector_type(8)));

constexpr int BATCH = 2, SEQ = 8192, DM = 1024, T = BATCH * SEQ, DEPTH = 2;
constexpr int PIN = 2328, PINP = 2560;
constexpr int NE = 32, FF = 1024, TOPK = 4;
constexpr int NCMP = 511, NCMPP = 512;
constexpr float NORM_EPS = 1e-6f;
constexpr float W8SCALE = 64.f;
constexpr int W8_E8M0 = 0x79797979, ONE_E8M0 = 0x7f7f7f7f;
constexpr float QSCALE = 0.125f * 1.4426950408889634f;
constexpr int NWAVES = 8, NTHREADS = 512;

constexpr size_t MiB = 1u << 20;
constexpr size_t WS_CTL = 0, CTL_ZERO_BYTES = 1 * MiB;
constexpr size_t WS_WIN = 1 * MiB;
constexpr size_t WS_WOUT = 11 * MiB;
constexpr size_t WS_SGW = 15 * MiB;
constexpr size_t WS_CW1 = 15 * MiB + 512 * 1024;
constexpr size_t WS_ROPE = 17 * MiB;
constexpr size_t WS_RWP = 21 * MiB;
constexpr size_t WS_MISC = 21 * MiB + 512 * 1024;
constexpr size_t WS_W1T = 32 * MiB;
constexpr size_t WS_W2T = 288 * MiB;
constexpr size_t WS_XR = 416 * MiB;
constexpr size_t WS_H = 480 * MiB;
constexpr size_t WS_UG = 513 * MiB, WS_VG = 529 * MiB, WS_Q = 545 * MiB;
constexpr size_t WS_KC = 561 * MiB, WS_VC = 565 * MiB, WS_KS = 569 * MiB, WS_KW = 573 * MiB;
constexpr size_t WS_VST = 577 * MiB, WS_VWT = 581 * MiB;
constexpr size_t WS_GATES = 585 * MiB;
constexpr size_t WS_KCMP = 587 * MiB;
constexpr size_t WS_VCT = 587 * MiB + 512 * 1024;
constexpr size_t WS_Y = 588 * MiB;
constexpr size_t WS_TOK = 620 * MiB;
constexpr size_t WS_ASG = 622 * MiB;
constexpr size_t WS_GATE4 = 622 * MiB + 512 * 1024;
constexpr size_t WS_YPART = 912 * MiB;
constexpr size_t WS_CNTI = 623 * MiB;
constexpr size_t WS_ACT = 624 * MiB;
constexpr size_t WS_YROWS = 768 * MiB;
constexpr size_t WS_H8 = 944 * MiB;
constexpr size_t WS_END = 962 * MiB;
constexpr int CW_BAR = 4096;
constexpr int CW_MOD = 16384;
constexpr int CW_CNT = 40960;
constexpr int CW_KMAX = 41088;
constexpr int CW_GCNT = 41216;

__device__ __forceinline__ unsigned cvtpk(float lo, float hi) { f32x2 v = {lo, hi}; bf16x2_t b = __builtin_convertvector(v, bf16x2_t); return __builtin_bit_cast(unsigned, b); }
__device__ __forceinline__ unsigned cvt4_fp8(float a, float b, float c, float d) { int w = 0; w = __builtin_amdgcn_cvt_pk_fp8_f32(a, b, w, false); w = __builtin_amdgcn_cvt_pk_fp8_f32(c, d, w, true); return (unsigned)w; }
__device__ __forceinline__ float bf2f(unsigned short b) { return __uint_as_float((unsigned)b << 16); }
__device__ __forceinline__ float bflo(unsigned w) { return __uint_as_float(w << 16); }
__device__ __forceinline__ float bfhi(unsigned w) { return __uint_as_float(w & 0xffff0000u); }
__device__ __forceinline__ float fast_exp2(float x) { return __builtin_amdgcn_exp2f(x); }
__device__ __forceinline__ float fast_rcp(float x) { return __builtin_amdgcn_rcpf(x); }
__device__ __forceinline__ float sigmoidf_(float x) { return fast_rcp(1.f + fast_exp2(-1.4426950408889634f * x)); }
__device__ __forceinline__ float gelu_tanh(float x) { const float u = 0.7978845608028654f * (x + 0.044715f * x * x * x); return x * fast_rcp(1.f + fast_exp2(-2.885390081777927f * u)); }

__device__ __forceinline__ float x16_sum(float x) { auto r = __builtin_amdgcn_permlane16_swap(__float_as_uint(x), __float_as_uint(x), false, false); return __uint_as_float(r[0]) + __uint_as_float(r[1]); }
__device__ __forceinline__ float x32_sum(float x) { auto r = __builtin_amdgcn_permlane32_swap(__float_as_uint(x), __float_as_uint(x), false, false); return __uint_as_float(r[0]) + __uint_as_float(r[1]); }
__device__ __forceinline__ float x16_max(float x) { auto r = __builtin_amdgcn_permlane16_swap(__float_as_uint(x), __float_as_uint(x), false, false); return fmaxf(__uint_as_float(r[0]), __uint_as_float(r[1])); }
__device__ __forceinline__ float x32_max(float x) { auto r = __builtin_amdgcn_permlane32_swap(__float_as_uint(x), __float_as_uint(x), false, false); return fmaxf(__uint_as_float(r[0]), __uint_as_float(r[1])); }
__device__ __forceinline__ float kg_sum(float x) { return x32_sum(x16_sum(x)); }
__device__ __forceinline__ float kg_max(float x) { return x32_max(x16_max(x)); }
__device__ __forceinline__ float quad_sum(float x) { x += __uint_as_float(__builtin_amdgcn_update_dpp(0u, __float_as_uint(x), 0xB1, 0xF, 0xF, true)); x += __uint_as_float(__builtin_amdgcn_update_dpp(0u, __float_as_uint(x), 0x4E, 0xF, 0xF, true)); return x; }
__device__ __forceinline__ float wave_sum(float v) {
    v = quad_sum(v);
    v += __uint_as_float(__builtin_amdgcn_update_dpp(0u, __float_as_uint(v), 0x141, 0xF, 0xF, true));
    v += __uint_as_float(__builtin_amdgcn_update_dpp(0u, __float_as_uint(v), 0x140, 0xF, 0xF, true));
    return x32_sum(x16_sum(v));
}
#define LDS_WAIT() asm volatile("s_waitcnt lgkmcnt(0)" ::: "memory")
#define VM_WAIT() asm volatile("s_waitcnt vmcnt(0)" ::: "memory")

__device__ __forceinline__ int kfrag_off(int key, int c8) {
    const int s = key >> 5, ko = key & 31, u = (ko >> 2) & 1, r16 = ((ko >> 3) << 2) | (ko & 3), ks = c8 >> 2, kg = c8 & 3;
    return s * 2048 + (u * 2 + ks) * 512 + (kg * 16 + r16) * 8;
}
__device__ __forceinline__ int vfrag_off(int key, int d) {
    const int s = key >> 5, ko = key & 31;
    return s * 2048 + (d >> 4) * 512 + ((ko >> 3) * 16 + (d & 15)) * 8 + (ko & 7);
}
namespace pg8 {
constexpr int BM = 256, BK = 64, HALF = 128, HTB = HALF * BK * 2, STAGE_BYTES = 8 * HTB, NXCD = 8, WGM = 8;
__host__ __device__ __forceinline__ int lds_byte(int r, int c) { const int st = (r >> 4) * 2 + (c >> 5), rr = r & 15, cc = c & 31, ob = rr * 64 + cc * 2; return st * 1024 + (ob ^ (((ob >> 9) & 1) << 5)); }
__host__ __device__ __forceinline__ void stage_rc(int b, int& R, int& C) { const int st = b / 1024, sb = b % 1024, swz = sb ^ (((sb >> 9) & 1) << 5); R = (st >> 1) * 16 + swz / 64; C = (st & 1) * 32 + (swz % 64) / 2; }
__host__ __device__ __forceinline__ int perm32(int rho) { const int n = rho >> 4, i = rho & 15; return 8 * (i >> 2) + 4 * n + (i & 3); }

struct Unit { int pm, pn, e, pnl, rloc; };

struct DenseOrder {
    int nM, nN, nwg, G, c;
    __device__ void init(int M, int N, int G_, int c_) { nM = M / BM; nN = N / BM; nwg = nM * nN; G = G_; c = c_; }
    __device__ bool next(int i, Unit& u) const {
        const long L = (long)i * G + c; if (L >= nwg) return false;
        int wgid = (int)L; { const int q = nwg / NXCD, r = nwg % NXCD, xcd = wgid % NXCD, off = wgid / NXCD; wgid = (xcd < r ? xcd * (q + 1) : r * (q + 1) + (xcd - r) * q) + off; }
        const int nig = WGM * nN, gid = wgid / nig, fm = gid * WGM, gsz = (nM - fm) < WGM ? (nM - fm) : WGM;
        u.pm = fm + ((wgid % nig) % gsz); u.pn = (wgid % nig) / gsz; u.e = 0; u.pnl = u.pn; u.rloc = 0; return true;
    }
    __device__ __forceinline__ unsigned rowoff(const Unit&, int) const { return 0u; }
};

struct MoeOrder {
    const LAS int* ust;
    const LAS int* bst;
    const LAS int* cnt;
    const int* tok;
    int NT, G, c, total, rowbytes;
    __device__ bool next(int i, Unit& u) const {
        const int L = i * G + c; if (L >= total) return false;
        int e = 0;
        for (int k = 1; k < NE; ++k) e += (L >= ust[k]) ? 1 : 0;
        e = __builtin_amdgcn_readfirstlane(e);
        const int loc = __builtin_amdgcn_readfirstlane(L - ust[e]), b0 = __builtin_amdgcn_readfirstlane(bst[e]), nb = __builtin_amdgcn_readfirstlane(bst[e + 1]) - b0;
        u.e = e; u.pnl = loc / nb; u.rloc = loc - u.pnl * nb; u.pm = b0 + u.rloc; u.pn = e * NT + u.pnl; return true;
    }
    __device__ __forceinline__ unsigned rowoff(const Unit& u, int r) const {
        const int slot = u.rloc * 256 + r; const int tk = slot < cnt[u.e] ? tok[u.e * 16384 + slot] : T;
        return (unsigned)tk * (unsigned)rowbytes;
    }
};

template <class Epi, class Sched, bool GATHER, bool ALIGN_EPI, bool FP8 = false>
__device__ __forceinline__ void gemm_phase(LAS unsigned char* lds, const bf16_t* A, const bf16_t* Bt, const int K, const Sched& S, const Epi& E) {
    int tid_ = threadIdx.x; asm volatile("" : "+v"(tid_));
    const int tid = tid_, wid = __builtin_amdgcn_readfirstlane(tid >> 6), lane = tid & 63, wr = wid >> 2, wc = wid & 3, fr = lane & 15, fq = lane >> 4;
    const int nt = K / BK;
    unsigned voffB[2];
#pragma unroll
    for (int i = 0; i < 2; ++i) { int R, C; stage_rc(tid * 16 + i * 8192, R, C); const int Rb = Epi::PERM ? ((R & ~31) + perm32(R & 31)) : R; voffB[i] = (unsigned)(Rb * K + C) * 2u; }
    const size_t kstep = (size_t)(BK * 2);
    const size_t hstep = (size_t)HALF * K * 2;
    const size_t tstep = 2 * hstep;
    const unsigned ldsw = (unsigned)wid * 1024u;
    const int aoff = lds_byte(wr * 64 + fr, fq * 8), boff = lds_byte(wc * 32 + fr, fq * 8);
#define PG8_SA(b, h) (((b) * 2 + (h)) * HTB)
#define PG8_SB(b, h) ((4 + (b) * 2 + (h)) * HTB)
#define PG8_STAGE(bufoff, gbase, v0, v1) do { \
        __builtin_amdgcn_global_load_lds((const unsigned*)((const char*)(gbase) + (v0)), (LAS unsigned*)(lds + (bufoff) + ldsw), 16, 0, 0); \
        __builtin_amdgcn_global_load_lds((const unsigned*)((const char*)(gbase) + (v1)), (LAS unsigned*)(lds + (bufoff) + ldsw + 8192), 16, 0, 0); } while (0)
#define PG8_STAGEB(bufoff, gbase) PG8_STAGE(bufoff, gbase, voffB[0], voffB[1])
#define PG8_CAT8(x0, x1) __builtin_shufflevector(x0, x1, 0, 1, 2, 3, 4, 5, 6, 7)
#define PG8_RD4(off) (*(const LAS i32x4*)(lds + (off)))
#define PG8_LDA(dst, b, h) do { if constexpr (FP8) { _Pragma("unroll") for (int m = 0; m < 4; ++m) dst##8[m] = PG8_CAT8(PG8_RD4(PG8_SA(b, h) + aoff + m * 2048), PG8_RD4(PG8_SA(b, h) + aoff + m * 2048 + 1024)); } \
        else { _Pragma("unroll") for (int m = 0; m < 4; ++m) _Pragma("unroll") for (int k = 0; k < 2; ++k) dst[m][k] = *(const LAS bf16x8*)(lds + PG8_SA(b, h) + aoff + m * 2048 + k * 1024); } } while (0)
#define PG8_LDB(dst, b, h) do { if constexpr (FP8) { _Pragma("unroll") for (int n = 0; n < 2; ++n) dst##8[n] = PG8_CAT8(PG8_RD4(PG8_SB(b, h) + boff + n * 2048), PG8_RD4(PG8_SB(b, h) + boff + n * 2048 + 1024)); } \
        else { _Pragma("unroll") for (int n = 0; n < 2; ++n) _Pragma("unroll") for (int k = 0; k < 2; ++k) dst[n][k] = *(const LAS bf16x8*)(lds + PG8_SB(b, h) + boff + n * 2048 + k * 1024); } } while (0)
#define PG8_MMA(ai, bj, At, Bt_) do { __builtin_amdgcn_s_setprio(1); _Pragma("unroll") for (int m = 0; m < 4; ++m) _Pragma("unroll") for (int n = 0; n < 2; ++n) { \
        if constexpr (FP8) { asm volatile("v_mfma_scale_f32_16x16x128_f8f6f4 %0, %1, %2, %0, %3, %4 op_sel_hi:[0,0,0]" : "+v"(acc[ai][bj][m][n]) : "v"(Bt_##8[n]), "v"(At##8[m]), "v"(sc_w), "v"(sc_x)); } \
        else { _Pragma("unroll") for (int k = 0; k < 2; ++k) acc[ai][bj][m][n] = __builtin_amdgcn_mfma_f32_16x16x32_bf16(Bt_[n][k], At[m][k], acc[ai][bj][m][n], 0, 0, 0); } } \
        __builtin_amdgcn_s_setprio(0); } while (0)
#define PG8_WAIT_V(n) asm volatile("s_waitcnt vmcnt(" #n ")" ::: "memory")
#define PG8_WAIT_L(n) asm volatile("s_waitcnt lgkmcnt(" #n ")" ::: "memory")
#define PG8_BAR __builtin_amdgcn_s_barrier()
#define PG8_SCHED __builtin_amdgcn_sched_barrier(0)
#define PG8_SETV(v, u) do { int t2_ = tid; asm volatile("" : "+v"(t2_)); _Pragma("unroll") for (int i_ = 0; i_ < 2; ++i_) { int R_, C_; stage_rc(t2_ * 16 + i_ * 8192, R_, C_); _Pragma("unroll") for (int h_ = 0; h_ < 2; ++h_) \
        v[h_][i_] = GATHER ? (S.rowoff(u, R_ + HALF * h_) + (unsigned)C_ * 2u) : (unsigned)((R_ + HALF * h_) * K + C_) * 2u; } } while (0)
    Unit cur, nxt; int ui = 0;
    if (!S.next(0, cur)) return;
    unsigned vc[2][2], vn[2][2];
    PG8_SETV(vc, cur);
    f32x4 acc[2][2][4][2];
#pragma unroll
    for (int a = 0; a < 2; ++a)
#pragma unroll
        for (int b = 0; b < 2; ++b)
#pragma unroll
            for (int m = 0; m < 4; ++m)
#pragma unroll
                for (int n = 0; n < 2; ++n) acc[a][b][m][n] = (f32x4){0.f, 0.f, 0.f, 0.f};
    bf16x8 At[4][2], B0[2][2], B1[2][2]; i32x8 At8[4], B08[2], B18[2];
    int sc_w = W8_E8M0, sc_x = ONE_E8M0; asm volatile("" : "+v"(sc_w), "+v"(sc_x));
    const char* cA = GATHER ? (const char*)A : (const char*)A + (size_t)cur.pm * tstep;
    const char* cB = (const char*)Bt + (size_t)cur.pn * tstep;
    PG8_STAGEB(PG8_SB(0, 0), cB); PG8_STAGEB(PG8_SB(0, 1), cB + hstep); PG8_STAGE(PG8_SA(0, 0), cA, vc[0][0], vc[0][1]); PG8_STAGE(PG8_SA(0, 1), cA, vc[1][0], vc[1][1]);
    if (wr == 1) PG8_BAR;
    PG8_WAIT_V(2); PG8_BAR;
    PG8_STAGEB(PG8_SB(1, 0), cB + kstep); PG8_STAGE(PG8_SA(1, 0), cA + kstep, vc[0][0], vc[0][1]); PG8_STAGEB(PG8_SB(1, 1), cB + hstep + kstep);
    PG8_WAIT_V(6); PG8_BAR;
    for (;;) {
        const bool has_next = S.next(ui + 1, nxt);
        const char* nA = GATHER ? (const char*)A : (has_next ? (const char*)A + (size_t)nxt.pm * tstep : cA);
        const char* nB = has_next ? (const char*)Bt + (size_t)nxt.pn * tstep : cB;
        if constexpr (GATHER) { if (has_next) { PG8_SETV(vn, nxt); } else {
#pragma unroll
            for (int h_ = 0; h_ < 2; ++h_)
#pragma unroll
                for (int i_ = 0; i_ < 2; ++i_) vn[h_][i_] = vc[h_][i_]; } }
#pragma nounroll
        for (int t = 0; t < nt; t += 2) {
            const bool last = (t == nt - 2);
            const char* a1 = cA + (size_t)(t + 1) * kstep;
            const char* a2 = last ? nA : cA + (size_t)(t + 2) * kstep; const char* b2 = last ? nB : cB + (size_t)(t + 2) * kstep;
            const char* a3 = a2 + kstep; const char* b3 = b2 + kstep;
            const unsigned w00 = (GATHER && last) ? vn[0][0] : vc[0][0], w01 = (GATHER && last) ? vn[0][1] : vc[0][1], w10 = (GATHER && last) ? vn[1][0] : vc[1][0], w11 = (GATHER && last) ? vn[1][1] : vc[1][1];
            PG8_LDB(B0, 0, 0); PG8_LDB(B1, 0, 1); PG8_SCHED; PG8_LDA(At, 0, 0); PG8_STAGE(PG8_SA(1, 1), a1, vc[1][0], vc[1][1]);
            PG8_WAIT_V(8); PG8_WAIT_L(0); PG8_BAR; PG8_MMA(0, 0, At, B0); PG8_MMA(0, 1, At, B1); PG8_BAR; PG8_SCHED;
            PG8_LDA(At, 0, 1); PG8_STAGEB(PG8_SB(0, 0), b2); PG8_STAGEB(PG8_SB(0, 1), b2 + hstep); PG8_STAGE(PG8_SA(0, 0), a2, w00, w01);
            PG8_WAIT_V(8); PG8_WAIT_L(0); PG8_BAR; PG8_MMA(1, 0, At, B0); PG8_MMA(1, 1, At, B1); PG8_BAR; PG8_SCHED;
            PG8_LDB(B0, 1, 0); PG8_LDB(B1, 1, 1); PG8_SCHED; PG8_LDA(At, 1, 0); PG8_STAGE(PG8_SA(0, 1), a2, w10, w11);
            PG8_WAIT_V(8); PG8_WAIT_L(0); PG8_BAR; PG8_MMA(0, 0, At, B0); PG8_MMA(0, 1, At, B1); PG8_BAR; PG8_SCHED;
            PG8_LDA(At, 1, 1); PG8_STAGEB(PG8_SB(1, 0), b3); PG8_STAGEB(PG8_SB(1, 1), b3 + hstep); PG8_STAGE(PG8_SA(1, 0), a3, w00, w01);
            PG8_WAIT_V(8); PG8_WAIT_L(0); PG8_BAR; PG8_MMA(1, 0, At, B0); PG8_MMA(1, 1, At, B1); PG8_BAR; PG8_SCHED;
        }
        if constexpr (FP8) { asm volatile("s_nop 15\n\ts_nop 15" ::: "memory"); }
        if constexpr (ALIGN_EPI) { if (wr == 0) PG8_BAR; }
        E(acc, cur, wr, wc, fr, fq);
        if (!has_next) break;
#pragma unroll
        for (int a = 0; a < 2; ++a)
#pragma unroll
            for (int b = 0; b < 2; ++b)
#pragma unroll
                for (int m = 0; m < 4; ++m)
#pragma unroll
                    for (int n = 0; n < 2; ++n) acc[a][b][m][n] = (f32x4){0.f, 0.f, 0.f, 0.f};
        cur = nxt; cA = nA; cB = nB; ++ui;
        if constexpr (GATHER) {
#pragma unroll
        for (int h_ = 0; h_ < 2; ++h_)
#pragma unroll
            for (int i_ = 0; i_ < 2; ++i_) vc[h_][i_] = vn[h_][i_]; }
        if constexpr (ALIGN_EPI) { if (wr == 1) PG8_BAR; }
    }
    PG8_WAIT_V(0);
    if constexpr (!ALIGN_EPI) { if (wr == 0) PG8_BAR; }
    PG8_BAR;
#undef PG8_SA
#undef PG8_SB
#undef PG8_STAGE
#undef PG8_STAGEB
#undef PG8_LDA
#undef PG8_LDB
#undef PG8_MMA
#undef PG8_CAT8
#undef PG8_RD4
#undef PG8_WAIT_V
#undef PG8_WAIT_L
#undef PG8_BAR
#undef PG8_SCHED
#undef PG8_SETV
}
}

#define XB_TMO      128
#define XB_XCNT(j)  (256  + 64 * (j))
#define XB_XSUB(j)  (1280 + 64 * (j))
#define XB_XGEN(j)  (2304 + 64 * (j))
#define XB_TOP      3328
#define XB_TOPGEN   3392
#define XCD_BAR_WORDS 3456
#define XB_SPIN_CAP (1u << 22)
__device__ __forceinline__ unsigned xb_ld(unsigned* p)              { return __hip_atomic_load(p, __ATOMIC_RELAXED, __HIP_MEMORY_SCOPE_AGENT); }
__device__ __forceinline__ unsigned xb_add(unsigned* p, unsigned v) { return __hip_atomic_fetch_add(p, v, __ATOMIC_RELAXED, __HIP_MEMORY_SCOPE_AGENT); }
__device__ __forceinline__ unsigned xb_xcc_id() { return (unsigned)__builtin_amdgcn_s_getreg((3 << 11) | 20) & 0xFu; }
#define XB_SPIN(cond, bar) do { unsigned _sp = 0; while (cond) { __builtin_amdgcn_s_sleep(1); \
    if ((++_sp & 255u) == 0u) { if (xb_ld(&(bar)[XB_TMO])) break; if (_sp > XB_SPIN_CAP) { atomicAdd(&(bar)[XB_TMO], 1u); break; } } } } while (0)
struct XcdBarrier { unsigned* bar; unsigned x; volatile LAS unsigned* st; };
__device__ __forceinline__ XcdBarrier xcd_barrier_post(unsigned* bar, volatile LAS unsigned* st) {
    XcdBarrier b; b.bar = bar; b.x = xb_xcc_id(); b.st = st;
    if (threadIdx.x == 0) (void)xb_add(&bar[XB_XCNT(b.x)], 1u);
    return b;
}
__device__ __forceinline__ void xcd_barrier_complete(unsigned* bar, unsigned x, unsigned& nloc, unsigned& nx) {
    const unsigned G = gridDim.x * gridDim.y * gridDim.z;
    unsigned sum, cnt, mine, sp = 0u;
    for (;;) {
        sum = 0u; cnt = 0u; mine = 0u;
#pragma unroll
        for (unsigned j = 0; j < 16; ++j) { const unsigned c = xb_ld(&bar[XB_XCNT(j)]); sum += c; cnt += (c > 0u) ? 1u : 0u; mine = (j == x) ? c : mine; }
        if (sum == G) break;
        __builtin_amdgcn_s_sleep(1);
        if ((++sp & 255u) == 0u) { if (xb_ld(&bar[XB_TMO])) break; if (sp > XB_SPIN_CAP) { atomicAdd(&bar[XB_TMO], 1u); break; } }
    }
    nloc = mine > 0u ? mine : 1u; nx = cnt > 0u ? cnt : 1u;
}
__device__ __forceinline__ void xcd_barrier(const XcdBarrier& b) {
    asm volatile("s_waitcnt vmcnt(0)" ::: "memory");
    __syncthreads();
    if (threadIdx.x == 0) {
        unsigned* bar = b.bar;
        __builtin_amdgcn_s_waitcnt(0);
        unsigned nloc = b.st[0], nx = b.st[1];
        if (nloc == 0u) { xcd_barrier_complete(bar, b.x, nloc, nx); b.st[0] = nloc; b.st[1] = nx; }
        const unsigned old = xb_add(&bar[XB_XSUB(b.x)], 1u);
        const unsigned gen = old / nloc;
        if (old + 1u == (gen + 1u) * nloc) {
            __builtin_amdgcn_fence(__ATOMIC_RELEASE, "agent");
            asm volatile("s_waitcnt vmcnt(0)" ::: "memory");
            const unsigned og = xb_add(&bar[XB_TOP], 1u);
            const unsigned tg = og / nx;
            if (og + 1u == (tg + 1u) * nx) xb_add(&bar[XB_TOPGEN], 1u);
            else XB_SPIN(xb_ld(&bar[XB_TOPGEN]) == tg, bar);
            __builtin_amdgcn_fence(__ATOMIC_ACQUIRE, "agent");
            xb_add(&bar[XB_XGEN(b.x)], 1u);
            asm volatile("s_waitcnt vmcnt(0)" ::: "memory");
        } else {
            XB_SPIN(xb_ld(&bar[XB_XGEN(b.x)]) == gen, bar);
            __builtin_amdgcn_fence(__ATOMIC_ACQUIRE, "agent");
            asm volatile("s_waitcnt vmcnt(0)" ::: "memory");
        }
    }
    __syncthreads();
}

struct Args { const void* in[26]; float* out; unsigned char* ws; int ph_lo, ph_hi, li, pad; };
enum { I_X = 0, I_C, I_POS, I_ADAW, I_ADAB, I_N1G, I_N2G, I_WIN, I_WOUT, I_SGLNG, I_SGLNB, I_SGW, I_SGB, I_PEK, I_PEV, I_CW1K, I_CW2K, I_CW1V, I_CW2V, I_RW, I_RB, I_EW1, I_EB1, I_EW2, I_EB2, I_FING };

#define GAS1 __attribute__((address_space(1)))
#define INP(A_, T_, i_) ({ int ix_ = (i_); asm volatile("" : "+s"(ix_)); (const T_*)(const GAS1 T_*)(A_).in[ix_]; })
struct Frame {
    LAS unsigned char* lds;
    unsigned* ctl;
    unsigned char* ws;
    int tid, lane, wave, vcu, G;
};
#define WSP(type, off) ((type*)(F.ws + (off)))
#define MODP(l, b, part) ((const float*)(F.ctl + CW_MOD) + ((size_t)((l) * 2 + (b)) * 6 + (part)) * 1024)

constexpr int RING_BYTES = 131072;
constexpr int ATT_LDS_BYTES = 147456;
constexpr int LDSCTL_OFF = ATT_LDS_BYTES;
constexpr int MISC_OFF = LDSCTL_OFF + 320;
constexpr int MOE_OFF = MISC_OFF + 128;
constexpr int LDS_BYTES = 163840;

struct EpiProj {
    static constexpr bool PERM = true;
    bf16_t *UG, *VG, *Q, *KC, *VC, *KS, *KW, *VST, *VWT; float* GATES; const float* ROPE; unsigned* kmax;
    __device__ __forceinline__ void operator()(const f32x4 (&acc)[2][2][4][2], const pg8::Unit& u, int wr, int wc, int fr, int fq) const {
        const int pn = u.pn; const int row0 = u.pm * 256 + wr * 64 + fr; const int b = u.pm >> 5;
        if (pn < 4 || pn == 6) {
#pragma unroll
            for (int ai = 0; ai < 2; ++ai)
#pragma unroll
                for (int m = 0; m < 4; ++m) { const size_t r = (size_t)(row0 + ai * 128 + m * 16);
#pragma unroll
                    for (int bj = 0; bj < 2; ++bj) { f32x4 v0 = acc[ai][bj][m][0], v1 = acc[ai][bj][m][1];
                        if (pn < 4) {
#pragma unroll
                            for (int i = 0; i < 4; ++i) { v0[i] = gelu_tanh(v0[i]); v1[i] = gelu_tanh(v1[i]); } }
                        u32x4 w; w.x = cvtpk(v0[0], v0[1]); w.y = cvtpk(v0[2], v0[3]); w.z = cvtpk(v1[0], v1[1]); w.w = cvtpk(v1[2], v1[3]);
                        bf16_t* dst;
                        if (pn < 2) dst = UG + r * 512 + pn * 256 + bj * 128 + wc * 32 + fq * 8;
                        else if (pn < 4) dst = VG + r * 512 + (pn - 2) * 256 + bj * 128 + wc * 32 + fq * 8;
                        else dst = (bj ? VC : KC) + r * 128 + wc * 32 + fq * 8;
                        *(u32x4*)dst = w; } }
        } else if (pn == 4 || pn == 5 || pn == 7) {
            const float sc = (pn == 7) ? 1.f : QSCALE; float nmax = 0.f;
#pragma unroll
            for (int ai = 0; ai < 2; ++ai)
#pragma unroll
                for (int m = 0; m < 4; ++m) { const size_t r = (size_t)(row0 + ai * 128 + m * 16);
                    const f32x4* cs = (const f32x4*)(ROPE + (r * 32 + fq * 8) * 2);
                    float o1[8], o2[8], nsq = 0.f;
#pragma unroll
                    for (int n = 0; n < 2; ++n) { const f32x4 c0 = cs[2 * n], c1 = cs[2 * n + 1]; const f32x4 x1 = acc[ai][0][m][n], x2 = acc[ai][1][m][n];
                        const float cc[4] = {c0[0], c0[2], c1[0], c1[2]}, ss[4] = {c0[1], c0[3], c1[1], c1[3]};
#pragma unroll
                        for (int i = 0; i < 4; ++i) { o1[4 * n + i] = (x1[i] * cc[i] - x2[i] * ss[i]) * sc; o2[4 * n + i] = (x2[i] * cc[i] + x1[i] * ss[i]) * sc; nsq += x1[i] * x1[i] + x2[i] * x2[i]; } }
                    u32x4 w1, w2; w1.x = cvtpk(o1[0], o1[1]); w1.y = cvtpk(o1[2], o1[3]); w1.z = cvtpk(o1[4], o1[5]); w1.w = cvtpk(o1[6], o1[7]);
                    w2.x = cvtpk(o2[0], o2[1]); w2.y = cvtpk(o2[2], o2[3]); w2.z = cvtpk(o2[4], o2[5]); w2.w = cvtpk(o2[6], o2[7]);
                    if (pn != 7) { bf16_t* dst = Q + r * 512 + (4 * (pn - 4) + wc) * 64 + fq * 8; *(u32x4*)dst = w1; *(u32x4*)(dst + 32) = w2; }
                    else { bf16_t* img = ((wc < 2) ? KS : KW) + (size_t)(b * 2 + (wc & 1)) * SEQ * 64; const int t = (int)r & (SEQ - 1);
                        *(u32x4*)(img + kfrag_off(t, fq)) = w1; *(u32x4*)(img + kfrag_off(t, 4 + fq)) = w2; }
                    nsq = kg_sum(nsq); nmax = fmaxf(nmax, nsq); }
            if (pn == 7) {
#pragma unroll
                for (int o = 1; o < 16; o <<= 1) nmax = fmaxf(nmax, __shfl_xor(nmax, o));
                if ((threadIdx.x & 63) == 0) atomicMax(kmax + ((wc < 2) ? 0 : 8) + b * 2 + (wc & 1), __float_as_uint(nmax * 1.02f));
            }
        } else if (pn == 8) {
            const int g = wc >> 1; float vmx = 0.f;
#pragma unroll
            for (int ai = 0; ai < 2; ++ai)
#pragma unroll
                for (int m = 0; m < 4; ++m) { const int r = row0 + ai * 128 + m * 16; const int s = r & (SEQ - 1);
#pragma unroll
                    for (int bj = 0; bj < 2; ++bj) { bf16_t* img = (bj ? VWT : VST) + (size_t)(b * 2 + g) * SEQ * 64;
#pragma unroll
                        for (int n = 0; n < 2; ++n)
#pragma unroll
                            for (int i = 0; i < 4; ++i) { img[vfrag_off(s, (wc & 1) * 32 + fq * 8 + n * 4 + i)] = (bf16_t)(cvtpk(acc[ai][bj][m][n][i], 0.f) & 0xffffu); if (bj == 0) vmx = fmaxf(vmx, fabsf(acc[ai][0][m][n][i])); } } }
#pragma unroll
            for (int o = 1; o < 64; o <<= 1) vmx = fmaxf(vmx, __shfl_xor(vmx, o));
            if ((threadIdx.x & 63) == 0) atomicMax(kmax + 4 + b * 2 + g, __float_as_uint(vmx * 1.01f));
        } else {
            if (wc == 0 && fq < 3) {
#pragma unroll
                for (int ai = 0; ai < 2; ++ai)
#pragma unroll
                    for (int m = 0; m < 4; ++m) { const size_t r = (size_t)(row0 + ai * 128 + m * 16);
#pragma unroll
                        for (int n = 0; n < 2; ++n) { f32x4 v = acc[ai][0][m][n];
#pragma unroll
                            for (int i = 0; i < 4; ++i) v[i] = sigmoidf_(v[i]);
                            *(f32x4*)(GATES + r * 24 + fq * 8 + n * 4) = v; } }
            }
        }
    }
};
struct EpiOut {
    static constexpr bool PERM = false;
    const float* xin; float* xout; const float* g1;
    __device__ __forceinline__ void operator()(const f32x4 (&acc)[2][2][4][2], const pg8::Unit& u, int wr, int wc, int fr, int fq) const {
        const int row0 = u.pm * 256 + wr * 64 + fr; const int b = u.pm >> 5; const int col0 = u.pn * 256 + wc * 32 + fq * 4;
        const float* gb = g1 + (size_t)b * 6144 + 2048;
        f32x4 gv[2][2];
#pragma unroll
        for (int bj = 0; bj < 2; ++bj)
#pragma unroll
            for (int n = 0; n < 2; ++n) gv[bj][n] = *(const f32x4*)(gb + col0 + bj * 128 + n * 16);
#pragma unroll
        for (int ai = 0; ai < 2; ++ai)
#pragma unroll
            for (int m = 0; m < 4; ++m) { const size_t off = (size_t)(row0 + ai * 128 + m * 16) * DM + col0;
#pragma unroll
                for (int bj = 0; bj < 2; ++bj)
#pragma unroll
                    for (int n = 0; n < 2; ++n) { const f32x4 xi = *(const f32x4*)(xin + off + bj * 128 + n * 16); *(f32x4*)(xout + off + bj * 128 + n * 16) = xi + gv[bj][n] * acc[ai][bj][m][n]; } }
    }
};
struct EpiSwiglu {
    static constexpr bool PERM = true;
    unsigned char* ACT; const float* b1;
    __device__ __forceinline__ void operator()(const f32x4 (&acc)[2][2][4][2], const pg8::Unit& u, int wr, int wc, int fr, int fq) const {
        const int row0 = u.pm * 256 + wr * 64 + fr; const int j0 = u.pnl * 128 + wc * 32 + fq * 8;
        const float* bb = b1 + (size_t)u.e * 2048 + j0;
        f32x4 bg[2], bl[2];
#pragma unroll
        for (int n = 0; n < 2; ++n) { bg[n] = *(const f32x4*)(bb + n * 4); bl[n] = *(const f32x4*)(bb + 1024 + n * 4); }
#pragma unroll
        for (int ai = 0; ai < 2; ++ai)
#pragma unroll
            for (int m = 0; m < 4; ++m) { float o[8];
#pragma unroll
                for (int n = 0; n < 2; ++n) { const f32x4 gl = acc[ai][0][m][n] + bg[n], ln = acc[ai][1][m][n] + bl[n];
#pragma unroll
                    for (int i = 0; i < 4; ++i) { const float gg = fminf(gl[i], 7.f), ll = fminf(fmaxf(ln[i], -7.f), 7.f); o[n * 4 + i] = gg * sigmoidf_(1.702f * gg) * (ll + 1.f); } }
                u32x2 w; w.x = cvt4_fp8(o[0], o[1], o[2], o[3]); w.y = cvt4_fp8(o[4], o[5], o[6], o[7]);
                *(u32x2*)(ACT + (size_t)(row0 + ai * 128 + m * 16) * FF + j0) = w; }
    }
};
struct EpiDown {
    static constexpr bool PERM = true;
    unsigned char* YR; const float* b2;
    __device__ __forceinline__ void operator()(const f32x4 (&acc)[2][2][4][2], const pg8::Unit& u, int wr, int wc, int fr, int fq) const {
        const int row0 = u.pm * 256 + wr * 64 + fr; const int c0 = u.pnl * 256 + wc * 32 + fq * 8;
        const float* bb = b2 + (size_t)u.e * 1024 + c0;
        f32x4 bv[2][2];
#pragma unroll
        for (int bj = 0; bj < 2; ++bj)
#pragma unroll
            for (int n = 0; n < 2; ++n) bv[bj][n] = *(const f32x4*)(bb + bj * 128 + n * 4);
#pragma unroll
        for (int ai = 0; ai < 2; ++ai)
#pragma unroll
            for (int m = 0; m < 4; ++m)
#pragma unroll
                for (int bj = 0; bj < 2; ++bj) { const f32x4 v0 = acc[ai][bj][m][0] + bv[bj][0], v1 = acc[ai][bj][m][1] + bv[bj][1];
                    u32x2 w; w.x = cvt4_fp8(v0[0], v0[1], v0[2], v0[3]); w.y = cvt4_fp8(v1[0], v1[1], v1[2], v1[3]);
                    *(u32x2*)(YR + (size_t)(row0 + ai * 128 + m * 16) * DM + c0 + bj * 128) = w; }
    }
};

__device__ __forceinline__ void tr_item(const float* W, int ldn, int k0, int c0, int nvalid, bf16_t* WT, int K, int drow0, LAS float* scr, int lane) {
    const int nn = lane & 31;
#pragma unroll 8
    for (int i = 0; i < 32; ++i) { const int kk = 2 * i + (lane >> 5); scr[kk * 33 + nn] = (nn < nvalid) ? W[(size_t)(k0 + kk) * ldn + c0 + nn] : 0.f; }
    LDS_WAIT(); asm volatile("" ::: "memory");
    const int c = lane & 7;
#pragma unroll
    for (int j = 0; j < 4; ++j) { const int n = (lane >> 3) + 8 * j; const LAS float* s = scr + (8 * c) * 33 + n;
        u32x4 o; o.x = cvtpk(s[0 * 33], s[1 * 33]); o.y = cvtpk(s[2 * 33], s[3 * 33]); o.z = cvtpk(s[4 * 33], s[5 * 33]); o.w = cvtpk(s[6 * 33], s[7 * 33]);
        *(u32x4*)(WT + (size_t)(drow0 + n) * K + k0 + 8 * c) = o; }
    LDS_WAIT(); asm volatile("" ::: "memory");
}
template <bool NTS> __device__ __forceinline__ void tr_item8(const float* W, int ldn, int k0, int c0, unsigned char* W8, int K, int drow0, LAS float* scr, int lane) {
    const int nn = lane & 31;
#pragma unroll 8
    for (int i = 0; i < 32; ++i) { const int kk = 2 * i + (lane >> 5); scr[kk * 33 + nn] = __builtin_nontemporal_load(W + (size_t)(k0 + kk) * ldn + c0 + nn) * W8SCALE; }
    LDS_WAIT(); asm volatile("" ::: "memory");
    const int c = lane & 3;
#pragma unroll
    for (int j = 0; j < 2; ++j) { const int n = (lane >> 2) + 16 * j; const LAS float* s = scr + (16 * c) * 33 + n;
        u32x4 o; o.x = cvt4_fp8(s[0 * 33], s[1 * 33], s[2 * 33], s[3 * 33]); o.y = cvt4_fp8(s[4 * 33], s[5 * 33], s[6 * 33], s[7 * 33]);
        o.z = cvt4_fp8(s[8 * 33], s[9 * 33], s[10 * 33], s[11 * 33]); o.w = cvt4_fp8(s[12 * 33], s[13 * 33], s[14 * 33], s[15 * 33]);
        if (NTS) __builtin_nontemporal_store(o, (u32x4*)(W8 + (size_t)(drow0 + n) * K + k0 + 16 * c)); else *(u32x4*)(W8 + (size_t)(drow0 + n) * K + k0 + 16 * c) = o; }
    LDS_WAIT(); asm volatile("" ::: "memory");
}
__device__ __forceinline__ void win_src(int p, int& c0, int& nvalid) {
    const int pn = p >> 8; nvalid = 32;
    if (pn < 4 || pn == 6) { c0 = p; }
    else if (pn == 4 || pn == 5) { const int pp = p - 1024 - 256 * (pn - 4), bj = pp >> 7, j = pp & 127; c0 = 1024 + (4 * (pn - 4) + (j >> 5)) * 64 + bj * 32; }
    else if (pn == 7) { const int pp = p - 1792, bj = pp >> 7, j = pp & 127, which = j >> 6, g = (j >> 5) & 1; c0 = (which ? 2048 : 1792) + g * 64 + bj * 32; }
    else if (pn == 8) { const int pp = p - 2048, bj = pp >> 7, j = pp & 127; c0 = (bj ? 2176 : 1920) + j; }
    else { const int pp = p - 2304; c0 = 2304 + pp; nvalid = 24 - pp; nvalid = nvalid < 0 ? 0 : (nvalid > 32 ? 32 : nvalid); if (nvalid == 0) c0 = 0; }
}
__device__ __forceinline__ void phase_prologue(Frame& F, const Args& a) {
    LAS float* scr = (LAS float*)(F.lds + F.wave * 8704);
    const int gw = F.vcu * NWAVES + F.wave, NGW = F.G * NWAVES; const int lane = F.lane;
    {
        const float* c = INP(a, float, I_C); const float* adaw = INP(a, float, I_ADAW); const float* adab = INP(a, float, I_ADAB);
        float* mod = (float*)(F.ctl + CW_MOD);
        LAS float* red = (LAS float*)(F.lds + 8 * 8704);
        for (int it = F.vcu; it < 2 * 24; it += F.G) {
            const int l = it / 24, nb = it % 24;
            const float* wp = adaw + ((size_t)l * 1024 + F.wave * 128) * 6144 + nb * 256 + lane * 4;
            f32x4 a0 = {0.f, 0.f, 0.f, 0.f}, a1 = a0;
#pragma unroll 4
            for (int k = 0; k < 128; ++k) { const f32x4 w = __builtin_nontemporal_load((const f32x4*)(wp + (size_t)k * 6144));
                const float c0 = c[F.wave * 128 + k], c1 = c[1024 + F.wave * 128 + k]; const float s0 = c0 * sigmoidf_(c0), s1 = c1 * sigmoidf_(c1);
                a0 += w * s0; a1 += w * s1; }
            *(LAS f32x4*)(red + (F.wave * 2 + 0) * 256 + lane * 4) = a0; *(LAS f32x4*)(red + (F.wave * 2 + 1) * 256 + lane * 4) = a1;
            __syncthreads();
            { const int b = F.tid >> 8, col = F.tid & 255; float sum = adab[(size_t)l * 6144 + nb * 256 + col];
#pragma unroll
              for (int ww = 0; ww < 8; ++ww) sum += red[(ww * 2 + b) * 256 + col];
              mod[((size_t)l * 2 + b) * 6144 + nb * 256 + col] = sum; }
            __syncthreads();
        }
    }
    {
        const float* win = INP(a, float, I_WIN); bf16_t* WinT = WSP(bf16_t, WS_WIN);
        for (int it = gw; it < 2 * 16 * 80; it += NGW) { const int l = it / 1280, kb = (it % 1280) / 80, nb = it % 80; int c0, nv; win_src(nb * 32, c0, nv);
            tr_item(win + (size_t)l * 1024 * PIN, PIN, kb * 64, c0, nv, WinT + (size_t)l * PINP * 1024, 1024, nb * 32, scr, lane); }
        const float* wout = INP(a, float, I_WOUT); bf16_t* WoutT = WSP(bf16_t, WS_WOUT);
        for (int it = gw; it < 2 * 16 * 32; it += NGW) { const int l = it / 512, kb = (it % 512) / 32, nb = it % 32;
            tr_item(wout + (size_t)l * 1024 * 1024, 1024, kb * 64, nb * 32, 32, WoutT + (size_t)l * 1024 * 1024, 1024, nb * 32, scr, lane); }
        bf16_t* CW1 = WSP(bf16_t, WS_CW1);
        for (int it = gw; it < 2 * 2 * 32 * 2; it += NGW) { const int l = it / 128, which = (it / 64) & 1, kb = (it % 64) / 2, nb = it & 1;
            const float* src = INP(a, float, which ? I_CW1V : I_CW1K) + (size_t)l * 2048 * 64;
            tr_item(src, 64, kb * 64, nb * 32, 32, CW1 + (size_t)(l * 2 + which) * 64 * 2048, 2048, nb * 32, scr, lane); }
        const float* ew1 = INP(a, float, I_EW1); unsigned char* W1T = WSP(unsigned char, WS_W1T);
        for (int it = gw; it < 2 * 32 * 16 * 64; it += NGW) { const int le = it >> 10, kb = (it >> 6) & 15, nb = it & 63; const int p = nb * 32, tile = p >> 8, bj = (p >> 7) & 1, j = p & 127;
            if (le < 32) tr_item8<false>(ew1 + (size_t)le * 1024 * 2048, 2048, kb * 64, bj * 1024 + tile * 128 + j, W1T + (size_t)le * 2048 * 1024, 1024, p, scr, lane);
            else tr_item8<true>(ew1 + (size_t)le * 1024 * 2048, 2048, kb * 64, bj * 1024 + tile * 128 + j, W1T + (size_t)le * 2048 * 1024, 1024, p, scr, lane); }
        const float* ew2 = INP(a, float, I_EW2); unsigned char* W2T = WSP(unsigned char, WS_W2T);
        for (int it = gw; it < 2 * 32 * 16 * 32; it += NGW) { const int le = it >> 9, kb = (it >> 5) & 15, nb = it & 31;
            if (le < 32) tr_item8<false>(ew2 + (size_t)le * 1024 * 1024, 1024, kb * 64, nb * 32, W2T + (size_t)le * 1024 * 1024, 1024, nb * 32, scr, lane);
            else tr_item8<true>(ew2 + (size_t)le * 1024 * 1024, 1024, kb * 64, nb * 32, W2T + (size_t)le * 1024 * 1024, 1024, nb * 32, scr, lane); }
    }
    {
        const int gt = (F.vcu * NWAVES + F.wave) * 64 + lane, NGT = NGW * 64;
        const float* sgw = INP(a, float, I_SGW); bf16_t* SGW = WSP(bf16_t, WS_SGW);
        for (int i = gt; i < 2 * 8 * 128 * 128; i += NGT) { const int s = i & 127, t = (i >> 7) & 127; SGW[i] = (bf16_t)(cvtpk(s <= t ? sgw[i] : 0.f, 0.f) & 0xffffu); }
        const int* pos = INP(a, int, I_POS); float* rope = WSP(float, WS_ROPE);
        for (int i = gt; i < T * 32; i += NGT) { const int tok = i >> 5, d = i & 31;
            const double inv = exp2(-(double)d * (13.287712379549449 / 32.0));
            const double rv = (double)pos[tok] * inv * 0.15915494309189535; const float fr = (float)(rv - __builtin_rint(rv));
            rope[2 * i] = __builtin_amdgcn_cosf(fr); rope[2 * i + 1] = __builtin_amdgcn_sinf(fr); }
        bf16_t* H = WSP(bf16_t, WS_H);
        for (int i = gt; i < 1024; i += NGT) { H[(size_t)T * 1024 + i] = 0; WSP(unsigned char, WS_H8)[(size_t)T * 1024 + i] = 0; }
        bf16_t* KCMP = WSP(bf16_t, WS_KCMP); bf16_t* VCT = WSP(bf16_t, WS_VCT);
        for (int i = gt; i < 2 * 2 * 64; i += NGT) { const int b = i >> 7, g = (i >> 6) & 1, d = i & 63; KCMP[(size_t)(b * 2 + g) * 512 * 64 + kfrag_off(511, d >> 3) + (d & 7)] = 0; VCT[(size_t)(b * 2 + g) * 512 * 64 + vfrag_off(511, d)] = 0; }
    }
    {
        float* cb = WSP(float, WS_MISC);
        for (int it = gw; it < 2 * 2 * 64; it += NGW) { const int l = it >> 7, which = (it >> 6) & 1, n = it & 63;
            const float* pe = INP(a, float, which ? I_PEV : I_PEK) + (size_t)l * 2048; const float* w1 = INP(a, float, which ? I_CW1V : I_CW1K) + (size_t)l * 2048 * 64;
            float s = 0.f; for (int k = lane; k < 2048; k += 64) s += pe[k] * w1[(size_t)k * 64 + n];
            s = wave_sum(s); if (lane == 0) cb[it] = s; }
    }
}

struct RowV { f32x4 v[4]; };
__device__ __forceinline__ RowV row_load(const float* p, int lane) { RowV r; const f32x4* q = (const f32x4*)p + lane;
#pragma unroll
    for (int j = 0; j < 4; ++j) r.v[j] = q[64 * j]; return r; }
__device__ __forceinline__ float row_ssq(const RowV& r) { float s = 0.f;
#pragma unroll
    for (int j = 0; j < 4; ++j) s += (r.v[j].x * r.v[j].x + r.v[j].y * r.v[j].y) + (r.v[j].z * r.v[j].z + r.v[j].w * r.v[j].w); return wave_sum(s); }
__device__ __forceinline__ void row_norm_store(const RowV& x, float rstd, const float* g, const float* sc, const float* sh, bf16_t* orow, int lane) {
    u32x2* o8 = (u32x2*)orow + lane;
#pragma unroll
    for (int j = 0; j < 4; ++j) { const f32x4 gg = ((const f32x4*)g)[lane + 64 * j], ss = ((const f32x4*)sc)[lane + 64 * j], hh = ((const f32x4*)sh)[lane + 64 * j];
        const f32x4 y = x.v[j] * rstd * gg * (ss + 1.f) + hh; u32x2 w; w.x = cvtpk(y.x, y.y); w.y = cvtpk(y.z, y.w); o8[64 * j] = w; }
}
__device__ __forceinline__ void row_norm_store8(const RowV& x, float rstd, const float* g, const float* sc, const float* sh, unsigned char* orow, int lane) {
    unsigned* o4 = (unsigned*)orow + lane;
#pragma unroll
    for (int j = 0; j < 4; ++j) { const f32x4 gg = ((const f32x4*)g)[lane + 64 * j], ss = ((const f32x4*)sc)[lane + 64 * j], hh = ((const f32x4*)sh)[lane + 64 * j];
        const f32x4 y = x.v[j] * rstd * gg * (ss + 1.f) + hh; o4[64 * j] = cvt4_fp8(y.x, y.y, y.z, y.w); }
}
__device__ __forceinline__ int expert_block_prefix(const unsigned* cnt, int lane) {
    int nb = (lane < NE) ? (int)((cnt[lane] + 255u) >> 8) : 0; int inc = nb;
#pragma unroll
    for (int o = 1; o < 32; o <<= 1) { const int t = __shfl_up(inc, o); if ((lane & 31) >= o) inc += t; }
    return inc - nb;
}
__device__ __forceinline__ void phase_n1_first(Frame& F, const Args& a) {
    const int gw = F.vcu * NWAVES + F.wave, NGW = F.G * NWAVES; const int lane = F.lane;
    const float* x = INP(a, float, I_X); const float* g = INP(a, float, I_N1G); bf16_t* H = WSP(bf16_t, WS_H);
    for (int m = gw; m < T; m += 2 * NGW) { const int m2 = m + NGW; const int b = m >> 13, b2 = m2 >> 13;
        const RowV r = row_load(x + (size_t)m * DM, lane); const RowV r2 = row_load(x + (size_t)m2 * DM, lane);
        const float rstd = 1.f / sqrtf(row_ssq(r) * (1.f / DM) + NORM_EPS), rstd2 = 1.f / sqrtf(row_ssq(r2) * (1.f / DM) + NORM_EPS);
        row_norm_store(r, rstd, g, MODP(0, b, 1), MODP(0, b, 0), H + (size_t)m * DM, lane);
        row_norm_store(r2, rstd2, g, MODP(0, b2, 1), MODP(0, b2, 0), H + (size_t)m2 * DM, lane); }
    float* RWP = WSP(float, WS_RWP); float* RBP = WSP(float, WS_MISC + 4096);
    const float* rw = INP(a, float, I_RW); const float* rb = INP(a, float, I_RB); const float* n2g = INP(a, float, I_N2G);
    const int gt = gw * 64 + lane, NGT = NGW * 64;
    for (int i = gt; i < 2 * 2 * 1024 * 32; i += NGT) { const int l = i >> 16, b = (i >> 15) & 1, k = (i >> 5) & 1023, e = i & 31;
        RWP[i] = n2g[l * 1024 + k] * (1.f + MODP(l, b, 4)[k]) * rw[((size_t)l * 1024 + k) * 32 + e]; }
    for (int it = gw; it < 2 * 2 * 32; it += NGW) { const int l = it >> 6, b = (it >> 5) & 1, e = it & 31; float s = 0.f;
        for (int k = lane; k < 1024; k += 64) s += MODP(l, b, 3)[k] * rw[((size_t)l * 1024 + k) * 32 + e];
        s = wave_sum(s); if (lane == 0) RBP[it] = s + rb[l * 32 + e]; }
}
__device__ __forceinline__ void phase_combine(Frame& F, const Args& a, int l) {
    const int gw = F.vcu * NWAVES + F.wave, NGW = F.G * NWAVES; const int lane = F.lane;
    float* XR = WSP(float, WS_XR); bf16_t* H = WSP(bf16_t, WS_H); const unsigned char* YR = WSP(unsigned char, WS_YROWS);
    const int* ASG = WSP(int, WS_ASG); const float* G4 = WSP(float, WS_GATE4);
    const int myprefix = expert_block_prefix(F.ctl + CW_CNT + l * 32, lane);
    const bool last = (l == DEPTH - 1);
    const float* g = last ? INP(a, float, I_FING) : INP(a, float, I_N1G) + (l + 1) * 1024;
#define COMB_LOAD(R_, WV_, GT_, M_) do { const int4 as4_ = *(const int4*)(ASG + (M_) * 4); const f32x4 gt4_ = *(const f32x4*)(G4 + (M_) * 4); \
        R_ = row_load(XR + (size_t)(M_) * DM, lane); const int asv_[4] = {as4_.x, as4_.y, as4_.z, as4_.w}; GT_[0] = gt4_.x; GT_[1] = gt4_.y; GT_[2] = gt4_.z; GT_[3] = gt4_.w; \
        _Pragma("unroll") for (int k = 0; k < 4; ++k) { const int e = asv_[k] >> 16, slot = asv_[k] & 0xffff; const int blk = __shfl(myprefix, e); \
            const unsigned* yr = (const unsigned*)(YR + ((size_t)blk * 256 + slot) * DM) + lane; _Pragma("unroll") for (int j = 0; j < 4; ++j) WV_[k][j] = __builtin_nontemporal_load(yr + 64 * j); } } while (0)
#define COMB_FINISH(R_, WV_, GT_, M_) do { const int b = (M_) >> 13; f32x4 y[4]; \
        _Pragma("unroll") for (int j = 0; j < 4; ++j) y[j] = (f32x4){0.f, 0.f, 0.f, 0.f}; \
        _Pragma("unroll") for (int k = 0; k < 4; ++k) _Pragma("unroll") for (int j = 0; j < 4; ++j) { const int w = (int)WV_[k][j]; const f32x2 lo_ = __builtin_amdgcn_cvt_pk_f32_fp8(w, false), hi_ = __builtin_amdgcn_cvt_pk_f32_fp8(w, true); y[j] += (f32x4){lo_.x, lo_.y, hi_.x, hi_.y} * GT_[k]; } \
        const float* g2 = MODP(l, b, 5); \
        _Pragma("unroll") for (int j = 0; j < 4; ++j) R_.v[j] += ((const f32x4*)g2)[lane + 64 * j] * y[j]; \
        const float rstd = 1.f / sqrtf(row_ssq(R_) * (1.f / DM) + NORM_EPS); \
        if (last) { f32x4* o = (f32x4*)(a.out + (size_t)(M_) * DM) + lane; _Pragma("unroll") for (int j = 0; j < 4; ++j) o[64 * j] = R_.v[j] * rstd * ((const f32x4*)g)[lane + 64 * j]; } \
        else { f32x4* xo = (f32x4*)(XR + (size_t)(M_) * DM) + lane; _Pragma("unroll") for (int j = 0; j < 4; ++j) xo[64 * j] = R_.v[j]; \
            row_norm_store(R_, rstd, g, MODP(l + 1, b, 1), MODP(l + 1, b, 0), H + (size_t)(M_) * DM, lane); } } while (0)
    for (int m = gw; m < T; m += 2 * NGW) { const int m2 = m + NGW;
        RowV rA, rB; unsigned wA[4][4], wB[4][4]; float gA[4], gB[4];
        COMB_LOAD(rA, wA, gA, m); COMB_LOAD(rB, wB, gB, m2);
        COMB_FINISH(rA, wA, gA, m); COMB_FINISH(rB, wB, gB, m2);
    }
#undef COMB_LOAD
#undef COMB_FINISH
}
__device__ __forceinline__ void compress_item(Frame& F, const Args& a, int l, int item) {
    const int which = item >> 7, b = (item >> 6) & 1, g = (item >> 5) & 1, n0 = (item & 31) * 16;
    const int lane = F.lane, w = F.wave, r16 = lane & 15, kg = lane >> 4;
    const bf16_t* src = WSP(bf16_t, which ? WS_VC : WS_KC);
    const bf16_t* W1 = WSP(bf16_t, WS_CW1) + (size_t)(l * 2 + which) * 64 * 2048;
    LAS float* red = (LAS float*)F.lds;
    LAS float* hid = (LAS float*)(F.lds + 32768);
    f32x4 acc[4];
#pragma unroll
    for (int i = 0; i < 4; ++i) acc[i] = (f32x4){0.f, 0.f, 0.f, 0.f};
    const int n = n0 + r16; const bool nval = n < NCMP;
#pragma unroll 2
    for (int ks = 0; ks < 8; ++ks) { const int k = 256 * w + 32 * ks + 8 * kg; const int li = k >> 6, d = k & 63;
        bf16x8 af = (bf16x8){0, 0, 0, 0, 0, 0, 0, 0};
        if (nval) af = *(const bf16x8*)(src + ((size_t)b * SEQ + 16 * n + li) * 128 + g * 64 + d);
#pragma unroll
        for (int nt = 0; nt < 4; ++nt) { const bf16x8 bf = *(const bf16x8*)(W1 + (size_t)(nt * 16 + r16) * 2048 + k); acc[nt] = __builtin_amdgcn_mfma_f32_16x16x32_bf16(af, bf, acc[nt], 0, 0, 0); } }
#pragma unroll
    for (int nt = 0; nt < 4; ++nt)
#pragma unroll
        for (int i = 0; i < 4; ++i) red[(w * 16 + 4 * kg + i) * 64 + nt * 16 + r16] = acc[nt][i];
    __syncthreads();
    const float* cb = WSP(float, WS_MISC) + (l * 2 + which) * 64;
    for (int i = F.tid; i < 1024; i += NTHREADS) { float s = cb[i & 63];
#pragma unroll
        for (int ww = 0; ww < 8; ++ww) s += red[ww * 1024 + i];
        hid[i] = gelu_tanh(s); }
    { const float* w2 = INP(a, float, which ? I_CW2V : I_CW2K) + (size_t)l * 4096; LAS f32x4* w2s4 = (LAS f32x4*)(F.lds + 40960);
      for (int i = F.tid; i < 1024; i += NTHREADS) w2s4[i] = ((const f32x4*)w2)[i]; }
    __syncthreads();
    {
        const int nn = F.tid >> 5, c = F.tid & 31; LAS float* w2s = (LAS float*)(F.lds + 40960);
        float o1 = 0.f, o2 = 0.f;
#pragma unroll 16
        for (int k = 0; k < 64; ++k) { const float h = hid[nn * 64 + k]; o1 += h * w2s[k * 64 + c]; o2 += h * w2s[k * 64 + c + 32]; }
        const int np = n0 + nn; float nsq_ = 0.f;
        if (np < NCMP) {
            if (!which) { const float* cs = WSP(float, WS_ROPE) + (((size_t)b * SEQ + 16 * np + 31) * 32 + c) * 2; const float cc = cs[0], ss = cs[1];
                const float r1 = o1 * cc - o2 * ss, r2 = o2 * cc + o1 * ss;
                bf16_t* img = WSP(bf16_t, WS_KCMP) + (size_t)(b * 2 + g) * 512 * 64; img[kfrag_off(np, c >> 3) + (c & 7)] = (bf16_t)(cvtpk(r1, 0.f) & 0xffffu); img[kfrag_off(np, 4 + (c >> 3)) + (c & 7)] = (bf16_t)(cvtpk(r2, 0.f) & 0xffffu);
                nsq_ = r1 * r1 + r2 * r2;
            } else { bf16_t* img = WSP(bf16_t, WS_VCT) + (size_t)(b * 2 + g) * 512 * 64; img[vfrag_off(np, c)] = (bf16_t)(cvtpk(o1, 0.f) & 0xffffu); img[vfrag_off(np, c + 32)] = (bf16_t)(cvtpk(o2, 0.f) & 0xffffu); }
        }
        if (!which) {
            float mx = quad_sum(nsq_);
            mx += __uint_as_float(__builtin_amdgcn_update_dpp(0u, __float_as_uint(mx), 0x141, 0xF, 0xF, true)); mx += __uint_as_float(__builtin_amdgcn_update_dpp(0u, __float_as_uint(mx), 0x140, 0xF, 0xF, true));
            mx = x16_sum(mx);
            mx = x32_max(mx);
            if (F.lane == 0) atomicMax(F.ctl + CW_KMAX + l * 16 + 12 + b * 2 + g, __float_as_uint(mx * 1.02f));
        }
    }
    __syncthreads();
}
__device__ __forceinline__ void sgu_item(Frame& F, const Args& a, int l, int ch) {
    const size_t tok0 = (size_t)ch * 128;
    const int lane = F.lane, w = F.wave, r16 = lane & 15, kg = lane >> 4;
    const bf16_t* VG = WSP(bf16_t, WS_VG); const bf16_t* UG = WSP(bf16_t, WS_UG); bf16_t* Y = WSP(bf16_t, WS_Y);
    LAS float* stats = (LAS float*)F.lds;
    LAS bf16_t* vnT = (LAS bf16_t*)(F.lds + 1024);
    constexpr int VP = 136;
    static_assert(1024 + 8 * 64 * 136 * 2 <= ATT_LDS_BYTES, "SGU LDS map");
    {
        u32x4 vrow[16];
#pragma unroll
        for (int tt = 0; tt < 16; ++tt) vrow[tt] = *(const u32x4*)(VG + (tok0 + 16 * w + tt) * 512 + lane * 8);
#pragma unroll
        for (int tt = 0; tt < 16; ++tt) { const int s = 16 * w + tt; const u32x4 v = vrow[tt];
            const float f[8] = {bflo(v.x), bfhi(v.x), bflo(v.y), bfhi(v.y), bflo(v.z), bfhi(v.z), bflo(v.w), bfhi(v.w)};
            float sm = 0.f;
#pragma unroll
            for (int i = 0; i < 8; ++i) sm += f[i];
            const float mu = wave_sum(sm) * (1.f / 512.f); float q = 0.f;
#pragma unroll
            for (int i = 0; i < 8; ++i) q += (f[i] - mu) * (f[i] - mu);
            const float var = wave_sum(q) * (1.f / 512.f);
            if (lane == 0) { stats[2 * s] = mu; stats[2 * s + 1] = 1.f / sqrtf(var + NORM_EPS); } }
    }
    __syncthreads();
    {
        const int s = F.tid & 127, hq = F.tid >> 7; const float mu = stats[2 * s], rs = stats[2 * s + 1];
#pragma unroll
        for (int hp = 0; hp < 2; ++hp) { const int h = hq + 4 * hp; const int cbase = h * 64;
            const float* lg = INP(a, float, I_SGLNG) + l * 512 + cbase; const float* lb = INP(a, float, I_SGLNB) + l * 512 + cbase;
#pragma unroll 2
            for (int d0 = 0; d0 < 64; d0 += 8) { const u32x4 v = *(const u32x4*)(VG + (tok0 + s) * 512 + cbase + d0);
                const float f[8] = {bflo(v.x), bfhi(v.x), bflo(v.y), bfhi(v.y), bflo(v.z), bfhi(v.z), bflo(v.w), bfhi(v.w)};
#pragma unroll
                for (int i = 0; i < 8; ++i) vnT[(h * 64 + d0 + i) * VP + s] = (bf16_t)(cvtpk((f[i] - mu) * rs * lg[d0 + i] + lb[d0 + i], 0.f) & 0xffffu); } }
    }
    __syncthreads();
    {
        const int h = w;
        const bf16_t* Wm = WSP(bf16_t, WS_SGW) + (size_t)(l * 8 + h) * 128 * 128; const float* bs = INP(a, float, I_SGB) + (size_t)(l * 8 + h) * 128;
#pragma nounroll
        for (int tt = 0; tt < 8; ++tt) {
            const int t = 16 * tt + r16; const float bb = bs[t];
            bf16x8 bw[4]; u32x2 ugv[4];
#pragma unroll
            for (int ks = 0; ks < 4; ++ks) bw[ks] = *(const bf16x8*)(Wm + (size_t)t * 128 + 32 * ks + 8 * kg);
#pragma unroll
            for (int dt = 0; dt < 4; ++dt) ugv[dt] = *(const u32x2*)(UG + (tok0 + t) * 512 + h * 64 + dt * 16 + 4 * kg);
            f32x4 acc[4];
#pragma unroll
            for (int i = 0; i < 4; ++i) acc[i] = (f32x4){0.f, 0.f, 0.f, 0.f};
            const int nks = (16 * tt + 15) / 32 + 1;
#pragma unroll
            for (int ks = 0; ks < 4; ++ks) { if (ks < nks) {
#pragma unroll
                for (int dt = 0; dt < 4; ++dt) { const bf16x8 afr = *(const LAS bf16x8*)(vnT + (h * 64 + dt * 16 + r16) * VP + 32 * ks + 8 * kg); acc[dt] = __builtin_amdgcn_mfma_f32_16x16x32_bf16(afr, bw[ks], acc[dt], 0, 0, 0); } } }
#pragma unroll
            for (int dt = 0; dt < 4; ++dt) { const u32x2 uu = ugv[dt];
                u32x2 o; o.x = cvtpk(bflo(uu.x) * (acc[dt][0] + bb), bfhi(uu.x) * (acc[dt][1] + bb)); o.y = cvtpk(bflo(uu.y) * (acc[dt][2] + bb), bfhi(uu.y) * (acc[dt][3] + bb));
                *(u32x2*)(Y + (tok0 + t) * 1024 + h * 64 + dt * 16 + 4 * kg) = o; }
        }
    }
    __syncthreads();
}
namespace att {
constexpr int OSP = 65;
constexpr int L_OH = 0;
constexpr int L_OL = 66560;
constexpr int L_LS = 133120;
constexpr int L_MREF = L_LS + 2048;
constexpr int USP = 129;
constexpr int L_SEL = L_MREF + 1024;
constexpr int L_CNT = L_SEL + 1024;
constexpr int L_LIST = L_CNT + 512;
constexpr int L_WCTR = L_LIST + 8192;
static_assert(L_WCTR + 16 <= ATT_LDS_BYTES, "attention LDS map");

struct Ptrs { const bf16_t *Q, *KS, *KW, *VST, *VWT, *KCMP, *VCT; const float* GATES; bf16_t* Y; float* YPART; float kmax, vmax, kwmax, kcmax; };

#define MFMA16(a, b, c) __builtin_amdgcn_mfma_f32_16x16x32_bf16(a, b, c, 0, 0, 0)

__device__ __forceinline__ void attn_unit(Frame& F, const Ptrs& P, int b, int g, int qb) {
    LAS unsigned char* lds = F.lds;
    const int tid = F.tid, lane = F.lane, w = F.wave, r16 = lane & 15, kg = lane >> 4;
    LAS int* Oh = (LAS int*)(lds + L_OH); LAS int* Ol = (LAS int*)(lds + L_OL); LAS float* imp = (LAS float*)(lds + L_OH);
    LAS int* lsel = (LAS int*)(lds + L_LS); LAS float* mref = (LAS float*)(lds + L_MREF);
    LAS unsigned* selm = (LAS unsigned*)(lds + L_SEL); LAS int* cnts = (LAS int*)(lds + L_CNT); LAS unsigned char* lists = lds + L_LIST; LAS int* wctr = (LAS int*)(lds + L_WCTR);
    const size_t tokb = (size_t)b * SEQ; const int t0 = qb * 64;
    const bf16_t* Qg = P.Q + (tokb + t0) * 512 + g * 256;
    LAS float* U = (LAS float*)(lds + L_OH); LAS float* linvc = (LAS float*)(lds + L_LS);
    {
        const int q = tid >> 3, part = tid & 7, hd = part >> 1, hf = part & 1;
        const u32x4* src = (const u32x4*)(Qg + (size_t)q * 512 + part * 32);
        float ss = 0.f;
#pragma unroll
        for (int i = 0; i < 4; ++i) { const u32x4 v = src[i]; const float f[8] = {bflo(v.x), bfhi(v.x), bflo(v.y), bfhi(v.y), bflo(v.z), bfhi(v.z), bflo(v.w), bfhi(v.w)};
#pragma unroll
            for (int k = 0; k < 8; ++k) ss += f[k] * f[k]; }
        ss += __uint_as_float(__builtin_amdgcn_update_dpp(0u, __float_as_uint(ss), 0xB1, 0xF, 0xF, true));
        if (hf == 0) mref[q * 4 + hd] = sqrtf(ss);
        { LAS u32x4* z4 = (LAS u32x4*)U; for (int i = tid; i < (256 * USP) / 4; i += NTHREADS) z4[i] = (u32x4){0u, 0u, 0u, 0u}; }
    }
    __syncthreads();
    const int hl = r16 & 3;
#define ATT_LDK(dst, base, key0) do { const char* kb_ = (const char*)(base) + (size_t)(key0) * 128; _Pragma("unroll") for (int u_ = 0; u_ < 2; ++u_) _Pragma("unroll") for (int ks_ = 0; ks_ < 2; ++ks_) \
        dst[u_][ks_] = *(const bf16x8*)(kb_ + koff + (u_ * 2 + ks_) * 1024); } while (0)
#define ATT_LDV(dst, vbase, LEN, key0) do { const char* vb_ = (const char*)(vbase) + (size_t)(key0) * 128; _Pragma("unroll") for (int dt_ = 0; dt_ < 4; ++dt_) \
        dst[dt_] = *(const bf16x8*)(vb_ + koff + dt_ * 1024); } while (0)
#define ATT_SHADOW() int ln_ = F.lane; asm volatile("" : "+v"(ln_)); const int r16 = ln_ & 15, kg = ln_ >> 4, hl = r16 & 3; const unsigned koff = (unsigned)ln_ * 16u
    {
        ATT_SHADOW();
        bf16x8 qf[2][2]; float mrc[2], lpart[2], carry[2] = {0.f, 0.f}; int nlim[2]; f32x4 o[2][4];
#pragma unroll
        for (int rt = 0; rt < 2; ++rt) { const int q = 8 * w + 4 * rt + (r16 >> 2);
#pragma unroll
            for (int ks = 0; ks < 2; ++ks) qf[rt][ks] = *(const bf16x8*)(Qg + (size_t)q * 512 + hl * 64 + ks * 32 + kg * 8);
            mrc[rt] = mref[q * 4 + hl] * P.kcmax; lpart[rt] = 0.f; nlim[rt] = (t0 + q - 31) >> 4;
#pragma unroll
            for (int dt = 0; dt < 4; ++dt) o[rt][dt] = (f32x4){0.f, 0.f, 0.f, 0.f}; }
        const int nkeys = 4 * qb + 3, NP = (nkeys + 31) >> 5;
        const int nlim_min = (t0 + 8 * w - 31) >> 4;
        const bf16_t* Kc = P.KCMP + (size_t)(b * 2 + g) * 512 * 64; const bf16_t* Vc = P.VCT + (size_t)(b * 2 + g) * 64 * 512;
#define ATT_S1_STEP(KF, VF, s_) do { _Pragma("unroll") for (int rt = 0; rt < 2; ++rt) { \
            f32x4 st[2]; float p[2][4]; \
            _Pragma("unroll") for (int u = 0; u < 2; ++u) { st[u] = MFMA16(KF[u][0], qf[rt][0], ((f32x4){0.f, 0.f, 0.f, 0.f})); st[u] = MFMA16(KF[u][1], qf[rt][1], st[u]); } \
            _Pragma("unroll") for (int u = 0; u < 2; ++u) _Pragma("unroll") for (int i = 0; i < 4; ++i) p[u][i] = fast_exp2(st[u][i] - mrc[rt]); \
            if (32 * (s_) + 31 > nlim_min) { _Pragma("unroll") for (int u = 0; u < 2; ++u) _Pragma("unroll") for (int i = 0; i < 4; ++i) { const int n = 32 * (s_) + 8 * kg + 4 * u + i; if (n > nlim[rt]) p[u][i] = 0.f; } } \
            const float s01 = (p[0][0] + p[0][1]) + (p[0][2] + p[0][3]), s11 = (p[1][0] + p[1][1]) + (p[1][2] + p[1][3]); lpart[rt] += s01 + s11; \
            {   \
                \
              const unsigned x_ = __float_as_uint(p[1][3]); const auto s16_ = __builtin_amdgcn_permlane16_swap(x_, x_, false, false); const auto s32_ = __builtin_amdgcn_permlane32_swap(s16_[1], s16_[1], false, false); \
              const float inc_ = (kg & 1) ? __uint_as_float(s16_[0]) : ((kg == 2) ? __uint_as_float(s32_[0]) : carry[rt]); carry[rt] = __uint_as_float(s32_[1]); \
              LAS float* ur = U + ((8 * w + 4 * rt + (r16 >> 2)) * 4 + hl) * USP + 8 * (s_) + 2 * kg; \
              ur[0] += (2.f * s01 - p[0][3]) + inc_; ur[1] += (2.f * s11 - p[1][3]) + p[0][3]; } \
            u32x4 pw; pw.x = cvtpk(p[0][0], p[0][1]); pw.y = cvtpk(p[0][2], p[0][3]); pw.z = cvtpk(p[1][0], p[1][1]); pw.w = cvtpk(p[1][2], p[1][3]); \
            const bf16x8 pf = __builtin_bit_cast(bf16x8, pw); \
            _Pragma("unroll") for (int dt = 0; dt < 4; ++dt) o[rt][dt] = MFMA16(VF[dt], pf, o[rt][dt]); } } while (0)
        {
            bf16x8 kA[2][2], vA[4], kB[2][2], vB[4];
            ATT_LDK(kA, Kc, 0); ATT_LDV(vA, Vc, 512, 0); if (NP > 1) { ATT_LDK(kB, Kc, 32); ATT_LDV(vB, Vc, 512, 32); }
#pragma nounroll
            for (int s2 = 0; s2 < NP; s2 += 2) {
                ATT_S1_STEP(kA, vA, s2);
                if (s2 + 2 < NP) { ATT_LDK(kA, Kc, 32 * (s2 + 2)); ATT_LDV(vA, Vc, 512, 32 * (s2 + 2)); }
                if (s2 + 1 < NP) { ATT_S1_STEP(kB, vB, s2 + 1);
                    if (s2 + 3 < NP) { ATT_LDK(kB, Kc, 32 * (s2 + 3)); ATT_LDV(vB, Vc, 512, 32 * (s2 + 3)); } }
            }
        }
#undef ATT_S1_STEP
#pragma unroll
        for (int rt = 0; rt < 2; ++rt) { const int q = 8 * w + 4 * rt + (r16 >> 2); const float lrow = kg_sum(lpart[rt]); const float linv = lrow > 0.f ? 1.f / lrow : 0.f;
            if (kg == 0) linvc[q * 4 + hl] = linv;
            const float gc = P.GATES[(tokb + t0 + q) * 24 + (g * 4 + hl) * 3 + 0] * linv;
            float* yp = P.YPART + (tokb + t0 + q) * 512 + (g * 4 + hl) * 64 + 4 * kg;
#pragma unroll
            for (int dt = 0; dt < 4; ++dt) *(f32x4*)(yp + dt * 16) = o[rt][dt] * gc; }
    }
    LDS_WAIT();
#pragma nounroll
    for (int qg = 0; qg < 2; ++qg) {
        if (qb <= 15) {
            if (lane < 4) { const int q = 8 * w + 4 * qg + lane; const unsigned long long m0 = (1ull << (qb + 1)) - 1ull;
                selm[q * 4 + 0] = (unsigned)m0; selm[q * 4 + 1] = (unsigned)(m0 >> 32); selm[q * 4 + 2] = 0u; selm[q * 4 + 3] = 0u; }
        } else {
            const int j0 = lane, j1 = lane + 64; int v0[4], v1[4], thr[4];
#pragma unroll
            for (int k = 0; k < 4; ++k) { const int q = 8 * w + 4 * qg + k; const LAS float* ur = U + (q * 4) * USP; const LAS float* li = linvc + q * 4;
                float i0 = 0.f, i1 = 0.f;
#pragma unroll
                for (int h = 0; h < 4; ++h) { i0 += ur[h * USP + j0] * li[h]; i1 += ur[h * USP + j1] * li[h]; }
                v0[k] = (j0 >= 1 && j0 <= qb - 2) ? (int)__float_as_uint(i0) : -1;
                v1[k] = (j1 <= qb - 2) ? (int)__float_as_uint(i1) : -1; thr[k] = 0; }
#pragma nounroll
            for (int bit = 30; bit >= 0; --bit) {
                const int c0_ = thr[0] | (1 << bit), c1_ = thr[1] | (1 << bit), c2_ = thr[2] | (1 << bit), c3_ = thr[3] | (1 << bit);
                const unsigned long long a0_ = __ballot(v0[0] >= c0_), a1_ = __ballot(v0[1] >= c1_), a2_ = __ballot(v0[2] >= c2_), a3_ = __ballot(v0[3] >= c3_);
                const unsigned long long b0_ = __ballot(v1[0] >= c0_), b1_ = __ballot(v1[1] >= c1_), b2_ = __ballot(v1[2] >= c2_), b3_ = __ballot(v1[3] >= c3_);
                asm volatile("" :: "s"(a0_), "s"(a1_), "s"(a2_), "s"(a3_), "s"(b0_), "s"(b1_), "s"(b2_), "s"(b3_));
                if (__popcll(a0_) + __popcll(b0_) >= 13) thr[0] = c0_;
                if (__popcll(a1_) + __popcll(b1_) >= 13) thr[1] = c1_;
                if (__popcll(a2_) + __popcll(b2_) >= 13) thr[2] = c2_;
                if (__popcll(a3_) + __popcll(b3_) >= 13) thr[3] = c3_; }
            const unsigned long long below = (1ull << lane) - 1ull;
#pragma nounroll
            for (int k = 0; k < 4; ++k) {
                const int vv0 = (k == 0) ? v0[0] : (k == 1) ? v0[1] : (k == 2) ? v0[2] : v0[3], vv1 = (k == 0) ? v1[0] : (k == 1) ? v1[1] : (k == 2) ? v1[2] : v1[3];
                const int th = (k == 0) ? thr[0] : (k == 1) ? thr[1] : (k == 2) ? thr[2] : thr[3];
                const bool gt0 = vv0 > th, gt1 = vv1 > th, eq0 = vv0 == th, eq1 = vv1 == th;
                const int need = 13 - (__popcll(__ballot(gt0)) + __popcll(__ballot(gt1)));
                const unsigned long long B0 = __ballot(eq0), B1 = __ballot(eq1);
                const int rk0 = __popcll(B0 & below), rk1 = __popcll(B0) + __popcll(B1 & below);
                unsigned long long m0 = __ballot(gt0 || (eq0 && rk0 < need)), m1 = __ballot(gt1 || (eq1 && rk1 < need));
                m0 |= 1ull;
                if (qb < 64) m0 |= (1ull << qb); else m1 |= (1ull << (qb - 64));
                if (qb - 1 < 64) m0 |= (1ull << (qb - 1)); else m1 |= (1ull << (qb - 65));
                if (lane == 0) { const int q = 8 * w + 4 * qg + k; selm[q * 4 + 0] = (unsigned)m0; selm[q * 4 + 1] = (unsigned)(m0 >> 32); selm[q * 4 + 2] = (unsigned)m1; selm[q * 4 + 3] = (unsigned)(m1 >> 32); } }
        }
    }
    __syncthreads();
    { LAS u32x4* z4 = (LAS u32x4*)Oh; for (int i = tid; i < (2 * 256 * OSP) / 4; i += NTHREADS) z4[i] = (u32x4){0u, 0u, 0u, 0u}; }
    lsel[tid] = 0;
    if (tid == 0) wctr[0] = 0;
    { const unsigned m0 = selm[lane * 4 + (w >> 1)];
#pragma nounroll
      for (int jj = 0; jj < 16; ++jj) { const int j = 16 * w + jj; const bool hit = (j <= qb) && ((m0 >> (16 * (w & 1) + jj)) & 1u);
          const unsigned long long mk = __ballot(hit); if (hit) lists[j * 64 + __popcll(mk & ((1ull << lane) - 1ull))] = (unsigned char)lane;
          if (lane == 0) cnts[j] = __popcll(mk); } }
    __syncthreads();
    for (int rep5 = 0; rep5 < ((ATTREP & 8) ? NREP : 1); ++rep5)
    {
        if (rep5 > 0) { __syncthreads(); if (tid == 0) wctr[0] = 0; __syncthreads(); }
        ATT_SHADOW();
        const bf16_t* Ks = P.KS + (size_t)(b * 2 + g) * SEQ * 64; const bf16_t* Vs = P.VST + (size_t)(b * 2 + g) * 64 * SEQ;
        const float S1 = 1048576.f / fmaxf(P.vmax, 1e-30f);
#define ATT_FETCH(idx_) do { int i_ = 0; if (lane == 0) i_ = __hip_atomic_fetch_add(wctr, 1, __ATOMIC_RELAXED, __HIP_MEMORY_SCOPE_WORKGROUP); idx_ = __builtin_amdgcn_readfirstlane(i_); } while (0)
#define ATT_JOF(idx_) (((idx_) == 0) ? 0 : (((idx_) == 1) ? qb : (((idx_) == 2) ? qb - 1 : (idx_) - 2)))
        bf16x8 kn[2][2][2];
        int idx; ATT_FETCH(idx);
        if (idx <= qb) { const int j = ATT_JOF(idx); ATT_LDK(kn[0], Ks, 64 * j); ATT_LDK(kn[1], Ks, 64 * j + 32); }
#pragma nounroll
        while (idx <= qb) {
            const int j = ATT_JOF(idx);
            bf16x8 kf[2][2][2], vf[2][4];
#pragma unroll
            for (int sp = 0; sp < 2; ++sp) {
#pragma unroll
                for (int u = 0; u < 2; ++u) { kf[sp][u][0] = kn[sp][u][0]; kf[sp][u][1] = kn[sp][u][1]; } }
            ATT_LDV(vf[0], Vs, SEQ, 64 * j); ATT_LDV(vf[1], Vs, SEQ, 64 * j + 32);
            int idx2; ATT_FETCH(idx2);
            if (idx2 <= qb) { const int j2 = ATT_JOF(idx2); ATT_LDK(kn[0], Ks, 64 * j2); ATT_LDK(kn[1], Ks, 64 * j2 + 32); }
            const int cnt = cnts[j];
            const int nch = (cnt + 3) >> 2;
            bf16x8 qn0, qn1; int qnx; bool vnx;
            { const int qs = (r16 >> 2); vnx = qs < cnt; qnx = lists[j * 64 + (vnx ? qs : (cnt > 0 ? cnt - 1 : 0))];
              const bf16_t* qp = Qg + (size_t)qnx * 512 + hl * 64 + kg * 8; qn0 = *(const bf16x8*)qp; qn1 = *(const bf16x8*)(qp + 32); }
#pragma nounroll
            for (int c = 0; c < nch; ++c) {
                const bool valid = vnx; const int q = qnx; const int row = q * 4 + hl; const bf16x8 q0 = qn0, q1 = qn1;
                if (c + 1 < nch) { const int qs = 4 * (c + 1) + (r16 >> 2); vnx = qs < cnt; qnx = lists[j * 64 + (vnx ? qs : cnt - 1)];
                    const bf16_t* qp = Qg + (size_t)qnx * 512 + hl * 64 + kg * 8; qn0 = *(const bf16x8*)qp; qn1 = *(const bf16x8*)(qp + 32); }
                const float mr = mref[row] * P.kmax;
                f32x4 o[4];
                float ps = 0.f;
                const bool slow = (j == qb) || (4 * c + 4 > cnt);
#define ATT_CHUNK(MASKED) \
                _Pragma("unroll") for (int sp = 0; sp < 2; ++sp) { \
                    f32x4 st[2]; float p[2][4]; \
                    _Pragma("unroll") for (int u = 0; u < 2; ++u) { st[u] = MFMA16(kf[sp][u][0], q0, ((f32x4){0.f, 0.f, 0.f, 0.f})); st[u] = MFMA16(kf[sp][u][1], q1, st[u]); } \
                    _Pragma("unroll") for (int u = 0; u < 2; ++u) _Pragma("unroll") for (int i = 0; i < 4; ++i) { float e = fast_exp2(st[u][i] - mr); \
                        if (MASKED) { const int kk = 32 * sp + 8 * kg + 4 * u + i; if (!valid || (j == qb && kk > q)) e = 0.f; } p[u][i] = e; ps += e; } \
                    u32x4 pw; pw.x = cvtpk(p[0][0], p[0][1]); pw.y = cvtpk(p[0][2], p[0][3]); pw.z = cvtpk(p[1][0], p[1][1]); pw.w = cvtpk(p[1][2], p[1][3]); \
                    const bf16x8 pf = __builtin_bit_cast(bf16x8, pw); \
                    _Pragma("unroll") for (int dt = 0; dt < 4; ++dt) o[dt] = (sp == 0) ? MFMA16(vf[0][dt], pf, ((f32x4){0.f, 0.f, 0.f, 0.f})) : MFMA16(vf[1][dt], pf, o[dt]); }
                if (slow) { ATT_CHUNK(true) } else { ATT_CHUNK(false) }
#undef ATT_CHUNK
                ps = kg_sum(ps);
                if (valid) {
                    if (kg == 0) { const float xs = ps * 1048576.f, hf_ = __builtin_rintf(xs); __hip_atomic_fetch_add(lsel + row, (int)hf_, __ATOMIC_RELAXED, __HIP_MEMORY_SCOPE_WORKGROUP);
                        __hip_atomic_fetch_add(lsel + 256 + row, (int)((xs - hf_) * 1048576.f), __ATOMIC_RELAXED, __HIP_MEMORY_SCOPE_WORKGROUP); }
#pragma unroll
                    for (int dt = 0; dt < 4; ++dt)
#pragma unroll
                        for (int i = 0; i < 4; ++i) { const float xs = o[dt][i] * S1, hf_ = __builtin_rintf(xs); const int off = row * OSP + dt * 16 + 4 * kg + i;
                            __hip_atomic_fetch_add(Oh + off, (int)hf_, __ATOMIC_RELAXED, __HIP_MEMORY_SCOPE_WORKGROUP);
                            __hip_atomic_fetch_add(Ol + off, (int)((xs - hf_) * 1048576.f), __ATOMIC_RELAXED, __HIP_MEMORY_SCOPE_WORKGROUP); }
                }
            }
            idx = idx2;
        }
    }
    f32x4 yacc[2][4];
    {
        ATT_SHADOW();
        bf16x8 qf[2][2]; float mrw[2], lpart[2]; f32x4 o[2][4];
#pragma unroll
        for (int rt = 0; rt < 2; ++rt) { const int q = 8 * w + 4 * rt + (r16 >> 2);
#pragma unroll
            for (int ks = 0; ks < 2; ++ks) qf[rt][ks] = *(const bf16x8*)(Qg + (size_t)q * 512 + hl * 64 + ks * 32 + kg * 8);
            mrw[rt] = mref[q * 4 + hl] * P.kwmax; lpart[rt] = 0.f;
#pragma unroll
            for (int dt = 0; dt < 4; ++dt) o[rt][dt] = (f32x4){0.f, 0.f, 0.f, 0.f}; }
        const bf16_t* Kw = P.KW + (size_t)(b * 2 + g) * SEQ * 64; const bf16_t* Vw = P.VWT + (size_t)(b * 2 + g) * 64 * SEQ;
        const int jlo = qb >= 8 ? qb - 8 : 0; const int nit = 2 * (qb - jlo + 1);
#define ATT_S4_STEP(KF, VF, it_) do { const int jw_ = jlo + ((it_) >> 1), sp_ = (it_) & 1; const int mode_ = (jw_ == qb) ? 1 : ((jw_ == qb - 8) ? 2 : 0); \
        _Pragma("unroll") for (int rt = 0; rt < 2; ++rt) { \
            f32x4 st[2]; float p[2][4]; \
            _Pragma("unroll") for (int u = 0; u < 2; ++u) { st[u] = MFMA16(KF[u][0], qf[rt][0], ((f32x4){0.f, 0.f, 0.f, 0.f})); st[u] = MFMA16(KF[u][1], qf[rt][1], st[u]); } \
            _Pragma("unroll") for (int u = 0; u < 2; ++u) _Pragma("unroll") for (int i = 0; i < 4; ++i) p[u][i] = fast_exp2(st[u][i] - mrw[rt]); \
            if (mode_) { const int tq = 8 * w + 4 * rt + (r16 >> 2); \
                _Pragma("unroll") for (int u = 0; u < 2; ++u) _Pragma("unroll") for (int i = 0; i < 4; ++i) { const int kk = 32 * sp_ + 8 * kg + 4 * u + i; const bool vis = (mode_ == 1) ? (kk <= tq) : (kk > tq); if (!vis) p[u][i] = 0.f; } } \
            lpart[rt] += ((p[0][0] + p[0][1]) + (p[0][2] + p[0][3])) + ((p[1][0] + p[1][1]) + (p[1][2] + p[1][3])); \
            u32x4 pw; pw.x = cvtpk(p[0][0], p[0][1]); pw.y = cvtpk(p[0][2], p[0][3]); pw.z = cvtpk(p[1][0], p[1][1]); pw.w = cvtpk(p[1][2], p[1][3]); \
            const bf16x8 pf = __builtin_bit_cast(bf16x8, pw); \
            _Pragma("unroll") for (int dt = 0; dt < 4; ++dt) o[rt][dt] = MFMA16(VF[dt], pf, o[rt][dt]); } } while (0)
        {
            bf16x8 kA[2][2], vA[4], kB[2][2], vB[4];
            ATT_LDK(kA, Kw, 64 * jlo); ATT_LDV(vA, Vw, SEQ, 64 * jlo); ATT_LDK(kB, Kw, 64 * jlo + 32); ATT_LDV(vB, Vw, SEQ, 64 * jlo + 32);
#pragma nounroll
            for (int it = 0; it < nit; it += 2) {
                ATT_S4_STEP(kA, vA, it);
                if (it + 2 < nit) { ATT_LDK(kA, Kw, 64 * jlo + 32 * (it + 2)); ATT_LDV(vA, Vw, SEQ, 64 * jlo + 32 * (it + 2)); }
                ATT_S4_STEP(kB, vB, it + 1);
                if (it + 3 < nit) { ATT_LDK(kB, Kw, 64 * jlo + 32 * (it + 3)); ATT_LDV(vB, Vw, SEQ, 64 * jlo + 32 * (it + 3)); }
            }
        }
#undef ATT_S4_STEP
#pragma unroll
        for (int rt = 0; rt < 2; ++rt) { const int q = 8 * w + 4 * rt + (r16 >> 2); const float lw_ = kg_sum(lpart[rt]); const float sc = lw_ > 0.f ? P.GATES[(tokb + t0 + q) * 24 + (g * 4 + hl) * 3 + 2] / lw_ : 0.f;
#pragma unroll
            for (int dt = 0; dt < 4; ++dt) yacc[rt][dt] = o[rt][dt] * sc; }
    }
    __syncthreads();
#pragma unroll
    for (int rt = 0; rt < 2; ++rt) { const int q = 8 * w + 4 * rt + (r16 >> 2), row = q * 4 + hl;
        const float lrow = (float)lsel[row] * (1.f / 1048576.f) + (float)lsel[256 + row] * (1.f / 1099511627776.f);
        const float invS1 = fmaxf(P.vmax, 1e-30f) * (1.f / 1048576.f);
        const float sc = lrow > 0.f ? P.GATES[(tokb + t0 + q) * 24 + (g * 4 + hl) * 3 + 1] / lrow * invS1 : 0.f;
        bf16_t* dst = P.Y + (tokb + t0 + q) * 1024 + 512 + (g * 4 + hl) * 64 + 4 * kg;
        const float* yp = P.YPART + (tokb + t0 + q) * 512 + (g * 4 + hl) * 64 + 4 * kg;
#pragma unroll
        for (int dt = 0; dt < 4; ++dt) { const LAS int* oh = Oh + row * OSP + dt * 16 + 4 * kg; const LAS int* ol = Ol + row * OSP + dt * 16 + 4 * kg;
            const f32x4 osel = (f32x4){(float)oh[0] + (float)ol[0] * (1.f / 1048576.f), (float)oh[1] + (float)ol[1] * (1.f / 1048576.f), (float)oh[2] + (float)ol[2] * (1.f / 1048576.f), (float)oh[3] + (float)ol[3] * (1.f / 1048576.f)};
            const f32x4 v = yacc[rt][dt] + *(const f32x4*)(yp + dt * 16) + osel * sc;
            u32x2 o; o.x = cvtpk(v[0], v[1]); o.y = cvtpk(v[2], v[3]); *(u32x2*)(dst + dt * 16) = o; } }
    __syncthreads();
}
#undef MFMA16
#undef ATT_LDK
#undef ATT_LDV
#undef ATT_SHADOW
#undef ATT_FETCH
#undef ATT_JOF
}

__device__ __forceinline__ void phase_n2(Frame& F, const Args& a, int l) {
    const int lane = F.lane, w = F.wave;
    const float* XR = WSP(float, WS_XR); unsigned char* H8 = WSP(unsigned char, WS_H8);
    const float* g = INP(a, float, I_N2G) + l * 1024;
    LAS float* part = (LAS float*)F.lds;
    LAS float* ssqp = (LAS float*)(F.lds + 32768);
    LAS float* lg = (LAS float*)(F.lds + 32768 + 1024);
    int* CNTI = WSP(int, WS_CNTI); int* ASG = WSP(int, WS_ASG); float* G4 = WSP(float, WS_GATE4);
    for (int item = F.vcu; item < T / 64; item += F.G) {
        const int tk0 = item * 64, b = tk0 >> 13; const int tt = w & 1, kq = w >> 1;
        const float* rwp = WSP(float, WS_RWP) + (size_t)(l * 2 + b) * 1024 * 32; const float* rbp = WSP(float, WS_MISC + 4096) + (l * 2 + b) * 32;
        const int i31 = lane & 31, hf = lane >> 5;
        {
            const float* xp = XR + (size_t)(tk0 + tt * 32 + i31) * DM + kq * 256 + 4 * hf; const float* wp = rwp + (size_t)(kq * 256 + 4 * hf) * 32 + i31;
            f32x16 acc;
#pragma unroll
            for (int r = 0; r < 16; ++r) acc[r] = 0.f;
            float ssq = 0.f;
#pragma nounroll
            for (int bt = 0; bt < 4; ++bt) {
                f32x4 xv[8]; float wv[8][4];
#pragma unroll
                for (int s = 0; s < 8; ++s) { xv[s] = *(const f32x4*)(xp + 8 * (bt * 8 + s)); const float* wq = wp + (size_t)(8 * (bt * 8 + s)) * 32;
                    wv[s][0] = wq[0]; wv[s][1] = wq[32]; wv[s][2] = wq[64]; wv[s][3] = wq[96]; }
#pragma unroll
                for (int s = 0; s < 8; ++s) { ssq += (xv[s].x * xv[s].x + xv[s].y * xv[s].y) + (xv[s].z * xv[s].z + xv[s].w * xv[s].w);
                    acc = __builtin_amdgcn_mfma_f32_32x32x2f32(xv[s].x, wv[s][0], acc, 0, 0, 0); acc = __builtin_amdgcn_mfma_f32_32x32x2f32(xv[s].y, wv[s][1], acc, 0, 0, 0);
                    acc = __builtin_amdgcn_mfma_f32_32x32x2f32(xv[s].z, wv[s][2], acc, 0, 0, 0); acc = __builtin_amdgcn_mfma_f32_32x32x2f32(xv[s].w, wv[s][3], acc, 0, 0, 0); }
            }
            ssq += __shfl_xor(ssq, 32);
            if (hf == 0) ssqp[kq * 64 + tt * 32 + i31] = ssq;
#pragma unroll
            for (int r = 0; r < 16; ++r) { const int tk = (r & 3) + 8 * (r >> 2) + 4 * hf; part[(w * 32 + tk) * 32 + i31] = acc[r]; }
        }
        __syncthreads();
        for (int i = F.tid; i < 64 * 32; i += NTHREADS) { const int tk = i >> 5, e = i & 31, t2 = tk >> 5, tl = tk & 31;
            const float sq = (ssqp[tk] + ssqp[64 + tk]) + (ssqp[128 + tk] + ssqp[192 + tk]); const float rstd = 1.f / sqrtf(sq * (1.f / DM) + NORM_EPS);
            const float v = (part[((0 * 2 + t2) * 32 + tl) * 32 + e] + part[((1 * 2 + t2) * 32 + tl) * 32 + e]) + (part[((2 * 2 + t2) * 32 + tl) * 32 + e] + part[((3 * 2 + t2) * 32 + tl) * 32 + e]);
            lg[tk * 33 + e] = v * rstd + rbp[e]; }
        __syncthreads();
        if (w < 2) {
            const int it = item * 2 + w;
            float v0 = -INFINITY, v1 = -INFINITY, v2 = -INFINITY, v3 = -INFINITY; int i0 = -1, i1 = -1, i2 = -1, i3 = -1;
            if (lane < 32) {
#pragma unroll 8
                for (int e = 0; e < 32; ++e) { const float v = lg[(w * 32 + lane) * 33 + e];
                    if (v > v3) { if (v > v2) { v3 = v2; i3 = i2; if (v > v1) { v2 = v1; i2 = i1; if (v > v0) { v1 = v0; i1 = i0; v0 = v; i0 = e; } else { v1 = v; i1 = e; } } else { v2 = v; i2 = e; } } else { v3 = v; i3 = e; } } }
            }
            const float e1 = __expf(v1 - v0), e2 = __expf(v2 - v0), e3 = __expf(v3 - v0); const float inv = 1.f / (1.f + e1 + e2 + e3);
            int r0 = 0, r1 = 0, r2 = 0, r3 = 0, mycnt = 0;
            for (int e = 0; e < 32; ++e) { const bool hit = (i0 == e) | (i1 == e) | (i2 == e) | (i3 == e); const unsigned long long U = __ballot(hit);
                const int rk = __popcll(U & ((1ull << lane) - 1ull));
                if (i0 == e) r0 = rk; if (i1 == e) r1 = rk; if (i2 == e) r2 = rk; if (i3 == e) r3 = rk;
                if (lane == e) mycnt = __popcll(U); }
            if (lane < 32) { const int tk = tk0 + w * 32 + lane; CNTI[it * 32 + lane] = mycnt;
                if (mycnt > 0) { atomicAdd(F.ctl + CW_GCNT + (l * 32 + (it >> 4)) * 32 + lane, (unsigned)mycnt); atomicAdd(F.ctl + CW_CNT + l * 32 + lane, (unsigned)mycnt); }
                *(int4*)(ASG + tk * 4) = make_int4((i0 << 16) | r0, (i1 << 16) | r1, (i2 << 16) | r2, (i3 << 16) | r3);
                *(f32x4*)(G4 + tk * 4) = (f32x4){inv, e1 * inv, e2 * inv, e3 * inv}; }
        }
#pragma unroll 2
        for (int rr = 0; rr < 8; ++rr) { const int m = tk0 + w * 8 + rr; const RowV r = row_load(XR + (size_t)m * DM, lane);
            const float rstd = 1.f / sqrtf(row_ssq(r) * (1.f / DM) + NORM_EPS);
            row_norm_store8(r, rstd, g, MODP(l, b, 4), MODP(l, b, 3), H8 + (size_t)m * DM, lane); }
        __syncthreads();
    }
}

__device__ __forceinline__ void phase_n2b(Frame& F, int l) {
    const int gw = F.vcu * NWAVES + F.wave, NGW = F.G * NWAVES; const int lane = F.lane;
    const int* CNTI = WSP(int, WS_CNTI); int* TOK = WSP(int, WS_TOK); int* ASG = WSP(int, WS_ASG); unsigned* cnt = F.ctl + CW_CNT + l * 32;
    for (int it = gw; it < T / 32; it += NGW) {
        int base = 0;
        {
            const unsigned* gc = F.ctl + CW_GCNT + l * 1024; const int grp = it >> 4, e = lane & 31; int s0 = 0, s1 = 0;
#pragma unroll
            for (int gI = 0; gI < 32; ++gI) { const int v = (int)gc[gI * 32 + e]; s0 += (gI < grp) ? v : 0; }
#pragma unroll
            for (int i = 0; i < 16; ++i) { const int v = CNTI[((grp << 4) + i) * 32 + e]; s1 += (((grp << 4) + i) < it) ? v : 0; }
            base = s0 + s1; }
        { const int tk = it * 32 + (lane & 31); const int4 as = *(const int4*)(ASG + tk * 4); int v[4] = {as.x, as.y, as.z, as.w};
#pragma unroll
            for (int k = 0; k < 4; ++k) { const int e = v[k] >> 16, rk = v[k] & 0xffff; const int sl = __shfl(base, e & 31) + rk; if (lane < 32) TOK[e * 16384 + sl] = tk; v[k] = (e << 16) | sl; }
            if (lane < 32) *(int4*)(ASG + tk * 4) = make_int4(v[0], v[1], v[2], v[3]); }
    }
}

__device__ __forceinline__ void moe_tables(Frame& F, int l, int NT, int& total) {
    LAS int* ust = (LAS int*)(F.lds + MOE_OFF); LAS int* bst = ust + 33; LAS int* cn = bst + 33;
    if (F.tid < 64) { const unsigned* cnt = F.ctl + CW_CNT + l * 32; const int lane = F.tid;
        const int c = (lane < NE) ? (int)cnt[lane] : 0; const int nb = (c + 255) >> 8; int inc = nb;
#pragma unroll
        for (int o = 1; o < 32; o <<= 1) { const int t = __shfl_up(inc, o); if ((lane & 31) >= o) inc += t; }
        if (lane < NE) { bst[lane] = inc - nb; ust[lane] = (inc - nb) * NT; cn[lane] = c; if (lane == NE - 1) { bst[NE] = inc; ust[NE] = inc * NT; } } }
    __syncthreads();
    total = ust[NE];
}

constexpr int PH_PROLOGUE = 0, PH_N1 = 1, PH_LAYER0 = 2, PH_PER_LAYER = 9, NPHASES = PH_LAYER0 + DEPTH * PH_PER_LAYER;
__global__ void __launch_bounds__(NTHREADS, 2) fwd_kernel(Args args) {
    extern __shared__ __attribute__((aligned(16))) unsigned char lds_raw[];
    Frame F;
    F.lds = (LAS unsigned char*)lds_raw; F.ws = args.ws; F.ctl = (unsigned*)(args.ws + WS_CTL);
    F.tid = threadIdx.x; F.lane = F.tid & 63; F.wave = __builtin_amdgcn_readfirstlane(F.tid >> 6);
    F.G = gridDim.x; { const int bx = blockIdx.x; F.vcu = (F.G % 8 == 0) ? (bx % 8) * (F.G / 8) + bx / 8 : bx; }
    for (int u = F.tid; u < (LDS_BYTES - LDSCTL_OFF) / 4; u += NTHREADS) ((LAS unsigned*)(F.lds + LDSCTL_OFF))[u] = 0u;
    __syncthreads();
    volatile LAS unsigned* MISC = (volatile LAS unsigned*)(F.lds + MISC_OFF);
    XcdBarrier bar; bar.bar = F.ctl + CW_BAR; bar.x = 0; bar.st = nullptr;
#if !MK_PER_PHASE
    bar = xcd_barrier_post(F.ctl + CW_BAR, MISC + 8);
#endif
    const int lo = args.ph_lo, hi = args.ph_hi;
#define IN(k) (lo <= (k) && (k) < hi)
#define REFRESH() do { int t_ = threadIdx.x; asm volatile("" : "+v"(t_)); F.tid = t_; F.lane = t_ & 63; F.wave = __builtin_amdgcn_readfirstlane(t_ >> 6); } while (0)
#define SEAM(k) do { if (IN(k) && IN((k) + 1)) xcd_barrier(bar); } while (0)
#define REPS(bit, idem) (((REPMASK & (bit)) && (idem)) ? NREP : 1)

    if (IN(PH_PROLOGUE) && !(SKIPMASK & 1)) for (int rep = 0; rep < REPS(1, true); ++rep) { REFRESH(); phase_prologue(F, args); } SEAM(PH_PROLOGUE);
    if (IN(PH_N1) && !(SKIPMASK & 2)) for (int rep = 0; rep < REPS(2, true); ++rep) { REFRESH(); phase_n1_first(F, args); } SEAM(PH_N1);
    for (int l = 0; l < DEPTH; ++l) {
        const int p0 = PH_LAYER0 + l * PH_PER_LAYER;
        if (IN(p0 + 0) && !(SKIPMASK & 4)) for (int rep = 0; rep < REPS(4, l == 0); ++rep) {
            pg8::DenseOrder S; S.init(T, PINP, F.G, (int)blockIdx.x);
            EpiProj E{WSP(bf16_t, WS_UG), WSP(bf16_t, WS_VG), WSP(bf16_t, WS_Q), WSP(bf16_t, WS_KC), WSP(bf16_t, WS_VC), WSP(bf16_t, WS_KS), WSP(bf16_t, WS_KW), WSP(bf16_t, WS_VST), WSP(bf16_t, WS_VWT),
                      WSP(float, WS_GATES), WSP(float, WS_ROPE), F.ctl + CW_KMAX + l * 16};
            pg8::gemm_phase<EpiProj, pg8::DenseOrder, false, true>(F.lds, WSP(bf16_t, WS_H), WSP(bf16_t, WS_WIN) + (size_t)l * PINP * 1024, 1024, S, E);
        }
        SEAM(p0 + 0);
        if (IN(p0 + 1) && !(SKIPMASK & 8)) for (int rep = 0; rep < REPS(8, l == 0); ++rep) { REFRESH();
            for (int it = F.vcu; it < 256; it += F.G) { if (it < 128) sgu_item(F, args, l, it); else { compress_item(F, args, l, 2 * (it - 128)); compress_item(F, args, l, 2 * (it - 128) + 1); } }
        }
        SEAM(p0 + 1);
        if (IN(p0 + 2) && !(SKIPMASK & 16)) for (int rep = 0; rep < REPS(16, l == 0); ++rep) { REFRESH();
            att::Ptrs P{WSP(bf16_t, WS_Q), WSP(bf16_t, WS_KS), WSP(bf16_t, WS_KW), WSP(bf16_t, WS_VST), WSP(bf16_t, WS_VWT), WSP(bf16_t, WS_KCMP), WSP(bf16_t, WS_VCT), WSP(float, WS_GATES), WSP(bf16_t, WS_Y), WSP(float, WS_YPART), 0.f};
            for (int it = F.vcu; it < 512; it += F.G) {
                const int uu = (it < 256) ? it : (767 - it);
                const int bg = uu >> 7, qb = uu & 127;
                const unsigned* km = F.ctl + CW_KMAX + l * 16 + bg;
                P.kmax = sqrtf(__uint_as_float(__hip_atomic_load(km, __ATOMIC_RELAXED, __HIP_MEMORY_SCOPE_AGENT)));
                P.vmax = __uint_as_float(__hip_atomic_load(km + 4, __ATOMIC_RELAXED, __HIP_MEMORY_SCOPE_AGENT));
                P.kwmax = sqrtf(__uint_as_float(__hip_atomic_load(km + 8, __ATOMIC_RELAXED, __HIP_MEMORY_SCOPE_AGENT)));
                P.kcmax = sqrtf(__uint_as_float(__hip_atomic_load(km + 12, __ATOMIC_RELAXED, __HIP_MEMORY_SCOPE_AGENT)));
                att::attn_unit(F, P, bg >> 1, bg & 1, qb);
            }
        }
        SEAM(p0 + 2);
        if (IN(p0 + 3) && !(SKIPMASK & 32)) for (int rep = 0; rep < REPS(32, l == 0); ++rep) {
            pg8::DenseOrder S; S.init(T, DM, F.G, (int)blockIdx.x);
            EpiOut E{l == 0 ? INP(args, float, I_X) : WSP(float, WS_XR), WSP(float, WS_XR), (const float*)(F.ctl + CW_MOD) + (size_t)l * 2 * 6144};
            pg8::gemm_phase<EpiOut, pg8::DenseOrder, false, true>(F.lds, WSP(bf16_t, WS_Y), WSP(bf16_t, WS_WOUT) + (size_t)l * 1024 * 1024, 1024, S, E);
        }
        SEAM(p0 + 3);
        if (IN(p0 + 4) && !(SKIPMASK & 64)) for (int rep = 0; rep < REPS(64, l == 0); ++rep) { REFRESH(); phase_n2(F, args, l); }
        SEAM(p0 + 4);
        if (IN(p0 + 5) && !(SKIPMASK & 64)) for (int rep = 0; rep < REPS(1024, l == 0); ++rep) { REFRESH(); phase_n2b(F, l); }
        SEAM(p0 + 5);
        if (IN(p0 + 6) && !(SKIPMASK & 128)) for (int rep = 0; rep < REPS(128, l == 0); ++rep) { REFRESH();
            int total; moe_tables(F, l, 8, total);
            LAS int* ust = (LAS int*)(F.lds + MOE_OFF);
            pg8::MoeOrder S{ust, ust + 33, ust + 66, WSP(int, WS_TOK), 8, F.G, F.vcu, total, 1024};
            EpiSwiglu E{WSP(unsigned char, WS_ACT), INP(args, float, I_EB1) + (size_t)l * NE * 2048};
            pg8::gemm_phase<EpiSwiglu, pg8::MoeOrder, true, true, true>(F.lds, WSP(bf16_t, WS_H8), (const bf16_t*)(WSP(unsigned char, WS_W1T) + (size_t)l * NE * 2048 * 1024), 512, S, E);
        }
        SEAM(p0 + 6);
        if (IN(p0 + 7) && !(SKIPMASK & 256)) for (int rep = 0; rep < REPS(256, l == 0); ++rep) { REFRESH();
            int total; moe_tables(F, l, 4, total);
            LAS int* ust = (LAS int*)(F.lds + MOE_OFF);
            pg8::MoeOrder S{ust, ust + 33, ust + 66, WSP(int, WS_TOK), 4, F.G, F.vcu, total, 1024};
            EpiDown E{WSP(unsigned char, WS_YROWS), INP(args, float, I_EB2) + (size_t)l * NE * 1024};
            pg8::gemm_phase<EpiDown, pg8::MoeOrder, false, true, true>(F.lds, WSP(bf16_t, WS_ACT), (const bf16_t*)(WSP(unsigned char, WS_W2T) + (size_t)l * NE * 1024 * 1024), 512, S, E);
        }
        SEAM(p0 + 7);
        if (IN(p0 + 8) && !(SKIPMASK & 512)) for (int rep = 0; rep < REPS(512, l == DEPTH - 1); ++rep) { REFRESH(); phase_combine(F, args, l); }
        if (l + 1 < DEPTH) SEAM(p0 + 8);
    }
#undef IN
#undef SEAM
}

extern "C" void kernel_launch(void* const* d_in, const int* in_sizes, int n_in, void* d_out, int out_size, void* d_ws, size_t ws_size, hipStream_t stream) {
    static int grid = 0;
    if (grid == 0) {
        if (n_in != 26 || out_size != T * DM || ws_size < WS_END) { fprintf(stderr, "kernel_launch: unexpected problem (n_in %d, out %d, ws %zu; need ws >= %zu)\n", n_in, out_size, ws_size, (size_t)WS_END); grid = -1; return; }
        int dev = 0, cus = 0, per_cu = 0;
        if (hipGetDevice(&dev) != hipSuccess || hipDeviceGetAttribute(&cus, hipDeviceAttributeMultiprocessorCount, dev) != hipSuccess) { grid = -1; return; }
        if (hipFuncSetAttribute((const void*)fwd_kernel, hipFuncAttributeMaxDynamicSharedMemorySize, LDS_BYTES) != hipSuccess) { fprintf(stderr, "kernel_launch: hipFuncSetAttribute failed\n"); grid = -1; return; }
        if (hipOccupancyMaxActiveBlocksPerMultiprocessor(&per_cu, (const void*)fwd_kernel, NTHREADS, LDS_BYTES) != hipSuccess || per_cu < 1) { fprintf(stderr, "kernel_launch: occupancy query says %d\n", per_cu); (void)hipGetLastError(); per_cu = 1; }
        grid = cus;
    }
    if (grid < 0) return;
    if (hipMemsetAsync((char*)d_ws + WS_CTL, 0, CTL_ZERO_BYTES, stream) != hipSuccess) { fprintf(stderr, "kernel_launch: memset failed\n"); return; }
    Args a{};
    for (int i = 0; i < 26; ++i) a.in[i] = d_in[i];
    a.out = (float*)d_out; a.ws = (unsigned char*)d_ws;
#if MK_PER_PHASE
    for (int p = 0; p < NPHASES; ++p) { a.ph_lo = p; a.ph_hi = p + 1; a.li = 0;
        hipLaunchKernelGGL(fwd_kernel, dim3(grid), dim3(NTHREADS), LDS_BYTES, stream, a); }
#else
    a.ph_lo = 0; a.ph_hi = NPHASES; a.li = 0;
    void* kargs[] = {&a};
    hipError_t e = hipLaunchCooperativeKernel((const void*)fwd_kernel, dim3(grid), dim3(NTHREADS), kargs, LDS_BYTES, stream);
    if (e != hipSuccess) fprintf(stderr, "kernel_launch: cooperative launch failed: %s (grid %d)\n", hipGetErrorString(e), grid);
#endif
}
```

```cpp
#include <hip/hip_runtime.h>
#include <cstdio>
#include <cstdint>

#ifndef SKIPMASK
#define SKIPMASK 0
#endif
#ifndef REPMASK
#define REPMASK 0
#endif
#ifndef NREP
#define NREP 3
#endif
#ifndef DUMMYINT
#define DUMMYINT 0
#endif
#ifndef ATTREP
#define ATTREP 0
#endif
#ifndef MK_PER_PHASE
#define MK_PER_PHASE 0
#endif

#define LAS __attribute__((address_space(3)))
typedef unsigned short bf16_t;
typedef short bf16x8 __attribute__((ext_vector_type(8)));
typedef float f32x4 __attribute__((ext_vector_type(4)));
typedef float f32x2 __attribute__((ext_vector_type(2)));
typedef float f32x16 __attribute__((ext_vector_type(16)));
typedef unsigned u32x4 __attribute__((ext_vector_type(4)));
typedef unsigned u32x2 __attribute__((ext_vector_type(2)));
typedef __bf16 bf16x2_t __attribute__((ext_vector_type(2)));
typedef int i32x4 __attribute__((ext_vector_type(4)));
typedef int i32x8 __attribute__((ext_vector_type(8)));

constexpr int BATCH = 2, SEQ = 8192, DM = 1024, T = BATCH * SEQ, DEPTH = 2;
constexpr int PIN = 2328, PINP = 2560;
constexpr int NE = 32, FF = 1024, TOPK = 4;
constexpr int NCMP = 511, NCMPP = 512;
constexpr float NORM_EPS = 1e-6f;
constexpr float W8SCALE = 64.f;
constexpr int W8_E8M0 = 0x79797979, ONE_E8M0 = 0x7f7f7f7f;
constexpr float QSCALE = 0.125f * 1.4426950408889634f;
constexpr int NWAVES = 8, NTHREADS = 512;

constexpr size_t MiB = 1u << 20;
constexpr size_t WS_CTL = 0, CTL_ZERO_BYTES = 1 * MiB;
constexpr size_t WS_WIN = 1 * MiB;
constexpr size_t WS_WOUT = 11 * MiB;
constexpr size_t WS_SGW = 15 * MiB;
constexpr size_t WS_CW1 = 15 * MiB + 512 * 1024;
constexpr size_t WS_ROPE = 17 * MiB;
constexpr size_t WS_RWP = 21 * MiB;
constexpr size_t WS_MISC = 21 * MiB + 512 * 1024;
constexpr size_t WS_W1T = 32 * MiB;
constexpr size_t WS_W2T = 288 * MiB;
constexpr size_t WS_XR = 416 * MiB;
constexpr size_t WS_H = 480 * MiB;
constexpr size_t WS_UG = 513 * MiB, WS_VG = 529 * MiB, WS_Q = 545 * MiB;
constexpr size_t WS_KC = 561 * MiB, WS_VC = 565 * MiB, WS_KS = 569 * MiB, WS_KW = 573 * MiB;
constexpr size_t WS_VST = 577 * MiB, WS_VWT = 581 * MiB;
constexpr size_t WS_GATES = 585 * MiB;
constexpr size_t WS_KCMP = 587 * MiB;
constexpr size_t WS_VCT = 587 * MiB + 512 * 1024;
constexpr size_t WS_Y = 588 * MiB;
constexpr size_t WS_TOK = 620 * MiB;
constexpr size_t WS_ASG = 622 * MiB;
constexpr size_t WS_GATE4 = 622 * MiB + 512 * 1024;
constexpr size_t WS_YPART = 912 * MiB;
constexpr size_t WS_CNTI = 623 * MiB;
constexpr size_t WS_ACT = 624 * MiB;
constexpr size_t WS_YROWS = 768 * MiB;
constexpr size_t WS_H8 = 944 * MiB;
constexpr size_t WS_END = 962 * MiB;
constexpr int CW_BAR = 4096;
constexpr int CW_MOD = 16384;
constexpr int CW_CNT = 40960;
constexpr int CW_KMAX = 41088;
constexpr int CW_GCNT = 41216;

__device__ __forceinline__ unsigned cvtpk(float lo, float hi) { f32x2 v = {lo, hi}; bf16x2_t b = __builtin_convertvector(v, bf16x2_t); return __builtin_bit_cast(unsigned, b); }
__device__ __forceinline__ unsigned cvt4_fp8(float a, float b, float c, float d) { int w = 0; w = __builtin_amdgcn_cvt_pk_fp8_f32(a, b, w, false); w = __builtin_amdgcn_cvt_pk_fp8_f32(c, d, w, true); return (unsigned)w; }
__device__ __forceinline__ float bf2f(unsigned short b) { return __uint_as_float((unsigned)b << 16); }
__device__ __forceinline__ float bflo(unsigned w) { return __uint_as_float(w << 16); }
__device__ __forceinline__ float bfhi(unsigned w) { return __uint_as_float(w & 0xffff0000u); }
__device__ __forceinline__ float fast_exp2(float x) { return __builtin_amdgcn_exp2f(x); }
__device__ __forceinline__ float fast_rcp(float x) { return __builtin_amdgcn_rcpf(x); }
__device__ __forceinline__ float sigmoidf_(float x) { return fast_rcp(1.f + fast_exp2(-1.4426950408889634f * x)); }
__device__ __forceinline__ float gelu_tanh(float x) { const float u = 0.7978845608028654f * (x + 0.044715f * x * x * x); return x * fast_rcp(1.f + fast_exp2(-2.885390081777927f * u)); }

__device__ __forceinline__ float x16_sum(float x) { auto r = __builtin_amdgcn_permlane16_swap(__float_as_uint(x), __float_as_uint(x), false, false); return __uint_as_float(r[0]) + __uint_as_float(r[1]); }
__device__ __forceinline__ float x32_sum(float x) { auto r = __builtin_amdgcn_permlane32_swap(__float_as_uint(x), __float_as_uint(x), false, false); return __uint_as_float(r[0]) + __uint_as_float(r[1]); }
__device__ __forceinline__ float x16_max(float x) { auto r = __builtin_amdgcn_permlane16_swap(__float_as_uint(x), __float_as_uint(x), false, false); return fmaxf(__uint_as_float(r[0]), __uint_as_float(r[1])); }
__device__ __forceinline__ float x32_max(float x) { auto r = __builtin_amdgcn_permlane32_swap(__float_as_uint(x), __float_as_uint(x), false, false); return fmaxf(__uint_as_float(r[0]), __uint_as_float(r[1])); }
__device__ __forceinline__ float kg_sum(float x) { return x32_sum(x16_sum(x)); }
__device__ __forceinline__ float kg_max(float x) { return x32_max(x16_max(x)); }
__device__ __forceinline__ float quad_sum(float x) { x += __uint_as_float(__builtin_amdgcn_update_dpp(0u, __float_as_uint(x), 0xB1, 0xF, 0xF, true)); x += __uint_as_float(__builtin_amdgcn_update_dpp(0u, __float_as_uint(x), 0x4E, 0xF, 0xF, true)); return x; }
__device__ __forceinline__ float wave_sum(float v) {
    v = quad_sum(v);
    v += __uint_as_float(__builtin_amdgcn_update_dpp(0u, __float_as_uint(v), 0x141, 0xF, 0xF, true));
    v += __uint_as_float(__builtin_amdgcn_update_dpp(0u, __float_as_uint(v), 0x140, 0xF, 0xF, true));
    return x32_sum(x16_sum(v));
}
#define LDS_WAIT() asm volatile("s_waitcnt lgkmcnt(0)" ::: "memory")
#define VM_WAIT() asm volatile("s_waitcnt vmcnt(0)" ::: "memory")

__device__ __forceinline__ int kfrag_off(int key, int c8) {
    const int s = key >> 5, ko = key & 31, u = (ko >> 2) & 1, r16 = ((ko >> 3) << 2) | (ko & 3), ks = c8 >> 2, kg = c8 & 3;
    return s * 2048 + (u * 2 + ks) * 512 + (kg * 16 + r16) * 8;
}
__device__ __forceinline__ int vfrag_off(int key, int d) {
    const int s = key >> 5, ko = key & 31;
    return s * 2048 + (d >> 4) * 512 + ((ko >> 3) * 16 + (d & 15)) * 8 + (ko & 7);
}
namespace pg8 {
constexpr int BM = 256, BK = 64, HALF = 128, HTB = HALF * BK * 2, STAGE_BYTES = 8 * HTB, NXCD = 8, WGM = 4;
__host__ __device__ __forceinline__ int lds_byte(int r, int c) { const int st = (r >> 4) * 2 + (c >> 5), rr = r & 15, cc = c & 31, ob = rr * 64 + cc * 2; return st * 1024 + (ob ^ (((ob >> 9) & 1) << 5)); }
__host__ __device__ __forceinline__ void stage_rc(int b, int& R, int& C) { const int st = b / 1024, sb = b % 1024, swz = sb ^ (((sb >> 9) & 1) << 5); R = (st >> 1) * 16 + swz / 64; C = (st & 1) * 32 + (swz % 64) / 2; }
__host__ __device__ __forceinline__ int perm32(int rho) { const int n = rho >> 4, i = rho & 15; return 8 * (i >> 2) + 4 * n + (i & 3); }

struct Unit { int pm, pn, e, pnl, rloc; };

struct DenseOrder {
    int nM, nN, nwg, G, c;
    __device__ void init(int M, int N, int G_, int c_) { nM = M / BM; nN = N / BM; nwg = nM * nN; G = G_; c = c_; }
    __device__ bool next(int i, Unit& u) const {
        const long L = (long)i * G + c; if (L >= nwg) return false;
        int wgid = (int)L; { const int q = nwg / NXCD, r = nwg % NXCD, xcd = wgid % NXCD, off = wgid / NXCD; wgid = (xcd < r ? xcd * (q + 1) : r * (q + 1) + (xcd - r) * q) + off; }
        const int nig = WGM * nN, gid = wgid / nig, fm = gid * WGM, gsz = (nM - fm) < WGM ? (nM - fm) : WGM;
        u.pm = fm + ((wgid % nig) % gsz); u.pn = (wgid % nig) / gsz; u.e = 0; u.pnl = u.pn; u.rloc = 0; return true;
    }
    __device__ __forceinline__ unsigned rowoff(const Unit&, int) const { return 0u; }
};

struct MoeOrder {
    const LAS int* ust;
    const LAS int* bst;
    const LAS int* cnt;
    const int* tok;
    int NT, G, c, total, rowbytes;
    __device__ bool next(int i, Unit& u) const {
        const int L = i * G + c; if (L >= total) return false;
        int e = 0;
        for (int k = 1; k < NE; ++k) e += (L >= ust[k]) ? 1 : 0;
        e = __builtin_amdgcn_readfirstlane(e);
        const int loc = __builtin_amdgcn_readfirstlane(L - ust[e]), b0 = __builtin_amdgcn_readfirstlane(bst[e]), nb = __builtin_amdgcn_readfirstlane(bst[e + 1]) - b0;
        u.e = e; u.pnl = loc / nb; u.rloc = loc - u.pnl * nb; u.pm = b0 + u.rloc; u.pn = e * NT + u.pnl; return true;
    }
    __device__ __forceinline__ unsigned rowoff(const Unit& u, int r) const {
        const int slot = u.rloc * 256 + r; const int tk = slot < cnt[u.e] ? tok[u.e * 16384 + slot] : T;
        return (unsigned)tk * (unsigned)rowbytes;
    }
};

template <class Epi, class Sched, bool GATHER, bool ALIGN_EPI, bool FP8 = false>
__device__ __forceinline__ void gemm_phase(LAS unsigned char* lds, const bf16_t* A, const bf16_t* Bt, const int K, const Sched& S, const Epi& E) {
    int tid_ = threadIdx.x; asm volatile("" : "+v"(tid_));
    const int tid = tid_, wid = __builtin_amdgcn_readfirstlane(tid >> 6), lane = tid & 63, wr = wid >> 2, wc = wid & 3, fr = lane & 15, fq = lane >> 4;
    const int nt = K / BK;
    unsigned voffB[2];
#pragma unroll
    for (int i = 0; i < 2; ++i) { int R, C; stage_rc(tid * 16 + i * 8192, R, C); const int Rb = Epi::PERM ? ((R & ~31) + perm32(R & 31)) : R; voffB[i] = (unsigned)(Rb * K + C) * 2u; }
    const size_t kstep = (size_t)(BK * 2);
    const size_t hstep = (size_t)HALF * K * 2;
    const size_t tstep = 2 * hstep;
    const unsigned ldsw = (unsigned)wid * 1024u;
    const int aoff = lds_byte(wr * 64 + fr, fq * 8), boff = lds_byte(wc * 32 + fr, fq * 8);
#define PG8_SA(b, h) (((b) * 2 + (h)) * HTB)
#define PG8_SB(b, h) ((4 + (b) * 2 + (h)) * HTB)
#define PG8_STAGE(bufoff, gbase, v0, v1) do { \
        __builtin_amdgcn_global_load_lds((const unsigned*)((const char*)(gbase) + (v0)), (LAS unsigned*)(lds + (bufoff) + ldsw), 16, 0, 0); \
        __builtin_amdgcn_global_load_lds((const unsigned*)((const char*)(gbase) + (v1)), (LAS unsigned*)(lds + (bufoff) + ldsw + 8192), 16, 0, 0); } while (0)
#define PG8_STAGEB(bufoff, gbase) PG8_STAGE(bufoff, gbase, voffB[0], voffB[1])
#define PG8_CAT8(x0, x1) __builtin_shufflevector(x0, x1, 0, 1, 2, 3, 4, 5, 6, 7)
#define PG8_RD4(off) (*(const LAS i32x4*)(lds + (off)))
#define PG8_LDA(dst, b, h) do { if constexpr (FP8) { _Pragma("unroll") for (int m = 0; m < 4; ++m) dst##8[m] = PG8_CAT8(PG8_RD4(PG8_SA(b, h) + aoff + m * 2048), PG8_RD4(PG8_SA(b, h) + aoff + m * 2048 + 1024)); } \
        else { _Pragma("unroll") for (int m = 0; m < 4; ++m) _Pragma("unroll") for (int k = 0; k < 2; ++k) dst[m][k] = *(const LAS bf16x8*)(lds + PG8_SA(b, h) + aoff + m * 2048 + k * 1024); } } while (0)
#define PG8_LDB(dst, b, h) do { if constexpr (FP8) { _Pragma("unroll") for (int n = 0; n < 2; ++n) dst##8[n] = PG8_CAT8(PG8_RD4(PG8_SB(b, h) + boff + n * 2048), PG8_RD4(PG8_SB(b, h) + boff + n * 2048 + 1024)); } \
        else { _Pragma("unroll") for (int n = 0; n < 2; ++n) _Pragma("unroll") for (int k = 0; k < 2; ++k) dst[n][k] = *(const LAS bf16x8*)(lds + PG8_SB(b, h) + boff + n * 2048 + k * 1024); } } while (0)
#define PG8_MMA(ai, bj, At, Bt_) do { __builtin_amdgcn_s_setprio(1); _Pragma("unroll") for (int m = 0; m < 4; ++m) _Pragma("unroll") for (int n = 0; n < 2; ++n) { \
        if constexpr (FP8) { asm volatile("v_mfma_scale_f32_16x16x128_f8f6f4 %0, %1, %2, %0, %3, %4 op_sel_hi:[0,0,0]" : "+v"(acc[ai][bj][m][n]) : "v"(Bt_##8[n]), "v"(At##8[m]), "v"(sc_w), "v"(sc_x)); } \
        else { _Pragma("unroll") for (int k = 0; k < 2; ++k) acc[ai][bj][m][n] = __builtin_amdgcn_mfma_f32_16x16x32_bf16(Bt_[n][k], At[m][k], acc[ai][bj][m][n], 0, 0, 0); } } \
        __builtin_amdgcn_s_setprio(0); } while (0)
#define PG8_WAIT_V(n) asm volatile("s_waitcnt vmcnt(" #n ")" ::: "memory")
#define PG8_WAIT_L(n) asm volatile("s_waitcnt lgkmcnt(" #n ")" ::: "memory")
#define PG8_BAR __builtin_amdgcn_s_barrier()
#define PG8_SCHED __builtin_amdgcn_sched_barrier(0)
#define PG8_SETV(v, u) do { int t2_ = tid; asm volatile("" : "+v"(t2_)); _Pragma("unroll") for (int i_ = 0; i_ < 2; ++i_) { int R_, C_; stage_rc(t2_ * 16 + i_ * 8192, R_, C_); _Pragma("unroll") for (int h_ = 0; h_ < 2; ++h_) \
        v[h_][i_] = GATHER ? (S.rowoff(u, R_ + HALF * h_) + (unsigned)C_ * 2u) : (unsigned)((R_ + HALF * h_) * K + C_) * 2u; } } while (0)
    Unit cur, nxt; int ui = 0;
    if (!S.next(0, cur)) return;
    unsigned vc[2][2], vn[2][2];
    PG8_SETV(vc, cur);
    f32x4 acc[2][2][4][2];
#pragma unroll
    for (int a = 0; a < 2; ++a)
#pragma unroll
        for (int b = 0; b < 2; ++b)
#pragma unroll
            for (int m = 0; m < 4; ++m)
#pragma unroll
                for (int n = 0; n < 2; ++n) acc[a][b][m][n] = (f32x4){0.f, 0.f, 0.f, 0.f};
    bf16x8 At[4][2], B0[2][2], B1[2][2]; i32x8 At8[4], B08[2], B18[2];
    int sc_w = W8_E8M0, sc_x = ONE_E8M0; asm volatile("" : "+v"(sc_w), "+v"(sc_x));
    const char* cA = GATHER ? (const char*)A : (const char*)A + (size_t)cur.pm * tstep;
    const char* cB = (const char*)Bt + (size_t)cur.pn * tstep;
    PG8_STAGEB(PG8_SB(0, 0), cB); PG8_STAGEB(PG8_SB(0, 1), cB + hstep); PG8_STAGE(PG8_SA(0, 0), cA, vc[0][0], vc[0][1]); PG8_STAGE(PG8_SA(0, 1), cA, vc[1][0], vc[1][1]);
    if (wr == 1) PG8_BAR;
    PG8_WAIT_V(2); PG8_BAR;
    PG8_STAGEB(PG8_SB(1, 0), cB + kstep); PG8_STAGE(PG8_SA(1, 0), cA + kstep, vc[0][0], vc[0][1]); PG8_STAGEB(PG8_SB(1, 1), cB + hstep + kstep);
    PG8_WAIT_V(6); PG8_BAR;
    for (;;) {
        const bool has_next = S.next(ui + 1, nxt);
        const char* nA = GATHER ? (const char*)A : (has_next ? (const char*)A + (size_t)nxt.pm * tstep : cA);
        const char* nB = has_next ? (const char*)Bt + (size_t)nxt.pn * tstep : cB;
        if constexpr (GATHER) { if (has_next) { PG8_SETV(vn, nxt); } else {
#pragma unroll
            for (int h_ = 0; h_ < 2; ++h_)
#pragma unroll
                for (int i_ = 0; i_ < 2; ++i_) vn[h_][i_] = vc[h_][i_]; } }
#pragma nounroll
        for (int t = 0; t < nt; t += 2) {
            const bool last = (t == nt - 2);
            const char* a1 = cA + (size_t)(t + 1) * kstep;
            const char* a2 = last ? nA : cA + (size_t)(t + 2) * kstep; const char* b2 = last ? nB : cB + (size_t)(t + 2) * kstep;
            const char* a3 = a2 + kstep; const char* b3 = b2 + kstep;
            const unsigned w00 = (GATHER && last) ? vn[0][0] : vc[0][0], w01 = (GATHER && last) ? vn[0][1] : vc[0][1], w10 = (GATHER && last) ? vn[1][0] : vc[1][0], w11 = (GATHER && last) ? vn[1][1] : vc[1][1];
            PG8_LDB(B0, 0, 0); PG8_LDB(B1, 0, 1); PG8_SCHED; PG8_LDA(At, 0, 0); PG8_STAGE(PG8_SA(1, 1), a1, vc[1][0], vc[1][1]);
            PG8_WAIT_V(8); PG8_WAIT_L(0); PG8_BAR; PG8_MMA(0, 0, At, B0); PG8_MMA(0, 1, At, B1); PG8_BAR; PG8_SCHED;
            PG8_LDA(At, 0, 1); PG8_STAGEB(PG8_SB(0, 0), b2); PG8_STAGEB(PG8_SB(0, 1), b2 + hstep); PG8_STAGE(PG8_SA(0, 0), a2, w00, w01);
            PG8_WAIT_V(8); PG8_WAIT_L(0); PG8_BAR; PG8_MMA(1, 0, At, B0); PG8_MMA(1, 1, At, B1); PG8_BAR; PG8_SCHED;
            PG8_LDB(B0, 1, 0); PG8_LDB(B1, 1, 1); PG8_SCHED; PG8_LDA(At, 1, 0); PG8_STAGE(PG8_SA(0, 1), a2, w10, w11);
            PG8_WAIT_V(8); PG8_WAIT_L(0); PG8_BAR; PG8_MMA(0, 0, At, B0); PG8_MMA(0, 1, At, B1); PG8_BAR; PG8_SCHED;
            PG8_LDA(At, 1, 1); PG8_STAGEB(PG8_SB(1, 0), b3); PG8_STAGEB(PG8_SB(1, 1), b3 + hstep); PG8_STAGE(PG8_SA(1, 0), a3, w00, w01);
            PG8_WAIT_V(8); PG8_WAIT_L(0); PG8_BAR; PG8_MMA(1, 0, At, B0); PG8_MMA(1, 1, At, B1); PG8_BAR; PG8_SCHED;
        }
        if constexpr (FP8) { asm volatile("s_nop 15\n\ts_nop 15" ::: "memory"); }
        if constexpr (ALIGN_EPI) { if (wr == 0) PG8_BAR; }
        E(acc, cur, wr, wc, fr, fq);
        if (!has_next) break;
#pragma unroll
        for (int a = 0; a < 2; ++a)
#pragma unroll
            for (int b = 0; b < 2; ++b)
#pragma unroll
                for (int m = 0; m < 4; ++m)
#pragma unroll
                    for (int n = 0; n < 2; ++n) acc[a][b][m][n] = (f32x4){0.f, 0.f, 0.f, 0.f};
        cur = nxt; cA = nA; cB = nB; ++ui;
        if constexpr (GATHER) {
#pragma unroll
        for (int h_ = 0; h_ < 2; ++h_)
#pragma unroll
            for (int i_ = 0; i_ < 2; ++i_) vc[h_][i_] = vn[h_][i_]; }
        if constexpr (ALIGN_EPI) { if (wr == 1) PG8_BAR; }
    }
    PG8_WAIT_V(0);
    if constexpr (!ALIGN_EPI) { if (wr == 0) PG8_BAR; }
    PG8_BAR;
#undef PG8_SA
#undef PG8_SB
#undef PG8_STAGE
#undef PG8_STAGEB
#undef PG8_LDA
#undef PG8_LDB
#undef PG8_MMA
#undef PG8_CAT8
#undef PG8_RD4
#undef PG8_WAIT_V
#undef PG8_WAIT_L
#undef PG8_BAR
#undef PG8_SCHED
#undef PG8_SETV
}
}

#define XB_TMO      128
#define XB_XCNT(j)  (256  + 64 * (j))
#define XB_XSUB(j)  (1280 + 64 * (j))
#define XB_XGEN(j)  (2304 + 64 * (j))
#define XB_TOP      3328
#define XB_TOPGEN   3392
#define XCD_BAR_WORDS 3456
#define XB_SPIN_CAP (1u << 22)
__device__ __forceinline__ unsigned xb_ld(unsigned* p)              { return __hip_atomic_load(p, __ATOMIC_RELAXED, __HIP_MEMORY_SCOPE_AGENT); }
__device__ __forceinline__ unsigned xb_add(unsigned* p, unsigned v) { return __hip_atomic_fetch_add(p, v, __ATOMIC_RELAXED, __HIP_MEMORY_SCOPE_AGENT); }
__device__ __forceinline__ unsigned xb_xcc_id() { return (unsigned)__builtin_amdgcn_s_getreg((3 << 11) | 20) & 0xFu; }
#define XB_SPIN(cond, bar) do { unsigned _sp = 0; while (cond) { __builtin_amdgcn_s_sleep(1); \
    if ((++_sp & 255u) == 0u) { if (xb_ld(&(bar)[XB_TMO])) break; if (_sp > XB_SPIN_CAP) { atomicAdd(&(bar)[XB_TMO], 1u); break; } } } } while (0)
struct XcdBarrier { unsigned* bar; unsigned x; volatile LAS unsigned* st; };
__device__ __forceinline__ XcdBarrier xcd_barrier_post(unsigned* bar, volatile LAS unsigned* st) {
    XcdBarrier b; b.bar = bar; b.x = xb_xcc_id(); b.st = st;
    if (threadIdx.x == 0) (void)xb_add(&bar[XB_XCNT(b.x)], 1u);
    return b;
}
__device__ __forceinline__ void xcd_barrier_complete(unsigned* bar, unsigned x, unsigned& nloc, unsigned& nx) {
    const unsigned G = gridDim.x * gridDim.y * gridDim.z;
    unsigned sum, cnt, mine, sp = 0u;
    for (;;) {
        sum = 0u; cnt = 0u; mine = 0u;
#pragma unroll
        for (unsigned j = 0; j < 16; ++j) { const unsigned c = xb_ld(&bar[XB_XCNT(j)]); sum += c; cnt += (c > 0u) ? 1u : 0u; mine = (j == x) ? c : mine; }
        if (sum == G) break;
        __builtin_amdgcn_s_sleep(1);
        if ((++sp & 255u) == 0u) { if (xb_ld(&bar[XB_TMO])) break; if (sp > XB_SPIN_CAP) { atomicAdd(&bar[XB_TMO], 1u); break; } }
    }
    nloc = mine > 0u ? mine : 1u; nx = cnt > 0u ? cnt : 1u;
}
__device__ __forceinline__ void xcd_barrier(const XcdBarrier& b) {
    asm volatile("s_waitcnt vmcnt(0)" ::: "memory");
    __syncthreads();
    if (threadIdx.x == 0) {
        unsigned* bar = b.bar;
        __builtin_amdgcn_s_waitcnt(0);
        unsigned nloc = b.st[0], nx = b.st[1];
        if (nloc == 0u) { xcd_barrier_complete(bar, b.x, nloc, nx); b.st[0] = nloc; b.st[1] = nx; }
        const unsigned old = xb_add(&bar[XB_XSUB(b.x)], 1u);
        const unsigned gen = old / nloc;
        if (old + 1u == (gen + 1u) * nloc) {
            __builtin_amdgcn_fence(__ATOMIC_RELEASE, "agent");
            asm volatile("s_waitcnt vmcnt(0)" ::: "memory");
            const unsigned og = xb_add(&bar[XB_TOP], 1u);
            const unsigned tg = og / nx;
            if (og + 1u == (tg + 1u) * nx) xb_add(&bar[XB_TOPGEN], 1u);
            else XB_SPIN(xb_ld(&bar[XB_TOPGEN]) == tg, bar);
            __builtin_amdgcn_fence(__ATOMIC_ACQUIRE, "agent");
            xb_add(&bar[XB_XGEN(b.x)], 1u);
            asm volatile("s_waitcnt vmcnt(0)" ::: "memory");
        } else {
            XB_SPIN(xb_ld(&bar[XB_XGEN(b.x)]) == gen, bar);
            __builtin_amdgcn_fence(__ATOMIC_ACQUIRE, "agent");
            asm volatile("s_waitcnt vmcnt(0)" ::: "memory");
        }
    }
    __syncthreads();
}

struct Args { const void* in[26]; float* out; unsigned char* ws; int ph_lo, ph_hi, li, pad; };
enum { I_X = 0, I_C, I_POS, I_ADAW, I_ADAB, I_N1G, I_N2G, I_WIN, I_WOUT, I_SGLNG, I_SGLNB, I_SGW, I_SGB, I_PEK, I_PEV, I_CW1K, I_CW2K, I_CW1V, I_CW2V, I_RW, I_RB, I_EW1, I_EB1, I_EW2, I_EB2, I_FING };

#define GAS1 __attribute__((address_space(1)))
#define INP(A_, T_, i_) ({ int ix_ = (i_); asm volatile("" : "+s"(ix_)); (const T_*)(const GAS1 T_*)(A_).in[ix_]; })
struct Frame {
    LAS unsigned char* lds;
    unsigned* ctl;
    unsigned char* ws;
    int tid, lane, wave, vcu, G;
};
#define WSP(type, off) ((type*)(F.ws + (off)))
#define MODP(l, b, part) ((const float*)(F.ctl + CW_MOD) + ((size_t)((l) * 2 + (b)) * 6 + (part)) * 1024)

constexpr int RING_BYTES = 131072;
constexpr int ATT_LDS_BYTES = 147456;
constexpr int LDSCTL_OFF = ATT_LDS_BYTES;
constexpr int MISC_OFF = LDSCTL_OFF + 320;
constexpr int MOE_OFF = MISC_OFF + 128;
constexpr int LDS_BYTES = 163840;

struct EpiProj {
    static constexpr bool PERM = true;
    bf16_t *UG, *VG, *Q, *KC, *VC, *KS, *KW, *VST, *VWT; float* GATES; const float* ROPE; unsigned* kmax;
    __device__ __forceinline__ void operator()(const f32x4 (&acc)[2][2][4][2], const pg8::Unit& u, int wr, int wc, int fr, int fq) const {
        const int pn = u.pn; const int row0 = u.pm * 256 + wr * 64 + fr; const int b = u.pm >> 5;
        if (pn < 4 || pn == 6) {
#pragma unroll
            for (int ai = 0; ai < 2; ++ai)
#pragma unroll
                for (int m = 0; m < 4; ++m) { const size_t r = (size_t)(row0 + ai * 128 + m * 16);
#pragma unroll
                    for (int bj = 0; bj < 2; ++bj) { f32x4 v0 = acc[ai][bj][m][0], v1 = acc[ai][bj][m][1];
                        if (pn < 4) {
#pragma unroll
                            for (int i = 0; i < 4; ++i) { v0[i] = gelu_tanh(v0[i]); v1[i] = gelu_tanh(v1[i]); } }
                        u32x4 w; w.x = cvtpk(v0[0], v0[1]); w.y = cvtpk(v0[2], v0[3]); w.z = cvtpk(v1[0], v1[1]); w.w = cvtpk(v1[2], v1[3]);
                        bf16_t* dst;
                        if (pn < 2) dst = UG + r * 512 + pn * 256 + bj * 128 + wc * 32 + fq * 8;
                        else if (pn < 4) dst = VG + r * 512 + (pn - 2) * 256 + bj * 128 + wc * 32 + fq * 8;
                        else dst = (bj ? VC : KC) + r * 128 + wc * 32 + fq * 8;
                        *(u32x4*)dst = w; } }
        } else if (pn == 4 || pn == 5 || pn == 7) {
            const float sc = (pn == 7) ? 1.f : QSCALE; float nmax = 0.f;
#pragma unroll
            for (int ai = 0; ai < 2; ++ai)
#pragma unroll
                for (int m = 0; m < 4; ++m) { const size_t r = (size_t)(row0 + ai * 128 + m * 16);
                    const f32x4* cs = (const f32x4*)(ROPE + (r * 32 + fq * 8) * 2);
                    float o1[8], o2[8], nsq = 0.f;
#pragma unroll
                    for (int n = 0; n < 2; ++n) { const f32x4 c0 = cs[2 * n], c1 = cs[2 * n + 1]; const f32x4 x1 = acc[ai][0][m][n], x2 = acc[ai][1][m][n];
                        const float cc[4] = {c0[0], c0[2], c1[0], c1[2]}, ss[4] = {c0[1], c0[3], c1[1], c1[3]};
#pragma unroll
                        for (int i = 0; i < 4; ++i) { o1[4 * n + i] = (x1[i] * cc[i] - x2[i] * ss[i]) * sc; o2[4 * n + i] = (x2[i] * cc[i] + x1[i] * ss[i]) * sc; nsq += x1[i] * x1[i] + x2[i] * x2[i]; } }
                    u32x4 w1, w2; w1.x = cvtpk(o1[0], o1[1]); w1.y = cvtpk(o1[2], o1[3]); w1.z = cvtpk(o1[4], o1[5]); w1.w = cvtpk(o1[6], o1[7]);
                    w2.x = cvtpk(o2[0], o2[1]); w2.y = cvtpk(o2[2], o2[3]); w2.z = cvtpk(o2[4], o2[5]); w2.w = cvtpk(o2[6], o2[7]);
                    if (pn != 7) { bf16_t* dst = Q + r * 512 + (4 * (pn - 4) + wc) * 64 + fq * 8; *(u32x4*)dst = w1; *(u32x4*)(dst + 32) = w2; }
                    else { bf16_t* img = ((wc < 2) ? KS : KW) + (size_t)(b * 2 + (wc & 1)) * SEQ * 64; const int t = (int)r & (SEQ - 1);
                        *(u32x4*)(img + kfrag_off(t, fq)) = w1; *(u32x4*)(img + kfrag_off(t, 4 + fq)) = w2; }
                    nsq = kg_sum(nsq); nmax = fmaxf(nmax, nsq); }
            if (pn == 7) {
#pragma unroll
                for (int o = 1; o < 16; o <<= 1) nmax = fmaxf(nmax, __shfl_xor(nmax, o));
                if ((threadIdx.x & 63) == 0) atomicMax(kmax + ((wc < 2) ? 0 : 8) + b * 2 + (wc & 1), __float_as_uint(nmax * 1.02f));
            }
        } else if (pn == 8) {
            const int g = wc >> 1; float vmx = 0.f;
#pragma unroll
            for (int ai = 0; ai < 2; ++ai)
#pragma unroll
                for (int m = 0; m < 4; ++m) { const int r = row0 + ai * 128 + m * 16; const int s = r & (SEQ - 1);
#pragma unroll
                    for (int bj = 0; bj < 2; ++bj) { bf16_t* img = (bj ? VWT : VST) + (size_t)(b * 2 + g) * SEQ * 64;
#pragma unroll
                        for (int n = 0; n < 2; ++n)
#pragma unroll
                            for (int i = 0; i < 4; ++i) { img[vfrag_off(s, (wc & 1) * 32 + fq * 8 + n * 4 + i)] = (bf16_t)(cvtpk(acc[ai][bj][m][n][i], 0.f) & 0xffffu); if (bj == 0) vmx = fmaxf(vmx, fabsf(acc[ai][0][m][n][i])); } } }
#pragma unroll
            for (int o = 1; o < 64; o <<= 1) vmx = fmaxf(vmx, __shfl_xor(vmx, o));
            if ((threadIdx.x & 63) == 0) atomicMax(kmax + 4 + b * 2 + g, __float_as_uint(vmx * 1.01f));
        } else {
            if (wc == 0 && fq < 3) {
#pragma unroll
                for (int ai = 0; ai < 2; ++ai)
#pragma unroll
                    for (int m = 0; m < 4; ++m) { const size_t r = (size_t)(row0 + ai * 128 + m * 16);
#pragma unroll
                        for (int n = 0; n < 2; ++n) { f32x4 v = acc[ai][0][m][n];
#pragma unroll
                            for (int i = 0; i < 4; ++i) v[i] = sigmoidf_(v[i]);
                            *(f32x4*)(GATES + r * 24 + fq * 8 + n * 4) = v; } }
            }
        }
    }
};
struct EpiOut {
    static constexpr bool PERM = false;
    const float* xin; float* xout; const float* g1;
    __device__ __forceinline__ void operator()(const f32x4 (&acc)[2][2][4][2], const pg8::Unit& u, int wr, int wc, int fr, int fq) const {
        const int row0 = u.pm * 256 + wr * 64 + fr; const int b = u.pm >> 5; const int col0 = u.pn * 256 + wc * 32 + fq * 4;
        const float* gb = g1 + (size_t)b * 6144 + 2048;
        f32x4 gv[2][2];
#pragma unroll
        for (int bj = 0; bj < 2; ++bj)
#pragma unroll
            for (int n = 0; n < 2; ++n) gv[bj][n] = *(const f32x4*)(gb + col0 + bj * 128 + n * 16);
#pragma unroll
        for (int ai = 0; ai < 2; ++ai)
#pragma unroll
            for (int m = 0; m < 4; ++m) { const size_t off = (size_t)(row0 + ai * 128 + m * 16) * DM + col0;
#pragma unroll
                for (int bj = 0; bj < 2; ++bj)
#pragma unroll
                    for (int n = 0; n < 2; ++n) { const f32x4 xi = *(const f32x4*)(xin + off + bj * 128 + n * 16); *(f32x4*)(xout + off + bj * 128 + n * 16) = xi + gv[bj][n] * acc[ai][bj][m][n]; } }
    }
};
struct EpiSwiglu {
    static constexpr bool PERM = true;
    unsigned char* ACT; const float* b1;
    __device__ __forceinline__ void operator()(const f32x4 (&acc)[2][2][4][2], const pg8::Unit& u, int wr, int wc, int fr, int fq) const {
        const int row0 = u.pm * 256 + wr * 64 + fr; const int j0 = u.pnl * 128 + wc * 32 + fq * 8;
        const float* bb = b1 + (size_t)u.e * 2048 + j0;
        f32x4 bg[2], bl[2];
#pragma unroll
        for (int n = 0; n < 2; ++n) { bg[n] = *(const f32x4*)(bb + n * 4); bl[n] = *(const f32x4*)(bb + 1024 + n * 4); }
#pragma unroll
        for (int ai = 0; ai < 2; ++ai)
#pragma unroll
            for (int m = 0; m < 4; ++m) { float o[8];
#pragma unroll
                for (int n = 0; n < 2; ++n) { const f32x4 gl = acc[ai][0][m][n] + bg[n], ln = acc[ai][1][m][n] + bl[n];
#pragma unroll
                    for (int i = 0; i < 4; ++i) { const float gg = fminf(gl[i], 7.f), ll = fminf(fmaxf(ln[i], -7.f), 7.f); o[n * 4 + i] = gg * sigmoidf_(1.702f * gg) * (ll + 1.f); } }
                u32x2 w; w.x = cvt4_fp8(o[0], o[1], o[2], o[3]); w.y = cvt4_fp8(o[4], o[5], o[6], o[7]);
                *(u32x2*)(ACT + (size_t)(row0 + ai * 128 + m * 16) * FF + j0) = w; }
    }
};
struct EpiDown {
    static constexpr bool PERM = true;
    unsigned char* YR; const float* b2;
    __device__ __forceinline__ void operator()(const f32x4 (&acc)[2][2][4][2], const pg8::Unit& u, int wr, int wc, int fr, int fq) const {
        const int row0 = u.pm * 256 + wr * 64 + fr; const int c0 = u.pnl * 256 + wc * 32 + fq * 8;
        const float* bb = b2 + (size_t)u.e * 1024 + c0;
        f32x4 bv[2][2];
#pragma unroll
        for (int bj = 0; bj < 2; ++bj)
#pragma unroll
            for (int n = 0; n < 2; ++n) bv[bj][n] = *(const f32x4*)(bb + bj * 128 + n * 4);
#pragma unroll
        for (int ai = 0; ai < 2; ++ai)
#pragma unroll
            for (int m = 0; m < 4; ++m)
#pragma unroll
                for (int bj = 0; bj < 2; ++bj) { const f32x4 v0 = acc[ai][bj][m][0] + bv[bj][0], v1 = acc[ai][bj][m][1] + bv[bj][1];
                    u32x2 w; w.x = cvt4_fp8(v0[0], v0[1], v0[2], v0[3]); w.y = cvt4_fp8(v1[0], v1[1], v1[2], v1[3]);
                    *(u32x2*)(YR + (size_t)(row0 + ai * 128 + m * 16) * DM + c0 + bj * 128) = w; }
    }
};

__device__ __forceinline__ void tr_item(const float* W, int ldn, int k0, int c0, int nvalid, bf16_t* WT, int K, int drow0, LAS float* scr, int lane) {
    const int nn = lane & 31;
#pragma unroll 8
    for (int i = 0; i < 32; ++i) { const int kk = 2 * i + (lane >> 5); scr[kk * 33 + nn] = (nn < nvalid) ? W[(size_t)(k0 + kk) * ldn + c0 + nn] : 0.f; }
    LDS_WAIT(); asm volatile("" ::: "memory");
    const int c = lane & 7;
#pragma unroll
    for (int j = 0; j < 4; ++j) { const int n = (lane >> 3) + 8 * j; const LAS float* s = scr + (8 * c) * 33 + n;
        u32x4 o; o.x = cvtpk(s[0 * 33], s[1 * 33]); o.y = cvtpk(s[2 * 33], s[3 * 33]); o.z = cvtpk(s[4 * 33], s[5 * 33]); o.w = cvtpk(s[6 * 33], s[7 * 33]);
        *(u32x4*)(WT + (size_t)(drow0 + n) * K + k0 + 8 * c) = o; }
    LDS_WAIT(); asm volatile("" ::: "memory");
}
template <bool NTS> __device__ __forceinline__ void tr_item8(const float* W, int ldn, int k0, int c0, unsigned char* W8, int K, int drow0, LAS float* scr, int lane) {
    const int nn = lane & 31;
#pragma unroll 8
    for (int i = 0; i < 32; ++i) { const int kk = 2 * i + (lane >> 5); scr[kk * 33 + nn] = __builtin_nontemporal_load(W + (size_t)(k0 + kk) * ldn + c0 + nn) * W8SCALE; }
    LDS_WAIT(); asm volatile("" ::: "memory");
    const int c = lane & 3;
#pragma unroll
    for (int j = 0; j < 2; ++j) { const int n = (lane >> 2) + 16 * j; const LAS float* s = scr + (16 * c) * 33 + n;
        u32x4 o; o.x = cvt4_fp8(s[0 * 33], s[1 * 33], s[2 * 33], s[3 * 33]); o.y = cvt4_fp8(s[4 * 33], s[5 * 33], s[6 * 33], s[7 * 33]);
        o.z = cvt4_fp8(s[8 * 33], s[9 * 33], s[10 * 33], s[11 * 33]); o.w = cvt4_fp8(s[12 * 33], s[13 * 33], s[14 * 33], s[15 * 33]);
        if (NTS) __builtin_nontemporal_store(o, (u32x4*)(W8 + (size_t)(drow0 + n) * K + k0 + 16 * c)); else *(u32x4*)(W8 + (size_t)(drow0 + n) * K + k0 + 16 * c) = o; }
    LDS_WAIT(); asm volatile("" ::: "memory");
}
__device__ __forceinline__ void win_src(int p, int& c0, int& nvalid) {
    const int pn = p >> 8; nvalid = 32;
    if (pn < 4 || pn == 6) { c0 = p; }
    else if (pn == 4 || pn == 5) { const int pp = p - 1024 - 256 * (pn - 4), bj = pp >> 7, j = pp & 127; c0 = 1024 + (4 * (pn - 4) + (j >> 5)) * 64 + bj * 32; }
    else if (pn == 7) { const int pp = p - 1792, bj = pp >> 7, j = pp & 127, which = j >> 6, g = (j >> 5) & 1; c0 = (which ? 2048 : 1792) + g * 64 + bj * 32; }
    else if (pn == 8) { const int pp = p - 2048, bj = pp >> 7, j = pp & 127; c0 = (bj ? 2176 : 1920) + j; }
    else { const int pp = p - 2304; c0 = 2304 + pp; nvalid = 24 - pp; nvalid = nvalid < 0 ? 0 : (nvalid > 32 ? 32 : nvalid); if (nvalid == 0) c0 = 0; }
}
__device__ __forceinline__ void phase_prologue(Frame& F, const Args& a) {
    LAS float* scr = (LAS float*)(F.lds + F.wave * 8704);
    const int gw = F.vcu * NWAVES + F.wave, NGW = F.G * NWAVES; const int lane = F.lane;
    {
        const float* c = INP(a, float, I_C); const float* adaw = INP(a, float, I_ADAW); const float* adab = INP(a, float, I_ADAB);
        float* mod = (float*)(F.ctl + CW_MOD);
        LAS float* red = (LAS float*)(F.lds + 8 * 8704);
        for (int it = F.vcu; it < 2 * 24; it += F.G) {
            const int l = it / 24, nb = it % 24;
            const float* wp = adaw + ((size_t)l * 1024 + F.wave * 128) * 6144 + nb * 256 + lane * 4;
            f32x4 a0 = {0.f, 0.f, 0.f, 0.f}, a1 = a0;
#pragma unroll 4
            for (int k = 0; k < 128; ++k) { const f32x4 w = __builtin_nontemporal_load((const f32x4*)(wp + (size_t)k * 6144));
                const float c0 = c[F.wave * 128 + k], c1 = c[1024 + F.wave * 128 + k]; const float s0 = c0 * sigmoidf_(c0), s1 = c1 * sigmoidf_(c1);
                a0 += w * s0; a1 += w * s1; }
            *(LAS f32x4*)(red + (F.wave * 2 + 0) * 256 + lane * 4) = a0; *(LAS f32x4*)(red + (F.wave * 2 + 1) * 256 + lane * 4) = a1;
            __syncthreads();
            { const int b = F.tid >> 8, col = F.tid & 255; float sum = adab[(size_t)l * 6144 + nb * 256 + col];
#pragma unroll
              for (int ww = 0; ww < 8; ++ww) sum += red[(ww * 2 + b) * 256 + col];
              mod[((size_t)l * 2 + b) * 6144 + nb * 256 + col] = sum; }
            __syncthreads();
        }
    }
    {
        const float* win = INP(a, float, I_WIN); bf16_t* WinT = WSP(bf16_t, WS_WIN);
        for (int it = gw; it < 2 * 16 * 80; it += NGW) { const int l = it / 1280, kb = (it % 1280) / 80, nb = it % 80; int c0, nv; win_src(nb * 32, c0, nv);
            tr_item(win + (size_t)l * 1024 * PIN, PIN, kb * 64, c0, nv, WinT + (size_t)l * PINP * 1024, 1024, nb * 32, scr, lane); }
        const float* wout = INP(a, float, I_WOUT); bf16_t* WoutT = WSP(bf16_t, WS_WOUT);
        for (int it = gw; it < 2 * 16 * 32; it += NGW) { const int l = it / 512, kb = (it % 512) / 32, nb = it % 32;
            tr_item(wout + (size_t)l * 1024 * 1024, 1024, kb * 64, nb * 32, 32, WoutT + (size_t)l * 1024 * 1024, 1024, nb * 32, scr, lane); }
        bf16_t* CW1 = WSP(bf16_t, WS_CW1);
        for (int it = gw; it < 2 * 2 * 32 * 2; it += NGW) { const int l = it / 128, which = (it / 64) & 1, kb = (it % 64) / 2, nb = it & 1;
            const float* src = INP(a, float, which ? I_CW1V : I_CW1K) + (size_t)l * 2048 * 64;
            tr_item(src, 64, kb * 64, nb * 32, 32, CW1 + (size_t)(l * 2 + which) * 64 * 2048, 2048, nb * 32, scr, lane); }
        const float* ew1 = INP(a, float, I_EW1); unsigned char* W1T = WSP(unsigned char, WS_W1T);
        for (int it = gw; it < 2 * 32 * 16 * 64; it += NGW) { const int le = it >> 10, kb = (it >> 6) & 15, nb = it & 63; const int p = nb * 32, tile = p >> 8, bj = (p >> 7) & 1, j = p & 127;
            if (le < 32) tr_item8<false>(ew1 + (size_t)le * 1024 * 2048, 2048, kb * 64, bj * 1024 + tile * 128 + j, W1T + (size_t)le * 2048 * 1024, 1024, p, scr, lane);
            else tr_item8<true>(ew1 + (size_t)le * 1024 * 2048, 2048, kb * 64, bj * 1024 + tile * 128 + j, W1T + (size_t)le * 2048 * 1024, 1024, p, scr, lane); }
        const float* ew2 = INP(a, float, I_EW2); unsigned char* W2T = WSP(unsigned char, WS_W2T);
        for (int it = gw; it < 2 * 32 * 16 * 32; it += NGW) { const int le = it >> 9, kb = (it >> 5) & 15, nb = it & 31;
            if (le < 32) tr_item8<false>(ew2 + (size_t)le * 1024 * 1024, 1024, kb * 64, nb * 32, W2T + (size_t)le * 1024 * 1024, 1024, nb * 32, scr, lane);
            else tr_item8<true>(ew2 + (size_t)le * 1024 * 1024, 1024, kb * 64, nb * 32, W2T + (size_t)le * 1024 * 1024, 1024, nb * 32, scr, lane); }
    }
    {
        const int gt = (F.vcu * NWAVES + F.wave) * 64 + lane, NGT = NGW * 64;
        const float* sgw = INP(a, float, I_SGW); bf16_t* SGW = WSP(bf16_t, WS_SGW);
        for (int i = gt; i < 2 * 8 * 128 * 128; i += NGT) { const int s = i & 127, t = (i >> 7) & 127; SGW[i] = (bf16_t)(cvtpk(s <= t ? sgw[i] : 0.f, 0.f) & 0xffffu); }
        const int* pos = INP(a, int, I_POS); float* rope = WSP(float, WS_ROPE);
        for (int i = gt; i < T * 32; i += NGT) { const int tok = i >> 5, d = i & 31;
            const double inv = exp2(-(double)d * (13.287712379549449 / 32.0));
            const double rv = (double)pos[tok] * inv * 0.15915494309189535; const float fr = (float)(rv - __builtin_rint(rv));
            rope[2 * i] = __builtin_amdgcn_cosf(fr); rope[2 * i + 1] = __builtin_amdgcn_sinf(fr); }
        bf16_t* H = WSP(bf16_t, WS_H);
        for (int i = gt; i < 1024; i += NGT) { H[(size_t)T * 1024 + i] = 0; WSP(unsigned char, WS_H8)[(size_t)T * 1024 + i] = 0; }
        bf16_t* KCMP = WSP(bf16_t, WS_KCMP); bf16_t* VCT = WSP(bf16_t, WS_VCT);
        for (int i = gt; i < 2 * 2 * 64; i += NGT) { const int b = i >> 7, g = (i >> 6) & 1, d = i & 63; KCMP[(size_t)(b * 2 + g) * 512 * 64 + kfrag_off(511, d >> 3) + (d & 7)] = 0; VCT[(size_t)(b * 2 + g) * 512 * 64 + vfrag_off(511, d)] = 0; }
    }
    {
        float* cb = WSP(float, WS_MISC);
        for (int it = gw; it < 2 * 2 * 64; it += NGW) { const int l = it >> 7, which = (it >> 6) & 1, n = it & 63;
            const float* pe = INP(a, float, which ? I_PEV : I_PEK) + (size_t)l * 2048; const float* w1 = INP(a, float, which ? I_CW1V : I_CW1K) + (size_t)l * 2048 * 64;
            float s = 0.f; for (int k = lane; k < 2048; k += 64) s += pe[k] * w1[(size_t)k * 64 + n];
            s = wave_sum(s); if (lane == 0) cb[it] = s; }
    }
}

struct RowV { f32x4 v[4]; };
__device__ __forceinline__ RowV row_load(const float* p, int lane) { RowV r; const f32x4* q = (const f32x4*)p + lane;
#pragma unroll
    for (int j = 0; j < 4; ++j) r.v[j] = q[64 * j]; return r; }
__device__ __forceinline__ float row_ssq(const RowV& r) { float s = 0.f;
#pragma unroll
    for (int j = 0; j < 4; ++j) s += (r.v[j].x * r.v[j].x + r.v[j].y * r.v[j].y) + (r.v[j].z * r.v[j].z + r.v[j].w * r.v[j].w); return wave_sum(s); }
__device__ __forceinline__ void row_norm_store(const RowV& x, float rstd, const float* g, const float* sc, const float* sh, bf16_t* orow, int lane) {
    u32x2* o8 = (u32x2*)orow + lane;
#pragma unroll
    for (int j = 0; j < 4; ++j) { const f32x4 gg = ((const f32x4*)g)[lane + 64 * j], ss = ((const f32x4*)sc)[lane + 64 * j], hh = ((const f32x4*)sh)[lane + 64 * j];
        const f32x4 y = x.v[j] * rstd * gg * (ss + 1.f) + hh; u32x2 w; w.x = cvtpk(y.x, y.y); w.y = cvtpk(y.z, y.w); o8[64 * j] = w; }
}
__device__ __forceinline__ void row_norm_store8(const RowV& x, float rstd, const float* g, const float* sc, const float* sh, unsigned char* orow, int lane) {
    unsigned* o4 = (unsigned*)orow + lane;
#pragma unroll
    for (int j = 0; j < 4; ++j) { const f32x4 gg = ((const f32x4*)g)[lane + 64 * j], ss = ((const f32x4*)sc)[lane + 64 * j], hh = ((const f32x4*)sh)[lane + 64 * j];
        const f32x4 y = x.v[j] * rstd * gg * (ss + 1.f) + hh; o4[64 * j] = cvt4_fp8(y.x, y.y, y.z, y.w); }
}
__device__ __forceinline__ int expert_block_prefix(const unsigned* cnt, int lane) {
    int nb = (lane < NE) ? (int)((cnt[lane] + 255u) >> 8) : 0; int inc = nb;
#pragma unroll
    for (int o = 1; o < 32; o <<= 1) { const int t = __shfl_up(inc, o); if ((lane & 31) >= o) inc += t; }
    return inc - nb;
}
__device__ __forceinline__ void phase_n1_first(Frame& F, const Args& a) {
    const int gw = F.vcu * NWAVES + F.wave, NGW = F.G * NWAVES; const int lane = F.lane;
    const float* x = INP(a, float, I_X); const float* g = INP(a, float, I_N1G); bf16_t* H = WSP(bf16_t, WS_H);
    for (int m = gw; m < T; m += 2 * NGW) { const int m2 = m + NGW; const int b = m >> 13, b2 = m2 >> 13;
        const RowV r = row_load(x + (size_t)m * DM, lane); const RowV r2 = row_load(x + (size_t)m2 * DM, lane);
        const float rstd = 1.f / sqrtf(row_ssq(r) * (1.f / DM) + NORM_EPS), rstd2 = 1.f / sqrtf(row_ssq(r2) * (1.f / DM) + NORM_EPS);
        row_norm_store(r, rstd, g, MODP(0, b, 1), MODP(0, b, 0), H + (size_t)m * DM, lane);
        row_norm_store(r2, rstd2, g, MODP(0, b2, 1), MODP(0, b2, 0), H + (size_t)m2 * DM, lane); }
    float* RWP = WSP(float, WS_RWP); float* RBP = WSP(float, WS_MISC + 4096);
    const float* rw = INP(a, float, I_RW); const float* rb = INP(a, float, I_RB); const float* n2g = INP(a, float, I_N2G);
    const int gt = gw * 64 + lane, NGT = NGW * 64;
    for (int i = gt; i < 2 * 2 * 1024 * 32; i += NGT) { const int l = i >> 16, b = (i >> 15) & 1, k = (i >> 5) & 1023, e = i & 31;
        RWP[i] = n2g[l * 1024 + k] * (1.f + MODP(l, b, 4)[k]) * rw[((size_t)l * 1024 + k) * 32 + e]; }
    for (int it = gw; it < 2 * 2 * 32; it += NGW) { const int l = it >> 6, b = (it >> 5) & 1, e = it & 31; float s = 0.f;
        for (int k = lane; k < 1024; k += 64) s += MODP(l, b, 3)[k] * rw[((size_t)l * 1024 + k) * 32 + e];
        s = wave_sum(s); if (lane == 0) RBP[it] = s + rb[l * 32 + e]; }
}
__device__ __forceinline__ void phase_combine(Frame& F, const Args& a, int l) {
    const int gw = F.vcu * NWAVES + F.wave, NGW = F.G * NWAVES; const int lane = F.lane;
    float* XR = WSP(float, WS_XR); bf16_t* H = WSP(bf16_t, WS_H); const unsigned char* YR = WSP(unsigned char, WS_YROWS);
    const int* ASG = WSP(int, WS_ASG); const float* G4 = WSP(float, WS_GATE4);
    const int myprefix = expert_block_prefix(F.ctl + CW_CNT + l * 32, lane);
    const bool last = (l == DEPTH - 1);
    const float* g = last ? INP(a, float, I_FING) : INP(a, float, I_N1G) + (l + 1) * 1024;
#define COMB_LOAD(R_, WV_, GT_, M_) do { const int4 as4_ = *(const int4*)(ASG + (M_) * 4); const f32x4 gt4_ = *(const f32x4*)(G4 + (M_) * 4); \
        R_ = row_load(XR + (size_t)(M_) * DM, lane); const int asv_[4] = {as4_.x, as4_.y, as4_.z, as4_.w}; GT_[0] = gt4_.x; GT_[1] = gt4_.y; GT_[2] = gt4_.z; GT_[3] = gt4_.w; \
        _Pragma("unroll") for (int k = 0; k < 4; ++k) { const int e = asv_[k] >> 16, slot = asv_[k] & 0xffff; const int blk = __shfl(myprefix, e); \
            const unsigned* yr = (const unsigned*)(YR + ((size_t)blk * 256 + slot) * DM) + lane; _Pragma("unroll") for (int j = 0; j < 4; ++j) WV_[k][j] = __builtin_nontemporal_load(yr + 64 * j); } } while (0)
#define COMB_FINISH(R_, WV_, GT_, M_) do { const int b = (M_) >> 13; f32x4 y[4]; \
        _Pragma("unroll") for (int j = 0; j < 4; ++j) y[j] = (f32x4){0.f, 0.f, 0.f, 0.f}; \
        _Pragma("unroll") for (int k = 0; k < 4; ++k) _Pragma("unroll") for (int j = 0; j < 4; ++j) { const int w = (int)WV_[k][j]; const f32x2 lo_ = __builtin_amdgcn_cvt_pk_f32_fp8(w, false), hi_ = __builtin_amdgcn_cvt_pk_f32_fp8(w, true); y[j] += (f32x4){lo_.x, lo_.y, hi_.x, hi_.y} * GT_[k]; } \
        const float* g2 = MODP(l, b, 5); \
        _Pragma("unroll") for (int j = 0; j < 4; ++j) R_.v[j] += ((const f32x4*)g2)[lane + 64 * j] * y[j]; \
        const float rstd = 1.f / sqrtf(row_ssq(R_) * (1.f / DM) + NORM_EPS); \
        if (last) { f32x4* o = (f32x4*)(a.out + (size_t)(M_) * DM) + lane; _Pragma("unroll") for (int j = 0; j < 4; ++j) o[64 * j] = R_.v[j] * rstd * ((const f32x4*)g)[lane + 64 * j]; } \
        else { f32x4* xo = (f32x4*)(XR + (size_t)(M_) * DM) + lane; _Pragma("unroll") for (int j = 0; j < 4; ++j) xo[64 * j] = R_.v[j]; \
            row_norm_store(R_, rstd, g, MODP(l + 1, b, 1), MODP(l + 1, b, 0), H + (size_t)(M_) * DM, lane); } } while (0)
    for (int m = gw; m < T; m += 2 * NGW) { const int m2 = m + NGW;
        RowV rA, rB; unsigned wA[4][4], wB[4][4]; float gA[4], gB[4];
        COMB_LOAD(rA, wA, gA, m); COMB_LOAD(rB, wB, gB, m2);
        COMB_FINISH(rA, wA, gA, m); COMB_FINISH(rB, wB, gB, m2);
    }
#undef COMB_LOAD
#undef COMB_FINISH
}
__device__ __forceinline__ void compress_item(Frame& F, const Args& a, int l, int item) {
    const int which = item >> 7, b = (item >> 6) & 1, g = (item >> 5) & 1, n0 = (item & 31) * 16;
    const int lane = F.lane, w = F.wave, r16 = lane & 15, kg = lane >> 4;
    const bf16_t* src = WSP(bf16_t, which ? WS_VC : WS_KC);
    const bf16_t* W1 = WSP(bf16_t, WS_CW1) + (size_t)(l * 2 + which) * 64 * 2048;
    LAS float* red = (LAS float*)F.lds;
    LAS float* hid = (LAS float*)(F.lds + 32768);
    f32x4 acc[4];
#pragma unroll
    for (int i = 0; i < 4; ++i) acc[i] = (f32x4){0.f, 0.f, 0.f, 0.f};
    const int n = n0 + r16; const bool nval = n < NCMP;
#pragma unroll 2
    for (int ks = 0; ks < 8; ++ks) { const int k = 256 * w + 32 * ks + 8 * kg; const int li = k >> 6, d = k & 63;
        bf16x8 af = (bf16x8){0, 0, 0, 0, 0, 0, 0, 0};
        if (nval) af = *(const bf16x8*)(src + ((size_t)b * SEQ + 16 * n + li) * 128 + g * 64 + d);
#pragma unroll
        for (int nt = 0; nt < 4; ++nt) { const bf16x8 bf = *(const bf16x8*)(W1 + (size_t)(nt * 16 + r16) * 2048 + k); acc[nt] = __builtin_amdgcn_mfma_f32_16x16x32_bf16(af, bf, acc[nt], 0, 0, 0); } }
#pragma unroll
    for (int nt = 0; nt < 4; ++nt)
#pragma unroll
        for (int i = 0; i < 4; ++i) red[(w * 16 + 4 * kg + i) * 64 + nt * 16 + r16] = acc[nt][i];
    __syncthreads();
    const float* cb = WSP(float, WS_MISC) + (l * 2 + which) * 64;
    for (int i = F.tid; i < 1024; i += NTHREADS) { float s = cb[i & 63];
#pragma unroll
        for (int ww = 0; ww < 8; ++ww) s += red[ww * 1024 + i];
        hid[i] = gelu_tanh(s); }
    { const float* w2 = INP(a, float, which ? I_CW2V : I_CW2K) + (size_t)l * 4096; LAS f32x4* w2s4 = (LAS f32x4*)(F.lds + 40960);
      for (int i = F.tid; i < 1024; i += NTHREADS) w2s4[i] = ((const f32x4*)w2)[i]; }
    __syncthreads();
    {
        const int nn = F.tid >> 5, c = F.tid & 31; LAS float* w2s = (LAS float*)(F.lds + 40960);
        float o1 = 0.f, o2 = 0.f;
#pragma unroll 16
        for (int k = 0; k < 64; ++k) { const float h = hid[nn * 64 + k]; o1 += h * w2s[k * 64 + c]; o2 += h * w2s[k * 64 + c + 32]; }
        const int np = n0 + nn; float nsq_ = 0.f;
        if (np < NCMP) {
            if (!which) { const float* cs = WSP(float, WS_ROPE) + (((size_t)b * SEQ + 16 * np + 31) * 32 + c) * 2; const float cc = cs[0], ss = cs[1];
                const float r1 = o1 * cc - o2 * ss, r2 = o2 * cc + o1 * ss;
                bf16_t* img = WSP(bf16_t, WS_KCMP) + (size_t)(b * 2 + g) * 512 * 64; img[kfrag_off(np, c >> 3) + (c & 7)] = (bf16_t)(cvtpk(r1, 0.f) & 0xffffu); img[kfrag_off(np, 4 + (c >> 3)) + (c & 7)] = (bf16_t)(cvtpk(r2, 0.f) & 0xffffu);
                nsq_ = r1 * r1 + r2 * r2;
            } else { bf16_t* img = WSP(bf16_t, WS_VCT) + (size_t)(b * 2 + g) * 512 * 64; img[vfrag_off(np, c)] = (bf16_t)(cvtpk(o1, 0.f) & 0xffffu); img[vfrag_off(np, c + 32)] = (bf16_t)(cvtpk(o2, 0.f) & 0xffffu); }
        }
        if (!which) {
            float mx = quad_sum(nsq_);
            mx += __uint_as_float(__builtin_amdgcn_update_dpp(0u, __float_as_uint(mx), 0x141, 0xF, 0xF, true)); mx += __uint_as_float(__builtin_amdgcn_update_dpp(0u, __float_as_uint(mx), 0x140, 0xF, 0xF, true));
            mx = x16_sum(mx);
            mx = x32_max(mx);
            if (F.lane == 0) atomicMax(F.ctl + CW_KMAX + l * 16 + 12 + b * 2 + g, __float_as_uint(mx * 1.02f));
        }
    }
    __syncthreads();
}
__device__ __forceinline__ void sgu_item(Frame& F, const Args& a, int l, int ch) {
    const size_t tok0 = (size_t)ch * 128;
    const int lane = F.lane, w = F.wave, r16 = lane & 15, kg = lane >> 4;
    const bf16_t* VG = WSP(bf16_t, WS_VG); const bf16_t* UG = WSP(bf16_t, WS_UG); bf16_t* Y = WSP(bf16_t, WS_Y);
    LAS float* stats = (LAS float*)F.lds;
    LAS bf16_t* vnT = (LAS bf16_t*)(F.lds + 1024);
    constexpr int VP = 136;
    static_assert(1024 + 8 * 64 * 136 * 2 <= ATT_LDS_BYTES, "SGU LDS map");
    {
        u32x4 vrow[16];
#pragma unroll
        for (int tt = 0; tt < 16; ++tt) vrow[tt] = *(const u32x4*)(VG + (tok0 + 16 * w + tt) * 512 + lane * 8);
#pragma unroll
        for (int tt = 0; tt < 16; ++tt) { const int s = 16 * w + tt; const u32x4 v = vrow[tt];
            const float f[8] = {bflo(v.x), bfhi(v.x), bflo(v.y), bfhi(v.y), bflo(v.z), bfhi(v.z), bflo(v.w), bfhi(v.w)};
            float sm = 0.f;
#pragma unroll
            for (int i = 0; i < 8; ++i) sm += f[i];
            const float mu = wave_sum(sm) * (1.f / 512.f); float q = 0.f;
#pragma unroll
            for (int i = 0; i < 8; ++i) q += (f[i] - mu) * (f[i] - mu);
            const float var = wave_sum(q) * (1.f / 512.f);
            if (lane == 0) { stats[2 * s] = mu; stats[2 * s + 1] = 1.f / sqrtf(var + NORM_EPS); } }
    }
    __syncthreads();
    {
        const int s = F.tid & 127, hq = F.tid >> 7; const float mu = stats[2 * s], rs = stats[2 * s + 1];
#pragma unroll
        for (int hp = 0; hp < 2; ++hp) { const int h = hq + 4 * hp; const int cbase = h * 64;
            const float* lg = INP(a, float, I_SGLNG) + l * 512 + cbase; const float* lb = INP(a, float, I_SGLNB) + l * 512 + cbase;
#pragma unroll 2
            for (int d0 = 0; d0 < 64; d0 += 8) { const u32x4 v = *(const u32x4*)(VG + (tok0 + s) * 512 + cbase + d0);
                const float f[8] = {bflo(v.x), bfhi(v.x), bflo(v.y), bfhi(v.y), bflo(v.z), bfhi(v.z), bflo(v.w), bfhi(v.w)};
#pragma unroll
                for (int i = 0; i < 8; ++i) vnT[(h * 64 + d0 + i) * VP + s] = (bf16_t)(cvtpk((f[i] - mu) * rs * lg[d0 + i] + lb[d0 + i], 0.f) & 0xffffu); } }
    }
    __syncthreads();
    {
        const int h = w;
        const bf16_t* Wm = WSP(bf16_t, WS_SGW) + (size_t)(l * 8 + h) * 128 * 128; const float* bs = INP(a, float, I_SGB) + (size_t)(l * 8 + h) * 128;
#pragma nounroll
        for (int tt = 0; tt < 8; ++tt) {
            const int t = 16 * tt + r16; const float bb = bs[t];
            bf16x8 bw[4]; u32x2 ugv[4];
#pragma unroll
            for (int ks = 0; ks < 4; ++ks) bw[ks] = *(const bf16x8*)(Wm + (size_t)t * 128 + 32 * ks + 8 * kg);
#pragma unroll
            for (int dt = 0; dt < 4; ++dt) ugv[dt] = *(const u32x2*)(UG + (tok0 + t) * 512 + h * 64 + dt * 16 + 4 * kg);
            f32x4 acc[4];
#pragma unroll
            for (int i = 0; i < 4; ++i) acc[i] = (f32x4){0.f, 0.f, 0.f, 0.f};
            const int nks = (16 * tt + 15) / 32 + 1;
#pragma unroll
            for (int ks = 0; ks < 4; ++ks) { if (ks < nks) {
#pragma unroll
                for (int dt = 0; dt < 4; ++dt) { const bf16x8 afr = *(const LAS bf16x8*)(vnT + (h * 64 + dt * 16 + r16) * VP + 32 * ks + 8 * kg); acc[dt] = __builtin_amdgcn_mfma_f32_16x16x32_bf16(afr, bw[ks], acc[dt], 0, 0, 0); } } }
#pragma unroll
            for (int dt = 0; dt < 4; ++dt) { const u32x2 uu = ugv[dt];
                u32x2 o; o.x = cvtpk(bflo(uu.x) * (acc[dt][0] + bb), bfhi(uu.x) * (acc[dt][1] + bb)); o.y = cvtpk(bflo(uu.y) * (acc[dt][2] + bb), bfhi(uu.y) * (acc[dt][3] + bb));
                *(u32x2*)(Y + (tok0 + t) * 1024 + h * 64 + dt * 16 + 4 * kg) = o; }
        }
    }
    __syncthreads();
}
namespace att {
constexpr int OSP = 65;
constexpr int L_OH = 0;
constexpr int L_OL = 66560;
constexpr int L_LS = 133120;
constexpr int L_MREF = L_LS + 2048;
constexpr int USP = 129;
constexpr int L_SEL = L_MREF + 1024;
constexpr int L_CNT = L_SEL + 1024;
constexpr int L_LIST = L_CNT + 512;
constexpr int L_WCTR = L_LIST + 8192;
static_assert(L_WCTR + 16 <= ATT_LDS_BYTES, "attention LDS map");

struct Ptrs { const bf16_t *Q, *KS, *KW, *VST, *VWT, *KCMP, *VCT; const float* GATES; bf16_t* Y; float* YPART; float kmax, vmax, kwmax, kcmax; };

#define MFMA16(a, b, c) __builtin_amdgcn_mfma_f32_16x16x32_bf16(a, b, c, 0, 0, 0)

__device__ __forceinline__ void attn_unit(Frame& F, const Ptrs& P, int b, int g, int qb) {
    LAS unsigned char* lds = F.lds;
    const int tid = F.tid, lane = F.lane, w = F.wave, r16 = lane & 15, kg = lane >> 4;
    LAS int* Oh = (LAS int*)(lds + L_OH); LAS int* Ol = (LAS int*)(lds + L_OL); LAS float* imp = (LAS float*)(lds + L_OH);
    LAS int* lsel = (LAS int*)(lds + L_LS); LAS float* mref = (LAS float*)(lds + L_MREF);
    LAS unsigned* selm = (LAS unsigned*)(lds + L_SEL); LAS int* cnts = (LAS int*)(lds + L_CNT); LAS unsigned char* lists = lds + L_LIST; LAS int* wctr = (LAS int*)(lds + L_WCTR);
    const size_t tokb = (size_t)b * SEQ; const int t0 = qb * 64;
    const bf16_t* Qg = P.Q + (tokb + t0) * 512 + g * 256;
    LAS float* U = (LAS float*)(lds + L_OH); LAS float* linvc = (LAS float*)(lds + L_LS);
    {
        const int q = tid >> 3, part = tid & 7, hd = part >> 1, hf = part & 1;
        const u32x4* src = (const u32x4*)(Qg + (size_t)q * 512 + part * 32);
        float ss = 0.f;
#pragma unroll
        for (int i = 0; i < 4; ++i) { const u32x4 v = src[i]; const float f[8] = {bflo(v.x), bfhi(v.x), bflo(v.y), bfhi(v.y), bflo(v.z), bfhi(v.z), bflo(v.w), bfhi(v.w)};
#pragma unroll
            for (int k = 0; k < 8; ++k) ss += f[k] * f[k]; }
        ss += __uint_as_float(__builtin_amdgcn_update_dpp(0u, __float_as_uint(ss), 0xB1, 0xF, 0xF, true));
        if (hf == 0) mref[q * 4 + hd] = sqrtf(ss);
        { LAS u32x4* z4 = (LAS u32x4*)U; for (int i = tid; i < (256 * USP) / 4; i += NTHREADS) z4[i] = (u32x4){0u, 0u, 0u, 0u}; }
    }
    __syncthreads();
    const int hl = r16 & 3;
#define ATT_LDK(dst, base, key0) do { const char* kb_ = (const char*)(base) + (size_t)(key0) * 128; _Pragma("unroll") for (int u_ = 0; u_ < 2; ++u_) _Pragma("unroll") for (int ks_ = 0; ks_ < 2; ++ks_) \
        dst[u_][ks_] = *(const bf16x8*)(kb_ + koff + (u_ * 2 + ks_) * 1024); } while (0)
#define ATT_LDV(dst, vbase, LEN, key0) do { const char* vb_ = (const char*)(vbase) + (size_t)(key0) * 128; _Pragma("unroll") for (int dt_ = 0; dt_ < 4; ++dt_) \
        dst[dt_] = *(const bf16x8*)(vb_ + koff + dt_ * 1024); } while (0)
#define ATT_SHADOW() int ln_ = F.lane; asm volatile("" : "+v"(ln_)); const int r16 = ln_ & 15, kg = ln_ >> 4, hl = r16 & 3; const unsigned koff = (unsigned)ln_ * 16u
    {
        ATT_SHADOW();
        bf16x8 qf[2][2]; float mrc[2], lpart[2], carry[2] = {0.f, 0.f}; int nlim[2]; f32x4 o[2][4];
#pragma unroll
        for (int rt = 0; rt < 2; ++rt) { const int q = 8 * w + 4 * rt + (r16 >> 2);
#pragma unroll
            for (int ks = 0; ks < 2; ++ks) qf[rt][ks] = *(const bf16x8*)(Qg + (size_t)q * 512 + hl * 64 + ks * 32 + kg * 8);
            mrc[rt] = mref[q * 4 + hl] * P.kcmax; lpart[rt] = 0.f; nlim[rt] = (t0 + q - 31) >> 4;
#pragma unroll
            for (int dt = 0; dt < 4; ++dt) o[rt][dt] = (f32x4){0.f, 0.f, 0.f, 0.f}; }
        const int nkeys = 4 * qb + 3, NP = (nkeys + 31) >> 5;
        const int nlim_min = (t0 + 8 * w - 31) >> 4;
        const bf16_t* Kc = P.KCMP + (size_t)(b * 2 + g) * 512 * 64; const bf16_t* Vc = P.VCT + (size_t)(b * 2 + g) * 64 * 512;
#define ATT_S1_STEP(KF, VF, s_) do { _Pragma("unroll") for (int rt = 0; rt < 2; ++rt) { \
            f32x4 st[2]; float p[2][4]; \
            _Pragma("unroll") for (int u = 0; u < 2; ++u) { st[u] = MFMA16(KF[u][0], qf[rt][0], ((f32x4){0.f, 0.f, 0.f, 0.f})); st[u] = MFMA16(KF[u][1], qf[rt][1], st[u]); } \
            _Pragma("unroll") for (int u = 0; u < 2; ++u) _Pragma("unroll") for (int i = 0; i < 4; ++i) p[u][i] = fast_exp2(st[u][i] - mrc[rt]); \
            if (32 * (s_) + 31 > nlim_min) { _Pragma("unroll") for (int u = 0; u < 2; ++u) _Pragma("unroll") for (int i = 0; i < 4; ++i) { const int n = 32 * (s_) + 8 * kg + 4 * u + i; if (n > nlim[rt]) p[u][i] = 0.f; } } \
            const float s01 = (p[0][0] + p[0][1]) + (p[0][2] + p[0][3]), s11 = (p[1][0] + p[1][1]) + (p[1][2] + p[1][3]); lpart[rt] += s01 + s11; \
            {   \
                \
              const unsigned x_ = __float_as_uint(p[1][3]); const auto s16_ = __builtin_amdgcn_permlane16_swap(x_, x_, false, false); const auto s32_ = __builtin_amdgcn_permlane32_swap(s16_[1], s16_[1], false, false); \
              const float inc_ = (kg & 1) ? __uint_as_float(s16_[0]) : ((kg == 2) ? __uint_as_float(s32_[0]) : carry[rt]); carry[rt] = __uint_as_float(s32_[1]); \
              LAS float* ur = U + ((8 * w + 4 * rt + (r16 >> 2)) * 4 + hl) * USP + 8 * (s_) + 2 * kg; \
              ur[0] += (2.f * s01 - p[0][3]) + inc_; ur[1] += (2.f * s11 - p[1][3]) + p[0][3]; } \
            u32x4 pw; pw.x = cvtpk(p[0][0], p[0][1]); pw.y = cvtpk(p[0][2], p[0][3]); pw.z = cvtpk(p[1][0], p[1][1]); pw.w = cvtpk(p[1][2], p[1][3]); \
            const bf16x8 pf = __builtin_bit_cast(bf16x8, pw); \
            _Pragma("unroll") for (int dt = 0; dt < 4; ++dt) o[rt][dt] = MFMA16(VF[dt], pf, o[rt][dt]); } } while (0)
        {
            bf16x8 kA[2][2], vA[4], kB[2][2], vB[4];
            ATT_LDK(kA, Kc, 0); ATT_LDV(vA, Vc, 512, 0); if (NP > 1) { ATT_LDK(kB, Kc, 32); ATT_LDV(vB, Vc, 512, 32); }
#pragma nounroll
            for (int s2 = 0; s2 < NP; s2 += 2) {
                ATT_S1_STEP(kA, vA, s2);
                if (s2 + 2 < NP) { ATT_LDK(kA, Kc, 32 * (s2 + 2)); ATT_LDV(vA, Vc, 512, 32 * (s2 + 2)); }
                if (s2 + 1 < NP) { ATT_S1_STEP(kB, vB, s2 + 1);
                    if (s2 + 3 < NP) { ATT_LDK(kB, Kc, 32 * (s2 + 3)); ATT_LDV(vB, Vc, 512, 32 * (s2 + 3)); } }
            }
        }
#undef ATT_S1_STEP
#pragma unroll
        for (int rt = 0; rt < 2; ++rt) { const int q = 8 * w + 4 * rt + (r16 >> 2); const float lrow = kg_sum(lpart[rt]); const float linv = lrow > 0.f ? 1.f / lrow : 0.f;
            if (kg == 0) linvc[q * 4 + hl] = linv;
            const float gc = P.GATES[(tokb + t0 + q) * 24 + (g * 4 + hl) * 3 + 0] * linv;
            float* yp = P.YPART + (tokb + t0 + q) * 512 + (g * 4 + hl) * 64 + 4 * kg;
#pragma unroll
            for (int dt = 0; dt < 4; ++dt) *(f32x4*)(yp + dt * 16) = o[rt][dt] * gc; }
    }
    LDS_WAIT();
#pragma nounroll
    for (int qg = 0; qg < 2; ++qg) {
        if (qb <= 15) {
            if (lane < 4) { const int q = 8 * w + 4 * qg + lane; const unsigned long long m0 = (1ull << (qb + 1)) - 1ull;
                selm[q * 4 + 0] = (unsigned)m0; selm[q * 4 + 1] = (unsigned)(m0 >> 32); selm[q * 4 + 2] = 0u; selm[q * 4 + 3] = 0u; }
        } else {
            const int j0 = lane, j1 = lane + 64; int v0[4], v1[4], thr[4];
#pragma unroll
            for (int k = 0; k < 4; ++k) { const int q = 8 * w + 4 * qg + k; const LAS float* ur = U + (q * 4) * USP; const LAS float* li = linvc + q * 4;
                float i0 = 0.f, i1 = 0.f;
#pragma unroll
                for (int h = 0; h < 4; ++h) { i0 += ur[h * USP + j0] * li[h]; i1 += ur[h * USP + j1] * li[h]; }
                v0[k] = (j0 >= 1 && j0 <= qb - 2) ? (int)__float_as_uint(i0) : -1;
                v1[k] = (j1 <= qb - 2) ? (int)__float_as_uint(i1) : -1; thr[k] = 0; }
#pragma nounroll
            for (int bit = 30; bit >= 0; --bit) {
                const int c0_ = thr[0] | (1 << bit), c1_ = thr[1] | (1 << bit), c2_ = thr[2] | (1 << bit), c3_ = thr[3] | (1 << bit);
                const unsigned long long a0_ = __ballot(v0[0] >= c0_), a1_ = __ballot(v0[1] >= c1_), a2_ = __ballot(v0[2] >= c2_), a3_ = __ballot(v0[3] >= c3_);
                const unsigned long long b0_ = __ballot(v1[0] >= c0_), b1_ = __ballot(v1[1] >= c1_), b2_ = __ballot(v1[2] >= c2_), b3_ = __ballot(v1[3] >= c3_);
                asm volatile("" :: "s"(a0_), "s"(a1_), "s"(a2_), "s"(a3_), "s"(b0_), "s"(b1_), "s"(b2_), "s"(b3_));
                if (__popcll(a0_) + __popcll(b0_) >= 13) thr[0] = c0_;
                if (__popcll(a1_) + __popcll(b1_) >= 13) thr[1] = c1_;
                if (__popcll(a2_) + __popcll(b2_) >= 13) thr[2] = c2_;
                if (__popcll(a3_) + __popcll(b3_) >= 13) thr[3] = c3_; }
            const unsigned long long below = (1ull << lane) - 1ull;
#pragma nounroll
            for (int k = 0; k < 4; ++k) {
                const int vv0 = (k == 0) ? v0[0] : (k == 1) ? v0[1] : (k == 2) ? v0[2] : v0[3], vv1 = (k == 0) ? v1[0] : (k == 1) ? v1[1] : (k == 2) ? v1[2] : v1[3];
                const int th = (k == 0) ? thr[0] : (k == 1) ? thr[1] : (k == 2) ? thr[2] : thr[3];
                const bool gt0 = vv0 > th, gt1 = vv1 > th, eq0 = vv0 == th, eq1 = vv1 == th;
                const int need = 13 - (__popcll(__ballot(gt0)) + __popcll(__ballot(gt1)));
                const unsigned long long B0 = __ballot(eq0), B1 = __ballot(eq1);
                const int rk0 = __popcll(B0 & below), rk1 = __popcll(B0) + __popcll(B1 & below);
                unsigned long long m0 = __ballot(gt0 || (eq0 && rk0 < need)), m1 = __ballot(gt1 || (eq1 && rk1 < need));
                m0 |= 1ull;
                if (qb < 64) m0 |= (1ull << qb); else m1 |= (1ull << (qb - 64));
                if (qb - 1 < 64) m0 |= (1ull << (qb - 1)); else m1 |= (1ull << (qb - 65));
                if (lane == 0) { const int q = 8 * w + 4 * qg + k; selm[q * 4 + 0] = (unsigned)m0; selm[q * 4 + 1] = (unsigned)(m0 >> 32); selm[q * 4 + 2] = (unsigned)m1; selm[q * 4 + 3] = (unsigned)(m1 >> 32); } }
        }
    }
    __syncthreads();
    { LAS u32x4* z4 = (LAS u32x4*)Oh; for (int i = tid; i < (2 * 256 * OSP) / 4; i += NTHREADS) z4[i] = (u32x4){0u, 0u, 0u, 0u}; }
    lsel[tid] = 0;
    if (tid == 0) wctr[0] = 0;
    { const unsigned m0 = selm[lane * 4 + (w >> 1)];
#pragma nounroll
      for (int jj = 0; jj < 16; ++jj) { const int j = 16 * w + jj; const bool hit = (j <= qb) && ((m0 >> (16 * (w & 1) + jj)) & 1u);
          const unsigned long long mk = __ballot(hit); if (hit) lists[j * 64 + __popcll(mk & ((1ull << lane) - 1ull))] = (unsigned char)lane;
          if (lane == 0) cnts[j] = __popcll(mk); } }
    __syncthreads();
    for (int rep5 = 0; rep5 < ((ATTREP & 8) ? NREP : 1); ++rep5)
    {
        if (rep5 > 0) { __syncthreads(); if (tid == 0) wctr[0] = 0; __syncthreads(); }
        ATT_SHADOW();
        const bf16_t* Ks = P.KS + (size_t)(b * 2 + g) * SEQ * 64; const bf16_t* Vs = P.VST + (size_t)(b * 2 + g) * 64 * SEQ;
        const float S1 = 1048576.f / fmaxf(P.vmax, 1e-30f);
#define ATT_FETCH(idx_) do { int i_ = 0; if (lane == 0) i_ = __hip_atomic_fetch_add(wctr, 1, __ATOMIC_RELAXED, __HIP_MEMORY_SCOPE_WORKGROUP); idx_ = __builtin_amdgcn_readfirstlane(i_); } while (0)
#define ATT_JOF(idx_) (((idx_) == 0) ? 0 : (((idx_) == 1) ? qb : (((idx_) == 2) ? qb - 1 : (idx_) - 2)))
        bf16x8 kn[2][2][2];
        int idx; ATT_FETCH(idx);
        if (idx <= qb) { const int j = ATT_JOF(idx); ATT_LDK(kn[0], Ks, 64 * j); ATT_LDK(kn[1], Ks, 64 * j + 32); }
#pragma nounroll
        while (idx <= qb) {
            const int j = ATT_JOF(idx);
            bf16x8 kf[2][2][2], vf[2][4];
#pragma unroll
            for (int sp = 0; sp < 2; ++sp) {
#pragma unroll
                for (int u = 0; u < 2; ++u) { kf[sp][u][0] = kn[sp][u][0]; kf[sp][u][1] = kn[sp][u][1]; } }
            ATT_LDV(vf[0], Vs, SEQ, 64 * j); ATT_LDV(vf[1], Vs, SEQ, 64 * j + 32);
            int idx2; ATT_FETCH(idx2);
            if (idx2 <= qb) { const int j2 = ATT_JOF(idx2); ATT_LDK(kn[0], Ks, 64 * j2); ATT_LDK(kn[1], Ks, 64 * j2 + 32); }
            const int cnt = cnts[j];
            const int nch = (cnt + 3) >> 2;
            bf16x8 qn0, qn1; int qnx; bool vnx;
            { const int qs = (r16 >> 2); vnx = qs < cnt; qnx = lists[j * 64 + (vnx ? qs : (cnt > 0 ? cnt - 1 : 0))];
              const bf16_t* qp = Qg + (size_t)qnx * 512 + hl * 64 + kg * 8; qn0 = *(const bf16x8*)qp; qn1 = *(const bf16x8*)(qp + 32); }
#pragma nounroll
            for (int c = 0; c < nch; ++c) {
                const bool valid = vnx; const int q = qnx; const int row = q * 4 + hl; const bf16x8 q0 = qn0, q1 = qn1;
                if (c + 1 < nch) { const int qs = 4 * (c + 1) + (r16 >> 2); vnx = qs < cnt; qnx = lists[j * 64 + (vnx ? qs : cnt - 1)];
                    const bf16_t* qp = Qg + (size_t)qnx * 512 + hl * 64 + kg * 8; qn0 = *(const bf16x8*)qp; qn1 = *(const bf16x8*)(qp + 32); }
                const float mr = mref[row] * P.kmax;
                f32x4 o[4];
                float ps = 0.f;
                const bool slow = (j == qb) || (4 * c + 4 > cnt);
#define ATT_CHUNK(MASKED) \
                _Pragma("unroll") for (int sp = 0; sp < 2; ++sp) { \
                    f32x4 st[2]; float p[2][4]; \
                    _Pragma("unroll") for (int u = 0; u < 2; ++u) { st[u] = MFMA16(kf[sp][u][0], q0, ((f32x4){0.f, 0.f, 0.f, 0.f})); st[u] = MFMA16(kf[sp][u][1], q1, st[u]); } \
                    _Pragma("unroll") for (int u = 0; u < 2; ++u) _Pragma("unroll") for (int i = 0; i < 4; ++i) { float e = fast_exp2(st[u][i] - mr); \
                        if (MASKED) { const int kk = 32 * sp + 8 * kg + 4 * u + i; if (!valid || (j == qb && kk > q)) e = 0.f; } p[u][i] = e; ps += e; } \
                    u32x4 pw; pw.x = cvtpk(p[0][0], p[0][1]); pw.y = cvtpk(p[0][2], p[0][3]); pw.z = cvtpk(p[1][0], p[1][1]); pw.w = cvtpk(p[1][2], p[1][3]); \
                    const bf16x8 pf = __builtin_bit_cast(bf16x8, pw); \
                    _Pragma("unroll") for (int dt = 0; dt < 4; ++dt) o[dt] = (sp == 0) ? MFMA16(vf[0][dt], pf, ((f32x4){0.f, 0.f, 0.f, 0.f})) : MFMA16(vf[1][dt], pf, o[dt]); }
                if (slow) { ATT_CHUNK(true) } else { ATT_CHUNK(false) }
#undef ATT_CHUNK
                ps = kg_sum(ps);
                if (valid) {
                    if (kg == 0) { const float xs = ps * 1048576.f, hf_ = __builtin_rintf(xs); __hip_atomic_fetch_add(lsel + row, (int)hf_, __ATOMIC_RELAXED, __HIP_MEMORY_SCOPE_WORKGROUP);
                        __hip_atomic_fetch_add(lsel + 256 + row, (int)((xs - hf_) * 1048576.f), __ATOMIC_RELAXED, __HIP_MEMORY_SCOPE_WORKGROUP); }
#pragma unroll
                    for (int dt = 0; dt < 4; ++dt)
#pragma unroll
                        for (int i = 0; i < 4; ++i) { const float xs = o[dt][i] * S1, hf_ = __builtin_rintf(xs); const int off = row * OSP + dt * 16 + 4 * kg + i;
                            __hip_atomic_fetch_add(Oh + off, (int)hf_, __ATOMIC_RELAXED, __HIP_MEMORY_SCOPE_WORKGROUP);
                            __hip_atomic_fetch_add(Ol + off, (int)((xs - hf_) * 1048576.f), __ATOMIC_RELAXED, __HIP_MEMORY_SCOPE_WORKGROUP); }
                }
            }
            idx = idx2;
        }
    }
    f32x4 yacc[2][4];
    {
        ATT_SHADOW();
        bf16x8 qf[2][2]; float mrw[2], lpart[2]; f32x4 o[2][4];
#pragma unroll
        for (int rt = 0; rt < 2; ++rt) { const int q = 8 * w + 4 * rt + (r16 >> 2);
#pragma unroll
            for (int ks = 0; ks < 2; ++ks) qf[rt][ks] = *(const bf16x8*)(Qg + (size_t)q * 512 + hl * 64 + ks * 32 + kg * 8);
            mrw[rt] = mref[q * 4 + hl] * P.kwmax; lpart[rt] = 0.f;
#pragma unroll
            for (int dt = 0; dt < 4; ++dt) o[rt][dt] = (f32x4){0.f, 0.f, 0.f, 0.f}; }
        const bf16_t* Kw = P.KW + (size_t)(b * 2 + g) * SEQ * 64; const bf16_t* Vw = P.VWT + (size_t)(b * 2 + g) * 64 * SEQ;
        const int jlo = qb >= 8 ? qb - 8 : 0; const int nit = 2 * (qb - jlo + 1);
#define ATT_S4_STEP(KF, VF, it_) do { const int jw_ = jlo + ((it_) >> 1), sp_ = (it_) & 1; const int mode_ = (jw_ == qb) ? 1 : ((jw_ == qb - 8) ? 2 : 0); \
        _Pragma("unroll") for (int rt = 0; rt < 2; ++rt) { \
            f32x4 st[2]; float p[2][4]; \
            _Pragma("unroll") for (int u = 0; u < 2; ++u) { st[u] = MFMA16(KF[u][0], qf[rt][0], ((f32x4){0.f, 0.f, 0.f, 0.f})); st[u] = MFMA16(KF[u][1], qf[rt][1], st[u]); } \
            _Pragma("unroll") for (int u = 0; u < 2; ++u) _Pragma("unroll") for (int i = 0; i < 4; ++i) p[u][i] = fast_exp2(st[u][i] - mrw[rt]); \
            if (mode_) { const int tq = 8 * w + 4 * rt + (r16 >> 2); \
                _Pragma("unroll") for (int u = 0; u < 2; ++u) _Pragma("unroll") for (int i = 0; i < 4; ++i) { const int kk = 32 * sp_ + 8 * kg + 4 * u + i; const bool vis = (mode_ == 1) ? (kk <= tq) : (kk > tq); if (!vis) p[u][i] = 0.f; } } \
            lpart[rt] += ((p[0][0] + p[0][1]) + (p[0][2] + p[0][3])) + ((p[1][0] + p[1][1]) + (p[1][2] + p[1][3])); \
            u32x4 pw; pw.x = cvtpk(p[0][0], p[0][1]); pw.y = cvtpk(p[0][2], p[0][3]); pw.z = cvtpk(p[1][0], p[1][1]); pw.w = cvtpk(p[1][2], p[1][3]); \
            const bf16x8 pf = __builtin_bit_cast(bf16x8, pw); \
            _Pragma("unroll") for (int dt = 0; dt < 4; ++dt) o[rt][dt] = MFMA16(VF[dt], pf, o[rt][dt]); } } while (0)
        {
            bf16x8 kA[2][2], vA[4], kB[2][2], vB[4];
            ATT_LDK(kA, Kw, 64 * jlo); ATT_LDV(vA, Vw, SEQ, 64 * jlo); ATT_LDK(kB, Kw, 64 * jlo + 32); ATT_LDV(vB, Vw, SEQ, 64 * jlo + 32);
#pragma nounroll
            for (int it = 0; it < nit; it += 2) {
                ATT_S4_STEP(kA, vA, it);
                if (it + 2 < nit) { ATT_LDK(kA, Kw, 64 * jlo + 32 * (it + 2)); ATT_LDV(vA, Vw, SEQ, 64 * jlo + 32 * (it + 2)); }
                ATT_S4_STEP(kB, vB, it + 1);
                if (it + 3 < nit) { ATT_LDK(kB, Kw, 64 * jlo + 32 * (it + 3)); ATT_LDV(vB, Vw, SEQ, 64 * jlo + 32 * (it + 3)); }
            }
        }
#undef ATT_S4_STEP
#pragma unroll
        for (int rt = 0; rt < 2; ++rt) { const int q = 8 * w + 4 * rt + (r16 >> 2); const float lw_ = kg_sum(lpart[rt]); const float sc = lw_ > 0.f ? P.GATES[(tokb + t0 + q) * 24 + (g * 4 + hl) * 3 + 2] / lw_ : 0.f;
#pragma unroll
            for (int dt = 0; dt < 4; ++dt) yacc[rt][dt] = o[rt][dt] * sc; }
    }
    __syncthreads();
#pragma unroll
    for (int rt = 0; rt < 2; ++rt) { const int q = 8 * w + 4 * rt + (r16 >> 2), row = q * 4 + hl;
        const float lrow = (float)lsel[row] * (1.f / 1048576.f) + (float)lsel[256 + row] * (1.f / 1099511627776.f);
        const float invS1 = fmaxf(P.vmax, 1e-30f) * (1.f / 1048576.f);
        const float sc = lrow > 0.f ? P.GATES[(tokb + t0 + q) * 24 + (g * 4 + hl) * 3 + 1] / lrow * invS1 : 0.f;
        bf16_t* dst = P.Y + (tokb + t0 + q) * 1024 + 512 + (g * 4 + hl) * 64 + 4 * kg;
        const float* yp = P.YPART + (tokb + t0 + q) * 512 + (g * 4 + hl) * 64 + 4 * kg;
#pragma unroll
        for (int dt = 0; dt < 4; ++dt) { const LAS int* oh = Oh + row * OSP + dt * 16 + 4 * kg; const LAS int* ol = Ol + row * OSP + dt * 16 + 4 * kg;
            const f32x4 osel = (f32x4){(float)oh[0] + (float)ol[0] * (1.f / 1048576.f), (float)oh[1] + (float)ol[1] * (1.f / 1048576.f), (float)oh[2] + (float)ol[2] * (1.f / 1048576.f), (float)oh[3] + (float)ol[3] * (1.f / 1048576.f)};
            const f32x4 v = yacc[rt][dt] + *(const f32x4*)(yp + dt * 16) + osel * sc;
            u32x2 o; o.x = cvtpk(v[0], v[1]); o.y = cvtpk(v[2], v[3]); *(u32x2*)(dst + dt * 16) = o; } }
    __syncthreads();
}
#undef MFMA16
#undef ATT_LDK
#undef ATT_LDV
#undef ATT_SHADOW
#undef ATT_FETCH
#undef ATT_JOF
}

__device__ __forceinline__ void phase_n2(Frame& F, const Args& a, int l) {
    const int lane = F.lane, w = F.wave;
    const float* XR = WSP(float, WS_XR); unsigned char* H8 = WSP(unsigned char, WS_H8);
    const float* g = INP(a, float, I_N2G) + l * 1024;
    LAS float* part = (LAS float*)F.lds;
    LAS float* ssqp = (LAS float*)(F.lds + 32768);
    LAS float* lg = (LAS float*)(F.lds + 32768 + 1024);
    int* CNTI = WSP(int, WS_CNTI); int* ASG = WSP(int, WS_ASG); float* G4 = WSP(float, WS_GATE4);
    for (int item = F.vcu; item < T / 64; item += F.G) {
        const int tk0 = item * 64, b = tk0 >> 13; const int tt = w & 1, kq = w >> 1;
        const float* rwp = WSP(float, WS_RWP) + (size_t)(l * 2 + b) * 1024 * 32; const float* rbp = WSP(float, WS_MISC + 4096) + (l * 2 + b) * 32;
        const int i31 = lane & 31, hf = lane >> 5;
        {
            const float* xp = XR + (size_t)(tk0 + tt * 32 + i31) * DM + kq * 256 + 4 * hf; const float* wp = rwp + (size_t)(kq * 256 + 4 * hf) * 32 + i31;
            f32x16 acc;
#pragma unroll
            for (int r = 0; r < 16; ++r) acc[r] = 0.f;
            float ssq = 0.f;
#pragma nounroll
            for (int bt = 0; bt < 4; ++bt) {
                f32x4 xv[8]; float wv[8][4];
#pragma unroll
                for (int s = 0; s < 8; ++s) { xv[s] = *(const f32x4*)(xp + 8 * (bt * 8 + s)); const float* wq = wp + (size_t)(8 * (bt * 8 + s)) * 32;
                    wv[s][0] = wq[0]; wv[s][1] = wq[32]; wv[s][2] = wq[64]; wv[s][3] = wq[96]; }
#pragma unroll
                for (int s = 0; s < 8; ++s) { ssq += (xv[s].x * xv[s].x + xv[s].y * xv[s].y) + (xv[s].z * xv[s].z + xv[s].w * xv[s].w);
                    acc = __builtin_amdgcn_mfma_f32_32x32x2f32(xv[s].x, wv[s][0], acc, 0, 0, 0); acc = __builtin_amdgcn_mfma_f32_32x32x2f32(xv[s].y, wv[s][1], acc, 0, 0, 0);
                    acc = __builtin_amdgcn_mfma_f32_32x32x2f32(xv[s].z, wv[s][2], acc, 0, 0, 0); acc = __builtin_amdgcn_mfma_f32_32x32x2f32(xv[s].w, wv[s][3], acc, 0, 0, 0); }
            }
            ssq += __shfl_xor(ssq, 32);
            if (hf == 0) ssqp[kq * 64 + tt * 32 + i31] = ssq;
#pragma unroll
            for (int r = 0; r < 16; ++r) { const int tk = (r & 3) + 8 * (r >> 2) + 4 * hf; part[(w * 32 + tk) * 32 + i31] = acc[r]; }
        }
        __syncthreads();
        for (int i = F.tid; i < 64 * 32; i += NTHREADS) { const int tk = i >> 5, e = i & 31, t2 = tk >> 5, tl = tk & 31;
            const float sq = (ssqp[tk] + ssqp[64 + tk]) + (ssqp[128 + tk] + ssqp[192 + tk]); const float rstd = 1.f / sqrtf(sq * (1.f / DM) + NORM_EPS);
            const float v = (part[((0 * 2 + t2) * 32 + tl) * 32 + e] + part[((1 * 2 + t2) * 32 + tl) * 32 + e]) + (part[((2 * 2 + t2) * 32 + tl) * 32 + e] + part[((3 * 2 + t2) * 32 + tl) * 32 + e]);
            lg[tk * 33 + e] = v * rstd + rbp[e]; }
        __syncthreads();
        if (w < 2) {
            const int it = item * 2 + w;
            float v0 = -INFINITY, v1 = -INFINITY, v2 = -INFINITY, v3 = -INFINITY; int i0 = -1, i1 = -1, i2 = -1, i3 = -1;
            if (lane < 32) {
#pragma unroll 8
                for (int e = 0; e < 32; ++e) { const float v = lg[(w * 32 + lane) * 33 + e];
                    if (v > v3) { if (v > v2) { v3 = v2; i3 = i2; if (v > v1) { v2 = v1; i2 = i1; if (v > v0) { v1 = v0; i1 = i0; v0 = v; i0 = e; } else { v1 = v; i1 = e; } } else { v2 = v; i2 = e; } } else { v3 = v; i3 = e; } } }
            }
            const float e1 = __expf(v1 - v0), e2 = __expf(v2 - v0), e3 = __expf(v3 - v0); const float inv = 1.f / (1.f + e1 + e2 + e3);
            int r0 = 0, r1 = 0, r2 = 0, r3 = 0, mycnt = 0;
            for (int e = 0; e < 32; ++e) { const bool hit = (i0 == e) | (i1 == e) | (i2 == e) | (i3 == e); const unsigned long long U = __ballot(hit);
                const int rk = __popcll(U & ((1ull << lane) - 1ull));
                if (i0 == e) r0 = rk; if (i1 == e) r1 = rk; if (i2 == e) r2 = rk; if (i3 == e) r3 = rk;
                if (lane == e) mycnt = __popcll(U); }
            if (lane < 32) { const int tk = tk0 + w * 32 + lane; CNTI[it * 32 + lane] = mycnt;
                if (mycnt > 0) { atomicAdd(F.ctl + CW_GCNT + (l * 32 + (it >> 4)) * 32 + lane, (unsigned)mycnt); atomicAdd(F.ctl + CW_CNT + l * 32 + lane, (unsigned)mycnt); }
                *(int4*)(ASG + tk * 4) = make_int4((i0 << 16) | r0, (i1 << 16) | r1, (i2 << 16) | r2, (i3 << 16) | r3);
                *(f32x4*)(G4 + tk * 4) = (f32x4){inv, e1 * inv, e2 * inv, e3 * inv}; }
        }
#pragma unroll 2
        for (int rr = 0; rr < 8; ++rr) { const int m = tk0 + w * 8 + rr; const RowV r = row_load(XR + (size_t)m * DM, lane);
            const float rstd = 1.f / sqrtf(row_ssq(r) * (1.f / DM) + NORM_EPS);
            row_norm_store8(r, rstd, g, MODP(l, b, 4), MODP(l, b, 3), H8 + (size_t)m * DM, lane); }
        __syncthreads();
    }
}

__device__ __forceinline__ void phase_n2b(Frame& F, int l) {
    const int gw = F.vcu * NWAVES + F.wave, NGW = F.G * NWAVES; const int lane = F.lane;
    const int* CNTI = WSP(int, WS_CNTI); int* TOK = WSP(int, WS_TOK); int* ASG = WSP(int, WS_ASG); unsigned* cnt = F.ctl + CW_CNT + l * 32;
    for (int it = gw; it < T / 32; it += NGW) {
        int base = 0;
        {
            const unsigned* gc = F.ctl + CW_GCNT + l * 1024; const int grp = it >> 4, e = lane & 31; int s0 = 0, s1 = 0;
#pragma unroll
            for (int gI = 0; gI < 32; ++gI) { const int v = (int)gc[gI * 32 + e]; s0 += (gI < grp) ? v : 0; }
#pragma unroll
            for (int i = 0; i < 16; ++i) { const int v = CNTI[((grp << 4) + i) * 32 + e]; s1 += (((grp << 4) + i) < it) ? v : 0; }
            base = s0 + s1; }
        { const int tk = it * 32 + (lane & 31); const int4 as = *(const int4*)(ASG + tk * 4); int v[4] = {as.x, as.y, as.z, as.w};
#pragma unroll
            for (int k = 0; k < 4; ++k) { const int e = v[k] >> 16, rk = v[k] & 0xffff; const int sl = __shfl(base, e & 31) + rk; if (lane < 32) TOK[e * 16384 + sl] = tk; v[k] = (e << 16) | sl; }
            if (lane < 32) *(int4*)(ASG + tk * 4) = make_int4(v[0], v[1], v[2], v[3]); }
    }
}

__device__ __forceinline__ void moe_tables(Frame& F, int l, int NT, int& total) {
    LAS int* ust = (LAS int*)(F.lds + MOE_OFF); LAS int* bst = ust + 33; LAS int* cn = bst + 33;
    if (F.tid < 64) { const unsigned* cnt = F.ctl + CW_CNT + l * 32; const int lane = F.tid;
        const int c = (lane < NE) ? (int)cnt[lane] : 0; const int nb = (c + 255) >> 8; int inc = nb;
#pragma unroll
        for (int o = 1; o < 32; o <<= 1) { const int t = __shfl_up(inc, o); if ((lane & 31) >= o) inc += t; }
        if (lane < NE) { bst[lane] = inc - nb; ust[lane] = (inc - nb) * NT; cn[lane] = c; if (lane == NE - 1) { bst[NE] = inc; ust[NE] = inc * NT; } } }
    __syncthreads();
    total = ust[NE];
}

constexpr int PH_PROLOGUE = 0, PH_N1 = 1, PH_LAYER0 = 2, PH_PER_LAYER = 9, NPHASES = PH_LAYER0 + DEPTH * PH_PER_LAYER;
__global__ void __launch_bounds__(NTHREADS, 2) fwd_kernel(Args args) {
    extern __shared__ __attribute__((aligned(16))) unsigned char lds_raw[];
    Frame F;
    F.lds = (LAS unsigned char*)lds_raw; F.ws = args.ws; F.ctl = (unsigned*)(args.ws + WS_CTL);
    F.tid = threadIdx.x; F.lane = F.tid & 63; F.wave = __builtin_amdgcn_readfirstlane(F.tid >> 6);
    F.G = gridDim.x; { const int bx = blockIdx.x; F.vcu = (F.G % 8 == 0) ? (bx % 8) * (F.G / 8) + bx / 8 : bx; }
    for (int u = F.tid; u < (LDS_BYTES - LDSCTL_OFF) / 4; u += NTHREADS) ((LAS unsigned*)(F.lds + LDSCTL_OFF))[u] = 0u;
    __syncthreads();
    volatile LAS unsigned* MISC = (volatile LAS unsigned*)(F.lds + MISC_OFF);
    XcdBarrier bar; bar.bar = F.ctl + CW_BAR; bar.x = 0; bar.st = nullptr;
#if !MK_PER_PHASE
    bar = xcd_barrier_post(F.ctl + CW_BAR, MISC + 8);
#endif
    const int lo = args.ph_lo, hi = args.ph_hi;
#define IN(k) (lo <= (k) && (k) < hi)
#define REFRESH() do { int t_ = threadIdx.x; asm volatile("" : "+v"(t_)); F.tid = t_; F.lane = t_ & 63; F.wave = __builtin_amdgcn_readfirstlane(t_ >> 6); } while (0)
#define SEAM(k) do { if (IN(k) && IN((k) + 1)) xcd_barrier(bar); } while (0)
#define REPS(bit, idem) (((REPMASK & (bit)) && (idem)) ? NREP : 1)

    if (IN(PH_PROLOGUE) && !(SKIPMASK & 1)) for (int rep = 0; rep < REPS(1, true); ++rep) { REFRESH(); phase_prologue(F, args); } SEAM(PH_PROLOGUE);
    if (IN(PH_N1) && !(SKIPMASK & 2)) for (int rep = 0; rep < REPS(2, true); ++rep) { REFRESH(); phase_n1_first(F, args); } SEAM(PH_N1);
    for (int l = 0; l < DEPTH; ++l) {
        const int p0 = PH_LAYER0 + l * PH_PER_LAYER;
        if (IN(p0 + 0) && !(SKIPMASK & 4)) for (int rep = 0; rep < REPS(4, l == 0); ++rep) {
            pg8::DenseOrder S; S.init(T, PINP, F.G, (int)blockIdx.x);
            EpiProj E{WSP(bf16_t, WS_UG), WSP(bf16_t, WS_VG), WSP(bf16_t, WS_Q), WSP(bf16_t, WS_KC), WSP(bf16_t, WS_VC), WSP(bf16_t, WS_KS), WSP(bf16_t, WS_KW), WSP(bf16_t, WS_VST), WSP(bf16_t, WS_VWT),
                      WSP(float, WS_GATES), WSP(float, WS_ROPE), F.ctl + CW_KMAX + l * 16};
            pg8::gemm_phase<EpiProj, pg8::DenseOrder, false, true>(F.lds, WSP(bf16_t, WS_H), WSP(bf16_t, WS_WIN) + (size_t)l * PINP * 1024, 1024, S, E);
        }
        SEAM(p0 + 0);
        if (IN(p0 + 1) && !(SKIPMASK & 8)) for (int rep = 0; rep < REPS(8, l == 0); ++rep) { REFRESH();
            for (int it = F.vcu; it < 256; it += F.G) { if (it < 128) sgu_item(F, args, l, it); else { compress_item(F, args, l, 2 * (it - 128)); compress_item(F, args, l, 2 * (it - 128) + 1); } }
        }
        SEAM(p0 + 1);
        if (IN(p0 + 2) && !(SKIPMASK & 16)) for (int rep = 0; rep < REPS(16, l == 0); ++rep) { REFRESH();
            att::Ptrs P{WSP(bf16_t, WS_Q), WSP(bf16_t, WS_KS), WSP(bf16_t, WS_KW), WSP(bf16_t, WS_VST), WSP(bf16_t, WS_VWT), WSP(bf16_t, WS_KCMP), WSP(bf16_t, WS_VCT), WSP(float, WS_GATES), WSP(bf16_t, WS_Y), WSP(float, WS_YPART), 0.f};
            for (int it = F.vcu; it < 512; it += F.G) {
                const int uu = (it < 256) ? it : (767 - it);
                const int bg = uu >> 7, qb = uu & 127;
                const unsigned* km = F.ctl + CW_KMAX + l * 16 + bg;
                P.kmax = sqrtf(__uint_as_float(__hip_atomic_load(km, __ATOMIC_RELAXED, __HIP_MEMORY_SCOPE_AGENT)));
                P.vmax = __uint_as_float(__hip_atomic_load(km + 4, __ATOMIC_RELAXED, __HIP_MEMORY_SCOPE_AGENT));
                P.kwmax = sqrtf(__uint_as_float(__hip_atomic_load(km + 8, __ATOMIC_RELAXED, __HIP_MEMORY_SCOPE_AGENT)));
                P.kcmax = sqrtf(__uint_as_float(__hip_atomic_load(km + 12, __ATOMIC_RELAXED, __HIP_MEMORY_SCOPE_AGENT)));
                att::attn_unit(F, P, bg >> 1, bg & 1, qb);
            }
        }
        SEAM(p0 + 2);
        if (IN(p0 + 3) && !(SKIPMASK & 32)) for (int rep = 0; rep < REPS(32, l == 0); ++rep) {
            pg8::DenseOrder S; S.init(T, DM, F.G, (int)blockIdx.x);
            EpiOut E{l == 0 ? INP(args, float, I_X) : WSP(float, WS_XR), WSP(float, WS_XR), (const float*)(F.ctl + CW_MOD) + (size_t)l * 2 * 6144};
            pg8::gemm_phase<EpiOut, pg8::DenseOrder, false, true>(F.lds, WSP(bf16_t, WS_Y), WSP(bf16_t, WS_WOUT) + (size_t)l * 1024 * 1024, 1024, S, E);
        }
        SEAM(p0 + 3);
        if (IN(p0 + 4) && !(SKIPMASK & 64)) for (int rep = 0; rep < REPS(64, l == 0); ++rep) { REFRESH(); phase_n2(F, args, l); }
        SEAM(p0 + 4);
        if (IN(p0 + 5) && !(SKIPMASK & 64)) for (int rep = 0; rep < REPS(1024, l == 0); ++rep) { REFRESH(); phase_n2b(F, l); }
        SEAM(p0 + 5);
        if (IN(p0 + 6) && !(SKIPMASK & 128)) for (int rep = 0; rep < REPS(128, l == 0); ++rep) { REFRESH();
            int total; moe_tables(F, l, 8, total);
            LAS int* ust = (LAS int*)(F.lds + MOE_OFF);
            pg8::MoeOrder S{ust, ust + 33, ust + 66, WSP(int, WS_TOK), 8, F.G, F.vcu, total, 1024};
            EpiSwiglu E{WSP(unsigned char, WS_ACT), INP(args, float, I_EB1) + (size_t)l * NE * 2048};
            pg8::gemm_phase<EpiSwiglu, pg8::MoeOrder, true, true, true>(F.lds, WSP(bf16_t, WS_H8), (const bf16_t*)(WSP(unsigned char, WS_W1T) + (size_t)l * NE * 2048 * 1024), 512, S, E);
        }
        SEAM(p0 + 6);
        if (IN(p0 + 7) && !(SKIPMASK & 256)) for (int rep = 0; rep < REPS(256, l == 0); ++rep) { REFRESH();
            int total; moe_tables(F, l, 4, total);
            LAS int* ust = (LAS int*)(F.lds + MOE_OFF);
            pg8::MoeOrder S{ust, ust + 33, ust + 66, WSP(int, WS_TOK), 4, F.G, F.vcu, total, 1024};
            EpiDown E{WSP(unsigned char, WS_YROWS), INP(args, float, I_EB2) + (size_t)l * NE * 1024};
            pg8::gemm_phase<EpiDown, pg8::MoeOrder, false, true, true>(F.lds, WSP(bf16_t, WS_ACT), (const bf16_t*)(WSP(unsigned char, WS_W2T) + (size_t)l * NE * 1024 * 1024), 512, S, E);
        }
        SEAM(p0 + 7);
        if (IN(p0 + 8) && !(SKIPMASK & 512)) for (int rep = 0; rep < REPS(512, l == DEPTH - 1); ++rep) { REFRESH(); phase_combine(F, args, l); }
        if (l + 1 < DEPTH) SEAM(p0 + 8);
    }
#undef IN
#undef SEAM
}

extern "C" void kernel_launch(void* const* d_in, const int* in_sizes, int n_in, void* d_out, int out_size, void* d_ws, size_t ws_size, hipStream_t stream) {
    static int grid = 0;
    if (grid == 0) {
        if (n_in != 26 || out_size != T * DM || ws_size < WS_END) { fprintf(stderr, "kernel_launch: unexpected problem (n_in %d, out %d, ws %zu; need ws >= %zu)\n", n_in, out_size, ws_size, (size_t)WS_END); grid = -1; return; }
        int dev = 0, cus = 0, per_cu = 0;
        if (hipGetDevice(&dev) != hipSuccess || hipDeviceGetAttribute(&cus, hipDeviceAttributeMultiprocessorCount, dev) != hipSuccess) { grid = -1; return; }
        if (hipFuncSetAttribute((const void*)fwd_kernel, hipFuncAttributeMaxDynamicSharedMemorySize, LDS_BYTES) != hipSuccess) { fprintf(stderr, "kernel_launch: hipFuncSetAttribute failed\n"); grid = -1; return; }
        if (hipOccupancyMaxActiveBlocksPerMultiprocessor(&per_cu, (const void*)fwd_kernel, NTHREADS, LDS_BYTES) != hipSuccess || per_cu < 1) { fprintf(stderr, "kernel_launch: occupancy query says %d\n", per_cu); (void)hipGetLastError(); per_cu = 1; }
        grid = cus;
    }
    if (grid < 0) return;
    if (hipMemsetAsync((char*)d_ws + WS_CTL, 0, CTL_ZERO_BYTES, stream) != hipSuccess) { fprintf(stderr, "kernel_launch: memset failed\n"); return; }
    Args a{};
    for (int i = 0; i < 26; ++i) a.in[i] = d_in[i];
    a.out = (float*)d_out; a.ws = (unsigned char*)d_ws;
#if MK_PER_PHASE
    for (int p = 0; p < NPHASES; ++p) { a.ph_lo = p; a.ph_hi = p + 1; a.li = 0;
        hipLaunchKernelGGL(fwd_kernel, dim3(grid), dim3(NTHREADS), LDS_BYTES, stream, a); }
#else
    a.ph_lo = 0; a.ph_hi = NPHASES; a.li = 0;
    void* kargs[] = {&a};
    hipError_t e = hipLaunchCooperativeKernel((const void*)fwd_kernel, dim3(grid), dim3(NTHREADS), kargs, LDS_BYTES, stream);
    if (e != hipSuccess) fprintf(stderr, "kernel_launch: cooperative launch failed: %s (grid %d)\n", hipGetErrorString(e), grid);
#endif
}
```

```cpp
#include <hip/hip_runtime.h>
#include <cstdio>
#include <cstdint>

#ifndef SKIPMASK
#define SKIPMASK 0
#endif
#ifndef REPMASK
#define REPMASK 0
#endif
#ifndef NREP
#define NREP 3
#endif
#ifndef DUMMYINT
#define DUMMYINT 0
#endif
#ifndef ATTREP
#define ATTREP 0
#endif
#ifndef MK_PER_PHASE
#define MK_PER_PHASE 0
#endif

#define LAS __attribute__((address_space(3)))
typedef unsigned short bf16_t;
typedef short bf16x8 __attribute__((ext_vector_type(8)));
typedef float f32x4 __attribute__((ext_vector_type(4)));
typedef float f32x2 __attribute__((ext_vector_type(2)));
typedef float f32x16 __attribute__((ext_vector_type(16)));
typedef unsigned u32x4 __attribute__((ext_vector_type(4)));
typedef unsigned u32x2 __attribute__((ext_vector_type(2)));
typedef __bf16 bf16x2_t __attribute__((ext_vector_type(2)));
typedef int i32x4 __attribute__((ext_vector_type(4)));
typedef int i32x8 __attribute__((ext_vector_type(8)));

constexpr int BATCH = 2, SEQ = 8192, DM = 1024, T = BATCH * SEQ, DEPTH = 2;
constexpr int PIN = 2328, PINP = 2560;
constexpr int NE = 32, FF = 1024, TOPK = 4;
constexpr int NCMP = 511, NCMPP = 512;
constexpr float NORM_EPS = 1e-6f;
constexpr float W8SCALE = 64.f;
constexpr int W8_E8M0 = 0x79797979, ONE_E8M0 = 0x7f7f7f7f;
constexpr float QSCALE = 0.125f * 1.4426950408889634f;
constexpr int NWAVES = 8, NTHREADS = 512;

constexpr size_t MiB = 1u << 20;
constexpr size_t WS_CTL = 0, CTL_ZERO_BYTES = 1 * MiB;
constexpr size_t WS_WIN = 1 * MiB;
constexpr size_t WS_WOUT = 11 * MiB;
constexpr size_t WS_SGW = 15 * MiB;
constexpr size_t WS_CW1 = 15 * MiB + 512 * 1024;
constexpr size_t WS_ROPE = 17 * MiB;
constexpr size_t WS_RWP = 21 * MiB;
constexpr size_t WS_MISC = 21 * MiB + 512 * 1024;
constexpr size_t WS_W1T = 32 * MiB;
constexpr size_t WS_W2T = 288 * MiB;
constexpr size_t WS_XR = 416 * MiB;
constexpr size_t WS_H = 480 * MiB;
constexpr size_t WS_UG = 513 * MiB, WS_VG = 529 * MiB, WS_Q = 545 * MiB;
constexpr size_t WS_KC = 561 * MiB, WS_VC = 565 * MiB, WS_KS = 569 * MiB, WS_KW = 573 * MiB;
constexpr size_t WS_VST = 577 * MiB, WS_VWT = 581 * MiB;
constexpr size_t WS_GATES = 585 * MiB;
constexpr size_t WS_KCMP = 587 * MiB;
constexpr size_t WS_VCT = 587 * MiB + 512 * 1024;
constexpr size_t WS_Y = 588 * MiB;
constexpr size_t WS_TOK = 620 * MiB;
constexpr size_t WS_ASG = 622 * MiB;
constexpr size_t WS_GATE4 = 622 * MiB + 512 * 1024;
constexpr size_t WS_YPART = 912 * MiB;
constexpr size_t WS_CNTI = 623 * MiB;
constexpr size_t WS_ACT = 624 * MiB;
constexpr size_t WS_YROWS = 768 * MiB;
constexpr size_t WS_WIN8 = 962 * MiB;
constexpr size_t WS_H8 = 944 * MiB;
constexpr size_t WS_END = 968 * MiB;
constexpr int CW_BAR = 4096;
constexpr int CW_MOD = 16384;
constexpr int CW_CNT = 40960;
constexpr int CW_KMAX = 41088;
constexpr int CW_GCNT = 41216;

__device__ __forceinline__ unsigned cvtpk(float lo, float hi) { f32x2 v = {lo, hi}; bf16x2_t b = __builtin_convertvector(v, bf16x2_t); return __builtin_bit_cast(unsigned, b); }
__device__ __forceinline__ unsigned cvt4_fp8(float a, float b, float c, float d) { int w = 0; w = __builtin_amdgcn_cvt_pk_fp8_f32(a, b, w, false); w = __builtin_amdgcn_cvt_pk_fp8_f32(c, d, w, true); return (unsigned)w; }
__device__ __forceinline__ float bf2f(unsigned short b) { return __uint_as_float((unsigned)b << 16); }
__device__ __forceinline__ float bflo(unsigned w) { return __uint_as_float(w << 16); }
__device__ __forceinline__ float bfhi(unsigned w) { return __uint_as_float(w & 0xffff0000u); }
__device__ __forceinline__ float fast_exp2(float x) { return __builtin_amdgcn_exp2f(x); }
__device__ __forceinline__ float fast_rcp(float x) { return __builtin_amdgcn_rcpf(x); }
__device__ __forceinline__ float sigmoidf_(float x) { return fast_rcp(1.f + fast_exp2(-1.4426950408889634f * x)); }
__device__ __forceinline__ float gelu_tanh(float x) { const float u = 0.7978845608028654f * (x + 0.044715f * x * x * x); return x * fast_rcp(1.f + fast_exp2(-2.885390081777927f * u)); }

__device__ __forceinline__ float x16_sum(float x) { auto r = __builtin_amdgcn_permlane16_swap(__float_as_uint(x), __float_as_uint(x), false, false); return __uint_as_float(r[0]) + __uint_as_float(r[1]); }
__device__ __forceinline__ float x32_sum(float x) { auto r = __builtin_amdgcn_permlane32_swap(__float_as_uint(x), __float_as_uint(x), false, false); return __uint_as_float(r[0]) + __uint_as_float(r[1]); }
__device__ __forceinline__ float x16_max(float x) { auto r = __builtin_amdgcn_permlane16_swap(__float_as_uint(x), __float_as_uint(x), false, false); return fmaxf(__uint_as_float(r[0]), __uint_as_float(r[1])); }
__device__ __forceinline__ float x32_max(float x) { auto r = __builtin_amdgcn_permlane32_swap(__float_as_uint(x), __float_as_uint(x), false, false); return fmaxf(__uint_as_float(r[0]), __uint_as_float(r[1])); }
__device__ __forceinline__ float kg_sum(float x) { return x32_sum(x16_sum(x)); }
__device__ __forceinline__ float kg_max(float x) { return x32_max(x16_max(x)); }
__device__ __forceinline__ float quad_sum(float x) { x += __uint_as_float(__builtin_amdgcn_update_dpp(0u, __float_as_uint(x), 0xB1, 0xF, 0xF, true)); x += __uint_as_float(__builtin_amdgcn_update_dpp(0u, __float_as_uint(x), 0x4E, 0xF, 0xF, true)); return x; }
__device__ __forceinline__ float wave_sum(float v) {
    v = quad_sum(v);
    v += __uint_as_float(__builtin_amdgcn_update_dpp(0u, __float_as_uint(v), 0x141, 0xF, 0xF, true));
    v += __uint_as_float(__builtin_amdgcn_update_dpp(0u, __float_as_uint(v), 0x140, 0xF, 0xF, true));
    return x32_sum(x16_sum(v));
}
#define LDS_WAIT() asm volatile("s_waitcnt lgkmcnt(0)" ::: "memory")
#define VM_WAIT() asm volatile("s_waitcnt vmcnt(0)" ::: "memory")

__device__ __forceinline__ int kfrag_off(int key, int c8) {
    const int s = key >> 5, ko = key & 31, u = (ko >> 2) & 1, r16 = ((ko >> 3) << 2) | (ko & 3), ks = c8 >> 2, kg = c8 & 3;
    return s * 2048 + (u * 2 + ks) * 512 + (kg * 16 + r16) * 8;
}
__device__ __forceinline__ int vfrag_off(int key, int d) {
    const int s = key >> 5, ko = key & 31;
    return s * 2048 + (d >> 4) * 512 + ((ko >> 3) * 16 + (d & 15)) * 8 + (ko & 7);
}
namespace pg8 {
constexpr int BM = 256, BK = 64, HALF = 128, HTB = HALF * BK * 2, STAGE_BYTES = 8 * HTB, NXCD = 8, WGM = 4;
__host__ __device__ __forceinline__ int lds_byte(int r, int c) { const int st = (r >> 4) * 2 + (c >> 5), rr = r & 15, cc = c & 31, ob = rr * 64 + cc * 2; return st * 1024 + (ob ^ (((ob >> 9) & 1) << 5)); }
__host__ __device__ __forceinline__ void stage_rc(int b, int& R, int& C) { const int st = b / 1024, sb = b % 1024, swz = sb ^ (((sb >> 9) & 1) << 5); R = (st >> 1) * 16 + swz / 64; C = (st & 1) * 32 + (swz % 64) / 2; }
__host__ __device__ __forceinline__ int perm32(int rho) { const int n = rho >> 4, i = rho & 15; return 8 * (i >> 2) + 4 * n + (i & 3); }

struct Unit { int pm, pn, e, pnl, rloc; };

struct DenseOrder {
    int nM, nN, nwg, G, c;
    __device__ void init(int M, int N, int G_, int c_) { nM = M / BM; nN = N / BM; nwg = nM * nN; G = G_; c = c_; }
    __device__ bool next(int i, Unit& u) const {
        const long L = (long)i * G + c; if (L >= nwg) return false;
        int wgid = (int)L; { const int q = nwg / NXCD, r = nwg % NXCD, xcd = wgid % NXCD, off = wgid / NXCD; wgid = (xcd < r ? xcd * (q + 1) : r * (q + 1) + (xcd - r) * q) + off; }
        const int nig = WGM * nN, gid = wgid / nig, fm = gid * WGM, gsz = (nM - fm) < WGM ? (nM - fm) : WGM;
        u.pm = fm + ((wgid % nig) % gsz); u.pn = (wgid % nig) / gsz; u.e = 0; u.pnl = u.pn; u.rloc = 0; return true;
    }
    __device__ __forceinline__ unsigned rowoff(const Unit&, int) const { return 0u; }
};

struct MoeOrder {
    const LAS int* ust;
    const LAS int* bst;
    const LAS int* cnt;
    const int* tok;
    int NT, G, c, total, rowbytes;
    __device__ bool next(int i, Unit& u) const {
        const int L = i * G + c; if (L >= total) return false;
        int e = 0;
        for (int k = 1; k < NE; ++k) e += (L >= ust[k]) ? 1 : 0;
        e = __builtin_amdgcn_readfirstlane(e);
        const int loc = __builtin_amdgcn_readfirstlane(L - ust[e]), b0 = __builtin_amdgcn_readfirstlane(bst[e]), nb = __builtin_amdgcn_readfirstlane(bst[e + 1]) - b0;
        u.e = e; u.pnl = loc / nb; u.rloc = loc - u.pnl * nb; u.pm = b0 + u.rloc; u.pn = e * NT + u.pnl; return true;
    }
    __device__ __forceinline__ unsigned rowoff(const Unit& u, int r) const {
        const int slot = u.rloc * 256 + r; const int tk = slot < cnt[u.e] ? tok[u.e * 16384 + slot] : T;
        return (unsigned)tk * (unsigned)rowbytes;
    }
};

template <class Epi, class Sched, bool GATHER, bool ALIGN_EPI, bool FP8 = false>
__device__ __forceinline__ void gemm_phase(LAS unsigned char* lds, const bf16_t* A, const bf16_t* Bt, const int K, const Sched& S, const Epi& E) {
    int tid_ = threadIdx.x; asm volatile("" : "+v"(tid_));
    const int tid = tid_, wid = __builtin_amdgcn_readfirstlane(tid >> 6), lane = tid & 63, wr = wid >> 2, wc = wid & 3, fr = lane & 15, fq = lane >> 4;
    const int nt = K / BK;
    unsigned voffB[2];
#pragma unroll
    for (int i = 0; i < 2; ++i) { int R, C; stage_rc(tid * 16 + i * 8192, R, C); const int Rb = Epi::PERM ? ((R & ~31) + perm32(R & 31)) : R; voffB[i] = (unsigned)(Rb * K + C) * 2u; }
    const size_t kstep = (size_t)(BK * 2);
    const size_t hstep = (size_t)HALF * K * 2;
    const size_t tstep = 2 * hstep;
    const unsigned ldsw = (unsigned)wid * 1024u;
    const int aoff = lds_byte(wr * 64 + fr, fq * 8), boff = lds_byte(wc * 32 + fr, fq * 8);
#define PG8_SA(b, h) (((b) * 2 + (h)) * HTB)
#define PG8_SB(b, h) ((4 + (b) * 2 + (h)) * HTB)
#define PG8_STAGE(bufoff, gbase, v0, v1) do { \
        __builtin_amdgcn_global_load_lds((const unsigned*)((const char*)(gbase) + (v0)), (LAS unsigned*)(lds + (bufoff) + ldsw), 16, 0, 0); \
        __builtin_amdgcn_global_load_lds((const unsigned*)((const char*)(gbase) + (v1)), (LAS unsigned*)(lds + (bufoff) + ldsw + 8192), 16, 0, 0); } while (0)
#define PG8_STAGEB(bufoff, gbase) PG8_STAGE(bufoff, gbase, voffB[0], voffB[1])
#define PG8_CAT8(x0, x1) __builtin_shufflevector(x0, x1, 0, 1, 2, 3, 4, 5, 6, 7)
#define PG8_RD4(off) (*(const LAS i32x4*)(lds + (off)))
#define PG8_LDA(dst, b, h) do { if constexpr (FP8) { _Pragma("unroll") for (int m = 0; m < 4; ++m) dst##8[m] = PG8_CAT8(PG8_RD4(PG8_SA(b, h) + aoff + m * 2048), PG8_RD4(PG8_SA(b, h) + aoff + m * 2048 + 1024)); } \
        else { _Pragma("unroll") for (int m = 0; m < 4; ++m) _Pragma("unroll") for (int k = 0; k < 2; ++k) dst[m][k] = *(const LAS bf16x8*)(lds + PG8_SA(b, h) + aoff + m * 2048 + k * 1024); } } while (0)
#define PG8_LDB(dst, b, h) do { if constexpr (FP8) { _Pragma("unroll") for (int n = 0; n < 2; ++n) dst##8[n] = PG8_CAT8(PG8_RD4(PG8_SB(b, h) + boff + n * 2048), PG8_RD4(PG8_SB(b, h) + boff + n * 2048 + 1024)); } \
        else { _Pragma("unroll") for (int n = 0; n < 2; ++n) _Pragma("unroll") for (int k = 0; k < 2; ++k) dst[n][k] = *(const LAS bf16x8*)(lds + PG8_SB(b, h) + boff + n * 2048 + k * 1024); } } while (0)
#define PG8_MMA(ai, bj, At, Bt_) do { __builtin_amdgcn_s_setprio(1); _Pragma("unroll") for (int m = 0; m < 4; ++m) _Pragma("unroll") for (int n = 0; n < 2; ++n) { \
        if constexpr (FP8) { asm volatile("v_mfma_scale_f32_16x16x128_f8f6f4 %0, %1, %2, %0, %3, %4 op_sel_hi:[0,0,0]" : "+v"(acc[ai][bj][m][n]) : "v"(Bt_##8[n]), "v"(At##8[m]), "v"(sc_w), "v"(sc_x)); } \
        else { _Pragma("unroll") for (int k = 0; k < 2; ++k) acc[ai][bj][m][n] = __builtin_amdgcn_mfma_f32_16x16x32_bf16(Bt_[n][k], At[m][k], acc[ai][bj][m][n], 0, 0, 0); } } \
        __builtin_amdgcn_s_setprio(0); } while (0)
#define PG8_WAIT_V(n) asm volatile("s_waitcnt vmcnt(" #n ")" ::: "memory")
#define PG8_WAIT_L(n) asm volatile("s_waitcnt lgkmcnt(" #n ")" ::: "memory")
#define PG8_BAR __builtin_amdgcn_s_barrier()
#define PG8_SCHED __builtin_amdgcn_sched_barrier(0)
#define PG8_SETV(v, u) do { int t2_ = tid; asm volatile("" : "+v"(t2_)); _Pragma("unroll") for (int i_ = 0; i_ < 2; ++i_) { int R_, C_; stage_rc(t2_ * 16 + i_ * 8192, R_, C_); _Pragma("unroll") for (int h_ = 0; h_ < 2; ++h_) \
        v[h_][i_] = GATHER ? (S.rowoff(u, R_ + HALF * h_) + (unsigned)C_ * 2u) : (unsigned)((R_ + HALF * h_) * K + C_) * 2u; } } while (0)
    Unit cur, nxt; int ui = 0;
    if (!S.next(0, cur)) return;
    unsigned vc[2][2], vn[2][2];
    PG8_SETV(vc, cur);
    f32x4 acc[2][2][4][2];
#pragma unroll
    for (int a = 0; a < 2; ++a)
#pragma unroll
        for (int b = 0; b < 2; ++b)
#pragma unroll
            for (int m = 0; m < 4; ++m)
#pragma unroll
                for (int n = 0; n < 2; ++n) acc[a][b][m][n] = (f32x4){0.f, 0.f, 0.f, 0.f};
    bf16x8 At[4][2], B0[2][2], B1[2][2]; i32x8 At8[4], B08[2], B18[2];
    int sc_w = W8_E8M0, sc_x = ONE_E8M0; asm volatile("" : "+v"(sc_w), "+v"(sc_x));
    const char* cA = GATHER ? (const char*)A : (const char*)A + (size_t)cur.pm * tstep;
    const char* cB = (const char*)Bt + (size_t)cur.pn * tstep;
    PG8_STAGEB(PG8_SB(0, 0), cB); PG8_STAGEB(PG8_SB(0, 1), cB + hstep); PG8_STAGE(PG8_SA(0, 0), cA, vc[0][0], vc[0][1]); PG8_STAGE(PG8_SA(0, 1), cA, vc[1][0], vc[1][1]);
    if (wr == 1) PG8_BAR;
    PG8_WAIT_V(2); PG8_BAR;
    PG8_STAGEB(PG8_SB(1, 0), cB + kstep); PG8_STAGE(PG8_SA(1, 0), cA + kstep, vc[0][0], vc[0][1]); PG8_STAGEB(PG8_SB(1, 1), cB + hstep + kstep);
    PG8_WAIT_V(6); PG8_BAR;
    for (;;) {
        const bool has_next = S.next(ui + 1, nxt);
        const char* nA = GATHER ? (const char*)A : (has_next ? (const char*)A + (size_t)nxt.pm * tstep : cA);
        const char* nB = has_next ? (const char*)Bt + (size_t)nxt.pn * tstep : cB;
        if constexpr (GATHER) { if (has_next) { PG8_SETV(vn, nxt); } else {
#pragma unroll
            for (int h_ = 0; h_ < 2; ++h_)
#pragma unroll
                for (int i_ = 0; i_ < 2; ++i_) vn[h_][i_] = vc[h_][i_]; } }
#pragma nounroll
        for (int t = 0; t < nt; t += 2) {
            const bool last = (t == nt - 2);
            const char* a1 = cA + (size_t)(t + 1) * kstep;
            const char* a2 = last ? nA : cA + (size_t)(t + 2) * kstep; const char* b2 = last ? nB : cB + (size_t)(t + 2) * kstep;
            const char* a3 = a2 + kstep; const char* b3 = b2 + kstep;
            const unsigned w00 = (GATHER && last) ? vn[0][0] : vc[0][0], w01 = (GATHER && last) ? vn[0][1] : vc[0][1], w10 = (GATHER && last) ? vn[1][0] : vc[1][0], w11 = (GATHER && last) ? vn[1][1] : vc[1][1];
            PG8_LDB(B0, 0, 0); PG8_LDB(B1, 0, 1); PG8_SCHED; PG8_LDA(At, 0, 0); PG8_STAGE(PG8_SA(1, 1), a1, vc[1][0], vc[1][1]);
            PG8_WAIT_V(8); PG8_WAIT_L(0); PG8_BAR; PG8_MMA(0, 0, At, B0); PG8_MMA(0, 1, At, B1); PG8_BAR; PG8_SCHED;
            PG8_LDA(At, 0, 1); PG8_STAGEB(PG8_SB(0, 0), b2); PG8_STAGEB(PG8_SB(0, 1), b2 + hstep); PG8_STAGE(PG8_SA(0, 0), a2, w00, w01);
            PG8_WAIT_V(8); PG8_WAIT_L(0); PG8_BAR; PG8_MMA(1, 0, At, B0); PG8_MMA(1, 1, At, B1); PG8_BAR; PG8_SCHED;
            PG8_LDB(B0, 1, 0); PG8_LDB(B1, 1, 1); PG8_SCHED; PG8_LDA(At, 1, 0); PG8_STAGE(PG8_SA(0, 1), a2, w10, w11);
            PG8_WAIT_V(8); PG8_WAIT_L(0); PG8_BAR; PG8_MMA(0, 0, At, B0); PG8_MMA(0, 1, At, B1); PG8_BAR; PG8_SCHED;
            PG8_LDA(At, 1, 1); PG8_STAGEB(PG8_SB(1, 0), b3); PG8_STAGEB(PG8_SB(1, 1), b3 + hstep); PG8_STAGE(PG8_SA(1, 0), a3, w00, w01);
            PG8_WAIT_V(8); PG8_WAIT_L(0); PG8_BAR; PG8_MMA(1, 0, At, B0); PG8_MMA(1, 1, At, B1); PG8_BAR; PG8_SCHED;
        }
        if constexpr (FP8) { asm volatile("s_nop 15\n\ts_nop 15" ::: "memory"); }
        if constexpr (ALIGN_EPI) { if (wr == 0) PG8_BAR; }
        E(acc, cur, wr, wc, fr, fq);
        if (!has_next) break;
#pragma unroll
        for (int a = 0; a < 2; ++a)
#pragma unroll
            for (int b = 0; b < 2; ++b)
#pragma unroll
                for (int m = 0; m < 4; ++m)
#pragma unroll
                    for (int n = 0; n < 2; ++n) acc[a][b][m][n] = (f32x4){0.f, 0.f, 0.f, 0.f};
        cur = nxt; cA = nA; cB = nB; ++ui;
        if constexpr (GATHER) {
#pragma unroll
        for (int h_ = 0; h_ < 2; ++h_)
#pragma unroll
            for (int i_ = 0; i_ < 2; ++i_) vc[h_][i_] = vn[h_][i_]; }
        if constexpr (ALIGN_EPI) { if (wr == 1) PG8_BAR; }
    }
    PG8_WAIT_V(0);
    if constexpr (!ALIGN_EPI) { if (wr == 0) PG8_BAR; }
    PG8_BAR;
#undef PG8_SA
#undef PG8_SB
#undef PG8_STAGE
#undef PG8_STAGEB
#undef PG8_LDA
#undef PG8_LDB
#undef PG8_MMA
#undef PG8_CAT8
#undef PG8_RD4
#undef PG8_WAIT_V
#undef PG8_WAIT_L
#undef PG8_BAR
#undef PG8_SCHED
#undef PG8_SETV
}
}

#define XB_TMO      128
#define XB_XCNT(j)  (256  + 64 * (j))
#define XB_XSUB(j)  (1280 + 64 * (j))
#define XB_XGEN(j)  (2304 + 64 * (j))
#define XB_TOP      3328
#define XB_TOPGEN   3392
#define XCD_BAR_WORDS 3456
#define XB_SPIN_CAP (1u << 22)
__device__ __forceinline__ unsigned xb_ld(unsigned* p)              { return __hip_atomic_load(p, __ATOMIC_RELAXED, __HIP_MEMORY_SCOPE_AGENT); }
__device__ __forceinline__ unsigned xb_add(unsigned* p, unsigned v) { return __hip_atomic_fetch_add(p, v, __ATOMIC_RELAXED, __HIP_MEMORY_SCOPE_AGENT); }
__device__ __forceinline__ unsigned xb_xcc_id() { return (unsigned)__builtin_amdgcn_s_getreg((3 << 11) | 20) & 0xFu; }
#define XB_SPIN(cond, bar) do { unsigned _sp = 0; while (cond) { __builtin_amdgcn_s_sleep(1); \
    if ((++_sp & 255u) == 0u) { if (xb_ld(&(bar)[XB_TMO])) break; if (_sp > XB_SPIN_CAP) { atomicAdd(&(bar)[XB_TMO], 1u); break; } } } } while (0)
struct XcdBarrier { unsigned* bar; unsigned x; volatile LAS unsigned* st; };
__device__ __forceinline__ XcdBarrier xcd_barrier_post(unsigned* bar, volatile LAS unsigned* st) {
    XcdBarrier b; b.bar = bar; b.x = xb_xcc_id(); b.st = st;
    if (threadIdx.x == 0) (void)xb_add(&bar[XB_XCNT(b.x)], 1u);
    return b;
}
__device__ __forceinline__ void xcd_barrier_complete(unsigned* bar, unsigned x, unsigned& nloc, unsigned& nx) {
    const unsigned G = gridDim.x * gridDim.y * gridDim.z;
    unsigned sum, cnt, mine, sp = 0u;
    for (;;) {
        sum = 0u; cnt = 0u; mine = 0u;
#pragma unroll
        for (unsigned j = 0; j < 16; ++j) { const unsigned c = xb_ld(&bar[XB_XCNT(j)]); sum += c; cnt += (c > 0u) ? 1u : 0u; mine = (j == x) ? c : mine; }
        if (sum == G) break;
        __builtin_amdgcn_s_sleep(1);
        if ((++sp & 255u) == 0u) { if (xb_ld(&bar[XB_TMO])) break; if (sp > XB_SPIN_CAP) { atomicAdd(&bar[XB_TMO], 1u); break; } }
    }
    nloc = mine > 0u ? mine : 1u; nx = cnt > 0u ? cnt : 1u;
}
__device__ __forceinline__ void xcd_barrier(const XcdBarrier& b) {
    asm volatile("s_waitcnt vmcnt(0)" ::: "memory");
    __syncthreads();
    if (threadIdx.x == 0) {
        unsigned* bar = b.bar;
        __builtin_amdgcn_s_waitcnt(0);
        unsigned nloc = b.st[0], nx = b.st[1];
        if (nloc == 0u) { xcd_barrier_complete(bar, b.x, nloc, nx); b.st[0] = nloc; b.st[1] = nx; }
        const unsigned old = xb_add(&bar[XB_XSUB(b.x)], 1u);
        const unsigned gen = old / nloc;
        if (old + 1u == (gen + 1u) * nloc) {
            __builtin_amdgcn_fence(__ATOMIC_RELEASE, "agent");
            asm volatile("s_waitcnt vmcnt(0)" ::: "memory");
            const unsigned og = xb_add(&bar[XB_TOP], 1u);
            const unsigned tg = og / nx;
            if (og + 1u == (tg + 1u) * nx) xb_add(&bar[XB_TOPGEN], 1u);
            else XB_SPIN(xb_ld(&bar[XB_TOPGEN]) == tg, bar);
            __builtin_amdgcn_fence(__ATOMIC_ACQUIRE, "agent");
            xb_add(&bar[XB_XGEN(b.x)], 1u);
            asm volatile("s_waitcnt vmcnt(0)" ::: "memory");
        } else {
            XB_SPIN(xb_ld(&bar[XB_XGEN(b.x)]) == gen, bar);
            __builtin_amdgcn_fence(__ATOMIC_ACQUIRE, "agent");
            asm volatile("s_waitcnt vmcnt(0)" ::: "memory");
        }
    }
    __syncthreads();
}

struct Args { const void* in[26]; float* out; unsigned char* ws; int ph_lo, ph_hi, li, pad; };
enum { I_X = 0, I_C, I_POS, I_ADAW, I_ADAB, I_N1G, I_N2G, I_WIN, I_WOUT, I_SGLNG, I_SGLNB, I_SGW, I_SGB, I_PEK, I_PEV, I_CW1K, I_CW2K, I_CW1V, I_CW2V, I_RW, I_RB, I_EW1, I_EB1, I_EW2, I_EB2, I_FING };

#define GAS1 __attribute__((address_space(1)))
#define INP(A_, T_, i_) ({ int ix_ = (i_); asm volatile("" : "+s"(ix_)); (const T_*)(const GAS1 T_*)(A_).in[ix_]; })
struct Frame {
    LAS unsigned char* lds;
    unsigned* ctl;
    unsigned char* ws;
    int tid, lane, wave, vcu, G;
};
#define WSP(type, off) ((type*)(F.ws + (off)))
#define MODP(l, b, part) ((const float*)(F.ctl + CW_MOD) + ((size_t)((l) * 2 + (b)) * 6 + (part)) * 1024)

constexpr int RING_BYTES = 131072;
constexpr int ATT_LDS_BYTES = 147456;
constexpr int LDSCTL_OFF = ATT_LDS_BYTES;
constexpr int MISC_OFF = LDSCTL_OFF + 320;
constexpr int MOE_OFF = MISC_OFF + 128;
constexpr int LDS_BYTES = 163840;

struct EpiProj {
    static constexpr bool PERM = true;
    bf16_t *UG, *VG, *Q, *KC, *VC, *KS, *KW, *VST, *VWT; float* GATES; const float* ROPE; unsigned* kmax; int pn_off;
    __device__ __forceinline__ void operator()(const f32x4 (&acc)[2][2][4][2], const pg8::Unit& u, int wr_, int wc_, int fr_, int fq_) const {
        int t_ = threadIdx.x; asm volatile("" : "+v"(t_)); const int wid_ = __builtin_amdgcn_readfirstlane(t_ >> 6); const int wr = wid_ >> 2, wc = wid_ & 3, fr = t_ & 15, fq = (t_ & 63) >> 4; (void)wr_; (void)wc_; (void)fr_; (void)fq_;
        const int pn = u.pn + pn_off; const int row0 = u.pm * 256 + wr * 64 + fr; const int b = u.pm >> 5;
        if (pn < 4 || pn == 6) {
#pragma unroll
            for (int ai = 0; ai < 2; ++ai)
#pragma unroll
                for (int m = 0; m < 4; ++m) { const size_t r = (size_t)(row0 + ai * 128 + m * 16);
#pragma unroll
                    for (int bj = 0; bj < 2; ++bj) { f32x4 v0 = acc[ai][bj][m][0], v1 = acc[ai][bj][m][1];
                        if (pn < 4) {
#pragma unroll
                            for (int i = 0; i < 4; ++i) { v0[i] = gelu_tanh(v0[i]); v1[i] = gelu_tanh(v1[i]); } }
                        u32x4 w; w.x = cvtpk(v0[0], v0[1]); w.y = cvtpk(v0[2], v0[3]); w.z = cvtpk(v1[0], v1[1]); w.w = cvtpk(v1[2], v1[3]);
                        bf16_t* dst;
                        if (pn < 2) dst = UG + r * 512 + pn * 256 + bj * 128 + wc * 32 + fq * 8;
                        else if (pn < 4) dst = VG + r * 512 + (pn - 2) * 256 + bj * 128 + wc * 32 + fq * 8;
                        else dst = (bj ? VC : KC) + r * 128 + wc * 32 + fq * 8;
                        *(u32x4*)dst = w; } }
        } else if (pn == 4 || pn == 5 || pn == 7) {
            const float sc = (pn == 7) ? 1.f : QSCALE; float nmax = 0.f;
#pragma unroll
            for (int ai = 0; ai < 2; ++ai)
#pragma unroll
                for (int m = 0; m < 4; ++m) { const size_t r = (size_t)(row0 + ai * 128 + m * 16);
                    const f32x4* cs = (const f32x4*)(ROPE + (r * 32 + fq * 8) * 2);
                    float o1[8], o2[8], nsq = 0.f;
#pragma unroll
                    for (int n = 0; n < 2; ++n) { const f32x4 c0 = cs[2 * n], c1 = cs[2 * n + 1]; const f32x4 x1 = acc[ai][0][m][n], x2 = acc[ai][1][m][n];
                        const float cc[4] = {c0[0], c0[2], c1[0], c1[2]}, ss[4] = {c0[1], c0[3], c1[1], c1[3]};
#pragma unroll
                        for (int i = 0; i < 4; ++i) { o1[4 * n + i] = (x1[i] * cc[i] - x2[i] * ss[i]) * sc; o2[4 * n + i] = (x2[i] * cc[i] + x1[i] * ss[i]) * sc; nsq += x1[i] * x1[i] + x2[i] * x2[i]; } }
                    u32x4 w1, w2; w1.x = cvtpk(o1[0], o1[1]); w1.y = cvtpk(o1[2], o1[3]); w1.z = cvtpk(o1[4], o1[5]); w1.w = cvtpk(o1[6], o1[7]);
                    w2.x = cvtpk(o2[0], o2[1]); w2.y = cvtpk(o2[2], o2[3]); w2.z = cvtpk(o2[4], o2[5]); w2.w = cvtpk(o2[6], o2[7]);
                    if (pn != 7) { bf16_t* dst = Q + r * 512 + (4 * (pn - 4) + wc) * 64 + fq * 8; *(u32x4*)dst = w1; *(u32x4*)(dst + 32) = w2; }
                    else { bf16_t* img = ((wc < 2) ? KS : KW) + (size_t)(b * 2 + (wc & 1)) * SEQ * 64; const int t = (int)r & (SEQ - 1);
                        *(u32x4*)(img + kfrag_off(t, fq)) = w1; *(u32x4*)(img + kfrag_off(t, 4 + fq)) = w2; }
                    nsq = kg_sum(nsq); nmax = fmaxf(nmax, nsq); asm volatile("" ::: "memory"); }
            if (pn == 7) {
#pragma unroll
                for (int o = 1; o < 16; o <<= 1) nmax = fmaxf(nmax, __shfl_xor(nmax, o));
                if ((threadIdx.x & 63) == 0) atomicMax(kmax + ((wc < 2) ? 0 : 8) + b * 2 + (wc & 1), __float_as_uint(nmax * 1.02f));
            }
        } else if (pn == 8) {
            const int g = wc >> 1; float vmx = 0.f;
#pragma unroll
            for (int ai = 0; ai < 2; ++ai)
#pragma unroll
                for (int m = 0; m < 4; ++m) { const int r = row0 + ai * 128 + m * 16; const int s = r & (SEQ - 1);
#pragma unroll
                    for (int bj = 0; bj < 2; ++bj) { bf16_t* img = (bj ? VWT : VST) + (size_t)(b * 2 + g) * SEQ * 64;
#pragma unroll
                        for (int n = 0; n < 2; ++n)
#pragma unroll
                            for (int i = 0; i < 4; ++i) { img[vfrag_off(s, (wc & 1) * 32 + fq * 8 + n * 4 + i)] = (bf16_t)(cvtpk(acc[ai][bj][m][n][i], 0.f) & 0xffffu); if (bj == 0) vmx = fmaxf(vmx, fabsf(acc[ai][0][m][n][i])); } } }
#pragma unroll
            for (int o = 1; o < 64; o <<= 1) vmx = fmaxf(vmx, __shfl_xor(vmx, o));
            if ((threadIdx.x & 63) == 0) atomicMax(kmax + 4 + b * 2 + g, __float_as_uint(vmx * 1.01f));
        } else {
            if (wc == 0 && fq < 3) {
#pragma unroll
                for (int ai = 0; ai < 2; ++ai)
#pragma unroll
                    for (int m = 0; m < 4; ++m) { const size_t r = (size_t)(row0 + ai * 128 + m * 16);
#pragma unroll
                        for (int n = 0; n < 2; ++n) { f32x4 v = acc[ai][0][m][n];
#pragma unroll
                            for (int i = 0; i < 4; ++i) v[i] = sigmoidf_(v[i]);
                            *(f32x4*)(GATES + r * 24 + fq * 8 + n * 4) = v; } }
            }
        }
    }
};
struct EpiOut {
    static constexpr bool PERM = false;
    const float* xin; float* xout; const float* g1;
    __device__ __forceinline__ void operator()(const f32x4 (&acc)[2][2][4][2], const pg8::Unit& u, int wr_, int wc_, int fr_, int fq_) const {
        int t_ = threadIdx.x; asm volatile("" : "+v"(t_)); const int wid_ = __builtin_amdgcn_readfirstlane(t_ >> 6); const int wr = wid_ >> 2, wc = wid_ & 3, fr = t_ & 15, fq = (t_ & 63) >> 4; (void)wr_; (void)wc_; (void)fr_; (void)fq_;
        const int row0 = u.pm * 256 + wr * 64 + fr; const int b = u.pm >> 5; const int col0 = u.pn * 256 + wc * 32 + fq * 4;
        const float* gb = g1 + (size_t)b * 6144 + 2048;
        f32x4 gv[2][2];
#pragma unroll
        for (int bj = 0; bj < 2; ++bj)
#pragma unroll
            for (int n = 0; n < 2; ++n) gv[bj][n] = *(const f32x4*)(gb + col0 + bj * 128 + n * 16);
#pragma unroll
        for (int ai = 0; ai < 2; ++ai)
#pragma unroll
            for (int m = 0; m < 4; ++m) { const size_t off = (size_t)(row0 + ai * 128 + m * 16) * DM + col0;
#pragma unroll
                for (int bj = 0; bj < 2; ++bj)
#pragma unroll
                    for (int n = 0; n < 2; ++n) { const f32x4 xi = *(const f32x4*)(xin + off + bj * 128 + n * 16); *(f32x4*)(xout + off + bj * 128 + n * 16) = xi + gv[bj][n] * acc[ai][bj][m][n]; } }
    }
};
struct EpiSwiglu {
    static constexpr bool PERM = true;
    unsigned char* ACT; const float* b1;
    __device__ __forceinline__ void operator()(const f32x4 (&acc)[2][2][4][2], const pg8::Unit& u, int wr_, int wc_, int fr_, int fq_) const {
        int t_ = threadIdx.x; asm volatile("" : "+v"(t_)); const int wid_ = __builtin_amdgcn_readfirstlane(t_ >> 6); const int wr = wid_ >> 2, wc = wid_ & 3, fr = t_ & 15, fq = (t_ & 63) >> 4; (void)wr_; (void)wc_; (void)fr_; (void)fq_;
        const int row0 = u.pm * 256 + wr * 64 + fr; const int j0 = u.pnl * 128 + wc * 32 + fq * 8;
        const float* bb = b1 + (size_t)u.e * 2048 + j0;
        f32x4 bg[2], bl[2];
#pragma unroll
        for (int n = 0; n < 2; ++n) { bg[n] = *(const f32x4*)(bb + n * 4); bl[n] = *(const f32x4*)(bb + 1024 + n * 4); }
#pragma unroll
        for (int ai = 0; ai < 2; ++ai)
#pragma unroll
            for (int m = 0; m < 4; ++m) { float o[8];
#pragma unroll
                for (int n = 0; n < 2; ++n) { const f32x4 gl = acc[ai][0][m][n] + bg[n], ln = acc[ai][1][m][n] + bl[n];
#pragma unroll
                    for (int i = 0; i < 4; ++i) { const float gg = fminf(gl[i], 7.f), ll = fminf(fmaxf(ln[i], -7.f), 7.f); o[n * 4 + i] = gg * sigmoidf_(1.702f * gg) * (ll + 1.f); } }
                u32x2 w; w.x = cvt4_fp8(o[0], o[1], o[2], o[3]); w.y = cvt4_fp8(o[4], o[5], o[6], o[7]);
                *(u32x2*)(ACT + (size_t)(row0 + ai * 128 + m * 16) * FF + j0) = w; }
    }
};
struct EpiDown {
    static constexpr bool PERM = true;
    unsigned char* YR; const float* b2;
    __device__ __forceinline__ void operator()(const f32x4 (&acc)[2][2][4][2], const pg8::Unit& u, int wr_, int wc_, int fr_, int fq_) const {
        int t_ = threadIdx.x; asm volatile("" : "+v"(t_)); const int wid_ = __builtin_amdgcn_readfirstlane(t_ >> 6); const int wr = wid_ >> 2, wc = wid_ & 3, fr = t_ & 15, fq = (t_ & 63) >> 4; (void)wr_; (void)wc_; (void)fr_; (void)fq_;
        const int row0 = u.pm * 256 + wr * 64 + fr; const int c0 = u.pnl * 256 + wc * 32 + fq * 8;
        const float* bb = b2 + (size_t)u.e * 1024 + c0;
        f32x4 bv[2][2];
#pragma unroll
        for (int bj = 0; bj < 2; ++bj)
#pragma unroll
            for (int n = 0; n < 2; ++n) bv[bj][n] = *(const f32x4*)(bb + bj * 128 + n * 4);
#pragma unroll
        for (int ai = 0; ai < 2; ++ai)
#pragma unroll
            for (int m = 0; m < 4; ++m)
#pragma unroll
                for (int bj = 0; bj < 2; ++bj) { const f32x4 v0 = acc[ai][bj][m][0] + bv[bj][0], v1 = acc[ai][bj][m][1] + bv[bj][1];
                    u32x2 w; w.x = cvt4_fp8(v0[0], v0[1], v0[2], v0[3]); w.y = cvt4_fp8(v1[0], v1[1], v1[2], v1[3]);
                    *(u32x2*)(YR + (size_t)(row0 + ai * 128 + m * 16) * DM + c0 + bj * 128) = w; }
    }
};

__device__ __forceinline__ void tr_item(const float* W, int ldn, int k0, int c0, int nvalid, bf16_t* WT, int K, int drow0, LAS float* scr, int lane) {
    const int nn = lane & 31;
#pragma unroll 8
    for (int i = 0; i < 32; ++i) { const int kk = 2 * i + (lane >> 5); scr[kk * 33 + nn] = (nn < nvalid) ? W[(size_t)(k0 + kk) * ldn + c0 + nn] : 0.f; }
    LDS_WAIT(); asm volatile("" ::: "memory");
    const int c = lane & 7;
#pragma unroll
    for (int j = 0; j < 4; ++j) { const int n = (lane >> 3) + 8 * j; const LAS float* s = scr + (8 * c) * 33 + n;
        u32x4 o; o.x = cvtpk(s[0 * 33], s[1 * 33]); o.y = cvtpk(s[2 * 33], s[3 * 33]); o.z = cvtpk(s[4 * 33], s[5 * 33]); o.w = cvtpk(s[6 * 33], s[7 * 33]);
        *(u32x4*)(WT + (size_t)(drow0 + n) * K + k0 + 8 * c) = o; }
    LDS_WAIT(); asm volatile("" ::: "memory");
}
template <bool NTS> __device__ __forceinline__ void tr_item8(const float* W, int ldn, int k0, int c0, unsigned char* W8, int K, int drow0, LAS float* scr, int lane, int nvalid = 32) {
    const int nn = lane & 31;
#pragma unroll 8
    for (int i = 0; i < 32; ++i) { const int kk = 2 * i + (lane >> 5); scr[kk * 33 + nn] = (nn < nvalid) ? __builtin_nontemporal_load(W + (size_t)(k0 + kk) * ldn + c0 + nn) * W8SCALE : 0.f; }
    LDS_WAIT(); asm volatile("" ::: "memory");
    const int c = lane & 3;
#pragma unroll
    for (int j = 0; j < 2; ++j) { const int n = (lane >> 2) + 16 * j; const LAS float* s = scr + (16 * c) * 33 + n;
        u32x4 o; o.x = cvt4_fp8(s[0 * 33], s[1 * 33], s[2 * 33], s[3 * 33]); o.y = cvt4_fp8(s[4 * 33], s[5 * 33], s[6 * 33], s[7 * 33]);
        o.z = cvt4_fp8(s[8 * 33], s[9 * 33], s[10 * 33], s[11 * 33]); o.w = cvt4_fp8(s[12 * 33], s[13 * 33], s[14 * 33], s[15 * 33]);
        if (NTS) __builtin_nontemporal_store(o, (u32x4*)(W8 + (size_t)(drow0 + n) * K + k0 + 16 * c)); else *(u32x4*)(W8 + (size_t)(drow0 + n) * K + k0 + 16 * c) = o; }
    LDS_WAIT(); asm volatile("" ::: "memory");
}
__device__ __forceinline__ void win_src(int p, int& c0, int& nvalid) {
    const int pn = p >> 8; nvalid = 32;
    if (pn < 4 || pn == 6) { c0 = p; }
    else if (pn == 4 || pn == 5) { const int pp = p - 1024 - 256 * (pn - 4), bj = pp >> 7, j = pp & 127; c0 = 1024 + (4 * (pn - 4) + (j >> 5)) * 64 + bj * 32; }
    else if (pn == 7) { const int pp = p - 1792, bj = pp >> 7, j = pp & 127, which = j >> 6, g = (j >> 5) & 1; c0 = (which ? 2048 : 1792) + g * 64 + bj * 32; }
    else if (pn == 8) { const int pp = p - 2048, bj = pp >> 7, j = pp & 127; c0 = (bj ? 2176 : 1920) + j; }
    else { const int pp = p - 2304; c0 = 2304 + pp; nvalid = 24 - pp; nvalid = nvalid < 0 ? 0 : (nvalid > 32 ? 32 : nvalid); if (nvalid == 0) c0 = 0; }
}
__device__ __forceinline__ void phase_prologue(Frame& F, const Args& a) {
    LAS float* scr = (LAS float*)(F.lds + F.wave * 8704);
    const int gw = F.vcu * NWAVES + F.wave, NGW = F.G * NWAVES; const int lane = F.lane;
    {
        const float* c = INP(a, float, I_C); const float* adaw = INP(a, float, I_ADAW); const float* adab = INP(a, float, I_ADAB);
        float* mod = (float*)(F.ctl + CW_MOD);
        LAS float* red = (LAS float*)(F.lds + 8 * 8704);
        for (int it = F.vcu; it < 2 * 24; it += F.G) {
            const int l = it / 24, nb = it % 24;
            const float* wp = adaw + ((size_t)l * 1024 + F.wave * 128) * 6144 + nb * 256 + lane * 4;
            f32x4 a0 = {0.f, 0.f, 0.f, 0.f}, a1 = a0;
#pragma unroll 4
            for (int k = 0; k < 128; ++k) { const f32x4 w = __builtin_nontemporal_load((const f32x4*)(wp + (size_t)k * 6144));
                const float c0 = c[F.wave * 128 + k], c1 = c[1024 + F.wave * 128 + k]; const float s0 = c0 * sigmoidf_(c0), s1 = c1 * sigmoidf_(c1);
                a0 += w * s0; a1 += w * s1; }
            *(LAS f32x4*)(red + (F.wave * 2 + 0) * 256 + lane * 4) = a0; *(LAS f32x4*)(red + (F.wave * 2 + 1) * 256 + lane * 4) = a1;
            __syncthreads();
            { const int b = F.tid >> 8, col = F.tid & 255; float sum = adab[(size_t)l * 6144 + nb * 256 + col];
#pragma unroll
              for (int ww = 0; ww < 8; ++ww) sum += red[(ww * 2 + b) * 256 + col];
              mod[((size_t)l * 2 + b) * 6144 + nb * 256 + col] = sum; }
            __syncthreads();
        }
    }
    {
        const float* win = INP(a, float, I_WIN);
        unsigned char* Win8 = WSP(unsigned char, WS_WIN8);
        for (int it = gw; it < 2 * 16 * 80; it += NGW) { const int l = it / 1280, kb = (it % 1280) / 80, nb = it % 80; int c0, nv; win_src(nb * 32, c0, nv);
            tr_item8<false>(win + (size_t)l * 1024 * PIN, PIN, kb * 64, c0, Win8 + (size_t)l * 2560 * 1024, 1024, nb * 32, scr, lane, nv); }
        const float* wout = INP(a, float, I_WOUT); bf16_t* WoutT = WSP(bf16_t, WS_WOUT);
        for (int it = gw; it < 2 * 16 * 32; it += NGW) { const int l = it / 512, kb = (it % 512) / 32, nb = it % 32;
            tr_item(wout + (size_t)l * 1024 * 1024, 1024, kb * 64, nb * 32, 32, WoutT + (size_t)l * 1024 * 1024, 1024, nb * 32, scr, lane); }
        bf16_t* CW1 = WSP(bf16_t, WS_CW1);
        for (int it = gw; it < 2 * 2 * 32 * 2; it += NGW) { const int l = it / 128, which = (it / 64) & 1, kb = (it % 64) / 2, nb = it & 1;
            const float* src = INP(a, float, which ? I_CW1V : I_CW1K) + (size_t)l * 2048 * 64;
            tr_item(src, 64, kb * 64, nb * 32, 32, CW1 + (size_t)(l * 2 + which) * 64 * 2048, 2048, nb * 32, scr, lane); }
        const float* ew1 = INP(a, float, I_EW1); unsigned char* W1T = WSP(unsigned char, WS_W1T);
        for (int it = gw; it < 2 * 32 * 16 * 64; it += NGW) { const int le = it >> 10, kb = (it >> 6) & 15, nb = it & 63; const int p = nb * 32, tile = p >> 8, bj = (p >> 7) & 1, j = p & 127;
            if (le < 32) tr_item8<false>(ew1 + (size_t)le * 1024 * 2048, 2048, kb * 64, bj * 1024 + tile * 128 + j, W1T + (size_t)le * 2048 * 1024, 1024, p, scr, lane);
            else tr_item8<true>(ew1 + (size_t)le * 1024 * 2048, 2048, kb * 64, bj * 1024 + tile * 128 + j, W1T + (size_t)le * 2048 * 1024, 1024, p, scr, lane); }
        const float* ew2 = INP(a, float, I_EW2); unsigned char* W2T = WSP(unsigned char, WS_W2T);
        for (int it = gw; it < 2 * 32 * 16 * 32; it += NGW) { const int le = it >> 9, kb = (it >> 5) & 15, nb = it & 31;
            if (le < 32) tr_item8<false>(ew2 + (size_t)le * 1024 * 1024, 1024, kb * 64, nb * 32, W2T + (size_t)le * 1024 * 1024, 1024, nb * 32, scr, lane);
            else tr_item8<true>(ew2 + (size_t)le * 1024 * 1024, 1024, kb * 64, nb * 32, W2T + (size_t)le * 1024 * 1024, 1024, nb * 32, scr, lane); }
    }
    {
        const int gt = (F.vcu * NWAVES + F.wave) * 64 + lane, NGT = NGW * 64;
        const float* sgw = INP(a, float, I_SGW); bf16_t* SGW = WSP(bf16_t, WS_SGW);
        for (int i = gt; i < 2 * 8 * 128 * 128; i += NGT) { const int s = i & 127, t = (i >> 7) & 127; SGW[i] = (bf16_t)(cvtpk(s <= t ? sgw[i] : 0.f, 0.f) & 0xffffu); }
        const int* pos = INP(a, int, I_POS); float* rope = WSP(float, WS_ROPE);
        for (int i = gt; i < T * 32; i += NGT) { const int tok = i >> 5, d = i & 31;
            const double inv = exp2(-(double)d * (13.287712379549449 / 32.0));
            const double rv = (double)pos[tok] * inv * 0.15915494309189535; const float fr = (float)(rv - __builtin_rint(rv));
            rope[2 * i] = __builtin_amdgcn_cosf(fr); rope[2 * i + 1] = __builtin_amdgcn_sinf(fr); }
        bf16_t* H = WSP(bf16_t, WS_H);
        for (int i = gt; i < 1024; i += NGT) { H[(size_t)T * 1024 + i] = 0; WSP(unsigned char, WS_H8)[(size_t)T * 1024 + i] = 0; }
        bf16_t* KCMP = WSP(bf16_t, WS_KCMP); bf16_t* VCT = WSP(bf16_t, WS_VCT);
        for (int i = gt; i < 2 * 2 * 64; i += NGT) { const int b = i >> 7, g = (i >> 6) & 1, d = i & 63; KCMP[(size_t)(b * 2 + g) * 512 * 64 + kfrag_off(511, d >> 3) + (d & 7)] = 0; VCT[(size_t)(b * 2 + g) * 512 * 64 + vfrag_off(511, d)] = 0; }
    }
    {
        float* cb = WSP(float, WS_MISC);
        for (int it = gw; it < 2 * 2 * 64; it += NGW) { const int l = it >> 7, which = (it >> 6) & 1, n = it & 63;
            const float* pe = INP(a, float, which ? I_PEV : I_PEK) + (size_t)l * 2048; const float* w1 = INP(a, float, which ? I_CW1V : I_CW1K) + (size_t)l * 2048 * 64;
            float s = 0.f; for (int k = lane; k < 2048; k += 64) s += pe[k] * w1[(size_t)k * 64 + n];
            s = wave_sum(s); if (lane == 0) cb[it] = s; }
    }
}

struct RowV { f32x4 v[4]; };
__device__ __forceinline__ RowV row_load(const float* p, int lane) { RowV r; const f32x4* q = (const f32x4*)p + lane;
#pragma unroll
    for (int j = 0; j < 4; ++j) r.v[j] = q[64 * j]; return r; }
__device__ __forceinline__ float row_ssq(const RowV& r) { float s = 0.f;
#pragma unroll
    for (int j = 0; j < 4; ++j) s += (r.v[j].x * r.v[j].x + r.v[j].y * r.v[j].y) + (r.v[j].z * r.v[j].z + r.v[j].w * r.v[j].w); return wave_sum(s); }
__device__ __forceinline__ void row_norm_store(const RowV& x, float rstd, const float* g, const float* sc, const float* sh, bf16_t* orow, int lane) {
    u32x2* o8 = (u32x2*)orow + lane;
#pragma unroll
    for (int j = 0; j < 4; ++j) { const f32x4 gg = ((const f32x4*)g)[lane + 64 * j], ss = ((const f32x4*)sc)[lane + 64 * j], hh = ((const f32x4*)sh)[lane + 64 * j];
        const f32x4 y = x.v[j] * rstd * gg * (ss + 1.f) + hh; u32x2 w; w.x = cvtpk(y.x, y.y); w.y = cvtpk(y.z, y.w); o8[64 * j] = w; }
}
__device__ __forceinline__ void quad_tr(unsigned (&a)[4], int lane) {
    const bool b0 = lane & 1, b1 = lane & 2;
    { const unsigned x = b0 ? a[0] : a[1]; const unsigned y = __builtin_amdgcn_update_dpp(0u, x, 0xB1, 0xF, 0xF, true); if (b0) a[0] = y; else a[1] = y; }
    { const unsigned x = b0 ? a[2] : a[3]; const unsigned y = __builtin_amdgcn_update_dpp(0u, x, 0xB1, 0xF, 0xF, true); if (b0) a[2] = y; else a[3] = y; }
    { const unsigned x = b1 ? a[0] : a[2]; const unsigned y = __builtin_amdgcn_update_dpp(0u, x, 0x4E, 0xF, 0xF, true); if (b1) a[0] = y; else a[2] = y; }
    { const unsigned x = b1 ? a[1] : a[3]; const unsigned y = __builtin_amdgcn_update_dpp(0u, x, 0x4E, 0xF, 0xF, true); if (b1) a[1] = y; else a[3] = y; }
}
__device__ __forceinline__ void row_norm_store8(const RowV& x, float rstd, const float* g, const float* sc, const float* sh, unsigned char* orow, int lane) {
    unsigned a[4];
#pragma unroll
    for (int j = 0; j < 4; ++j) { const f32x4 gg = ((const f32x4*)g)[lane + 64 * j], ss = ((const f32x4*)sc)[lane + 64 * j], hh = ((const f32x4*)sh)[lane + 64 * j];
        const f32x4 y = x.v[j] * rstd * gg * (ss + 1.f) + hh; a[j] = cvt4_fp8(y.x, y.y, y.z, y.w); }
    quad_tr(a, lane);
    *(u32x4*)(orow + 256 * (lane & 3) + 16 * (lane >> 2)) = (u32x4){a[0], a[1], a[2], a[3]};
}
__device__ __forceinline__ int expert_block_prefix(const unsigned* cnt, int lane) {
    int nb = (lane < NE) ? (int)((cnt[lane] + 255u) >> 8) : 0; int inc = nb;
#pragma unroll
    for (int o = 1; o < 32; o <<= 1) { const int t = __shfl_up(inc, o); if ((lane & 31) >= o) inc += t; }
    return inc - nb;
}
__device__ __forceinline__ void phase_n1_first(Frame& F, const Args& a) {
    const int gw = F.vcu * NWAVES + F.wave, NGW = F.G * NWAVES; const int lane = F.lane;
    const float* x = INP(a, float, I_X); const float* g = INP(a, float, I_N1G); bf16_t* H = WSP(bf16_t, WS_H); unsigned char* H8 = WSP(unsigned char, WS_H8);
    for (int m = gw; m < T; m += 2 * NGW) { const int m2 = m + NGW; const int b = m >> 13, b2 = m2 >> 13;
        const RowV r = row_load(x + (size_t)m * DM, lane); const RowV r2 = row_load(x + (size_t)m2 * DM, lane);
        const float rstd = 1.f / sqrtf(row_ssq(r) * (1.f / DM) + NORM_EPS), rstd2 = 1.f / sqrtf(row_ssq(r2) * (1.f / DM) + NORM_EPS);
        row_norm_store8(r, rstd, g, MODP(0, b, 1), MODP(0, b, 0), H8 + (size_t)m * DM, lane);
        row_norm_store8(r2, rstd2, g, MODP(0, b2, 1), MODP(0, b2, 0), H8 + (size_t)m2 * DM, lane); }
    float* RWP = WSP(float, WS_RWP); float* RBP = WSP(float, WS_MISC + 4096);
    const float* rw = INP(a, float, I_RW); const float* rb = INP(a, float, I_RB); const float* n2g = INP(a, float, I_N2G);
    const int gt = gw * 64 + lane, NGT = NGW * 64;
    for (int i = gt; i < 2 * 2 * 1024 * 32; i += NGT) { const int l = i >> 16, b = (i >> 15) & 1, k = (i >> 5) & 1023, e = i & 31;
        RWP[i] = n2g[l * 1024 + k] * (1.f + MODP(l, b, 4)[k]) * rw[((size_t)l * 1024 + k) * 32 + e]; }
    for (int it = gw; it < 2 * 2 * 32; it += NGW) { const int l = it >> 6, b = (it >> 5) & 1, e = it & 31; float s = 0.f;
        for (int k = lane; k < 1024; k += 64) s += MODP(l, b, 3)[k] * rw[((size_t)l * 1024 + k) * 32 + e];
        s = wave_sum(s); if (lane == 0) RBP[it] = s + rb[l * 32 + e]; }
}
__device__ __forceinline__ void phase_combine(Frame& F, const Args& a, int l) {
    const int gw = F.vcu * NWAVES + F.wave, NGW = F.G * NWAVES; const int lane = F.lane;
    float* XR = WSP(float, WS_XR); bf16_t* H = WSP(bf16_t, WS_H); const unsigned char* YR = WSP(unsigned char, WS_YROWS);
    const int* ASG = WSP(int, WS_ASG); const float* G4 = WSP(float, WS_GATE4);
    const int myprefix = expert_block_prefix(F.ctl + CW_CNT + l * 32, lane);
    const bool last = (l == DEPTH - 1);
    const float* g = last ? INP(a, float, I_FING) : INP(a, float, I_N1G) + (l + 1) * 1024;
#define COMB_LOAD(R_, WV_, GT_, M_) do { const int4 as4_ = *(const int4*)(ASG + (M_) * 4); const f32x4 gt4_ = *(const f32x4*)(G4 + (M_) * 4); \
        R_ = row_load(XR + (size_t)(M_) * DM, lane); const int asv_[4] = {as4_.x, as4_.y, as4_.z, as4_.w}; GT_[0] = gt4_.x; GT_[1] = gt4_.y; GT_[2] = gt4_.z; GT_[3] = gt4_.w; \
        _Pragma("unroll") for (int k = 0; k < 4; ++k) { const int e = asv_[k] >> 16, slot = asv_[k] & 0xffff; const int blk = __shfl(myprefix, e); \
            const unsigned* yr = (const unsigned*)(YR + ((size_t)blk * 256 + slot) * DM) + lane; _Pragma("unroll") for (int j = 0; j < 4; ++j) WV_[k][j] = __builtin_nontemporal_load(yr + 64 * j); } } while (0)
#define COMB_FINISH(R_, WV_, GT_, M_) do { const int b = (M_) >> 13; f32x4 y[4]; \
        _Pragma("unroll") for (int j = 0; j < 4; ++j) y[j] = (f32x4){0.f, 0.f, 0.f, 0.f}; \
        _Pragma("unroll") for (int k = 0; k < 4; ++k) _Pragma("unroll") for (int j = 0; j < 4; ++j) { const int w = (int)WV_[k][j]; const f32x2 lo_ = __builtin_amdgcn_cvt_pk_f32_fp8(w, false), hi_ = __builtin_amdgcn_cvt_pk_f32_fp8(w, true); y[j] += (f32x4){lo_.x, lo_.y, hi_.x, hi_.y} * GT_[k]; } \
        const float* g2 = MODP(l, b, 5); \
        _Pragma("unroll") for (int j = 0; j < 4; ++j) R_.v[j] += ((const f32x4*)g2)[lane + 64 * j] * y[j]; \
        const float rstd = 1.f / sqrtf(row_ssq(R_) * (1.f / DM) + NORM_EPS); \
        if (last) { f32x4* o = (f32x4*)(a.out + (size_t)(M_) * DM) + lane; _Pragma("unroll") for (int j = 0; j < 4; ++j) o[64 * j] = R_.v[j] * rstd * ((const f32x4*)g)[lane + 64 * j]; } \
        else { f32x4* xo = (f32x4*)(XR + (size_t)(M_) * DM) + lane; _Pragma("unroll") for (int j = 0; j < 4; ++j) xo[64 * j] = R_.v[j]; \
            row_norm_store8(R_, rstd, g, MODP(l + 1, b, 1), MODP(l + 1, b, 0), WSP(unsigned char, WS_H8) + (size_t)(M_) * DM, lane); } } while (0)
    for (int m = gw; m < T; m += 2 * NGW) { const int m2 = m + NGW;
        RowV rA, rB; unsigned wA[4][4], wB[4][4]; float gA[4], gB[4];
        COMB_LOAD(rA, wA, gA, m); COMB_LOAD(rB, wB, gB, m2);
        COMB_FINISH(rA, wA, gA, m); COMB_FINISH(rB, wB, gB, m2);
    }
#undef COMB_LOAD
#undef COMB_FINISH
}
__device__ __forceinline__ void compress_item(Frame& F, const Args& a, int l, int item) {
    const int which = item >> 7, b = (item >> 6) & 1, g = (item >> 5) & 1, n0 = (item & 31) * 16;
    const int lane = F.lane, w = F.wave, r16 = lane & 15, kg = lane >> 4;
    const bf16_t* src = WSP(bf16_t, which ? WS_VC : WS_KC);
    const bf16_t* W1 = WSP(bf16_t, WS_CW1) + (size_t)(l * 2 + which) * 64 * 2048;
    LAS float* red = (LAS float*)F.lds;
    LAS float* hid = (LAS float*)(F.lds + 32768);
    f32x4 acc[4];
#pragma unroll
    for (int i = 0; i < 4; ++i) acc[i] = (f32x4){0.f, 0.f, 0.f, 0.f};
    const int n = n0 + r16; const bool nval = n < NCMP;
#pragma unroll 2
    for (int ks = 0; ks < 8; ++ks) { const int k = 256 * w + 32 * ks + 8 * kg; const int li = k >> 6, d = k & 63;
        bf16x8 af = (bf16x8){0, 0, 0, 0, 0, 0, 0, 0};
        if (nval) af = *(const bf16x8*)(src + ((size_t)b * SEQ + 16 * n + li) * 128 + g * 64 + d);
#pragma unroll
        for (int nt = 0; nt < 4; ++nt) { const bf16x8 bf = *(const bf16x8*)(W1 + (size_t)(nt * 16 + r16) * 2048 + k); acc[nt] = __builtin_amdgcn_mfma_f32_16x16x32_bf16(af, bf, acc[nt], 0, 0, 0); } }
#pragma unroll
    for (int nt = 0; nt < 4; ++nt)
#pragma unroll
        for (int i = 0; i < 4; ++i) red[(w * 16 + 4 * kg + i) * 64 + nt * 16 + r16] = acc[nt][i];
    __syncthreads();
    const float* cb = WSP(float, WS_MISC) + (l * 2 + which) * 64;
    for (int i = F.tid; i < 1024; i += NTHREADS) { float s = cb[i & 63];
#pragma unroll
        for (int ww = 0; ww < 8; ++ww) s += red[ww * 1024 + i];
        hid[i] = gelu_tanh(s); }
    { const float* w2 = INP(a, float, which ? I_CW2V : I_CW2K) + (size_t)l * 4096; LAS f32x4* w2s4 = (LAS f32x4*)(F.lds + 40960);
      for (int i = F.tid; i < 1024; i += NTHREADS) w2s4[i] = ((const f32x4*)w2)[i]; }
    __syncthreads();
    {
        const int nn = F.tid >> 5, c = F.tid & 31; LAS float* w2s = (LAS float*)(F.lds + 40960);
        float o1 = 0.f, o2 = 0.f;
#pragma unroll 16
        for (int k = 0; k < 64; ++k) { const float h = hid[nn * 64 + k]; o1 += h * w2s[k * 64 + c]; o2 += h * w2s[k * 64 + c + 32]; }
        const int np = n0 + nn; float nsq_ = 0.f;
        if (np < NCMP) {
            if (!which) { const float* cs = WSP(float, WS_ROPE) + (((size_t)b * SEQ + 16 * np + 31) * 32 + c) * 2; const float cc = cs[0], ss = cs[1];
                const float r1 = o1 * cc - o2 * ss, r2 = o2 * cc + o1 * ss;
                bf16_t* img = WSP(bf16_t, WS_KCMP) + (size_t)(b * 2 + g) * 512 * 64; img[kfrag_off(np, c >> 3) + (c & 7)] = (bf16_t)(cvtpk(r1, 0.f) & 0xffffu); img[kfrag_off(np, 4 + (c >> 3)) + (c & 7)] = (bf16_t)(cvtpk(r2, 0.f) & 0xffffu);
                nsq_ = r1 * r1 + r2 * r2;
            } else { bf16_t* img = WSP(bf16_t, WS_VCT) + (size_t)(b * 2 + g) * 512 * 64; img[vfrag_off(np, c)] = (bf16_t)(cvtpk(o1, 0.f) & 0xffffu); img[vfrag_off(np, c + 32)] = (bf16_t)(cvtpk(o2, 0.f) & 0xffffu); }
        }
        if (!which) {
            float mx = quad_sum(nsq_);
            mx += __uint_as_float(__builtin_amdgcn_update_dpp(0u, __float_as_uint(mx), 0x141, 0xF, 0xF, true)); mx += __uint_as_float(__builtin_amdgcn_update_dpp(0u, __float_as_uint(mx), 0x140, 0xF, 0xF, true));
            mx = x16_sum(mx);
            mx = x32_max(mx);
            if (F.lane == 0) atomicMax(F.ctl + CW_KMAX + l * 16 + 12 + b * 2 + g, __float_as_uint(mx * 1.02f));
        }
    }
    __syncthreads();
}
__device__ __forceinline__ void sgu_item(Frame& F, const Args& a, int l, int ch) {
    const size_t tok0 = (size_t)ch * 128;
    const int lane = F.lane, w = F.wave, r16 = lane & 15, kg = lane >> 4;
    const bf16_t* VG = WSP(bf16_t, WS_VG); const bf16_t* UG = WSP(bf16_t, WS_UG); bf16_t* Y = WSP(bf16_t, WS_Y);
    LAS float* stats = (LAS float*)F.lds;
    LAS bf16_t* vnT = (LAS bf16_t*)(F.lds + 1024);
    constexpr int VP = 136;
    static_assert(1024 + 8 * 64 * 136 * 2 <= ATT_LDS_BYTES, "SGU LDS map");
    {
        u32x4 vrow[16];
#pragma unroll
        for (int tt = 0; tt < 16; ++tt) vrow[tt] = *(const u32x4*)(VG + (tok0 + 16 * w + tt) * 512 + lane * 8);
#pragma unroll
        for (int tt = 0; tt < 16; ++tt) { const int s = 16 * w + tt; const u32x4 v = vrow[tt];
            const float f[8] = {bflo(v.x), bfhi(v.x), bflo(v.y), bfhi(v.y), bflo(v.z), bfhi(v.z), bflo(v.w), bfhi(v.w)};
            float sm = 0.f;
#pragma unroll
            for (int i = 0; i < 8; ++i) sm += f[i];
            const float mu = wave_sum(sm) * (1.f / 512.f); float q = 0.f;
#pragma unroll
            for (int i = 0; i < 8; ++i) q += (f[i] - mu) * (f[i] - mu);
            const float var = wave_sum(q) * (1.f / 512.f);
            if (lane == 0) { stats[2 * s] = mu; stats[2 * s + 1] = 1.f / sqrtf(var + NORM_EPS); } }
    }
    __syncthreads();
    {
        const int s = F.tid & 127, hq = F.tid >> 7; const float mu = stats[2 * s], rs = stats[2 * s + 1];
#pragma unroll
        for (int hp = 0; hp < 2; ++hp) { const int h = hq + 4 * hp; const int cbase = h * 64;
            const float* lg = INP(a, float, I_SGLNG) + l * 512 + cbase; const float* lb = INP(a, float, I_SGLNB) + l * 512 + cbase;
#pragma unroll 2
            for (int d0 = 0; d0 < 64; d0 += 8) { const u32x4 v = *(const u32x4*)(VG + (tok0 + s) * 512 + cbase + d0);
                const float f[8] = {bflo(v.x), bfhi(v.x), bflo(v.y), bfhi(v.y), bflo(v.z), bfhi(v.z), bflo(v.w), bfhi(v.w)};
#pragma unroll
                for (int i = 0; i < 8; ++i) vnT[(h * 64 + d0 + i) * VP + s] = (bf16_t)(cvtpk((f[i] - mu) * rs * lg[d0 + i] + lb[d0 + i], 0.f) & 0xffffu); } }
    }
    __syncthreads();
    {
        const int h = w;
        const bf16_t* Wm = WSP(bf16_t, WS_SGW) + (size_t)(l * 8 + h) * 128 * 128; const float* bs = INP(a, float, I_SGB) + (size_t)(l * 8 + h) * 128;
#pragma nounroll
        for (int tt = 0; tt < 8; ++tt) {
            const int t = 16 * tt + r16; const float bb = bs[t];
            bf16x8 bw[4]; u32x2 ugv[4];
#pragma unroll
            for (int ks = 0; ks < 4; ++ks) bw[ks] = *(const bf16x8*)(Wm + (size_t)t * 128 + 32 * ks + 8 * kg);
#pragma unroll
            for (int dt = 0; dt < 4; ++dt) ugv[dt] = *(const u32x2*)(UG + (tok0 + t) * 512 + h * 64 + dt * 16 + 4 * kg);
            f32x4 acc[4];
#pragma unroll
            for (int i = 0; i < 4; ++i) acc[i] = (f32x4){0.f, 0.f, 0.f, 0.f};
            const int nks = (16 * tt + 15) / 32 + 1;
#pragma unroll
            for (int ks = 0; ks < 4; ++ks) { if (ks < nks) {
#pragma unroll
                for (int dt = 0; dt < 4; ++dt) { const bf16x8 afr = *(const LAS bf16x8*)(vnT + (h * 64 + dt * 16 + r16) * VP + 32 * ks + 8 * kg); acc[dt] = __builtin_amdgcn_mfma_f32_16x16x32_bf16(afr, bw[ks], acc[dt], 0, 0, 0); } } }
#pragma unroll
            for (int dt = 0; dt < 4; ++dt) { const u32x2 uu = ugv[dt];
                u32x2 o; o.x = cvtpk(bflo(uu.x) * (acc[dt][0] + bb), bfhi(uu.x) * (acc[dt][1] + bb)); o.y = cvtpk(bflo(uu.y) * (acc[dt][2] + bb), bfhi(uu.y) * (acc[dt][3] + bb));
                *(u32x2*)(Y + (tok0 + t) * 1024 + h * 64 + dt * 16 + 4 * kg) = o; }
        }
    }
    __syncthreads();
}
namespace att {
constexpr int OSP = 65;
constexpr int L_OH = 0;
constexpr int L_OL = 66560;
constexpr int L_LS = 133120;
constexpr int L_MREF = L_LS + 2048;
constexpr int USP = 129;
constexpr int L_SEL = L_MREF + 1024;
constexpr int L_CNT = L_SEL + 1024;
constexpr int L_LIST = L_CNT + 512;
constexpr int L_WCTR = L_LIST + 8192;
static_assert(L_WCTR + 16 <= ATT_LDS_BYTES, "attention LDS map");

struct Ptrs { const bf16_t *Q, *KS, *KW, *VST, *VWT, *KCMP, *VCT; const float* GATES; bf16_t* Y; float* YPART; float kmax, vmax, kwmax, kcmax; };

#define MFMA16(a, b, c) __builtin_amdgcn_mfma_f32_16x16x32_bf16(a, b, c, 0, 0, 0)

__device__ __forceinline__ void attn_unit(Frame& F, const Ptrs& P, int b, int g, int qb) {
    LAS unsigned char* lds = F.lds;
    const int tid = F.tid, lane = F.lane, w = F.wave, r16 = lane & 15, kg = lane >> 4;
    LAS int* Oh = (LAS int*)(lds + L_OH); LAS int* Ol = (LAS int*)(lds + L_OL); LAS float* imp = (LAS float*)(lds + L_OH);
    LAS int* lsel = (LAS int*)(lds + L_LS); LAS float* mref = (LAS float*)(lds + L_MREF);
    LAS unsigned* selm = (LAS unsigned*)(lds + L_SEL); LAS int* cnts = (LAS int*)(lds + L_CNT); LAS unsigned char* lists = lds + L_LIST; LAS int* wctr = (LAS int*)(lds + L_WCTR);
    const size_t tokb = (size_t)b * SEQ; const int t0 = qb * 64;
    const bf16_t* Qg = P.Q + (tokb + t0) * 512 + g * 256;
    LAS float* U = (LAS float*)(lds + L_OH); LAS float* linvc = (LAS float*)(lds + L_LS);
    {
        const int q = tid >> 3, part = tid & 7, hd = part >> 1, hf = part & 1;
        const u32x4* src = (const u32x4*)(Qg + (size_t)q * 512 + part * 32);
        float ss = 0.f;
#pragma unroll
        for (int i = 0; i < 4; ++i) { const u32x4 v = src[i]; const float f[8] = {bflo(v.x), bfhi(v.x), bflo(v.y), bfhi(v.y), bflo(v.z), bfhi(v.z), bflo(v.w), bfhi(v.w)};
#pragma unroll
            for (int k = 0; k < 8; ++k) ss += f[k] * f[k]; }
        ss += __uint_as_float(__builtin_amdgcn_update_dpp(0u, __float_as_uint(ss), 0xB1, 0xF, 0xF, true));
        if (hf == 0) mref[q * 4 + hd] = sqrtf(ss);
        { u32x4 zz_ = {0u, 0u, 0u, 0u}; asm volatile("" : "+v"(zz_)); LAS u32x4* z4 = (LAS u32x4*)U; for (int i = tid; i < (256 * USP) / 4; i += NTHREADS) z4[i] = zz_; }
    }
    __syncthreads();
    const int hl = r16 & 3;
#define ATT_LDK(dst, base, key0) do { const char* kb_ = (const char*)(base) + (size_t)(key0) * 128; _Pragma("unroll") for (int u_ = 0; u_ < 2; ++u_) _Pragma("unroll") for (int ks_ = 0; ks_ < 2; ++ks_) \
        dst[u_][ks_] = *(const bf16x8*)(kb_ + koff + (u_ * 2 + ks_) * 1024); } while (0)
#define ATT_LDV(dst, vbase, LEN, key0) do { const char* vb_ = (const char*)(vbase) + (size_t)(key0) * 128; _Pragma("unroll") for (int dt_ = 0; dt_ < 4; ++dt_) \
        dst[dt_] = *(const bf16x8*)(vb_ + koff + dt_ * 1024); } while (0)
#define ATT_SHADOW() int ln_ = F.lane; asm volatile("" : "+v"(ln_)); const int r16 = ln_ & 15, kg = ln_ >> 4, hl = r16 & 3; const unsigned koff = (unsigned)ln_ * 16u
    {
        ATT_SHADOW();
        bf16x8 qf[2][2]; float mrc[2], lpart[2], carry[2] = {0.f, 0.f}; int nlim[2]; f32x4 o[2][4];
#pragma unroll
        for (int rt = 0; rt < 2; ++rt) { const int q = 8 * w + 4 * rt + (r16 >> 2);
#pragma unroll
            for (int ks = 0; ks < 2; ++ks) qf[rt][ks] = *(const bf16x8*)(Qg + (size_t)q * 512 + hl * 64 + ks * 32 + kg * 8);
            mrc[rt] = mref[q * 4 + hl] * P.kcmax; lpart[rt] = 0.f; nlim[rt] = (t0 + q - 31) >> 4;
#pragma unroll
            for (int dt = 0; dt < 4; ++dt) o[rt][dt] = (f32x4){0.f, 0.f, 0.f, 0.f}; }
        const int nkeys = 4 * qb + 3, NP = (nkeys + 31) >> 5;
        const int nlim_min = (t0 + 8 * w - 31) >> 4;
        const bf16_t* Kc = P.KCMP + (size_t)(b * 2 + g) * 512 * 64; const bf16_t* Vc = P.VCT + (size_t)(b * 2 + g) * 64 * 512;
#define ATT_S1_STEP(KF, VF, s_) do { _Pragma("unroll") for (int rt = 0; rt < 2; ++rt) { \
            f32x4 st[2]; float p[2][4]; \
            _Pragma("unroll") for (int u = 0; u < 2; ++u) { st[u] = MFMA16(KF[u][0], qf[rt][0], ((f32x4){0.f, 0.f, 0.f, 0.f})); st[u] = MFMA16(KF[u][1], qf[rt][1], st[u]); } \
            _Pragma("unroll") for (int u = 0; u < 2; ++u) _Pragma("unroll") for (int i = 0; i < 4; ++i) p[u][i] = fast_exp2(st[u][i] - mrc[rt]); \
            if (32 * (s_) + 31 > nlim_min) { _Pragma("unroll") for (int u = 0; u < 2; ++u) _Pragma("unroll") for (int i = 0; i < 4; ++i) { const int n = 32 * (s_) + 8 * kg + 4 * u + i; if (n > nlim[rt]) p[u][i] = 0.f; } } \
            const float s01 = (p[0][0] + p[0][1]) + (p[0][2] + p[0][3]), s11 = (p[1][0] + p[1][1]) + (p[1][2] + p[1][3]); lpart[rt] += s01 + s11; \
            {   \
                \
              const unsigned x_ = __float_as_uint(p[1][3]); const auto s16_ = __builtin_amdgcn_permlane16_swap(x_, x_, false, false); const auto s32_ = __builtin_amdgcn_permlane32_swap(s16_[1], s16_[1], false, false); \
              const float inc_ = (kg & 1) ? __uint_as_float(s16_[0]) : ((kg == 2) ? __uint_as_float(s32_[0]) : carry[rt]); carry[rt] = __uint_as_float(s32_[1]); \
              LAS float* ur = U + ((8 * w + 4 * rt + (r16 >> 2)) * 4 + hl) * USP + 8 * (s_) + 2 * kg; \
              ur[0] += (2.f * s01 - p[0][3]) + inc_; ur[1] += (2.f * s11 - p[1][3]) + p[0][3]; } \
            u32x4 pw; pw.x = cvtpk(p[0][0], p[0][1]); pw.y = cvtpk(p[0][2], p[0][3]); pw.z = cvtpk(p[1][0], p[1][1]); pw.w = cvtpk(p[1][2], p[1][3]); \
            const bf16x8 pf = __builtin_bit_cast(bf16x8, pw); \
            _Pragma("unroll") for (int dt = 0; dt < 4; ++dt) o[rt][dt] = MFMA16(VF[dt], pf, o[rt][dt]); } } while (0)
        {
            bf16x8 kA[2][2], vA[4], kB[2][2], vB[4];
            ATT_LDK(kA, Kc, 0); ATT_LDV(vA, Vc, 512, 0); if (NP > 1) { ATT_LDK(kB, Kc, 32); ATT_LDV(vB, Vc, 512, 32); }
#pragma nounroll
            for (int s2 = 0; s2 < NP; s2 += 2) {
                ATT_S1_STEP(kA, vA, s2);
                if (s2 + 2 < NP) { ATT_LDK(kA, Kc, 32 * (s2 + 2)); ATT_LDV(vA, Vc, 512, 32 * (s2 + 2)); }
                if (s2 + 1 < NP) { ATT_S1_STEP(kB, vB, s2 + 1);
                    if (s2 + 3 < NP) { ATT_LDK(kB, Kc, 32 * (s2 + 3)); ATT_LDV(vB, Vc, 512, 32 * (s2 + 3)); } }
            }
        }
#undef ATT_S1_STEP
#pragma unroll
        for (int rt = 0; rt < 2; ++rt) { const int q = 8 * w + 4 * rt + (r16 >> 2); const float lrow = kg_sum(lpart[rt]); const float linv = lrow > 0.f ? 1.f / lrow : 0.f;
            if (kg == 0) linvc[q * 4 + hl] = linv;
            const float gc = P.GATES[(tokb + t0 + q) * 24 + (g * 4 + hl) * 3 + 0] * linv;
            float* yp = P.YPART + (tokb + t0 + q) * 512 + (g * 4 + hl) * 64 + 4 * kg;
#pragma unroll
            for (int dt = 0; dt < 4; ++dt) *(f32x4*)(yp + dt * 16) = o[rt][dt] * gc; }
    }
    LDS_WAIT();
#pragma nounroll
    for (int qg = 0; qg < 2; ++qg) {
        if (qb <= 15) {
            if (lane < 4) { const int q = 8 * w + 4 * qg + lane; const unsigned long long m0 = (1ull << (qb + 1)) - 1ull;
                selm[q * 4 + 0] = (unsigned)m0; selm[q * 4 + 1] = (unsigned)(m0 >> 32); selm[q * 4 + 2] = 0u; selm[q * 4 + 3] = 0u; }
        } else {
            const int j0 = lane, j1 = lane + 64; int v0[4], v1[4], thr[4];
#pragma unroll
            for (int k = 0; k < 4; ++k) { const int q = 8 * w + 4 * qg + k; const LAS float* ur = U + (q * 4) * USP; const LAS float* li = linvc + q * 4;
                float i0 = 0.f, i1 = 0.f;
#pragma unroll
                for (int h = 0; h < 4; ++h) { i0 += ur[h * USP + j0] * li[h]; i1 += ur[h * USP + j1] * li[h]; }
                v0[k] = (j0 >= 1 && j0 <= qb - 2) ? (int)__float_as_uint(i0) : -1;
                v1[k] = (j1 <= qb - 2) ? (int)__float_as_uint(i1) : -1; thr[k] = 0; }
#pragma nounroll
            for (int bit = 30; bit >= 0; --bit) {
                const int c0_ = thr[0] | (1 << bit), c1_ = thr[1] | (1 << bit), c2_ = thr[2] | (1 << bit), c3_ = thr[3] | (1 << bit);
                const unsigned long long a0_ = __ballot(v0[0] >= c0_), a1_ = __ballot(v0[1] >= c1_), a2_ = __ballot(v0[2] >= c2_), a3_ = __ballot(v0[3] >= c3_);
                const unsigned long long b0_ = __ballot(v1[0] >= c0_), b1_ = __ballot(v1[1] >= c1_), b2_ = __ballot(v1[2] >= c2_), b3_ = __ballot(v1[3] >= c3_);
                asm volatile("" :: "s"(a0_), "s"(a1_), "s"(a2_), "s"(a3_), "s"(b0_), "s"(b1_), "s"(b2_), "s"(b3_));
                if (__popcll(a0_) + __popcll(b0_) >= 13) thr[0] = c0_;
                if (__popcll(a1_) + __popcll(b1_) >= 13) thr[1] = c1_;
                if (__popcll(a2_) + __popcll(b2_) >= 13) thr[2] = c2_;
                if (__popcll(a3_) + __popcll(b3_) >= 13) thr[3] = c3_; }
            const unsigned long long below = (1ull << lane) - 1ull;
#pragma nounroll
            for (int k = 0; k < 4; ++k) {
                const int vv0 = (k == 0) ? v0[0] : (k == 1) ? v0[1] : (k == 2) ? v0[2] : v0[3], vv1 = (k == 0) ? v1[0] : (k == 1) ? v1[1] : (k == 2) ? v1[2] : v1[3];
                const int th = (k == 0) ? thr[0] : (k == 1) ? thr[1] : (k == 2) ? thr[2] : thr[3];
                const bool gt0 = vv0 > th, gt1 = vv1 > th, eq0 = vv0 == th, eq1 = vv1 == th;
                const int need = 13 - (__popcll(__ballot(gt0)) + __popcll(__ballot(gt1)));
                const unsigned long long B0 = __ballot(eq0), B1 = __ballot(eq1);
                const int rk0 = __popcll(B0 & below), rk1 = __popcll(B0) + __popcll(B1 & below);
                unsigned long long m0 = __ballot(gt0 || (eq0 && rk0 < need)), m1 = __ballot(gt1 || (eq1 && rk1 < need));
                m0 |= 1ull;
                if (qb < 64) m0 |= (1ull << qb); else m1 |= (1ull << (qb - 64));
                if (qb - 1 < 64) m0 |= (1ull << (qb - 1)); else m1 |= (1ull << (qb - 65));
                if (lane == 0) { const int q = 8 * w + 4 * qg + k; selm[q * 4 + 0] = (unsigned)m0; selm[q * 4 + 1] = (unsigned)(m0 >> 32); selm[q * 4 + 2] = (unsigned)m1; selm[q * 4 + 3] = (unsigned)(m1 >> 32); } }
        }
    }
    __syncthreads();
    { u32x4 zz_ = {0u, 0u, 0u, 0u}; asm volatile("" : "+v"(zz_)); LAS u32x4* z4 = (LAS u32x4*)Oh; for (int i = tid; i < (2 * 256 * OSP) / 4; i += NTHREADS) z4[i] = zz_; }
    lsel[tid] = 0;
    if (tid == 0) wctr[0] = 0;
    { const unsigned m0 = selm[lane * 4 + (w >> 1)];
#pragma nounroll
      for (int jj = 0; jj < 16; ++jj) { const int j = 16 * w + jj; const bool hit = (j <= qb) && ((m0 >> (16 * (w & 1) + jj)) & 1u);
          const unsigned long long mk = __ballot(hit); if (hit) lists[j * 64 + __popcll(mk & ((1ull << lane) - 1ull))] = (unsigned char)lane;
          if (lane == 0) cnts[j] = __popcll(mk); } }
    __syncthreads();
    for (int rep5 = 0; rep5 < ((ATTREP & 8) ? NREP : 1); ++rep5)
    {
        if (rep5 > 0) { __syncthreads(); if (tid == 0) wctr[0] = 0; __syncthreads(); }
        ATT_SHADOW();
        const bf16_t* Ks = P.KS + (size_t)(b * 2 + g) * SEQ * 64; const bf16_t* Vs = P.VST + (size_t)(b * 2 + g) * 64 * SEQ;
        const float S1 = 1048576.f / fmaxf(P.vmax, 1e-30f);
#define ATT_FETCH(idx_) do { int i_ = 0; if (lane == 0) i_ = __hip_atomic_fetch_add(wctr, 1, __ATOMIC_RELAXED, __HIP_MEMORY_SCOPE_WORKGROUP); idx_ = __builtin_amdgcn_readfirstlane(i_); } while (0)
#define ATT_JOF(idx_) (((idx_) == 0) ? 0 : (((idx_) == 1) ? qb : (((idx_) == 2) ? qb - 1 : (idx_) - 2)))
        bf16x8 kn[2][2][2];
        int idx; ATT_FETCH(idx);
        if (idx <= qb) { const int j = ATT_JOF(idx); ATT_LDK(kn[0], Ks, 64 * j); ATT_LDK(kn[1], Ks, 64 * j + 32); }
#pragma nounroll
        while (idx <= qb) {
            const int j = ATT_JOF(idx);
            bf16x8 kf[2][2][2], vf[2][4];
#pragma unroll
            for (int sp = 0; sp < 2; ++sp) {
#pragma unroll
                for (int u = 0; u < 2; ++u) { kf[sp][u][0] = kn[sp][u][0]; kf[sp][u][1] = kn[sp][u][1]; } }
            ATT_LDV(vf[0], Vs, SEQ, 64 * j); ATT_LDV(vf[1], Vs, SEQ, 64 * j + 32);
            int idx2; ATT_FETCH(idx2);
            if (idx2 <= qb) { const int j2 = ATT_JOF(idx2); ATT_LDK(kn[0], Ks, 64 * j2); ATT_LDK(kn[1], Ks, 64 * j2 + 32); }
            const int cnt = cnts[j];
            const int nch = (cnt + 3) >> 2;
            bf16x8 qn0, qn1; int qnx; bool vnx;
            { const int qs = (r16 >> 2); vnx = qs < cnt; qnx = lists[j * 64 + (vnx ? qs : (cnt > 0 ? cnt - 1 : 0))];
              const bf16_t* qp = Qg + (size_t)qnx * 512 + hl * 64 + kg * 8; qn0 = *(const bf16x8*)qp; qn1 = *(const bf16x8*)(qp + 32); }
#pragma nounroll
            for (int c = 0; c < nch; ++c) {
                const bool valid = vnx; const int q = qnx; const int row = q * 4 + hl; const bf16x8 q0 = qn0, q1 = qn1;
                if (c + 1 < nch) { const int qs = 4 * (c + 1) + (r16 >> 2); vnx = qs < cnt; qnx = lists[j * 64 + (vnx ? qs : cnt - 1)];
                    const bf16_t* qp = Qg + (size_t)qnx * 512 + hl * 64 + kg * 8; qn0 = *(const bf16x8*)qp; qn1 = *(const bf16x8*)(qp + 32); }
                const float mr = mref[row] * P.kmax;
                f32x4 o[4];
                float ps = 0.f;
                const bool slow = (j == qb) || (4 * c + 4 > cnt);
#define ATT_CHUNK(MASKED) \
                _Pragma("unroll") for (int sp = 0; sp < 2; ++sp) { \
                    f32x4 st[2]; float p[2][4]; \
                    _Pragma("unroll") for (int u = 0; u < 2; ++u) { st[u] = MFMA16(kf[sp][u][0], q0, ((f32x4){0.f, 0.f, 0.f, 0.f})); st[u] = MFMA16(kf[sp][u][1], q1, st[u]); } \
                    _Pragma("unroll") for (int u = 0; u < 2; ++u) _Pragma("unroll") for (int i = 0; i < 4; ++i) { float e = fast_exp2(st[u][i] - mr); \
                        if (MASKED) { const int kk = 32 * sp + 8 * kg + 4 * u + i; if (!valid || (j == qb && kk > q)) e = 0.f; } p[u][i] = e; ps += e; } \
                    u32x4 pw; pw.x = cvtpk(p[0][0], p[0][1]); pw.y = cvtpk(p[0][2], p[0][3]); pw.z = cvtpk(p[1][0], p[1][1]); pw.w = cvtpk(p[1][2], p[1][3]); \
                    const bf16x8 pf = __builtin_bit_cast(bf16x8, pw); \
                    _Pragma("unroll") for (int dt = 0; dt < 4; ++dt) o[dt] = (sp == 0) ? MFMA16(vf[0][dt], pf, ((f32x4){0.f, 0.f, 0.f, 0.f})) : MFMA16(vf[1][dt], pf, o[dt]); }
                if (slow) { ATT_CHUNK(true) } else { ATT_CHUNK(false) }
#undef ATT_CHUNK
                ps = kg_sum(ps);
                if (valid) {
                    if (kg == 0) { const float xs = ps * 1048576.f, hf_ = __builtin_rintf(xs); __hip_atomic_fetch_add(lsel + row, (int)hf_, __ATOMIC_RELAXED, __HIP_MEMORY_SCOPE_WORKGROUP);
                        __hip_atomic_fetch_add(lsel + 256 + row, (int)((xs - hf_) * 1048576.f), __ATOMIC_RELAXED, __HIP_MEMORY_SCOPE_WORKGROUP); }
#pragma unroll
                    for (int dt = 0; dt < 4; ++dt)
#pragma unroll
                        for (int i = 0; i < 4; ++i) { const float xs = o[dt][i] * S1, hf_ = __builtin_rintf(xs); const int off = row * OSP + dt * 16 + 4 * kg + i;
                            __hip_atomic_fetch_add(Oh + off, (int)hf_, __ATOMIC_RELAXED, __HIP_MEMORY_SCOPE_WORKGROUP);
                            __hip_atomic_fetch_add(Ol + off, (int)((xs - hf_) * 1048576.f), __ATOMIC_RELAXED, __HIP_MEMORY_SCOPE_WORKGROUP); }
                }
            }
            idx = idx2;
        }
    }
    f32x4 yacc[2][4];
    {
        ATT_SHADOW();
        bf16x8 qf[2][2]; float mrw[2], lpart[2]; f32x4 o[2][4];
#pragma unroll
        for (int rt = 0; rt < 2; ++rt) { const int q = 8 * w + 4 * rt + (r16 >> 2);
#pragma unroll
            for (int ks = 0; ks < 2; ++ks) qf[rt][ks] = *(const bf16x8*)(Qg + (size_t)q * 512 + hl * 64 + ks * 32 + kg * 8);
            mrw[rt] = mref[q * 4 + hl] * P.kwmax; lpart[rt] = 0.f;
#pragma unroll
            for (int dt = 0; dt < 4; ++dt) o[rt][dt] = (f32x4){0.f, 0.f, 0.f, 0.f}; }
        const bf16_t* Kw = P.KW + (size_t)(b * 2 + g) * SEQ * 64; const bf16_t* Vw = P.VWT + (size_t)(b * 2 + g) * 64 * SEQ;
        const int jlo = qb >= 8 ? qb - 8 : 0; const int nit = 2 * (qb - jlo + 1);
#define ATT_S4_STEP(KF, VF, it_) do { const int jw_ = jlo + ((it_) >> 1), sp_ = (it_) & 1; const int mode_ = (jw_ == qb) ? 1 : ((jw_ == qb - 8) ? 2 : 0); \
        _Pragma("unroll") for (int rt = 0; rt < 2; ++rt) { \
            f32x4 st[2]; float p[2][4]; \
            _Pragma("unroll") for (int u = 0; u < 2; ++u) { st[u] = MFMA16(KF[u][0], qf[rt][0], ((f32x4){0.f, 0.f, 0.f, 0.f})); st[u] = MFMA16(KF[u][1], qf[rt][1], st[u]); } \
            _Pragma("unroll") for (int u = 0; u < 2; ++u) _Pragma("unroll") for (int i = 0; i < 4; ++i) p[u][i] = fast_exp2(st[u][i] - mrw[rt]); \
            if (mode_) { const int tq = 8 * w + 4 * rt + (r16 >> 2); \
                _Pragma("unroll") for (int u = 0; u < 2; ++u) _Pragma("unroll") for (int i = 0; i < 4; ++i) { const int kk = 32 * sp_ + 8 * kg + 4 * u + i; const bool vis = (mode_ == 1) ? (kk <= tq) : (kk > tq); if (!vis) p[u][i] = 0.f; } } \
            lpart[rt] += ((p[0][0] + p[0][1]) + (p[0][2] + p[0][3])) + ((p[1][0] + p[1][1]) + (p[1][2] + p[1][3])); \
            u32x4 pw; pw.x = cvtpk(p[0][0], p[0][1]); pw.y = cvtpk(p[0][2], p[0][3]); pw.z = cvtpk(p[1][0], p[1][1]); pw.w = cvtpk(p[1][2], p[1][3]); \
            const bf16x8 pf = __builtin_bit_cast(bf16x8, pw); \
            _Pragma("unroll") for (int dt = 0; dt < 4; ++dt) o[rt][dt] = MFMA16(VF[dt], pf, o[rt][dt]); } } while (0)
        {
            bf16x8 kA[2][2], vA[4], kB[2][2], vB[4];
            ATT_LDK(kA, Kw, 64 * jlo); ATT_LDV(vA, Vw, SEQ, 64 * jlo); ATT_LDK(kB, Kw, 64 * jlo + 32); ATT_LDV(vB, Vw, SEQ, 64 * jlo + 32);
#pragma nounroll
            for (int it = 0; it < nit; it += 2) {
                ATT_S4_STEP(kA, vA, it);
                if (it + 2 < nit) { ATT_LDK(kA, Kw, 64 * jlo + 32 * (it + 2)); ATT_LDV(vA, Vw, SEQ, 64 * jlo + 32 * (it + 2)); }
                ATT_S4_STEP(kB, vB, it + 1);
                if (it + 3 < nit) { ATT_LDK(kB, Kw, 64 * jlo + 32 * (it + 3)); ATT_LDV(vB, Vw, SEQ, 64 * jlo + 32 * (it + 3)); }
            }
        }
#undef ATT_S4_STEP
#pragma unroll
        for (int rt = 0; rt < 2; ++rt) { const int q = 8 * w + 4 * rt + (r16 >> 2); const float lw_ = kg_sum(lpart[rt]); const float sc = lw_ > 0.f ? P.GATES[(tokb + t0 + q) * 24 + (g * 4 + hl) * 3 + 2] / lw_ : 0.f;
#pragma unroll
            for (int dt = 0; dt < 4; ++dt) yacc[rt][dt] = o[rt][dt] * sc; }
    }
    __syncthreads();
#pragma unroll
    for (int rt = 0; rt < 2; ++rt) { const int q = 8 * w + 4 * rt + (r16 >> 2), row = q * 4 + hl;
        const float lrow = (float)lsel[row] * (1.f / 1048576.f) + (float)lsel[256 + row] * (1.f / 1099511627776.f);
        const float invS1 = fmaxf(P.vmax, 1e-30f) * (1.f / 1048576.f);
        const float sc = lrow > 0.f ? P.GATES[(tokb + t0 + q) * 24 + (g * 4 + hl) * 3 + 1] / lrow * invS1 : 0.f;
        bf16_t* dst = P.Y + (tokb + t0 + q) * 1024 + 512 + (g * 4 + hl) * 64 + 4 * kg;
        const float* yp = P.YPART + (tokb + t0 + q) * 512 + (g * 4 + hl) * 64 + 4 * kg;
#pragma unroll
        for (int dt = 0; dt < 4; ++dt) { const LAS int* oh = Oh + row * OSP + dt * 16 + 4 * kg; const LAS int* ol = Ol + row * OSP + dt * 16 + 4 * kg;
            const f32x4 osel = (f32x4){(float)oh[0] + (float)ol[0] * (1.f / 1048576.f), (float)oh[1] + (float)ol[1] * (1.f / 1048576.f), (float)oh[2] + (float)ol[2] * (1.f / 1048576.f), (float)oh[3] + (float)ol[3] * (1.f / 1048576.f)};
            const f32x4 v = yacc[rt][dt] + *(const f32x4*)(yp + dt * 16) + osel * sc;
            u32x2 o; o.x = cvtpk(v[0], v[1]); o.y = cvtpk(v[2], v[3]); *(u32x2*)(dst + dt * 16) = o; } }
    __syncthreads();
}
#undef MFMA16
#undef ATT_LDK
#undef ATT_LDV
#undef ATT_SHADOW
#undef ATT_FETCH
#undef ATT_JOF
}

__device__ __forceinline__ void phase_n2(Frame& F, const Args& a, int l) {
    const int lane = F.lane, w = F.wave;
    const float* XR = WSP(float, WS_XR); unsigned char* H8 = WSP(unsigned char, WS_H8);
    const float* g = INP(a, float, I_N2G) + l * 1024;
    LAS float* part = (LAS float*)F.lds;
    LAS float* ssqp = (LAS float*)(F.lds + 32768);
    LAS float* lg = (LAS float*)(F.lds + 32768 + 1024);
    int* CNTI = WSP(int, WS_CNTI); int* ASG = WSP(int, WS_ASG); float* G4 = WSP(float, WS_GATE4);
    for (int item = F.vcu; item < T / 64; item += F.G) {
        const int tk0 = item * 64, b = tk0 >> 13; const int tt = w & 1, kq = w >> 1;
        const float* rwp = WSP(float, WS_RWP) + (size_t)(l * 2 + b) * 1024 * 32; const float* rbp = WSP(float, WS_MISC + 4096) + (l * 2 + b) * 32;
        const int i31 = lane & 31, hf = lane >> 5;
        {
            const float* xp = XR + (size_t)(tk0 + tt * 32 + i31) * DM + kq * 256 + 4 * hf; const float* wp = rwp + (size_t)(kq * 256 + 4 * hf) * 32 + i31;
            f32x16 acc;
#pragma unroll
            for (int r = 0; r < 16; ++r) acc[r] = 0.f;
            float ssq = 0.f;
#pragma nounroll
            for (int bt = 0; bt < 4; ++bt) {
                f32x4 xv[8]; float wv[8][4];
#pragma unroll
                for (int s = 0; s < 8; ++s) { xv[s] = *(const f32x4*)(xp + 8 * (bt * 8 + s)); const float* wq = wp + (size_t)(8 * (bt * 8 + s)) * 32;
                    wv[s][0] = wq[0]; wv[s][1] = wq[32]; wv[s][2] = wq[64]; wv[s][3] = wq[96]; }
#pragma unroll
                for (int s = 0; s < 8; ++s) { ssq += (xv[s].x * xv[s].x + xv[s].y * xv[s].y) + (xv[s].z * xv[s].z + xv[s].w * xv[s].w);
                    acc = __builtin_amdgcn_mfma_f32_32x32x2f32(xv[s].x, wv[s][0], acc, 0, 0, 0); acc = __builtin_amdgcn_mfma_f32_32x32x2f32(xv[s].y, wv[s][1], acc, 0, 0, 0);
                    acc = __builtin_amdgcn_mfma_f32_32x32x2f32(xv[s].z, wv[s][2], acc, 0, 0, 0); acc = __builtin_amdgcn_mfma_f32_32x32x2f32(xv[s].w, wv[s][3], acc, 0, 0, 0); }
            }
            ssq += __shfl_xor(ssq, 32);
            if (hf == 0) ssqp[kq * 64 + tt * 32 + i31] = ssq;
#pragma unroll
            for (int r = 0; r < 16; ++r) { const int tk = (r & 3) + 8 * (r >> 2) + 4 * hf; part[(w * 32 + tk) * 32 + i31] = acc[r]; }
        }
        __syncthreads();
        for (int i = F.tid; i < 64 * 32; i += NTHREADS) { const int tk = i >> 5, e = i & 31, t2 = tk >> 5, tl = tk & 31;
            const float sq = (ssqp[tk] + ssqp[64 + tk]) + (ssqp[128 + tk] + ssqp[192 + tk]); const float rstd = 1.f / sqrtf(sq * (1.f / DM) + NORM_EPS);
            const float v = (part[((0 * 2 + t2) * 32 + tl) * 32 + e] + part[((1 * 2 + t2) * 32 + tl) * 32 + e]) + (part[((2 * 2 + t2) * 32 + tl) * 32 + e] + part[((3 * 2 + t2) * 32 + tl) * 32 + e]);
            lg[tk * 33 + e] = v * rstd + rbp[e]; }
        __syncthreads();
        if (w < 2) {
            const int it = item * 2 + w;
            float v0 = -INFINITY, v1 = -INFINITY, v2 = -INFINITY, v3 = -INFINITY; int i0 = -1, i1 = -1, i2 = -1, i3 = -1;
            if (lane < 32) {
#pragma unroll 8
                for (int e = 0; e < 32; ++e) { const float v = lg[(w * 32 + lane) * 33 + e];
                    if (v > v3) { if (v > v2) { v3 = v2; i3 = i2; if (v > v1) { v2 = v1; i2 = i1; if (v > v0) { v1 = v0; i1 = i0; v0 = v; i0 = e; } else { v1 = v; i1 = e; } } else { v2 = v; i2 = e; } } else { v3 = v; i3 = e; } } }
            }
            const float e1 = __expf(v1 - v0), e2 = __expf(v2 - v0), e3 = __expf(v3 - v0); const float inv = 1.f / (1.f + e1 + e2 + e3);
            int r0 = 0, r1 = 0, r2 = 0, r3 = 0, mycnt = 0;
            for (int e = 0; e < 32; ++e) { const bool hit = (i0 == e) | (i1 == e) | (i2 == e) | (i3 == e); const unsigned long long U = __ballot(hit);
                const int rk = __popcll(U & ((1ull << lane) - 1ull));
                if (i0 == e) r0 = rk; if (i1 == e) r1 = rk; if (i2 == e) r2 = rk; if (i3 == e) r3 = rk;
                if (lane == e) mycnt = __popcll(U); }
            if (lane < 32) { const int tk = tk0 + w * 32 + lane; CNTI[it * 32 + lane] = mycnt;
                if (mycnt > 0) { atomicAdd(F.ctl + CW_GCNT + (l * 32 + (it >> 4)) * 32 + lane, (unsigned)mycnt); atomicAdd(F.ctl + CW_CNT + l * 32 + lane, (unsigned)mycnt); }
                *(int4*)(ASG + tk * 4) = make_int4((i0 << 16) | r0, (i1 << 16) | r1, (i2 << 16) | r2, (i3 << 16) | r3);
                *(f32x4*)(G4 + tk * 4) = (f32x4){inv, e1 * inv, e2 * inv, e3 * inv}; }
        }
#pragma unroll 2
        for (int rr = 0; rr < 8; ++rr) { const int m = tk0 + w * 8 + rr; const RowV r = row_load(XR + (size_t)m * DM, lane);
            const float rstd = 1.f / sqrtf(row_ssq(r) * (1.f / DM) + NORM_EPS);
            row_norm_store8(r, rstd, g, MODP(l, b, 4), MODP(l, b, 3), H8 + (size_t)m * DM, lane); }
        __syncthreads();
    }
}

__device__ __forceinline__ void phase_n2b(Frame& F, int l) {
    const int gw = F.vcu * NWAVES + F.wave, NGW = F.G * NWAVES; const int lane = F.lane;
    const int* CNTI = WSP(int, WS_CNTI); int* TOK = WSP(int, WS_TOK); int* ASG = WSP(int, WS_ASG); unsigned* cnt = F.ctl + CW_CNT + l * 32;
    for (int it = gw; it < T / 32; it += NGW) {
        int base = 0;
        {
            const unsigned* gc = F.ctl + CW_GCNT + l * 1024; const int grp = it >> 4, e = lane & 31; int s0 = 0, s1 = 0;
#pragma unroll
            for (int gI = 0; gI < 32; ++gI) { const int v = (int)gc[gI * 32 + e]; s0 += (gI < grp) ? v : 0; }
#pragma unroll
            for (int i = 0; i < 16; ++i) { const int v = CNTI[((grp << 4) + i) * 32 + e]; s1 += (((grp << 4) + i) < it) ? v : 0; }
            base = s0 + s1; }
        { const int tk = it * 32 + (lane & 31); const int4 as = *(const int4*)(ASG + tk * 4); int v[4] = {as.x, as.y, as.z, as.w};
#pragma unroll
            for (int k = 0; k < 4; ++k) { const int e = v[k] >> 16, rk = v[k] & 0xffff; const int sl = __shfl(base, e & 31) + rk; if (lane < 32) TOK[e * 16384 + sl] = tk; v[k] = (e << 16) | sl; }
            if (lane < 32) *(int4*)(ASG + tk * 4) = make_int4(v[0], v[1], v[2], v[3]); }
    }
}

__device__ __forceinline__ void moe_tables(Frame& F, int l, int NT, int& total) {
    LAS int* ust = (LAS int*)(F.lds + MOE_OFF); LAS int* bst = ust + 33; LAS int* cn = bst + 33;
    if (F.tid < 64) { const unsigned* cnt = F.ctl + CW_CNT + l * 32; const int lane = F.tid;
        const int c = (lane < NE) ? (int)cnt[lane] : 0; const int nb = (c + 255) >> 8; int inc = nb;
#pragma unroll
        for (int o = 1; o < 32; o <<= 1) { const int t = __shfl_up(inc, o); if ((lane & 31) >= o) inc += t; }
        if (lane < NE) { bst[lane] = inc - nb; ust[lane] = (inc - nb) * NT; cn[lane] = c; if (lane == NE - 1) { bst[NE] = inc; ust[NE] = inc * NT; } } }
    __syncthreads();
    total = ust[NE];
}

constexpr int PH_PROLOGUE = 0, PH_N1 = 1, PH_LAYER0 = 2, PH_PER_LAYER = 9, NPHASES = PH_LAYER0 + DEPTH * PH_PER_LAYER;
__global__ void __launch_bounds__(NTHREADS, 2) fwd_kernel(Args args) {
    extern __shared__ __attribute__((aligned(16))) unsigned char lds_raw[];
    Frame F;
    F.lds = (LAS unsigned char*)lds_raw; F.ws = args.ws; F.ctl = (unsigned*)(args.ws + WS_CTL);
    F.tid = threadIdx.x; F.lane = F.tid & 63; F.wave = __builtin_amdgcn_readfirstlane(F.tid >> 6);
    F.G = gridDim.x; { const int bx = blockIdx.x; F.vcu = (F.G % 8 == 0) ? (bx % 8) * (F.G / 8) + bx / 8 : bx; }
    for (int u = F.tid; u < (LDS_BYTES - LDSCTL_OFF) / 4; u += NTHREADS) ((LAS unsigned*)(F.lds + LDSCTL_OFF))[u] = 0u;
    __syncthreads();
    volatile LAS unsigned* MISC = (volatile LAS unsigned*)(F.lds + MISC_OFF);
    XcdBarrier bar; bar.bar = F.ctl + CW_BAR; bar.x = 0; bar.st = nullptr;
#if !MK_PER_PHASE
    bar = xcd_barrier_post(F.ctl + CW_BAR, MISC + 8);
#endif
    const int lo = args.ph_lo, hi = args.ph_hi;
#define IN(k) (lo <= (k) && (k) < hi)
#define REFRESH() do { int t_ = threadIdx.x; asm volatile("" : "+v"(t_)); F.tid = t_; F.lane = t_ & 63; F.wave = __builtin_amdgcn_readfirstlane(t_ >> 6); } while (0)
#define SEAM(k) do { if (IN(k) && IN((k) + 1)) xcd_barrier(bar); } while (0)
#define REPS(bit, idem) (((REPMASK & (bit)) && (idem)) ? NREP : 1)

    if (IN(PH_PROLOGUE) && !(SKIPMASK & 1)) for (int rep = 0; rep < REPS(1, true); ++rep) { REFRESH(); phase_prologue(F, args); } SEAM(PH_PROLOGUE);
    if (IN(PH_N1) && !(SKIPMASK & 2)) for (int rep = 0; rep < REPS(2, true); ++rep) { REFRESH(); phase_n1_first(F, args); } SEAM(PH_N1);
    for (int l = 0; l < DEPTH; ++l) {
        const int p0 = PH_LAYER0 + l * PH_PER_LAYER;
        if (IN(p0 + 0) && !(SKIPMASK & 4)) for (int rep = 0; rep < REPS(4, l == 0); ++rep) {
            { pg8::DenseOrder S; S.init(T, 2560, F.G, ({ int b_ = (int)blockIdx.x; asm volatile("" : "+s"(b_)); b_; }));
              EpiProj E{WSP(bf16_t, WS_UG), WSP(bf16_t, WS_VG), WSP(bf16_t, WS_Q), WSP(bf16_t, WS_KC), WSP(bf16_t, WS_VC), WSP(bf16_t, WS_KS), WSP(bf16_t, WS_KW), WSP(bf16_t, WS_VST), WSP(bf16_t, WS_VWT),
                        WSP(float, WS_GATES), WSP(float, WS_ROPE), F.ctl + CW_KMAX + l * 16, 0};
              pg8::gemm_phase<EpiProj, pg8::DenseOrder, false, true, true>(F.lds, WSP(bf16_t, WS_H8), (const bf16_t*)(WSP(unsigned char, WS_WIN8) + (size_t)l * 2560 * 1024), 512, S, E); }
        }
        SEAM(p0 + 0);
        if (IN(p0 + 1) && !(SKIPMASK & 8)) for (int rep = 0; rep < REPS(8, l == 0); ++rep) { REFRESH();
            for (int it = F.vcu; it < 256; it += F.G) { if (it < 128) sgu_item(F, args, l, it); else { compress_item(F, args, l, 2 * (it - 128)); compress_item(F, args, l, 2 * (it - 128) + 1); } }
        }
        SEAM(p0 + 1);
        if (IN(p0 + 2) && !(SKIPMASK & 16)) for (int rep = 0; rep < REPS(16, l == 0); ++rep) { REFRESH();
            att::Ptrs P{WSP(bf16_t, WS_Q), WSP(bf16_t, WS_KS), WSP(bf16_t, WS_KW), WSP(bf16_t, WS_VST), WSP(bf16_t, WS_VWT), WSP(bf16_t, WS_KCMP), WSP(bf16_t, WS_VCT), WSP(float, WS_GATES), WSP(bf16_t, WS_Y), WSP(float, WS_YPART), 0.f};
            for (int it = F.vcu; it < 512; it += F.G) {
                const int uu = (it < 256) ? it : (767 - it);
                const int bg = uu >> 7, qb = uu & 127;
                const unsigned* km = F.ctl + CW_KMAX + l * 16 + bg;
                P.kmax = sqrtf(__uint_as_float(__hip_atomic_load(km, __ATOMIC_RELAXED, __HIP_MEMORY_SCOPE_AGENT)));
                P.vmax = __uint_as_float(__hip_atomic_load(km + 4, __ATOMIC_RELAXED, __HIP_MEMORY_SCOPE_AGENT));
                P.kwmax = sqrtf(__uint_as_float(__hip_atomic_load(km + 8, __ATOMIC_RELAXED, __HIP_MEMORY_SCOPE_AGENT)));
                P.kcmax = sqrtf(__uint_as_float(__hip_atomic_load(km + 12, __ATOMIC_RELAXED, __HIP_MEMORY_SCOPE_AGENT)));
                att::attn_unit(F, P, bg >> 1, bg & 1, qb);
            }
        }
        SEAM(p0 + 2);
        if (IN(p0 + 3) && !(SKIPMASK & 32)) for (int rep = 0; rep < REPS(32, l == 0); ++rep) {
            pg8::DenseOrder S; S.init(T, DM, F.G, ({ int b_ = (int)blockIdx.x; asm volatile("" : "+s"(b_)); b_; }));
            EpiOut E{l == 0 ? INP(args, float, I_X) : WSP(float, WS_XR), WSP(float, WS_XR), (const float*)(F.ctl + CW_MOD) + (size_t)l * 2 * 6144};
            pg8::gemm_phase<EpiOut, pg8::DenseOrder, false, true>(F.lds, WSP(bf16_t, WS_Y), WSP(bf16_t, WS_WOUT) + (size_t)l * 1024 * 1024, 1024, S, E);
        }
        SEAM(p0 + 3);
        if (IN(p0 + 4) && !(SKIPMASK & 64)) for (int rep = 0; rep < REPS(64, l == 0); ++rep) { REFRESH(); phase_n2(F, args, l); }
        SEAM(p0 + 4);
        if (IN(p0 + 5) && !(SKIPMASK & 64)) for (int rep = 0; rep < REPS(1024, l == 0); ++rep) { REFRESH(); phase_n2b(F, l); }
        SEAM(p0 + 5);
        if (IN(p0 + 6) && !(SKIPMASK & 128)) for (int rep = 0; rep < REPS(128, l == 0); ++rep) { REFRESH();
            int total; moe_tables(F, l, 8, total);
            LAS int* ust = (LAS int*)(F.lds + MOE_OFF);
            pg8::MoeOrder S{ust, ust + 33, ust + 66, WSP(int, WS_TOK), 8, F.G, F.vcu, total, 1024};
            EpiSwiglu E{WSP(unsigned char, WS_ACT), INP(args, float, I_EB1) + (size_t)l * NE * 2048};
            pg8::gemm_phase<EpiSwiglu, pg8::MoeOrder, true, true, true>(F.lds, WSP(bf16_t, WS_H8), (const bf16_t*)(WSP(unsigned char, WS_W1T) + (size_t)l * NE * 2048 * 1024), 512, S, E);
        }
        SEAM(p0 + 6);
        if (IN(p0 + 7) && !(SKIPMASK & 256)) for (int rep = 0; rep < REPS(256, l == 0); ++rep) { REFRESH();
            int total; moe_tables(F, l, 4, total);
            LAS int* ust = (LAS int*)(F.lds + MOE_OFF);
            pg8::MoeOrder S{ust, ust + 33, ust + 66, WSP(int, WS_TOK), 4, F.G, F.vcu, total, 1024};
            EpiDown E{WSP(unsigned char, WS_YROWS), INP(args, float, I_EB2) + (size_t)l * NE * 1024};
            pg8::gemm_phase<EpiDown, pg8::MoeOrder, false, true, true>(F.lds, WSP(bf16_t, WS_ACT), (const bf16_t*)(WSP(unsigned char, WS_W2T) + (size_t)l * NE * 1024 * 1024), 512, S, E);
        }
        SEAM(p0 + 7);
        if (IN(p0 + 8) && !(SKIPMASK & 512)) for (int rep = 0; rep < REPS(512, l == DEPTH - 1); ++rep) { REFRESH(); phase_combine(F, args, l); }
        if (l + 1 < DEPTH) SEAM(p0 + 8);
    }
#undef IN
#undef SEAM
}

extern "C" void kernel_launch(void* const* d_in, const int* in_sizes, int n_in, void* d_out, int out_size, void* d_ws, size_t ws_size, hipStream_t stream) {
    static int grid = 0;
    if (grid == 0) {
        if (n_in != 26 || out_size != T * DM || ws_size < WS_END) { fprintf(stderr, "kernel_launch: unexpected problem (n_in %d, out %d, ws %zu; need ws >= %zu)\n", n_in, out_size, ws_size, (size_t)WS_END); grid = -1; return; }
        int dev = 0, cus = 0, per_cu = 0;
        if (hipGetDevice(&dev) != hipSuccess || hipDeviceGetAttribute(&cus, hipDeviceAttributeMultiprocessorCount, dev) != hipSuccess) { grid = -1; return; }
        if (hipFuncSetAttribute((const void*)fwd_kernel, hipFuncAttributeMaxDynamicSharedMemorySize, LDS_BYTES) != hipSuccess) { fprintf(stderr, "kernel_launch: hipFuncSetAttribute failed\n"); grid = -1; return; }
        if (hipOccupancyMaxActiveBlocksPerMultiprocessor(&per_cu, (const void*)fwd_kernel, NTHREADS, LDS_BYTES) != hipSuccess || per_cu < 1) { fprintf(stderr, "kernel_launch: occupancy query says %d\n", per_cu); (void)hipGetLastError(); per_cu = 1; }
        grid = cus;
    }
    if (grid < 0) return;
    if (hipMemsetAsync((char*)d_ws + WS_CTL, 0, CTL_ZERO_BYTES, stream) != hipSuccess) { fprintf(stderr, "kernel_launch: memset failed\n"); return; }
    Args a{};
    for (int i = 0; i < 26; ++i) a.in[i] = d_in[i];
    a.out = (float*)d_out; a.ws = (unsigned char*)d_ws;
#if MK_PER_PHASE
    for (int p = 0; p < NPHASES; ++p) { a.ph_lo = p; a.ph_hi = p + 1; a.li = 0;
        hipLaunchKernelGGL(fwd_kernel, dim3(grid), dim3(NTHREADS), LDS_BYTES, stream, a); }
#else
    a.ph_lo = 0; a.ph_hi = NPHASES; a.li = 0;
    void* kargs[] = {&a};
    hipError_t e = hipLaunchCooperativeKernel((const void*)fwd_kernel, dim3(grid), dim3(NTHREADS), kargs, LDS_BYTES, stream);
    if (e != hipSuccess) fprintf(stderr, "kernel_launch: cooperative launch failed: %s (grid %d)\n", hipGetErrorString(e), grid);
#endif
}
```

```cpp
#include <hip/hip_runtime.h>
#include <cstdio>
#include <cstdint>

#ifndef SKIPMASK
#define SKIPMASK 0
#endif
#ifndef REPMASK
#define REPMASK 0
#endif
#ifndef NREP
#define NREP 3
#endif
#ifndef DUMMYINT
#define DUMMYINT 0
#endif
#ifndef ATTREP
#define ATTREP 0
#endif
#ifndef MK_PER_PHASE
#define MK_PER_PHASE 0
#endif

#define LAS __attribute__((address_space(3)))
typedef unsigned short bf16_t;
typedef short bf16x8 __attribute__((ext_vector_type(8)));
typedef float f32x4 __attribute__((ext_vector_type(4)));
typedef float f32x2 __attribute__((ext_vector_type(2)));
typedef float f32x16 __attribute__((ext_vector_type(16)));
typedef unsigned u32x4 __attribute__((ext_vector_type(4)));
typedef unsigned u32x2 __attribute__((ext_vector_type(2)));
typedef __bf16 bf16x2_t __attribute__((ext_vector_type(2)));
typedef int i32x4 __attribute__((ext_vector_type(4)));
typedef int i32x8 __attribute__((ext_vector_type(8)));

constexpr int BATCH = 2, SEQ = 8192, DM = 1024, T = BATCH * SEQ, DEPTH = 2;
constexpr int PIN = 2328, PINP = 2560;
constexpr int NE = 32, FF = 1024, TOPK = 4;
constexpr int NCMP = 511, NCMPP = 512;
constexpr float NORM_EPS = 1e-6f;
constexpr float W8SCALE = 64.f;
constexpr int W8_E8M0 = 0x79797979, ONE_E8M0 = 0x7f7f7f7f;
constexpr float QSCALE = 0.125f * 1.4426950408889634f;
constexpr int NWAVES = 8, NTHREADS = 512;

constexpr size_t MiB = 1u << 20;
constexpr size_t WS_CTL = 0, CTL_ZERO_BYTES = 1 * MiB;
constexpr size_t WS_WIN = 1 * MiB;
constexpr size_t WS_WOUT = 11 * MiB;
constexpr size_t WS_SGW = 15 * MiB;
constexpr size_t WS_CW1 = 15 * MiB + 512 * 1024;
constexpr size_t WS_ROPE = 17 * MiB;
constexpr size_t WS_RWP = 21 * MiB;
constexpr size_t WS_MISC = 21 * MiB + 512 * 1024;
constexpr size_t WS_W1T = 32 * MiB;
constexpr size_t WS_W2T = 288 * MiB;
constexpr size_t WS_XR = 416 * MiB;
constexpr size_t WS_H = 480 * MiB;
constexpr size_t WS_UG = 513 * MiB, WS_VG = 529 * MiB, WS_Q = 545 * MiB;
constexpr size_t WS_KC = 561 * MiB, WS_VC = 565 * MiB, WS_KS = 569 * MiB, WS_KW = 573 * MiB;
constexpr size_t WS_VST = 577 * MiB, WS_VWT = 581 * MiB;
constexpr size_t WS_GATES = 585 * MiB;
constexpr size_t WS_KCMP = 587 * MiB;
constexpr size_t WS_VCT = 587 * MiB + 512 * 1024;
constexpr size_t WS_Y = 588 * MiB;
constexpr size_t WS_TOK = 620 * MiB;
constexpr size_t WS_ASG = 622 * MiB;
constexpr size_t WS_GATE4 = 622 * MiB + 512 * 1024;
constexpr size_t WS_YPART = 912 * MiB;
constexpr size_t WS_CNTI = 623 * MiB;
constexpr size_t WS_ACT = 624 * MiB;
constexpr size_t WS_YROWS = 768 * MiB;
constexpr size_t WS_WIN8 = 962 * MiB;
constexpr size_t WS_H8 = 944 * MiB;
constexpr size_t WS_END = 968 * MiB;
constexpr int CW_BAR = 4096;
constexpr int CW_MOD = 16384;
constexpr int CW_CNT = 40960;
constexpr int CW_KMAX = 41088;
constexpr int CW_GCNT = 41216;

__device__ __forceinline__ unsigned cvtpk(float lo, float hi) { f32x2 v = {lo, hi}; bf16x2_t b = __builtin_convertvector(v, bf16x2_t); return __builtin_bit_cast(unsigned, b); }
__device__ __forceinline__ unsigned cvt4_fp8(float a, float b, float c, float d) { int w = 0; w = __builtin_amdgcn_cvt_pk_fp8_f32(a, b, w, false); w = __builtin_amdgcn_cvt_pk_fp8_f32(c, d, w, true); return (unsigned)w; }
__device__ __forceinline__ float bf2f(unsigned short b) { return __uint_as_float((unsigned)b << 16); }
__device__ __forceinline__ float bflo(unsigned w) { return __uint_as_float(w << 16); }
__device__ __forceinline__ float bfhi(unsigned w) { return __uint_as_float(w & 0xffff0000u); }
__device__ __forceinline__ float fast_exp2(float x) { return __builtin_amdgcn_exp2f(x); }
__device__ __forceinline__ float fast_rcp(float x) { return __builtin_amdgcn_rcpf(x); }
__device__ __forceinline__ float sigmoidf_(float x) { return fast_rcp(1.f + fast_exp2(-1.4426950408889634f * x)); }
__device__ __forceinline__ float gelu_tanh(float x) { const float u = 0.7978845608028654f * (x + 0.044715f * x * x * x); return x * fast_rcp(1.f + fast_exp2(-2.885390081777927f * u)); }

__device__ __forceinline__ float x16_sum(float x) { auto r = __builtin_amdgcn_permlane16_swap(__float_as_uint(x), __float_as_uint(x), false, false); return __uint_as_float(r[0]) + __uint_as_float(r[1]); }
__device__ __forceinline__ float x32_sum(float x) { auto r = __builtin_amdgcn_permlane32_swap(__float_as_uint(x), __float_as_uint(x), false, false); return __uint_as_float(r[0]) + __uint_as_float(r[1]); }
__device__ __forceinline__ float x16_max(float x) { auto r = __builtin_amdgcn_permlane16_swap(__float_as_uint(x), __float_as_uint(x), false, false); return fmaxf(__uint_as_float(r[0]), __uint_as_float(r[1])); }
__device__ __forceinline__ float x32_max(float x) { auto r = __builtin_amdgcn_permlane32_swap(__float_as_uint(x), __float_as_uint(x), false, false); return fmaxf(__uint_as_float(r[0]), __uint_as_float(r[1])); }
__device__ __forceinline__ float kg_sum(float x) { return x32_sum(x16_sum(x)); }
__device__ __forceinline__ float kg_max(float x) { return x32_max(x16_max(x)); }
__device__ __forceinline__ float quad_sum(float x) { x += __uint_as_float(__builtin_amdgcn_update_dpp(0u, __float_as_uint(x), 0xB1, 0xF, 0xF, true)); x += __uint_as_float(__builtin_amdgcn_update_dpp(0u, __float_as_uint(x), 0x4E, 0xF, 0xF, true)); return x; }
__device__ __forceinline__ float wave_sum(float v) {
    v = quad_sum(v);
    v += __uint_as_float(__builtin_amdgcn_update_dpp(0u, __float_as_uint(v), 0x141, 0xF, 0xF, true));
    v += __uint_as_float(__builtin_amdgcn_update_dpp(0u, __float_as_uint(v), 0x140, 0xF, 0xF, true));
    return x32_sum(x16_sum(v));
}
#define LDS_WAIT() asm volatile("s_waitcnt lgkmcnt(0)" ::: "memory")
#define VM_WAIT() asm volatile("s_waitcnt vmcnt(0)" ::: "memory")

__device__ __forceinline__ int kfrag_off(int key, int c8) {
    const int s = key >> 5, ko = key & 31, u = (ko >> 2) & 1, r16 = ((ko >> 3) << 2) | (ko & 3), ks = c8 >> 2, kg = c8 & 3;
    return s * 2048 + (u * 2 + ks) * 512 + (kg * 16 + r16) * 8;
}
__device__ __forceinline__ int vfrag_off(int key, int d) {
    const int s = key >> 5, ko = key & 31;
    return s * 2048 + (d >> 4) * 512 + ((ko >> 3) * 16 + (d & 15)) * 8 + (ko & 7);
}
namespace pg8 {
constexpr int BM = 256, BK = 64, HALF = 128, HTB = HALF * BK * 2, STAGE_BYTES = 8 * HTB, NXCD = 8, WGM = 4;
__host__ __device__ __forceinline__ int lds_byte(int r, int c) { const int st = (r >> 4) * 2 + (c >> 5), rr = r & 15, cc = c & 31, ob = rr * 64 + cc * 2; return st * 1024 + (ob ^ (((ob >> 9) & 1) << 5)); }
__host__ __device__ __forceinline__ void stage_rc(int b, int& R, int& C) { const int st = b / 1024, sb = b % 1024, swz = sb ^ (((sb >> 9) & 1) << 5); R = (st >> 1) * 16 + swz / 64; C = (st & 1) * 32 + (swz % 64) / 2; }
__host__ __device__ __forceinline__ int perm32(int rho) { const int n = rho >> 4, i = rho & 15; return 8 * (i >> 2) + 4 * n + (i & 3); }

struct Unit { int pm, pn, e, pnl, rloc, hs; };

__device__ __forceinline__ bool unit_index(int i, int G, int c, int total, int& L, int& hs) {
    const int nfr = total / G, R = total - nfr * G; hs = 0;
    if (i < nfr) { L = i * G + c; return true; }
    if (i > nfr || R == 0) return false;
    if (2 * R <= G) { if (c >= 2 * R) return false; const int h = c >= R ? 1 : 0; L = nfr * G + c - h * R; hs = 1 + h; return true; }
    if (c >= R) return false;
    L = nfr * G + c; return true;
}

struct DenseOrder {
    static constexpr bool SPLIT = false;
    int nM, nN, nwg, G, c;
    __device__ void init(int M, int N, int G_, int c_) { nM = M / BM; nN = N / BM; nwg = nM * nN; G = G_; c = c_; }
    __device__ bool next(int i, Unit& u) const {
        const long L = (long)i * G + c; if (L >= nwg) return false;
        u.hs = 0; int wgid = (int)L; { const int q = nwg / NXCD, r = nwg % NXCD, xcd = wgid % NXCD, off = wgid / NXCD; wgid = (xcd < r ? xcd * (q + 1) : r * (q + 1) + (xcd - r) * q) + off; }
        const int nig = WGM * nN, gid = wgid / nig, fm = gid * WGM, gsz = (nM - fm) < WGM ? (nM - fm) : WGM;
        u.pm = fm + ((wgid % nig) % gsz); u.pn = (wgid % nig) / gsz; u.e = 0; u.pnl = u.pn; u.rloc = 0; return true;
    }
    __device__ __forceinline__ unsigned rowoff(const Unit&, int) const { return 0u; }
};

struct MoeOrder {
    static constexpr bool SPLIT = true;
    const LAS int* ust;
    const LAS int* bst;
    const LAS int* cnt;
    const int* tok;
    int NT, G, c, total, rowbytes;
    __device__ bool next(int i, Unit& u) const {
        int L, hs; if (!unit_index(i, G, c, total, L, hs)) return false;
        u.hs = hs; int e = 0;
        for (int k = 1; k < NE; ++k) e += (L >= ust[k]) ? 1 : 0;
        e = __builtin_amdgcn_readfirstlane(e);
        const int loc = __builtin_amdgcn_readfirstlane(L - ust[e]), b0 = __builtin_amdgcn_readfirstlane(bst[e]), nb = __builtin_amdgcn_readfirstlane(bst[e + 1]) - b0;
        u.e = e; u.pnl = loc / nb; u.rloc = loc - u.pnl * nb; u.pm = b0 + u.rloc; u.pn = e * NT + u.pnl; return true;
    }
    __device__ __forceinline__ unsigned rowoff(const Unit& u, int r) const {
        const int slot = u.rloc * 256 + r + (u.hs == 2 ? 128 : 0); const int tk = slot < cnt[u.e] ? tok[u.e * 16384 + slot] : T;
        return (unsigned)tk * (unsigned)rowbytes;
    }
};

template <class Epi, class Sched, bool GATHER, bool ALIGN_EPI, bool FP8 = false>
__device__ __forceinline__ void gemm_phase(LAS unsigned char* lds, const bf16_t* A, const bf16_t* Bt, const int K, const Sched& S, const Epi& E) {
    int tid_ = threadIdx.x; asm volatile("" : "+v"(tid_));
    const int tid = tid_, wid = __builtin_amdgcn_readfirstlane(tid >> 6), lane = tid & 63, wr = wid >> 2, wc = wid & 3, fr = lane & 15, fq = lane >> 4;
    const int nt = K / BK;
    unsigned voffB[2];
#pragma unroll
    for (int i = 0; i < 2; ++i) { int R, C; stage_rc(tid * 16 + i * 8192, R, C); const int Rb = Epi::PERM ? ((R & ~31) + perm32(R & 31)) : R; voffB[i] = (unsigned)(Rb * K + C) * 2u; }
    const size_t kstep = (size_t)(BK * 2);
    const size_t hstep = (size_t)HALF * K * 2;
    const size_t tstep = 2 * hstep;
    const unsigned ldsw = (unsigned)wid * 1024u;
    const int aoff = lds_byte(wr * 64 + fr, fq * 8), boff = lds_byte(wc * 32 + fr, fq * 8);
#define PG8_SA(b, h) (((b) * 2 + (h)) * HTB)
#define PG8_SB(b, h) ((4 + (b) * 2 + (h)) * HTB)
#define PG8_STAGE(bufoff, gbase, v0, v1) do { \
        __builtin_amdgcn_global_load_lds((const unsigned*)((const char*)(gbase) + (v0)), (LAS unsigned*)(lds + (bufoff) + ldsw), 16, 0, 0); \
        __builtin_amdgcn_global_load_lds((const unsigned*)((const char*)(gbase) + (v1)), (LAS unsigned*)(lds + (bufoff) + ldsw + 8192), 16, 0, 0); } while (0)
#define PG8_STAGEB(bufoff, gbase) PG8_STAGE(bufoff, gbase, voffB[0], voffB[1])
#define PG8_CAT8(x0, x1) __builtin_shufflevector(x0, x1, 0, 1, 2, 3, 4, 5, 6, 7)
#define PG8_RD4(off) (*(const LAS i32x4*)(lds + (off)))
#define PG8_LDA(dst, b, h) do { if constexpr (FP8) { _Pragma("unroll") for (int m = 0; m < 4; ++m) dst##8[m] = PG8_CAT8(PG8_RD4(PG8_SA(b, h) + aoff + m * 2048), PG8_RD4(PG8_SA(b, h) + aoff + m * 2048 + 1024)); } \
        else { _Pragma("unroll") for (int m = 0; m < 4; ++m) _Pragma("unroll") for (int k = 0; k < 2; ++k) dst[m][k] = *(const LAS bf16x8*)(lds + PG8_SA(b, h) + aoff + m * 2048 + k * 1024); } } while (0)
#define PG8_LDB(dst, b, h) do { if constexpr (FP8) { _Pragma("unroll") for (int n = 0; n < 2; ++n) dst##8[n] = PG8_CAT8(PG8_RD4(PG8_SB(b, h) + boff + n * 2048), PG8_RD4(PG8_SB(b, h) + boff + n * 2048 + 1024)); } \
        else { _Pragma("unroll") for (int n = 0; n < 2; ++n) _Pragma("unroll") for (int k = 0; k < 2; ++k) dst[n][k] = *(const LAS bf16x8*)(lds + PG8_SB(b, h) + boff + n * 2048 + k * 1024); } } while (0)
#define PG8_MMA(ai, bj, At, Bt_) do { __builtin_amdgcn_s_setprio(1); _Pragma("unroll") for (int m = 0; m < 4; ++m) _Pragma("unroll") for (int n = 0; n < 2; ++n) { \
        if constexpr (FP8) { asm volatile("v_mfma_scale_f32_16x16x128_f8f6f4 %0, %1, %2, %0, %3, %4 op_sel_hi:[0,0,0]" : "+v"(acc[ai][bj][m][n]) : "v"(Bt_##8[n]), "v"(At##8[m]), "v"(sc_w), "v"(sc_x)); } \
        else { _Pragma("unroll") for (int k = 0; k < 2; ++k) acc[ai][bj][m][n] = __builtin_amdgcn_mfma_f32_16x16x32_bf16(Bt_[n][k], At[m][k], acc[ai][bj][m][n], 0, 0, 0); } } \
        __builtin_amdgcn_s_setprio(0); } while (0)
#define PG8_WAIT_V(n) asm volatile("s_waitcnt vmcnt(" #n ")" ::: "memory")
#define PG8_WAIT_L(n) asm volatile("s_waitcnt lgkmcnt(" #n ")" ::: "memory")
#define PG8_BAR __builtin_amdgcn_s_barrier()
#define PG8_SCHED __builtin_amdgcn_sched_barrier(0)
#define PG8_SETV(v, u) do { int t2_ = tid; asm volatile("" : "+v"(t2_)); _Pragma("unroll") for (int i_ = 0; i_ < 2; ++i_) { int R_, C_; stage_rc(t2_ * 16 + i_ * 8192, R_, C_); _Pragma("unroll") for (int h_ = 0; h_ < 2; ++h_) \
        v[h_][i_] = GATHER ? (S.rowoff(u, R_ + HALF * h_) + (unsigned)C_ * 2u) : (unsigned)((R_ + HALF * h_) * K + C_) * 2u; } } while (0)
    Unit cur, nxt; int ui = 0;
    if (!S.next(0, cur)) return;
    unsigned vc[2][2], vn[2][2];
    PG8_SETV(vc, cur);
    f32x4 acc[2][2][4][2];
#pragma unroll
    for (int a = 0; a < 2; ++a)
#pragma unroll
        for (int b = 0; b < 2; ++b)
#pragma unroll
            for (int m = 0; m < 4; ++m)
#pragma unroll
                for (int n = 0; n < 2; ++n) acc[a][b][m][n] = (f32x4){0.f, 0.f, 0.f, 0.f};
    bf16x8 At[4][2], B0[2][2], B1[2][2]; i32x8 At8[4], B08[2], B18[2];
    int sc_w = W8_E8M0, sc_x = ONE_E8M0; asm volatile("" : "+v"(sc_w), "+v"(sc_x));
    const char* cA = GATHER ? (const char*)A : (const char*)A + (size_t)cur.pm * tstep + (cur.hs == 2 ? hstep : (size_t)0);
    const char* cB = (const char*)Bt + (size_t)cur.pn * tstep;
    PG8_STAGEB(PG8_SB(0, 0), cB); PG8_STAGEB(PG8_SB(0, 1), cB + hstep); PG8_STAGE(PG8_SA(0, 0), cA, vc[0][0], vc[0][1]); PG8_STAGE(PG8_SA(0, 1), cA, vc[1][0], vc[1][1]);
    if (wr == 1) PG8_BAR;
    PG8_WAIT_V(2); PG8_BAR;
    PG8_STAGEB(PG8_SB(1, 0), cB + kstep); PG8_STAGE(PG8_SA(1, 0), cA + kstep, vc[0][0], vc[0][1]); PG8_STAGEB(PG8_SB(1, 1), cB + hstep + kstep);
    PG8_WAIT_V(6); PG8_BAR;
    for (;;) {
        const bool has_next = S.next(ui + 1, nxt);
        const char* nA = GATHER ? (const char*)A : (has_next ? (const char*)A + (size_t)nxt.pm * tstep + (nxt.hs == 2 ? hstep : (size_t)0) : cA);
        const bool full = !Sched::SPLIT || cur.hs == 0;
        const char* nB = has_next ? (const char*)Bt + (size_t)nxt.pn * tstep : cB;
        if constexpr (GATHER) { if (has_next) { PG8_SETV(vn, nxt); } else {
#pragma unroll
            for (int h_ = 0; h_ < 2; ++h_)
#pragma unroll
                for (int i_ = 0; i_ < 2; ++i_) vn[h_][i_] = vc[h_][i_]; } }
#pragma nounroll
        for (int t = 0; t < nt; t += 2) {
            const bool last = (t == nt - 2);
            const char* a1 = cA + (size_t)(t + 1) * kstep;
            const char* a2 = last ? nA : cA + (size_t)(t + 2) * kstep; const char* b2 = last ? nB : cB + (size_t)(t + 2) * kstep;
            const char* a3 = a2 + kstep; const char* b3 = b2 + kstep;
            const unsigned w00 = (GATHER && last) ? vn[0][0] : vc[0][0], w01 = (GATHER && last) ? vn[0][1] : vc[0][1], w10 = (GATHER && last) ? vn[1][0] : vc[1][0], w11 = (GATHER && last) ? vn[1][1] : vc[1][1];
            PG8_LDB(B0, 0, 0); PG8_LDB(B1, 0, 1); PG8_SCHED; PG8_LDA(At, 0, 0); PG8_STAGE(PG8_SA(1, 1), a1, vc[1][0], vc[1][1]);
            PG8_WAIT_V(8); PG8_WAIT_L(0); PG8_BAR; PG8_MMA(0, 0, At, B0); PG8_MMA(0, 1, At, B1); PG8_BAR; PG8_SCHED;
            if (full) PG8_LDA(At, 0, 1); PG8_STAGEB(PG8_SB(0, 0), b2); PG8_STAGEB(PG8_SB(0, 1), b2 + hstep); PG8_STAGE(PG8_SA(0, 0), a2, w00, w01);
            PG8_WAIT_V(8); PG8_WAIT_L(0); PG8_BAR; if (full) { PG8_MMA(1, 0, At, B0); PG8_MMA(1, 1, At, B1); } PG8_BAR; PG8_SCHED;
            PG8_LDB(B0, 1, 0); PG8_LDB(B1, 1, 1); PG8_SCHED; PG8_LDA(At, 1, 0); PG8_STAGE(PG8_SA(0, 1), a2, w10, w11);
            PG8_WAIT_V(8); PG8_WAIT_L(0); PG8_BAR; PG8_MMA(0, 0, At, B0); PG8_MMA(0, 1, At, B1); PG8_BAR; PG8_SCHED;
            if (full) PG8_LDA(At, 1, 1); PG8_STAGEB(PG8_SB(1, 0), b3); PG8_STAGEB(PG8_SB(1, 1), b3 + hstep); PG8_STAGE(PG8_SA(1, 0), a3, w00, w01);
            PG8_WAIT_V(8); PG8_WAIT_L(0); PG8_BAR; if (full) { PG8_MMA(1, 0, At, B0); PG8_MMA(1, 1, At, B1); } PG8_BAR; PG8_SCHED;
        }
        if constexpr (FP8) { asm volatile("s_nop 15\n\ts_nop 15" ::: "memory"); }
        if constexpr (ALIGN_EPI) { if (wr == 0) PG8_BAR; }
        E(acc, cur, wr, wc, fr, fq);
        if (!has_next) break;
#pragma unroll
        for (int a = 0; a < 2; ++a)
#pragma unroll
            for (int b = 0; b < 2; ++b)
#pragma unroll
                for (int m = 0; m < 4; ++m)
#pragma unroll
                    for (int n = 0; n < 2; ++n) acc[a][b][m][n] = (f32x4){0.f, 0.f, 0.f, 0.f};
        cur = nxt; cA = nA; cB = nB; ++ui;
        if constexpr (GATHER) {
#pragma unroll
        for (int h_ = 0; h_ < 2; ++h_)
#pragma unroll
            for (int i_ = 0; i_ < 2; ++i_) vc[h_][i_] = vn[h_][i_]; }
        if constexpr (ALIGN_EPI) { if (wr == 1) PG8_BAR; }
    }
    PG8_WAIT_V(0);
    if constexpr (!ALIGN_EPI) { if (wr == 0) PG8_BAR; }
    PG8_BAR;
#undef PG8_SA
#undef PG8_SB
#undef PG8_STAGE
#undef PG8_STAGEB
#undef PG8_LDA
#undef PG8_LDB
#undef PG8_MMA
#undef PG8_CAT8
#undef PG8_RD4
#undef PG8_WAIT_V
#undef PG8_WAIT_L
#undef PG8_BAR
#undef PG8_SCHED
#undef PG8_SETV
}
}

#define XB_TMO      128
#define XB_XCNT(j)  (256  + 64 * (j))
#define XB_XSUB(j)  (1280 + 64 * (j))
#define XB_XGEN(j)  (2304 + 64 * (j))
#define XB_TOP      3328
#define XB_TOPGEN   3392
#define XCD_BAR_WORDS 3456
#define XB_SPIN_CAP (1u << 22)
__device__ __forceinline__ unsigned xb_ld(unsigned* p)              { return __hip_atomic_load(p, __ATOMIC_RELAXED, __HIP_MEMORY_SCOPE_AGENT); }
__device__ __forceinline__ unsigned xb_add(unsigned* p, unsigned v) { return __hip_atomic_fetch_add(p, v, __ATOMIC_RELAXED, __HIP_MEMORY_SCOPE_AGENT); }
__device__ __forceinline__ unsigned xb_xcc_id() { return (unsigned)__builtin_amdgcn_s_getreg((3 << 11) | 20) & 0xFu; }
#define XB_SPIN(cond, bar) do { unsigned _sp = 0; while (cond) { __builtin_amdgcn_s_sleep(1); \
    if ((++_sp & 255u) == 0u) { if (xb_ld(&(bar)[XB_TMO])) break; if (_sp > XB_SPIN_CAP) { atomicAdd(&(bar)[XB_TMO], 1u); break; } } } } while (0)
struct XcdBarrier { unsigned* bar; unsigned x; volatile LAS unsigned* st; };
__device__ __forceinline__ XcdBarrier xcd_barrier_post(unsigned* bar, volatile LAS unsigned* st) {
    XcdBarrier b; b.bar = bar; b.x = xb_xcc_id(); b.st = st;
    if (threadIdx.x == 0) (void)xb_add(&bar[XB_XCNT(b.x)], 1u);
    return b;
}
__device__ __forceinline__ void xcd_barrier_complete(unsigned* bar, unsigned x, unsigned& nloc, unsigned& nx) {
    const unsigned G = gridDim.x * gridDim.y * gridDim.z;
    unsigned sum, cnt, mine, sp = 0u;
    for (;;) {
        sum = 0u; cnt = 0u; mine = 0u;
#pragma unroll
        for (unsigned j = 0; j < 16; ++j) { const unsigned c = xb_ld(&bar[XB_XCNT(j)]); sum += c; cnt += (c > 0u) ? 1u : 0u; mine = (j == x) ? c : mine; }
        if (sum == G) break;
        __builtin_amdgcn_s_sleep(1);
        if ((++sp & 255u) == 0u) { if (xb_ld(&bar[XB_TMO])) break; if (sp > XB_SPIN_CAP) { atomicAdd(&bar[XB_TMO], 1u); break; } }
    }
    nloc = mine > 0u ? mine : 1u; nx = cnt > 0u ? cnt : 1u;
}
__device__ __forceinline__ void xcd_barrier(const XcdBarrier& b) {
    asm volatile("s_waitcnt vmcnt(0)" ::: "memory");
    __syncthreads();
    if (threadIdx.x == 0) {
        unsigned* bar = b.bar;
        __builtin_amdgcn_s_waitcnt(0);
        unsigned nloc = b.st[0], nx = b.st[1];
        if (nloc == 0u) { xcd_barrier_complete(bar, b.x, nloc, nx); b.st[0] = nloc; b.st[1] = nx; }
        const unsigned old = xb_add(&bar[XB_XSUB(b.x)], 1u);
        const unsigned gen = old / nloc;
        if (old + 1u == (gen + 1u) * nloc) {
            __builtin_amdgcn_fence(__ATOMIC_RELEASE, "agent");
            asm volatile("s_waitcnt vmcnt(0)" ::: "memory");
            const unsigned og = xb_add(&bar[XB_TOP], 1u);
            const unsigned tg = og / nx;
            if (og + 1u == (tg + 1u) * nx) xb_add(&bar[XB_TOPGEN], 1u);
            else XB_SPIN(xb_ld(&bar[XB_TOPGEN]) == tg, bar);
            __builtin_amdgcn_fence(__ATOMIC_ACQUIRE, "agent");
            xb_add(&bar[XB_XGEN(b.x)], 1u);
            asm volatile("s_waitcnt vmcnt(0)" ::: "memory");
        } else {
            XB_SPIN(xb_ld(&bar[XB_XGEN(b.x)]) == gen, bar);
            __builtin_amdgcn_fence(__ATOMIC_ACQUIRE, "agent");
            asm volatile("s_waitcnt vmcnt(0)" ::: "memory");
        }
    }
    __syncthreads();
}

struct Args { const void* in[26]; float* out; unsigned char* ws; int ph_lo, ph_hi, li, pad; };
enum { I_X = 0, I_C, I_POS, I_ADAW, I_ADAB, I_N1G, I_N2G, I_WIN, I_WOUT, I_SGLNG, I_SGLNB, I_SGW, I_SGB, I_PEK, I_PEV, I_CW1K, I_CW2K, I_CW1V, I_CW2V, I_RW, I_RB, I_EW1, I_EB1, I_EW2, I_EB2, I_FING };

#define GAS1 __attribute__((address_space(1)))
#define INP(A_, T_, i_) ({ int ix_ = (i_); asm volatile("" : "+s"(ix_)); (const T_*)(const GAS1 T_*)(A_).in[ix_]; })
struct Frame {
    LAS unsigned char* lds;
    unsigned* ctl;
    unsigned char* ws;
    int tid, lane, wave, vcu, G;
};
#define WSP(type, off) ((type*)(F.ws + (off)))
#define MODP(l, b, part) ((const float*)(F.ctl + CW_MOD) + ((size_t)((l) * 2 + (b)) * 6 + (part)) * 1024)

constexpr int RING_BYTES = 131072;
constexpr int ATT_LDS_BYTES = 147456;
constexpr int LDSCTL_OFF = ATT_LDS_BYTES;
constexpr int MISC_OFF = LDSCTL_OFF + 320;
constexpr int MOE_OFF = MISC_OFF + 128;
constexpr int LDS_BYTES = 163840;

struct EpiProj {
    static constexpr bool PERM = true;
    bf16_t *UG, *VG, *Q, *KC, *VC, *KS, *KW, *VST, *VWT; float* GATES; const float* ROPE; unsigned* kmax; int pn_off;
    __device__ __forceinline__ void operator()(const f32x4 (&acc)[2][2][4][2], const pg8::Unit& u, int wr_, int wc_, int fr_, int fq_) const {
        int t_ = threadIdx.x; asm volatile("" : "+v"(t_)); const int wid_ = __builtin_amdgcn_readfirstlane(t_ >> 6); const int wr = wid_ >> 2, wc = wid_ & 3, fr = t_ & 15, fq = (t_ & 63) >> 4; (void)wr_; (void)wc_; (void)fr_; (void)fq_;
        const int pn = u.pn + pn_off; const int row0 = u.pm * 256 + (u.hs == 2 ? 128 : 0) + wr * 64 + fr; const int b = u.pm >> 5; const int nai = u.hs ? 1 : 2;
        if (pn < 4 || pn == 6) {
#pragma unroll
            for (int ai = 0; ai < 2; ++ai) if (ai < nai)
#pragma unroll
                for (int m = 0; m < 4; ++m) { const size_t r = (size_t)(row0 + ai * 128 + m * 16);
#pragma unroll
                    for (int bj = 0; bj < 2; ++bj) { f32x4 v0 = acc[ai][bj][m][0], v1 = acc[ai][bj][m][1];
                        if (pn < 4) {
#pragma unroll
                            for (int i = 0; i < 4; ++i) { v0[i] = gelu_tanh(v0[i]); v1[i] = gelu_tanh(v1[i]); } }
                        u32x4 w; w.x = cvtpk(v0[0], v0[1]); w.y = cvtpk(v0[2], v0[3]); w.z = cvtpk(v1[0], v1[1]); w.w = cvtpk(v1[2], v1[3]);
                        bf16_t* dst;
                        if (pn < 2) dst = UG + r * 512 + pn * 256 + bj * 128 + wc * 32 + fq * 8;
                        else if (pn < 4) dst = VG + r * 512 + (pn - 2) * 256 + bj * 128 + wc * 32 + fq * 8;
                        else dst = (bj ? VC : KC) + r * 128 + wc * 32 + fq * 8;
                        *(u32x4*)dst = w; } }
        } else if (pn == 4 || pn == 5 || pn == 7) {
            const float sc = (pn == 7) ? 1.f : QSCALE; float nmax = 0.f;
#pragma unroll
            for (int ai = 0; ai < 2; ++ai) if (ai < nai)
#pragma unroll
                for (int m = 0; m < 4; ++m) { const size_t r = (size_t)(row0 + ai * 128 + m * 16);
                    const f32x4* cs = (const f32x4*)(ROPE + (r * 32 + fq * 8) * 2);
                    float o1[8], o2[8], nsq = 0.f;
#pragma unroll
                    for (int n = 0; n < 2; ++n) { const f32x4 c0 = cs[2 * n], c1 = cs[2 * n + 1]; const f32x4 x1 = acc[ai][0][m][n], x2 = acc[ai][1][m][n];
                        const float cc[4] = {c0[0], c0[2], c1[0], c1[2]}, ss[4] = {c0[1], c0[3], c1[1], c1[3]};
#pragma unroll
                        for (int i = 0; i < 4; ++i) { o1[4 * n + i] = (x1[i] * cc[i] - x2[i] * ss[i]) * sc; o2[4 * n + i] = (x2[i] * cc[i] + x1[i] * ss[i]) * sc; nsq += x1[i] * x1[i] + x2[i] * x2[i]; } }
                    u32x4 w1, w2; w1.x = cvtpk(o1[0], o1[1]); w1.y = cvtpk(o1[2], o1[3]); w1.z = cvtpk(o1[4], o1[5]); w1.w = cvtpk(o1[6], o1[7]);
                    w2.x = cvtpk(o2[0], o2[1]); w2.y = cvtpk(o2[2], o2[3]); w2.z = cvtpk(o2[4], o2[5]); w2.w = cvtpk(o2[6], o2[7]);
                    if (pn != 7) { bf16_t* dst = Q + r * 512 + (4 * (pn - 4) + wc) * 64 + fq * 8; *(u32x4*)dst = w1; *(u32x4*)(dst + 32) = w2; }
                    else { bf16_t* img = ((wc < 2) ? KS : KW) + (size_t)(b * 2 + (wc & 1)) * SEQ * 64; const int t = (int)r & (SEQ - 1);
                        *(u32x4*)(img + kfrag_off(t, fq)) = w1; *(u32x4*)(img + kfrag_off(t, 4 + fq)) = w2; }
                    nsq = kg_sum(nsq); nmax = fmaxf(nmax, nsq); asm volatile("" ::: "memory"); }
            if (pn == 7) {
#pragma unroll
                for (int o = 1; o < 16; o <<= 1) nmax = fmaxf(nmax, __shfl_xor(nmax, o));
                if ((threadIdx.x & 63) == 0) atomicMax(kmax + ((wc < 2) ? 0 : 8) + b * 2 + (wc & 1), __float_as_uint(nmax * 1.02f));
            }
        } else if (pn == 8) {
            const int g = wc >> 1; float vmx = 0.f;
#pragma unroll
            for (int ai = 0; ai < 2; ++ai) if (ai < nai)
#pragma unroll
                for (int m = 0; m < 4; ++m) { const int r = row0 + ai * 128 + m * 16; const int s = r & (SEQ - 1);
#pragma unroll
                    for (int bj = 0; bj < 2; ++bj) { bf16_t* img = (bj ? VWT : VST) + (size_t)(b * 2 + g) * SEQ * 64;
#pragma unroll
                        for (int n = 0; n < 2; ++n)
#pragma unroll
                            for (int i = 0; i < 4; ++i) { img[vfrag_off(s, (wc & 1) * 32 + fq * 8 + n * 4 + i)] = (bf16_t)(cvtpk(acc[ai][bj][m][n][i], 0.f) & 0xffffu); if (bj == 0) vmx = fmaxf(vmx, fabsf(acc[ai][0][m][n][i])); } } }
#pragma unroll
            for (int o = 1; o < 64; o <<= 1) vmx = fmaxf(vmx, __shfl_xor(vmx, o));
            if ((threadIdx.x & 63) == 0) atomicMax(kmax + 4 + b * 2 + g, __float_as_uint(vmx * 1.01f));
        } else {
            if (wc == 0 && fq < 3) {
#pragma unroll
                for (int ai = 0; ai < 2; ++ai) if (ai < nai)
#pragma unroll
                    for (int m = 0; m < 4; ++m) { const size_t r = (size_t)(row0 + ai * 128 + m * 16);
#pragma unroll
                        for (int n = 0; n < 2; ++n) { f32x4 v = acc[ai][0][m][n];
#pragma unroll
                            for (int i = 0; i < 4; ++i) v[i] = sigmoidf_(v[i]);
                            *(f32x4*)(GATES + r * 24 + fq * 8 + n * 4) = v; } }
            }
        }
    }
};
struct EpiOut {
    static constexpr bool PERM = false;
    const float* xin; float* xout; const float* g1;
    __device__ __forceinline__ void operator()(const f32x4 (&acc)[2][2][4][2], const pg8::Unit& u, int wr_, int wc_, int fr_, int fq_) const {
        int t_ = threadIdx.x; asm volatile("" : "+v"(t_)); const int wid_ = __builtin_amdgcn_readfirstlane(t_ >> 6); const int wr = wid_ >> 2, wc = wid_ & 3, fr = t_ & 15, fq = (t_ & 63) >> 4; (void)wr_; (void)wc_; (void)fr_; (void)fq_;
        const int row0 = u.pm * 256 + (u.hs == 2 ? 128 : 0) + wr * 64 + fr; const int b = u.pm >> 5; const int col0 = u.pn * 256 + wc * 32 + fq * 4; const int nai = u.hs ? 1 : 2;
        const float* gb = g1 + (size_t)b * 6144 + 2048;
        f32x4 gv[2][2];
#pragma unroll
        for (int bj = 0; bj < 2; ++bj)
#pragma unroll
            for (int n = 0; n < 2; ++n) gv[bj][n] = *(const f32x4*)(gb + col0 + bj * 128 + n * 16);
#pragma unroll
        for (int ai = 0; ai < 2; ++ai) if (ai < nai)
#pragma unroll
            for (int m = 0; m < 4; ++m) { const size_t off = (size_t)(row0 + ai * 128 + m * 16) * DM + col0;
#pragma unroll
                for (int bj = 0; bj < 2; ++bj)
#pragma unroll
                    for (int n = 0; n < 2; ++n) { const f32x4 xi = *(const f32x4*)(xin + off + bj * 128 + n * 16); *(f32x4*)(xout + off + bj * 128 + n * 16) = xi + gv[bj][n] * acc[ai][bj][m][n]; } }
    }
};
struct EpiSwiglu {
    static constexpr bool PERM = true;
    unsigned char* ACT; const float* b1;
    __device__ __forceinline__ void operator()(const f32x4 (&acc)[2][2][4][2], const pg8::Unit& u, int wr_, int wc_, int fr_, int fq_) const {
        int t_ = threadIdx.x; asm volatile("" : "+v"(t_)); const int wid_ = __builtin_amdgcn_readfirstlane(t_ >> 6); const int wr = wid_ >> 2, wc = wid_ & 3, fr = t_ & 15, fq = (t_ & 63) >> 4; (void)wr_; (void)wc_; (void)fr_; (void)fq_;
        const int row0 = u.pm * 256 + (u.hs == 2 ? 128 : 0) + wr * 64 + fr; const int j0 = u.pnl * 128 + wc * 32 + fq * 8; const int nai = u.hs ? 1 : 2;
        const float* bb = b1 + (size_t)u.e * 2048 + j0;
        f32x4 bg[2], bl[2];
#pragma unroll
        for (int n = 0; n < 2; ++n) { bg[n] = *(const f32x4*)(bb + n * 4); bl[n] = *(const f32x4*)(bb + 1024 + n * 4); }
#pragma unroll
        for (int ai = 0; ai < 2; ++ai) if (ai < nai)
#pragma unroll
            for (int m = 0; m < 4; ++m) { float o[8];
#pragma unroll
                for (int n = 0; n < 2; ++n) { const f32x4 gl = acc[ai][0][m][n] + bg[n], ln = acc[ai][1][m][n] + bl[n];
#pragma unroll
                    for (int i = 0; i < 4; ++i) { const float gg = fminf(gl[i], 7.f), ll = fminf(fmaxf(ln[i], -7.f), 7.f); o[n * 4 + i] = gg * sigmoidf_(1.702f * gg) * (ll + 1.f); } }
                u32x2 w; w.x = cvt4_fp8(o[0], o[1], o[2], o[3]); w.y = cvt4_fp8(o[4], o[5], o[6], o[7]);
                *(u32x2*)(ACT + (size_t)(row0 + ai * 128 + m * 16) * FF + j0) = w; }
    }
};
struct EpiDown {
    static constexpr bool PERM = true;
    unsigned char* YR; const float* b2;
    __device__ __forceinline__ void operator()(const f32x4 (&acc)[2][2][4][2], const pg8::Unit& u, int wr_, int wc_, int fr_, int fq_) const {
        int t_ = threadIdx.x; asm volatile("" : "+v"(t_)); const int wid_ = __builtin_amdgcn_readfirstlane(t_ >> 6); const int wr = wid_ >> 2, wc = wid_ & 3, fr = t_ & 15, fq = (t_ & 63) >> 4; (void)wr_; (void)wc_; (void)fr_; (void)fq_;
        const int row0 = u.pm * 256 + (u.hs == 2 ? 128 : 0) + wr * 64 + fr; const int c0 = u.pnl * 256 + wc * 32 + fq * 8; const int nai = u.hs ? 1 : 2;
        const float* bb = b2 + (size_t)u.e * 1024 + c0;
        f32x4 bv[2][2];
#pragma unroll
        for (int bj = 0; bj < 2; ++bj)
#pragma unroll
            for (int n = 0; n < 2; ++n) bv[bj][n] = *(const f32x4*)(bb + bj * 128 + n * 4);
#pragma unroll
        for (int ai = 0; ai < 2; ++ai) if (ai < nai)
#pragma unroll
            for (int m = 0; m < 4; ++m)
#pragma unroll
                for (int bj = 0; bj < 2; ++bj) { const f32x4 v0 = acc[ai][bj][m][0] + bv[bj][0], v1 = acc[ai][bj][m][1] + bv[bj][1];
                    u32x2 w; w.x = cvt4_fp8(v0[0], v0[1], v0[2], v0[3]); w.y = cvt4_fp8(v1[0], v1[1], v1[2], v1[3]);
                    *(u32x2*)(YR + (size_t)(row0 + ai * 128 + m * 16) * DM + c0 + bj * 128) = w; }
    }
};

__device__ __forceinline__ void tr_item(const float* W, int ldn, int k0, int c0, int nvalid, bf16_t* WT, int K, int drow0, LAS float* scr, int lane) {
    const int nn = lane & 31;
#pragma unroll 8
    for (int i = 0; i < 32; ++i) { const int kk = 2 * i + (lane >> 5); scr[kk * 33 + nn] = (nn < nvalid) ? W[(size_t)(k0 + kk) * ldn + c0 + nn] : 0.f; }
    LDS_WAIT(); asm volatile("" ::: "memory");
    const int c = lane & 7;
#pragma unroll
    for (int j = 0; j < 4; ++j) { const int n = (lane >> 3) + 8 * j; const LAS float* s = scr + (8 * c) * 33 + n;
        u32x4 o; o.x = cvtpk(s[0 * 33], s[1 * 33]); o.y = cvtpk(s[2 * 33], s[3 * 33]); o.z = cvtpk(s[4 * 33], s[5 * 33]); o.w = cvtpk(s[6 * 33], s[7 * 33]);
        *(u32x4*)(WT + (size_t)(drow0 + n) * K + k0 + 8 * c) = o; }
    LDS_WAIT(); asm volatile("" ::: "memory");
}
template <bool NTS> __device__ __forceinline__ void tr_item8(const float* W, int ldn, int k0, int c0, unsigned char* W8, int K, int drow0, LAS float* scr, int lane, int nvalid = 32) {
    const int nn = lane & 31;
#pragma unroll 8
    for (int i = 0; i < 32; ++i) { const int kk = 2 * i + (lane >> 5); scr[kk * 33 + nn] = (nn < nvalid) ? __builtin_nontemporal_load(W + (size_t)(k0 + kk) * ldn + c0 + nn) * W8SCALE : 0.f; }
    LDS_WAIT(); asm volatile("" ::: "memory");
    const int c = lane & 3;
#pragma unroll
    for (int j = 0; j < 2; ++j) { const int n = (lane >> 2) + 16 * j; const LAS float* s = scr + (16 * c) * 33 + n;
        u32x4 o; o.x = cvt4_fp8(s[0 * 33], s[1 * 33], s[2 * 33], s[3 * 33]); o.y = cvt4_fp8(s[4 * 33], s[5 * 33], s[6 * 33], s[7 * 33]);
        o.z = cvt4_fp8(s[8 * 33], s[9 * 33], s[10 * 33], s[11 * 33]); o.w = cvt4_fp8(s[12 * 33], s[13 * 33], s[14 * 33], s[15 * 33]);
        if (NTS) __builtin_nontemporal_store(o, (u32x4*)(W8 + (size_t)(drow0 + n) * K + k0 + 16 * c)); else *(u32x4*)(W8 + (size_t)(drow0 + n) * K + k0 + 16 * c) = o; }
    LDS_WAIT(); asm volatile("" ::: "memory");
}
__device__ __forceinline__ void win_src(int p, int& c0, int& nvalid) {
    const int pn = p >> 8; nvalid = 32;
    if (pn < 4 || pn == 6) { c0 = p; }
    else if (pn == 4 || pn == 5) { const int pp = p - 1024 - 256 * (pn - 4), bj = pp >> 7, j = pp & 127; c0 = 1024 + (4 * (pn - 4) + (j >> 5)) * 64 + bj * 32; }
    else if (pn == 7) { const int pp = p - 1792, bj = pp >> 7, j = pp & 127, which = j >> 6, g = (j >> 5) & 1; c0 = (which ? 2048 : 1792) + g * 64 + bj * 32; }
    else if (pn == 8) { const int pp = p - 2048, bj = pp >> 7, j = pp & 127; c0 = (bj ? 2176 : 1920) + j; }
    else { const int pp = p - 2304; c0 = 2304 + pp; nvalid = 24 - pp; nvalid = nvalid < 0 ? 0 : (nvalid > 32 ? 32 : nvalid); if (nvalid == 0) c0 = 0; }
}
__device__ __forceinline__ void phase_prologue(Frame& F, const Args& a) {
    LAS float* scr = (LAS float*)(F.lds + F.wave * 8704);
    const int gw = F.vcu * NWAVES + F.wave, NGW = F.G * NWAVES; const int lane = F.lane;
    {
        const float* c = INP(a, float, I_C); const float* adaw = INP(a, float, I_ADAW); const float* adab = INP(a, float, I_ADAB);
        float* mod = (float*)(F.ctl + CW_MOD);
        LAS float* red = (LAS float*)(F.lds + 8 * 8704);
        for (int it = F.vcu; it < 2 * 24; it += F.G) {
            const int l = it / 24, nb = it % 24;
            const float* wp = adaw + ((size_t)l * 1024 + F.wave * 128) * 6144 + nb * 256 + lane * 4;
            f32x4 a0 = {0.f, 0.f, 0.f, 0.f}, a1 = a0;
#pragma unroll 4
            for (int k = 0; k < 128; ++k) { const f32x4 w = __builtin_nontemporal_load((const f32x4*)(wp + (size_t)k * 6144));
                const float c0 = c[F.wave * 128 + k], c1 = c[1024 + F.wave * 128 + k]; const float s0 = c0 * sigmoidf_(c0), s1 = c1 * sigmoidf_(c1);
                a0 += w * s0; a1 += w * s1; }
            *(LAS f32x4*)(red + (F.wave * 2 + 0) * 256 + lane * 4) = a0; *(LAS f32x4*)(red + (F.wave * 2 + 1) * 256 + lane * 4) = a1;
            __syncthreads();
            { const int b = F.tid >> 8, col = F.tid & 255; float sum = adab[(size_t)l * 6144 + nb * 256 + col];
#pragma unroll
              for (int ww = 0; ww < 8; ++ww) sum += red[(ww * 2 + b) * 256 + col];
              mod[((size_t)l * 2 + b) * 6144 + nb * 256 + col] = sum; }
            __syncthreads();
        }
    }
    {
        const float* win = INP(a, float, I_WIN);
        unsigned char* Win8 = WSP(unsigned char, WS_WIN8);
        for (int it = gw; it < 2 * 16 * 80; it += NGW) { const int l = it / 1280, kb = (it % 1280) / 80, nb = it % 80; int c0, nv; win_src(nb * 32, c0, nv);
            tr_item8<false>(win + (size_t)l * 1024 * PIN, PIN, kb * 64, c0, Win8 + (size_t)l * 2560 * 1024, 1024, nb * 32, scr, lane, nv); }
        const float* wout = INP(a, float, I_WOUT); bf16_t* WoutT = WSP(bf16_t, WS_WOUT);
        for (int it = gw; it < 2 * 16 * 32; it += NGW) { const int l = it / 512, kb = (it % 512) / 32, nb = it % 32;
            tr_item(wout + (size_t)l * 1024 * 1024, 1024, kb * 64, nb * 32, 32, WoutT + (size_t)l * 1024 * 1024, 1024, nb * 32, scr, lane); }
        bf16_t* CW1 = WSP(bf16_t, WS_CW1);
        for (int it = gw; it < 2 * 2 * 32 * 2; it += NGW) { const int l = it / 128, which = (it / 64) & 1, kb = (it % 64) / 2, nb = it & 1;
            const float* src = INP(a, float, which ? I_CW1V : I_CW1K) + (size_t)l * 2048 * 64;
            tr_item(src, 64, kb * 64, nb * 32, 32, CW1 + (size_t)(l * 2 + which) * 64 * 2048, 2048, nb * 32, scr, lane); }
        const float* ew1 = INP(a, float, I_EW1); unsigned char* W1T = WSP(unsigned char, WS_W1T);
        for (int it = gw; it < 2 * 32 * 16 * 64; it += NGW) { const int le = it >> 10, kb = (it >> 6) & 15, nb = it & 63; const int p = nb * 32, tile = p >> 8, bj = (p >> 7) & 1, j = p & 127;
            if (le < 32) tr_item8<false>(ew1 + (size_t)le * 1024 * 2048, 2048, kb * 64, bj * 1024 + tile * 128 + j, W1T + (size_t)le * 2048 * 1024, 1024, p, scr, lane);
            else tr_item8<true>(ew1 + (size_t)le * 1024 * 2048, 2048, kb * 64, bj * 1024 + tile * 128 + j, W1T + (size_t)le * 2048 * 1024, 1024, p, scr, lane); }
        const float* ew2 = INP(a, float, I_EW2); unsigned char* W2T = WSP(unsigned char, WS_W2T);
        for (int it = gw; it < 2 * 32 * 16 * 32; it += NGW) { const int le = it >> 9, kb = (it >> 5) & 15, nb = it & 31;
            if (le < 32) tr_item8<false>(ew2 + (size_t)le * 1024 * 1024, 1024, kb * 64, nb * 32, W2T + (size_t)le * 1024 * 1024, 1024, nb * 32, scr, lane);
            else tr_item8<true>(ew2 + (size_t)le * 1024 * 1024, 1024, kb * 64, nb * 32, W2T + (size_t)le * 1024 * 1024, 1024, nb * 32, scr, lane); }
    }
    {
        const int gt = (F.vcu * NWAVES + F.wave) * 64 + lane, NGT = NGW * 64;
        const float* sgw = INP(a, float, I_SGW); bf16_t* SGW = WSP(bf16_t, WS_SGW);
        for (int i = gt; i < 2 * 8 * 128 * 128; i += NGT) { const int s = i & 127, t = (i >> 7) & 127; SGW[i] = (bf16_t)(cvtpk(s <= t ? sgw[i] : 0.f, 0.f) & 0xffffu); }
        const int* pos = INP(a, int, I_POS); float* rope = WSP(float, WS_ROPE);
        for (int i = gt; i < T * 32; i += NGT) { const int tok = i >> 5, d = i & 31;
            const double inv = exp2(-(double)d * (13.287712379549449 / 32.0));
            const double rv = (double)pos[tok] * inv * 0.15915494309189535; const float fr = (float)(rv - __builtin_rint(rv));
            rope[2 * i] = __builtin_amdgcn_cosf(fr); rope[2 * i + 1] = __builtin_amdgcn_sinf(fr); }
        bf16_t* H = WSP(bf16_t, WS_H);
        for (int i = gt; i < 1024; i += NGT) { H[(size_t)T * 1024 + i] = 0; WSP(unsigned char, WS_H8)[(size_t)T * 1024 + i] = 0; }
        bf16_t* KCMP = WSP(bf16_t, WS_KCMP); bf16_t* VCT = WSP(bf16_t, WS_VCT);
        for (int i = gt; i < 2 * 2 * 64; i += NGT) { const int b = i >> 7, g = (i >> 6) & 1, d = i & 63; KCMP[(size_t)(b * 2 + g) * 512 * 64 + kfrag_off(511, d >> 3) + (d & 7)] = 0; VCT[(size_t)(b * 2 + g) * 512 * 64 + vfrag_off(511, d)] = 0; }
    }
    {
        float* cb = WSP(float, WS_MISC);
        for (int it = gw; it < 2 * 2 * 64; it += NGW) { const int l = it >> 7, which = (it >> 6) & 1, n = it & 63;
            const float* pe = INP(a, float, which ? I_PEV : I_PEK) + (size_t)l * 2048; const float* w1 = INP(a, float, which ? I_CW1V : I_CW1K) + (size_t)l * 2048 * 64;
            float s = 0.f; for (int k = lane; k < 2048; k += 64) s += pe[k] * w1[(size_t)k * 64 + n];
            s = wave_sum(s); if (lane == 0) cb[it] = s; }
    }
}

struct RowV { f32x4 v[4]; };
__device__ __forceinline__ RowV row_load(const float* p, int lane) { RowV r; const f32x4* q = (const f32x4*)p + lane;
#pragma unroll
    for (int j = 0; j < 4; ++j) r.v[j] = q[64 * j]; return r; }
__device__ __forceinline__ float row_ssq(const RowV& r) { float s = 0.f;
#pragma unroll
    for (int j = 0; j < 4; ++j) s += (r.v[j].x * r.v[j].x + r.v[j].y * r.v[j].y) + (r.v[j].z * r.v[j].z + r.v[j].w * r.v[j].w); return wave_sum(s); }
__device__ __forceinline__ void row_norm_store(const RowV& x, float rstd, const float* g, const float* sc, const float* sh, bf16_t* orow, int lane) {
    u32x2* o8 = (u32x2*)orow + lane;
#pragma unroll
    for (int j = 0; j < 4; ++j) { const f32x4 gg = ((const f32x4*)g)[lane + 64 * j], ss = ((const f32x4*)sc)[lane + 64 * j], hh = ((const f32x4*)sh)[lane + 64 * j];
        const f32x4 y = x.v[j] * rstd * gg * (ss + 1.f) + hh; u32x2 w; w.x = cvtpk(y.x, y.y); w.y = cvtpk(y.z, y.w); o8[64 * j] = w; }
}
__device__ __forceinline__ void quad_tr(unsigned (&a)[4], int lane) {
    const bool b0 = lane & 1, b1 = lane & 2;
    { const unsigned x = b0 ? a[0] : a[1]; const unsigned y = __builtin_amdgcn_update_dpp(0u, x, 0xB1, 0xF, 0xF, true); if (b0) a[0] = y; else a[1] = y; }
    { const unsigned x = b0 ? a[2] : a[3]; const unsigned y = __builtin_amdgcn_update_dpp(0u, x, 0xB1, 0xF, 0xF, true); if (b0) a[2] = y; else a[3] = y; }
    { const unsigned x = b1 ? a[0] : a[2]; const unsigned y = __builtin_amdgcn_update_dpp(0u, x, 0x4E, 0xF, 0xF, true); if (b1) a[0] = y; else a[2] = y; }
    { const unsigned x = b1 ? a[1] : a[3]; const unsigned y = __builtin_amdgcn_update_dpp(0u, x, 0x4E, 0xF, 0xF, true); if (b1) a[1] = y; else a[3] = y; }
}
__device__ __forceinline__ void row_norm_store8(const RowV& x, float rstd, const float* g, const float* sc, const float* sh, unsigned char* orow, int lane) {
    unsigned a[4];
#pragma unroll
    for (int j = 0; j < 4; ++j) { const f32x4 gg = ((const f32x4*)g)[lane + 64 * j], ss = ((const f32x4*)sc)[lane + 64 * j], hh = ((const f32x4*)sh)[lane + 64 * j];
        const f32x4 y = x.v[j] * rstd * gg * (ss + 1.f) + hh; a[j] = cvt4_fp8(y.x, y.y, y.z, y.w); }
    quad_tr(a, lane);
    *(u32x4*)(orow + 256 * (lane & 3) + 16 * (lane >> 2)) = (u32x4){a[0], a[1], a[2], a[3]};
}
__device__ __forceinline__ int expert_block_prefix(const unsigned* cnt, int lane) {
    int nb = (lane < NE) ? (int)((cnt[lane] + 255u) >> 8) : 0; int inc = nb;
#pragma unroll
    for (int o = 1; o < 32; o <<= 1) { const int t = __shfl_up(inc, o); if ((lane & 31) >= o) inc += t; }
    return inc - nb;
}
__device__ __forceinline__ void phase_n1_first(Frame& F, const Args& a) {
    const int gw = F.vcu * NWAVES + F.wave, NGW = F.G * NWAVES; const int lane = F.lane;
    const float* x = INP(a, float, I_X); const float* g = INP(a, float, I_N1G); bf16_t* H = WSP(bf16_t, WS_H); unsigned char* H8 = WSP(unsigned char, WS_H8);
    for (int m = gw; m < T; m += 2 * NGW) { const int m2 = m + NGW; const int b = m >> 13, b2 = m2 >> 13;
        const RowV r = row_load(x + (size_t)m * DM, lane); const RowV r2 = row_load(x + (size_t)m2 * DM, lane);
        const float rstd = 1.f / sqrtf(row_ssq(r) * (1.f / DM) + NORM_EPS), rstd2 = 1.f / sqrtf(row_ssq(r2) * (1.f / DM) + NORM_EPS);
        row_norm_store8(r, rstd, g, MODP(0, b, 1), MODP(0, b, 0), H8 + (size_t)m * DM, lane);
        row_norm_store8(r2, rstd2, g, MODP(0, b2, 1), MODP(0, b2, 0), H8 + (size_t)m2 * DM, lane); }
    float* RWP = WSP(float, WS_RWP); float* RBP = WSP(float, WS_MISC + 4096);
    const float* rw = INP(a, float, I_RW); const float* rb = INP(a, float, I_RB); const float* n2g = INP(a, float, I_N2G);
    const int gt = gw * 64 + lane, NGT = NGW * 64;
    for (int i = gt; i < 2 * 2 * 1024 * 32; i += NGT) { const int l = i >> 16, b = (i >> 15) & 1, k = (i >> 5) & 1023, e = i & 31;
        RWP[i] = n2g[l * 1024 + k] * (1.f + MODP(l, b, 4)[k]) * rw[((size_t)l * 1024 + k) * 32 + e]; }
    for (int it = gw; it < 2 * 2 * 32; it += NGW) { const int l = it >> 6, b = (it >> 5) & 1, e = it & 31; float s = 0.f;
        for (int k = lane; k < 1024; k += 64) s += MODP(l, b, 3)[k] * rw[((size_t)l * 1024 + k) * 32 + e];
        s = wave_sum(s); if (lane == 0) RBP[it] = s + rb[l * 32 + e]; }
}
__device__ __forceinline__ void phase_combine(Frame& F, const Args& a, int l) {
    const int gw = F.vcu * NWAVES + F.wave, NGW = F.G * NWAVES; const int lane = F.lane;
    float* XR = WSP(float, WS_XR); bf16_t* H = WSP(bf16_t, WS_H); const unsigned char* YR = WSP(unsigned char, WS_YROWS);
    const int* ASG = WSP(int, WS_ASG); const float* G4 = WSP(float, WS_GATE4);
    const int myprefix = expert_block_prefix(F.ctl + CW_CNT + l * 32, lane);
    const bool last = (l == DEPTH - 1);
    const float* g = last ? INP(a, float, I_FING) : INP(a, float, I_N1G) + (l + 1) * 1024;
#define COMB_LOAD(R_, WV_, GT_, M_) do { const int4 as4_ = *(const int4*)(ASG + (M_) * 4); const f32x4 gt4_ = *(const f32x4*)(G4 + (M_) * 4); \
        R_ = row_load(XR + (size_t)(M_) * DM, lane); const int asv_[4] = {as4_.x, as4_.y, as4_.z, as4_.w}; GT_[0] = gt4_.x; GT_[1] = gt4_.y; GT_[2] = gt4_.z; GT_[3] = gt4_.w; \
        _Pragma("unroll") for (int k = 0; k < 4; ++k) { const int e = asv_[k] >> 16, slot = asv_[k] & 0xffff; const int blk = __shfl(myprefix, e); \
            const unsigned* yr = (const unsigned*)(YR + ((size_t)blk * 256 + slot) * DM) + lane; _Pragma("unroll") for (int j = 0; j < 4; ++j) WV_[k][j] = __builtin_nontemporal_load(yr + 64 * j); } } while (0)
#define COMB_FINISH(R_, WV_, GT_, M_) do { const int b = (M_) >> 13; f32x4 y[4]; \
        _Pragma("unroll") for (int j = 0; j < 4; ++j) y[j] = (f32x4){0.f, 0.f, 0.f, 0.f}; \
        _Pragma("unroll") for (int k = 0; k < 4; ++k) _Pragma("unroll") for (int j = 0; j < 4; ++j) { const int w = (int)WV_[k][j]; const f32x2 lo_ = __builtin_amdgcn_cvt_pk_f32_fp8(w, false), hi_ = __builtin_amdgcn_cvt_pk_f32_fp8(w, true); y[j] += (f32x4){lo_.x, lo_.y, hi_.x, hi_.y} * GT_[k]; } \
        const float* g2 = MODP(l, b, 5); \
        _Pragma("unroll") for (int j = 0; j < 4; ++j) R_.v[j] += ((const f32x4*)g2)[lane + 64 * j] * y[j]; \
        const float rstd = 1.f / sqrtf(row_ssq(R_) * (1.f / DM) + NORM_EPS); \
        if (last) { f32x4* o = (f32x4*)(a.out + (size_t)(M_) * DM) + lane; _Pragma("unroll") for (int j = 0; j < 4; ++j) o[64 * j] = R_.v[j] * rstd * ((const f32x4*)g)[lane + 64 * j]; } \
        else { f32x4* xo = (f32x4*)(XR + (size_t)(M_) * DM) + lane; _Pragma("unroll") for (int j = 0; j < 4; ++j) xo[64 * j] = R_.v[j]; \
            row_norm_store8(R_, rstd, g, MODP(l + 1, b, 1), MODP(l + 1, b, 0), WSP(unsigned char, WS_H8) + (size_t)(M_) * DM, lane); } } while (0)
    for (int m = gw; m < T; m += 2 * NGW) { const int m2 = m + NGW;
        RowV rA, rB; unsigned wA[4][4], wB[4][4]; float gA[4], gB[4];
        COMB_LOAD(rA, wA, gA, m); COMB_LOAD(rB, wB, gB, m2);
        COMB_FINISH(rA, wA, gA, m); COMB_FINISH(rB, wB, gB, m2);
    }
#undef COMB_LOAD
#undef COMB_FINISH
}
__device__ __forceinline__ void compress_item(Frame& F, const Args& a, int l, int item) {
    const int which = item >> 7, b = (item >> 6) & 1, g = (item >> 5) & 1, n0 = (item & 31) * 16;
    const int lane = F.lane, w = F.wave, r16 = lane & 15, kg = lane >> 4;
    const bf16_t* src = WSP(bf16_t, which ? WS_VC : WS_KC);
    const bf16_t* W1 = WSP(bf16_t, WS_CW1) + (size_t)(l * 2 + which) * 64 * 2048;
    LAS float* red = (LAS float*)F.lds;
    LAS float* hid = (LAS float*)(F.lds + 32768);
    f32x4 acc[4];
#pragma unroll
    for (int i = 0; i < 4; ++i) acc[i] = (f32x4){0.f, 0.f, 0.f, 0.f};
    const int n = n0 + r16; const bool nval = n < NCMP;
#pragma unroll 2
    for (int ks = 0; ks < 8; ++ks) { const int k = 256 * w + 32 * ks + 8 * kg; const int li = k >> 6, d = k & 63;
        bf16x8 af = (bf16x8){0, 0, 0, 0, 0, 0, 0, 0};
        if (nval) af = *(const bf16x8*)(src + ((size_t)b * SEQ + 16 * n + li) * 128 + g * 64 + d);
#pragma unroll
        for (int nt = 0; nt < 4; ++nt) { const bf16x8 bf = *(const bf16x8*)(W1 + (size_t)(nt * 16 + r16) * 2048 + k); acc[nt] = __builtin_amdgcn_mfma_f32_16x16x32_bf16(af, bf, acc[nt], 0, 0, 0); } }
#pragma unroll
    for (int nt = 0; nt < 4; ++nt)
#pragma unroll
        for (int i = 0; i < 4; ++i) red[(w * 16 + 4 * kg + i) * 64 + nt * 16 + r16] = acc[nt][i];
    __syncthreads();
    const float* cb = WSP(float, WS_MISC) + (l * 2 + which) * 64;
    for (int i = F.tid; i < 1024; i += NTHREADS) { float s = cb[i & 63];
#pragma unroll
        for (int ww = 0; ww < 8; ++ww) s += red[ww * 1024 + i];
        hid[i] = gelu_tanh(s); }
    { const float* w2 = INP(a, float, which ? I_CW2V : I_CW2K) + (size_t)l * 4096; LAS f32x4* w2s4 = (LAS f32x4*)(F.lds + 40960);
      for (int i = F.tid; i < 1024; i += NTHREADS) w2s4[i] = ((const f32x4*)w2)[i]; }
    __syncthreads();
    {
        const int nn = F.tid >> 5, c = F.tid & 31; LAS float* w2s = (LAS float*)(F.lds + 40960);
        float o1 = 0.f, o2 = 0.f;
#pragma unroll 16
        for (int k = 0; k < 64; ++k) { const float h = hid[nn * 64 + k]; o1 += h * w2s[k * 64 + c]; o2 += h * w2s[k * 64 + c + 32]; }
        const int np = n0 + nn; float nsq_ = 0.f;
        if (np < NCMP) {
            if (!which) { const float* cs = WSP(float, WS_ROPE) + (((size_t)b * SEQ + 16 * np + 31) * 32 + c) * 2; const float cc = cs[0], ss = cs[1];
                const float r1 = o1 * cc - o2 * ss, r2 = o2 * cc + o1 * ss;
                bf16_t* img = WSP(bf16_t, WS_KCMP) + (size_t)(b * 2 + g) * 512 * 64; img[kfrag_off(np, c >> 3) + (c & 7)] = (bf16_t)(cvtpk(r1, 0.f) & 0xffffu); img[kfrag_off(np, 4 + (c >> 3)) + (c & 7)] = (bf16_t)(cvtpk(r2, 0.f) & 0xffffu);
                nsq_ = r1 * r1 + r2 * r2;
            } else { bf16_t* img = WSP(bf16_t, WS_VCT) + (size_t)(b * 2 + g) * 512 * 64; img[vfrag_off(np, c)] = (bf16_t)(cvtpk(o1, 0.f) & 0xffffu); img[vfrag_off(np, c + 32)] = (bf16_t)(cvtpk(o2, 0.f) & 0xffffu); }
        }
        if (!which) {
            float mx = quad_sum(nsq_);
            mx += __uint_as_float(__builtin_amdgcn_update_dpp(0u, __float_as_uint(mx), 0x141, 0xF, 0xF, true)); mx += __uint_as_float(__builtin_amdgcn_update_dpp(0u, __float_as_uint(mx), 0x140, 0xF, 0xF, true));
            mx = x16_sum(mx);
            mx = x32_max(mx);
            if (F.lane == 0) atomicMax(F.ctl + CW_KMAX + l * 16 + 12 + b * 2 + g, __float_as_uint(mx * 1.02f));
        }
    }
    __syncthreads();
}
__device__ __forceinline__ void sgu_item(Frame& F, const Args& a, int l, int ch) {
    const size_t tok0 = (size_t)ch * 128;
    const int lane = F.lane, w = F.wave, r16 = lane & 15, kg = lane >> 4;
    const bf16_t* VG = WSP(bf16_t, WS_VG); const bf16_t* UG = WSP(bf16_t, WS_UG); bf16_t* Y = WSP(bf16_t, WS_Y);
    LAS float* stats = (LAS float*)F.lds;
    LAS bf16_t* vnT = (LAS bf16_t*)(F.lds + 1024);
    constexpr int VP = 136;
    static_assert(1024 + 8 * 64 * 136 * 2 <= ATT_LDS_BYTES, "SGU LDS map");
    {
        u32x4 vrow[16];
#pragma unroll
        for (int tt = 0; tt < 16; ++tt) vrow[tt] = *(const u32x4*)(VG + (tok0 + 16 * w + tt) * 512 + lane * 8);
#pragma unroll
        for (int tt = 0; tt < 16; ++tt) { const int s = 16 * w + tt; const u32x4 v = vrow[tt];
            const float f[8] = {bflo(v.x), bfhi(v.x), bflo(v.y), bfhi(v.y), bflo(v.z), bfhi(v.z), bflo(v.w), bfhi(v.w)};
            float sm = 0.f;
#pragma unroll
            for (int i = 0; i < 8; ++i) sm += f[i];
            const float mu = wave_sum(sm) * (1.f / 512.f); float q = 0.f;
#pragma unroll
            for (int i = 0; i < 8; ++i) q += (f[i] - mu) * (f[i] - mu);
            const float var = wave_sum(q) * (1.f / 512.f);
            if (lane == 0) { stats[2 * s] = mu; stats[2 * s + 1] = 1.f / sqrtf(var + NORM_EPS); } }
    }
    __syncthreads();
    {
        const int s = F.tid & 127, hq = F.tid >> 7; const float mu = stats[2 * s], rs = stats[2 * s + 1];
#pragma unroll
        for (int hp = 0; hp < 2; ++hp) { const int h = hq + 4 * hp; const int cbase = h * 64;
            const float* lg = INP(a, float, I_SGLNG) + l * 512 + cbase; const float* lb = INP(a, float, I_SGLNB) + l * 512 + cbase;
#pragma unroll 2
            for (int d0 = 0; d0 < 64; d0 += 8) { const u32x4 v = *(const u32x4*)(VG + (tok0 + s) * 512 + cbase + d0);
                const float f[8] = {bflo(v.x), bfhi(v.x), bflo(v.y), bfhi(v.y), bflo(v.z), bfhi(v.z), bflo(v.w), bfhi(v.w)};
#pragma unroll
                for (int i = 0; i < 8; ++i) vnT[(h * 64 + d0 + i) * VP + s] = (bf16_t)(cvtpk((f[i] - mu) * rs * lg[d0 + i] + lb[d0 + i], 0.f) & 0xffffu); } }
    }
    __syncthreads();
    {
        const int h = w;
        const bf16_t* Wm = WSP(bf16_t, WS_SGW) + (size_t)(l * 8 + h) * 128 * 128; const float* bs = INP(a, float, I_SGB) + (size_t)(l * 8 + h) * 128;
#pragma nounroll
        for (int tt = 0; tt < 8; ++tt) {
            const int t = 16 * tt + r16; const float bb = bs[t];
            bf16x8 bw[4]; u32x2 ugv[4];
#pragma unroll
            for (int ks = 0; ks < 4; ++ks) bw[ks] = *(const bf16x8*)(Wm + (size_t)t * 128 + 32 * ks + 8 * kg);
#pragma unroll
            for (int dt = 0; dt < 4; ++dt) ugv[dt] = *(const u32x2*)(UG + (tok0 + t) * 512 + h * 64 + dt * 16 + 4 * kg);
            f32x4 acc[4];
#pragma unroll
            for (int i = 0; i < 4; ++i) acc[i] = (f32x4){0.f, 0.f, 0.f, 0.f};
            const int nks = (16 * tt + 15) / 32 + 1;
#pragma unroll
            for (int ks = 0; ks < 4; ++ks) { if (ks < nks) {
#pragma unroll
                for (int dt = 0; dt < 4; ++dt) { const bf16x8 afr = *(const LAS bf16x8*)(vnT + (h * 64 + dt * 16 + r16) * VP + 32 * ks + 8 * kg); acc[dt] = __builtin_amdgcn_mfma_f32_16x16x32_bf16(afr, bw[ks], acc[dt], 0, 0, 0); } } }
#pragma unroll
            for (int dt = 0; dt < 4; ++dt) { const u32x2 uu = ugv[dt];
                u32x2 o; o.x = cvtpk(bflo(uu.x) * (acc[dt][0] + bb), bfhi(uu.x) * (acc[dt][1] + bb)); o.y = cvtpk(bflo(uu.y) * (acc[dt][2] + bb), bfhi(uu.y) * (acc[dt][3] + bb));
                *(u32x2*)(Y + (tok0 + t) * 1024 + h * 64 + dt * 16 + 4 * kg) = o; }
        }
    }
    __syncthreads();
}
namespace att {
constexpr int OSP = 65;
constexpr int L_OH = 0;
constexpr int L_OL = 66560;
constexpr int L_LS = 133120;
constexpr int L_MREF = L_LS + 2048;
constexpr int USP = 129;
constexpr int L_SEL = L_MREF + 1024;
constexpr int L_CNT = L_SEL + 1024;
constexpr int L_LIST = L_CNT + 512;
constexpr int L_WCTR = L_LIST + 8192;
static_assert(L_WCTR + 16 <= ATT_LDS_BYTES, "attention LDS map");

struct Ptrs { const bf16_t *Q, *KS, *KW, *VST, *VWT, *KCMP, *VCT; const float* GATES; bf16_t* Y; float* YPART; float kmax, vmax, kwmax, kcmax; };

#define MFMA16(a, b, c) __builtin_amdgcn_mfma_f32_16x16x32_bf16(a, b, c, 0, 0, 0)

__device__ __forceinline__ void attn_unit(Frame& F, const Ptrs& P, int b, int g, int qb) {
    LAS unsigned char* lds = F.lds;
    const int tid = F.tid, lane = F.lane, w = F.wave, r16 = lane & 15, kg = lane >> 4;
    LAS int* Oh = (LAS int*)(lds + L_OH); LAS int* Ol = (LAS int*)(lds + L_OL); LAS float* imp = (LAS float*)(lds + L_OH);
    LAS int* lsel = (LAS int*)(lds + L_LS); LAS float* mref = (LAS float*)(lds + L_MREF);
    LAS unsigned* selm = (LAS unsigned*)(lds + L_SEL); LAS int* cnts = (LAS int*)(lds + L_CNT); LAS unsigned char* lists = lds + L_LIST; LAS int* wctr = (LAS int*)(lds + L_WCTR);
    const size_t tokb = (size_t)b * SEQ; const int t0 = qb * 64;
    const bf16_t* Qg = P.Q + (tokb + t0) * 512 + g * 256;
    LAS float* U = (LAS float*)(lds + L_OH); LAS float* linvc = (LAS float*)(lds + L_LS);
    {
        const int q = tid >> 3, part = tid & 7, hd = part >> 1, hf = part & 1;
        const u32x4* src = (const u32x4*)(Qg + (size_t)q * 512 + part * 32);
        float ss = 0.f;
#pragma unroll
        for (int i = 0; i < 4; ++i) { const u32x4 v = src[i]; const float f[8] = {bflo(v.x), bfhi(v.x), bflo(v.y), bfhi(v.y), bflo(v.z), bfhi(v.z), bflo(v.w), bfhi(v.w)};
#pragma unroll
            for (int k = 0; k < 8; ++k) ss += f[k] * f[k]; }
        ss += __uint_as_float(__builtin_amdgcn_update_dpp(0u, __float_as_uint(ss), 0xB1, 0xF, 0xF, true));
        if (hf == 0) mref[q * 4 + hd] = sqrtf(ss);
        { u32x4 zz_ = {0u, 0u, 0u, 0u}; asm volatile("" : "+v"(zz_)); LAS u32x4* z4 = (LAS u32x4*)U; for (int i = tid; i < (256 * USP) / 4; i += NTHREADS) z4[i] = zz_; }
    }
    __syncthreads();
    const int hl = r16 & 3;
#define ATT_LDK(dst, base, key0) do { const char* kb_ = (const char*)(base) + (size_t)(key0) * 128; _Pragma("unroll") for (int u_ = 0; u_ < 2; ++u_) _Pragma("unroll") for (int ks_ = 0; ks_ < 2; ++ks_) \
        dst[u_][ks_] = *(const bf16x8*)(kb_ + koff + (u_ * 2 + ks_) * 1024); } while (0)
#define ATT_LDV(dst, vbase, LEN, key0) do { const char* vb_ = (const char*)(vbase) + (size_t)(key0) * 128; _Pragma("unroll") for (int dt_ = 0; dt_ < 4; ++dt_) \
        dst[dt_] = *(const bf16x8*)(vb_ + koff + dt_ * 1024); } while (0)
#define ATT_SHADOW() int ln_ = F.lane; asm volatile("" : "+v"(ln_)); const int r16 = ln_ & 15, kg = ln_ >> 4, hl = r16 & 3; const unsigned koff = (unsigned)ln_ * 16u
    {
        ATT_SHADOW();
        bf16x8 qf[2][2]; float mrc[2], lpart[2], carry[2] = {0.f, 0.f}; int nlim[2]; f32x4 o[2][4];
#pragma unroll
        for (int rt = 0; rt < 2; ++rt) { const int q = 8 * w + 4 * rt + (r16 >> 2);
#pragma unroll
            for (int ks = 0; ks < 2; ++ks) qf[rt][ks] = *(const bf16x8*)(Qg + (size_t)q * 512 + hl * 64 + ks * 32 + kg * 8);
            mrc[rt] = mref[q * 4 + hl] * P.kcmax; lpart[rt] = 0.f; nlim[rt] = (t0 + q - 31) >> 4;
#pragma unroll
            for (int dt = 0; dt < 4; ++dt) o[rt][dt] = (f32x4){0.f, 0.f, 0.f, 0.f}; }
        const int nkeys = 4 * qb + 3, NP = (nkeys + 31) >> 5;
        const int nlim_min = (t0 + 8 * w - 31) >> 4;
        const bf16_t* Kc = P.KCMP + (size_t)(b * 2 + g) * 512 * 64; const bf16_t* Vc = P.VCT + (size_t)(b * 2 + g) * 64 * 512;
#define ATT_S1_STEP(KF, VF, s_) do { _Pragma("unroll") for (int rt = 0; rt < 2; ++rt) { \
            f32x4 st[2]; float p[2][4]; \
            _Pragma("unroll") for (int u = 0; u < 2; ++u) { st[u] = MFMA16(KF[u][0], qf[rt][0], ((f32x4){0.f, 0.f, 0.f, 0.f})); st[u] = MFMA16(KF[u][1], qf[rt][1], st[u]); } \
            _Pragma("unroll") for (int u = 0; u < 2; ++u) _Pragma("unroll") for (int i = 0; i < 4; ++i) p[u][i] = fast_exp2(st[u][i] - mrc[rt]); \
            if (32 * (s_) + 31 > nlim_min) { _Pragma("unroll") for (int u = 0; u < 2; ++u) _Pragma("unroll") for (int i = 0; i < 4; ++i) { const int n = 32 * (s_) + 8 * kg + 4 * u + i; if (n > nlim[rt]) p[u][i] = 0.f; } } \
            const float s01 = (p[0][0] + p[0][1]) + (p[0][2] + p[0][3]), s11 = (p[1][0] + p[1][1]) + (p[1][2] + p[1][3]); lpart[rt] += s01 + s11; \
            {   \
                \
              const unsigned x_ = __float_as_uint(p[1][3]); const auto s16_ = __builtin_amdgcn_permlane16_swap(x_, x_, false, false); const auto s32_ = __builtin_amdgcn_permlane32_swap(s16_[1], s16_[1], false, false); \
              const float inc_ = (kg & 1) ? __uint_as_float(s16_[0]) : ((kg == 2) ? __uint_as_float(s32_[0]) : carry[rt]); carry[rt] = __uint_as_float(s32_[1]); \
              LAS float* ur = U + ((8 * w + 4 * rt + (r16 >> 2)) * 4 + hl) * USP + 8 * (s_) + 2 * kg; \
              ur[0] += (2.f * s01 - p[0][3]) + inc_; ur[1] += (2.f * s11 - p[1][3]) + p[0][3]; } \
            u32x4 pw; pw.x = cvtpk(p[0][0], p[0][1]); pw.y = cvtpk(p[0][2], p[0][3]); pw.z = cvtpk(p[1][0], p[1][1]); pw.w = cvtpk(p[1][2], p[1][3]); \
            const bf16x8 pf = __builtin_bit_cast(bf16x8, pw); \
            _Pragma("unroll") for (int dt = 0; dt < 4; ++dt) o[rt][dt] = MFMA16(VF[dt], pf, o[rt][dt]); } } while (0)
        {
            bf16x8 kA[2][2], vA[4], kB[2][2], vB[4];
            ATT_LDK(kA, Kc, 0); ATT_LDV(vA, Vc, 512, 0); if (NP > 1) { ATT_LDK(kB, Kc, 32); ATT_LDV(vB, Vc, 512, 32); }
#pragma nounroll
            for (int s2 = 0; s2 < NP; s2 += 2) {
                ATT_S1_STEP(kA, vA, s2);
                if (s2 + 2 < NP) { ATT_LDK(kA, Kc, 32 * (s2 + 2)); ATT_LDV(vA, Vc, 512, 32 * (s2 + 2)); }
                if (s2 + 1 < NP) { ATT_S1_STEP(kB, vB, s2 + 1);
                    if (s2 + 3 < NP) { ATT_LDK(kB, Kc, 32 * (s2 + 3)); ATT_LDV(vB, Vc, 512, 32 * (s2 + 3)); } }
            }
        }
#undef ATT_S1_STEP
#pragma unroll
        for (int rt = 0; rt < 2; ++rt) { const int q = 8 * w + 4 * rt + (r16 >> 2); const float lrow = kg_sum(lpart[rt]); const float linv = lrow > 0.f ? 1.f / lrow : 0.f;
            if (kg == 0) linvc[q * 4 + hl] = linv;
            const float gc = P.GATES[(tokb + t0 + q) * 24 + (g * 4 + hl) * 3 + 0] * linv;
            float* yp = P.YPART + (tokb + t0 + q) * 512 + (g * 4 + hl) * 64 + 4 * kg;
#pragma unroll
            for (int dt = 0; dt < 4; ++dt) *(f32x4*)(yp + dt * 16) = o[rt][dt] * gc; }
    }
    LDS_WAIT();
#pragma nounroll
    for (int qg = 0; qg < 2; ++qg) {
        if (qb <= 15) {
            if (lane < 4) { const int q = 8 * w + 4 * qg + lane; const unsigned long long m0 = (1ull << (qb + 1)) - 1ull;
                selm[q * 4 + 0] = (unsigned)m0; selm[q * 4 + 1] = (unsigned)(m0 >> 32); selm[q * 4 + 2] = 0u; selm[q * 4 + 3] = 0u; }
        } else {
            const int j0 = lane, j1 = lane + 64; int v0[4], v1[4], thr[4];
#pragma unroll
            for (int k = 0; k < 4; ++k) { const int q = 8 * w + 4 * qg + k; const LAS float* ur = U + (q * 4) * USP; const LAS float* li = linvc + q * 4;
                float i0 = 0.f, i1 = 0.f;
#pragma unroll
                for (int h = 0; h < 4; ++h) { i0 += ur[h * USP + j0] * li[h]; i1 += ur[h * USP + j1] * li[h]; }
                v0[k] = (j0 >= 1 && j0 <= qb - 2) ? (int)__float_as_uint(i0) : -1;
                v1[k] = (j1 <= qb - 2) ? (int)__float_as_uint(i1) : -1; thr[k] = 0; }
#pragma nounroll
            for (int bit = 30; bit >= 0; --bit) {
                const int c0_ = thr[0] | (1 << bit), c1_ = thr[1] | (1 << bit), c2_ = thr[2] | (1 << bit), c3_ = thr[3] | (1 << bit);
                const unsigned long long a0_ = __ballot(v0[0] >= c0_), a1_ = __ballot(v0[1] >= c1_), a2_ = __ballot(v0[2] >= c2_), a3_ = __ballot(v0[3] >= c3_);
                const unsigned long long b0_ = __ballot(v1[0] >= c0_), b1_ = __ballot(v1[1] >= c1_), b2_ = __ballot(v1[2] >= c2_), b3_ = __ballot(v1[3] >= c3_);
                asm volatile("" :: "s"(a0_), "s"(a1_), "s"(a2_), "s"(a3_), "s"(b0_), "s"(b1_), "s"(b2_), "s"(b3_));
                if (__popcll(a0_) + __popcll(b0_) >= 13) thr[0] = c0_;
                if (__popcll(a1_) + __popcll(b1_) >= 13) thr[1] = c1_;
                if (__popcll(a2_) + __popcll(b2_) >= 13) thr[2] = c2_;
                if (__popcll(a3_) + __popcll(b3_) >= 13) thr[3] = c3_; }
            const unsigned long long below = (1ull << lane) - 1ull;
#pragma nounroll
            for (int k = 0; k < 4; ++k) {
                const int vv0 = (k == 0) ? v0[0] : (k == 1) ? v0[1] : (k == 2) ? v0[2] : v0[3], vv1 = (k == 0) ? v1[0] : (k == 1) ? v1[1] : (k == 2) ? v1[2] : v1[3];
                const int th = (k == 0) ? thr[0] : (k == 1) ? thr[1] : (k == 2) ? thr[2] : thr[3];
                const bool gt0 = vv0 > th, gt1 = vv1 > th, eq0 = vv0 == th, eq1 = vv1 == th;
                const int need = 13 - (__popcll(__ballot(gt0)) + __popcll(__ballot(gt1)));
                const unsigned long long B0 = __ballot(eq0), B1 = __ballot(eq1);
                const int rk0 = __popcll(B0 & below), rk1 = __popcll(B0) + __popcll(B1 & below);
                unsigned long long m0 = __ballot(gt0 || (eq0 && rk0 < need)), m1 = __ballot(gt1 || (eq1 && rk1 < need));
                m0 |= 1ull;
                if (qb < 64) m0 |= (1ull << qb); else m1 |= (1ull << (qb - 64));
                if (qb - 1 < 64) m0 |= (1ull << (qb - 1)); else m1 |= (1ull << (qb - 65));
                if (lane == 0) { const int q = 8 * w + 4 * qg + k; selm[q * 4 + 0] = (unsigned)m0; selm[q * 4 + 1] = (unsigned)(m0 >> 32); selm[q * 4 + 2] = (unsigned)m1; selm[q * 4 + 3] = (unsigned)(m1 >> 32); } }
        }
    }
    __syncthreads();
    { u32x4 zz_ = {0u, 0u, 0u, 0u}; asm volatile("" : "+v"(zz_)); LAS u32x4* z4 = (LAS u32x4*)Oh; for (int i = tid; i < (2 * 256 * OSP) / 4; i += NTHREADS) z4[i] = zz_; }
    lsel[tid] = 0;
    if (tid == 0) wctr[0] = 0;
    { const unsigned m0 = selm[lane * 4 + (w >> 1)];
#pragma nounroll
      for (int jj = 0; jj < 16; ++jj) { const int j = 16 * w + jj; const bool hit = (j <= qb) && ((m0 >> (16 * (w & 1) + jj)) & 1u);
          const unsigned long long mk = __ballot(hit); if (hit) lists[j * 64 + __popcll(mk & ((1ull << lane) - 1ull))] = (unsigned char)lane;
          if (lane == 0) cnts[j] = __popcll(mk); } }
    __syncthreads();
    for (int rep5 = 0; rep5 < ((ATTREP & 8) ? NREP : 1); ++rep5)
    {
        if (rep5 > 0) { __syncthreads(); if (tid == 0) wctr[0] = 0; __syncthreads(); }
        ATT_SHADOW();
        const bf16_t* Ks = P.KS + (size_t)(b * 2 + g) * SEQ * 64; const bf16_t* Vs = P.VST + (size_t)(b * 2 + g) * 64 * SEQ;
        const float S1 = 1048576.f / fmaxf(P.vmax, 1e-30f);
#define ATT_FETCH(idx_) do { int i_ = 0; if (lane == 0) i_ = __hip_atomic_fetch_add(wctr, 1, __ATOMIC_RELAXED, __HIP_MEMORY_SCOPE_WORKGROUP); idx_ = __builtin_amdgcn_readfirstlane(i_); } while (0)
#define ATT_JOF(idx_) (((idx_) == 0) ? 0 : (((idx_) == 1) ? qb : (((idx_) == 2) ? qb - 1 : (idx_) - 2)))
        bf16x8 kn[2][2][2];
        int idx; ATT_FETCH(idx);
        if (idx <= qb) { const int j = ATT_JOF(idx); ATT_LDK(kn[0], Ks, 64 * j); ATT_LDK(kn[1], Ks, 64 * j + 32); }
#pragma nounroll
        while (idx <= qb) {
            const int j = ATT_JOF(idx);
            bf16x8 kf[2][2][2], vf[2][4];
#pragma unroll
            for (int sp = 0; sp < 2; ++sp) {
#pragma unroll
                for (int u = 0; u < 2; ++u) { kf[sp][u][0] = kn[sp][u][0]; kf[sp][u][1] = kn[sp][u][1]; } }
            ATT_LDV(vf[0], Vs, SEQ, 64 * j); ATT_LDV(vf[1], Vs, SEQ, 64 * j + 32);
            int idx2; ATT_FETCH(idx2);
            if (idx2 <= qb) { const int j2 = ATT_JOF(idx2); ATT_LDK(kn[0], Ks, 64 * j2); ATT_LDK(kn[1], Ks, 64 * j2 + 32); }
            const int cnt = cnts[j];
            const int nch = (cnt + 3) >> 2;
            bf16x8 qn0, qn1; int qnx; bool vnx;
            { const int qs = (r16 >> 2); vnx = qs < cnt; qnx = lists[j * 64 + (vnx ? qs : (cnt > 0 ? cnt - 1 : 0))];
              const bf16_t* qp = Qg + (size_t)qnx * 512 + hl * 64 + kg * 8; qn0 = *(const bf16x8*)qp; qn1 = *(const bf16x8*)(qp + 32); }
#pragma nounroll
            for (int c = 0; c < nch; ++c) {
                const bool valid = vnx; const int q = qnx; const int row = q * 4 + hl; const bf16x8 q0 = qn0, q1 = qn1;
                if (c + 1 < nch) { const int qs = 4 * (c + 1) + (r16 >> 2); vnx = qs < cnt; qnx = lists[j * 64 + (vnx ? qs : cnt - 1)];
                    const bf16_t* qp = Qg + (size_t)qnx * 512 + hl * 64 + kg * 8; qn0 = *(const bf16x8*)qp; qn1 = *(const bf16x8*)(qp + 32); }
                const float mr = mref[row] * P.kmax;
                f32x4 o[4];
                float ps = 0.f;
                const bool slow = (j == qb) || (4 * c + 4 > cnt);
#define ATT_CHUNK(MASKED) \
                _Pragma("unroll") for (int sp = 0; sp < 2; ++sp) { \
                    f32x4 st[2]; float p[2][4]; \
                    _Pragma("unroll") for (int u = 0; u < 2; ++u) { st[u] = MFMA16(kf[sp][u][0], q0, ((f32x4){0.f, 0.f, 0.f, 0.f})); st[u] = MFMA16(kf[sp][u][1], q1, st[u]); } \
                    _Pragma("unroll") for (int u = 0; u < 2; ++u) _Pragma("unroll") for (int i = 0; i < 4; ++i) { float e = fast_exp2(st[u][i] - mr); \
                        if (MASKED) { const int kk = 32 * sp + 8 * kg + 4 * u + i; if (!valid || (j == qb && kk > q)) e = 0.f; } p[u][i] = e; ps += e; } \
                    u32x4 pw; pw.x = cvtpk(p[0][0], p[0][1]); pw.y = cvtpk(p[0][2], p[0][3]); pw.z = cvtpk(p[1][0], p[1][1]); pw.w = cvtpk(p[1][2], p[1][3]); \
                    const bf16x8 pf = __builtin_bit_cast(bf16x8, pw); \
                    _Pragma("unroll") for (int dt = 0; dt < 4; ++dt) o[dt] = (sp == 0) ? MFMA16(vf[0][dt], pf, ((f32x4){0.f, 0.f, 0.f, 0.f})) : MFMA16(vf[1][dt], pf, o[dt]); }
                if (slow) { ATT_CHUNK(true) } else { ATT_CHUNK(false) }
#undef ATT_CHUNK
                ps = kg_sum(ps);
                if (valid) {
                    if (kg == 0) { const float xs = ps * 1048576.f, hf_ = __builtin_rintf(xs); __hip_atomic_fetch_add(lsel + row, (int)hf_, __ATOMIC_RELAXED, __HIP_MEMORY_SCOPE_WORKGROUP);
                        __hip_atomic_fetch_add(lsel + 256 + row, (int)((xs - hf_) * 1048576.f), __ATOMIC_RELAXED, __HIP_MEMORY_SCOPE_WORKGROUP); }
#pragma unroll
                    for (int dt = 0; dt < 4; ++dt)
#pragma unroll
                        for (int i = 0; i < 4; ++i) { const float xs = o[dt][i] * S1, hf_ = __builtin_rintf(xs); const int off = row * OSP + dt * 16 + 4 * kg + i;
                            __hip_atomic_fetch_add(Oh + off, (int)hf_, __ATOMIC_RELAXED, __HIP_MEMORY_SCOPE_WORKGROUP);
                            __hip_atomic_fetch_add(Ol + off, (int)((xs - hf_) * 1048576.f), __ATOMIC_RELAXED, __HIP_MEMORY_SCOPE_WORKGROUP); }
                }
            }
            idx = idx2;
        }
    }
    f32x4 yacc[2][4];
    {
        ATT_SHADOW();
        bf16x8 qf[2][2]; float mrw[2], lpart[2]; f32x4 o[2][4];
#pragma unroll
        for (int rt = 0; rt < 2; ++rt) { const int q = 8 * w + 4 * rt + (r16 >> 2);
#pragma unroll
            for (int ks = 0; ks < 2; ++ks) qf[rt][ks] = *(const bf16x8*)(Qg + (size_t)q * 512 + hl * 64 + ks * 32 + kg * 8);
            mrw[rt] = mref[q * 4 + hl] * P.kwmax; lpart[rt] = 0.f;
#pragma unroll
            for (int dt = 0; dt < 4; ++dt) o[rt][dt] = (f32x4){0.f, 0.f, 0.f, 0.f}; }
        const bf16_t* Kw = P.KW + (size_t)(b * 2 + g) * SEQ * 64; const bf16_t* Vw = P.VWT + (size_t)(b * 2 + g) * 64 * SEQ;
        const int jlo = qb >= 8 ? qb - 8 : 0; const int nit = 2 * (qb - jlo + 1);
#define ATT_S4_STEP(KF, VF, it_) do { const int jw_ = jlo + ((it_) >> 1), sp_ = (it_) & 1; const int mode_ = (jw_ == qb) ? 1 : ((jw_ == qb - 8) ? 2 : 0); \
        _Pragma("unroll") for (int rt = 0; rt < 2; ++rt) { \
            f32x4 st[2]; float p[2][4]; \
            _Pragma("unroll") for (int u = 0; u < 2; ++u) { st[u] = MFMA16(KF[u][0], qf[rt][0], ((f32x4){0.f, 0.f, 0.f, 0.f})); st[u] = MFMA16(KF[u][1], qf[rt][1], st[u]); } \
            _Pragma("unroll") for (int u = 0; u < 2; ++u) _Pragma("unroll") for (int i = 0; i < 4; ++i) p[u][i] = fast_exp2(st[u][i] - mrw[rt]); \
            if (mode_) { const int tq = 8 * w + 4 * rt + (r16 >> 2); \
                _Pragma("unroll") for (int u = 0; u < 2; ++u) _Pragma("unroll") for (int i = 0; i < 4; ++i) { const int kk = 32 * sp_ + 8 * kg + 4 * u + i; const bool vis = (mode_ == 1) ? (kk <= tq) : (kk > tq); if (!vis) p[u][i] = 0.f; } } \
            lpart[rt] += ((p[0][0] + p[0][1]) + (p[0][2] + p[0][3])) + ((p[1][0] + p[1][1]) + (p[1][2] + p[1][3])); \
            u32x4 pw; pw.x = cvtpk(p[0][0], p[0][1]); pw.y = cvtpk(p[0][2], p[0][3]); pw.z = cvtpk(p[1][0], p[1][1]); pw.w = cvtpk(p[1][2], p[1][3]); \
            const bf16x8 pf = __builtin_bit_cast(bf16x8, pw); \
            _Pragma("unroll") for (int dt = 0; dt < 4; ++dt) o[rt][dt] = MFMA16(VF[dt], pf, o[rt][dt]); } } while (0)
        {
            bf16x8 kA[2][2], vA[4], kB[2][2], vB[4];
            ATT_LDK(kA, Kw, 64 * jlo); ATT_LDV(vA, Vw, SEQ, 64 * jlo); ATT_LDK(kB, Kw, 64 * jlo + 32); ATT_LDV(vB, Vw, SEQ, 64 * jlo + 32);
#pragma nounroll
            for (int it = 0; it < nit; it += 2) {
                ATT_S4_STEP(kA, vA, it);
                if (it + 2 < nit) { ATT_LDK(kA, Kw, 64 * jlo + 32 * (it + 2)); ATT_LDV(vA, Vw, SEQ, 64 * jlo + 32 * (it + 2)); }
                ATT_S4_STEP(kB, vB, it + 1);
                if (it + 3 < nit) { ATT_LDK(kB, Kw, 64 * jlo + 32 * (it + 3)); ATT_LDV(vB, Vw, SEQ, 64 * jlo + 32 * (it + 3)); }
            }
        }
#undef ATT_S4_STEP
#pragma unroll
        for (int rt = 0; rt < 2; ++rt) { const int q = 8 * w + 4 * rt + (r16 >> 2); const float lw_ = kg_sum(lpart[rt]); const float sc = lw_ > 0.f ? P.GATES[(tokb + t0 + q) * 24 + (g * 4 + hl) * 3 + 2] / lw_ : 0.f;
#pragma unroll
            for (int dt = 0; dt < 4; ++dt) yacc[rt][dt] = o[rt][dt] * sc; }
    }
    __syncthreads();
#pragma unroll
    for (int rt = 0; rt < 2; ++rt) { const int q = 8 * w + 4 * rt + (r16 >> 2), row = q * 4 + hl;
        const float lrow = (float)lsel[row] * (1.f / 1048576.f) + (float)lsel[256 + row] * (1.f / 1099511627776.f);
        const float invS1 = fmaxf(P.vmax, 1e-30f) * (1.f / 1048576.f);
        const float sc = lrow > 0.f ? P.GATES[(tokb + t0 + q) * 24 + (g * 4 + hl) * 3 + 1] / lrow * invS1 : 0.f;
        bf16_t* dst = P.Y + (tokb + t0 + q) * 1024 + 512 + (g * 4 + hl) * 64 + 4 * kg;
        const float* yp = P.YPART + (tokb + t0 + q) * 512 + (g * 4 + hl) * 64 + 4 * kg;
#pragma unroll
        for (int dt = 0; dt < 4; ++dt) { const LAS int* oh = Oh + row * OSP + dt * 16 + 4 * kg; const LAS int* ol = Ol + row * OSP + dt * 16 + 4 * kg;
            const f32x4 osel = (f32x4){(float)oh[0] + (float)ol[0] * (1.f / 1048576.f), (float)oh[1] + (float)ol[1] * (1.f / 1048576.f), (float)oh[2] + (float)ol[2] * (1.f / 1048576.f), (float)oh[3] + (float)ol[3] * (1.f / 1048576.f)};
            const f32x4 v = yacc[rt][dt] + *(const f32x4*)(yp + dt * 16) + osel * sc;
            u32x2 o; o.x = cvtpk(v[0], v[1]); o.y = cvtpk(v[2], v[3]); *(u32x2*)(dst + dt * 16) = o; } }
    __syncthreads();
}
#undef MFMA16
#undef ATT_LDK
#undef ATT_LDV
#undef ATT_SHADOW
#undef ATT_FETCH
#undef ATT_JOF
}

__device__ __forceinline__ void phase_n2(Frame& F, const Args& a, int l) {
    const int lane = F.lane, w = F.wave;
    const float* XR = WSP(float, WS_XR); unsigned char* H8 = WSP(unsigned char, WS_H8);
    const float* g = INP(a, float, I_N2G) + l * 1024;
    LAS float* part = (LAS float*)F.lds;
    LAS float* ssqp = (LAS float*)(F.lds + 32768);
    LAS float* lg = (LAS float*)(F.lds + 32768 + 1024);
    int* CNTI = WSP(int, WS_CNTI); int* ASG = WSP(int, WS_ASG); float* G4 = WSP(float, WS_GATE4);
    for (int item = F.vcu; item < T / 64; item += F.G) {
        const int tk0 = item * 64, b = tk0 >> 13; const int tt = w & 1, kq = w >> 1;
        const float* rwp = WSP(float, WS_RWP) + (size_t)(l * 2 + b) * 1024 * 32; const float* rbp = WSP(float, WS_MISC + 4096) + (l * 2 + b) * 32;
        const int i31 = lane & 31, hf = lane >> 5;
        {
            const float* xp = XR + (size_t)(tk0 + tt * 32 + i31) * DM + kq * 256 + 4 * hf; const float* wp = rwp + (size_t)(kq * 256 + 4 * hf) * 32 + i31;
            f32x16 acc;
#pragma unroll
            for (int r = 0; r < 16; ++r) acc[r] = 0.f;
            float ssq = 0.f;
#pragma nounroll
            for (int bt = 0; bt < 4; ++bt) {
                f32x4 xv[8]; float wv[8][4];
#pragma unroll
                for (int s = 0; s < 8; ++s) { xv[s] = *(const f32x4*)(xp + 8 * (bt * 8 + s)); const float* wq = wp + (size_t)(8 * (bt * 8 + s)) * 32;
                    wv[s][0] = wq[0]; wv[s][1] = wq[32]; wv[s][2] = wq[64]; wv[s][3] = wq[96]; }
#pragma unroll
                for (int s = 0; s < 8; ++s) { ssq += (xv[s].x * xv[s].x + xv[s].y * xv[s].y) + (xv[s].z * xv[s].z + xv[s].w * xv[s].w);
                    acc = __builtin_amdgcn_mfma_f32_32x32x2f32(xv[s].x, wv[s][0], acc, 0, 0, 0); acc = __builtin_amdgcn_mfma_f32_32x32x2f32(xv[s].y, wv[s][1], acc, 0, 0, 0);
                    acc = __builtin_amdgcn_mfma_f32_32x32x2f32(xv[s].z, wv[s][2], acc, 0, 0, 0); acc = __builtin_amdgcn_mfma_f32_32x32x2f32(xv[s].w, wv[s][3], acc, 0, 0, 0); }
            }
            ssq += __shfl_xor(ssq, 32);
            if (hf == 0) ssqp[kq * 64 + tt * 32 + i31] = ssq;
#pragma unroll
            for (int r = 0; r < 16; ++r) { const int tk = (r & 3) + 8 * (r >> 2) + 4 * hf; part[(w * 32 + tk) * 32 + i31] = acc[r]; }
        }
        __syncthreads();
        for (int i = F.tid; i < 64 * 32; i += NTHREADS) { const int tk = i >> 5, e = i & 31, t2 = tk >> 5, tl = tk & 31;
            const float sq = (ssqp[tk] + ssqp[64 + tk]) + (ssqp[128 + tk] + ssqp[192 + tk]); const float rstd = 1.f / sqrtf(sq * (1.f / DM) + NORM_EPS);
            const float v = (part[((0 * 2 + t2) * 32 + tl) * 32 + e] + part[((1 * 2 + t2) * 32 + tl) * 32 + e]) + (part[((2 * 2 + t2) * 32 + tl) * 32 + e] + part[((3 * 2 + t2) * 32 + tl) * 32 + e]);
            lg[tk * 33 + e] = v * rstd + rbp[e]; }
        __syncthreads();
        if (w < 2) {
            const int it = item * 2 + w;
            float v0 = -INFINITY, v1 = -INFINITY, v2 = -INFINITY, v3 = -INFINITY; int i0 = -1, i1 = -1, i2 = -1, i3 = -1;
            if (lane < 32) {
#pragma unroll 8
                for (int e = 0; e < 32; ++e) { const float v = lg[(w * 32 + lane) * 33 + e];
                    if (v > v3) { if (v > v2) { v3 = v2; i3 = i2; if (v > v1) { v2 = v1; i2 = i1; if (v > v0) { v1 = v0; i1 = i0; v0 = v; i0 = e; } else { v1 = v; i1 = e; } } else { v2 = v; i2 = e; } } else { v3 = v; i3 = e; } } }
            }
            const float e1 = __expf(v1 - v0), e2 = __expf(v2 - v0), e3 = __expf(v3 - v0); const float inv = 1.f / (1.f + e1 + e2 + e3);
            int r0 = 0, r1 = 0, r2 = 0, r3 = 0, mycnt = 0;
            for (int e = 0; e < 32; ++e) { const bool hit = (i0 == e) | (i1 == e) | (i2 == e) | (i3 == e); const unsigned long long U = __ballot(hit);
                const int rk = __popcll(U & ((1ull << lane) - 1ull));
                if (i0 == e) r0 = rk; if (i1 == e) r1 = rk; if (i2 == e) r2 = rk; if (i3 == e) r3 = rk;
                if (lane == e) mycnt = __popcll(U); }
            if (lane < 32) { const int tk = tk0 + w * 32 + lane; CNTI[it * 32 + lane] = mycnt;
                if (mycnt > 0) { atomicAdd(F.ctl + CW_GCNT + (l * 32 + (it >> 4)) * 32 + lane, (unsigned)mycnt); atomicAdd(F.ctl + CW_CNT + l * 32 + lane, (unsigned)mycnt); }
                *(int4*)(ASG + tk * 4) = make_int4((i0 << 16) | r0, (i1 << 16) | r1, (i2 << 16) | r2, (i3 << 16) | r3);
                *(f32x4*)(G4 + tk * 4) = (f32x4){inv, e1 * inv, e2 * inv, e3 * inv}; }
        }
#pragma unroll 2
        for (int rr = 0; rr < 8; ++rr) { const int m = tk0 + w * 8 + rr; const RowV r = row_load(XR + (size_t)m * DM, lane);
            const float rstd = 1.f / sqrtf(row_ssq(r) * (1.f / DM) + NORM_EPS);
            row_norm_store8(r, rstd, g, MODP(l, b, 4), MODP(l, b, 3), H8 + (size_t)m * DM, lane); }
        __syncthreads();
    }
}

__device__ __forceinline__ void phase_n2b(Frame& F, int l) {
    const int gw = F.vcu * NWAVES + F.wave, NGW = F.G * NWAVES; const int lane = F.lane;
    const int* CNTI = WSP(int, WS_CNTI); int* TOK = WSP(int, WS_TOK); int* ASG = WSP(int, WS_ASG); unsigned* cnt = F.ctl + CW_CNT + l * 32;
    for (int it = gw; it < T / 32; it += NGW) {
        int base = 0;
        {
            const unsigned* gc = F.ctl + CW_GCNT + l * 1024; const int grp = it >> 4, e = lane & 31; int s0 = 0, s1 = 0;
#pragma unroll
            for (int gI = 0; gI < 32; ++gI) { const int v = (int)gc[gI * 32 + e]; s0 += (gI < grp) ? v : 0; }
#pragma unroll
            for (int i = 0; i < 16; ++i) { const int v = CNTI[((grp << 4) + i) * 32 + e]; s1 += (((grp << 4) + i) < it) ? v : 0; }
            base = s0 + s1; }
        { const int tk = it * 32 + (lane & 31); const int4 as = *(const int4*)(ASG + tk * 4); int v[4] = {as.x, as.y, as.z, as.w};
#pragma unroll
            for (int k = 0; k < 4; ++k) { const int e = v[k] >> 16, rk = v[k] & 0xffff; const int sl = __shfl(base, e & 31) + rk; if (lane < 32) TOK[e * 16384 + sl] = tk; v[k] = (e << 16) | sl; }
            if (lane < 32) *(int4*)(ASG + tk * 4) = make_int4(v[0], v[1], v[2], v[3]); }
    }
}

__device__ __forceinline__ void moe_tables(Frame& F, int l, int NT, int& total) {
    LAS int* ust = (LAS int*)(F.lds + MOE_OFF); LAS int* bst = ust + 33; LAS int* cn = bst + 33;
    if (F.tid < 64) { const unsigned* cnt = F.ctl + CW_CNT + l * 32; const int lane = F.tid;
        const int c = (lane < NE) ? (int)cnt[lane] : 0; const int nb = (c + 255) >> 8; int inc = nb;
#pragma unroll
        for (int o = 1; o < 32; o <<= 1) { const int t = __shfl_up(inc, o); if ((lane & 31) >= o) inc += t; }
        if (lane < NE) { bst[lane] = inc - nb; ust[lane] = (inc - nb) * NT; cn[lane] = c; if (lane == NE - 1) { bst[NE] = inc; ust[NE] = inc * NT; } } }
    __syncthreads();
    total = ust[NE];
}

constexpr int PH_PROLOGUE = 0, PH_N1 = 1, PH_LAYER0 = 2, PH_PER_LAYER = 9, NPHASES = PH_LAYER0 + DEPTH * PH_PER_LAYER;
__global__ void __launch_bounds__(NTHREADS, 2) fwd_kernel(Args args) {
    extern __shared__ __attribute__((aligned(16))) unsigned char lds_raw[];
    Frame F;
    F.lds = (LAS unsigned char*)lds_raw; F.ws = args.ws; F.ctl = (unsigned*)(args.ws + WS_CTL);
    F.tid = threadIdx.x; F.lane = F.tid & 63; F.wave = __builtin_amdgcn_readfirstlane(F.tid >> 6);
    F.G = gridDim.x; { const int bx = blockIdx.x; F.vcu = (F.G % 8 == 0) ? (bx % 8) * (F.G / 8) + bx / 8 : bx; }
    for (int u = F.tid; u < (LDS_BYTES - LDSCTL_OFF) / 4; u += NTHREADS) ((LAS unsigned*)(F.lds + LDSCTL_OFF))[u] = 0u;
    __syncthreads();
    volatile LAS unsigned* MISC = (volatile LAS unsigned*)(F.lds + MISC_OFF);
    XcdBarrier bar; bar.bar = F.ctl + CW_BAR; bar.x = 0; bar.st = nullptr;
#if !MK_PER_PHASE
    bar = xcd_barrier_post(F.ctl + CW_BAR, MISC + 8);
#endif
    const int lo = args.ph_lo, hi = args.ph_hi;
#define IN(k) (lo <= (k) && (k) < hi)
#define REFRESH() do { int t_ = threadIdx.x; asm volatile("" : "+v"(t_)); F.tid = t_; F.lane = t_ & 63; F.wave = __builtin_amdgcn_readfirstlane(t_ >> 6); } while (0)
#define SEAM(k) do { if (IN(k) && IN((k) + 1)) xcd_barrier(bar); } while (0)
#define REPS(bit, idem) (((REPMASK & (bit)) && (idem)) ? NREP : 1)

    if (IN(PH_PROLOGUE) && !(SKIPMASK & 1)) for (int rep = 0; rep < REPS(1, true); ++rep) { REFRESH(); phase_prologue(F, args); } SEAM(PH_PROLOGUE);
    if (IN(PH_N1) && !(SKIPMASK & 2)) for (int rep = 0; rep < REPS(2, true); ++rep) { REFRESH(); phase_n1_first(F, args); } SEAM(PH_N1);
    for (int l = 0; l < DEPTH; ++l) {
        const int p0 = PH_LAYER0 + l * PH_PER_LAYER;
        if (IN(p0 + 0) && !(SKIPMASK & 4)) for (int rep = 0; rep < REPS(4, l == 0); ++rep) {
            { pg8::DenseOrder S; S.init(T, 2560, F.G, ({ int b_ = (int)blockIdx.x; asm volatile("" : "+s"(b_)); b_; }));
              EpiProj E{WSP(bf16_t, WS_UG), WSP(bf16_t, WS_VG), WSP(bf16_t, WS_Q), WSP(bf16_t, WS_KC), WSP(bf16_t, WS_VC), WSP(bf16_t, WS_KS), WSP(bf16_t, WS_KW), WSP(bf16_t, WS_VST), WSP(bf16_t, WS_VWT),
                        WSP(float, WS_GATES), WSP(float, WS_ROPE), F.ctl + CW_KMAX + l * 16, 0};
              pg8::gemm_phase<EpiProj, pg8::DenseOrder, false, true, true>(F.lds, WSP(bf16_t, WS_H8), (const bf16_t*)(WSP(unsigned char, WS_WIN8) + (size_t)l * 2560 * 1024), 512, S, E); }
        }
        SEAM(p0 + 0);
        if (IN(p0 + 1) && !(SKIPMASK & 8)) for (int rep = 0; rep < REPS(8, l == 0); ++rep) { REFRESH();
            for (int it = F.vcu; it < 256; it += F.G) { if (it < 128) sgu_item(F, args, l, it); else { compress_item(F, args, l, 2 * (it - 128)); compress_item(F, args, l, 2 * (it - 128) + 1); } }
        }
        SEAM(p0 + 1);
        if (IN(p0 + 2) && !(SKIPMASK & 16)) for (int rep = 0; rep < REPS(16, l == 0); ++rep) { REFRESH();
            att::Ptrs P{WSP(bf16_t, WS_Q), WSP(bf16_t, WS_KS), WSP(bf16_t, WS_KW), WSP(bf16_t, WS_VST), WSP(bf16_t, WS_VWT), WSP(bf16_t, WS_KCMP), WSP(bf16_t, WS_VCT), WSP(float, WS_GATES), WSP(bf16_t, WS_Y), WSP(float, WS_YPART), 0.f};
            for (int it = F.vcu; it < 512; it += F.G) {
                const int uu = (it < 256) ? it : (767 - it);
                const int bg = uu >> 7, qb = uu & 127;
                const unsigned* km = F.ctl + CW_KMAX + l * 16 + bg;
                P.kmax = sqrtf(__uint_as_float(__hip_atomic_load(km, __ATOMIC_RELAXED, __HIP_MEMORY_SCOPE_AGENT)));
                P.vmax = __uint_as_float(__hip_atomic_load(km + 4, __ATOMIC_RELAXED, __HIP_MEMORY_SCOPE_AGENT));
                P.kwmax = sqrtf(__uint_as_float(__hip_atomic_load(km + 8, __ATOMIC_RELAXED, __HIP_MEMORY_SCOPE_AGENT)));
                P.kcmax = sqrtf(__uint_as_float(__hip_atomic_load(km + 12, __ATOMIC_RELAXED, __HIP_MEMORY_SCOPE_AGENT)));
                att::attn_unit(F, P, bg >> 1, bg & 1, qb);
            }
        }
        SEAM(p0 + 2);
        if (IN(p0 + 3) && !(SKIPMASK & 32)) for (int rep = 0; rep < REPS(32, l == 0); ++rep) {
            pg8::DenseOrder S; S.init(T, DM, F.G, ({ int b_ = (int)blockIdx.x; asm volatile("" : "+s"(b_)); b_; }));
            EpiOut E{l == 0 ? INP(args, float, I_X) : WSP(float, WS_XR), WSP(float, WS_XR), (const float*)(F.ctl + CW_MOD) + (size_t)l * 2 * 6144};
            pg8::gemm_phase<EpiOut, pg8::DenseOrder, false, true>(F.lds, WSP(bf16_t, WS_Y), WSP(bf16_t, WS_WOUT) + (size_t)l * 1024 * 1024, 1024, S, E);
        }
        SEAM(p0 + 3);
        if (IN(p0 + 4) && !(SKIPMASK & 64)) for (int rep = 0; rep < REPS(64, l == 0); ++rep) { REFRESH(); phase_n2(F, args, l); }
        SEAM(p0 + 4);
        if (IN(p0 + 5) && !(SKIPMASK & 64)) for (int rep = 0; rep < REPS(1024, l == 0); ++rep) { REFRESH(); phase_n2b(F, l); }
        SEAM(p0 + 5);
        if (IN(p0 + 6) && !(SKIPMASK & 128)) for (int rep = 0; rep < REPS(128, l == 0); ++rep) { REFRESH();
            int total; moe_tables(F, l, 8, total);
            LAS int* ust = (LAS int*)(F.lds + MOE_OFF);
            pg8::MoeOrder S{ust, ust + 33, ust + 66, WSP(int, WS_TOK), 8, F.G, F.vcu, total, 1024};
            EpiSwiglu E{WSP(unsigned char, WS_ACT), INP(args, float, I_EB1) + (size_t)l * NE * 2048};
            pg8::gemm_phase<EpiSwiglu, pg8::MoeOrder, true, true, true>(F.lds, WSP(bf16_t, WS_H8), (const bf16_t*)(WSP(unsigned char, WS_W1T) + (size_t)l * NE * 2048 * 1024), 512, S, E);
        }
        SEAM(p0 + 6);
        if (IN(p0 + 7) && !(SKIPMASK & 256)) for (int rep = 0; rep < REPS(256, l == 0); ++rep) { REFRESH();
            int total; moe_tables(F, l, 4, total);
            LAS int* ust = (LAS int*)(F.lds + MOE_OFF);
            pg8::MoeOrder S{ust, ust + 33, ust + 66, WSP(int, WS_TOK), 4, F.G, F.vcu, total, 1024};
            EpiDown E{WSP(unsigned char, WS_YROWS), INP(args, float, I_EB2) + (size_t)l * NE * 1024};
            pg8::gemm_phase<EpiDown, pg8::MoeOrder, false, true, true>(F.lds, WSP(bf16_t, WS_ACT), (const bf16_t*)(WSP(unsigned char, WS_W2T) + (size_t)l * NE * 1024 * 1024), 512, S, E);
        }
        SEAM(p0 + 7);
        if (IN(p0 + 8) && !(SKIPMASK & 512)) for (int rep = 0; rep < REPS(512, l == DEPTH - 1); ++rep) { REFRESH(); phase_combine(F, args, l); }
        if (l + 1 < DEPTH) SEAM(p0 + 8);
    }
#undef IN
#undef SEAM
}

extern "C" void kernel_launch(void* const* d_in, const int* in_sizes, int n_in, void* d_out, int out_size, void* d_ws, size_t ws_size, hipStream_t stream) {
    static int grid = 0;
    if (grid == 0) {
        if (n_in != 26 || out_size != T * DM || ws_size < WS_END) { fprintf(stderr, "kernel_launch: unexpected problem (n_in %d, out %d, ws %zu; need ws >= %zu)\n", n_in, out_size, ws_size, (size_t)WS_END); grid = -1; return; }
        int dev = 0, cus = 0, per_cu = 0;
        if (hipGetDevice(&dev) != hipSuccess || hipDeviceGetAttribute(&cus, hipDeviceAttributeMultiprocessorCount, dev) != hipSuccess) { grid = -1; return; }
        if (hipFuncSetAttribute((const void*)fwd_kernel, hipFuncAttributeMaxDynamicSharedMemorySize, LDS_BYTES) != hipSuccess) { fprintf(stderr, "kernel_launch: hipFuncSetAttribute failed\n"); grid = -1; return; }
        if (hipOccupancyMaxActiveBlocksPerMultiprocessor(&per_cu, (const void*)fwd_kernel, NTHREADS, LDS_BYTES) != hipSuccess || per_cu < 1) { fprintf(stderr, "kernel_launch: occupancy query says %d\n", per_cu); (void)hipGetLastError(); per_cu = 1; }
        grid = cus;
    }
    if (grid < 0) return;
    if (hipMemsetAsync((char*)d_ws + WS_CTL, 0, CTL_ZERO_BYTES, stream) != hipSuccess) { fprintf(stderr, "kernel_launch: memset failed\n"); return; }
    Args a{};
    for (int i = 0; i < 26; ++i) a.in[i] = d_in[i];
    a.out = (float*)d_out; a.ws = (unsigned char*)d_ws;
#if MK_PER_PHASE
    for (int p = 0; p < NPHASES; ++p) { a.ph_lo = p; a.ph_hi = p + 1; a.li = 0;
        hipLaunchKernelGGL(fwd_kernel, dim3(grid), dim3(NTHREADS), LDS_BYTES, stream, a); }
#else
    a.ph_lo = 0; a.ph_hi = NPHASES; a.li = 0;
    void* kargs[] = {&a};
    hipError_t e = hipLaunchCooperativeKernel((const void*)fwd_kernel, dim3(grid), dim3(NTHREADS), kargs, LDS_BYTES, stream);
    if (e != hipSuccess) fprintf(stderr, "kernel_launch: cooperative launch failed: %s (grid %d)\n", hipGetErrorString(e), grid);
#endif
}
```

```cpp
#include <hip/hip_runtime.h>
#include <cstdio>
#include <cstdint>

#ifndef SKIPMASK
#define SKIPMASK 0
#endif
#ifndef REPMASK
#define REPMASK 0
#endif
#ifndef NREP
#define NREP 3
#endif
#ifndef DUMMYINT
#define DUMMYINT 0
#endif
#ifndef ATTREP
#define ATTREP 0
#endif
#ifndef MK_PER_PHASE
#define MK_PER_PHASE 0
#endif

#define LAS __attribute__((address_space(3)))
typedef unsigned short bf16_t;
typedef short bf16x8 __attribute__((ext_vector_type(8)));
typedef float f32x4 __attribute__((ext_vector_type(4)));
typedef float f32x2 __attribute__((ext_vector_type(2)));
typedef float f32x16 __attribute__((ext_vector_type(16)));
typedef unsigned u32x4 __attribute__((ext_vector_type(4)));
typedef unsigned u32x2 __attribute__((ext_vector_type(2)));
typedef __bf16 bf16x2_t __attribute__((ext_vector_type(2)));
typedef int i32x4 __attribute__((ext_vector_type(4)));
typedef int i32x8 __attribute__((ext_vector_type(8)));

constexpr int BATCH = 2, SEQ = 8192, DM = 1024, T = BATCH * SEQ, DEPTH = 2;
constexpr int PIN = 2328, PINP = 2560;
constexpr int NE = 32, FF = 1024, TOPK = 4;
constexpr int NCMP = 511, NCMPP = 512;
constexpr float NORM_EPS = 1e-6f;
constexpr float W8SCALE = 64.f;
constexpr int W8_E8M0 = 0x79797979, ONE_E8M0 = 0x7f7f7f7f;
constexpr float QSCALE = 0.125f * 1.4426950408889634f;
constexpr int NWAVES = 8, NTHREADS = 512;

constexpr size_t MiB = 1u << 20;
constexpr size_t WS_CTL = 0, CTL_ZERO_BYTES = 1 * MiB;
constexpr size_t WS_WIN = 1 * MiB;
constexpr size_t WS_WOUT = 11 * MiB;
constexpr size_t WS_SGW = 15 * MiB;
constexpr size_t WS_CW1 = 15 * MiB + 512 * 1024;
constexpr size_t WS_ROPE = 17 * MiB;
constexpr size_t WS_RWP = 21 * MiB;
constexpr size_t WS_MISC = 21 * MiB + 512 * 1024;
constexpr size_t WS_W1T = 32 * MiB;
constexpr size_t WS_W2T = 288 * MiB;
constexpr size_t WS_XR = 416 * MiB;
constexpr size_t WS_H = 480 * MiB;
constexpr size_t WS_UG = 513 * MiB, WS_VG = 529 * MiB, WS_Q = 545 * MiB;
constexpr size_t WS_KC = 561 * MiB, WS_VC = 565 * MiB, WS_KS = 569 * MiB, WS_KW = 573 * MiB;
constexpr size_t WS_VST = 577 * MiB, WS_VWT = 581 * MiB;
constexpr size_t WS_GATES = 585 * MiB;
constexpr size_t WS_KCMP = 587 * MiB;
constexpr size_t WS_VCT = 587 * MiB + 512 * 1024;
constexpr size_t WS_Y = 588 * MiB;
constexpr size_t WS_TOK = 620 * MiB;
constexpr size_t WS_ASG = 622 * MiB;
constexpr size_t WS_GATE4 = 622 * MiB + 512 * 1024;
constexpr size_t WS_YPART = 912 * MiB;
constexpr size_t WS_CNTI = 623 * MiB;
constexpr size_t WS_ACT = 624 * MiB;
constexpr size_t WS_YROWS = 768 * MiB;
constexpr size_t WS_WIN8 = 962 * MiB;
constexpr size_t WS_H8 = 944 * MiB;
constexpr size_t WS_END = 968 * MiB;
constexpr int CW_BAR = 4096;
constexpr int CW_MOD = 16384;
constexpr int CW_CNT = 40960;
constexpr int CW_KMAX = 41088;
constexpr int CW_GCNT = 41216;

__device__ __forceinline__ unsigned cvtpk(float lo, float hi) { f32x2 v = {lo, hi}; bf16x2_t b = __builtin_convertvector(v, bf16x2_t); return __builtin_bit_cast(unsigned, b); }
__device__ __forceinline__ unsigned cvt4_fp8(float a, float b, float c, float d) { int w = 0; w = __builtin_amdgcn_cvt_pk_fp8_f32(a, b, w, false); w = __builtin_amdgcn_cvt_pk_fp8_f32(c, d, w, true); return (unsigned)w; }
__device__ __forceinline__ float bf2f(unsigned short b) { return __uint_as_float((unsigned)b << 16); }
__device__ __forceinline__ float bflo(unsigned w) { return __uint_as_float(w << 16); }
__device__ __forceinline__ float bfhi(unsigned w) { return __uint_as_float(w & 0xffff0000u); }
__device__ __forceinline__ float fast_exp2(float x) { return __builtin_amdgcn_exp2f(x); }
__device__ __forceinline__ float fast_rcp(float x) { return __builtin_amdgcn_rcpf(x); }
__device__ __forceinline__ float sigmoidf_(float x) { return fast_rcp(1.f + fast_exp2(-1.4426950408889634f * x)); }
__device__ __forceinline__ float gelu_tanh(float x) { const float u = 0.7978845608028654f * (x + 0.044715f * x * x * x); return x * fast_rcp(1.f + fast_exp2(-2.885390081777927f * u)); }

__device__ __forceinline__ float x16_sum(float x) { auto r = __builtin_amdgcn_permlane16_swap(__float_as_uint(x), __float_as_uint(x), false, false); return __uint_as_float(r[0]) + __uint_as_float(r[1]); }
__device__ __forceinline__ float x32_sum(float x) { auto r = __builtin_amdgcn_permlane32_swap(__float_as_uint(x), __float_as_uint(x), false, false); return __uint_as_float(r[0]) + __uint_as_float(r[1]); }
__device__ __forceinline__ float x16_max(float x) { auto r = __builtin_amdgcn_permlane16_swap(__float_as_uint(x), __float_as_uint(x), false, false); return fmaxf(__uint_as_float(r[0]), __uint_as_float(r[1])); }
__device__ __forceinline__ float x32_max(float x) { auto r = __builtin_amdgcn_permlane32_swap(__float_as_uint(x), __float_as_uint(x), false, false); return fmaxf(__uint_as_float(r[0]), __uint_as_float(r[1])); }
__device__ __forceinline__ float kg_sum(float x) { return x32_sum(x16_sum(x)); }
__device__ __forceinline__ float kg_max(float x) { return x32_max(x16_max(x)); }
__device__ __forceinline__ float quad_sum(float x) { x += __uint_as_float(__builtin_amdgcn_update_dpp(0u, __float_as_uint(x), 0xB1, 0xF, 0xF, true)); x += __uint_as_float(__builtin_amdgcn_update_dpp(0u, __float_as_uint(x), 0x4E, 0xF, 0xF, true)); return x; }
__device__ __forceinline__ float wave_sum(float v) {
    v = quad_sum(v);
    v += __uint_as_float(__builtin_amdgcn_update_dpp(0u, __float_as_uint(v), 0x141, 0xF, 0xF, true));
    v += __uint_as_float(__builtin_amdgcn_update_dpp(0u, __float_as_uint(v), 0x140, 0xF, 0xF, true));
    return x32_sum(x16_sum(v));
}
#define LDS_WAIT() asm volatile("s_waitcnt lgkmcnt(0)" ::: "memory")
#define VM_WAIT() asm volatile("s_waitcnt vmcnt(0)" ::: "memory")

__device__ __forceinline__ int kfrag_off(int key, int c8) {
    const int s = key >> 5, ko = key & 31, u = (ko >> 2) & 1, r16 = ((ko >> 3) << 2) | (ko & 3), ks = c8 >> 2, kg = c8 & 3;
    return s * 2048 + (u * 2 + ks) * 512 + (kg * 16 + r16) * 8;
}
__device__ __forceinline__ int vfrag_off(int key, int d) {
    const int s = key >> 5, ko = key & 31;
    return s * 2048 + (d >> 4) * 512 + ((ko >> 3) * 16 + (d & 15)) * 8 + (ko & 7);
}
namespace pg8 {
constexpr int BM = 256, BK = 64, HALF = 128, HTB = HALF * BK * 2, STAGE_BYTES = 8 * HTB, NXCD = 8, WGM = 4;
__host__ __device__ __forceinline__ int lds_byte(int r, int c) { const int st = (r >> 4) * 2 + (c >> 5), rr = r & 15, cc = c & 31, ob = rr * 64 + cc * 2; return st * 1024 + (ob ^ (((ob >> 9) & 1) << 5)); }
__host__ __device__ __forceinline__ void stage_rc(int b, int& R, int& C) { const int st = b / 1024, sb = b % 1024, swz = sb ^ (((sb >> 9) & 1) << 5); R = (st >> 1) * 16 + swz / 64; C = (st & 1) * 32 + (swz % 64) / 2; }
__host__ __device__ __forceinline__ int perm32(int rho) { const int n = rho >> 4, i = rho & 15; return 8 * (i >> 2) + 4 * n + (i & 3); }

struct Unit { int pm, pn, e, pnl, rloc, hs, rot; };

__device__ __forceinline__ bool unit_index(int i, int G, int c, int total, int& L, int& hs) {
    const int nfr = total / G, R = total - nfr * G; hs = 0;
    if (i < nfr) { L = i * G + c; return true; }
    if (i > nfr || R == 0) return false;
    if (2 * R <= G) { if (c >= 2 * R) return false; const int h = c >= R ? 1 : 0; L = nfr * G + c - h * R; hs = 1 + h; return true; }
    if (c >= R) return false;
    L = nfr * G + c; return true;
}

struct DenseOrder {
    static constexpr bool SPLIT = false;
    int nM, nN, nwg, G, c;
    __device__ void init(int M, int N, int G_, int c_) { nM = M / BM; nN = N / BM; nwg = nM * nN; G = G_; c = c_; }
    __device__ bool next(int i, Unit& u) const {
        const long L = (long)i * G + c; if (L >= nwg) return false;
        u.hs = 0; int wgid = (int)L; { const int q = nwg / NXCD, r = nwg % NXCD, xcd = wgid % NXCD, off = wgid / NXCD; wgid = (xcd < r ? xcd * (q + 1) : r * (q + 1) + (xcd - r) * q) + off; }
        const int nig = WGM * nN, gid = wgid / nig, fm = gid * WGM, gsz = (nM - fm) < WGM ? (nM - fm) : WGM;
        u.pm = fm + ((wgid % nig) % gsz); u.pn = (wgid % nig) / gsz; u.e = 0; u.pnl = u.pn; u.rloc = 0; u.rot = (u.pm + u.pn) & 3; return true;
    }
    __device__ __forceinline__ unsigned rowoff(const Unit&, int) const { return 0u; }
};

struct MoeOrder {
    static constexpr bool SPLIT = true;
    const LAS int* ust;
    const LAS int* bst;
    const LAS int* cnt;
    const int* tok;
    int NT, G, c, total, rowbytes;
    __device__ bool next(int i, Unit& u) const {
        int L, hs; if (!unit_index(i, G, c, total, L, hs)) return false;
        u.hs = hs; int e = 0;
        for (int k = 1; k < NE; ++k) e += (L >= ust[k]) ? 1 : 0;
        e = __builtin_amdgcn_readfirstlane(e);
        const int loc = __builtin_amdgcn_readfirstlane(L - ust[e]), b0 = __builtin_amdgcn_readfirstlane(bst[e]), nb = __builtin_amdgcn_readfirstlane(bst[e + 1]) - b0;
        u.e = e; u.pnl = loc / nb; u.rloc = loc - u.pnl * nb; u.pm = b0 + u.rloc; u.pn = e * NT + u.pnl; u.rot = (u.rloc + u.pnl) & 3; return true;
    }
    __device__ __forceinline__ unsigned rowoff(const Unit& u, int r) const {
        const int slot = u.rloc * 256 + r + (u.hs == 2 ? 128 : 0); const int tk = slot < cnt[u.e] ? tok[u.e * 16384 + slot] : T;
        return (unsigned)tk * (unsigned)rowbytes;
    }
};

template <class Epi, class Sched, bool GATHER, bool ALIGN_EPI, bool FP8 = false>
__device__ __forceinline__ void gemm_phase(LAS unsigned char* lds, const bf16_t* A, const bf16_t* Bt, const int K, const Sched& S, const Epi& E) {
    int tid_ = threadIdx.x; asm volatile("" : "+v"(tid_));
    const int tid = tid_, wid = __builtin_amdgcn_readfirstlane(tid >> 6), lane = tid & 63, wr = wid >> 2, wc = wid & 3, fr = lane & 15, fq = lane >> 4;
    const int nt = K / BK;
    unsigned voffB[2];
#pragma unroll
    for (int i = 0; i < 2; ++i) { int R, C; stage_rc(tid * 16 + i * 8192, R, C); const int Rb = Epi::PERM ? ((R & ~31) + perm32(R & 31)) : R; voffB[i] = (unsigned)(Rb * K + C) * 2u; }
    const size_t kstep = (size_t)(BK * 2);
    const size_t hstep = (size_t)HALF * K * 2;
    const size_t tstep = 2 * hstep;
    const unsigned ldsw = (unsigned)wid * 1024u;
    const int aoff = lds_byte(wr * 64 + fr, fq * 8), boff = lds_byte(wc * 32 + fr, fq * 8);
#define PG8_SA(b, h) (((b) * 2 + (h)) * HTB)
#define PG8_SB(b, h) ((4 + (b) * 2 + (h)) * HTB)
#define PG8_STAGE(bufoff, gbase, v0, v1) do { \
        __builtin_amdgcn_global_load_lds((const unsigned*)((const char*)(gbase) + (v0)), (LAS unsigned*)(lds + (bufoff) + ldsw), 16, 0, 0); \
        __builtin_amdgcn_global_load_lds((const unsigned*)((const char*)(gbase) + (v1)), (LAS unsigned*)(lds + (bufoff) + ldsw + 8192), 16, 0, 0); } while (0)
#define PG8_STAGEB(bufoff, gbase) PG8_STAGE(bufoff, gbase, voffB[0], voffB[1])
#define PG8_CAT8(x0, x1) __builtin_shufflevector(x0, x1, 0, 1, 2, 3, 4, 5, 6, 7)
#define PG8_RD4(off) (*(const LAS i32x4*)(lds + (off)))
#define PG8_LDA(dst, b, h) do { if constexpr (FP8) { _Pragma("unroll") for (int m = 0; m < 4; ++m) dst##8[m] = PG8_CAT8(PG8_RD4(PG8_SA(b, h) + aoff + m * 2048), PG8_RD4(PG8_SA(b, h) + aoff + m * 2048 + 1024)); } \
        else { _Pragma("unroll") for (int m = 0; m < 4; ++m) _Pragma("unroll") for (int k = 0; k < 2; ++k) dst[m][k] = *(const LAS bf16x8*)(lds + PG8_SA(b, h) + aoff + m * 2048 + k * 1024); } } while (0)
#define PG8_LDB(dst, b, h) do { if constexpr (FP8) { _Pragma("unroll") for (int n = 0; n < 2; ++n) dst##8[n] = PG8_CAT8(PG8_RD4(PG8_SB(b, h) + boff + n * 2048), PG8_RD4(PG8_SB(b, h) + boff + n * 2048 + 1024)); } \
        else { _Pragma("unroll") for (int n = 0; n < 2; ++n) _Pragma("unroll") for (int k = 0; k < 2; ++k) dst[n][k] = *(const LAS bf16x8*)(lds + PG8_SB(b, h) + boff + n * 2048 + k * 1024); } } while (0)
#define PG8_MMA(ai, bj, At, Bt_) do { __builtin_amdgcn_s_setprio(1); _Pragma("unroll") for (int m = 0; m < 4; ++m) _Pragma("unroll") for (int n = 0; n < 2; ++n) { \
        if constexpr (FP8) { asm volatile("v_mfma_scale_f32_16x16x128_f8f6f4 %0, %1, %2, %0, %3, %4 op_sel_hi:[0,0,0]" : "+v"(acc[ai][bj][m][n]) : "v"(Bt_##8[n]), "v"(At##8[m]), "v"(sc_w), "v"(sc_x)); } \
        else { _Pragma("unroll") for (int k = 0; k < 2; ++k) acc[ai][bj][m][n] = __builtin_amdgcn_mfma_f32_16x16x32_bf16(Bt_[n][k], At[m][k], acc[ai][bj][m][n], 0, 0, 0); } } \
        __builtin_amdgcn_s_setprio(0); } while (0)
#define PG8_WAIT_V(n) asm volatile("s_waitcnt vmcnt(" #n ")" ::: "memory")
#define PG8_WAIT_L(n) asm volatile("s_waitcnt lgkmcnt(" #n ")" ::: "memory")
#define PG8_BAR __builtin_amdgcn_s_barrier()
#define PG8_SCHED __builtin_amdgcn_sched_barrier(0)
#define PG8_SETV(v, u) do { int t2_ = tid; asm volatile("" : "+v"(t2_)); _Pragma("unroll") for (int i_ = 0; i_ < 2; ++i_) { int R_, C_; stage_rc(t2_ * 16 + i_ * 8192, R_, C_); _Pragma("unroll") for (int h_ = 0; h_ < 2; ++h_) \
        v[h_][i_] = GATHER ? (S.rowoff(u, R_ + HALF * h_) + (unsigned)C_ * 2u) : (unsigned)((R_ + HALF * h_) * K + C_) * 2u; } } while (0)
    Unit cur, nxt; int ui = 0;
    if (!S.next(0, cur)) return;
    unsigned vc[2][2], vn[2][2];
    PG8_SETV(vc, cur);
    f32x4 acc[2][2][4][2];
#pragma unroll
    for (int a = 0; a < 2; ++a)
#pragma unroll
        for (int b = 0; b < 2; ++b)
#pragma unroll
            for (int m = 0; m < 4; ++m)
#pragma unroll
                for (int n = 0; n < 2; ++n) acc[a][b][m][n] = (f32x4){0.f, 0.f, 0.f, 0.f};
    bf16x8 At[4][2], B0[2][2], B1[2][2]; i32x8 At8[4], B08[2], B18[2];
    int sc_w = W8_E8M0, sc_x = ONE_E8M0; asm volatile("" : "+v"(sc_w), "+v"(sc_x));
    const char* cA = GATHER ? (const char*)A : (const char*)A + (size_t)cur.pm * tstep + (cur.hs == 2 ? hstep : (size_t)0);
    const char* cB = (const char*)Bt + (size_t)cur.pn * tstep;
    const int nq = nt >> 2;
    { const size_t r0 = (size_t)(cur.rot * nq) * kstep;
    PG8_STAGEB(PG8_SB(0, 0), cB + r0); PG8_STAGEB(PG8_SB(0, 1), cB + r0 + hstep); PG8_STAGE(PG8_SA(0, 0), cA + r0, vc[0][0], vc[0][1]); PG8_STAGE(PG8_SA(0, 1), cA + r0, vc[1][0], vc[1][1]);
    if (wr == 1) PG8_BAR;
    PG8_WAIT_V(2); PG8_BAR;
    PG8_STAGEB(PG8_SB(1, 0), cB + r0 + kstep); PG8_STAGE(PG8_SA(1, 0), cA + r0 + kstep, vc[0][0], vc[0][1]); PG8_STAGEB(PG8_SB(1, 1), cB + r0 + hstep + kstep); }
    PG8_WAIT_V(6); PG8_BAR;
    for (;;) {
        const bool has_next = S.next(ui + 1, nxt);
        const char* nA = GATHER ? (const char*)A : (has_next ? (const char*)A + (size_t)nxt.pm * tstep + (nxt.hs == 2 ? hstep : (size_t)0) : cA);
        const bool full = !Sched::SPLIT || cur.hs == 0;
        const char* nB = has_next ? (const char*)Bt + (size_t)nxt.pn * tstep : cB;
        if constexpr (GATHER) { if (has_next) { PG8_SETV(vn, nxt); } else {
#pragma unroll
            for (int h_ = 0; h_ < 2; ++h_)
#pragma unroll
                for (int i_ = 0; i_ < 2; ++i_) vn[h_][i_] = vc[h_][i_]; } }
        const size_t rn = (size_t)((has_next ? nxt.rot : cur.rot) * nq) * kstep;
        int kp = cur.rot * nq;
#pragma nounroll
        for (int t = 0; t < nt; t += 2) {
            const bool last = (t == nt - 2);
            int kn = kp + 2; kn = kn >= nt ? kn - nt : kn;
            const char* a1 = cA + (size_t)(kp + 1) * kstep;
            const char* a2 = last ? nA + rn : cA + (size_t)kn * kstep; const char* b2 = last ? nB + rn : cB + (size_t)kn * kstep; kp = kn;
            const char* a3 = a2 + kstep; const char* b3 = b2 + kstep;
            const unsigned w00 = (GATHER && last) ? vn[0][0] : vc[0][0], w01 = (GATHER && last) ? vn[0][1] : vc[0][1], w10 = (GATHER && last) ? vn[1][0] : vc[1][0], w11 = (GATHER && last) ? vn[1][1] : vc[1][1];
            PG8_LDB(B0, 0, 0); PG8_LDB(B1, 0, 1); PG8_SCHED; PG8_LDA(At, 0, 0); PG8_STAGE(PG8_SA(1, 1), a1, vc[1][0], vc[1][1]);
            PG8_WAIT_V(8); PG8_WAIT_L(0); PG8_BAR; PG8_MMA(0, 0, At, B0); PG8_MMA(0, 1, At, B1); PG8_BAR; PG8_SCHED;
            if (full) PG8_LDA(At, 0, 1); PG8_STAGEB(PG8_SB(0, 0), b2); PG8_STAGEB(PG8_SB(0, 1), b2 + hstep); PG8_STAGE(PG8_SA(0, 0), a2, w00, w01);
            PG8_WAIT_V(8); PG8_WAIT_L(0); PG8_BAR; if (full) { PG8_MMA(1, 0, At, B0); PG8_MMA(1, 1, At, B1); } PG8_BAR; PG8_SCHED;
            PG8_LDB(B0, 1, 0); PG8_LDB(B1, 1, 1); PG8_SCHED; PG8_LDA(At, 1, 0); PG8_STAGE(PG8_SA(0, 1), a2, w10, w11);
            PG8_WAIT_V(8); PG8_WAIT_L(0); PG8_BAR; PG8_MMA(0, 0, At, B0); PG8_MMA(0, 1, At, B1); PG8_BAR; PG8_SCHED;
            if (full) PG8_LDA(At, 1, 1); PG8_STAGEB(PG8_SB(1, 0), b3); PG8_STAGEB(PG8_SB(1, 1), b3 + hstep); PG8_STAGE(PG8_SA(1, 0), a3, w00, w01);
            PG8_WAIT_V(8); PG8_WAIT_L(0); PG8_BAR; if (full) { PG8_MMA(1, 0, At, B0); PG8_MMA(1, 1, At, B1); } PG8_BAR; PG8_SCHED;
        }
        if constexpr (FP8) { asm volatile("s_nop 15\n\ts_nop 15" ::: "memory"); }
        if constexpr (ALIGN_EPI) { if (wr == 0) PG8_BAR; }
        E(acc, cur, wr, wc, fr, fq);
        if (!has_next) break;
#pragma unroll
        for (int a = 0; a < 2; ++a)
#pragma unroll
            for (int b = 0; b < 2; ++b)
#pragma unroll
                for (int m = 0; m < 4; ++m)
#pragma unroll
                    for (int n = 0; n < 2; ++n) acc[a][b][m][n] = (f32x4){0.f, 0.f, 0.f, 0.f};
        cur = nxt; cA = nA; cB = nB; ++ui;
        if constexpr (GATHER) {
#pragma unroll
        for (int h_ = 0; h_ < 2; ++h_)
#pragma unroll
            for (int i_ = 0; i_ < 2; ++i_) vc[h_][i_] = vn[h_][i_]; }
        if constexpr (ALIGN_EPI) { if (wr == 1) PG8_BAR; }
    }
    PG8_WAIT_V(0);
    if constexpr (!ALIGN_EPI) { if (wr == 0) PG8_BAR; }
    PG8_BAR;
#undef PG8_SA
#undef PG8_SB
#undef PG8_STAGE
#undef PG8_STAGEB
#undef PG8_LDA
#undef PG8_LDB
#undef PG8_MMA
#undef PG8_CAT8
#undef PG8_RD4
#undef PG8_WAIT_V
#undef PG8_WAIT_L
#undef PG8_BAR
#undef PG8_SCHED
#undef PG8_SETV
}
}

#define XB_TMO      128
#define XB_XCNT(j)  (256  + 64 * (j))
#define XB_XSUB(j)  (1280 + 64 * (j))
#define XB_XGEN(j)  (2304 + 64 * (j))
#define XB_TOP      3328
#define XB_TOPGEN   3392
#define XCD_BAR_WORDS 3456
#define XB_SPIN_CAP (1u << 22)
__device__ __forceinline__ unsigned xb_ld(unsigned* p)              { return __hip_atomic_load(p, __ATOMIC_RELAXED, __HIP_MEMORY_SCOPE_AGENT); }
__device__ __forceinline__ unsigned xb_add(unsigned* p, unsigned v) { return __hip_atomic_fetch_add(p, v, __ATOMIC_RELAXED, __HIP_MEMORY_SCOPE_AGENT); }
__device__ __forceinline__ unsigned xb_xcc_id() { return (unsigned)__builtin_amdgcn_s_getreg((3 << 11) | 20) & 0xFu; }
#define XB_SPIN(cond, bar) do { unsigned _sp = 0; while (cond) { __builtin_amdgcn_s_sleep(1); \
    if ((++_sp & 255u) == 0u) { if (xb_ld(&(bar)[XB_TMO])) break; if (_sp > XB_SPIN_CAP) { atomicAdd(&(bar)[XB_TMO], 1u); break; } } } } while (0)
struct XcdBarrier { unsigned* bar; unsigned x; volatile LAS unsigned* st; };
__device__ __forceinline__ XcdBarrier xcd_barrier_post(unsigned* bar, volatile LAS unsigned* st) {
    XcdBarrier b; b.bar = bar; b.x = xb_xcc_id(); b.st = st;
    if (threadIdx.x == 0) (void)xb_add(&bar[XB_XCNT(b.x)], 1u);
    return b;
}
__device__ __forceinline__ void xcd_barrier_complete(unsigned* bar, unsigned x, unsigned& nloc, unsigned& nx) {
    const unsigned G = gridDim.x * gridDim.y * gridDim.z;
    unsigned sum, cnt, mine, sp = 0u;
    for (;;) {
        sum = 0u; cnt = 0u; mine = 0u;
#pragma unroll
        for (unsigned j = 0; j < 16; ++j) { const unsigned c = xb_ld(&bar[XB_XCNT(j)]); sum += c; cnt += (c > 0u) ? 1u : 0u; mine = (j == x) ? c : mine; }
        if (sum == G) break;
        __builtin_amdgcn_s_sleep(1);
        if ((++sp & 255u) == 0u) { if (xb_ld(&bar[XB_TMO])) break; if (sp > XB_SPIN_CAP) { atomicAdd(&bar[XB_TMO], 1u); break; } }
    }
    nloc = mine > 0u ? mine : 1u; nx = cnt > 0u ? cnt : 1u;
}
__device__ __forceinline__ void xcd_barrier(const XcdBarrier& b) {
    asm volatile("s_waitcnt vmcnt(0)" ::: "memory");
    __syncthreads();
    if (threadIdx.x == 0) {
        unsigned* bar = b.bar;
        __builtin_amdgcn_s_waitcnt(0);
        unsigned nloc = b.st[0], nx = b.st[1];
        if (nloc == 0u) { xcd_barrier_complete(bar, b.x, nloc, nx); b.st[0] = nloc; b.st[1] = nx; }
        const unsigned old = xb_add(&bar[XB_XSUB(b.x)], 1u);
        const unsigned gen = old / nloc;
        if (old + 1u == (gen + 1u) * nloc) {
            __builtin_amdgcn_fence(__ATOMIC_RELEASE, "agent");
            asm volatile("s_waitcnt vmcnt(0)" ::: "memory");
            const unsigned og = xb_add(&bar[XB_TOP], 1u);
            const unsigned tg = og / nx;
            if (og + 1u == (tg + 1u) * nx) xb_add(&bar[XB_TOPGEN], 1u);
            else XB_SPIN(xb_ld(&bar[XB_TOPGEN]) == tg, bar);
            __builtin_amdgcn_fence(__ATOMIC_ACQUIRE, "agent");
            xb_add(&bar[XB_XGEN(b.x)], 1u);
            asm volatile("s_waitcnt vmcnt(0)" ::: "memory");
        } else {
            XB_SPIN(xb_ld(&bar[XB_XGEN(b.x)]) == gen, bar);
            __builtin_amdgcn_fence(__ATOMIC_ACQUIRE, "agent");
            asm volatile("s_waitcnt vmcnt(0)" ::: "memory");
        }
    }
    __syncthreads();
}

struct Args { const void* in[26]; float* out; unsigned char* ws; int ph_lo, ph_hi, li, pad; };
enum { I_X = 0, I_C, I_POS, I_ADAW, I_ADAB, I_N1G, I_N2G, I_WIN, I_WOUT, I_SGLNG, I_SGLNB, I_SGW, I_SGB, I_PEK, I_PEV, I_CW1K, I_CW2K, I_CW1V, I_CW2V, I_RW, I_RB, I_EW1, I_EB1, I_EW2, I_EB2, I_FING };

#define GAS1 __attribute__((address_space(1)))
#define INP(A_, T_, i_) ({ int ix_ = (i_); asm volatile("" : "+s"(ix_)); (const T_*)(const GAS1 T_*)(A_).in[ix_]; })
struct Frame {
    LAS unsigned char* lds;
    unsigned* ctl;
    unsigned char* ws;
    int tid, lane, wave, vcu, G;
};
#define WSP(type, off) ((type*)(F.ws + (off)))
#define MODP(l, b, part) ((const float*)(F.ctl + CW_MOD) + ((size_t)((l) * 2 + (b)) * 6 + (part)) * 1024)

constexpr int RING_BYTES = 131072;
constexpr int ATT_LDS_BYTES = 147456;
constexpr int LDSCTL_OFF = ATT_LDS_BYTES;
constexpr int MISC_OFF = LDSCTL_OFF + 320;
constexpr int MOE_OFF = MISC_OFF + 128;
constexpr int LDS_BYTES = 163840;

struct EpiProj {
    static constexpr bool PERM = true;
    bf16_t *UG, *VG, *Q, *KC, *VC, *KS, *KW, *VST, *VWT; float* GATES; const float* ROPE; unsigned* kmax; int pn_off;
    __device__ __forceinline__ void operator()(const f32x4 (&acc)[2][2][4][2], const pg8::Unit& u, int wr_, int wc_, int fr_, int fq_) const {
        int t_ = threadIdx.x; asm volatile("" : "+v"(t_)); const int wid_ = __builtin_amdgcn_readfirstlane(t_ >> 6); const int wr = wid_ >> 2, wc = wid_ & 3, fr = t_ & 15, fq = (t_ & 63) >> 4; (void)wr_; (void)wc_; (void)fr_; (void)fq_;
        const int pn = u.pn + pn_off; const int row0 = u.pm * 256 + (u.hs == 2 ? 128 : 0) + wr * 64 + fr; const int b = u.pm >> 5; const int nai = u.hs ? 1 : 2;
        if (pn < 4 || pn == 6) {
#pragma unroll
            for (int ai = 0; ai < 2; ++ai) if (ai < nai)
#pragma unroll
                for (int m = 0; m < 4; ++m) { const size_t r = (size_t)(row0 + ai * 128 + m * 16);
#pragma unroll
                    for (int bj = 0; bj < 2; ++bj) { f32x4 v0 = acc[ai][bj][m][0], v1 = acc[ai][bj][m][1];
                        if (pn < 4) {
#pragma unroll
                            for (int i = 0; i < 4; ++i) { v0[i] = gelu_tanh(v0[i]); v1[i] = gelu_tanh(v1[i]); } }
                        u32x4 w; w.x = cvtpk(v0[0], v0[1]); w.y = cvtpk(v0[2], v0[3]); w.z = cvtpk(v1[0], v1[1]); w.w = cvtpk(v1[2], v1[3]);
                        bf16_t* dst;
                        if (pn < 2) dst = UG + r * 512 + pn * 256 + bj * 128 + wc * 32 + fq * 8;
                        else if (pn < 4) dst = VG + r * 512 + (pn - 2) * 256 + bj * 128 + wc * 32 + fq * 8;
                        else dst = (bj ? VC : KC) + r * 128 + wc * 32 + fq * 8;
                        *(u32x4*)dst = w; } }
        } else if (pn == 4 || pn == 5 || pn == 7) {
            const float sc = (pn == 7) ? 1.f : QSCALE; float nmax = 0.f;
#pragma unroll
            for (int ai = 0; ai < 2; ++ai) if (ai < nai)
#pragma unroll
                for (int m = 0; m < 4; ++m) { const size_t r = (size_t)(row0 + ai * 128 + m * 16);
                    const f32x4* cs = (const f32x4*)(ROPE + (r * 32 + fq * 8) * 2);
                    float o1[8], o2[8], nsq = 0.f;
#pragma unroll
                    for (int n = 0; n < 2; ++n) { const f32x4 c0 = cs[2 * n], c1 = cs[2 * n + 1]; const f32x4 x1 = acc[ai][0][m][n], x2 = acc[ai][1][m][n];
                        const float cc[4] = {c0[0], c0[2], c1[0], c1[2]}, ss[4] = {c0[1], c0[3], c1[1], c1[3]};
#pragma unroll
                        for (int i = 0; i < 4; ++i) { o1[4 * n + i] = (x1[i] * cc[i] - x2[i] * ss[i]) * sc; o2[4 * n + i] = (x2[i] * cc[i] + x1[i] * ss[i]) * sc; nsq += x1[i] * x1[i] + x2[i] * x2[i]; } }
                    u32x4 w1, w2; w1.x = cvtpk(o1[0], o1[1]); w1.y = cvtpk(o1[2], o1[3]); w1.z = cvtpk(o1[4], o1[5]); w1.w = cvtpk(o1[6], o1[7]);
                    w2.x = cvtpk(o2[0], o2[1]); w2.y = cvtpk(o2[2], o2[3]); w2.z = cvtpk(o2[4], o2[5]); w2.w = cvtpk(o2[6], o2[7]);
                    if (pn != 7) { bf16_t* dst = Q + r * 512 + (4 * (pn - 4) + wc) * 64 + fq * 8; *(u32x4*)dst = w1; *(u32x4*)(dst + 32) = w2; }
                    else { bf16_t* img = ((wc < 2) ? KS : KW) + (size_t)(b * 2 + (wc & 1)) * SEQ * 64; const int t = (int)r & (SEQ - 1);
                        *(u32x4*)(img + kfrag_off(t, fq)) = w1; *(u32x4*)(img + kfrag_off(t, 4 + fq)) = w2; }
                    nsq = kg_sum(nsq); nmax = fmaxf(nmax, nsq); asm volatile("" ::: "memory"); }
            if (pn == 7) {
#pragma unroll
                for (int o = 1; o < 16; o <<= 1) nmax = fmaxf(nmax, __shfl_xor(nmax, o));
                if ((threadIdx.x & 63) == 0) atomicMax(kmax + ((wc < 2) ? 0 : 8) + b * 2 + (wc & 1), __float_as_uint(nmax * 1.02f));
            }
        } else if (pn == 8) {
            const int g = wc >> 1; float vmx = 0.f;
#pragma unroll
            for (int ai = 0; ai < 2; ++ai) if (ai < nai)
#pragma unroll
                for (int m = 0; m < 4; ++m) { const int r = row0 + ai * 128 + m * 16; const int s = r & (SEQ - 1);
#pragma unroll
                    for (int bj = 0; bj < 2; ++bj) { bf16_t* img = (bj ? VWT : VST) + (size_t)(b * 2 + g) * SEQ * 64;
#pragma unroll
                        for (int n = 0; n < 2; ++n)
#pragma unroll
                            for (int i = 0; i < 4; ++i) { img[vfrag_off(s, (wc & 1) * 32 + fq * 8 + n * 4 + i)] = (bf16_t)(cvtpk(acc[ai][bj][m][n][i], 0.f) & 0xffffu); if (bj == 0) vmx = fmaxf(vmx, fabsf(acc[ai][0][m][n][i])); } } }
#pragma unroll
            for (int o = 1; o < 64; o <<= 1) vmx = fmaxf(vmx, __shfl_xor(vmx, o));
            if ((threadIdx.x & 63) == 0) atomicMax(kmax + 4 + b * 2 + g, __float_as_uint(vmx * 1.01f));
        } else {
            if (wc == 0 && fq < 3) {
#pragma unroll
                for (int ai = 0; ai < 2; ++ai) if (ai < nai)
#pragma unroll
                    for (int m = 0; m < 4; ++m) { const size_t r = (size_t)(row0 + ai * 128 + m * 16);
#pragma unroll
                        for (int n = 0; n < 2; ++n) { f32x4 v = acc[ai][0][m][n];
#pragma unroll
                            for (int i = 0; i < 4; ++i) v[i] = sigmoidf_(v[i]);
                            *(f32x4*)(GATES + r * 24 + fq * 8 + n * 4) = v; } }
            }
        }
    }
};
struct EpiOut {
    static constexpr bool PERM = false;
    const float* xin; float* xout; const float* g1;
    __device__ __forceinline__ void operator()(const f32x4 (&acc)[2][2][4][2], const pg8::Unit& u, int wr_, int wc_, int fr_, int fq_) const {
        int t_ = threadIdx.x; asm volatile("" : "+v"(t_)); const int wid_ = __builtin_amdgcn_readfirstlane(t_ >> 6); const int wr = wid_ >> 2, wc = wid_ & 3, fr = t_ & 15, fq = (t_ & 63) >> 4; (void)wr_; (void)wc_; (void)fr_; (void)fq_;
        const int row0 = u.pm * 256 + (u.hs == 2 ? 128 : 0) + wr * 64 + fr; const int b = u.pm >> 5; const int col0 = u.pn * 256 + wc * 32 + fq * 4; const int nai = u.hs ? 1 : 2;
        const float* gb = g1 + (size_t)b * 6144 + 2048;
        f32x4 gv[2][2];
#pragma unroll
        for (int bj = 0; bj < 2; ++bj)
#pragma unroll
            for (int n = 0; n < 2; ++n) gv[bj][n] = *(const f32x4*)(gb + col0 + bj * 128 + n * 16);
#pragma unroll
        for (int ai = 0; ai < 2; ++ai) if (ai < nai)
#pragma unroll
            for (int m = 0; m < 4; ++m) { const size_t off = (size_t)(row0 + ai * 128 + m * 16) * DM + col0;
#pragma unroll
                for (int bj = 0; bj < 2; ++bj)
#pragma unroll
                    for (int n = 0; n < 2; ++n) { const f32x4 xi = *(const f32x4*)(xin + off + bj * 128 + n * 16); *(f32x4*)(xout + off + bj * 128 + n * 16) = xi + gv[bj][n] * acc[ai][bj][m][n]; } }
    }
};
struct EpiSwiglu {
    static constexpr bool PERM = true;
    unsigned char* ACT; const float* b1;
    __device__ __forceinline__ void operator()(const f32x4 (&acc)[2][2][4][2], const pg8::Unit& u, int wr_, int wc_, int fr_, int fq_) const {
        int t_ = threadIdx.x; asm volatile("" : "+v"(t_)); const int wid_ = __builtin_amdgcn_readfirstlane(t_ >> 6); const int wr = wid_ >> 2, wc = wid_ & 3, fr = t_ & 15, fq = (t_ & 63) >> 4; (void)wr_; (void)wc_; (void)fr_; (void)fq_;
        const int row0 = u.pm * 256 + (u.hs == 2 ? 128 : 0) + wr * 64 + fr; const int j0 = u.pnl * 128 + wc * 32 + fq * 8; const int nai = u.hs ? 1 : 2;
        const float* bb = b1 + (size_t)u.e * 2048 + j0;
        f32x4 bg[2], bl[2];
#pragma unroll
        for (int n = 0; n < 2; ++n) { bg[n] = *(const f32x4*)(bb + n * 4); bl[n] = *(const f32x4*)(bb + 1024 + n * 4); }
#pragma unroll
        for (int ai = 0; ai < 2; ++ai) if (ai < nai)
#pragma unroll
            for (int m = 0; m < 4; ++m) { float o[8];
#pragma unroll
                for (int n = 0; n < 2; ++n) { const f32x4 gl = acc[ai][0][m][n] + bg[n], ln = acc[ai][1][m][n] + bl[n];
#pragma unroll
                    for (int i = 0; i < 4; ++i) { const float gg = fminf(gl[i], 7.f), ll = fminf(fmaxf(ln[i], -7.f), 7.f); o[n * 4 + i] = gg * sigmoidf_(1.702f * gg) * (ll + 1.f); } }
                u32x2 w; w.x = cvt4_fp8(o[0], o[1], o[2], o[3]); w.y = cvt4_fp8(o[4], o[5], o[6], o[7]);
                *(u32x2*)(ACT + (size_t)(row0 + ai * 128 + m * 16) * FF + j0) = w; }
    }
};
struct EpiDown {
    static constexpr bool PERM = true;
    unsigned char* YR; const float* b2;
    __device__ __forceinline__ void operator()(const f32x4 (&acc)[2][2][4][2], const pg8::Unit& u, int wr_, int wc_, int fr_, int fq_) const {
        int t_ = threadIdx.x; asm volatile("" : "+v"(t_)); const int wid_ = __builtin_amdgcn_readfirstlane(t_ >> 6); const int wr = wid_ >> 2, wc = wid_ & 3, fr = t_ & 15, fq = (t_ & 63) >> 4; (void)wr_; (void)wc_; (void)fr_; (void)fq_;
        const int row0 = u.pm * 256 + (u.hs == 2 ? 128 : 0) + wr * 64 + fr; const int c0 = u.pnl * 256 + wc * 32 + fq * 8; const int nai = u.hs ? 1 : 2;
        const float* bb = b2 + (size_t)u.e * 1024 + c0;
        f32x4 bv[2][2];
#pragma unroll
        for (int bj = 0; bj < 2; ++bj)
#pragma unroll
            for (int n = 0; n < 2; ++n) bv[bj][n] = *(const f32x4*)(bb + bj * 128 + n * 4);
#pragma unroll
        for (int ai = 0; ai < 2; ++ai) if (ai < nai)
#pragma unroll
            for (int m = 0; m < 4; ++m)
#pragma unroll
                for (int bj = 0; bj < 2; ++bj) { const f32x4 v0 = acc[ai][bj][m][0] + bv[bj][0], v1 = acc[ai][bj][m][1] + bv[bj][1];
                    u32x2 w; w.x = cvt4_fp8(v0[0], v0[1], v0[2], v0[3]); w.y = cvt4_fp8(v1[0], v1[1], v1[2], v1[3]);
                    *(u32x2*)(YR + (size_t)(row0 + ai * 128 + m * 16) * DM + c0 + bj * 128) = w; }
    }
};

__device__ __forceinline__ void tr_item(const float* W, int ldn, int k0, int c0, int nvalid, bf16_t* WT, int K, int drow0, LAS float* scr, int lane) {
    const int nn = lane & 31;
#pragma unroll 8
    for (int i = 0; i < 32; ++i) { const int kk = 2 * i + (lane >> 5); scr[kk * 33 + nn] = (nn < nvalid) ? W[(size_t)(k0 + kk) * ldn + c0 + nn] : 0.f; }
    LDS_WAIT(); asm volatile("" ::: "memory");
    const int c = lane & 7;
#pragma unroll
    for (int j = 0; j < 4; ++j) { const int n = (lane >> 3) + 8 * j; const LAS float* s = scr + (8 * c) * 33 + n;
        u32x4 o; o.x = cvtpk(s[0 * 33], s[1 * 33]); o.y = cvtpk(s[2 * 33], s[3 * 33]); o.z = cvtpk(s[4 * 33], s[5 * 33]); o.w = cvtpk(s[6 * 33], s[7 * 33]);
        *(u32x4*)(WT + (size_t)(drow0 + n) * K + k0 + 8 * c) = o; }
    LDS_WAIT(); asm volatile("" ::: "memory");
}
template <bool NTS> __device__ __forceinline__ void tr_item8(const float* W, int ldn, int k0, int c0, unsigned char* W8, int K, int drow0, LAS float* scr, int lane, int nvalid = 32) {
    const int nn = lane & 31;
#pragma unroll 8
    for (int i = 0; i < 32; ++i) { const int kk = 2 * i + (lane >> 5); scr[kk * 33 + nn] = (nn < nvalid) ? __builtin_nontemporal_load(W + (size_t)(k0 + kk) * ldn + c0 + nn) * W8SCALE : 0.f; }
    LDS_WAIT(); asm volatile("" ::: "memory");
    const int c = lane & 3;
#pragma unroll
    for (int j = 0; j < 2; ++j) { const int n = (lane >> 2) + 16 * j; const LAS float* s = scr + (16 * c) * 33 + n;
        u32x4 o; o.x = cvt4_fp8(s[0 * 33], s[1 * 33], s[2 * 33], s[3 * 33]); o.y = cvt4_fp8(s[4 * 33], s[5 * 33], s[6 * 33], s[7 * 33]);
        o.z = cvt4_fp8(s[8 * 33], s[9 * 33], s[10 * 33], s[11 * 33]); o.w = cvt4_fp8(s[12 * 33], s[13 * 33], s[14 * 33], s[15 * 33]);
        if (NTS) __builtin_nontemporal_store(o, (u32x4*)(W8 + (size_t)(drow0 + n) * K + k0 + 16 * c)); else *(u32x4*)(W8 + (size_t)(drow0 + n) * K + k0 + 16 * c) = o; }
    LDS_WAIT(); asm volatile("" ::: "memory");
}
__device__ __forceinline__ void win_src(int p, int& c0, int& nvalid) {
    const int pn = p >> 8; nvalid = 32;
    if (pn < 4 || pn == 6) { c0 = p; }
    else if (pn == 4 || pn == 5) { const int pp = p - 1024 - 256 * (pn - 4), bj = pp >> 7, j = pp & 127; c0 = 1024 + (4 * (pn - 4) + (j >> 5)) * 64 + bj * 32; }
    else if (pn == 7) { const int pp = p - 1792, bj = pp >> 7, j = pp & 127, which = j >> 6, g = (j >> 5) & 1; c0 = (which ? 2048 : 1792) + g * 64 + bj * 32; }
    else if (pn == 8) { const int pp = p - 2048, bj = pp >> 7, j = pp & 127; c0 = (bj ? 2176 : 1920) + j; }
    else { const int pp = p - 2304; c0 = 2304 + pp; nvalid = 24 - pp; nvalid = nvalid < 0 ? 0 : (nvalid > 32 ? 32 : nvalid); if (nvalid == 0) c0 = 0; }
}
__device__ __forceinline__ void phase_prologue(Frame& F, const Args& a) {
    LAS float* scr = (LAS float*)(F.lds + F.wave * 8704);
    const int gw = F.vcu * NWAVES + F.wave, NGW = F.G * NWAVES; const int lane = F.lane;
    {
        const float* c = INP(a, float, I_C); const float* adaw = INP(a, float, I_ADAW); const float* adab = INP(a, float, I_ADAB);
        float* mod = (float*)(F.ctl + CW_MOD);
        LAS float* red = (LAS float*)(F.lds + 8 * 8704);
        for (int it = F.vcu; it < 2 * 24; it += F.G) {
            const int l = it / 24, nb = it % 24;
            const float* wp = adaw + ((size_t)l * 1024 + F.wave * 128) * 6144 + nb * 256 + lane * 4;
            f32x4 a0 = {0.f, 0.f, 0.f, 0.f}, a1 = a0;
#pragma unroll 4
            for (int k = 0; k < 128; ++k) { const f32x4 w = __builtin_nontemporal_load((const f32x4*)(wp + (size_t)k * 6144));
                const float c0 = c[F.wave * 128 + k], c1 = c[1024 + F.wave * 128 + k]; const float s0 = c0 * sigmoidf_(c0), s1 = c1 * sigmoidf_(c1);
                a0 += w * s0; a1 += w * s1; }
            *(LAS f32x4*)(red + (F.wave * 2 + 0) * 256 + lane * 4) = a0; *(LAS f32x4*)(red + (F.wave * 2 + 1) * 256 + lane * 4) = a1;
            __syncthreads();
            { const int b = F.tid >> 8, col = F.tid & 255; float sum = adab[(size_t)l * 6144 + nb * 256 + col];
#pragma unroll
              for (int ww = 0; ww < 8; ++ww) sum += red[(ww * 2 + b) * 256 + col];
              mod[((size_t)l * 2 + b) * 6144 + nb * 256 + col] = sum; }
            __syncthreads();
        }
    }
    {
        const float* win = INP(a, float, I_WIN);
        unsigned char* Win8 = WSP(unsigned char, WS_WIN8);
        for (int it = gw; it < 2 * 16 * 80; it += NGW) { const int l = it / 1280, kb = (it % 1280) / 80, nb = it % 80; int c0, nv; win_src(nb * 32, c0, nv);
            tr_item8<false>(win + (size_t)l * 1024 * PIN, PIN, kb * 64, c0, Win8 + (size_t)l * 2560 * 1024, 1024, nb * 32, scr, lane, nv); }
        const float* wout = INP(a, float, I_WOUT); bf16_t* WoutT = WSP(bf16_t, WS_WOUT);
        for (int it = gw; it < 2 * 16 * 32; it += NGW) { const int l = it / 512, kb = (it % 512) / 32, nb = it % 32;
            tr_item(wout + (size_t)l * 1024 * 1024, 1024, kb * 64, nb * 32, 32, WoutT + (size_t)l * 1024 * 1024, 1024, nb * 32, scr, lane); }
        bf16_t* CW1 = WSP(bf16_t, WS_CW1);
        for (int it = gw; it < 2 * 2 * 32 * 2; it += NGW) { const int l = it / 128, which = (it / 64) & 1, kb = (it % 64) / 2, nb = it & 1;
            const float* src = INP(a, float, which ? I_CW1V : I_CW1K) + (size_t)l * 2048 * 64;
            tr_item(src, 64, kb * 64, nb * 32, 32, CW1 + (size_t)(l * 2 + which) * 64 * 2048, 2048, nb * 32, scr, lane); }
        const float* ew1 = INP(a, float, I_EW1); unsigned char* W1T = WSP(unsigned char, WS_W1T);
        for (int it = gw; it < 2 * 32 * 16 * 64; it += NGW) { const int le = it >> 10, kb = (it >> 6) & 15, nb = it & 63; const int p = nb * 32, tile = p >> 8, bj = (p >> 7) & 1, j = p & 127;
            if (le < 32) tr_item8<false>(ew1 + (size_t)le * 1024 * 2048, 2048, kb * 64, bj * 1024 + tile * 128 + j, W1T + (size_t)le * 2048 * 1024, 1024, p, scr, lane);
            else tr_item8<true>(ew1 + (size_t)le * 1024 * 2048, 2048, kb * 64, bj * 1024 + tile * 128 + j, W1T + (size_t)le * 2048 * 1024, 1024, p, scr, lane); }
        const float* ew2 = INP(a, float, I_EW2); unsigned char* W2T = WSP(unsigned char, WS_W2T);
        for (int it = gw; it < 2 * 32 * 16 * 32; it += NGW) { const int le = it >> 9, kb = (it >> 5) & 15, nb = it & 31;
            if (le < 32) tr_item8<false>(ew2 + (size_t)le * 1024 * 1024, 1024, kb * 64, nb * 32, W2T + (size_t)le * 1024 * 1024, 1024, nb * 32, scr, lane);
            else tr_item8<true>(ew2 + (size_t)le * 1024 * 1024, 1024, kb * 64, nb * 32, W2T + (size_t)le * 1024 * 1024, 1024, nb * 32, scr, lane); }
    }
    {
        const int gt = (F.vcu * NWAVES + F.wave) * 64 + lane, NGT = NGW * 64;
        const float* sgw = INP(a, float, I_SGW); bf16_t* SGW = WSP(bf16_t, WS_SGW);
        for (int i = gt; i < 2 * 8 * 128 * 128; i += NGT) { const int s = i & 127, t = (i >> 7) & 127; SGW[i] = (bf16_t)(cvtpk(s <= t ? sgw[i] : 0.f, 0.f) & 0xffffu); }
        const int* pos = INP(a, int, I_POS); float* rope = WSP(float, WS_ROPE);
        for (int i = gt; i < T * 32; i += NGT) { const int tok = i >> 5, d = i & 31;
            const double inv = exp2(-(double)d * (13.287712379549449 / 32.0));
            const double rv = (double)pos[tok] * inv * 0.15915494309189535; const float fr = (float)(rv - __builtin_rint(rv));
            rope[2 * i] = __builtin_amdgcn_cosf(fr); rope[2 * i + 1] = __builtin_amdgcn_sinf(fr); }
        bf16_t* H = WSP(bf16_t, WS_H);
        for (int i = gt; i < 1024; i += NGT) { H[(size_t)T * 1024 + i] = 0; WSP(unsigned char, WS_H8)[(size_t)T * 1024 + i] = 0; }
        bf16_t* KCMP = WSP(bf16_t, WS_KCMP); bf16_t* VCT = WSP(bf16_t, WS_VCT);
        for (int i = gt; i < 2 * 2 * 64; i += NGT) { const int b = i >> 7, g = (i >> 6) & 1, d = i & 63; KCMP[(size_t)(b * 2 + g) * 512 * 64 + kfrag_off(511, d >> 3) + (d & 7)] = 0; VCT[(size_t)(b * 2 + g) * 512 * 64 + vfrag_off(511, d)] = 0; }
    }
    {
        float* cb = WSP(float, WS_MISC);
        for (int it = gw; it < 2 * 2 * 64; it += NGW) { const int l = it >> 7, which = (it >> 6) & 1, n = it & 63;
            const float* pe = INP(a, float, which ? I_PEV : I_PEK) + (size_t)l * 2048; const float* w1 = INP(a, float, which ? I_CW1V : I_CW1K) + (size_t)l * 2048 * 64;
            float s = 0.f; for (int k = lane; k < 2048; k += 64) s += pe[k] * w1[(size_t)k * 64 + n];
            s = wave_sum(s); if (lane == 0) cb[it] = s; }
    }
}

struct RowV { f32x4 v[4]; };
__device__ __forceinline__ RowV row_load(const float* p, int lane) { RowV r; const f32x4* q = (const f32x4*)p + lane;
#pragma unroll
    for (int j = 0; j < 4; ++j) r.v[j] = q[64 * j]; return r; }
__device__ __forceinline__ float row_ssq(const RowV& r) { float s = 0.f;
#pragma unroll
    for (int j = 0; j < 4; ++j) s += (r.v[j].x * r.v[j].x + r.v[j].y * r.v[j].y) + (r.v[j].z * r.v[j].z + r.v[j].w * r.v[j].w); return wave_sum(s); }
__device__ __forceinline__ void row_norm_store(const RowV& x, float rstd, const float* g, const float* sc, const float* sh, bf16_t* orow, int lane) {
    u32x2* o8 = (u32x2*)orow + lane;
#pragma unroll
    for (int j = 0; j < 4; ++j) { const f32x4 gg = ((const f32x4*)g)[lane + 64 * j], ss = ((const f32x4*)sc)[lane + 64 * j], hh = ((const f32x4*)sh)[lane + 64 * j];
        const f32x4 y = x.v[j] * rstd * gg * (ss + 1.f) + hh; u32x2 w; w.x = cvtpk(y.x, y.y); w.y = cvtpk(y.z, y.w); o8[64 * j] = w; }
}
__device__ __forceinline__ void quad_tr(unsigned (&a)[4], int lane) {
    const bool b0 = lane & 1, b1 = lane & 2;
    { const unsigned x = b0 ? a[0] : a[1]; const unsigned y = __builtin_amdgcn_update_dpp(0u, x, 0xB1, 0xF, 0xF, true); if (b0) a[0] = y; else a[1] = y; }
    { const unsigned x = b0 ? a[2] : a[3]; const unsigned y = __builtin_amdgcn_update_dpp(0u, x, 0xB1, 0xF, 0xF, true); if (b0) a[2] = y; else a[3] = y; }
    { const unsigned x = b1 ? a[0] : a[2]; const unsigned y = __builtin_amdgcn_update_dpp(0u, x, 0x4E, 0xF, 0xF, true); if (b1) a[0] = y; else a[2] = y; }
    { const unsigned x = b1 ? a[1] : a[3]; const unsigned y = __builtin_amdgcn_update_dpp(0u, x, 0x4E, 0xF, 0xF, true); if (b1) a[1] = y; else a[3] = y; }
}
__device__ __forceinline__ void row_norm_store8(const RowV& x, float rstd, const float* g, const float* sc, const float* sh, unsigned char* orow, int lane) {
    unsigned a[4];
#pragma unroll
    for (int j = 0; j < 4; ++j) { const f32x4 gg = ((const f32x4*)g)[lane + 64 * j], ss = ((const f32x4*)sc)[lane + 64 * j], hh = ((const f32x4*)sh)[lane + 64 * j];
        const f32x4 y = x.v[j] * rstd * gg * (ss + 1.f) + hh; a[j] = cvt4_fp8(y.x, y.y, y.z, y.w); }
    quad_tr(a, lane);
    *(u32x4*)(orow + 256 * (lane & 3) + 16 * (lane >> 2)) = (u32x4){a[0], a[1], a[2], a[3]};
}
__device__ __forceinline__ int expert_block_prefix(const unsigned* cnt, int lane) {
    int nb = (lane < NE) ? (int)((cnt[lane] + 255u) >> 8) : 0; int inc = nb;
#pragma unroll
    for (int o = 1; o < 32; o <<= 1) { const int t = __shfl_up(inc, o); if ((lane & 31) >= o) inc += t; }
    return inc - nb;
}
__device__ __forceinline__ void phase_n1_first(Frame& F, const Args& a) {
    const int gw = F.vcu * NWAVES + F.wave, NGW = F.G * NWAVES; const int lane = F.lane;
    const float* x = INP(a, float, I_X); const float* g = INP(a, float, I_N1G); bf16_t* H = WSP(bf16_t, WS_H); unsigned char* H8 = WSP(unsigned char, WS_H8);
    for (int m = gw; m < T; m += 2 * NGW) { const int m2 = m + NGW; const int b = m >> 13, b2 = m2 >> 13;
        const RowV r = row_load(x + (size_t)m * DM, lane); const RowV r2 = row_load(x + (size_t)m2 * DM, lane);
        const float rstd = 1.f / sqrtf(row_ssq(r) * (1.f / DM) + NORM_EPS), rstd2 = 1.f / sqrtf(row_ssq(r2) * (1.f / DM) + NORM_EPS);
        row_norm_store8(r, rstd, g, MODP(0, b, 1), MODP(0, b, 0), H8 + (size_t)m * DM, lane);
        row_norm_store8(r2, rstd2, g, MODP(0, b2, 1), MODP(0, b2, 0), H8 + (size_t)m2 * DM, lane); }
    float* RWP = WSP(float, WS_RWP); float* RBP = WSP(float, WS_MISC + 4096);
    const float* rw = INP(a, float, I_RW); const float* rb = INP(a, float, I_RB); const float* n2g = INP(a, float, I_N2G);
    const int gt = gw * 64 + lane, NGT = NGW * 64;
    for (int i = gt; i < 2 * 2 * 1024 * 32; i += NGT) { const int l = i >> 16, b = (i >> 15) & 1, k = (i >> 5) & 1023, e = i & 31;
        RWP[i] = n2g[l * 1024 + k] * (1.f + MODP(l, b, 4)[k]) * rw[((size_t)l * 1024 + k) * 32 + e]; }
    for (int it = gw; it < 2 * 2 * 32; it += NGW) { const int l = it >> 6, b = (it >> 5) & 1, e = it & 31; float s = 0.f;
        for (int k = lane; k < 1024; k += 64) s += MODP(l, b, 3)[k] * rw[((size_t)l * 1024 + k) * 32 + e];
        s = wave_sum(s); if (lane == 0) RBP[it] = s + rb[l * 32 + e]; }
}
__device__ __forceinline__ void phase_combine(Frame& F, const Args& a, int l) {
    const int gw = F.vcu * NWAVES + F.wave, NGW = F.G * NWAVES; const int lane = F.lane;
    float* XR = WSP(float, WS_XR); bf16_t* H = WSP(bf16_t, WS_H); const unsigned char* YR = WSP(unsigned char, WS_YROWS);
    const int* ASG = WSP(int, WS_ASG); const float* G4 = WSP(float, WS_GATE4);
    const int myprefix = expert_block_prefix(F.ctl + CW_CNT + l * 32, lane);
    const bool last = (l == DEPTH - 1);
    const float* g = last ? INP(a, float, I_FING) : INP(a, float, I_N1G) + (l + 1) * 1024;
#define COMB_LOAD(R_, WV_, GT_, M_) do { const int4 as4_ = *(const int4*)(ASG + (M_) * 4); const f32x4 gt4_ = *(const f32x4*)(G4 + (M_) * 4); \
        R_ = row_load(XR + (size_t)(M_) * DM, lane); const int asv_[4] = {as4_.x, as4_.y, as4_.z, as4_.w}; GT_[0] = gt4_.x; GT_[1] = gt4_.y; GT_[2] = gt4_.z; GT_[3] = gt4_.w; \
        _Pragma("unroll") for (int k = 0; k < 4; ++k) { const int e = asv_[k] >> 16, slot = asv_[k] & 0xffff; const int blk = __shfl(myprefix, e); \
            const unsigned* yr = (const unsigned*)(YR + ((size_t)blk * 256 + slot) * DM) + lane; _Pragma("unroll") for (int j = 0; j < 4; ++j) WV_[k][j] = __builtin_nontemporal_load(yr + 64 * j); } } while (0)
#define COMB_FINISH(R_, WV_, GT_, M_) do { const int b = (M_) >> 13; f32x4 y[4]; \
        _Pragma("unroll") for (int j = 0; j < 4; ++j) y[j] = (f32x4){0.f, 0.f, 0.f, 0.f}; \
        _Pragma("unroll") for (int k = 0; k < 4; ++k) _Pragma("unroll") for (int j = 0; j < 4; ++j) { const int w = (int)WV_[k][j]; const f32x2 lo_ = __builtin_amdgcn_cvt_pk_f32_fp8(w, false), hi_ = __builtin_amdgcn_cvt_pk_f32_fp8(w, true); y[j] += (f32x4){lo_.x, lo_.y, hi_.x, hi_.y} * GT_[k]; } \
        const float* g2 = MODP(l, b, 5); \
        _Pragma("unroll") for (int j = 0; j < 4; ++j) R_.v[j] += ((const f32x4*)g2)[lane + 64 * j] * y[j]; \
        const float rstd = 1.f / sqrtf(row_ssq(R_) * (1.f / DM) + NORM_EPS); \
        if (last) { f32x4* o = (f32x4*)(a.out + (size_t)(M_) * DM) + lane; _Pragma("unroll") for (int j = 0; j < 4; ++j) o[64 * j] = R_.v[j] * rstd * ((const f32x4*)g)[lane + 64 * j]; } \
        else { f32x4* xo = (f32x4*)(XR + (size_t)(M_) * DM) + lane; _Pragma("unroll") for (int j = 0; j < 4; ++j) xo[64 * j] = R_.v[j]; \
            row_norm_store8(R_, rstd, g, MODP(l + 1, b, 1), MODP(l + 1, b, 0), WSP(unsigned char, WS_H8) + (size_t)(M_) * DM, lane); } } while (0)
    for (int m = gw; m < T; m += 2 * NGW) { const int m2 = m + NGW;
        RowV rA, rB; unsigned wA[4][4], wB[4][4]; float gA[4], gB[4];
        COMB_LOAD(rA, wA, gA, m); COMB_LOAD(rB, wB, gB, m2);
        COMB_FINISH(rA, wA, gA, m); COMB_FINISH(rB, wB, gB, m2);
    }
#undef COMB_LOAD
#undef COMB_FINISH
}
__device__ __forceinline__ void compress_item(Frame& F, const Args& a, int l, int item) {
    const int which = item >> 7, b = (item >> 6) & 1, g = (item >> 5) & 1, n0 = (item & 31) * 16;
    const int lane = F.lane, w = F.wave, r16 = lane & 15, kg = lane >> 4;
    const bf16_t* src = WSP(bf16_t, which ? WS_VC : WS_KC);
    const bf16_t* W1 = WSP(bf16_t, WS_CW1) + (size_t)(l * 2 + which) * 64 * 2048;
    LAS float* red = (LAS float*)F.lds;
    LAS float* hid = (LAS float*)(F.lds + 32768);
    f32x4 acc[4];
#pragma unroll
    for (int i = 0; i < 4; ++i) acc[i] = (f32x4){0.f, 0.f, 0.f, 0.f};
    const int n = n0 + r16; const bool nval = n < NCMP;
#pragma unroll 2
    for (int ks = 0; ks < 8; ++ks) { const int k = 256 * w + 32 * ks + 8 * kg; const int li = k >> 6, d = k & 63;
        bf16x8 af = (bf16x8){0, 0, 0, 0, 0, 0, 0, 0};
        if (nval) af = *(const bf16x8*)(src + ((size_t)b * SEQ + 16 * n + li) * 128 + g * 64 + d);
#pragma unroll
        for (int nt = 0; nt < 4; ++nt) { const bf16x8 bf = *(const bf16x8*)(W1 + (size_t)(nt * 16 + r16) * 2048 + k); acc[nt] = __builtin_amdgcn_mfma_f32_16x16x32_bf16(af, bf, acc[nt], 0, 0, 0); } }
#pragma unroll
    for (int nt = 0; nt < 4; ++nt)
#pragma unroll
        for (int i = 0; i < 4; ++i) red[(w * 16 + 4 * kg + i) * 64 + nt * 16 + r16] = acc[nt][i];
    __syncthreads();
    const float* cb = WSP(float, WS_MISC) + (l * 2 + which) * 64;
    for (int i = F.tid; i < 1024; i += NTHREADS) { float s = cb[i & 63];
#pragma unroll
        for (int ww = 0; ww < 8; ++ww) s += red[ww * 1024 + i];
        hid[i] = gelu_tanh(s); }
    { const float* w2 = INP(a, float, which ? I_CW2V : I_CW2K) + (size_t)l * 4096; LAS f32x4* w2s4 = (LAS f32x4*)(F.lds + 40960);
      for (int i = F.tid; i < 1024; i += NTHREADS) w2s4[i] = ((const f32x4*)w2)[i]; }
    __syncthreads();
    {
        const int nn = F.tid >> 5, c = F.tid & 31; LAS float* w2s = (LAS float*)(F.lds + 40960);
        float o1 = 0.f, o2 = 0.f;
#pragma unroll 16
        for (int k = 0; k < 64; ++k) { const float h = hid[nn * 64 + k]; o1 += h * w2s[k * 64 + c]; o2 += h * w2s[k * 64 + c + 32]; }
        const int np = n0 + nn; float nsq_ = 0.f;
        if (np < NCMP) {
            if (!which) { const float* cs = WSP(float, WS_ROPE) + (((size_t)b * SEQ + 16 * np + 31) * 32 + c) * 2; const float cc = cs[0], ss = cs[1];
                const float r1 = o1 * cc - o2 * ss, r2 = o2 * cc + o1 * ss;
                bf16_t* img = WSP(bf16_t, WS_KCMP) + (size_t)(b * 2 + g) * 512 * 64; img[kfrag_off(np, c >> 3) + (c & 7)] = (bf16_t)(cvtpk(r1, 0.f) & 0xffffu); img[kfrag_off(np, 4 + (c >> 3)) + (c & 7)] = (bf16_t)(cvtpk(r2, 0.f) & 0xffffu);
                nsq_ = r1 * r1 + r2 * r2;
            } else { bf16_t* img = WSP(bf16_t, WS_VCT) + (size_t)(b * 2 + g) * 512 * 64; img[vfrag_off(np, c)] = (bf16_t)(cvtpk(o1, 0.f) & 0xffffu); img[vfrag_off(np, c + 32)] = (bf16_t)(cvtpk(o2, 0.f) & 0xffffu); }
        }
        if (!which) {
            float mx = quad_sum(nsq_);
            mx += __uint_as_float(__builtin_amdgcn_update_dpp(0u, __float_as_uint(mx), 0x141, 0xF, 0xF, true)); mx += __uint_as_float(__builtin_amdgcn_update_dpp(0u, __float_as_uint(mx), 0x140, 0xF, 0xF, true));
            mx = x16_sum(mx);
            mx = x32_max(mx);
            if (F.lane == 0) atomicMax(F.ctl + CW_KMAX + l * 16 + 12 + b * 2 + g, __float_as_uint(mx * 1.02f));
        }
    }
    __syncthreads();
}
__device__ __forceinline__ void sgu_item(Frame& F, const Args& a, int l, int ch) {
    const size_t tok0 = (size_t)ch * 128;
    const int lane = F.lane, w = F.wave, r16 = lane & 15, kg = lane >> 4;
    const bf16_t* VG = WSP(bf16_t, WS_VG); const bf16_t* UG = WSP(bf16_t, WS_UG); bf16_t* Y = WSP(bf16_t, WS_Y);
    LAS float* stats = (LAS float*)F.lds;
    LAS bf16_t* vnT = (LAS bf16_t*)(F.lds + 1024);
    constexpr int VP = 136;
    static_assert(1024 + 8 * 64 * 136 * 2 <= ATT_LDS_BYTES, "SGU LDS map");
    {
        u32x4 vrow[16];
#pragma unroll
        for (int tt = 0; tt < 16; ++tt) vrow[tt] = *(const u32x4*)(VG + (tok0 + 16 * w + tt) * 512 + lane * 8);
#pragma unroll
        for (int tt = 0; tt < 16; ++tt) { const int s = 16 * w + tt; const u32x4 v = vrow[tt];
            const float f[8] = {bflo(v.x), bfhi(v.x), bflo(v.y), bfhi(v.y), bflo(v.z), bfhi(v.z), bflo(v.w), bfhi(v.w)};
            float sm = 0.f;
#pragma unroll
            for (int i = 0; i < 8; ++i) sm += f[i];
            const float mu = wave_sum(sm) * (1.f / 512.f); float q = 0.f;
#pragma unroll
            for (int i = 0; i < 8; ++i) q += (f[i] - mu) * (f[i] - mu);
            const float var = wave_sum(q) * (1.f / 512.f);
            if (lane == 0) { stats[2 * s] = mu; stats[2 * s + 1] = 1.f / sqrtf(var + NORM_EPS); } }
    }
    __syncthreads();
    {
        const int s = F.tid & 127, hq = F.tid >> 7; const float mu = stats[2 * s], rs = stats[2 * s + 1];
#pragma unroll
        for (int hp = 0; hp < 2; ++hp) { const int h = hq + 4 * hp; const int cbase = h * 64;
            const float* lg = INP(a, float, I_SGLNG) + l * 512 + cbase; const float* lb = INP(a, float, I_SGLNB) + l * 512 + cbase;
#pragma unroll 2
            for (int d0 = 0; d0 < 64; d0 += 8) { const u32x4 v = *(const u32x4*)(VG + (tok0 + s) * 512 + cbase + d0);
                const float f[8] = {bflo(v.x), bfhi(v.x), bflo(v.y), bfhi(v.y), bflo(v.z), bfhi(v.z), bflo(v.w), bfhi(v.w)};
#pragma unroll
                for (int i = 0; i < 8; ++i) vnT[(h * 64 + d0 + i) * VP + s] = (bf16_t)(cvtpk((f[i] - mu) * rs * lg[d0 + i] + lb[d0 + i], 0.f) & 0xffffu); } }
    }
    __syncthreads();
    {
        const int h = w;
        const bf16_t* Wm = WSP(bf16_t, WS_SGW) + (size_t)(l * 8 + h) * 128 * 128; const float* bs = INP(a, float, I_SGB) + (size_t)(l * 8 + h) * 128;
#pragma nounroll
        for (int tt = 0; tt < 8; ++tt) {
            const int t = 16 * tt + r16; const float bb = bs[t];
            bf16x8 bw[4]; u32x2 ugv[4];
#pragma unroll
            for (int ks = 0; ks < 4; ++ks) bw[ks] = *(const bf16x8*)(Wm + (size_t)t * 128 + 32 * ks + 8 * kg);
#pragma unroll
            for (int dt = 0; dt < 4; ++dt) ugv[dt] = *(const u32x2*)(UG + (tok0 + t) * 512 + h * 64 + dt * 16 + 4 * kg);
            f32x4 acc[4];
#pragma unroll
            for (int i = 0; i < 4; ++i) acc[i] = (f32x4){0.f, 0.f, 0.f, 0.f};
            const int nks = (16 * tt + 15) / 32 + 1;
#pragma unroll
            for (int ks = 0; ks < 4; ++ks) { if (ks < nks) {
#pragma unroll
                for (int dt = 0; dt < 4; ++dt) { const bf16x8 afr = *(const LAS bf16x8*)(vnT + (h * 64 + dt * 16 + r16) * VP + 32 * ks + 8 * kg); acc[dt] = __builtin_amdgcn_mfma_f32_16x16x32_bf16(afr, bw[ks], acc[dt], 0, 0, 0); } } }
#pragma unroll
            for (int dt = 0; dt < 4; ++dt) { const u32x2 uu = ugv[dt];
                u32x2 o; o.x = cvtpk(bflo(uu.x) * (acc[dt][0] + bb), bfhi(uu.x) * (acc[dt][1] + bb)); o.y = cvtpk(bflo(uu.y) * (acc[dt][2] + bb), bfhi(uu.y) * (acc[dt][3] + bb));
                *(u32x2*)(Y + (tok0 + t) * 1024 + h * 64 + dt * 16 + 4 * kg) = o; }
        }
    }
    __syncthreads();
}
namespace att {
constexpr int OSP = 65;
constexpr int L_OH = 0;
constexpr int L_OL = 66560;
constexpr int L_LS = 133120;
constexpr int L_MREF = L_LS + 2048;
constexpr int USP = 129;
constexpr int L_SEL = L_MREF + 1024;
constexpr int L_CNT = L_SEL + 1024;
constexpr int L_LIST = L_CNT + 512;
constexpr int L_WCTR = L_LIST + 8192;
static_assert(L_WCTR + 16 <= ATT_LDS_BYTES, "attention LDS map");

struct Ptrs { const bf16_t *Q, *KS, *KW, *VST, *VWT, *KCMP, *VCT; const float* GATES; bf16_t* Y; float* YPART; float kmax, vmax, kwmax, kcmax; };

#define MFMA16(a, b, c) __builtin_amdgcn_mfma_f32_16x16x32_bf16(a, b, c, 0, 0, 0)

__device__ __forceinline__ void attn_unit(Frame& F, const Ptrs& P, int b, int g, int qb) {
    LAS unsigned char* lds = F.lds;
    const int tid = F.tid, lane = F.lane, w = F.wave, r16 = lane & 15, kg = lane >> 4;
    LAS int* Oh = (LAS int*)(lds + L_OH); LAS int* Ol = (LAS int*)(lds + L_OL); LAS float* imp = (LAS float*)(lds + L_OH);
    LAS int* lsel = (LAS int*)(lds + L_LS); LAS float* mref = (LAS float*)(lds + L_MREF);
    LAS unsigned* selm = (LAS unsigned*)(lds + L_SEL); LAS int* cnts = (LAS int*)(lds + L_CNT); LAS unsigned char* lists = lds + L_LIST; LAS int* wctr = (LAS int*)(lds + L_WCTR);
    const size_t tokb = (size_t)b * SEQ; const int t0 = qb * 64;
    const bf16_t* Qg = P.Q + (tokb + t0) * 512 + g * 256;
    LAS float* U = (LAS float*)(lds + L_OH); LAS float* linvc = (LAS float*)(lds + L_LS);
    {
        const int q = tid >> 3, part = tid & 7, hd = part >> 1, hf = part & 1;
        const u32x4* src = (const u32x4*)(Qg + (size_t)q * 512 + part * 32);
        float ss = 0.f;
#pragma unroll
        for (int i = 0; i < 4; ++i) { const u32x4 v = src[i]; const float f[8] = {bflo(v.x), bfhi(v.x), bflo(v.y), bfhi(v.y), bflo(v.z), bfhi(v.z), bflo(v.w), bfhi(v.w)};
#pragma unroll
            for (int k = 0; k < 8; ++k) ss += f[k] * f[k]; }
        ss += __uint_as_float(__builtin_amdgcn_update_dpp(0u, __float_as_uint(ss), 0xB1, 0xF, 0xF, true));
        if (hf == 0) mref[q * 4 + hd] = sqrtf(ss);
        { u32x4 zz_ = {0u, 0u, 0u, 0u}; asm volatile("" : "+v"(zz_)); LAS u32x4* z4 = (LAS u32x4*)U; for (int i = tid; i < (256 * USP) / 4; i += NTHREADS) z4[i] = zz_; }
    }
    __syncthreads();
    const int hl = r16 & 3;
#define ATT_LDK(dst, base, key0) do { const char* kb_ = (const char*)(base) + (size_t)(key0) * 128; _Pragma("unroll") for (int u_ = 0; u_ < 2; ++u_) _Pragma("unroll") for (int ks_ = 0; ks_ < 2; ++ks_) \
        dst[u_][ks_] = *(const bf16x8*)(kb_ + koff + (u_ * 2 + ks_) * 1024); } while (0)
#define ATT_LDV(dst, vbase, LEN, key0) do { const char* vb_ = (const char*)(vbase) + (size_t)(key0) * 128; _Pragma("unroll") for (int dt_ = 0; dt_ < 4; ++dt_) \
        dst[dt_] = *(const bf16x8*)(vb_ + koff + dt_ * 1024); } while (0)
#define ATT_SHADOW() int ln_ = F.lane; asm volatile("" : "+v"(ln_)); const int r16 = ln_ & 15, kg = ln_ >> 4, hl = r16 & 3; const unsigned koff = (unsigned)ln_ * 16u
    {
        ATT_SHADOW();
        bf16x8 qf[2][2]; float mrc[2], lpart[2], carry[2] = {0.f, 0.f}; int nlim[2]; f32x4 o[2][4];
#pragma unroll
        for (int rt = 0; rt < 2; ++rt) { const int q = 8 * w + 4 * rt + (r16 >> 2);
#pragma unroll
            for (int ks = 0; ks < 2; ++ks) qf[rt][ks] = *(const bf16x8*)(Qg + (size_t)q * 512 + hl * 64 + ks * 32 + kg * 8);
            mrc[rt] = mref[q * 4 + hl] * P.kcmax; lpart[rt] = 0.f; nlim[rt] = (t0 + q - 31) >> 4;
#pragma unroll
            for (int dt = 0; dt < 4; ++dt) o[rt][dt] = (f32x4){0.f, 0.f, 0.f, 0.f}; }
        const int nkeys = 4 * qb + 3, NP = (nkeys + 31) >> 5;
        const int nlim_min = (t0 + 8 * w - 31) >> 4;
        const bf16_t* Kc = P.KCMP + (size_t)(b * 2 + g) * 512 * 64; const bf16_t* Vc = P.VCT + (size_t)(b * 2 + g) * 64 * 512;
#define ATT_S1_STEP(KF, VF, s_) do { _Pragma("unroll") for (int rt = 0; rt < 2; ++rt) { \
            f32x4 st[2]; float p[2][4]; \
            _Pragma("unroll") for (int u = 0; u < 2; ++u) { st[u] = MFMA16(KF[u][0], qf[rt][0], ((f32x4){0.f, 0.f, 0.f, 0.f})); st[u] = MFMA16(KF[u][1], qf[rt][1], st[u]); } \
            _Pragma("unroll") for (int u = 0; u < 2; ++u) _Pragma("unroll") for (int i = 0; i < 4; ++i) p[u][i] = fast_exp2(st[u][i] - mrc[rt]); \
            if (32 * (s_) + 31 > nlim_min) { _Pragma("unroll") for (int u = 0; u < 2; ++u) _Pragma("unroll") for (int i = 0; i < 4; ++i) { const int n = 32 * (s_) + 8 * kg + 4 * u + i; if (n > nlim[rt]) p[u][i] = 0.f; } } \
            const float s01 = (p[0][0] + p[0][1]) + (p[0][2] + p[0][3]), s11 = (p[1][0] + p[1][1]) + (p[1][2] + p[1][3]); lpart[rt] += s01 + s11; \
            {   \
                \
              const unsigned x_ = __float_as_uint(p[1][3]); const auto s16_ = __builtin_amdgcn_permlane16_swap(x_, x_, false, false); const auto s32_ = __builtin_amdgcn_permlane32_swap(s16_[1], s16_[1], false, false); \
              const float inc_ = (kg & 1) ? __uint_as_float(s16_[0]) : ((kg == 2) ? __uint_as_float(s32_[0]) : carry[rt]); carry[rt] = __uint_as_float(s32_[1]); \
              LAS float* ur = U + ((8 * w + 4 * rt + (r16 >> 2)) * 4 + hl) * USP + 8 * (s_) + 2 * kg; \
              ur[0] += (2.f * s01 - p[0][3]) + inc_; ur[1] += (2.f * s11 - p[1][3]) + p[0][3]; } \
            u32x4 pw; pw.x = cvtpk(p[0][0], p[0][1]); pw.y = cvtpk(p[0][2], p[0][3]); pw.z = cvtpk(p[1][0], p[1][1]); pw.w = cvtpk(p[1][2], p[1][3]); \
            const bf16x8 pf = __builtin_bit_cast(bf16x8, pw); \
            _Pragma("unroll") for (int dt = 0; dt < 4; ++dt) o[rt][dt] = MFMA16(VF[dt], pf, o[rt][dt]); } } while (0)
        {
            bf16x8 kA[2][2], vA[4], kB[2][2], vB[4];
            ATT_LDK(kA, Kc, 0); ATT_LDV(vA, Vc, 512, 0); if (NP > 1) { ATT_LDK(kB, Kc, 32); ATT_LDV(vB, Vc, 512, 32); }
#pragma nounroll
            for (int s2 = 0; s2 < NP; s2 += 2) {
                ATT_S1_STEP(kA, vA, s2);
                if (s2 + 2 < NP) { ATT_LDK(kA, Kc, 32 * (s2 + 2)); ATT_LDV(vA, Vc, 512, 32 * (s2 + 2)); }
                if (s2 + 1 < NP) { ATT_S1_STEP(kB, vB, s2 + 1);
                    if (s2 + 3 < NP) { ATT_LDK(kB, Kc, 32 * (s2 + 3)); ATT_LDV(vB, Vc, 512, 32 * (s2 + 3)); } }
            }
        }
#undef ATT_S1_STEP
#pragma unroll
        for (int rt = 0; rt < 2; ++rt) { const int q = 8 * w + 4 * rt + (r16 >> 2); const float lrow = kg_sum(lpart[rt]); const float linv = lrow > 0.f ? 1.f / lrow : 0.f;
            if (kg == 0) linvc[q * 4 + hl] = linv;
            const float gc = P.GATES[(tokb + t0 + q) * 24 + (g * 4 + hl) * 3 + 0] * linv;
            float* yp = P.YPART + (tokb + t0 + q) * 512 + (g * 4 + hl) * 64 + 4 * kg;
#pragma unroll
            for (int dt = 0; dt < 4; ++dt) *(f32x4*)(yp + dt * 16) = o[rt][dt] * gc; }
    }
    LDS_WAIT();
#pragma nounroll
    for (int qg = 0; qg < 2; ++qg) {
        if (qb <= 15) {
            if (lane < 4) { const int q = 8 * w + 4 * qg + lane; const unsigned long long m0 = (1ull << (qb + 1)) - 1ull;
                selm[q * 4 + 0] = (unsigned)m0; selm[q * 4 + 1] = (unsigned)(m0 >> 32); selm[q * 4 + 2] = 0u; selm[q * 4 + 3] = 0u; }
        } else {
            const int j0 = lane, j1 = lane + 64; int v0[4], v1[4], thr[4];
#pragma unroll
            for (int k = 0; k < 4; ++k) { const int q = 8 * w + 4 * qg + k; const LAS float* ur = U + (q * 4) * USP; const LAS float* li = linvc + q * 4;
                float i0 = 0.f, i1 = 0.f;
#pragma unroll
                for (int h = 0; h < 4; ++h) { i0 += ur[h * USP + j0] * li[h]; i1 += ur[h * USP + j1] * li[h]; }
                v0[k] = (j0 >= 1 && j0 <= qb - 2) ? (int)__float_as_uint(i0) : -1;
                v1[k] = (j1 <= qb - 2) ? (int)__float_as_uint(i1) : -1; thr[k] = 0; }
#pragma nounroll
            for (int bit = 30; bit >= 0; --bit) {
                const int c0_ = thr[0] | (1 << bit), c1_ = thr[1] | (1 << bit), c2_ = thr[2] | (1 << bit), c3_ = thr[3] | (1 << bit);
                const unsigned long long a0_ = __ballot(v0[0] >= c0_), a1_ = __ballot(v0[1] >= c1_), a2_ = __ballot(v0[2] >= c2_), a3_ = __ballot(v0[3] >= c3_);
                const unsigned long long b0_ = __ballot(v1[0] >= c0_), b1_ = __ballot(v1[1] >= c1_), b2_ = __ballot(v1[2] >= c2_), b3_ = __ballot(v1[3] >= c3_);
                asm volatile("" :: "s"(a0_), "s"(a1_), "s"(a2_), "s"(a3_), "s"(b0_), "s"(b1_), "s"(b2_), "s"(b3_));
                if (__popcll(a0_) + __popcll(b0_) >= 13) thr[0] = c0_;
                if (__popcll(a1_) + __popcll(b1_) >= 13) thr[1] = c1_;
                if (__popcll(a2_) + __popcll(b2_) >= 13) thr[2] = c2_;
                if (__popcll(a3_) + __popcll(b3_) >= 13) thr[3] = c3_; }
            const unsigned long long below = (1ull << lane) - 1ull;
#pragma nounroll
            for (int k = 0; k < 4; ++k) {
                const int vv0 = (k == 0) ? v0[0] : (k == 1) ? v0[1] : (k == 2) ? v0[2] : v0[3], vv1 = (k == 0) ? v1[0] : (k == 1) ? v1[1] : (k == 2) ? v1[2] : v1[3];
                const int th = (k == 0) ? thr[0] : (k == 1) ? thr[1] : (k == 2) ? thr[2] : thr[3];
                const bool gt0 = vv0 > th, gt1 = vv1 > th, eq0 = vv0 == th, eq1 = vv1 == th;
                const int need = 13 - (__popcll(__ballot(gt0)) + __popcll(__ballot(gt1)));
                const unsigned long long B0 = __ballot(eq0), B1 = __ballot(eq1);
                const int rk0 = __popcll(B0 & below), rk1 = __popcll(B0) + __popcll(B1 & below);
                unsigned long long m0 = __ballot(gt0 || (eq0 && rk0 < need)), m1 = __ballot(gt1 || (eq1 && rk1 < need));
                m0 |= 1ull;
                if (qb < 64) m0 |= (1ull << qb); else m1 |= (1ull << (qb - 64));
                if (qb - 1 < 64) m0 |= (1ull << (qb - 1)); else m1 |= (1ull << (qb - 65));
                if (lane == 0) { const int q = 8 * w + 4 * qg + k; selm[q * 4 + 0] = (unsigned)m0; selm[q * 4 + 1] = (unsigned)(m0 >> 32); selm[q * 4 + 2] = (unsigned)m1; selm[q * 4 + 3] = (unsigned)(m1 >> 32); } }
        }
    }
    __syncthreads();
    { u32x4 zz_ = {0u, 0u, 0u, 0u}; asm volatile("" : "+v"(zz_)); LAS u32x4* z4 = (LAS u32x4*)Oh; for (int i = tid; i < (2 * 256 * OSP) / 4; i += NTHREADS) z4[i] = zz_; }
    lsel[tid] = 0;
    if (tid == 0) wctr[0] = 0;
    { const unsigned m0 = selm[lane * 4 + (w >> 1)];
#pragma nounroll
      for (int jj = 0; jj < 16; ++jj) { const int j = 16 * w + jj; const bool hit = (j <= qb) && ((m0 >> (16 * (w & 1) + jj)) & 1u);
          const unsigned long long mk = __ballot(hit); if (hit) lists[j * 64 + __popcll(mk & ((1ull << lane) - 1ull))] = (unsigned char)lane;
          if (lane == 0) cnts[j] = __popcll(mk); } }
    __syncthreads();
    for (int rep5 = 0; rep5 < ((ATTREP & 8) ? NREP : 1); ++rep5)
    {
        if (rep5 > 0) { __syncthreads(); if (tid == 0) wctr[0] = 0; __syncthreads(); }
        ATT_SHADOW();
        const bf16_t* Ks = P.KS + (size_t)(b * 2 + g) * SEQ * 64; const bf16_t* Vs = P.VST + (size_t)(b * 2 + g) * 64 * SEQ;
        const float S1 = 1048576.f / fmaxf(P.vmax, 1e-30f);
#define ATT_FETCH(idx_) do { int i_ = 0; if (lane == 0) i_ = __hip_atomic_fetch_add(wctr, 1, __ATOMIC_RELAXED, __HIP_MEMORY_SCOPE_WORKGROUP); idx_ = __builtin_amdgcn_readfirstlane(i_); } while (0)
#define ATT_JOF(idx_) (((idx_) == 0) ? 0 : (((idx_) == 1) ? qb : (((idx_) == 2) ? qb - 1 : (idx_) - 2)))
        bf16x8 kn[2][2][2];
        int idx; ATT_FETCH(idx);
        if (idx <= qb) { const int j = ATT_JOF(idx); ATT_LDK(kn[0], Ks, 64 * j); ATT_LDK(kn[1], Ks, 64 * j + 32); }
#pragma nounroll
        while (idx <= qb) {
            const int j = ATT_JOF(idx);
            bf16x8 kf[2][2][2], vf[2][4];
#pragma unroll
            for (int sp = 0; sp < 2; ++sp) {
#pragma unroll
                for (int u = 0; u < 2; ++u) { kf[sp][u][0] = kn[sp][u][0]; kf[sp][u][1] = kn[sp][u][1]; } }
            ATT_LDV(vf[0], Vs, SEQ, 64 * j); ATT_LDV(vf[1], Vs, SEQ, 64 * j + 32);
            int idx2; ATT_FETCH(idx2);
            if (idx2 <= qb) { const int j2 = ATT_JOF(idx2); ATT_LDK(kn[0], Ks, 64 * j2); ATT_LDK(kn[1], Ks, 64 * j2 + 32); }
            const int cnt = cnts[j];
            const int nch = (cnt + 3) >> 2;
            bf16x8 qn0, qn1; int qnx; bool vnx;
            { const int qs = (r16 >> 2); vnx = qs < cnt; qnx = lists[j * 64 + (vnx ? qs : (cnt > 0 ? cnt - 1 : 0))];
              const bf16_t* qp = Qg + (size_t)qnx * 512 + hl * 64 + kg * 8; qn0 = *(const bf16x8*)qp; qn1 = *(const bf16x8*)(qp + 32); }
#pragma nounroll
            for (int c = 0; c < nch; ++c) {
                const bool valid = vnx; const int q = qnx; const int row = q * 4 + hl; const bf16x8 q0 = qn0, q1 = qn1;
                if (c + 1 < nch) { const int qs = 4 * (c + 1) + (r16 >> 2); vnx = qs < cnt; qnx = lists[j * 64 + (vnx ? qs : cnt - 1)];
                    const bf16_t* qp = Qg + (size_t)qnx * 512 + hl * 64 + kg * 8; qn0 = *(const bf16x8*)qp; qn1 = *(const bf16x8*)(qp + 32); }
                const float mr = mref[row] * P.kmax;
                f32x4 o[4];
                float ps = 0.f;
                const bool slow = (j == qb) || (4 * c + 4 > cnt);
#define ATT_CHUNK(MASKED) \
                _Pragma("unroll") for (int sp = 0; sp < 2; ++sp) { \
                    f32x4 st[2]; float p[2][4]; \
                    _Pragma("unroll") for (int u = 0; u < 2; ++u) { st[u] = MFMA16(kf[sp][u][0], q0, ((f32x4){0.f, 0.f, 0.f, 0.f})); st[u] = MFMA16(kf[sp][u][1], q1, st[u]); } \
                    _Pragma("unroll") for (int u = 0; u < 2; ++u) _Pragma("unroll") for (int i = 0; i < 4; ++i) { float e = fast_exp2(st[u][i] - mr); \
                        if (MASKED) { const int kk = 32 * sp + 8 * kg + 4 * u + i; if (!valid || (j == qb && kk > q)) e = 0.f; } p[u][i] = e; ps += e; } \
                    u32x4 pw; pw.x = cvtpk(p[0][0], p[0][1]); pw.y = cvtpk(p[0][2], p[0][3]); pw.z = cvtpk(p[1][0], p[1][1]); pw.w = cvtpk(p[1][2], p[1][3]); \
                    const bf16x8 pf = __builtin_bit_cast(bf16x8, pw); \
                    _Pragma("unroll") for (int dt = 0; dt < 4; ++dt) o[dt] = (sp == 0) ? MFMA16(vf[0][dt], pf, ((f32x4){0.f, 0.f, 0.f, 0.f})) : MFMA16(vf[1][dt], pf, o[dt]); }
                if (slow) { ATT_CHUNK(true) } else { ATT_CHUNK(false) }
#undef ATT_CHUNK
                ps = kg_sum(ps);
                if (valid) {
                    if (kg == 0) { const float xs = ps * 1048576.f, hf_ = __builtin_rintf(xs); __hip_atomic_fetch_add(lsel + row, (int)hf_, __ATOMIC_RELAXED, __HIP_MEMORY_SCOPE_WORKGROUP);
                        __hip_atomic_fetch_add(lsel + 256 + row, (int)((xs - hf_) * 1048576.f), __ATOMIC_RELAXED, __HIP_MEMORY_SCOPE_WORKGROUP); }
#pragma unroll
                    for (int dt = 0; dt < 4; ++dt)
#pragma unroll
                        for (int i = 0; i < 4; ++i) { const float xs = o[dt][i] * S1, hf_ = __builtin_rintf(xs); const int off = row * OSP + dt * 16 + 4 * kg + i;
                            __hip_atomic_fetch_add(Oh + off, (int)hf_, __ATOMIC_RELAXED, __HIP_MEMORY_SCOPE_WORKGROUP);
                            __hip_atomic_fetch_add(Ol + off, (int)((xs - hf_) * 1048576.f), __ATOMIC_RELAXED, __HIP_MEMORY_SCOPE_WORKGROUP); }
                }
            }
            idx = idx2;
        }
    }
    f32x4 yacc[2][4];
    {
        ATT_SHADOW();
        bf16x8 qf[2][2]; float mrw[2], lpart[2]; f32x4 o[2][4];
#pragma unroll
        for (int rt = 0; rt < 2; ++rt) { const int q = 8 * w + 4 * rt + (r16 >> 2);
#pragma unroll
            for (int ks = 0; ks < 2; ++ks) qf[rt][ks] = *(const bf16x8*)(Qg + (size_t)q * 512 + hl * 64 + ks * 32 + kg * 8);
            mrw[rt] = mref[q * 4 + hl] * P.kwmax; lpart[rt] = 0.f;
#pragma unroll
            for (int dt = 0; dt < 4; ++dt) o[rt][dt] = (f32x4){0.f, 0.f, 0.f, 0.f}; }
        const bf16_t* Kw = P.KW + (size_t)(b * 2 + g) * SEQ * 64; const bf16_t* Vw = P.VWT + (size_t)(b * 2 + g) * 64 * SEQ;
        const int jlo = qb >= 8 ? qb - 8 : 0; const int nit = 2 * (qb - jlo + 1);
#define ATT_S4_STEP(KF, VF, it_) do { const int jw_ = jlo + ((it_) >> 1), sp_ = (it_) & 1; const int mode_ = (jw_ == qb) ? 1 : ((jw_ == qb - 8) ? 2 : 0); \
        _Pragma("unroll") for (int rt = 0; rt < 2; ++rt) { \
            f32x4 st[2]; float p[2][4]; \
            _Pragma("unroll") for (int u = 0; u < 2; ++u) { st[u] = MFMA16(KF[u][0], qf[rt][0], ((f32x4){0.f, 0.f, 0.f, 0.f})); st[u] = MFMA16(KF[u][1], qf[rt][1], st[u]); } \
            _Pragma("unroll") for (int u = 0; u < 2; ++u) _Pragma("unroll") for (int i = 0; i < 4; ++i) p[u][i] = fast_exp2(st[u][i] - mrw[rt]); \
            if (mode_) { const int tq = 8 * w + 4 * rt + (r16 >> 2); \
                _Pragma("unroll") for (int u = 0; u < 2; ++u) _Pragma("unroll") for (int i = 0; i < 4; ++i) { const int kk = 32 * sp_ + 8 * kg + 4 * u + i; const bool vis = (mode_ == 1) ? (kk <= tq) : (kk > tq); if (!vis) p[u][i] = 0.f; } } \
            lpart[rt] += ((p[0][0] + p[0][1]) + (p[0][2] + p[0][3])) + ((p[1][0] + p[1][1]) + (p[1][2] + p[1][3])); \
            u32x4 pw; pw.x = cvtpk(p[0][0], p[0][1]); pw.y = cvtpk(p[0][2], p[0][3]); pw.z = cvtpk(p[1][0], p[1][1]); pw.w = cvtpk(p[1][2], p[1][3]); \
            const bf16x8 pf = __builtin_bit_cast(bf16x8, pw); \
            _Pragma("unroll") for (int dt = 0; dt < 4; ++dt) o[rt][dt] = MFMA16(VF[dt], pf, o[rt][dt]); } } while (0)
        {
            bf16x8 kA[2][2], vA[4], kB[2][2], vB[4];
            ATT_LDK(kA, Kw, 64 * jlo); ATT_LDV(vA, Vw, SEQ, 64 * jlo); ATT_LDK(kB, Kw, 64 * jlo + 32); ATT_LDV(vB, Vw, SEQ, 64 * jlo + 32);
#pragma nounroll
            for (int it = 0; it < nit; it += 2) {
                ATT_S4_STEP(kA, vA, it);
                if (it + 2 < nit) { ATT_LDK(kA, Kw, 64 * jlo + 32 * (it + 2)); ATT_LDV(vA, Vw, SEQ, 64 * jlo + 32 * (it + 2)); }
                ATT_S4_STEP(kB, vB, it + 1);
                if (it + 3 < nit) { ATT_LDK(kB, Kw, 64 * jlo + 32 * (it + 3)); ATT_LDV(vB, Vw, SEQ, 64 * jlo + 32 * (it + 3)); }
            }
        }
#undef ATT_S4_STEP
#pragma unroll
        for (int rt = 0; rt < 2; ++rt) { const int q = 8 * w + 4 * rt + (r16 >> 2); const float lw_ = kg_sum(lpart[rt]); const float sc = lw_ > 0.f ? P.GATES[(tokb + t0 + q) * 24 + (g * 4 + hl) * 3 + 2] / lw_ : 0.f;
#pragma unroll
            for (int dt = 0; dt < 4; ++dt) yacc[rt][dt] = o[rt][dt] * sc; }
    }
    __syncthreads();
#pragma unroll
    for (int rt = 0; rt < 2; ++rt) { const int q = 8 * w + 4 * rt + (r16 >> 2), row = q * 4 + hl;
        const float lrow = (float)lsel[row] * (1.f / 1048576.f) + (float)lsel[256 + row] * (1.f / 1099511627776.f);
        const float invS1 = fmaxf(P.vmax, 1e-30f) * (1.f / 1048576.f);
        const float sc = lrow > 0.f ? P.GATES[(tokb + t0 + q) * 24 + (g * 4 + hl) * 3 + 1] / lrow * invS1 : 0.f;
        bf16_t* dst = P.Y + (tokb + t0 + q) * 1024 + 512 + (g * 4 + hl) * 64 + 4 * kg;
        const float* yp = P.YPART + (tokb + t0 + q) * 512 + (g * 4 + hl) * 64 + 4 * kg;
#pragma unroll
        for (int dt = 0; dt < 4; ++dt) { const LAS int* oh = Oh + row * OSP + dt * 16 + 4 * kg; const LAS int* ol = Ol + row * OSP + dt * 16 + 4 * kg;
            const f32x4 osel = (f32x4){(float)oh[0] + (float)ol[0] * (1.f / 1048576.f), (float)oh[1] + (float)ol[1] * (1.f / 1048576.f), (float)oh[2] + (float)ol[2] * (1.f / 1048576.f), (float)oh[3] + (float)ol[3] * (1.f / 1048576.f)};
            const f32x4 v = yacc[rt][dt] + *(const f32x4*)(yp + dt * 16) + osel * sc;
            u32x2 o; o.x = cvtpk(v[0], v[1]); o.y = cvtpk(v[2], v[3]); *(u32x2*)(dst + dt * 16) = o; } }
    __syncthreads();
}
#undef MFMA16
#undef ATT_LDK
#undef ATT_LDV
#undef ATT_SHADOW
#undef ATT_FETCH
#undef ATT_JOF
}

__device__ __forceinline__ void phase_n2(Frame& F, const Args& a, int l) {
    const int lane = F.lane, w = F.wave;
    const float* XR = WSP(float, WS_XR); unsigned char* H8 = WSP(unsigned char, WS_H8);
    const float* g = INP(a, float, I_N2G) + l * 1024;
    LAS float* part = (LAS float*)F.lds;
    LAS float* ssqp = (LAS float*)(F.lds + 32768);
    LAS float* lg = (LAS float*)(F.lds + 32768 + 1024);
    int* CNTI = WSP(int, WS_CNTI); int* ASG = WSP(int, WS_ASG); float* G4 = WSP(float, WS_GATE4);
    for (int item = F.vcu; item < T / 64; item += F.G) {
        const int tk0 = item * 64, b = tk0 >> 13; const int tt = w & 1, kq = w >> 1;
        const float* rwp = WSP(float, WS_RWP) + (size_t)(l * 2 + b) * 1024 * 32; const float* rbp = WSP(float, WS_MISC + 4096) + (l * 2 + b) * 32;
        const int i31 = lane & 31, hf = lane >> 5;
        {
            const float* xp = XR + (size_t)(tk0 + tt * 32 + i31) * DM + kq * 256 + 4 * hf; const float* wp = rwp + (size_t)(kq * 256 + 4 * hf) * 32 + i31;
            f32x16 acc;
#pragma unroll
            for (int r = 0; r < 16; ++r) acc[r] = 0.f;
            float ssq = 0.f;
#pragma nounroll
            for (int bt = 0; bt < 4; ++bt) {
                f32x4 xv[8]; float wv[8][4];
#pragma unroll
                for (int s = 0; s < 8; ++s) { xv[s] = *(const f32x4*)(xp + 8 * (bt * 8 + s)); const float* wq = wp + (size_t)(8 * (bt * 8 + s)) * 32;
                    wv[s][0] = wq[0]; wv[s][1] = wq[32]; wv[s][2] = wq[64]; wv[s][3] = wq[96]; }
#pragma unroll
                for (int s = 0; s < 8; ++s) { ssq += (xv[s].x * xv[s].x + xv[s].y * xv[s].y) + (xv[s].z * xv[s].z + xv[s].w * xv[s].w);
                    acc = __builtin_amdgcn_mfma_f32_32x32x2f32(xv[s].x, wv[s][0], acc, 0, 0, 0); acc = __builtin_amdgcn_mfma_f32_32x32x2f32(xv[s].y, wv[s][1], acc, 0, 0, 0);
                    acc = __builtin_amdgcn_mfma_f32_32x32x2f32(xv[s].z, wv[s][2], acc, 0, 0, 0); acc = __builtin_amdgcn_mfma_f32_32x32x2f32(xv[s].w, wv[s][3], acc, 0, 0, 0); }
            }
            ssq += __shfl_xor(ssq, 32);
            if (hf == 0) ssqp[kq * 64 + tt * 32 + i31] = ssq;
#pragma unroll
            for (int r = 0; r < 16; ++r) { const int tk = (r & 3) + 8 * (r >> 2) + 4 * hf; part[(w * 32 + tk) * 32 + i31] = acc[r]; }
        }
        __syncthreads();
        for (int i = F.tid; i < 64 * 32; i += NTHREADS) { const int tk = i >> 5, e = i & 31, t2 = tk >> 5, tl = tk & 31;
            const float sq = (ssqp[tk] + ssqp[64 + tk]) + (ssqp[128 + tk] + ssqp[192 + tk]); const float rstd = 1.f / sqrtf(sq * (1.f / DM) + NORM_EPS);
            const float v = (part[((0 * 2 + t2) * 32 + tl) * 32 + e] + part[((1 * 2 + t2) * 32 + tl) * 32 + e]) + (part[((2 * 2 + t2) * 32 + tl) * 32 + e] + part[((3 * 2 + t2) * 32 + tl) * 32 + e]);
            lg[tk * 33 + e] = v * rstd + rbp[e]; }
        __syncthreads();
        if (w < 2) {
            const int it = item * 2 + w;
            float v0 = -INFINITY, v1 = -INFINITY, v2 = -INFINITY, v3 = -INFINITY; int i0 = -1, i1 = -1, i2 = -1, i3 = -1;
            if (lane < 32) {
#pragma unroll 8
                for (int e = 0; e < 32; ++e) { const float v = lg[(w * 32 + lane) * 33 + e];
                    if (v > v3) { if (v > v2) { v3 = v2; i3 = i2; if (v > v1) { v2 = v1; i2 = i1; if (v > v0) { v1 = v0; i1 = i0; v0 = v; i0 = e; } else { v1 = v; i1 = e; } } else { v2 = v; i2 = e; } } else { v3 = v; i3 = e; } } }
            }
            const float e1 = __expf(v1 - v0), e2 = __expf(v2 - v0), e3 = __expf(v3 - v0); const float inv = 1.f / (1.f + e1 + e2 + e3);
            int r0 = 0, r1 = 0, r2 = 0, r3 = 0, mycnt = 0;
            for (int e = 0; e < 32; ++e) { const bool hit = (i0 == e) | (i1 == e) | (i2 == e) | (i3 == e); const unsigned long long U = __ballot(hit);
                const int rk = __popcll(U & ((1ull << lane) - 1ull));
                if (i0 == e) r0 = rk; if (i1 == e) r1 = rk; if (i2 == e) r2 = rk; if (i3 == e) r3 = rk;
                if (lane == e) mycnt = __popcll(U); }
            if (lane < 32) { const int tk = tk0 + w * 32 + lane; CNTI[it * 32 + lane] = mycnt;
                if (mycnt > 0) { atomicAdd(F.ctl + CW_GCNT + (l * 32 + (it >> 4)) * 32 + lane, (unsigned)mycnt); atomicAdd(F.ctl + CW_CNT + l * 32 + lane, (unsigned)mycnt); }
                *(int4*)(ASG + tk * 4) = make_int4((i0 << 16) | r0, (i1 << 16) | r1, (i2 << 16) | r2, (i3 << 16) | r3);
                *(f32x4*)(G4 + tk * 4) = (f32x4){inv, e1 * inv, e2 * inv, e3 * inv}; }
        }
#pragma unroll 2
        for (int rr = 0; rr < 8; ++rr) { const int m = tk0 + w * 8 + rr; const RowV r = row_load(XR + (size_t)m * DM, lane);
            const float rstd = 1.f / sqrtf(row_ssq(r) * (1.f / DM) + NORM_EPS);
            row_norm_store8(r, rstd, g, MODP(l, b, 4), MODP(l, b, 3), H8 + (size_t)m * DM, lane); }
        __syncthreads();
    }
}

__device__ __forceinline__ void phase_n2b(Frame& F, int l) {
    const int gw = F.vcu * NWAVES + F.wave, NGW = F.G * NWAVES; const int lane = F.lane;
    const int* CNTI = WSP(int, WS_CNTI); int* TOK = WSP(int, WS_TOK); int* ASG = WSP(int, WS_ASG); unsigned* cnt = F.ctl + CW_CNT + l * 32;
    for (int it = gw; it < T / 32; it += NGW) {
        int base = 0;
        {
            const unsigned* gc = F.ctl + CW_GCNT + l * 1024; const int grp = it >> 4, e = lane & 31; int s0 = 0, s1 = 0;
#pragma unroll
            for (int gI = 0; gI < 32; ++gI) { const int v = (int)gc[gI * 32 + e]; s0 += (gI < grp) ? v : 0; }
#pragma unroll
            for (int i = 0; i < 16; ++i) { const int v = CNTI[((grp << 4) + i) * 32 + e]; s1 += (((grp << 4) + i) < it) ? v : 0; }
            base = s0 + s1; }
        { const int tk = it * 32 + (lane & 31); const int4 as = *(const int4*)(ASG + tk * 4); int v[4] = {as.x, as.y, as.z, as.w};
#pragma unroll
            for (int k = 0; k < 4; ++k) { const int e = v[k] >> 16, rk = v[k] & 0xffff; const int sl = __shfl(base, e & 31) + rk; if (lane < 32) TOK[e * 16384 + sl] = tk; v[k] = (e << 16) | sl; }
            if (lane < 32) *(int4*)(ASG + tk * 4) = make_int4(v[0], v[1], v[2], v[3]); }
    }
}

__device__ __forceinline__ void moe_tables(Frame& F, int l, int NT, int& total) {
    LAS int* ust = (LAS int*)(F.lds + MOE_OFF); LAS int* bst = ust + 33; LAS int* cn = bst + 33;
    if (F.tid < 64) { const unsigned* cnt = F.ctl + CW_CNT + l * 32; const int lane = F.tid;
        const int c = (lane < NE) ? (int)cnt[lane] : 0; const int nb = (c + 255) >> 8; int inc = nb;
#pragma unroll
        for (int o = 1; o < 32; o <<= 1) { const int t = __shfl_up(inc, o); if ((lane & 31) >= o) inc += t; }
        if (lane < NE) { bst[lane] = inc - nb; ust[lane] = (inc - nb) * NT; cn[lane] = c; if (lane == NE - 1) { bst[NE] = inc; ust[NE] = inc * NT; } } }
    __syncthreads();
    total = ust[NE];
}

constexpr int PH_PROLOGUE = 0, PH_N1 = 1, PH_LAYER0 = 2, PH_PER_LAYER = 9, NPHASES = PH_LAYER0 + DEPTH * PH_PER_LAYER;
__global__ void __launch_bounds__(NTHREADS, 2) fwd_kernel(Args args) {
    extern __shared__ __attribute__((aligned(16))) unsigned char lds_raw[];
    Frame F;
    F.lds = (LAS unsigned char*)lds_raw; F.ws = args.ws; F.ctl = (unsigned*)(args.ws + WS_CTL);
    F.tid = threadIdx.x; F.lane = F.tid & 63; F.wave = __builtin_amdgcn_readfirstlane(F.tid >> 6);
    F.G = gridDim.x; { const int bx = blockIdx.x; F.vcu = (F.G % 8 == 0) ? (bx % 8) * (F.G / 8) + bx / 8 : bx; }
    for (int u = F.tid; u < (LDS_BYTES - LDSCTL_OFF) / 4; u += NTHREADS) ((LAS unsigned*)(F.lds + LDSCTL_OFF))[u] = 0u;
    __syncthreads();
    volatile LAS unsigned* MISC = (volatile LAS unsigned*)(F.lds + MISC_OFF);
    XcdBarrier bar; bar.bar = F.ctl + CW_BAR; bar.x = 0; bar.st = nullptr;
#if !MK_PER_PHASE
    bar = xcd_barrier_post(F.ctl + CW_BAR, MISC + 8);
#endif
    const int lo = args.ph_lo, hi = args.ph_hi;
#define IN(k) (lo <= (k) && (k) < hi)
#define REFRESH() do { int t_ = threadIdx.x; asm volatile("" : "+v"(t_)); F.tid = t_; F.lane = t_ & 63; F.wave = __builtin_amdgcn_readfirstlane(t_ >> 6); } while (0)
#define SEAM(k) do { if (IN(k) && IN((k) + 1)) xcd_barrier(bar); } while (0)
#define REPS(bit, idem) (((REPMASK & (bit)) && (idem)) ? NREP : 1)

    if (IN(PH_PROLOGUE) && !(SKIPMASK & 1)) for (int rep = 0; rep < REPS(1, true); ++rep) { REFRESH(); phase_prologue(F, args); } SEAM(PH_PROLOGUE);
    if (IN(PH_N1) && !(SKIPMASK & 2)) for (int rep = 0; rep < REPS(2, true); ++rep) { REFRESH(); phase_n1_first(F, args); } SEAM(PH_N1);
    for (int l = 0; l < DEPTH; ++l) {
        const int p0 = PH_LAYER0 + l * PH_PER_LAYER;
        if (IN(p0 + 0) && !(SKIPMASK & 4)) for (int rep = 0; rep < REPS(4, l == 0); ++rep) {
            { pg8::DenseOrder S; S.init(T, 2560, F.G, ({ int b_ = (int)blockIdx.x; asm volatile("" : "+s"(b_)); b_; }));
              EpiProj E{WSP(bf16_t, WS_UG), WSP(bf16_t, WS_VG), WSP(bf16_t, WS_Q), WSP(bf16_t, WS_KC), WSP(bf16_t, WS_VC), WSP(bf16_t, WS_KS), WSP(bf16_t, WS_KW), WSP(bf16_t, WS_VST), WSP(bf16_t, WS_VWT),
                        WSP(float, WS_GATES), WSP(float, WS_ROPE), F.ctl + CW_KMAX + l * 16, 0};
              pg8::gemm_phase<EpiProj, pg8::DenseOrder, false, true, true>(F.lds, WSP(bf16_t, WS_H8), (const bf16_t*)(WSP(unsigned char, WS_WIN8) + (size_t)l * 2560 * 1024), 512, S, E); }
        }
        SEAM(p0 + 0);
        if (IN(p0 + 1) && !(SKIPMASK & 8)) for (int rep = 0; rep < REPS(8, l == 0); ++rep) { REFRESH();
            for (int it = F.vcu; it < 256; it += F.G) { if (it < 128) sgu_item(F, args, l, it); else { compress_item(F, args, l, 2 * (it - 128)); compress_item(F, args, l, 2 * (it - 128) + 1); } }
        }
        SEAM(p0 + 1);
        if (IN(p0 + 2) && !(SKIPMASK & 16)) for (int rep = 0; rep < REPS(16, l == 0); ++rep) { REFRESH();
            att::Ptrs P{WSP(bf16_t, WS_Q), WSP(bf16_t, WS_KS), WSP(bf16_t, WS_KW), WSP(bf16_t, WS_VST), WSP(bf16_t, WS_VWT), WSP(bf16_t, WS_KCMP), WSP(bf16_t, WS_VCT), WSP(float, WS_GATES), WSP(bf16_t, WS_Y), WSP(float, WS_YPART), 0.f};
            for (int it = F.vcu; it < 512; it += F.G) {
                const int uu = (it < 256) ? it : (767 - it);
                const int bg = uu >> 7, qb = uu & 127;
                const unsigned* km = F.ctl + CW_KMAX + l * 16 + bg;
                P.kmax = sqrtf(__uint_as_float(__hip_atomic_load(km, __ATOMIC_RELAXED, __HIP_MEMORY_SCOPE_AGENT)));
                P.vmax = __uint_as_float(__hip_atomic_load(km + 4, __ATOMIC_RELAXED, __HIP_MEMORY_SCOPE_AGENT));
                P.kwmax = sqrtf(__uint_as_float(__hip_atomic_load(km + 8, __ATOMIC_RELAXED, __HIP_MEMORY_SCOPE_AGENT)));
                P.kcmax = sqrtf(__uint_as_float(__hip_atomic_load(km + 12, __ATOMIC_RELAXED, __HIP_MEMORY_SCOPE_AGENT)));
                att::attn_unit(F, P, bg >> 1, bg & 1, qb);
            }
        }
        SEAM(p0 + 2);
        if (IN(p0 + 3) && !(SKIPMASK & 32)) for (int rep = 0; rep < REPS(32, l == 0); ++rep) {
            pg8::DenseOrder S; S.init(T, DM, F.G, ({ int b_ = (int)blockIdx.x; asm volatile("" : "+s"(b_)); b_; }));
            EpiOut E{l == 0 ? INP(args, float, I_X) : WSP(float, WS_XR), WSP(float, WS_XR), (const float*)(F.ctl + CW_MOD) + (size_t)l * 2 * 6144};
            pg8::gemm_phase<EpiOut, pg8::DenseOrder, false, true>(F.lds, WSP(bf16_t, WS_Y), WSP(bf16_t, WS_WOUT) + (size_t)l * 1024 * 1024, 1024, S, E);
        }
        SEAM(p0 + 3);
        if (IN(p0 + 4) && !(SKIPMASK & 64)) for (int rep = 0; rep < REPS(64, l == 0); ++rep) { REFRESH(); phase_n2(F, args, l); }
        SEAM(p0 + 4);
        if (IN(p0 + 5) && !(SKIPMASK & 64)) for (int rep = 0; rep < REPS(1024, l == 0); ++rep) { REFRESH(); phase_n2b(F, l); }
        SEAM(p0 + 5);
        if (IN(p0 + 6) && !(SKIPMASK & 128)) for (int rep = 0; rep < REPS(128, l == 0); ++rep) { REFRESH();
            int total; moe_tables(F, l, 8, total);
            LAS int* ust = (LAS int*)(F.lds + MOE_OFF);
            pg8::MoeOrder S{ust, ust + 33, ust + 66, WSP(int, WS_TOK), 8, F.G, F.vcu, total, 1024};
            EpiSwiglu E{WSP(unsigned char, WS_ACT), INP(args, float, I_EB1) + (size_t)l * NE * 2048};
            pg8::gemm_phase<EpiSwiglu, pg8::MoeOrder, true, true, true>(F.lds, WSP(bf16_t, WS_H8), (const bf16_t*)(WSP(unsigned char, WS_W1T) + (size_t)l * NE * 2048 * 1024), 512, S, E);
        }
        SEAM(p0 + 6);
        if (IN(p0 + 7) && !(SKIPMASK & 256)) for (int rep = 0; rep < REPS(256, l == 0); ++rep) { REFRESH();
            int total; moe_tables(F, l, 4, total);
            LAS int* ust = (LAS int*)(F.lds + MOE_OFF);
            pg8::MoeOrder S{ust, ust + 33, ust + 66, WSP(int, WS_TOK), 4, F.G, F.vcu, total, 1024};
            EpiDown E{WSP(unsigned char, WS_YROWS), INP(args, float, I_EB2) + (size_t)l * NE * 1024};
            pg8::gemm_phase<EpiDown, pg8::MoeOrder, false, true, true>(F.lds, WSP(bf16_t, WS_ACT), (const bf16_t*)(WSP(unsigned char, WS_W2T) + (size_t)l * NE * 1024 * 1024), 512, S, E);
        }
        SEAM(p0 + 7);
        if (IN(p0 + 8) && !(SKIPMASK & 512)) for (int rep = 0; rep < REPS(512, l == DEPTH - 1); ++rep) { REFRESH(); phase_combine(F, args, l); }
        if (l + 1 < DEPTH) SEAM(p0 + 8);
    }
#undef IN
#undef SEAM
}

extern "C" void kernel_launch(void* const* d_in, const int* in_sizes, int n_in, void* d_out, int out_size, void* d_ws, size_t ws_size, hipStream_t stream) {
    static int grid = 0;
    if (grid == 0) {
        if (n_in != 26 || out_size != T * DM || ws_size < WS_END) { fprintf(stderr, "kernel_launch: unexpected problem (n_in %d, out %d, ws %zu; need ws >= %zu)\n", n_in, out_size, ws_size, (size_t)WS_END); grid = -1; return; }
        int dev = 0, cus = 0, per_cu = 0;
        if (hipGetDevice(&dev) != hipSuccess || hipDeviceGetAttribute(&cus, hipDeviceAttributeMultiprocessorCount, dev) != hipSuccess) { grid = -1; return; }
        if (hipFuncSetAttribute((const void*)fwd_kernel, hipFuncAttributeMaxDynamicSharedMemorySize, LDS_BYTES) != hipSuccess) { fprintf(stderr, "kernel_launch: hipFuncSetAttribute failed\n"); grid = -1; return; }
        if (hipOccupancyMaxActiveBlocksPerMultiprocessor(&per_cu, (const void*)fwd_kernel, NTHREADS, LDS_BYTES) != hipSuccess || per_cu < 1) { fprintf(stderr, "kernel_launch: occupancy query says %d\n", per_cu); (void)hipGetLastError(); per_cu = 1; }
        grid = cus;
    }
    if (grid < 0) return;
    if (hipMemsetAsync((char*)d_ws + WS_CTL, 0, CTL_ZERO_BYTES, stream) != hipSuccess) { fprintf(stderr, "kernel_launch: memset failed\n"); return; }
    Args a{};
    for (int i = 0; i < 26; ++i) a.in[i] = d_in[i];
    a.out = (float*)d_out; a.ws = (unsigned char*)d_ws;
#if MK_PER_PHASE
    for (int p = 0; p < NPHASES; ++p) { a.ph_lo = p; a.ph_hi = p + 1; a.li = 0;
        hipLaunchKernelGGL(fwd_kernel, dim3(grid), dim3(NTHREADS), LDS_BYTES, stream, a); }
#else
    a.ph_lo = 0; a.ph_hi = NPHASES; a.li = 0;
    void* kargs[] = {&a};
    hipError_t e = hipLaunchCooperativeKernel((const void*)fwd_kernel, dim3(grid), dim3(NTHREADS), kargs, LDS_BYTES, stream);
    if (e != hipSuccess) fprintf(stderr, "kernel_launch: cooperative launch failed: %s (grid %d)\n", hipGetErrorString(e), grid);
#endif
}
```

```cpp
#include <hip/hip_runtime.h>
#include <cstdio>
#include <cstdint>

#ifndef SKIPMASK
#define SKIPMASK 0
#endif
#ifndef REPMASK
#define REPMASK 0
#endif
#ifndef NREP
#define NREP 3
#endif
#ifndef DUMMYINT
#define DUMMYINT 0
#endif
#ifndef ATTREP
#define ATTREP 0
#endif
#ifndef MK_PER_PHASE
#define MK_PER_PHASE 0
#endif

#define LAS __attribute__((address_space(3)))
typedef unsigned short bf16_t;
typedef short bf16x8 __attribute__((ext_vector_type(8)));
typedef float f32x4 __attribute__((ext_vector_type(4)));
typedef float f32x2 __attribute__((ext_vector_type(2)));
typedef float f32x16 __attribute__((ext_vector_type(16)));
typedef unsigned u32x4 __attribute__((ext_vector_type(4)));
typedef unsigned u32x2 __attribute__((ext_vector_type(2)));
typedef __bf16 bf16x2_t __attribute__((ext_vector_type(2)));
typedef int i32x4 __attribute__((ext_vector_type(4)));
typedef int i32x8 __attribute__((ext_vector_type(8)));

constexpr int BATCH = 2, SEQ = 8192, DM = 1024, T = BATCH * SEQ, DEPTH = 2;
constexpr int PIN = 2328, PINP = 2560;
constexpr int NE = 32, FF = 1024, TOPK = 4;
constexpr int NCMP = 511, NCMPP = 512;
constexpr float NORM_EPS = 1e-6f;
constexpr float W8SCALE = 64.f;
constexpr int W8_E8M0 = 0x79797979, ONE_E8M0 = 0x7f7f7f7f;
constexpr float QSCALE = 0.125f * 1.4426950408889634f;
constexpr int NWAVES = 8, NTHREADS = 512;

constexpr size_t MiB = 1u << 20;
constexpr size_t WS_CTL = 0, CTL_ZERO_BYTES = 1 * MiB;
constexpr size_t WS_WIN = 1 * MiB;
constexpr size_t WS_WOUT = 11 * MiB;
constexpr size_t WS_SGW = 15 * MiB;
constexpr size_t WS_CW1 = 15 * MiB + 512 * 1024;
constexpr size_t WS_ROPE = 17 * MiB;
constexpr size_t WS_RWP = 21 * MiB;
constexpr size_t WS_MISC = 21 * MiB + 512 * 1024;
constexpr size_t WS_W1T = 32 * MiB;
constexpr size_t WS_W2T = 288 * MiB;
constexpr size_t WS_XR = 416 * MiB;
constexpr size_t WS_H = 480 * MiB;
constexpr size_t WS_UG = 513 * MiB, WS_VG = 529 * MiB, WS_Q = 545 * MiB;
constexpr size_t WS_KC = 561 * MiB, WS_VC = 565 * MiB, WS_KS = 569 * MiB, WS_KW = 573 * MiB;
constexpr size_t WS_VST = 577 * MiB, WS_VWT = 581 * MiB;
constexpr size_t WS_GATES = 585 * MiB;
constexpr size_t WS_KCMP = 587 * MiB;
constexpr size_t WS_VCT = 587 * MiB + 512 * 1024;
constexpr size_t WS_Y = 588 * MiB;
constexpr size_t WS_TOK = 620 * MiB;
constexpr size_t WS_ASG = 622 * MiB;
constexpr size_t WS_GATE4 = 622 * MiB + 512 * 1024;
constexpr size_t WS_YPART = 912 * MiB;
constexpr size_t WS_CNTI = 623 * MiB;
constexpr size_t WS_ACT = 624 * MiB;
constexpr size_t WS_YROWS = 768 * MiB;
constexpr size_t WS_WIN8 = 962 * MiB;
constexpr size_t WS_H8 = 944 * MiB;
constexpr size_t WS_END = 968 * MiB;
constexpr int CW_BAR = 4096;
constexpr int CW_MOD = 16384;
constexpr int CW_CNT = 40960;
constexpr int CW_KMAX = 41088;
constexpr int CW_GCNT = 41216;

__device__ __forceinline__ unsigned cvtpk(float lo, float hi) { f32x2 v = {lo, hi}; bf16x2_t b = __builtin_convertvector(v, bf16x2_t); return __builtin_bit_cast(unsigned, b); }
__device__ __forceinline__ unsigned cvt4_fp8(float a, float b, float c, float d) { int w = 0; w = __builtin_amdgcn_cvt_pk_fp8_f32(a, b, w, false); w = __builtin_amdgcn_cvt_pk_fp8_f32(c, d, w, true); return (unsigned)w; }
__device__ __forceinline__ float bf2f(unsigned short b) { return __uint_as_float((unsigned)b << 16); }
__device__ __forceinline__ float bflo(unsigned w) { return __uint_as_float(w << 16); }
__device__ __forceinline__ float bfhi(unsigned w) { return __uint_as_float(w & 0xffff0000u); }
__device__ __forceinline__ float fast_exp2(float x) { return __builtin_amdgcn_exp2f(x); }
__device__ __forceinline__ float fast_rcp(float x) { return __builtin_amdgcn_rcpf(x); }
__device__ __forceinline__ float sigmoidf_(float x) { return fast_rcp(1.f + fast_exp2(-1.4426950408889634f * x)); }
__device__ __forceinline__ float gelu_tanh(float x) { const float u = 0.7978845608028654f * (x + 0.044715f * x * x * x); return x * fast_rcp(1.f + fast_exp2(-2.885390081777927f * u)); }

__device__ __forceinline__ float x16_sum(float x) { auto r = __builtin_amdgcn_permlane16_swap(__float_as_uint(x), __float_as_uint(x), false, false); return __uint_as_float(r[0]) + __uint_as_float(r[1]); }
__device__ __forceinline__ float x32_sum(float x) { auto r = __builtin_amdgcn_permlane32_swap(__float_as_uint(x), __float_as_uint(x), false, false); return __uint_as_float(r[0]) + __uint_as_float(r[1]); }
__device__ __forceinline__ float x16_max(float x) { auto r = __builtin_amdgcn_permlane16_swap(__float_as_uint(x), __float_as_uint(x), false, false); return fmaxf(__uint_as_float(r[0]), __uint_as_float(r[1])); }
__device__ __forceinline__ float x32_max(float x) { auto r = __builtin_amdgcn_permlane32_swap(__float_as_uint(x), __float_as_uint(x), false, false); return fmaxf(__uint_as_float(r[0]), __uint_as_float(r[1])); }
__device__ __forceinline__ float kg_sum(float x) { return x32_sum(x16_sum(x)); }
__device__ __forceinline__ float kg_max(float x) { return x32_max(x16_max(x)); }
__device__ __forceinline__ float quad_sum(float x) { x += __uint_as_float(__builtin_amdgcn_update_dpp(0u, __float_as_uint(x), 0xB1, 0xF, 0xF, true)); x += __uint_as_float(__builtin_amdgcn_update_dpp(0u, __float_as_uint(x), 0x4E, 0xF, 0xF, true)); return x; }
__device__ __forceinline__ float wave_sum(float v) {
    v = quad_sum(v);
    v += __uint_as_float(__builtin_amdgcn_update_dpp(0u, __float_as_uint(v), 0x141, 0xF, 0xF, true));
    v += __uint_as_float(__builtin_amdgcn_update_dpp(0u, __float_as_uint(v), 0x140, 0xF, 0xF, true));
    return x32_sum(x16_sum(v));
}
#define LDS_WAIT() asm volatile("s_waitcnt lgkmcnt(0)" ::: "memory")
#define VM_WAIT() asm volatile("s_waitcnt vmcnt(0)" ::: "memory")

__device__ __forceinline__ int kfrag_off(int key, int c8) {
    const int s = key >> 5, ko = key & 31, u = (ko >> 2) & 1, r16 = ((ko >> 3) << 2) | (ko & 3), ks = c8 >> 2, kg = c8 & 3;
    return s * 2048 + (u * 2 + ks) * 512 + (kg * 16 + r16) * 8;
}
__device__ __forceinline__ int vfrag_off(int key, int d) {
    const int s = key >> 5, ko = key & 31;
    return s * 2048 + (d >> 4) * 512 + ((ko >> 3) * 16 + (d & 15)) * 8 + (ko & 7);
}
namespace pg8 {
constexpr int BM = 256, BK = 64, HALF = 128, HTB = HALF * BK * 2, STAGE_BYTES = 8 * HTB, NXCD = 8, WGM = 4;
__host__ __device__ __forceinline__ int lds_byte(int r, int c) { const int st = (r >> 4) * 2 + (c >> 5), rr = r & 15, cc = c & 31, ob = rr * 64 + cc * 2; return st * 1024 + (ob ^ (((ob >> 9) & 1) << 5)); }
__host__ __device__ __forceinline__ void stage_rc(int b, int& R, int& C) { const int st = b / 1024, sb = b % 1024, swz = sb ^ (((sb >> 9) & 1) << 5); R = (st >> 1) * 16 + swz / 64; C = (st & 1) * 32 + (swz % 64) / 2; }
__host__ __device__ __forceinline__ int perm32(int rho) { const int n = rho >> 4, i = rho & 15; return 8 * (i >> 2) + 4 * n + (i & 3); }

struct Unit { int pm, pn, e, pnl, rloc, hs, rot; };

__device__ __forceinline__ bool unit_index(int i, int G, int c, int total, int& L, int& hs) {
    const int nfr = total / G, R = total - nfr * G; hs = 0;
    if (i < nfr) { L = i * G + c; return true; }
    if (i > nfr || R == 0) return false;
    if (2 * R <= G) { if (c >= 2 * R) return false; const int h = c >= R ? 1 : 0; L = nfr * G + c - h * R; hs = 1 + h; return true; }
    if (c >= R) return false;
    L = nfr * G + c; return true;
}

struct DenseOrder {
    static constexpr bool SPLIT = false;
    int nM, nN, nwg, G, c;
    __device__ void init(int M, int N, int G_, int c_) { nM = M / BM; nN = N / BM; nwg = nM * nN; G = G_; c = c_; }
    __device__ bool next(int i, Unit& u) const {
        const long L = (long)i * G + c; if (L >= nwg) return false;
        u.hs = 0; int wgid = (int)L; { const int q = nwg / NXCD, r = nwg % NXCD, xcd = wgid % NXCD, off = wgid / NXCD; wgid = (xcd < r ? xcd * (q + 1) : r * (q + 1) + (xcd - r) * q) + off; }
        const int nig = WGM * nN, gid = wgid / nig, fm = gid * WGM, gsz = (nM - fm) < WGM ? (nM - fm) : WGM;
        u.pm = fm + ((wgid % nig) % gsz); u.pn = (wgid % nig) / gsz; u.e = 0; u.pnl = u.pn; u.rloc = 0; u.rot = (u.pm + u.pn) & 3; return true;
    }
    __device__ __forceinline__ unsigned rowoff(const Unit&, int) const { return 0u; }
};

struct MoeOrder {
    static constexpr bool SPLIT = true;
    const LAS int* ust;
    const LAS int* bst;
    const LAS int* cnt;
    const int* tok;
    int NT, G, c, total, rowbytes;
    __device__ bool next(int i, Unit& u) const {
        int L, hs; if (!unit_index(i, G, c, total, L, hs)) return false;
        u.hs = hs; int e = 0;
        for (int k = 1; k < NE; ++k) e += (L >= ust[k]) ? 1 : 0;
        e = __builtin_amdgcn_readfirstlane(e);
        const int loc = __builtin_amdgcn_readfirstlane(L - ust[e]), b0 = __builtin_amdgcn_readfirstlane(bst[e]), nb = __builtin_amdgcn_readfirstlane(bst[e + 1]) - b0;
        u.e = e; u.pnl = loc / nb; u.rloc = loc - u.pnl * nb; u.pm = b0 + u.rloc; u.pn = e * NT + u.pnl; u.rot = (u.rloc + u.pnl) & 3; return true;
    }
    __device__ __forceinline__ unsigned rowoff(const Unit& u, int r) const {
        const int slot = u.rloc * 256 + r + (u.hs == 2 ? 128 : 0); const int tk = slot < cnt[u.e] ? tok[u.e * 16384 + slot] : T;
        return (unsigned)tk * (unsigned)rowbytes;
    }
};

template <class Epi, class Sched, bool GATHER, bool ALIGN_EPI, bool FP8 = false>
__device__ __forceinline__ void gemm_phase(LAS unsigned char* lds, const bf16_t* A, const bf16_t* Bt, const int K, const Sched& S, const Epi& E) {
    int tid_ = threadIdx.x; asm volatile("" : "+v"(tid_));
    const int tid = tid_, wid = __builtin_amdgcn_readfirstlane(tid >> 6), lane = tid & 63, wr = wid >> 2, wc = wid & 3, fr = lane & 15, fq = lane >> 4;
    const int nt = K / BK;
    unsigned voffB[2];
#pragma unroll
    for (int i = 0; i < 2; ++i) { int R, C; stage_rc(tid * 16 + i * 8192, R, C); const int Rb = Epi::PERM ? ((R & ~31) + perm32(R & 31)) : R; voffB[i] = (unsigned)(Rb * K + C) * 2u; }
    const size_t kstep = (size_t)(BK * 2);
    const size_t hstep = (size_t)HALF * K * 2;
    const size_t tstep = 2 * hstep;
    const unsigned ldsw = (unsigned)wid * 1024u;
    const int aoff = lds_byte(wr * 64 + fr, fq * 8), boff = lds_byte(wc * 32 + fr, fq * 8);
#define PG8_SA(b, h) (((b) * 2 + (h)) * HTB)
#define PG8_SB(b, h) ((4 + (b) * 2 + (h)) * HTB)
#define PG8_STAGE(bufoff, gbase, v0, v1) do { \
        __builtin_amdgcn_global_load_lds((const unsigned*)((const char*)(gbase) + (v0)), (LAS unsigned*)(lds + (bufoff) + ldsw), 16, 0, 0); \
        __builtin_amdgcn_global_load_lds((const unsigned*)((const char*)(gbase) + (v1)), (LAS unsigned*)(lds + (bufoff) + ldsw + 8192), 16, 0, 0); } while (0)
#define PG8_STAGEB(bufoff, gbase) PG8_STAGE(bufoff, gbase, voffB[0], voffB[1])
#define PG8_CAT8(x0, x1) __builtin_shufflevector(x0, x1, 0, 1, 2, 3, 4, 5, 6, 7)
#define PG8_RD4(off) (*(const LAS i32x4*)(lds + (off)))
#define PG8_LDA(dst, b, h) do { if constexpr (FP8) { _Pragma("unroll") for (int m = 0; m < 4; ++m) dst##8[m] = PG8_CAT8(PG8_RD4(PG8_SA(b, h) + aoff + m * 2048), PG8_RD4(PG8_SA(b, h) + aoff + m * 2048 + 1024)); } \
        else { _Pragma("unroll") for (int m = 0; m < 4; ++m) _Pragma("unroll") for (int k = 0; k < 2; ++k) dst[m][k] = *(const LAS bf16x8*)(lds + PG8_SA(b, h) + aoff + m * 2048 + k * 1024); } } while (0)
#define PG8_LDB(dst, b, h) do { if constexpr (FP8) { _Pragma("unroll") for (int n = 0; n < 2; ++n) dst##8[n] = PG8_CAT8(PG8_RD4(PG8_SB(b, h) + boff + n * 2048), PG8_RD4(PG8_SB(b, h) + boff + n * 2048 + 1024)); } \
        else { _Pragma("unroll") for (int n = 0; n < 2; ++n) _Pragma("unroll") for (int k = 0; k < 2; ++k) dst[n][k] = *(const LAS bf16x8*)(lds + PG8_SB(b, h) + boff + n * 2048 + k * 1024); } } while (0)
#define PG8_MMA(ai, bj, At, Bt_) do { __builtin_amdgcn_s_setprio(1); _Pragma("unroll") for (int m = 0; m < 4; ++m) _Pragma("unroll") for (int n = 0; n < 2; ++n) { \
        if constexpr (FP8) { asm volatile("v_mfma_scale_f32_16x16x128_f8f6f4 %0, %1, %2, %0, %3, %4 op_sel_hi:[0,0,0]" : "+v"(acc[ai][bj][m][n]) : "v"(Bt_##8[n]), "v"(At##8[m]), "v"(sc_w), "v"(sc_x)); } \
        else { _Pragma("unroll") for (int k = 0; k < 2; ++k) acc[ai][bj][m][n] = __builtin_amdgcn_mfma_f32_16x16x32_bf16(Bt_[n][k], At[m][k], acc[ai][bj][m][n], 0, 0, 0); } } \
        __builtin_amdgcn_s_setprio(0); } while (0)
#define PG8_WAIT_V(n) asm volatile("s_waitcnt vmcnt(" #n ")" ::: "memory")
#define PG8_WAIT_L(n) asm volatile("s_waitcnt lgkmcnt(" #n ")" ::: "memory")
#define PG8_BAR __builtin_amdgcn_s_barrier()
#define PG8_SCHED __builtin_amdgcn_sched_barrier(0)
#define PG8_SETV(v, u) do { int t2_ = tid; asm volatile("" : "+v"(t2_)); _Pragma("unroll") for (int i_ = 0; i_ < 2; ++i_) { int R_, C_; stage_rc(t2_ * 16 + i_ * 8192, R_, C_); _Pragma("unroll") for (int h_ = 0; h_ < 2; ++h_) \
        v[h_][i_] = GATHER ? (S.rowoff(u, R_ + HALF * h_) + (unsigned)C_ * 2u) : (unsigned)((R_ + HALF * h_) * K + C_) * 2u; } } while (0)
    Unit cur, nxt; int ui = 0;
    if (!S.next(0, cur)) return;
    unsigned vc[2][2], vn[2][2];
    PG8_SETV(vc, cur);
    f32x4 acc[2][2][4][2];
#pragma unroll
    for (int a = 0; a < 2; ++a)
#pragma unroll
        for (int b = 0; b < 2; ++b)
#pragma unroll
            for (int m = 0; m < 4; ++m)
#pragma unroll
                for (int n = 0; n < 2; ++n) acc[a][b][m][n] = (f32x4){0.f, 0.f, 0.f, 0.f};
    bf16x8 At[4][2], B0[2][2], B1[2][2]; i32x8 At8[4], B08[2], B18[2];
    int sc_w = W8_E8M0, sc_x = ONE_E8M0; asm volatile("" : "+v"(sc_w), "+v"(sc_x));
    const char* cA = GATHER ? (const char*)A : (const char*)A + (size_t)cur.pm * tstep + (cur.hs == 2 ? hstep : (size_t)0);
    const char* cB = (const char*)Bt + (size_t)cur.pn * tstep;
    const int nq = nt >> 2;
    { const size_t r0 = (size_t)(cur.rot * nq) * kstep;
    PG8_STAGEB(PG8_SB(0, 0), cB + r0); PG8_STAGEB(PG8_SB(0, 1), cB + r0 + hstep); PG8_STAGE(PG8_SA(0, 0), cA + r0, vc[0][0], vc[0][1]); PG8_STAGE(PG8_SA(0, 1), cA + r0, vc[1][0], vc[1][1]);
    if (wr == 1) PG8_BAR;
    PG8_WAIT_V(2); PG8_BAR;
    PG8_STAGEB(PG8_SB(1, 0), cB + r0 + kstep); PG8_STAGE(PG8_SA(1, 0), cA + r0 + kstep, vc[0][0], vc[0][1]); PG8_STAGEB(PG8_SB(1, 1), cB + r0 + hstep + kstep); }
    PG8_WAIT_V(6); PG8_BAR;
    for (;;) {
        const bool has_next = S.next(ui + 1, nxt);
        const char* nA = GATHER ? (const char*)A : (has_next ? (const char*)A + (size_t)nxt.pm * tstep + (nxt.hs == 2 ? hstep : (size_t)0) : cA);
        const bool full = !Sched::SPLIT || cur.hs == 0;
        const char* nB = has_next ? (const char*)Bt + (size_t)nxt.pn * tstep : cB;
        if constexpr (GATHER) { if (has_next) { PG8_SETV(vn, nxt); } else {
#pragma unroll
            for (int h_ = 0; h_ < 2; ++h_)
#pragma unroll
                for (int i_ = 0; i_ < 2; ++i_) vn[h_][i_] = vc[h_][i_]; } }
        const size_t rn = (size_t)((has_next ? nxt.rot : cur.rot) * nq) * kstep;
        int kp = cur.rot * nq;
#pragma nounroll
        for (int t = 0; t < nt; t += 2) {
            const bool last = (t == nt - 2);
            int kn = kp + 2; kn = kn >= nt ? kn - nt : kn;
            const char* a1 = cA + (size_t)(kp + 1) * kstep;
            const char* a2 = last ? nA + rn : cA + (size_t)kn * kstep; const char* b2 = last ? nB + rn : cB + (size_t)kn * kstep; kp = kn;
            const char* a3 = a2 + kstep; const char* b3 = b2 + kstep;
            const unsigned w00 = (GATHER && last) ? vn[0][0] : vc[0][0], w01 = (GATHER && last) ? vn[0][1] : vc[0][1], w10 = (GATHER && last) ? vn[1][0] : vc[1][0], w11 = (GATHER && last) ? vn[1][1] : vc[1][1];
            PG8_LDB(B0, 0, 0); PG8_LDB(B1, 0, 1); PG8_SCHED; PG8_LDA(At, 0, 0); PG8_STAGE(PG8_SA(1, 1), a1, vc[1][0], vc[1][1]);
            PG8_WAIT_V(8); PG8_WAIT_L(0); PG8_BAR; PG8_MMA(0, 0, At, B0); PG8_MMA(0, 1, At, B1); PG8_BAR; PG8_SCHED;
            if (full) PG8_LDA(At, 0, 1); PG8_STAGEB(PG8_SB(0, 0), b2); PG8_STAGEB(PG8_SB(0, 1), b2 + hstep); PG8_STAGE(PG8_SA(0, 0), a2, w00, w01);
            PG8_WAIT_V(8); PG8_WAIT_L(0); PG8_BAR; if (full) { PG8_MMA(1, 0, At, B0); PG8_MMA(1, 1, At, B1); } PG8_BAR; PG8_SCHED;
            PG8_LDB(B0, 1, 0); PG8_LDB(B1, 1, 1); PG8_SCHED; PG8_LDA(At, 1, 0); PG8_STAGE(PG8_SA(0, 1), a2, w10, w11);
            PG8_WAIT_V(8); PG8_WAIT_L(0); PG8_BAR; PG8_MMA(0, 0, At, B0); PG8_MMA(0, 1, At, B1); PG8_BAR; PG8_SCHED;
            if (full) PG8_LDA(At, 1, 1); PG8_STAGEB(PG8_SB(1, 0), b3); PG8_STAGEB(PG8_SB(1, 1), b3 + hstep); PG8_STAGE(PG8_SA(1, 0), a3, w00, w01);
            PG8_WAIT_V(8); PG8_WAIT_L(0); PG8_BAR; if (full) { PG8_MMA(1, 0, At, B0); PG8_MMA(1, 1, At, B1); } PG8_BAR; PG8_SCHED;
        }
        if constexpr (FP8) { asm volatile("s_nop 15\n\ts_nop 15" ::: "memory"); }
        if constexpr (ALIGN_EPI) { if (wr == 0) PG8_BAR; }
        E(acc, cur, wr, wc, fr, fq);
        if (!has_next) break;
#pragma unroll
        for (int a = 0; a < 2; ++a)
#pragma unroll
            for (int b = 0; b < 2; ++b)
#pragma unroll
                for (int m = 0; m < 4; ++m)
#pragma unroll
                    for (int n = 0; n < 2; ++n) acc[a][b][m][n] = (f32x4){0.f, 0.f, 0.f, 0.f};
        cur = nxt; cA = nA; cB = nB; ++ui;
        if constexpr (GATHER) {
#pragma unroll
        for (int h_ = 0; h_ < 2; ++h_)
#pragma unroll
            for (int i_ = 0; i_ < 2; ++i_) vc[h_][i_] = vn[h_][i_]; }
        if constexpr (ALIGN_EPI) { if (wr == 1) PG8_BAR; }
    }
    PG8_WAIT_V(0);
    if constexpr (!ALIGN_EPI) { if (wr == 0) PG8_BAR; }
    PG8_BAR;
#undef PG8_SA
#undef PG8_SB
#undef PG8_STAGE
#undef PG8_STAGEB
#undef PG8_LDA
#undef PG8_LDB
#undef PG8_MMA
#undef PG8_CAT8
#undef PG8_RD4
#undef PG8_WAIT_V
#undef PG8_WAIT_L
#undef PG8_BAR
#undef PG8_SCHED
#undef PG8_SETV
}
}

#define XB_TMO      128
#define XB_XCNT(j)  (256  + 64 * (j))
#define XB_XSUB(j)  (1280 + 64 * (j))
#define XB_XGEN(j)  (2304 + 64 * (j))
#define XB_TOP      3328
#define XB_TOPGEN   3392
#define XCD_BAR_WORDS 3456
#define XB_SPIN_CAP (1u << 22)
__device__ __forceinline__ unsigned xb_ld(unsigned* p)              { return __hip_atomic_load(p, __ATOMIC_RELAXED, __HIP_MEMORY_SCOPE_AGENT); }
__device__ __forceinline__ unsigned xb_add(unsigned* p, unsigned v) { return __hip_atomic_fetch_add(p, v, __ATOMIC_RELAXED, __HIP_MEMORY_SCOPE_AGENT); }
__device__ __forceinline__ unsigned xb_xcc_id() { return (unsigned)__builtin_amdgcn_s_getreg((3 << 11) | 20) & 0xFu; }
#define XB_SPIN(cond, bar) do { unsigned _sp = 0; while (cond) { __builtin_amdgcn_s_sleep(1); \
    if ((++_sp & 255u) == 0u) { if (xb_ld(&(bar)[XB_TMO])) break; if (_sp > XB_SPIN_CAP) { atomicAdd(&(bar)[XB_TMO], 1u); break; } } } } while (0)
struct XcdBarrier { unsigned* bar; unsigned x; volatile LAS unsigned* st; };
__device__ __forceinline__ XcdBarrier xcd_barrier_post(unsigned* bar, volatile LAS unsigned* st) {
    XcdBarrier b; b.bar = bar; b.x = xb_xcc_id(); b.st = st;
    if (threadIdx.x == 0) (void)xb_add(&bar[XB_XCNT(b.x)], 1u);
    return b;
}
__device__ __forceinline__ void xcd_barrier_complete(unsigned* bar, unsigned x, unsigned& nloc, unsigned& nx) {
    const unsigned G = gridDim.x * gridDim.y * gridDim.z;
    unsigned sum, cnt, mine, sp = 0u;
    for (;;) {
        sum = 0u; cnt = 0u; mine = 0u;
#pragma unroll
        for (unsigned j = 0; j < 16; ++j) { const unsigned c = xb_ld(&bar[XB_XCNT(j)]); sum += c; cnt += (c > 0u) ? 1u : 0u; mine = (j == x) ? c : mine; }
        if (sum == G) break;
        __builtin_amdgcn_s_sleep(1);
        if ((++sp & 255u) == 0u) { if (xb_ld(&bar[XB_TMO])) break; if (sp > XB_SPIN_CAP) { atomicAdd(&bar[XB_TMO], 1u); break; } }
    }
    nloc = mine > 0u ? mine : 1u; nx = cnt > 0u ? cnt : 1u;
}
__device__ __forceinline__ void xcd_barrier(const XcdBarrier& b) {
    asm volatile("s_waitcnt vmcnt(0)" ::: "memory");
    __syncthreads();
    if (threadIdx.x == 0) {
        unsigned* bar = b.bar;
        __builtin_amdgcn_s_waitcnt(0);
        unsigned nloc = b.st[0], nx = b.st[1];
        if (nloc == 0u) { xcd_barrier_complete(bar, b.x, nloc, nx); b.st[0] = nloc; b.st[1] = nx; }
        const unsigned old = xb_add(&bar[XB_XSUB(b.x)], 1u);
        const unsigned gen = old / nloc;
        if (old + 1u == (gen + 1u) * nloc) {
            __builtin_amdgcn_fence(__ATOMIC_RELEASE, "agent");
            asm volatile("s_waitcnt vmcnt(0)" ::: "memory");
            const unsigned og = xb_add(&bar[XB_TOP], 1u);
            const unsigned tg = og / nx;
            if (og + 1u == (tg + 1u) * nx) xb_add(&bar[XB_TOPGEN], 1u);
            else XB_SPIN(xb_ld(&bar[XB_TOPGEN]) == tg, bar);
            __builtin_amdgcn_fence(__ATOMIC_ACQUIRE, "agent");
            xb_add(&bar[XB_XGEN(b.x)], 1u);
            asm volatile("s_waitcnt vmcnt(0)" ::: "memory");
        } else {
            XB_SPIN(xb_ld(&bar[XB_XGEN(b.x)]) == gen, bar);
            __builtin_amdgcn_fence(__ATOMIC_ACQUIRE, "agent");
            asm volatile("s_waitcnt vmcnt(0)" ::: "memory");
        }
    }
    __syncthreads();
}

struct Args { const void* in[26]; float* out; unsigned char* ws; int ph_lo, ph_hi, li, pad; };
enum { I_X = 0, I_C, I_POS, I_ADAW, I_ADAB, I_N1G, I_N2G, I_WIN, I_WOUT, I_SGLNG, I_SGLNB, I_SGW, I_SGB, I_PEK, I_PEV, I_CW1K, I_CW2K, I_CW1V, I_CW2V, I_RW, I_RB, I_EW1, I_EB1, I_EW2, I_EB2, I_FING };

#define GAS1 __attribute__((address_space(1)))
#define INP(A_, T_, i_) ({ int ix_ = (i_); asm volatile("" : "+s"(ix_)); (const T_*)(const GAS1 T_*)(A_).in[ix_]; })
struct Frame {
    LAS unsigned char* lds;
    unsigned* ctl;
    unsigned char* ws;
    int tid, lane, wave, vcu, G;
};
#define WSP(type, off) ((type*)(F.ws + (off)))
#define MODP(l, b, part) ((const float*)(F.ctl + CW_MOD) + ((size_t)((l) * 2 + (b)) * 6 + (part)) * 1024)

constexpr int RING_BYTES = 131072;
constexpr int ATT_LDS_BYTES = 147456;
constexpr int LDSCTL_OFF = ATT_LDS_BYTES;
constexpr int MISC_OFF = LDSCTL_OFF + 320;
constexpr int MOE_OFF = MISC_OFF + 128;
constexpr int LDS_BYTES = 163840;

struct EpiProj {
    static constexpr bool PERM = true;
    bf16_t *UG, *VG, *Q, *KC, *VC, *KS, *KW, *VST, *VWT; float* GATES; const float* ROPE; unsigned* kmax; int pn_off;
    __device__ __forceinline__ void operator()(const f32x4 (&acc)[2][2][4][2], const pg8::Unit& u, int wr_, int wc_, int fr_, int fq_) const {
        int t_ = threadIdx.x; asm volatile("" : "+v"(t_)); const int wid_ = __builtin_amdgcn_readfirstlane(t_ >> 6); const int wr = wid_ >> 2, wc = wid_ & 3, fr = t_ & 15, fq = (t_ & 63) >> 4; (void)wr_; (void)wc_; (void)fr_; (void)fq_;
        const int pn = u.pn + pn_off; const int row0 = u.pm * 256 + (u.hs == 2 ? 128 : 0) + wr * 64 + fr; const int b = u.pm >> 5; const int nai = u.hs ? 1 : 2;
        if (pn < 4 || pn == 6) {
#pragma unroll
            for (int ai = 0; ai < 2; ++ai) if (ai < nai)
#pragma unroll
                for (int m = 0; m < 4; ++m) { const size_t r = (size_t)(row0 + ai * 128 + m * 16);
#pragma unroll
                    for (int bj = 0; bj < 2; ++bj) { f32x4 v0 = acc[ai][bj][m][0], v1 = acc[ai][bj][m][1];
                        if (pn < 4) {
#pragma unroll
                            for (int i = 0; i < 4; ++i) { v0[i] = gelu_tanh(v0[i]); v1[i] = gelu_tanh(v1[i]); } }
                        u32x4 w; w.x = cvtpk(v0[0], v0[1]); w.y = cvtpk(v0[2], v0[3]); w.z = cvtpk(v1[0], v1[1]); w.w = cvtpk(v1[2], v1[3]);
                        bf16_t* dst;
                        if (pn < 2) dst = UG + r * 512 + pn * 256 + bj * 128 + wc * 32 + fq * 8;
                        else if (pn < 4) dst = VG + r * 512 + (pn - 2) * 256 + bj * 128 + wc * 32 + fq * 8;
                        else dst = (bj ? VC : KC) + r * 128 + wc * 32 + fq * 8;
                        *(u32x4*)dst = w; } }
        } else if (pn == 4 || pn == 5 || pn == 7) {
            const float sc = (pn == 7) ? 1.f : QSCALE; float nmax = 0.f;
#pragma unroll
            for (int ai = 0; ai < 2; ++ai) if (ai < nai)
#pragma unroll
                for (int m = 0; m < 4; ++m) { const size_t r = (size_t)(row0 + ai * 128 + m * 16);
                    const f32x4* cs = (const f32x4*)(ROPE + (r * 32 + fq * 8) * 2);
                    float o1[8], o2[8], nsq = 0.f;
#pragma unroll
                    for (int n = 0; n < 2; ++n) { const f32x4 c0 = cs[2 * n], c1 = cs[2 * n + 1]; const f32x4 x1 = acc[ai][0][m][n], x2 = acc[ai][1][m][n];
                        const float cc[4] = {c0[0], c0[2], c1[0], c1[2]}, ss[4] = {c0[1], c0[3], c1[1], c1[3]};
#pragma unroll
                        for (int i = 0; i < 4; ++i) { o1[4 * n + i] = (x1[i] * cc[i] - x2[i] * ss[i]) * sc; o2[4 * n + i] = (x2[i] * cc[i] + x1[i] * ss[i]) * sc; nsq += x1[i] * x1[i] + x2[i] * x2[i]; } }
                    u32x4 w1, w2; w1.x = cvtpk(o1[0], o1[1]); w1.y = cvtpk(o1[2], o1[3]); w1.z = cvtpk(o1[4], o1[5]); w1.w = cvtpk(o1[6], o1[7]);
                    w2.x = cvtpk(o2[0], o2[1]); w2.y = cvtpk(o2[2], o2[3]); w2.z = cvtpk(o2[4], o2[5]); w2.w = cvtpk(o2[6], o2[7]);
                    if (pn != 7) { bf16_t* dst = Q + r * 512 + (4 * (pn - 4) + wc) * 64 + fq * 8; *(u32x4*)dst = w1; *(u32x4*)(dst + 32) = w2; }
                    else { bf16_t* img = ((wc < 2) ? KS : KW) + (size_t)(b * 2 + (wc & 1)) * SEQ * 64; const int t = (int)r & (SEQ - 1);
                        *(u32x4*)(img + kfrag_off(t, fq)) = w1; *(u32x4*)(img + kfrag_off(t, 4 + fq)) = w2; }
                    nsq = kg_sum(nsq); nmax = fmaxf(nmax, nsq); asm volatile("" ::: "memory"); }
            if (pn == 7) {
#pragma unroll
                for (int o = 1; o < 16; o <<= 1) nmax = fmaxf(nmax, __shfl_xor(nmax, o));
                if ((threadIdx.x & 63) == 0) atomicMax(kmax + ((wc < 2) ? 0 : 8) + b * 2 + (wc & 1), __float_as_uint(nmax * 1.02f));
            }
        } else if (pn == 8) {
            const int g = wc >> 1; float vmx = 0.f;
#pragma unroll
            for (int ai = 0; ai < 2; ++ai) if (ai < nai)
#pragma unroll
                for (int m = 0; m < 4; ++m) { const int r = row0 + ai * 128 + m * 16; const int s = r & (SEQ - 1);
#pragma unroll
                    for (int bj = 0; bj < 2; ++bj) { bf16_t* img = (bj ? VWT : VST) + (size_t)(b * 2 + g) * SEQ * 64;
#pragma unroll
                        for (int n = 0; n < 2; ++n)
#pragma unroll
                            for (int i = 0; i < 4; ++i) { img[vfrag_off(s, (wc & 1) * 32 + fq * 8 + n * 4 + i)] = (bf16_t)(cvtpk(acc[ai][bj][m][n][i], 0.f) & 0xffffu); if (bj == 0) vmx = fmaxf(vmx, fabsf(acc[ai][0][m][n][i])); } } }
#pragma unroll
            for (int o = 1; o < 64; o <<= 1) vmx = fmaxf(vmx, __shfl_xor(vmx, o));
            if ((threadIdx.x & 63) == 0) atomicMax(kmax + 4 + b * 2 + g, __float_as_uint(vmx * 1.01f));
        } else {
            if (wc == 0 && fq < 3) {
#pragma unroll
                for (int ai = 0; ai < 2; ++ai) if (ai < nai)
#pragma unroll
                    for (int m = 0; m < 4; ++m) { const size_t r = (size_t)(row0 + ai * 128 + m * 16);
#pragma unroll
                        for (int n = 0; n < 2; ++n) { f32x4 v = acc[ai][0][m][n];
#pragma unroll
                            for (int i = 0; i < 4; ++i) v[i] = sigmoidf_(v[i]);
                            *(f32x4*)(GATES + r * 24 + fq * 8 + n * 4) = v; } }
            }
        }
    }
};
struct EpiOut {
    static constexpr bool PERM = false;
    const float* xin; float* xout; const float* g1;
    __device__ __forceinline__ void operator()(const f32x4 (&acc)[2][2][4][2], const pg8::Unit& u, int wr_, int wc_, int fr_, int fq_) const {
        int t_ = threadIdx.x; asm volatile("" : "+v"(t_)); const int wid_ = __builtin_amdgcn_readfirstlane(t_ >> 6); const int wr = wid_ >> 2, wc = wid_ & 3, fr = t_ & 15, fq = (t_ & 63) >> 4; (void)wr_; (void)wc_; (void)fr_; (void)fq_;
        const int row0 = u.pm * 256 + (u.hs == 2 ? 128 : 0) + wr * 64 + fr; const int b = u.pm >> 5; const int col0 = u.pn * 256 + wc * 32 + fq * 4; const int nai = u.hs ? 1 : 2;
        const float* gb = g1 + (size_t)b * 6144 + 2048;
        f32x4 gv[2][2];
#pragma unroll
        for (int bj = 0; bj < 2; ++bj)
#pragma unroll
            for (int n = 0; n < 2; ++n) gv[bj][n] = *(const f32x4*)(gb + col0 + bj * 128 + n * 16);
#pragma unroll
        for (int ai = 0; ai < 2; ++ai) if (ai < nai)
#pragma unroll
            for (int m = 0; m < 4; ++m) { const size_t off = (size_t)(row0 + ai * 128 + m * 16) * DM + col0;
#pragma unroll
                for (int bj = 0; bj < 2; ++bj)
#pragma unroll
                    for (int n = 0; n < 2; ++n) { const f32x4 xi = *(const f32x4*)(xin + off + bj * 128 + n * 16); *(f32x4*)(xout + off + bj * 128 + n * 16) = xi + gv[bj][n] * acc[ai][bj][m][n]; } }
    }
};
struct EpiSwiglu {
    static constexpr bool PERM = true;
    unsigned char* ACT; const float* b1;
    __device__ __forceinline__ void operator()(const f32x4 (&acc)[2][2][4][2], const pg8::Unit& u, int wr_, int wc_, int fr_, int fq_) const {
        int t_ = threadIdx.x; asm volatile("" : "+v"(t_)); const int wid_ = __builtin_amdgcn_readfirstlane(t_ >> 6); const int wr = wid_ >> 2, wc = wid_ & 3, fr = t_ & 15, fq = (t_ & 63) >> 4; (void)wr_; (void)wc_; (void)fr_; (void)fq_;
        const int row0 = u.pm * 256 + (u.hs == 2 ? 128 : 0) + wr * 64 + fr; const int j0 = u.pnl * 128 + wc * 32 + fq * 8; const int nai = u.hs ? 1 : 2;
        const float* bb = b1 + (size_t)u.e * 2048 + j0;
        f32x4 bg[2], bl[2];
#pragma unroll
        for (int n = 0; n < 2; ++n) { bg[n] = *(const f32x4*)(bb + n * 4); bl[n] = *(const f32x4*)(bb + 1024 + n * 4); }
#pragma unroll
        for (int ai = 0; ai < 2; ++ai) if (ai < nai)
#pragma unroll
            for (int m = 0; m < 4; ++m) { float o[8];
#pragma unroll
                for (int n = 0; n < 2; ++n) { const f32x4 gl = acc[ai][0][m][n] + bg[n], ln = acc[ai][1][m][n] + bl[n];
#pragma unroll
                    for (int i = 0; i < 4; ++i) { const float gg = fminf(gl[i], 7.f), ll = fminf(fmaxf(ln[i], -7.f), 7.f); o[n * 4 + i] = gg * sigmoidf_(1.702f * gg) * (ll + 1.f); } }
                u32x2 w; w.x = cvt4_fp8(o[0], o[1], o[2], o[3]); w.y = cvt4_fp8(o[4], o[5], o[6], o[7]);
                *(u32x2*)(ACT + (size_t)(row0 + ai * 128 + m * 16) * FF + j0) = w; }
    }
};
struct EpiDown {
    static constexpr bool PERM = true;
    unsigned char* YR; const float* b2;
    __device__ __forceinline__ void operator()(const f32x4 (&acc)[2][2][4][2], const pg8::Unit& u, int wr_, int wc_, int fr_, int fq_) const {
        int t_ = threadIdx.x; asm volatile("" : "+v"(t_)); const int wid_ = __builtin_amdgcn_readfirstlane(t_ >> 6); const int wr = wid_ >> 2, wc = wid_ & 3, fr = t_ & 15, fq = (t_ & 63) >> 4; (void)wr_; (void)wc_; (void)fr_; (void)fq_;
        const int row0 = u.pm * 256 + (u.hs == 2 ? 128 : 0) + wr * 64 + fr; const int c0 = u.pnl * 256 + wc * 32 + fq * 8; const int nai = u.hs ? 1 : 2;
        const float* bb = b2 + (size_t)u.e * 1024 + c0;
        f32x4 bv[2][2];
#pragma unroll
        for (int bj = 0; bj < 2; ++bj)
#pragma unroll
            for (int n = 0; n < 2; ++n) bv[bj][n] = *(const f32x4*)(bb + bj * 128 + n * 4);
#pragma unroll
        for (int ai = 0; ai < 2; ++ai) if (ai < nai)
#pragma unroll
            for (int m = 0; m < 4; ++m)
#pragma unroll
                for (int bj = 0; bj < 2; ++bj) { const f32x4 v0 = acc[ai][bj][m][0] + bv[bj][0], v1 = acc[ai][bj][m][1] + bv[bj][1];
                    u32x2 w; w.x = cvt4_fp8(v0[0], v0[1], v0[2], v0[3]); w.y = cvt4_fp8(v1[0], v1[1], v1[2], v1[3]);
                    *(u32x2*)(YR + (size_t)(row0 + ai * 128 + m * 16) * DM + c0 + bj * 128) = w; }
    }
};

__device__ __forceinline__ void tr_item(const float* W, int ldn, int k0, int c0, int nvalid, bf16_t* WT, int K, int drow0, LAS float* scr, int lane) {
    const int nn = lane & 31;
#pragma unroll 8
    for (int i = 0; i < 32; ++i) { const int kk = 2 * i + (lane >> 5); scr[kk * 33 + nn] = (nn < nvalid) ? W[(size_t)(k0 + kk) * ldn + c0 + nn] : 0.f; }
    LDS_WAIT(); asm volatile("" ::: "memory");
    const int c = lane & 7;
#pragma unroll
    for (int j = 0; j < 4; ++j) { const int n = (lane >> 3) + 8 * j; const LAS float* s = scr + (8 * c) * 33 + n;
        u32x4 o; o.x = cvtpk(s[0 * 33], s[1 * 33]); o.y = cvtpk(s[2 * 33], s[3 * 33]); o.z = cvtpk(s[4 * 33], s[5 * 33]); o.w = cvtpk(s[6 * 33], s[7 * 33]);
        *(u32x4*)(WT + (size_t)(drow0 + n) * K + k0 + 8 * c) = o; }
    LDS_WAIT(); asm volatile("" ::: "memory");
}
template <bool NTS> __device__ __forceinline__ void tr_item8(const float* W, int ldn, int k0, int c0, unsigned char* W8, int K, int drow0, LAS float* scr, int lane, int nvalid = 32) {
    const int nn = lane & 31;
#pragma unroll 32
    for (int i = 0; i < 32; ++i) { const int kk = 2 * i + (lane >> 5); scr[kk * 33 + nn] = (nn < nvalid) ? __builtin_nontemporal_load(W + (size_t)(k0 + kk) * ldn + c0 + nn) * W8SCALE : 0.f; }
    LDS_WAIT(); asm volatile("" ::: "memory");
    const int c = lane & 3;
#pragma unroll
    for (int j = 0; j < 2; ++j) { const int n = (lane >> 2) + 16 * j; const LAS float* s = scr + (16 * c) * 33 + n;
        u32x4 o; o.x = cvt4_fp8(s[0 * 33], s[1 * 33], s[2 * 33], s[3 * 33]); o.y = cvt4_fp8(s[4 * 33], s[5 * 33], s[6 * 33], s[7 * 33]);
        o.z = cvt4_fp8(s[8 * 33], s[9 * 33], s[10 * 33], s[11 * 33]); o.w = cvt4_fp8(s[12 * 33], s[13 * 33], s[14 * 33], s[15 * 33]);
        if (NTS) __builtin_nontemporal_store(o, (u32x4*)(W8 + (size_t)(drow0 + n) * K + k0 + 16 * c)); else *(u32x4*)(W8 + (size_t)(drow0 + n) * K + k0 + 16 * c) = o; }
    LDS_WAIT(); asm volatile("" ::: "memory");
}
__device__ __forceinline__ void win_src(int p, int& c0, int& nvalid) {
    const int pn = p >> 8; nvalid = 32;
    if (pn < 4 || pn == 6) { c0 = p; }
    else if (pn == 4 || pn == 5) { const int pp = p - 1024 - 256 * (pn - 4), bj = pp >> 7, j = pp & 127; c0 = 1024 + (4 * (pn - 4) + (j >> 5)) * 64 + bj * 32; }
    else if (pn == 7) { const int pp = p - 1792, bj = pp >> 7, j = pp & 127, which = j >> 6, g = (j >> 5) & 1; c0 = (which ? 2048 : 1792) + g * 64 + bj * 32; }
    else if (pn == 8) { const int pp = p - 2048, bj = pp >> 7, j = pp & 127; c0 = (bj ? 2176 : 1920) + j; }
    else { const int pp = p - 2304; c0 = 2304 + pp; nvalid = 24 - pp; nvalid = nvalid < 0 ? 0 : (nvalid > 32 ? 32 : nvalid); if (nvalid == 0) c0 = 0; }
}
__device__ __forceinline__ void phase_prologue(Frame& F, const Args& a) {
    LAS float* scr = (LAS float*)(F.lds + F.wave * 8704);
    const int gw = F.vcu * NWAVES + F.wave, NGW = F.G * NWAVES; const int lane = F.lane;
    {
        const float* c = INP(a, float, I_C); const float* adaw = INP(a, float, I_ADAW); const float* adab = INP(a, float, I_ADAB);
        float* mod = (float*)(F.ctl + CW_MOD);
        LAS float* red = (LAS float*)(F.lds + 8 * 8704);
        for (int it = F.vcu; it < 2 * 24; it += F.G) {
            const int l = it / 24, nb = it % 24;
            const float* wp = adaw + ((size_t)l * 1024 + F.wave * 128) * 6144 + nb * 256 + lane * 4;
            f32x4 a0 = {0.f, 0.f, 0.f, 0.f}, a1 = a0;
#pragma unroll 4
            for (int k = 0; k < 128; ++k) { const f32x4 w = __builtin_nontemporal_load((const f32x4*)(wp + (size_t)k * 6144));
                const float c0 = c[F.wave * 128 + k], c1 = c[1024 + F.wave * 128 + k]; const float s0 = c0 * sigmoidf_(c0), s1 = c1 * sigmoidf_(c1);
                a0 += w * s0; a1 += w * s1; }
            *(LAS f32x4*)(red + (F.wave * 2 + 0) * 256 + lane * 4) = a0; *(LAS f32x4*)(red + (F.wave * 2 + 1) * 256 + lane * 4) = a1;
            __syncthreads();
            { const int b = F.tid >> 8, col = F.tid & 255; float sum = adab[(size_t)l * 6144 + nb * 256 + col];
#pragma unroll
              for (int ww = 0; ww < 8; ++ww) sum += red[(ww * 2 + b) * 256 + col];
              mod[((size_t)l * 2 + b) * 6144 + nb * 256 + col] = sum; }
            __syncthreads();
        }
    }
    {
        const float* win = INP(a, float, I_WIN);
        unsigned char* Win8 = WSP(unsigned char, WS_WIN8);
        for (int it = gw; it < 2 * 16 * 80; it += NGW) { const int l = it / 1280, kb = (it % 1280) / 80, nb = it % 80; int c0, nv; win_src(nb * 32, c0, nv);
            tr_item8<false>(win + (size_t)l * 1024 * PIN, PIN, kb * 64, c0, Win8 + (size_t)l * 2560 * 1024, 1024, nb * 32, scr, lane, nv); }
        const float* wout = INP(a, float, I_WOUT); bf16_t* WoutT = WSP(bf16_t, WS_WOUT);
        for (int it = gw; it < 2 * 16 * 32; it += NGW) { const int l = it / 512, kb = (it % 512) / 32, nb = it % 32;
            tr_item(wout + (size_t)l * 1024 * 1024, 1024, kb * 64, nb * 32, 32, WoutT + (size_t)l * 1024 * 1024, 1024, nb * 32, scr, lane); }
        bf16_t* CW1 = WSP(bf16_t, WS_CW1);
        for (int it = gw; it < 2 * 2 * 32 * 2; it += NGW) { const int l = it / 128, which = (it / 64) & 1, kb = (it % 64) / 2, nb = it & 1;
            const float* src = INP(a, float, which ? I_CW1V : I_CW1K) + (size_t)l * 2048 * 64;
            tr_item(src, 64, kb * 64, nb * 32, 32, CW1 + (size_t)(l * 2 + which) * 64 * 2048, 2048, nb * 32, scr, lane); }
        const float* ew1 = INP(a, float, I_EW1); unsigned char* W1T = WSP(unsigned char, WS_W1T);
        for (int it = gw; it < 2 * 32 * 16 * 64; it += NGW) { const int le = it >> 10, kb = (it >> 6) & 15, nb = it & 63; const int p = nb * 32, tile = p >> 8, bj = (p >> 7) & 1, j = p & 127;
            if (le < 32) tr_item8<false>(ew1 + (size_t)le * 1024 * 2048, 2048, kb * 64, bj * 1024 + tile * 128 + j, W1T + (size_t)le * 2048 * 1024, 1024, p, scr, lane);
            else tr_item8<true>(ew1 + (size_t)le * 1024 * 2048, 2048, kb * 64, bj * 1024 + tile * 128 + j, W1T + (size_t)le * 2048 * 1024, 1024, p, scr, lane); }
        const float* ew2 = INP(a, float, I_EW2); unsigned char* W2T = WSP(unsigned char, WS_W2T);
        for (int it = gw; it < 2 * 32 * 16 * 32; it += NGW) { const int le = it >> 9, kb = (it >> 5) & 15, nb = it & 31;
            if (le < 32) tr_item8<false>(ew2 + (size_t)le * 1024 * 1024, 1024, kb * 64, nb * 32, W2T + (size_t)le * 1024 * 1024, 1024, nb * 32, scr, lane);
            else tr_item8<true>(ew2 + (size_t)le * 1024 * 1024, 1024, kb * 64, nb * 32, W2T + (size_t)le * 1024 * 1024, 1024, nb * 32, scr, lane); }
    }
    {
        const int gt = (F.vcu * NWAVES + F.wave) * 64 + lane, NGT = NGW * 64;
        const float* sgw = INP(a, float, I_SGW); bf16_t* SGW = WSP(bf16_t, WS_SGW);
        for (int i = gt; i < 2 * 8 * 128 * 128; i += NGT) { const int s = i & 127, t = (i >> 7) & 127; SGW[i] = (bf16_t)(cvtpk(s <= t ? sgw[i] : 0.f, 0.f) & 0xffffu); }
        const int* pos = INP(a, int, I_POS); float* rope = WSP(float, WS_ROPE);
        for (int i = gt; i < T * 32; i += NGT) { const int tok = i >> 5, d = i & 31;
            const double inv = exp2(-(double)d * (13.287712379549449 / 32.0));
            const double rv = (double)pos[tok] * inv * 0.15915494309189535; const float fr = (float)(rv - __builtin_rint(rv));
            rope[2 * i] = __builtin_amdgcn_cosf(fr); rope[2 * i + 1] = __builtin_amdgcn_sinf(fr); }
        bf16_t* H = WSP(bf16_t, WS_H);
        for (int i = gt; i < 1024; i += NGT) { H[(size_t)T * 1024 + i] = 0; WSP(unsigned char, WS_H8)[(size_t)T * 1024 + i] = 0; }
        bf16_t* KCMP = WSP(bf16_t, WS_KCMP); bf16_t* VCT = WSP(bf16_t, WS_VCT);
        for (int i = gt; i < 2 * 2 * 64; i += NGT) { const int b = i >> 7, g = (i >> 6) & 1, d = i & 63; KCMP[(size_t)(b * 2 + g) * 512 * 64 + kfrag_off(511, d >> 3) + (d & 7)] = 0; VCT[(size_t)(b * 2 + g) * 512 * 64 + vfrag_off(511, d)] = 0; }
    }
    {
        float* cb = WSP(float, WS_MISC);
        for (int it = gw; it < 2 * 2 * 64; it += NGW) { const int l = it >> 7, which = (it >> 6) & 1, n = it & 63;
            const float* pe = INP(a, float, which ? I_PEV : I_PEK) + (size_t)l * 2048; const float* w1 = INP(a, float, which ? I_CW1V : I_CW1K) + (size_t)l * 2048 * 64;
            float s = 0.f; for (int k = lane; k < 2048; k += 64) s += pe[k] * w1[(size_t)k * 64 + n];
            s = wave_sum(s); if (lane == 0) cb[it] = s; }
    }
}

struct RowV { f32x4 v[4]; };
__device__ __forceinline__ RowV row_load(const float* p, int lane) { RowV r; const f32x4* q = (const f32x4*)p + lane;
#pragma unroll
    for (int j = 0; j < 4; ++j) r.v[j] = q[64 * j]; return r; }
__device__ __forceinline__ float row_ssq(const RowV& r) { float s = 0.f;
#pragma unroll
    for (int j = 0; j < 4; ++j) s += (r.v[j].x * r.v[j].x + r.v[j].y * r.v[j].y) + (r.v[j].z * r.v[j].z + r.v[j].w * r.v[j].w); return wave_sum(s); }
__device__ __forceinline__ void row_norm_store(const RowV& x, float rstd, const float* g, const float* sc, const float* sh, bf16_t* orow, int lane) {
    u32x2* o8 = (u32x2*)orow + lane;
#pragma unroll
    for (int j = 0; j < 4; ++j) { const f32x4 gg = ((const f32x4*)g)[lane + 64 * j], ss = ((const f32x4*)sc)[lane + 64 * j], hh = ((const f32x4*)sh)[lane + 64 * j];
        const f32x4 y = x.v[j] * rstd * gg * (ss + 1.f) + hh; u32x2 w; w.x = cvtpk(y.x, y.y); w.y = cvtpk(y.z, y.w); o8[64 * j] = w; }
}
__device__ __forceinline__ void quad_tr(unsigned (&a)[4], int lane) {
    const bool b0 = lane & 1, b1 = lane & 2;
    { const unsigned x = b0 ? a[0] : a[1]; const unsigned y = __builtin_amdgcn_update_dpp(0u, x, 0xB1, 0xF, 0xF, true); if (b0) a[0] = y; else a[1] = y; }
    { const unsigned x = b0 ? a[2] : a[3]; const unsigned y = __builtin_amdgcn_update_dpp(0u, x, 0xB1, 0xF, 0xF, true); if (b0) a[2] = y; else a[3] = y; }
    { const unsigned x = b1 ? a[0] : a[2]; const unsigned y = __builtin_amdgcn_update_dpp(0u, x, 0x4E, 0xF, 0xF, true); if (b1) a[0] = y; else a[2] = y; }
    { const unsigned x = b1 ? a[1] : a[3]; const unsigned y = __builtin_amdgcn_update_dpp(0u, x, 0x4E, 0xF, 0xF, true); if (b1) a[1] = y; else a[3] = y; }
}
__device__ __forceinline__ void row_norm_store8(const RowV& x, float rstd, const float* g, const float* sc, const float* sh, unsigned char* orow, int lane) {
    unsigned a[4];
#pragma unroll
    for (int j = 0; j < 4; ++j) { const f32x4 gg = ((const f32x4*)g)[lane + 64 * j], ss = ((const f32x4*)sc)[lane + 64 * j], hh = ((const f32x4*)sh)[lane + 64 * j];
        const f32x4 y = x.v[j] * rstd * gg * (ss + 1.f) + hh; a[j] = cvt4_fp8(y.x, y.y, y.z, y.w); }
    quad_tr(a, lane);
    *(u32x4*)(orow + 256 * (lane & 3) + 16 * (lane >> 2)) = (u32x4){a[0], a[1], a[2], a[3]};
}
__device__ __forceinline__ int expert_block_prefix(const unsigned* cnt, int lane) {
    int nb = (lane < NE) ? (int)((cnt[lane] + 255u) >> 8) : 0; int inc = nb;
#pragma unroll
    for (int o = 1; o < 32; o <<= 1) { const int t = __shfl_up(inc, o); if ((lane & 31) >= o) inc += t; }
    return inc - nb;
}
__device__ __forceinline__ void phase_n1_first(Frame& F, const Args& a) {
    const int gw = F.vcu * NWAVES + F.wave, NGW = F.G * NWAVES; const int lane = F.lane;
    const float* x = INP(a, float, I_X); const float* g = INP(a, float, I_N1G); bf16_t* H = WSP(bf16_t, WS_H); unsigned char* H8 = WSP(unsigned char, WS_H8);
    for (int m = gw; m < T; m += 2 * NGW) { const int m2 = m + NGW; const int b = m >> 13, b2 = m2 >> 13;
        const RowV r = row_load(x + (size_t)m * DM, lane); const RowV r2 = row_load(x + (size_t)m2 * DM, lane);
        const float rstd = 1.f / sqrtf(row_ssq(r) * (1.f / DM) + NORM_EPS), rstd2 = 1.f / sqrtf(row_ssq(r2) * (1.f / DM) + NORM_EPS);
        row_norm_store8(r, rstd, g, MODP(0, b, 1), MODP(0, b, 0), H8 + (size_t)m * DM, lane);
        row_norm_store8(r2, rstd2, g, MODP(0, b2, 1), MODP(0, b2, 0), H8 + (size_t)m2 * DM, lane); }
    float* RWP = WSP(float, WS_RWP); float* RBP = WSP(float, WS_MISC + 4096);
    const float* rw = INP(a, float, I_RW); const float* rb = INP(a, float, I_RB); const float* n2g = INP(a, float, I_N2G);
    const int gt = gw * 64 + lane, NGT = NGW * 64;
    for (int i = gt; i < 2 * 2 * 1024 * 32; i += NGT) { const int l = i >> 16, b = (i >> 15) & 1, k = (i >> 5) & 1023, e = i & 31;
        RWP[i] = n2g[l * 1024 + k] * (1.f + MODP(l, b, 4)[k]) * rw[((size_t)l * 1024 + k) * 32 + e]; }
    for (int it = gw; it < 2 * 2 * 32; it += NGW) { const int l = it >> 6, b = (it >> 5) & 1, e = it & 31; float s = 0.f;
        for (int k = lane; k < 1024; k += 64) s += MODP(l, b, 3)[k] * rw[((size_t)l * 1024 + k) * 32 + e];
        s = wave_sum(s); if (lane == 0) RBP[it] = s + rb[l * 32 + e]; }
}
__device__ __forceinline__ void phase_combine(Frame& F, const Args& a, int l) {
    const int gw = F.vcu * NWAVES + F.wave, NGW = F.G * NWAVES; const int lane = F.lane;
    float* XR = WSP(float, WS_XR); bf16_t* H = WSP(bf16_t, WS_H); const unsigned char* YR = WSP(unsigned char, WS_YROWS);
    const int* ASG = WSP(int, WS_ASG); const float* G4 = WSP(float, WS_GATE4);
    const int myprefix = expert_block_prefix(F.ctl + CW_CNT + l * 32, lane);
    const bool last = (l == DEPTH - 1);
    const float* g = last ? INP(a, float, I_FING) : INP(a, float, I_N1G) + (l + 1) * 1024;
#define COMB_LOAD(R_, WV_, GT_, M_) do { const int4 as4_ = *(const int4*)(ASG + (M_) * 4); const f32x4 gt4_ = *(const f32x4*)(G4 + (M_) * 4); \
        R_ = row_load(XR + (size_t)(M_) * DM, lane); const int asv_[4] = {as4_.x, as4_.y, as4_.z, as4_.w}; GT_[0] = gt4_.x; GT_[1] = gt4_.y; GT_[2] = gt4_.z; GT_[3] = gt4_.w; \
        _Pragma("unroll") for (int k = 0; k < 4; ++k) { const int e = asv_[k] >> 16, slot = asv_[k] & 0xffff; const int blk = __shfl(myprefix, e); \
            const unsigned* yr = (const unsigned*)(YR + ((size_t)blk * 256 + slot) * DM) + lane; _Pragma("unroll") for (int j = 0; j < 4; ++j) WV_[k][j] = __builtin_nontemporal_load(yr + 64 * j); } } while (0)
#define COMB_FINISH(R_, WV_, GT_, M_) do { const int b = (M_) >> 13; f32x4 y[4]; \
        _Pragma("unroll") for (int j = 0; j < 4; ++j) y[j] = (f32x4){0.f, 0.f, 0.f, 0.f}; \
        _Pragma("unroll") for (int k = 0; k < 4; ++k) _Pragma("unroll") for (int j = 0; j < 4; ++j) { const int w = (int)WV_[k][j]; const f32x2 lo_ = __builtin_amdgcn_cvt_pk_f32_fp8(w, false), hi_ = __builtin_amdgcn_cvt_pk_f32_fp8(w, true); y[j] += (f32x4){lo_.x, lo_.y, hi_.x, hi_.y} * GT_[k]; } \
        const float* g2 = MODP(l, b, 5); \
        _Pragma("unroll") for (int j = 0; j < 4; ++j) R_.v[j] += ((const f32x4*)g2)[lane + 64 * j] * y[j]; \
        const float rstd = 1.f / sqrtf(row_ssq(R_) * (1.f / DM) + NORM_EPS); \
        if (last) { f32x4* o = (f32x4*)(a.out + (size_t)(M_) * DM) + lane; _Pragma("unroll") for (int j = 0; j < 4; ++j) o[64 * j] = R_.v[j] * rstd * ((const f32x4*)g)[lane + 64 * j]; } \
        else { f32x4* xo = (f32x4*)(XR + (size_t)(M_) * DM) + lane; _Pragma("unroll") for (int j = 0; j < 4; ++j) xo[64 * j] = R_.v[j]; \
            row_norm_store8(R_, rstd, g, MODP(l + 1, b, 1), MODP(l + 1, b, 0), WSP(unsigned char, WS_H8) + (size_t)(M_) * DM, lane); } } while (0)
    for (int m = gw; m < T; m += 2 * NGW) { const int m2 = m + NGW;
        RowV rA, rB; unsigned wA[4][4], wB[4][4]; float gA[4], gB[4];
        COMB_LOAD(rA, wA, gA, m); COMB_LOAD(rB, wB, gB, m2);
        COMB_FINISH(rA, wA, gA, m); COMB_FINISH(rB, wB, gB, m2);
    }
#undef COMB_LOAD
#undef COMB_FINISH
}
__device__ __forceinline__ void compress_item(Frame& F, const Args& a, int l, int item) {
    const int which = item >> 7, b = (item >> 6) & 1, g = (item >> 5) & 1, n0 = (item & 31) * 16;
    const int lane = F.lane, w = F.wave, r16 = lane & 15, kg = lane >> 4;
    const bf16_t* src = WSP(bf16_t, which ? WS_VC : WS_KC);
    const bf16_t* W1 = WSP(bf16_t, WS_CW1) + (size_t)(l * 2 + which) * 64 * 2048;
    LAS float* red = (LAS float*)F.lds;
    LAS float* hid = (LAS float*)(F.lds + 32768);
    f32x4 acc[4];
#pragma unroll
    for (int i = 0; i < 4; ++i) acc[i] = (f32x4){0.f, 0.f, 0.f, 0.f};
    const int n = n0 + r16; const bool nval = n < NCMP;
#pragma unroll 2
    for (int ks = 0; ks < 8; ++ks) { const int k = 256 * w + 32 * ks + 8 * kg; const int li = k >> 6, d = k & 63;
        bf16x8 af = (bf16x8){0, 0, 0, 0, 0, 0, 0, 0};
        if (nval) af = *(const bf16x8*)(src + ((size_t)b * SEQ + 16 * n + li) * 128 + g * 64 + d);
#pragma unroll
        for (int nt = 0; nt < 4; ++nt) { const bf16x8 bf = *(const bf16x8*)(W1 + (size_t)(nt * 16 + r16) * 2048 + k); acc[nt] = __builtin_amdgcn_mfma_f32_16x16x32_bf16(af, bf, acc[nt], 0, 0, 0); } }
#pragma unroll
    for (int nt = 0; nt < 4; ++nt)
#pragma unroll
        for (int i = 0; i < 4; ++i) red[(w * 16 + 4 * kg + i) * 64 + nt * 16 + r16] = acc[nt][i];
    __syncthreads();
    const float* cb = WSP(float, WS_MISC) + (l * 2 + which) * 64;
    for (int i = F.tid; i < 1024; i += NTHREADS) { float s = cb[i & 63];
#pragma unroll
        for (int ww = 0; ww < 8; ++ww) s += red[ww * 1024 + i];
        hid[i] = gelu_tanh(s); }
    { const float* w2 = INP(a, float, which ? I_CW2V : I_CW2K) + (size_t)l * 4096; LAS f32x4* w2s4 = (LAS f32x4*)(F.lds + 40960);
      for (int i = F.tid; i < 1024; i += NTHREADS) w2s4[i] = ((const f32x4*)w2)[i]; }
    __syncthreads();
    {
        const int nn = F.tid >> 5, c = F.tid & 31; LAS float* w2s = (LAS float*)(F.lds + 40960);
        float o1 = 0.f, o2 = 0.f;
#pragma unroll 16
        for (int k = 0; k < 64; ++k) { const float h = hid[nn * 64 + k]; o1 += h * w2s[k * 64 + c]; o2 += h * w2s[k * 64 + c + 32]; }
        const int np = n0 + nn; float nsq_ = 0.f;
        if (np < NCMP) {
            if (!which) { const float* cs = WSP(float, WS_ROPE) + (((size_t)b * SEQ + 16 * np + 31) * 32 + c) * 2; const float cc = cs[0], ss = cs[1];
                const float r1 = o1 * cc - o2 * ss, r2 = o2 * cc + o1 * ss;
                bf16_t* img = WSP(bf16_t, WS_KCMP) + (size_t)(b * 2 + g) * 512 * 64; img[kfrag_off(np, c >> 3) + (c & 7)] = (bf16_t)(cvtpk(r1, 0.f) & 0xffffu); img[kfrag_off(np, 4 + (c >> 3)) + (c & 7)] = (bf16_t)(cvtpk(r2, 0.f) & 0xffffu);
                nsq_ = r1 * r1 + r2 * r2;
            } else { bf16_t* img = WSP(bf16_t, WS_VCT) + (size_t)(b * 2 + g) * 512 * 64; img[vfrag_off(np, c)] = (bf16_t)(cvtpk(o1, 0.f) & 0xffffu); img[vfrag_off(np, c + 32)] = (bf16_t)(cvtpk(o2, 0.f) & 0xffffu); }
        }
        if (!which) {
            float mx = quad_sum(nsq_);
            mx += __uint_as_float(__builtin_amdgcn_update_dpp(0u, __float_as_uint(mx), 0x141, 0xF, 0xF, true)); mx += __uint_as_float(__builtin_amdgcn_update_dpp(0u, __float_as_uint(mx), 0x140, 0xF, 0xF, true));
            mx = x16_sum(mx);
            mx = x32_max(mx);
            if (F.lane == 0) atomicMax(F.ctl + CW_KMAX + l * 16 + 12 + b * 2 + g, __float_as_uint(mx * 1.02f));
        }
    }
    __syncthreads();
}
__device__ __forceinline__ void sgu_item(Frame& F, const Args& a, int l, int ch) {
    const size_t tok0 = (size_t)ch * 128;
    const int lane = F.lane, w = F.wave, r16 = lane & 15, kg = lane >> 4;
    const bf16_t* VG = WSP(bf16_t, WS_VG); const bf16_t* UG = WSP(bf16_t, WS_UG); bf16_t* Y = WSP(bf16_t, WS_Y);
    LAS float* stats = (LAS float*)F.lds;
    LAS bf16_t* vnT = (LAS bf16_t*)(F.lds + 1024);
    constexpr int VP = 136;
    static_assert(1024 + 8 * 64 * 136 * 2 <= ATT_LDS_BYTES, "SGU LDS map");
    {
        u32x4 vrow[16];
#pragma unroll
        for (int tt = 0; tt < 16; ++tt) vrow[tt] = *(const u32x4*)(VG + (tok0 + 16 * w + tt) * 512 + lane * 8);
#pragma unroll
        for (int tt = 0; tt < 16; ++tt) { const int s = 16 * w + tt; const u32x4 v = vrow[tt];
            const float f[8] = {bflo(v.x), bfhi(v.x), bflo(v.y), bfhi(v.y), bflo(v.z), bfhi(v.z), bflo(v.w), bfhi(v.w)};
            float sm = 0.f;
#pragma unroll
            for (int i = 0; i < 8; ++i) sm += f[i];
            const float mu = wave_sum(sm) * (1.f / 512.f); float q = 0.f;
#pragma unroll
            for (int i = 0; i < 8; ++i) q += (f[i] - mu) * (f[i] - mu);
            const float var = wave_sum(q) * (1.f / 512.f);
            if (lane == 0) { stats[2 * s] = mu; stats[2 * s + 1] = 1.f / sqrtf(var + NORM_EPS); } }
    }
    __syncthreads();
    {
        const int s = F.tid & 127, hq = F.tid >> 7; const float mu = stats[2 * s], rs = stats[2 * s + 1];
#pragma unroll
        for (int hp = 0; hp < 2; ++hp) { const int h = hq + 4 * hp; const int cbase = h * 64;
            const float* lg = INP(a, float, I_SGLNG) + l * 512 + cbase; const float* lb = INP(a, float, I_SGLNB) + l * 512 + cbase;
#pragma unroll 2
            for (int d0 = 0; d0 < 64; d0 += 8) { const u32x4 v = *(const u32x4*)(VG + (tok0 + s) * 512 + cbase + d0);
                const float f[8] = {bflo(v.x), bfhi(v.x), bflo(v.y), bfhi(v.y), bflo(v.z), bfhi(v.z), bflo(v.w), bfhi(v.w)};
#pragma unroll
                for (int i = 0; i < 8; ++i) vnT[(h * 64 + d0 + i) * VP + s] = (bf16_t)(cvtpk((f[i] - mu) * rs * lg[d0 + i] + lb[d0 + i], 0.f) & 0xffffu); } }
    }
    __syncthreads();
    {
        const int h = w;
        const bf16_t* Wm = WSP(bf16_t, WS_SGW) + (size_t)(l * 8 + h) * 128 * 128; const float* bs = INP(a, float, I_SGB) + (size_t)(l * 8 + h) * 128;
#pragma nounroll
        for (int tt = 0; tt < 8; ++tt) {
            const int t = 16 * tt + r16; const float bb = bs[t];
            bf16x8 bw[4]; u32x2 ugv[4];
#pragma unroll
            for (int ks = 0; ks < 4; ++ks) bw[ks] = *(const bf16x8*)(Wm + (size_t)t * 128 + 32 * ks + 8 * kg);
#pragma unroll
            for (int dt = 0; dt < 4; ++dt) ugv[dt] = *(const u32x2*)(UG + (tok0 + t) * 512 + h * 64 + dt * 16 + 4 * kg);
            f32x4 acc[4];
#pragma unroll
            for (int i = 0; i < 4; ++i) acc[i] = (f32x4){0.f, 0.f, 0.f, 0.f};
            const int nks = (16 * tt + 15) / 32 + 1;
#pragma unroll
            for (int ks = 0; ks < 4; ++ks) { if (ks < nks) {
#pragma unroll
                for (int dt = 0; dt < 4; ++dt) { const bf16x8 afr = *(const LAS bf16x8*)(vnT + (h * 64 + dt * 16 + r16) * VP + 32 * ks + 8 * kg); acc[dt] = __builtin_amdgcn_mfma_f32_16x16x32_bf16(afr, bw[ks], acc[dt], 0, 0, 0); } } }
#pragma unroll
            for (int dt = 0; dt < 4; ++dt) { const u32x2 uu = ugv[dt];
                u32x2 o; o.x = cvtpk(bflo(uu.x) * (acc[dt][0] + bb), bfhi(uu.x) * (acc[dt][1] + bb)); o.y = cvtpk(bflo(uu.y) * (acc[dt][2] + bb), bfhi(uu.y) * (acc[dt][3] + bb));
                *(u32x2*)(Y + (tok0 + t) * 1024 + h * 64 + dt * 16 + 4 * kg) = o; }
        }
    }
    __syncthreads();
}
namespace att {
constexpr int OSP = 65;
constexpr int L_OH = 0;
constexpr int L_OL = 66560;
constexpr int L_LS = 133120;
constexpr int L_MREF = L_LS + 2048;
constexpr int USP = 129;
constexpr int L_SEL = L_MREF + 1024;
constexpr int L_CNT = L_SEL + 1024;
constexpr int L_LIST = L_CNT + 512;
constexpr int L_WCTR = L_LIST + 8192;
static_assert(L_WCTR + 16 <= ATT_LDS_BYTES, "attention LDS map");

struct Ptrs { const bf16_t *Q, *KS, *KW, *VST, *VWT, *KCMP, *VCT; const float* GATES; bf16_t* Y; float* YPART; float kmax, vmax, kwmax, kcmax; };

#define MFMA16(a, b, c) __builtin_amdgcn_mfma_f32_16x16x32_bf16(a, b, c, 0, 0, 0)

__device__ __forceinline__ void attn_unit(Frame& F, const Ptrs& P, int b, int g, int qb) {
    LAS unsigned char* lds = F.lds;
    const int tid = F.tid, lane = F.lane, w = F.wave, r16 = lane & 15, kg = lane >> 4;
    LAS int* Oh = (LAS int*)(lds + L_OH); LAS int* Ol = (LAS int*)(lds + L_OL); LAS float* imp = (LAS float*)(lds + L_OH);
    LAS int* lsel = (LAS int*)(lds + L_LS); LAS float* mref = (LAS float*)(lds + L_MREF);
    LAS unsigned* selm = (LAS unsigned*)(lds + L_SEL); LAS int* cnts = (LAS int*)(lds + L_CNT); LAS unsigned char* lists = lds + L_LIST; LAS int* wctr = (LAS int*)(lds + L_WCTR);
    const size_t tokb = (size_t)b * SEQ; const int t0 = qb * 64;
    const bf16_t* Qg = P.Q + (tokb + t0) * 512 + g * 256;
    LAS float* U = (LAS float*)(lds + L_OH); LAS float* linvc = (LAS float*)(lds + L_LS);
    {
        const int q = tid >> 3, part = tid & 7, hd = part >> 1, hf = part & 1;
        const u32x4* src = (const u32x4*)(Qg + (size_t)q * 512 + part * 32);
        float ss = 0.f;
#pragma unroll
        for (int i = 0; i < 4; ++i) { const u32x4 v = src[i]; const float f[8] = {bflo(v.x), bfhi(v.x), bflo(v.y), bfhi(v.y), bflo(v.z), bfhi(v.z), bflo(v.w), bfhi(v.w)};
#pragma unroll
            for (int k = 0; k < 8; ++k) ss += f[k] * f[k]; }
        ss += __uint_as_float(__builtin_amdgcn_update_dpp(0u, __float_as_uint(ss), 0xB1, 0xF, 0xF, true));
        if (hf == 0) mref[q * 4 + hd] = sqrtf(ss);
        { u32x4 zz_ = {0u, 0u, 0u, 0u}; asm volatile("" : "+v"(zz_)); LAS u32x4* z4 = (LAS u32x4*)U; for (int i = tid; i < (256 * USP) / 4; i += NTHREADS) z4[i] = zz_; }
    }
    __syncthreads();
    const int hl = r16 & 3;
#define ATT_LDK(dst, base, key0) do { const char* kb_ = (const char*)(base) + (size_t)(key0) * 128; _Pragma("unroll") for (int u_ = 0; u_ < 2; ++u_) _Pragma("unroll") for (int ks_ = 0; ks_ < 2; ++ks_) \
        dst[u_][ks_] = *(const bf16x8*)(kb_ + koff + (u_ * 2 + ks_) * 1024); } while (0)
#define ATT_LDV(dst, vbase, LEN, key0) do { const char* vb_ = (const char*)(vbase) + (size_t)(key0) * 128; _Pragma("unroll") for (int dt_ = 0; dt_ < 4; ++dt_) \
        dst[dt_] = *(const bf16x8*)(vb_ + koff + dt_ * 1024); } while (0)
#define ATT_SHADOW() int ln_ = F.lane; asm volatile("" : "+v"(ln_)); const int r16 = ln_ & 15, kg = ln_ >> 4, hl = r16 & 3; const unsigned koff = (unsigned)ln_ * 16u
    {
        ATT_SHADOW();
        bf16x8 qf[2][2]; float mrc[2], lpart[2], carry[2] = {0.f, 0.f}; int nlim[2]; f32x4 o[2][4];
#pragma unroll
        for (int rt = 0; rt < 2; ++rt) { const int q = 8 * w + 4 * rt + (r16 >> 2);
#pragma unroll
            for (int ks = 0; ks < 2; ++ks) qf[rt][ks] = *(const bf16x8*)(Qg + (size_t)q * 512 + hl * 64 + ks * 32 + kg * 8);
            mrc[rt] = mref[q * 4 + hl] * P.kcmax; lpart[rt] = 0.f; nlim[rt] = (t0 + q - 31) >> 4;
#pragma unroll
            for (int dt = 0; dt < 4; ++dt) o[rt][dt] = (f32x4){0.f, 0.f, 0.f, 0.f}; }
        const int nkeys = 4 * qb + 3, NP = (nkeys + 31) >> 5;
        const int nlim_min = (t0 + 8 * w - 31) >> 4;
        const bf16_t* Kc = P.KCMP + (size_t)(b * 2 + g) * 512 * 64; const bf16_t* Vc = P.VCT + (size_t)(b * 2 + g) * 64 * 512;
#define ATT_S1_STEP(KF, VF, s_) do { _Pragma("unroll") for (int rt = 0; rt < 2; ++rt) { \
            f32x4 st[2]; float p[2][4]; \
            _Pragma("unroll") for (int u = 0; u < 2; ++u) { st[u] = MFMA16(KF[u][0], qf[rt][0], ((f32x4){0.f, 0.f, 0.f, 0.f})); st[u] = MFMA16(KF[u][1], qf[rt][1], st[u]); } \
            _Pragma("unroll") for (int u = 0; u < 2; ++u) _Pragma("unroll") for (int i = 0; i < 4; ++i) p[u][i] = fast_exp2(st[u][i] - mrc[rt]); \
            if (32 * (s_) + 31 > nlim_min) { _Pragma("unroll") for (int u = 0; u < 2; ++u) _Pragma("unroll") for (int i = 0; i < 4; ++i) { const int n = 32 * (s_) + 8 * kg + 4 * u + i; if (n > nlim[rt]) p[u][i] = 0.f; } } \
            const float s01 = (p[0][0] + p[0][1]) + (p[0][2] + p[0][3]), s11 = (p[1][0] + p[1][1]) + (p[1][2] + p[1][3]); lpart[rt] += s01 + s11; \
            {   \
                \
              const unsigned x_ = __float_as_uint(p[1][3]); const auto s16_ = __builtin_amdgcn_permlane16_swap(x_, x_, false, false); const auto s32_ = __builtin_amdgcn_permlane32_swap(s16_[1], s16_[1], false, false); \
              const float inc_ = (kg & 1) ? __uint_as_float(s16_[0]) : ((kg == 2) ? __uint_as_float(s32_[0]) : carry[rt]); carry[rt] = __uint_as_float(s32_[1]); \
              LAS float* ur = U + ((8 * w + 4 * rt + (r16 >> 2)) * 4 + hl) * USP + 8 * (s_) + 2 * kg; \
              ur[0] += (2.f * s01 - p[0][3]) + inc_; ur[1] += (2.f * s11 - p[1][3]) + p[0][3]; } \
            u32x4 pw; pw.x = cvtpk(p[0][0], p[0][1]); pw.y = cvtpk(p[0][2], p[0][3]); pw.z = cvtpk(p[1][0], p[1][1]); pw.w = cvtpk(p[1][2], p[1][3]); \
            const bf16x8 pf = __builtin_bit_cast(bf16x8, pw); \
            _Pragma("unroll") for (int dt = 0; dt < 4; ++dt) o[rt][dt] = MFMA16(VF[dt], pf, o[rt][dt]); } } while (0)
        {
            bf16x8 kA[2][2], vA[4], kB[2][2], vB[4];
            ATT_LDK(kA, Kc, 0); ATT_LDV(vA, Vc, 512, 0); if (NP > 1) { ATT_LDK(kB, Kc, 32); ATT_LDV(vB, Vc, 512, 32); }
#pragma nounroll
            for (int s2 = 0; s2 < NP; s2 += 2) {
                ATT_S1_STEP(kA, vA, s2);
                if (s2 + 2 < NP) { ATT_LDK(kA, Kc, 32 * (s2 + 2)); ATT_LDV(vA, Vc, 512, 32 * (s2 + 2)); }
                if (s2 + 1 < NP) { ATT_S1_STEP(kB, vB, s2 + 1);
                    if (s2 + 3 < NP) { ATT_LDK(kB, Kc, 32 * (s2 + 3)); ATT_LDV(vB, Vc, 512, 32 * (s2 + 3)); } }
            }
        }
#undef ATT_S1_STEP
#pragma unroll
        for (int rt = 0; rt < 2; ++rt) { const int q = 8 * w + 4 * rt + (r16 >> 2); const float lrow = kg_sum(lpart[rt]); const float linv = lrow > 0.f ? 1.f / lrow : 0.f;
            if (kg == 0) linvc[q * 4 + hl] = linv;
            const float gc = P.GATES[(tokb + t0 + q) * 24 + (g * 4 + hl) * 3 + 0] * linv;
            float* yp = P.YPART + (tokb + t0 + q) * 512 + (g * 4 + hl) * 64 + 4 * kg;
#pragma unroll
            for (int dt = 0; dt < 4; ++dt) *(f32x4*)(yp + dt * 16) = o[rt][dt] * gc; }
    }
    LDS_WAIT();
#pragma nounroll
    for (int qg = 0; qg < 2; ++qg) {
        if (qb <= 15) {
            if (lane < 4) { const int q = 8 * w + 4 * qg + lane; const unsigned long long m0 = (1ull << (qb + 1)) - 1ull;
                selm[q * 4 + 0] = (unsigned)m0; selm[q * 4 + 1] = (unsigned)(m0 >> 32); selm[q * 4 + 2] = 0u; selm[q * 4 + 3] = 0u; }
        } else {
            const int j0 = lane, j1 = lane + 64; int v0[4], v1[4], thr[4];
#pragma unroll
            for (int k = 0; k < 4; ++k) { const int q = 8 * w + 4 * qg + k; const LAS float* ur = U + (q * 4) * USP; const LAS float* li = linvc + q * 4;
                float i0 = 0.f, i1 = 0.f;
#pragma unroll
                for (int h = 0; h < 4; ++h) { i0 += ur[h * USP + j0] * li[h]; i1 += ur[h * USP + j1] * li[h]; }
                v0[k] = (j0 >= 1 && j0 <= qb - 2) ? (int)__float_as_uint(i0) : -1;
                v1[k] = (j1 <= qb - 2) ? (int)__float_as_uint(i1) : -1; thr[k] = 0; }
#pragma nounroll
            for (int bit = 30; bit >= 0; --bit) {
                const int c0_ = thr[0] | (1 << bit), c1_ = thr[1] | (1 << bit), c2_ = thr[2] | (1 << bit), c3_ = thr[3] | (1 << bit);
                const unsigned long long a0_ = __ballot(v0[0] >= c0_), a1_ = __ballot(v0[1] >= c1_), a2_ = __ballot(v0[2] >= c2_), a3_ = __ballot(v0[3] >= c3_);
                const unsigned long long b0_ = __ballot(v1[0] >= c0_), b1_ = __ballot(v1[1] >= c1_), b2_ = __ballot(v1[2] >= c2_), b3_ = __ballot(v1[3] >= c3_);
                asm volatile("" :: "s"(a0_), "s"(a1_), "s"(a2_), "s"(a3_), "s"(b0_), "s"(b1_), "s"(b2_), "s"(b3_));
                if (__popcll(a0_) + __popcll(b0_) >= 13) thr[0] = c0_;
                if (__popcll(a1_) + __popcll(b1_) >= 13) thr[1] = c1_;
                if (__popcll(a2_) + __popcll(b2_) >= 13) thr[2] = c2_;
                if (__popcll(a3_) + __popcll(b3_) >= 13) thr[3] = c3_; }
            const unsigned long long below = (1ull << lane) - 1ull;
#pragma nounroll
            for (int k = 0; k < 4; ++k) {
                const int vv0 = (k == 0) ? v0[0] : (k == 1) ? v0[1] : (k == 2) ? v0[2] : v0[3], vv1 = (k == 0) ? v1[0] : (k == 1) ? v1[1] : (k == 2) ? v1[2] : v1[3];
                const int th = (k == 0) ? thr[0] : (k == 1) ? thr[1] : (k == 2) ? thr[2] : thr[3];
                const bool gt0 = vv0 > th, gt1 = vv1 > th, eq0 = vv0 == th, eq1 = vv1 == th;
                const int need = 13 - (__popcll(__ballot(gt0)) + __popcll(__ballot(gt1)));
                const unsigned long long B0 = __ballot(eq0), B1 = __ballot(eq1);
                const int rk0 = __popcll(B0 & below), rk1 = __popcll(B0) + __popcll(B1 & below);
                unsigned long long m0 = __ballot(gt0 || (eq0 && rk0 < need)), m1 = __ballot(gt1 || (eq1 && rk1 < need));
                m0 |= 1ull;
                if (qb < 64) m0 |= (1ull << qb); else m1 |= (1ull << (qb - 64));
                if (qb - 1 < 64) m0 |= (1ull << (qb - 1)); else m1 |= (1ull << (qb - 65));
                if (lane == 0) { const int q = 8 * w + 4 * qg + k; selm[q * 4 + 0] = (unsigned)m0; selm[q * 4 + 1] = (unsigned)(m0 >> 32); selm[q * 4 + 2] = (unsigned)m1; selm[q * 4 + 3] = (unsigned)(m1 >> 32); } }
        }
    }
    __syncthreads();
    { u32x4 zz_ = {0u, 0u, 0u, 0u}; asm volatile("" : "+v"(zz_)); LAS u32x4* z4 = (LAS u32x4*)Oh; for (int i = tid; i < (2 * 256 * OSP) / 4; i += NTHREADS) z4[i] = zz_; }
    lsel[tid] = 0;
    if (tid == 0) wctr[0] = 0;
    { const unsigned m0 = selm[lane * 4 + (w >> 1)];
#pragma nounroll
      for (int jj = 0; jj < 16; ++jj) { const int j = 16 * w + jj; const bool hit = (j <= qb) && ((m0 >> (16 * (w & 1) + jj)) & 1u);
          const unsigned long long mk = __ballot(hit); if (hit) lists[j * 64 + __popcll(mk & ((1ull << lane) - 1ull))] = (unsigned char)lane;
          if (lane == 0) cnts[j] = __popcll(mk); } }
    __syncthreads();
    for (int rep5 = 0; rep5 < ((ATTREP & 8) ? NREP : 1); ++rep5)
    {
        if (rep5 > 0) { __syncthreads(); if (tid == 0) wctr[0] = 0; __syncthreads(); }
        ATT_SHADOW();
        const bf16_t* Ks = P.KS + (size_t)(b * 2 + g) * SEQ * 64; const bf16_t* Vs = P.VST + (size_t)(b * 2 + g) * 64 * SEQ;
        const float S1 = 1048576.f / fmaxf(P.vmax, 1e-30f);
#define ATT_FETCH(idx_) do { int i_ = 0; if (lane == 0) i_ = __hip_atomic_fetch_add(wctr, 1, __ATOMIC_RELAXED, __HIP_MEMORY_SCOPE_WORKGROUP); idx_ = __builtin_amdgcn_readfirstlane(i_); } while (0)
#define ATT_JOF(idx_) (((idx_) == 0) ? 0 : (((idx_) == 1) ? qb : (((idx_) == 2) ? qb - 1 : (idx_) - 2)))
        bf16x8 kn[2][2][2];
        int idx; ATT_FETCH(idx);
        if (idx <= qb) { const int j = ATT_JOF(idx); ATT_LDK(kn[0], Ks, 64 * j); ATT_LDK(kn[1], Ks, 64 * j + 32); }
#pragma nounroll
        while (idx <= qb) {
            const int j = ATT_JOF(idx);
            bf16x8 kf[2][2][2], vf[2][4];
#pragma unroll
            for (int sp = 0; sp < 2; ++sp) {
#pragma unroll
                for (int u = 0; u < 2; ++u) { kf[sp][u][0] = kn[sp][u][0]; kf[sp][u][1] = kn[sp][u][1]; } }
            ATT_LDV(vf[0], Vs, SEQ, 64 * j); ATT_LDV(vf[1], Vs, SEQ, 64 * j + 32);
            int idx2; ATT_FETCH(idx2);
            if (idx2 <= qb) { const int j2 = ATT_JOF(idx2); ATT_LDK(kn[0], Ks, 64 * j2); ATT_LDK(kn[1], Ks, 64 * j2 + 32); }
            const int cnt = cnts[j];
            const int nch = (cnt + 3) >> 2;
            bf16x8 qn0, qn1; int qnx; bool vnx;
            { const int qs = (r16 >> 2); vnx = qs < cnt; qnx = lists[j * 64 + (vnx ? qs : (cnt > 0 ? cnt - 1 : 0))];
              const bf16_t* qp = Qg + (size_t)qnx * 512 + hl * 64 + kg * 8; qn0 = *(const bf16x8*)qp; qn1 = *(const bf16x8*)(qp + 32); }
#pragma nounroll
            for (int c = 0; c < nch; ++c) {
                const bool valid = vnx; const int q = qnx; const int row = q * 4 + hl; const bf16x8 q0 = qn0, q1 = qn1;
                if (c + 1 < nch) { const int qs = 4 * (c + 1) + (r16 >> 2); vnx = qs < cnt; qnx = lists[j * 64 + (vnx ? qs : cnt - 1)];
                    const bf16_t* qp = Qg + (size_t)qnx * 512 + hl * 64 + kg * 8; qn0 = *(const bf16x8*)qp; qn1 = *(const bf16x8*)(qp + 32); }
                const float mr = mref[row] * P.kmax;
                f32x4 o[4];
                float ps = 0.f;
                const bool slow = (j == qb) || (4 * c + 4 > cnt);
#define ATT_CHUNK(MASKED) \
                _Pragma("unroll") for (int sp = 0; sp < 2; ++sp) { \
                    f32x4 st[2]; float p[2][4]; \
                    _Pragma("unroll") for (int u = 0; u < 2; ++u) { st[u] = MFMA16(kf[sp][u][0], q0, ((f32x4){0.f, 0.f, 0.f, 0.f})); st[u] = MFMA16(kf[sp][u][1], q1, st[u]); } \
                    _Pragma("unroll") for (int u = 0; u < 2; ++u) _Pragma("unroll") for (int i = 0; i < 4; ++i) { float e = fast_exp2(st[u][i] - mr); \
                        if (MASKED) { const int kk = 32 * sp + 8 * kg + 4 * u + i; if (!valid || (j == qb && kk > q)) e = 0.f; } p[u][i] = e; ps += e; } \
                    u32x4 pw; pw.x = cvtpk(p[0][0], p[0][1]); pw.y = cvtpk(p[0][2], p[0][3]); pw.z = cvtpk(p[1][0], p[1][1]); pw.w = cvtpk(p[1][2], p[1][3]); \
                    const bf16x8 pf = __builtin_bit_cast(bf16x8, pw); \
                    _Pragma("unroll") for (int dt = 0; dt < 4; ++dt) o[dt] = (sp == 0) ? MFMA16(vf[0][dt], pf, ((f32x4){0.f, 0.f, 0.f, 0.f})) : MFMA16(vf[1][dt], pf, o[dt]); }
                if (slow) { ATT_CHUNK(true) } else { ATT_CHUNK(false) }
#undef ATT_CHUNK
                ps = kg_sum(ps);
                if (valid) {
                    if (kg == 0) { const float xs = ps * 1048576.f, hf_ = __builtin_rintf(xs); __hip_atomic_fetch_add(lsel + row, (int)hf_, __ATOMIC_RELAXED, __HIP_MEMORY_SCOPE_WORKGROUP);
                        __hip_atomic_fetch_add(lsel + 256 + row, (int)((xs - hf_) * 1048576.f), __ATOMIC_RELAXED, __HIP_MEMORY_SCOPE_WORKGROUP); }
#pragma unroll
                    for (int dt = 0; dt < 4; ++dt)
#pragma unroll
                        for (int i = 0; i < 4; ++i) { const float xs = o[dt][i] * S1, hf_ = __builtin_rintf(xs); const int off = row * OSP + dt * 16 + 4 * kg + i;
                            __hip_atomic_fetch_add(Oh + off, (int)hf_, __ATOMIC_RELAXED, __HIP_MEMORY_SCOPE_WORKGROUP);
                            __hip_atomic_fetch_add(Ol + off, (int)((xs - hf_) * 1048576.f), __ATOMIC_RELAXED, __HIP_MEMORY_SCOPE_WORKGROUP); }
                }
            }
            idx = idx2;
        }
    }
    f32x4 yacc[2][4];
    {
        ATT_SHADOW();
        bf16x8 qf[2][2]; float mrw[2], lpart[2]; f32x4 o[2][4];
#pragma unroll
        for (int rt = 0; rt < 2; ++rt) { const int q = 8 * w + 4 * rt + (r16 >> 2);
#pragma unroll
            for (int ks = 0; ks < 2; ++ks) qf[rt][ks] = *(const bf16x8*)(Qg + (size_t)q * 512 + hl * 64 + ks * 32 + kg * 8);
            mrw[rt] = mref[q * 4 + hl] * P.kwmax; lpart[rt] = 0.f;
#pragma unroll
            for (int dt = 0; dt < 4; ++dt) o[rt][dt] = (f32x4){0.f, 0.f, 0.f, 0.f}; }
        const bf16_t* Kw = P.KW + (size_t)(b * 2 + g) * SEQ * 64; const bf16_t* Vw = P.VWT + (size_t)(b * 2 + g) * 64 * SEQ;
        const int jlo = qb >= 8 ? qb - 8 : 0; const int nit = 2 * (qb - jlo + 1);
#define ATT_S4_STEP(KF, VF, it_) do { const int jw_ = jlo + ((it_) >> 1), sp_ = (it_) & 1; const int mode_ = (jw_ == qb) ? 1 : ((jw_ == qb - 8) ? 2 : 0); \
        _Pragma("unroll") for (int rt = 0; rt < 2; ++rt) { \
            f32x4 st[2]; float p[2][4]; \
            _Pragma("unroll") for (int u = 0; u < 2; ++u) { st[u] = MFMA16(KF[u][0], qf[rt][0], ((f32x4){0.f, 0.f, 0.f, 0.f})); st[u] = MFMA16(KF[u][1], qf[rt][1], st[u]); } \
            _Pragma("unroll") for (int u = 0; u < 2; ++u) _Pragma("unroll") for (int i = 0; i < 4; ++i) p[u][i] = fast_exp2(st[u][i] - mrw[rt]); \
            if (mode_) { const int tq = 8 * w + 4 * rt + (r16 >> 2); \
                _Pragma("unroll") for (int u = 0; u < 2; ++u) _Pragma("unroll") for (int i = 0; i < 4; ++i) { const int kk = 32 * sp_ + 8 * kg + 4 * u + i; const bool vis = (mode_ == 1) ? (kk <= tq) : (kk > tq); if (!vis) p[u][i] = 0.f; } } \
            lpart[rt] += ((p[0][0] + p[0][1]) + (p[0][2] + p[0][3])) + ((p[1][0] + p[1][1]) + (p[1][2] + p[1][3])); \
            u32x4 pw; pw.x = cvtpk(p[0][0], p[0][1]); pw.y = cvtpk(p[0][2], p[0][3]); pw.z = cvtpk(p[1][0], p[1][1]); pw.w = cvtpk(p[1][2], p[1][3]); \
            const bf16x8 pf = __builtin_bit_cast(bf16x8, pw); \
            _Pragma("unroll") for (int dt = 0; dt < 4; ++dt) o[rt][dt] = MFMA16(VF[dt], pf, o[rt][dt]); } } while (0)
        {
            bf16x8 kA[2][2], vA[4], kB[2][2], vB[4];
            ATT_LDK(kA, Kw, 64 * jlo); ATT_LDV(vA, Vw, SEQ, 64 * jlo); ATT_LDK(kB, Kw, 64 * jlo + 32); ATT_LDV(vB, Vw, SEQ, 64 * jlo + 32);
#pragma nounroll
            for (int it = 0; it < nit; it += 2) {
                ATT_S4_STEP(kA, vA, it);
                if (it + 2 < nit) { ATT_LDK(kA, Kw, 64 * jlo + 32 * (it + 2)); ATT_LDV(vA, Vw, SEQ, 64 * jlo + 32 * (it + 2)); }
                ATT_S4_STEP(kB, vB, it + 1);
                if (it + 3 < nit) { ATT_LDK(kB, Kw, 64 * jlo + 32 * (it + 3)); ATT_LDV(vB, Vw, SEQ, 64 * jlo + 32 * (it + 3)); }
            }
        }
#undef ATT_S4_STEP
#pragma unroll
        for (int rt = 0; rt < 2; ++rt) { const int q = 8 * w + 4 * rt + (r16 >> 2); const float lw_ = kg_sum(lpart[rt]); const float sc = lw_ > 0.f ? P.GATES[(tokb + t0 + q) * 24 + (g * 4 + hl) * 3 + 2] / lw_ : 0.f;
#pragma unroll
            for (int dt = 0; dt < 4; ++dt) yacc[rt][dt] = o[rt][dt] * sc; }
    }
    __syncthreads();
#pragma unroll
    for (int rt = 0; rt < 2; ++rt) { const int q = 8 * w + 4 * rt + (r16 >> 2), row = q * 4 + hl;
        const float lrow = (float)lsel[row] * (1.f / 1048576.f) + (float)lsel[256 + row] * (1.f / 1099511627776.f);
        const float invS1 = fmaxf(P.vmax, 1e-30f) * (1.f / 1048576.f);
        const float sc = lrow > 0.f ? P.GATES[(tokb + t0 + q) * 24 + (g * 4 + hl) * 3 + 1] / lrow * invS1 : 0.f;
        bf16_t* dst = P.Y + (tokb + t0 + q) * 1024 + 512 + (g * 4 + hl) * 64 + 4 * kg;
        const float* yp = P.YPART + (tokb + t0 + q) * 512 + (g * 4 + hl) * 64 + 4 * kg;
#pragma unroll
        for (int dt = 0; dt < 4; ++dt) { const LAS int* oh = Oh + row * OSP + dt * 16 + 4 * kg; const LAS int* ol = Ol + row * OSP + dt * 16 + 4 * kg;
            const f32x4 osel = (f32x4){(float)oh[0] + (float)ol[0] * (1.f / 1048576.f), (float)oh[1] + (float)ol[1] * (1.f / 1048576.f), (float)oh[2] + (float)ol[2] * (1.f / 1048576.f), (float)oh[3] + (float)ol[3] * (1.f / 1048576.f)};
            const f32x4 v = yacc[rt][dt] + *(const f32x4*)(yp + dt * 16) + osel * sc;
            u32x2 o; o.x = cvtpk(v[0], v[1]); o.y = cvtpk(v[2], v[3]); *(u32x2*)(dst + dt * 16) = o; } }
    __syncthreads();
}
#undef MFMA16
#undef ATT_LDK
#undef ATT_LDV
#undef ATT_SHADOW
#undef ATT_FETCH
#undef ATT_JOF
}

__device__ __forceinline__ void phase_n2(Frame& F, const Args& a, int l) {
    const int lane = F.lane, w = F.wave;
    const float* XR = WSP(float, WS_XR); unsigned char* H8 = WSP(unsigned char, WS_H8);
    const float* g = INP(a, float, I_N2G) + l * 1024;
    LAS float* part = (LAS float*)F.lds;
    LAS float* ssqp = (LAS float*)(F.lds + 32768);
    LAS float* lg = (LAS float*)(F.lds + 32768 + 1024);
    int* CNTI = WSP(int, WS_CNTI); int* ASG = WSP(int, WS_ASG); float* G4 = WSP(float, WS_GATE4);
    for (int item = F.vcu; item < T / 64; item += F.G) {
        const int tk0 = item * 64, b = tk0 >> 13; const int tt = w & 1, kq = w >> 1;
        const float* rwp = WSP(float, WS_RWP) + (size_t)(l * 2 + b) * 1024 * 32; const float* rbp = WSP(float, WS_MISC + 4096) + (l * 2 + b) * 32;
        const int i31 = lane & 31, hf = lane >> 5;
        {
            const float* xp = XR + (size_t)(tk0 + tt * 32 + i31) * DM + kq * 256 + 4 * hf; const float* wp = rwp + (size_t)(kq * 256 + 4 * hf) * 32 + i31;
            f32x16 acc;
#pragma unroll
            for (int r = 0; r < 16; ++r) acc[r] = 0.f;
            float ssq = 0.f;
#pragma nounroll
            for (int bt = 0; bt < 4; ++bt) {
                f32x4 xv[8]; float wv[8][4];
#pragma unroll
                for (int s = 0; s < 8; ++s) { xv[s] = *(const f32x4*)(xp + 8 * (bt * 8 + s)); const float* wq = wp + (size_t)(8 * (bt * 8 + s)) * 32;
                    wv[s][0] = wq[0]; wv[s][1] = wq[32]; wv[s][2] = wq[64]; wv[s][3] = wq[96]; }
#pragma unroll
                for (int s = 0; s < 8; ++s) { ssq += (xv[s].x * xv[s].x + xv[s].y * xv[s].y) + (xv[s].z * xv[s].z + xv[s].w * xv[s].w);
                    acc = __builtin_amdgcn_mfma_f32_32x32x2f32(xv[s].x, wv[s][0], acc, 0, 0, 0); acc = __builtin_amdgcn_mfma_f32_32x32x2f32(xv[s].y, wv[s][1], acc, 0, 0, 0);
                    acc = __builtin_amdgcn_mfma_f32_32x32x2f32(xv[s].z, wv[s][2], acc, 0, 0, 0); acc = __builtin_amdgcn_mfma_f32_32x32x2f32(xv[s].w, wv[s][3], acc, 0, 0, 0); }
            }
            ssq += __shfl_xor(ssq, 32);
            if (hf == 0) ssqp[kq * 64 + tt * 32 + i31] = ssq;
#pragma unroll
            for (int r = 0; r < 16; ++r) { const int tk = (r & 3) + 8 * (r >> 2) + 4 * hf; part[(w * 32 + tk) * 32 + i31] = acc[r]; }
        }
        __syncthreads();
        for (int i = F.tid; i < 64 * 32; i += NTHREADS) { const int tk = i >> 5, e = i & 31, t2 = tk >> 5, tl = tk & 31;
            const float sq = (ssqp[tk] + ssqp[64 + tk]) + (ssqp[128 + tk] + ssqp[192 + tk]); const float rstd = 1.f / sqrtf(sq * (1.f / DM) + NORM_EPS);
            const float v = (part[((0 * 2 + t2) * 32 + tl) * 32 + e] + part[((1 * 2 + t2) * 32 + tl) * 32 + e]) + (part[((2 * 2 + t2) * 32 + tl) * 32 + e] + part[((3 * 2 + t2) * 32 + tl) * 32 + e]);
            lg[tk * 33 + e] = v * rstd + rbp[e]; }
        __syncthreads();
        if (w < 2) {
            const int it = item * 2 + w;
            float v0 = -INFINITY, v1 = -INFINITY, v2 = -INFINITY, v3 = -INFINITY; int i0 = -1, i1 = -1, i2 = -1, i3 = -1;
            if (lane < 32) {
#pragma unroll 8
                for (int e = 0; e < 32; ++e) { const float v = lg[(w * 32 + lane) * 33 + e];
                    if (v > v3) { if (v > v2) { v3 = v2; i3 = i2; if (v > v1) { v2 = v1; i2 = i1; if (v > v0) { v1 = v0; i1 = i0; v0 = v; i0 = e; } else { v1 = v; i1 = e; } } else { v2 = v; i2 = e; } } else { v3 = v; i3 = e; } } }
            }
            const float e1 = __expf(v1 - v0), e2 = __expf(v2 - v0), e3 = __expf(v3 - v0); const float inv = 1.f / (1.f + e1 + e2 + e3);
            int r0 = 0, r1 = 0, r2 = 0, r3 = 0, mycnt = 0;
            for (int e = 0; e < 32; ++e) { const bool hit = (i0 == e) | (i1 == e) | (i2 == e) | (i3 == e); const unsigned long long U = __ballot(hit);
                const int rk = __popcll(U & ((1ull << lane) - 1ull));
                if (i0 == e) r0 = rk; if (i1 == e) r1 = rk; if (i2 == e) r2 = rk; if (i3 == e) r3 = rk;
                if (lane == e) mycnt = __popcll(U); }
            if (lane < 32) { const int tk = tk0 + w * 32 + lane; CNTI[it * 32 + lane] = mycnt;
                if (mycnt > 0) { atomicAdd(F.ctl + CW_GCNT + (l * 32 + (it >> 4)) * 32 + lane, (unsigned)mycnt); atomicAdd(F.ctl + CW_CNT + l * 32 + lane, (unsigned)mycnt); }
                *(int4*)(ASG + tk * 4) = make_int4((i0 << 16) | r0, (i1 << 16) | r1, (i2 << 16) | r2, (i3 << 16) | r3);
                *(f32x4*)(G4 + tk * 4) = (f32x4){inv, e1 * inv, e2 * inv, e3 * inv}; }
        }
#pragma unroll 2
        for (int rr = 0; rr < 8; ++rr) { const int m = tk0 + w * 8 + rr; const RowV r = row_load(XR + (size_t)m * DM, lane);
            const float rstd = 1.f / sqrtf(row_ssq(r) * (1.f / DM) + NORM_EPS);
            row_norm_store8(r, rstd, g, MODP(l, b, 4), MODP(l, b, 3), H8 + (size_t)m * DM, lane); }
        __syncthreads();
    }
}

__device__ __forceinline__ void phase_n2b(Frame& F, int l) {
    const int gw = F.vcu * NWAVES + F.wave, NGW = F.G * NWAVES; const int lane = F.lane;
    const int* CNTI = WSP(int, WS_CNTI); int* TOK = WSP(int, WS_TOK); int* ASG = WSP(int, WS_ASG); unsigned* cnt = F.ctl + CW_CNT + l * 32;
    for (int it = gw; it < T / 32; it += NGW) {
        int base = 0;
        {
            const unsigned* gc = F.ctl + CW_GCNT + l * 1024; const int grp = it >> 4, e = lane & 31; int s0 = 0, s1 = 0;
#pragma unroll
            for (int gI = 0; gI < 32; ++gI) { const int v = (int)gc[gI * 32 + e]; s0 += (gI < grp) ? v : 0; }
#pragma unroll
            for (int i = 0; i < 16; ++i) { const int v = CNTI[((grp << 4) + i) * 32 + e]; s1 += (((grp << 4) + i) < it) ? v : 0; }
            base = s0 + s1; }
        { const int tk = it * 32 + (lane & 31); const int4 as = *(const int4*)(ASG + tk * 4); int v[4] = {as.x, as.y, as.z, as.w};
#pragma unroll
            for (int k = 0; k < 4; ++k) { const int e = v[k] >> 16, rk = v[k] & 0xffff; const int sl = __shfl(base, e & 31) + rk; if (lane < 32) TOK[e * 16384 + sl] = tk; v[k] = (e << 16) | sl; }
            if (lane < 32) *(int4*)(ASG + tk * 4) = make_int4(v[0], v[1], v[2], v[3]); }
    }
}

__device__ __forceinline__ void moe_tables(Frame& F, int l, int NT, int& total) {
    LAS int* ust = (LAS int*)(F.lds + MOE_OFF); LAS int* bst = ust + 33; LAS int* cn = bst + 33;
    if (F.tid < 64) { const unsigned* cnt = F.ctl + CW_CNT + l * 32; const int lane = F.tid;
        const int c = (lane < NE) ? (int)cnt[lane] : 0; const int nb = (c + 255) >> 8; int inc = nb;
#pragma unroll
        for (int o = 1; o < 32; o <<= 1) { const int t = __shfl_up(inc, o); if ((lane & 31) >= o) inc += t; }
        if (lane < NE) { bst[lane] = inc - nb; ust[lane] = (inc - nb) * NT; cn[lane] = c; if (lane == NE - 1) { bst[NE] = inc; ust[NE] = inc * NT; } } }
    __syncthreads();
    total = ust[NE];
}

constexpr int PH_PROLOGUE = 0, PH_N1 = 1, PH_LAYER0 = 2, PH_PER_LAYER = 9, NPHASES = PH_LAYER0 + DEPTH * PH_PER_LAYER;
__global__ void __launch_bounds__(NTHREADS, 2) fwd_kernel(Args args) {
    extern __shared__ __attribute__((aligned(16))) unsigned char lds_raw[];
    Frame F;
    F.lds = (LAS unsigned char*)lds_raw; F.ws = args.ws; F.ctl = (unsigned*)(args.ws + WS_CTL);
    F.tid = threadIdx.x; F.lane = F.tid & 63; F.wave = __builtin_amdgcn_readfirstlane(F.tid >> 6);
    F.G = gridDim.x; { const int bx = blockIdx.x; F.vcu = (F.G % 8 == 0) ? (bx % 8) * (F.G / 8) + bx / 8 : bx; }
    for (int u = F.tid; u < (LDS_BYTES - LDSCTL_OFF) / 4; u += NTHREADS) ((LAS unsigned*)(F.lds + LDSCTL_OFF))[u] = 0u;
    __syncthreads();
    volatile LAS unsigned* MISC = (volatile LAS unsigned*)(F.lds + MISC_OFF);
    XcdBarrier bar; bar.bar = F.ctl + CW_BAR; bar.x = 0; bar.st = nullptr;
#if !MK_PER_PHASE
    bar = xcd_barrier_post(F.ctl + CW_BAR, MISC + 8);
#endif
    const int lo = args.ph_lo, hi = args.ph_hi;
#define IN(k) (lo <= (k) && (k) < hi)
#define REFRESH() do { int t_ = threadIdx.x; asm volatile("" : "+v"(t_)); F.tid = t_; F.lane = t_ & 63; F.wave = __builtin_amdgcn_readfirstlane(t_ >> 6); } while (0)
#define SEAM(k) do { if (IN(k) && IN((k) + 1)) xcd_barrier(bar); } while (0)
#define REPS(bit, idem) (((REPMASK & (bit)) && (idem)) ? NREP : 1)

    if (IN(PH_PROLOGUE) && !(SKIPMASK & 1)) for (int rep = 0; rep < REPS(1, true); ++rep) { REFRESH(); phase_prologue(F, args); } SEAM(PH_PROLOGUE);
    if (IN(PH_N1) && !(SKIPMASK & 2)) for (int rep = 0; rep < REPS(2, true); ++rep) { REFRESH(); phase_n1_first(F, args); } SEAM(PH_N1);
    for (int l = 0; l < DEPTH; ++l) {
        const int p0 = PH_LAYER0 + l * PH_PER_LAYER;
        if (IN(p0 + 0) && !(SKIPMASK & 4)) for (int rep = 0; rep < REPS(4, l == 0); ++rep) {
            { pg8::DenseOrder S; S.init(T, 2560, F.G, ({ int b_ = (int)blockIdx.x; asm volatile("" : "+s"(b_)); b_; }));
              EpiProj E{WSP(bf16_t, WS_UG), WSP(bf16_t, WS_VG), WSP(bf16_t, WS_Q), WSP(bf16_t, WS_KC), WSP(bf16_t, WS_VC), WSP(bf16_t, WS_KS), WSP(bf16_t, WS_KW), WSP(bf16_t, WS_VST), WSP(bf16_t, WS_VWT),
                        WSP(float, WS_GATES), WSP(float, WS_ROPE), F.ctl + CW_KMAX + l * 16, 0};
              pg8::gemm_phase<EpiProj, pg8::DenseOrder, false, true, true>(F.lds, WSP(bf16_t, WS_H8), (const bf16_t*)(WSP(unsigned char, WS_WIN8) + (size_t)l * 2560 * 1024), 512, S, E); }
        }
        SEAM(p0 + 0);
        if (IN(p0 + 1) && !(SKIPMASK & 8)) for (int rep = 0; rep < REPS(8, l == 0); ++rep) { REFRESH();
            for (int it = F.vcu; it < 256; it += F.G) { if (it < 128) sgu_item(F, args, l, it); else { compress_item(F, args, l, 2 * (it - 128)); compress_item(F, args, l, 2 * (it - 128) + 1); } }
        }
        SEAM(p0 + 1);
        if (IN(p0 + 2) && !(SKIPMASK & 16)) for (int rep = 0; rep < REPS(16, l == 0); ++rep) { REFRESH();
            att::Ptrs P{WSP(bf16_t, WS_Q), WSP(bf16_t, WS_KS), WSP(bf16_t, WS_KW), WSP(bf16_t, WS_VST), WSP(bf16_t, WS_VWT), WSP(bf16_t, WS_KCMP), WSP(bf16_t, WS_VCT), WSP(float, WS_GATES), WSP(bf16_t, WS_Y), WSP(float, WS_YPART), 0.f};
            for (int it = F.vcu; it < 512; it += F.G) {
                const int uu = (it < 256) ? it : (767 - it);
                const int bg = uu >> 7, qb = uu & 127;
                const unsigned* km = F.ctl + CW_KMAX + l * 16 + bg;
                P.kmax = sqrtf(__uint_as_float(__hip_atomic_load(km, __ATOMIC_RELAXED, __HIP_MEMORY_SCOPE_AGENT)));
                P.vmax = __uint_as_float(__hip_atomic_load(km + 4, __ATOMIC_RELAXED, __HIP_MEMORY_SCOPE_AGENT));
                P.kwmax = sqrtf(__uint_as_float(__hip_atomic_load(km + 8, __ATOMIC_RELAXED, __HIP_MEMORY_SCOPE_AGENT)));
                P.kcmax = sqrtf(__uint_as_float(__hip_atomic_load(km + 12, __ATOMIC_RELAXED, __HIP_MEMORY_SCOPE_AGENT)));
                att::attn_unit(F, P, bg >> 1, bg & 1, qb);
            }
        }
        SEAM(p0 + 2);
        if (IN(p0 + 3) && !(SKIPMASK & 32)) for (int rep = 0; rep < REPS(32, l == 0); ++rep) {
            pg8::DenseOrder S; S.init(T, DM, F.G, ({ int b_ = (int)blockIdx.x; asm volatile("" : "+s"(b_)); b_; }));
            EpiOut E{l == 0 ? INP(args, float, I_X) : WSP(float, WS_XR), WSP(float, WS_XR), (const float*)(F.ctl + CW_MOD) + (size_t)l * 2 * 6144};
            pg8::gemm_phase<EpiOut, pg8::DenseOrder, false, true>(F.lds, WSP(bf16_t, WS_Y), WSP(bf16_t, WS_WOUT) + (size_t)l * 1024 * 1024, 1024, S, E);
        }
        SEAM(p0 + 3);
        if (IN(p0 + 4) && !(SKIPMASK & 64)) for (int rep = 0; rep < REPS(64, l == 0); ++rep) { REFRESH(); phase_n2(F, args, l); }
        SEAM(p0 + 4);
        if (IN(p0 + 5) && !(SKIPMASK & 64)) for (int rep = 0; rep < REPS(1024, l == 0); ++rep) { REFRESH(); phase_n2b(F, l); }
        SEAM(p0 + 5);
        if (IN(p0 + 6) && !(SKIPMASK & 128)) for (int rep = 0; rep < REPS(128, l == 0); ++rep) { REFRESH();
            int total; moe_tables(F, l, 8, total);
            LAS int* ust = (LAS int*)(F.lds + MOE_OFF);
            pg8::MoeOrder S{ust, ust + 33, ust + 66, WSP(int, WS_TOK), 8, F.G, F.vcu, total, 1024};
            EpiSwiglu E{WSP(unsigned char, WS_ACT), INP(args, float, I_EB1) + (size_t)l * NE * 2048};
            pg8::gemm_phase<EpiSwiglu, pg8::MoeOrder, true, true, true>(F.lds, WSP(bf16_t, WS_H8), (const bf16_t*)(WSP(unsigned char, WS_W1T) + (size_t)l * NE * 2048 * 1024), 512, S, E);
        }
        SEAM(p0 + 6);
        if (IN(p0 + 7) && !(SKIPMASK & 256)) for (int rep = 0; rep < REPS(256, l == 0); ++rep) { REFRESH();
            int total; moe_tables(F, l, 4, total);
            LAS int* ust = (LAS int*)(F.lds + MOE_OFF);
            pg8::MoeOrder S{ust, ust + 33, ust + 66, WSP(int, WS_TOK), 4, F.G, F.vcu, total, 1024};
            EpiDown E{WSP(unsigned char, WS_YROWS), INP(args, float, I_EB2) + (size_t)l * NE * 1024};
            pg8::gemm_phase<EpiDown, pg8::MoeOrder, false, true, true>(F.lds, WSP(bf16_t, WS_ACT), (const bf16_t*)(WSP(unsigned char, WS_W2T) + (size_t)l * NE * 1024 * 1024), 512, S, E);
        }
        SEAM(p0 + 7);
        if (IN(p0 + 8) && !(SKIPMASK & 512)) for (int rep = 0; rep < REPS(512, l == DEPTH - 1); ++rep) { REFRESH(); phase_combine(F, args, l); }
        if (l + 1 < DEPTH) SEAM(p0 + 8);
    }
#undef IN
#undef SEAM
}

extern "C" void kernel_launch(void* const* d_in, const int* in_sizes, int n_in, void* d_out, int out_size, void* d_ws, size_t ws_size, hipStream_t stream) {
    static int grid = 0;
    if (grid == 0) {
        if (n_in != 26 || out_size != T * DM || ws_size < WS_END) { fprintf(stderr, "kernel_launch: unexpected problem (n_in %d, out %d, ws %zu; need ws >= %zu)\n", n_in, out_size, ws_size, (size_t)WS_END); grid = -1; return; }
        int dev = 0, cus = 0, per_cu = 0;
        if (hipGetDevice(&dev) != hipSuccess || hipDeviceGetAttribute(&cus, hipDeviceAttributeMultiprocessorCount, dev) != hipSuccess) { grid = -1; return; }
        if (hipFuncSetAttribute((const void*)fwd_kernel, hipFuncAttributeMaxDynamicSharedMemorySize, LDS_BYTES) != hipSuccess) { fprintf(stderr, "kernel_launch: hipFuncSetAttribute failed\n"); grid = -1; return; }
        if (hipOccupancyMaxActiveBlocksPerMultiprocessor(&per_cu, (const void*)fwd_kernel, NTHREADS, LDS_BYTES) != hipSuccess || per_cu < 1) { fprintf(stderr, "kernel_launch: occupancy query says %d\n", per_cu); (void)hipGetLastError(); per_cu = 1; }
        grid = cus;
    }
    if (grid < 0) return;
    if (hipMemsetAsync((char*)d_ws + WS_CTL, 0, CTL_ZERO_BYTES, stream) != hipSuccess) { fprintf(stderr, "kernel_launch: memset failed\n"); return; }
    Args a{};
    for (int i = 0; i < 26; ++i) a.in[i] = d_in[i];
    a.out = (float*)d_out; a.ws = (unsigned char*)d_ws;
#if MK_PER_PHASE
    for (int p = 0; p < NPHASES; ++p) { a.ph_lo = p; a.ph_hi = p + 1; a.li = 0;
        hipLaunchKernelGGL(fwd_kernel, dim3(grid), dim3(NTHREADS), LDS_BYTES, stream, a); }
#else
    a.ph_lo = 0; a.ph_hi = NPHASES; a.li = 0;
    void* kargs[] = {&a};
    hipError_t e = hipLaunchCooperativeKernel((const void*)fwd_kernel, dim3(grid), dim3(NTHREADS), kargs, LDS_BYTES, stream);
    if (e != hipSuccess) fprintf(stderr, "kernel_launch: cooperative launch failed: %s (grid %d)\n", hipGetErrorString(e), grid);
#endif
}
```

```cpp
#include <hip/hip_runtime.h>
#include <cstdio>
#include <cstdint>

#ifndef SKIPMASK
#define SKIPMASK 0
#endif
#ifndef REPMASK
#define REPMASK 0
#endif
#ifndef NREP
#define NREP 3
#endif
#ifndef DUMMYINT
#define DUMMYINT 0
#endif
#ifndef ATTREP
#define ATTREP 0
#endif
#ifndef MK_PER_PHASE
#define MK_PER_PHASE 0
#endif

#define LAS __attribute__((address_space(3)))
typedef unsigned short bf16_t;
typedef short bf16x8 __attribute__((ext_vector_type(8)));
typedef float f32x4 __attribute__((ext_vector_type(4)));
typedef float f32x2 __attribute__((ext_vector_type(2)));
typedef float f32x16 __attribute__((ext_vector_type(16)));
typedef unsigned u32x4 __attribute__((ext_vector_type(4)));
typedef unsigned u32x2 __attribute__((ext_vector_type(2)));
typedef __bf16 bf16x2_t __attribute__((ext_vector_type(2)));
typedef int i32x4 __attribute__((ext_vector_type(4)));
typedef int i32x8 __attribute__((ext_vector_type(8)));

constexpr int BATCH = 2, SEQ = 8192, DM = 1024, T = BATCH * SEQ, DEPTH = 2;
constexpr int PIN = 2328, PINP = 2560;
constexpr int NE = 32, FF = 1024, TOPK = 4;
constexpr int NCMP = 511, NCMPP = 512;
constexpr float NORM_EPS = 1e-6f;
constexpr float W8SCALE = 64.f;
constexpr int W8_E8M0 = 0x79797979, ONE_E8M0 = 0x7f7f7f7f;
constexpr float QSCALE = 0.125f * 1.4426950408889634f;
constexpr int NWAVES = 8, NTHREADS = 512;

constexpr size_t MiB = 1u << 20;
constexpr size_t WS_CTL = 0, CTL_ZERO_BYTES = 1 * MiB;
constexpr size_t WS_WIN = 1 * MiB;
constexpr size_t WS_WOUT = 11 * MiB;
constexpr size_t WS_SGW = 15 * MiB;
constexpr size_t WS_CW1 = 15 * MiB + 512 * 1024;
constexpr size_t WS_ROPE = 17 * MiB;
constexpr size_t WS_RWP = 21 * MiB;
constexpr size_t WS_MISC = 21 * MiB + 512 * 1024;
constexpr size_t WS_W1T = 32 * MiB;
constexpr size_t WS_W2T = 288 * MiB;
constexpr size_t WS_XR = 416 * MiB;
constexpr size_t WS_H = 480 * MiB;
constexpr size_t WS_UG = 513 * MiB, WS_VG = 529 * MiB, WS_Q = 545 * MiB;
constexpr size_t WS_KC = 561 * MiB, WS_VC = 565 * MiB, WS_KS = 569 * MiB, WS_KW = 573 * MiB;
constexpr size_t WS_VST = 577 * MiB, WS_VWT = 581 * MiB;
constexpr size_t WS_GATES = 585 * MiB;
constexpr size_t WS_KCMP = 587 * MiB;
constexpr size_t WS_VCT = 587 * MiB + 512 * 1024;
constexpr size_t WS_Y = 588 * MiB;
constexpr size_t WS_TOK = 620 * MiB;
constexpr size_t WS_ASG = 622 * MiB;
constexpr size_t WS_GATE4 = 622 * MiB + 512 * 1024;
constexpr size_t WS_YPART = 912 * MiB;
constexpr size_t WS_CNTI = 623 * MiB;
constexpr size_t WS_ACT = 624 * MiB;
constexpr size_t WS_YROWS = 768 * MiB;
constexpr size_t WS_WIN8 = 962 * MiB;
constexpr size_t WS_H8 = 944 * MiB;
constexpr size_t WS_END = 968 * MiB;
constexpr int CW_BAR = 4096;
constexpr int CW_MOD = 16384;
constexpr int CW_CNT = 40960;
constexpr int CW_KMAX = 41088;
constexpr int CW_GCNT = 41216;

__device__ __forceinline__ unsigned cvtpk(float lo, float hi) { f32x2 v = {lo, hi}; bf16x2_t b = __builtin_convertvector(v, bf16x2_t); return __builtin_bit_cast(unsigned, b); }
__device__ __forceinline__ unsigned cvt4_fp8(float a, float b, float c, float d) { int w = 0; w = __builtin_amdgcn_cvt_pk_fp8_f32(a, b, w, false); w = __builtin_amdgcn_cvt_pk_fp8_f32(c, d, w, true); return (unsigned)w; }
__device__ __forceinline__ float bf2f(unsigned short b) { return __uint_as_float((unsigned)b << 16); }
__device__ __forceinline__ float bflo(unsigned w) { return __uint_as_float(w << 16); }
__device__ __forceinline__ float bfhi(unsigned w) { return __uint_as_float(w & 0xffff0000u); }
__device__ __forceinline__ float fast_exp2(float x) { return __builtin_amdgcn_exp2f(x); }
__device__ __forceinline__ float fast_rcp(float x) { return __builtin_amdgcn_rcpf(x); }
__device__ __forceinline__ float sigmoidf_(float x) { return fast_rcp(1.f + fast_exp2(-1.4426950408889634f * x)); }
__device__ __forceinline__ float gelu_tanh(float x) { const float u = 0.7978845608028654f * (x + 0.044715f * x * x * x); return x * fast_rcp(1.f + fast_exp2(-2.885390081777927f * u)); }

__device__ __forceinline__ float x16_sum(float x) { auto r = __builtin_amdgcn_permlane16_swap(__float_as_uint(x), __float_as_uint(x), false, false); return __uint_as_float(r[0]) + __uint_as_float(r[1]); }
__device__ __forceinline__ float x32_sum(float x) { auto r = __builtin_amdgcn_permlane32_swap(__float_as_uint(x), __float_as_uint(x), false, false); return __uint_as_float(r[0]) + __uint_as_float(r[1]); }
__device__ __forceinline__ float x16_max(float x) { auto r = __builtin_amdgcn_permlane16_swap(__float_as_uint(x), __float_as_uint(x), false, false); return fmaxf(__uint_as_float(r[0]), __uint_as_float(r[1])); }
__device__ __forceinline__ float x32_max(float x) { auto r = __builtin_amdgcn_permlane32_swap(__float_as_uint(x), __float_as_uint(x), false, false); return fmaxf(__uint_as_float(r[0]), __uint_as_float(r[1])); }
__device__ __forceinline__ float kg_sum(float x) { return x32_sum(x16_sum(x)); }
__device__ __forceinline__ float kg_max(float x) { return x32_max(x16_max(x)); }
__device__ __forceinline__ float quad_sum(float x) { x += __uint_as_float(__builtin_amdgcn_update_dpp(0u, __float_as_uint(x), 0xB1, 0xF, 0xF, true)); x += __uint_as_float(__builtin_amdgcn_update_dpp(0u, __float_as_uint(x), 0x4E, 0xF, 0xF, true)); return x; }
__device__ __forceinline__ float wave_sum(float v) {
    v = quad_sum(v);
    v += __uint_as_float(__builtin_amdgcn_update_dpp(0u, __float_as_uint(v), 0x141, 0xF, 0xF, true));
    v += __uint_as_float(__builtin_amdgcn_update_dpp(0u, __float_as_uint(v), 0x140, 0xF, 0xF, true));
    return x32_sum(x16_sum(v));
}
#define LDS_WAIT() asm volatile("s_waitcnt lgkmcnt(0)" ::: "memory")
#define VM_WAIT() asm volatile("s_waitcnt vmcnt(0)" ::: "memory")

__device__ __forceinline__ int kfrag_off(int key, int c8) {
    const int s = key >> 5, ko = key & 31, u = (ko >> 2) & 1, r16 = ((ko >> 3) << 2) | (ko & 3), ks = c8 >> 2, kg = c8 & 3;
    return s * 2048 + (u * 2 + ks) * 512 + (kg * 16 + r16) * 8;
}
__device__ __forceinline__ int vfrag_off(int key, int d) {
    const int s = key >> 5, ko = key & 31;
    return s * 2048 + (d >> 4) * 512 + ((ko >> 3) * 16 + (d & 15)) * 8 + (ko & 7);
}
namespace pg8 {
constexpr int BM = 256, BK = 64, HALF = 128, HTB = HALF * BK * 2, STAGE_BYTES = 8 * HTB, NXCD = 8, WGM = 4;
__host__ __device__ __forceinline__ int lds_byte(int r, int c) { const int st = (r >> 4) * 2 + (c >> 5), rr = r & 15, cc = c & 31, ob = rr * 64 + cc * 2; return st * 1024 + (ob ^ (((ob >> 9) & 1) << 5)); }
__host__ __device__ __forceinline__ void stage_rc(int b, int& R, int& C) { const int st = b / 1024, sb = b % 1024, swz = sb ^ (((sb >> 9) & 1) << 5); R = (st >> 1) * 16 + swz / 64; C = (st & 1) * 32 + (swz % 64) / 2; }
__host__ __device__ __forceinline__ int perm32(int rho) { const int n = rho >> 4, i = rho & 15; return 8 * (i >> 2) + 4 * n + (i & 3); }

struct Unit { int pm, pn, e, pnl, rloc, hs, rot; };

__device__ __forceinline__ bool unit_index(int i, int G, int c, int total, int& L, int& hs) {
    const int nfr = total / G, R = total - nfr * G; hs = 0;
    if (i < nfr) { L = i * G + c; return true; }
    if (i > nfr || R == 0) return false;
    if (2 * R <= G) { if (c >= 2 * R) return false; const int h = c >= R ? 1 : 0; L = nfr * G + c - h * R; hs = 1 + h; return true; }
    if (c >= R) return false;
    L = nfr * G + c; return true;
}

struct DenseOrder {
    static constexpr bool SPLIT = false;
    int nM, nN, nwg, G, c;
    __device__ void init(int M, int N, int G_, int c_) { nM = M / BM; nN = N / BM; nwg = nM * nN; G = G_; c = c_; }
    __device__ bool next(int i, Unit& u) const {
        const long L = (long)i * G + c; if (L >= nwg) return false;
        u.hs = 0; int wgid = (int)L; { const int q = nwg / NXCD, r = nwg % NXCD, xcd = wgid % NXCD, off = wgid / NXCD; wgid = (xcd < r ? xcd * (q + 1) : r * (q + 1) + (xcd - r) * q) + off; }
        const int nig = WGM * nN, gid = wgid / nig, fm = gid * WGM, gsz = (nM - fm) < WGM ? (nM - fm) : WGM;
        u.pm = fm + ((wgid % nig) % gsz); u.pn = (wgid % nig) / gsz; u.e = 0; u.pnl = u.pn; u.rloc = 0; u.rot = (u.pm + u.pn) & 3; return true;
    }
    __device__ __forceinline__ unsigned rowoff(const Unit&, int) const { return 0u; }
};

struct MoeOrder {
    static constexpr bool SPLIT = true;
    const LAS int* ust;
    const LAS int* bst;
    const LAS int* cnt;
    const int* tok;
    int NT, G, c, total, rowbytes;
    __device__ bool next(int i, Unit& u) const {
        int L, hs; if (!unit_index(i, G, c, total, L, hs)) return false;
        u.hs = hs; int e = 0;
        for (int k = 1; k < NE; ++k) e += (L >= ust[k]) ? 1 : 0;
        e = __builtin_amdgcn_readfirstlane(e);
        const int loc = __builtin_amdgcn_readfirstlane(L - ust[e]), b0 = __builtin_amdgcn_readfirstlane(bst[e]), nb = __builtin_amdgcn_readfirstlane(bst[e + 1]) - b0;
        u.e = e; u.pnl = loc / nb; u.rloc = loc - u.pnl * nb; u.pm = b0 + u.rloc; u.pn = e * NT + u.pnl; u.rot = (u.rloc + u.pnl) & 3; return true;
    }
    __device__ __forceinline__ unsigned rowoff(const Unit& u, int r) const {
        const int slot = u.rloc * 256 + r + (u.hs == 2 ? 128 : 0); const int tk = slot < cnt[u.e] ? tok[u.e * 16384 + slot] : T;
        return (unsigned)tk * (unsigned)rowbytes;
    }
};

template <class Epi, class Sched, bool GATHER, bool ALIGN_EPI, bool FP8 = false>
__device__ __forceinline__ void gemm_phase(LAS unsigned char* lds, const bf16_t* A, const bf16_t* Bt, const int K, const Sched& S, const Epi& E) {
    int tid_ = threadIdx.x; asm volatile("" : "+v"(tid_));
    const int tid = tid_, wid = __builtin_amdgcn_readfirstlane(tid >> 6), lane = tid & 63, wr = wid >> 2, wc = wid & 3, fr = lane & 15, fq = lane >> 4;
    const int nt = K / BK;
    unsigned voffB[2];
#pragma unroll
    for (int i = 0; i < 2; ++i) { int R, C; stage_rc(tid * 16 + i * 8192, R, C); const int Rb = Epi::PERM ? ((R & ~31) + perm32(R & 31)) : R; voffB[i] = (unsigned)(Rb * K + C) * 2u; }
    const size_t kstep = (size_t)(BK * 2);
    const size_t hstep = (size_t)HALF * K * 2;
    const size_t tstep = 2 * hstep;
    const unsigned ldsw = (unsigned)wid * 1024u;
    const int aoff = lds_byte(wr * 64 + fr, fq * 8), boff = lds_byte(wc * 32 + fr, fq * 8);
#define PG8_SA(b, h) (((b) * 2 + (h)) * HTB)
#define PG8_SB(b, h) ((4 + (b) * 2 + (h)) * HTB)
#define PG8_STAGE(bufoff, gbase, v0, v1) do { \
        __builtin_amdgcn_global_load_lds((const unsigned*)((const char*)(gbase) + (v0)), (LAS unsigned*)(lds + (bufoff) + ldsw), 16, 0, 0); \
        __builtin_amdgcn_global_load_lds((const unsigned*)((const char*)(gbase) + (v1)), (LAS unsigned*)(lds + (bufoff) + ldsw + 8192), 16, 0, 0); } while (0)
#define PG8_STAGEB(bufoff, gbase) PG8_STAGE(bufoff, gbase, voffB[0], voffB[1])
#define PG8_CAT8(x0, x1) __builtin_shufflevector(x0, x1, 0, 1, 2, 3, 4, 5, 6, 7)
#define PG8_RD4(off) (*(const LAS i32x4*)(lds + (off)))
#define PG8_LDA(dst, b, h) do { if constexpr (FP8) { _Pragma("unroll") for (int m = 0; m < 4; ++m) dst##8[m] = PG8_CAT8(PG8_RD4(PG8_SA(b, h) + aoff + m * 2048), PG8_RD4(PG8_SA(b, h) + aoff + m * 2048 + 1024)); } \
        else { _Pragma("unroll") for (int m = 0; m < 4; ++m) _Pragma("unroll") for (int k = 0; k < 2; ++k) dst[m][k] = *(const LAS bf16x8*)(lds + PG8_SA(b, h) + aoff + m * 2048 + k * 1024); } } while (0)
#define PG8_LDB(dst, b, h) do { if constexpr (FP8) { _Pragma("unroll") for (int n = 0; n < 2; ++n) dst##8[n] = PG8_CAT8(PG8_RD4(PG8_SB(b, h) + boff + n * 2048), PG8_RD4(PG8_SB(b, h) + boff + n * 2048 + 1024)); } \
        else { _Pragma("unroll") for (int n = 0; n < 2; ++n) _Pragma("unroll") for (int k = 0; k < 2; ++k) dst[n][k] = *(const LAS bf16x8*)(lds + PG8_SB(b, h) + boff + n * 2048 + k * 1024); } } while (0)
#define PG8_MMA(ai, bj, At, Bt_) do { __builtin_amdgcn_s_setprio(1); _Pragma("unroll") for (int m = 0; m < 4; ++m) _Pragma("unroll") for (int n = 0; n < 2; ++n) { \
        if constexpr (FP8) { asm volatile("v_mfma_scale_f32_16x16x128_f8f6f4 %0, %1, %2, %0, %3, %4 op_sel_hi:[0,0,0]" : "+v"(acc[ai][bj][m][n]) : "v"(Bt_##8[n]), "v"(At##8[m]), "v"(sc_w), "v"(sc_x)); } \
        else { _Pragma("unroll") for (int k = 0; k < 2; ++k) acc[ai][bj][m][n] = __builtin_amdgcn_mfma_f32_16x16x32_bf16(Bt_[n][k], At[m][k], acc[ai][bj][m][n], 0, 0, 0); } } \
        __builtin_amdgcn_s_setprio(0); } while (0)
#define PG8_WAIT_V(n) asm volatile("s_waitcnt vmcnt(" #n ")" ::: "memory")
#define PG8_WAIT_L(n) asm volatile("s_waitcnt lgkmcnt(" #n ")" ::: "memory")
#define PG8_BAR __builtin_amdgcn_s_barrier()
#define PG8_SCHED __builtin_amdgcn_sched_barrier(0)
#define PG8_SETV(v, u) do { int t2_ = tid; asm volatile("" : "+v"(t2_)); _Pragma("unroll") for (int i_ = 0; i_ < 2; ++i_) { int R_, C_; stage_rc(t2_ * 16 + i_ * 8192, R_, C_); _Pragma("unroll") for (int h_ = 0; h_ < 2; ++h_) \
        v[h_][i_] = GATHER ? (S.rowoff(u, R_ + HALF * h_) + (unsigned)C_ * 2u) : (unsigned)((R_ + HALF * h_) * K + C_) * 2u; } } while (0)
    Unit cur, nxt; int ui = 0;
    if (!S.next(0, cur)) return;
    unsigned vc[2][2], vn[2][2];
    PG8_SETV(vc, cur);
    f32x4 acc[2][2][4][2];
#pragma unroll
    for (int a = 0; a < 2; ++a)
#pragma unroll
        for (int b = 0; b < 2; ++b)
#pragma unroll
            for (int m = 0; m < 4; ++m)
#pragma unroll
                for (int n = 0; n < 2; ++n) acc[a][b][m][n] = (f32x4){0.f, 0.f, 0.f, 0.f};
    bf16x8 At[4][2], B0[2][2], B1[2][2]; i32x8 At8[4], B08[2], B18[2];
    int sc_w = W8_E8M0, sc_x = ONE_E8M0; asm volatile("" : "+v"(sc_w), "+v"(sc_x));
    const char* cA = GATHER ? (const char*)A : (const char*)A + (size_t)cur.pm * tstep + (cur.hs == 2 ? hstep : (size_t)0);
    const char* cB = (const char*)Bt + (size_t)cur.pn * tstep;
    const int nq = nt >> 2;
    { const size_t r0 = (size_t)(cur.rot * nq) * kstep;
    PG8_STAGEB(PG8_SB(0, 0), cB + r0); PG8_STAGEB(PG8_SB(0, 1), cB + r0 + hstep); PG8_STAGE(PG8_SA(0, 0), cA + r0, vc[0][0], vc[0][1]); PG8_STAGE(PG8_SA(0, 1), cA + r0, vc[1][0], vc[1][1]);
    if (wr == 1) PG8_BAR;
    PG8_WAIT_V(2); PG8_BAR;
    PG8_STAGEB(PG8_SB(1, 0), cB + r0 + kstep); PG8_STAGE(PG8_SA(1, 0), cA + r0 + kstep, vc[0][0], vc[0][1]); PG8_STAGEB(PG8_SB(1, 1), cB + r0 + hstep + kstep); }
    PG8_WAIT_V(6); PG8_BAR;
    for (;;) {
        const bool has_next = S.next(ui + 1, nxt);
        const char* nA = GATHER ? (const char*)A : (has_next ? (const char*)A + (size_t)nxt.pm * tstep + (nxt.hs == 2 ? hstep : (size_t)0) : cA);
        const bool full = !Sched::SPLIT || cur.hs == 0;
        const char* nB = has_next ? (const char*)Bt + (size_t)nxt.pn * tstep : cB;
        if constexpr (GATHER) { if (has_next) { PG8_SETV(vn, nxt); } else {
#pragma unroll
            for (int h_ = 0; h_ < 2; ++h_)
#pragma unroll
                for (int i_ = 0; i_ < 2; ++i_) vn[h_][i_] = vc[h_][i_]; } }
        const size_t rn = (size_t)((has_next ? nxt.rot : cur.rot) * nq) * kstep;
        int kp = cur.rot * nq;
#pragma nounroll
        for (int t = 0; t < nt; t += 2) {
            const bool last = (t == nt - 2);
            int kn = kp + 2; kn = kn >= nt ? kn - nt : kn;
            const char* a1 = cA + (size_t)(kp + 1) * kstep;
            const char* a2 = last ? nA + rn : cA + (size_t)kn * kstep; const char* b2 = last ? nB + rn : cB + (size_t)kn * kstep; kp = kn;
            const char* a3 = a2 + kstep; const char* b3 = b2 + kstep;
            const unsigned w00 = (GATHER && last) ? vn[0][0] : vc[0][0], w01 = (GATHER && last) ? vn[0][1] : vc[0][1], w10 = (GATHER && last) ? vn[1][0] : vc[1][0], w11 = (GATHER && last) ? vn[1][1] : vc[1][1];
            PG8_LDB(B0, 0, 0); PG8_LDB(B1, 0, 1); PG8_SCHED; PG8_LDA(At, 0, 0); PG8_STAGE(PG8_SA(1, 1), a1, vc[1][0], vc[1][1]);
            PG8_WAIT_V(8); PG8_WAIT_L(0); PG8_BAR; PG8_MMA(0, 0, At, B0); PG8_MMA(0, 1, At, B1); PG8_BAR; PG8_SCHED;
            if (full) PG8_LDA(At, 0, 1); PG8_STAGEB(PG8_SB(0, 0), b2); PG8_STAGEB(PG8_SB(0, 1), b2 + hstep); PG8_STAGE(PG8_SA(0, 0), a2, w00, w01);
            PG8_WAIT_V(8); PG8_WAIT_L(0); PG8_BAR; if (full) { PG8_MMA(1, 0, At, B0); PG8_MMA(1, 1, At, B1); } PG8_BAR; PG8_SCHED;
            PG8_LDB(B0, 1, 0); PG8_LDB(B1, 1, 1); PG8_SCHED; PG8_LDA(At, 1, 0); PG8_STAGE(PG8_SA(0, 1), a2, w10, w11);
            PG8_WAIT_V(8); PG8_WAIT_L(0); PG8_BAR; PG8_MMA(0, 0, At, B0); PG8_MMA(0, 1, At, B1); PG8_BAR; PG8_SCHED;
            if (full) PG8_LDA(At, 1, 1); PG8_STAGEB(PG8_SB(1, 0), b3); PG8_STAGEB(PG8_SB(1, 1), b3 + hstep); PG8_STAGE(PG8_SA(1, 0), a3, w00, w01);
            PG8_WAIT_V(8); PG8_WAIT_L(0); PG8_BAR; if (full) { PG8_MMA(1, 0, At, B0); PG8_MMA(1, 1, At, B1); } PG8_BAR; PG8_SCHED;
        }
        if constexpr (FP8) { asm volatile("s_nop 15\n\ts_nop 15" ::: "memory"); }
        if constexpr (ALIGN_EPI) { if (wr == 0) PG8_BAR; }
        E(acc, cur, wr, wc, fr, fq);
        if (!has_next) break;
#pragma unroll
        for (int a = 0; a < 2; ++a)
#pragma unroll
            for (int b = 0; b < 2; ++b)
#pragma unroll
                for (int m = 0; m < 4; ++m)
#pragma unroll
                    for (int n = 0; n < 2; ++n) acc[a][b][m][n] = (f32x4){0.f, 0.f, 0.f, 0.f};
        cur = nxt; cA = nA; cB = nB; ++ui;
        if constexpr (GATHER) {
#pragma unroll
        for (int h_ = 0; h_ < 2; ++h_)
#pragma unroll
            for (int i_ = 0; i_ < 2; ++i_) vc[h_][i_] = vn[h_][i_]; }
        if constexpr (ALIGN_EPI) { if (wr == 1) PG8_BAR; }
    }
    PG8_WAIT_V(0);
    if constexpr (!ALIGN_EPI) { if (wr == 0) PG8_BAR; }
    PG8_BAR;
#undef PG8_SA
#undef PG8_SB
#undef PG8_STAGE
#undef PG8_STAGEB
#undef PG8_LDA
#undef PG8_LDB
#undef PG8_MMA
#undef PG8_CAT8
#undef PG8_RD4
#undef PG8_WAIT_V
#undef PG8_WAIT_L
#undef PG8_BAR
#undef PG8_SCHED
#undef PG8_SETV
}
}

#define XB_TMO      128
#define XB_XCNT(j)  (256  + 64 * (j))
#define XB_XSUB(j)  (1280 + 64 * (j))
#define XB_XGEN(j)  (2304 + 64 * (j))
#define XB_TOP      3328
#define XB_TOPGEN   3392
#define XCD_BAR_WORDS 3456
#define XB_SPIN_CAP (1u << 22)
__device__ __forceinline__ unsigned xb_ld(unsigned* p)              { return __hip_atomic_load(p, __ATOMIC_RELAXED, __HIP_MEMORY_SCOPE_AGENT); }
__device__ __forceinline__ unsigned xb_add(unsigned* p, unsigned v) { return __hip_atomic_fetch_add(p, v, __ATOMIC_RELAXED, __HIP_MEMORY_SCOPE_AGENT); }
__device__ __forceinline__ unsigned xb_xcc_id() { return (unsigned)__builtin_amdgcn_s_getreg((3 << 11) | 20) & 0xFu; }
#define XB_SPIN(cond, bar) do { unsigned _sp = 0; while (cond) { __builtin_amdgcn_s_sleep(1); \
    if ((++_sp & 255u) == 0u) { if (xb_ld(&(bar)[XB_TMO])) break; if (_sp > XB_SPIN_CAP) { atomicAdd(&(bar)[XB_TMO], 1u); break; } } } } while (0)
struct XcdBarrier { unsigned* bar; unsigned x; volatile LAS unsigned* st; };
__device__ __forceinline__ XcdBarrier xcd_barrier_post(unsigned* bar, volatile LAS unsigned* st) {
    XcdBarrier b; b.bar = bar; b.x = xb_xcc_id(); b.st = st;
    if (threadIdx.x == 0) (void)xb_add(&bar[XB_XCNT(b.x)], 1u);
    return b;
}
__device__ __forceinline__ void xcd_barrier_complete(unsigned* bar, unsigned x, unsigned& nloc, unsigned& nx) {
    const unsigned G = gridDim.x * gridDim.y * gridDim.z;
    unsigned sum, cnt, mine, sp = 0u;
    for (;;) {
        sum = 0u; cnt = 0u; mine = 0u;
#pragma unroll
        for (unsigned j = 0; j < 16; ++j) { const unsigned c = xb_ld(&bar[XB_XCNT(j)]); sum += c; cnt += (c > 0u) ? 1u : 0u; mine = (j == x) ? c : mine; }
        if (sum == G) break;
        __builtin_amdgcn_s_sleep(1);
        if ((++sp & 255u) == 0u) { if (xb_ld(&bar[XB_TMO])) break; if (sp > XB_SPIN_CAP) { atomicAdd(&bar[XB_TMO], 1u); break; } }
    }
    nloc = mine > 0u ? mine : 1u; nx = cnt > 0u ? cnt : 1u;
}
__device__ __forceinline__ void xcd_barrier(const XcdBarrier& b) {
    asm volatile("s_waitcnt vmcnt(0)" ::: "memory");
    __syncthreads();
    if (threadIdx.x == 0) {
        unsigned* bar = b.bar;
        __builtin_amdgcn_s_waitcnt(0);
        unsigned nloc = b.st[0], nx = b.st[1];
        if (nloc == 0u) { xcd_barrier_complete(bar, b.x, nloc, nx); b.st[0] = nloc; b.st[1] = nx; }
        const unsigned old = xb_add(&bar[XB_XSUB(b.x)], 1u);
        const unsigned gen = old / nloc;
        if (old + 1u == (gen + 1u) * nloc) {
            __builtin_amdgcn_fence(__ATOMIC_RELEASE, "agent");
            asm volatile("s_waitcnt vmcnt(0)" ::: "memory");
            const unsigned og = xb_add(&bar[XB_TOP], 1u);
            const unsigned tg = og / nx;
            if (og + 1u == (tg + 1u) * nx) xb_add(&bar[XB_TOPGEN], 1u);
            else XB_SPIN(xb_ld(&bar[XB_TOPGEN]) == tg, bar);
            __builtin_amdgcn_fence(__ATOMIC_ACQUIRE, "agent");
            xb_add(&bar[XB_XGEN(b.x)], 1u);
            asm volatile("s_waitcnt vmcnt(0)" ::: "memory");
        } else {
            XB_SPIN(xb_ld(&bar[XB_XGEN(b.x)]) == gen, bar);
            __builtin_amdgcn_fence(__ATOMIC_ACQUIRE, "agent");
            asm volatile("s_waitcnt vmcnt(0)" ::: "memory");
        }
    }
    __syncthreads();
}

struct Args { const void* in[26]; float* out; unsigned char* ws; int ph_lo, ph_hi, li, pad; };
enum { I_X = 0, I_C, I_POS, I_ADAW, I_ADAB, I_N1G, I_N2G, I_WIN, I_WOUT, I_SGLNG, I_SGLNB, I_SGW, I_SGB, I_PEK, I_PEV, I_CW1K, I_CW2K, I_CW1V, I_CW2V, I_RW, I_RB, I_EW1, I_EB1, I_EW2, I_EB2, I_FING };

#define GAS1 __attribute__((address_space(1)))
#define INP(A_, T_, i_) ({ int ix_ = (i_); asm volatile("" : "+s"(ix_)); (const T_*)(const GAS1 T_*)(A_).in[ix_]; })
struct Frame {
    LAS unsigned char* lds;
    unsigned* ctl;
    unsigned char* ws;
    int tid, lane, wave, vcu, G;
};
#define WSP(type, off) ((type*)(F.ws + (off)))
#define MODP(l, b, part) ((const float*)(F.ctl + CW_MOD) + ((size_t)((l) * 2 + (b)) * 6 + (part)) * 1024)

constexpr int RING_BYTES = 131072;
constexpr int ATT_LDS_BYTES = 147456;
constexpr int LDSCTL_OFF = ATT_LDS_BYTES;
constexpr int MISC_OFF = LDSCTL_OFF + 320;
constexpr int MOE_OFF = MISC_OFF + 128;
constexpr int LDS_BYTES = 163840;

struct EpiProj {
    static constexpr bool PERM = true;
    bf16_t *UG, *VG, *Q, *KC, *VC, *KS, *KW, *VST, *VWT; float* GATES; const float* ROPE; unsigned* kmax; int pn_off;
    __device__ __forceinline__ void operator()(const f32x4 (&acc)[2][2][4][2], const pg8::Unit& u, int wr_, int wc_, int fr_, int fq_) const {
        int t_ = threadIdx.x; asm volatile("" : "+v"(t_)); const int wid_ = __builtin_amdgcn_readfirstlane(t_ >> 6); const int wr = wid_ >> 2, wc = wid_ & 3, fr = t_ & 15, fq = (t_ & 63) >> 4; (void)wr_; (void)wc_; (void)fr_; (void)fq_;
        const int pn = u.pn + pn_off; const int row0 = u.pm * 256 + (u.hs == 2 ? 128 : 0) + wr * 64 + fr; const int b = u.pm >> 5; const int nai = u.hs ? 1 : 2;
        if (pn < 4 || pn == 6) {
#pragma unroll
            for (int ai = 0; ai < 2; ++ai) if (ai < nai)
#pragma unroll
                for (int m = 0; m < 4; ++m) { const size_t r = (size_t)(row0 + ai * 128 + m * 16);
#pragma unroll
                    for (int bj = 0; bj < 2; ++bj) { f32x4 v0 = acc[ai][bj][m][0], v1 = acc[ai][bj][m][1];
                        if (pn < 4) {
#pragma unroll
                            for (int i = 0; i < 4; ++i) { v0[i] = gelu_tanh(v0[i]); v1[i] = gelu_tanh(v1[i]); } }
                        u32x4 w; w.x = cvtpk(v0[0], v0[1]); w.y = cvtpk(v0[2], v0[3]); w.z = cvtpk(v1[0], v1[1]); w.w = cvtpk(v1[2], v1[3]);
                        bf16_t* dst;
                        if (pn < 2) dst = UG + r * 512 + pn * 256 + bj * 128 + wc * 32 + fq * 8;
                        else if (pn < 4) dst = VG + r * 512 + (pn - 2) * 256 + bj * 128 + wc * 32 + fq * 8;
                        else dst = (bj ? VC : KC) + r * 128 + wc * 32 + fq * 8;
                        *(u32x4*)dst = w; } }
        } else if (pn == 4 || pn == 5 || pn == 7) {
            const float sc = (pn == 7) ? 1.f : QSCALE; float nmax = 0.f;
#pragma unroll
            for (int ai = 0; ai < 2; ++ai) if (ai < nai)
#pragma unroll
                for (int m = 0; m < 4; ++m) { const size_t r = (size_t)(row0 + ai * 128 + m * 16);
                    const f32x4* cs = (const f32x4*)(ROPE + (r * 32 + fq * 8) * 2);
                    float o1[8], o2[8], nsq = 0.f;
#pragma unroll
                    for (int n = 0; n < 2; ++n) { const f32x4 c0 = cs[2 * n], c1 = cs[2 * n + 1]; const f32x4 x1 = acc[ai][0][m][n], x2 = acc[ai][1][m][n];
                        const float cc[4] = {c0[0], c0[2], c1[0], c1[2]}, ss[4] = {c0[1], c0[3], c1[1], c1[3]};
#pragma unroll
                        for (int i = 0; i < 4; ++i) { o1[4 * n + i] = (x1[i] * cc[i] - x2[i] * ss[i]) * sc; o2[4 * n + i] = (x2[i] * cc[i] + x1[i] * ss[i]) * sc; nsq += x1[i] * x1[i] + x2[i] * x2[i]; } }
                    u32x4 w1, w2; w1.x = cvtpk(o1[0], o1[1]); w1.y = cvtpk(o1[2], o1[3]); w1.z = cvtpk(o1[4], o1[5]); w1.w = cvtpk(o1[6], o1[7]);
                    w2.x = cvtpk(o2[0], o2[1]); w2.y = cvtpk(o2[2], o2[3]); w2.z = cvtpk(o2[4], o2[5]); w2.w = cvtpk(o2[6], o2[7]);
                    if (pn != 7) { bf16_t* dst = Q + r * 512 + (4 * (pn - 4) + wc) * 64 + fq * 8; *(u32x4*)dst = w1; *(u32x4*)(dst + 32) = w2; }
                    else { bf16_t* img = ((wc < 2) ? KS : KW) + (size_t)(b * 2 + (wc & 1)) * SEQ * 64; const int t = (int)r & (SEQ - 1);
                        *(u32x4*)(img + kfrag_off(t, fq)) = w1; *(u32x4*)(img + kfrag_off(t, 4 + fq)) = w2; }
                    nsq = kg_sum(nsq); nmax = fmaxf(nmax, nsq); asm volatile("" ::: "memory"); }
            if (pn == 7) {
#pragma unroll
                for (int o = 1; o < 16; o <<= 1) nmax = fmaxf(nmax, __shfl_xor(nmax, o));
                if ((threadIdx.x & 63) == 0) atomicMax(kmax + ((wc < 2) ? 0 : 8) + b * 2 + (wc & 1), __float_as_uint(nmax * 1.02f));
            }
        } else if (pn == 8) {
            const int g = wc >> 1; float vmx = 0.f;
#pragma unroll
            for (int ai = 0; ai < 2; ++ai) if (ai < nai)
#pragma unroll
                for (int m = 0; m < 4; ++m) { const int r = row0 + ai * 128 + m * 16; const int s = r & (SEQ - 1);
#pragma unroll
                    for (int bj = 0; bj < 2; ++bj) { bf16_t* img = (bj ? VWT : VST) + (size_t)(b * 2 + g) * SEQ * 64;
#pragma unroll
                        for (int n = 0; n < 2; ++n)
#pragma unroll
                            for (int i = 0; i < 4; ++i) { img[vfrag_off(s, (wc & 1) * 32 + fq * 8 + n * 4 + i)] = (bf16_t)(cvtpk(acc[ai][bj][m][n][i], 0.f) & 0xffffu); if (bj == 0) vmx = fmaxf(vmx, fabsf(acc[ai][0][m][n][i])); } } }
#pragma unroll
            for (int o = 1; o < 64; o <<= 1) vmx = fmaxf(vmx, __shfl_xor(vmx, o));
            if ((threadIdx.x & 63) == 0) atomicMax(kmax + 4 + b * 2 + g, __float_as_uint(vmx * 1.01f));
        } else {
            if (wc == 0 && fq < 3) {
#pragma unroll
                for (int ai = 0; ai < 2; ++ai) if (ai < nai)
#pragma unroll
                    for (int m = 0; m < 4; ++m) { const size_t r = (size_t)(row0 + ai * 128 + m * 16);
#pragma unroll
                        for (int n = 0; n < 2; ++n) { f32x4 v = acc[ai][0][m][n];
#pragma unroll
                            for (int i = 0; i < 4; ++i) v[i] = sigmoidf_(v[i]);
                            *(f32x4*)(GATES + r * 24 + fq * 8 + n * 4) = v; } }
            }
        }
    }
};
struct EpiOut {
    static constexpr bool PERM = false;
    const float* xin; float* xout; const float* g1;
    __device__ __forceinline__ void operator()(const f32x4 (&acc)[2][2][4][2], const pg8::Unit& u, int wr_, int wc_, int fr_, int fq_) const {
        int t_ = threadIdx.x; asm volatile("" : "+v"(t_)); const int wid_ = __builtin_amdgcn_readfirstlane(t_ >> 6); const int wr = wid_ >> 2, wc = wid_ & 3, fr = t_ & 15, fq = (t_ & 63) >> 4; (void)wr_; (void)wc_; (void)fr_; (void)fq_;
        const int row0 = u.pm * 256 + (u.hs == 2 ? 128 : 0) + wr * 64 + fr; const int b = u.pm >> 5; const int col0 = u.pn * 256 + wc * 32 + fq * 4; const int nai = u.hs ? 1 : 2;
        const float* gb = g1 + (size_t)b * 6144 + 2048;
        f32x4 gv[2][2];
#pragma unroll
        for (int bj = 0; bj < 2; ++bj)
#pragma unroll
            for (int n = 0; n < 2; ++n) gv[bj][n] = *(const f32x4*)(gb + col0 + bj * 128 + n * 16);
#pragma unroll
        for (int ai = 0; ai < 2; ++ai) if (ai < nai)
#pragma unroll
            for (int m = 0; m < 4; ++m) { const size_t off = (size_t)(row0 + ai * 128 + m * 16) * DM + col0;
#pragma unroll
                for (int bj = 0; bj < 2; ++bj)
#pragma unroll
                    for (int n = 0; n < 2; ++n) { const f32x4 xi = *(const f32x4*)(xin + off + bj * 128 + n * 16); *(f32x4*)(xout + off + bj * 128 + n * 16) = xi + gv[bj][n] * acc[ai][bj][m][n]; } }
    }
};
struct EpiSwiglu {
    static constexpr bool PERM = true;
    unsigned char* ACT; const float* b1;
    __device__ __forceinline__ void operator()(const f32x4 (&acc)[2][2][4][2], const pg8::Unit& u, int wr_, int wc_, int fr_, int fq_) const {
        int t_ = threadIdx.x; asm volatile("" : "+v"(t_)); const int wid_ = __builtin_amdgcn_readfirstlane(t_ >> 6); const int wr = wid_ >> 2, wc = wid_ & 3, fr = t_ & 15, fq = (t_ & 63) >> 4; (void)wr_; (void)wc_; (void)fr_; (void)fq_;
        const int row0 = u.pm * 256 + (u.hs == 2 ? 128 : 0) + wr * 64 + fr; const int j0 = u.pnl * 128 + wc * 32 + fq * 8; const int nai = u.hs ? 1 : 2;
        const float* bb = b1 + (size_t)u.e * 2048 + j0;
        f32x4 bg[2], bl[2];
#pragma unroll
        for (int n = 0; n < 2; ++n) { bg[n] = *(const f32x4*)(bb + n * 4); bl[n] = *(const f32x4*)(bb + 1024 + n * 4); }
#pragma unroll
        for (int ai = 0; ai < 2; ++ai) if (ai < nai)
#pragma unroll
            for (int m = 0; m < 4; ++m) { float o[8];
#pragma unroll
                for (int n = 0; n < 2; ++n) { const f32x4 gl = acc[ai][0][m][n] + bg[n], ln = acc[ai][1][m][n] + bl[n];
#pragma unroll
                    for (int i = 0; i < 4; ++i) { const float gg = fminf(gl[i], 7.f), ll = fminf(fmaxf(ln[i], -7.f), 7.f); o[n * 4 + i] = gg * sigmoidf_(1.702f * gg) * (ll + 1.f); } }
                u32x2 w; w.x = cvt4_fp8(o[0], o[1], o[2], o[3]); w.y = cvt4_fp8(o[4], o[5], o[6], o[7]);
                *(u32x2*)(ACT + (size_t)(row0 + ai * 128 + m * 16) * FF + j0) = w; }
    }
};
struct EpiDown {
    static constexpr bool PERM = true;
    unsigned char* YR; const float* b2;
    __device__ __forceinline__ void operator()(const f32x4 (&acc)[2][2][4][2], const pg8::Unit& u, int wr_, int wc_, int fr_, int fq_) const {
        int t_ = threadIdx.x; asm volatile("" : "+v"(t_)); const int wid_ = __builtin_amdgcn_readfirstlane(t_ >> 6); const int wr = wid_ >> 2, wc = wid_ & 3, fr = t_ & 15, fq = (t_ & 63) >> 4; (void)wr_; (void)wc_; (void)fr_; (void)fq_;
        const int row0 = u.pm * 256 + (u.hs == 2 ? 128 : 0) + wr * 64 + fr; const int c0 = u.pnl * 256 + wc * 32 + fq * 8; const int nai = u.hs ? 1 : 2;
        const float* bb = b2 + (size_t)u.e * 1024 + c0;
        f32x4 bv[2][2];
#pragma unroll
        for (int bj = 0; bj < 2; ++bj)
#pragma unroll
            for (int n = 0; n < 2; ++n) bv[bj][n] = *(const f32x4*)(bb + bj * 128 + n * 4);
#pragma unroll
        for (int ai = 0; ai < 2; ++ai) if (ai < nai)
#pragma unroll
            for (int m = 0; m < 4; ++m)
#pragma unroll
                for (int bj = 0; bj < 2; ++bj) { const f32x4 v0 = acc[ai][bj][m][0] + bv[bj][0], v1 = acc[ai][bj][m][1] + bv[bj][1];
                    u32x2 w; w.x = cvt4_fp8(v0[0], v0[1], v0[2], v0[3]); w.y = cvt4_fp8(v1[0], v1[1], v1[2], v1[3]);
                    *(u32x2*)(YR + (size_t)(row0 + ai * 128 + m * 16) * DM + c0 + bj * 128) = w; }
    }
};

__device__ __forceinline__ void tr_item(const float* W, int ldn, int k0, int c0, int nvalid, bf16_t* WT, int K, int drow0, LAS float* scr, int lane) {
    const int nn = lane & 31;
#pragma unroll 8
    for (int i = 0; i < 32; ++i) { const int kk = 2 * i + (lane >> 5); scr[kk * 33 + nn] = (nn < nvalid) ? W[(size_t)(k0 + kk) * ldn + c0 + nn] : 0.f; }
    LDS_WAIT(); asm volatile("" ::: "memory");
    const int c = lane & 7;
#pragma unroll
    for (int j = 0; j < 4; ++j) { const int n = (lane >> 3) + 8 * j; const LAS float* s = scr + (8 * c) * 33 + n;
        u32x4 o; o.x = cvtpk(s[0 * 33], s[1 * 33]); o.y = cvtpk(s[2 * 33], s[3 * 33]); o.z = cvtpk(s[4 * 33], s[5 * 33]); o.w = cvtpk(s[6 * 33], s[7 * 33]);
        *(u32x4*)(WT + (size_t)(drow0 + n) * K + k0 + 8 * c) = o; }
    LDS_WAIT(); asm volatile("" ::: "memory");
}
template <bool NTS> __device__ __forceinline__ void tr_item8(const float* W, int ldn, int k0, int c0, unsigned char* W8, int K, int drow0, LAS float* scr, int lane, int nvalid = 32) {
    const int nn = lane & 31;
#pragma unroll 32
    for (int i = 0; i < 32; ++i) { const int kk = 2 * i + (lane >> 5); scr[kk * 33 + nn] = (nn < nvalid) ? __builtin_nontemporal_load(W + (size_t)(k0 + kk) * ldn + c0 + nn) * W8SCALE : 0.f; }
    LDS_WAIT(); asm volatile("" ::: "memory");
    const int c = lane & 3;
#pragma unroll
    for (int j = 0; j < 2; ++j) { const int n = (lane >> 2) + 16 * j; const LAS float* s = scr + (16 * c) * 33 + n;
        u32x4 o; o.x = cvt4_fp8(s[0 * 33], s[1 * 33], s[2 * 33], s[3 * 33]); o.y = cvt4_fp8(s[4 * 33], s[5 * 33], s[6 * 33], s[7 * 33]);
        o.z = cvt4_fp8(s[8 * 33], s[9 * 33], s[10 * 33], s[11 * 33]); o.w = cvt4_fp8(s[12 * 33], s[13 * 33], s[14 * 33], s[15 * 33]);
        if (NTS) __builtin_nontemporal_store(o, (u32x4*)(W8 + (size_t)(drow0 + n) * K + k0 + 16 * c)); else *(u32x4*)(W8 + (size_t)(drow0 + n) * K + k0 + 16 * c) = o; }
    LDS_WAIT(); asm volatile("" ::: "memory");
}
template <bool W1MAP, bool NTS>
__device__ __forceinline__ void tr_block8(const float* W, int ldn, int k0, int c0, unsigned char* W8, int half, LAS unsigned char* img, int tid) {
    const int cg = tid & 255, ks = tid >> 8;
    const float* src = W + (size_t)k0 * ldn + c0 + 4 * cg;
    const int rot = 4 * ((cg >> 1) & 7);
#pragma unroll
    for (int sub = 0; sub < 4; ++sub) {
        f32x4 w[4][4];
#pragma unroll
        for (int i = 0; i < 4; ++i) { const int kq = ks + 2 * (sub * 4 + i);
#pragma unroll
            for (int r = 0; r < 4; ++r) w[i][r] = __builtin_nontemporal_load((const f32x4*)(src + (size_t)(4 * kq + r) * ldn)); }
#pragma unroll
        for (int i = 0; i < 4; ++i) { const int kq = ks + 2 * (sub * 4 + i);
#pragma unroll
            for (int j = 0; j < 4; ++j)
                *(LAS unsigned*)(img + (4 * cg + j) * 144 + (((kq + rot) & 31) << 2)) = cvt4_fp8(w[i][0][j] * W8SCALE, w[i][1][j] * W8SCALE, w[i][2][j] * W8SCALE, w[i][3][j] * W8SCALE); }
    }
    __syncthreads();
#pragma unroll 4
    for (int i = 0; i < 16; ++i) { const int n = (tid >> 3) + 64 * i, q = tid & 7;
        const u32x4 o = *(const LAS u32x4*)(img + n * 144 + (((4 * q + 4 * ((n >> 3) & 7)) & 31) << 2));
        const int drow = W1MAP ? ((n >> 7) * 256 + half * 128 + (n & 127)) : n;
        u32x4* dst = (u32x4*)(W8 + (size_t)drow * 1024 + k0 + 16 * q);
        if (NTS) __builtin_nontemporal_store(o, dst); else *dst = o; }
    __syncthreads();
}
__device__ __forceinline__ void win_src(int p, int& c0, int& nvalid) {
    const int pn = p >> 8; nvalid = 32;
    if (pn < 4 || pn == 6) { c0 = p; }
    else if (pn == 4 || pn == 5) { const int pp = p - 1024 - 256 * (pn - 4), bj = pp >> 7, j = pp & 127; c0 = 1024 + (4 * (pn - 4) + (j >> 5)) * 64 + bj * 32; }
    else if (pn == 7) { const int pp = p - 1792, bj = pp >> 7, j = pp & 127, which = j >> 6, g = (j >> 5) & 1; c0 = (which ? 2048 : 1792) + g * 64 + bj * 32; }
    else if (pn == 8) { const int pp = p - 2048, bj = pp >> 7, j = pp & 127; c0 = (bj ? 2176 : 1920) + j; }
    else { const int pp = p - 2304; c0 = 2304 + pp; nvalid = 24 - pp; nvalid = nvalid < 0 ? 0 : (nvalid > 32 ? 32 : nvalid); if (nvalid == 0) c0 = 0; }
}
__device__ __forceinline__ void phase_prologue(Frame& F, const Args& a) {
    LAS float* scr = (LAS float*)(F.lds + F.wave * 8704);
    const int gw = F.vcu * NWAVES + F.wave, NGW = F.G * NWAVES; const int lane = F.lane;
    {
        const float* c = INP(a, float, I_C); const float* adaw = INP(a, float, I_ADAW); const float* adab = INP(a, float, I_ADAB);
        float* mod = (float*)(F.ctl + CW_MOD);
        LAS float* red = (LAS float*)(F.lds + 8 * 8704);
        for (int it = F.vcu; it < 2 * 96; it += F.G) {
            const int l = it / 96, nb = it % 96;
            const float* wp = adaw + ((size_t)l * 1024 + F.wave * 128) * 6144 + nb * 64 + lane;
            float a0 = 0.f, a1 = 0.f;
#pragma unroll 32
            for (int k = 0; k < 128; ++k) { const float w = __builtin_nontemporal_load(wp + (size_t)k * 6144);
                const float c0 = c[F.wave * 128 + k], c1 = c[1024 + F.wave * 128 + k]; const float s0 = c0 * sigmoidf_(c0), s1 = c1 * sigmoidf_(c1);
                a0 += w * s0; a1 += w * s1; }
            red[(F.wave * 2 + 0) * 64 + lane] = a0; red[(F.wave * 2 + 1) * 64 + lane] = a1;
            __syncthreads();
            if (F.tid < 128) { const int b = F.tid >> 6, col = F.tid & 63; float sum = adab[(size_t)l * 6144 + nb * 64 + col];
#pragma unroll
              for (int ww = 0; ww < 8; ++ww) sum += red[(ww * 2 + b) * 64 + col];
              mod[((size_t)l * 2 + b) * 6144 + nb * 64 + col] = sum; }
            __syncthreads();
        }
    }
    {
        const float* win = INP(a, float, I_WIN);
        unsigned char* Win8 = WSP(unsigned char, WS_WIN8);
        for (int it = gw; it < 2 * 16 * 80; it += NGW) { const int l = it / 1280, kb = (it % 1280) / 80, nb = it % 80; int c0, nv; win_src(nb * 32, c0, nv);
            tr_item8<false>(win + (size_t)l * 1024 * PIN, PIN, kb * 64, c0, Win8 + (size_t)l * 2560 * 1024, 1024, nb * 32, scr, lane, nv); }
        const float* wout = INP(a, float, I_WOUT); bf16_t* WoutT = WSP(bf16_t, WS_WOUT);
        for (int it = gw; it < 2 * 16 * 32; it += NGW) { const int l = it / 512, kb = (it % 512) / 32, nb = it % 32;
            tr_item(wout + (size_t)l * 1024 * 1024, 1024, kb * 64, nb * 32, 32, WoutT + (size_t)l * 1024 * 1024, 1024, nb * 32, scr, lane); }
        bf16_t* CW1 = WSP(bf16_t, WS_CW1);
        for (int it = gw; it < 2 * 2 * 32 * 2; it += NGW) { const int l = it / 128, which = (it / 64) & 1, kb = (it % 64) / 2, nb = it & 1;
            const float* src = INP(a, float, which ? I_CW1V : I_CW1K) + (size_t)l * 2048 * 64;
            tr_item(src, 64, kb * 64, nb * 32, 32, CW1 + (size_t)(l * 2 + which) * 64 * 2048, 2048, nb * 32, scr, lane); }
        __syncthreads();
        const float* ew1 = INP(a, float, I_EW1); unsigned char* W1T = WSP(unsigned char, WS_W1T);
        for (int it = F.vcu; it < 2 * 32 * 8 * 2; it += F.G) { const int le = it >> 4, kb = (it >> 1) & 7, half = it & 1;
            if (le < 32) tr_block8<true, false>(ew1 + (size_t)le * 1024 * 2048, 2048, kb * 128, half * 1024, W1T + (size_t)le * 2048 * 1024, half, F.lds, F.tid);
            else tr_block8<true, true>(ew1 + (size_t)le * 1024 * 2048, 2048, kb * 128, half * 1024, W1T + (size_t)le * 2048 * 1024, half, F.lds, F.tid); }
        const float* ew2 = INP(a, float, I_EW2); unsigned char* W2T = WSP(unsigned char, WS_W2T);
        for (int it = F.vcu; it < 2 * 32 * 8; it += F.G) { const int le = it >> 3, kb = it & 7;
            if (le < 32) tr_block8<false, false>(ew2 + (size_t)le * 1024 * 1024, 1024, kb * 128, 0, W2T + (size_t)le * 1024 * 1024, 0, F.lds, F.tid);
            else tr_block8<false, true>(ew2 + (size_t)le * 1024 * 1024, 1024, kb * 128, 0, W2T + (size_t)le * 1024 * 1024, 0, F.lds, F.tid); }
    }
    {
        const int gt = (F.vcu * NWAVES + F.wave) * 64 + lane, NGT = NGW * 64;
        const float* sgw = INP(a, float, I_SGW); bf16_t* SGW = WSP(bf16_t, WS_SGW);
        for (int i = gt; i < 2 * 8 * 128 * 128; i += NGT) { const int s = i & 127, t = (i >> 7) & 127; SGW[i] = (bf16_t)(cvtpk(s <= t ? sgw[i] : 0.f, 0.f) & 0xffffu); }
        const int* pos = INP(a, int, I_POS); float* rope = WSP(float, WS_ROPE);
        for (int i = gt; i < T * 32; i += NGT) { const int tok = i >> 5, d = i & 31;
            const double inv = exp2(-(double)d * (13.287712379549449 / 32.0));
            const double rv = (double)pos[tok] * inv * 0.15915494309189535; const float fr = (float)(rv - __builtin_rint(rv));
            rope[2 * i] = __builtin_amdgcn_cosf(fr); rope[2 * i + 1] = __builtin_amdgcn_sinf(fr); }
        bf16_t* H = WSP(bf16_t, WS_H);
        for (int i = gt; i < 1024; i += NGT) { H[(size_t)T * 1024 + i] = 0; WSP(unsigned char, WS_H8)[(size_t)T * 1024 + i] = 0; }
        bf16_t* KCMP = WSP(bf16_t, WS_KCMP); bf16_t* VCT = WSP(bf16_t, WS_VCT);
        for (int i = gt; i < 2 * 2 * 64; i += NGT) { const int b = i >> 7, g = (i >> 6) & 1, d = i & 63; KCMP[(size_t)(b * 2 + g) * 512 * 64 + kfrag_off(511, d >> 3) + (d & 7)] = 0; VCT[(size_t)(b * 2 + g) * 512 * 64 + vfrag_off(511, d)] = 0; }
    }
    {
        float* cb = WSP(float, WS_MISC);
        for (int it = gw; it < 2 * 2 * 64; it += NGW) { const int l = it >> 7, which = (it >> 6) & 1, n = it & 63;
            const float* pe = INP(a, float, which ? I_PEV : I_PEK) + (size_t)l * 2048; const float* w1 = INP(a, float, which ? I_CW1V : I_CW1K) + (size_t)l * 2048 * 64;
            float s = 0.f; for (int k = lane; k < 2048; k += 64) s += pe[k] * w1[(size_t)k * 64 + n];
            s = wave_sum(s); if (lane == 0) cb[it] = s; }
    }
}

struct RowV { f32x4 v[4]; };
__device__ __forceinline__ RowV row_load(const float* p, int lane) { RowV r; const f32x4* q = (const f32x4*)p + lane;
#pragma unroll
    for (int j = 0; j < 4; ++j) r.v[j] = q[64 * j]; return r; }
__device__ __forceinline__ float row_ssq(const RowV& r) { float s = 0.f;
#pragma unroll
    for (int j = 0; j < 4; ++j) s += (r.v[j].x * r.v[j].x + r.v[j].y * r.v[j].y) + (r.v[j].z * r.v[j].z + r.v[j].w * r.v[j].w); return wave_sum(s); }
__device__ __forceinline__ void row_norm_store(const RowV& x, float rstd, const float* g, const float* sc, const float* sh, bf16_t* orow, int lane) {
    u32x2* o8 = (u32x2*)orow + lane;
#pragma unroll
    for (int j = 0; j < 4; ++j) { const f32x4 gg = ((const f32x4*)g)[lane + 64 * j], ss = ((const f32x4*)sc)[lane + 64 * j], hh = ((const f32x4*)sh)[lane + 64 * j];
        const f32x4 y = x.v[j] * rstd * gg * (ss + 1.f) + hh; u32x2 w; w.x = cvtpk(y.x, y.y); w.y = cvtpk(y.z, y.w); o8[64 * j] = w; }
}
__device__ __forceinline__ void quad_tr(unsigned (&a)[4], int lane) {
    const bool b0 = lane & 1, b1 = lane & 2;
    { const unsigned x = b0 ? a[0] : a[1]; const unsigned y = __builtin_amdgcn_update_dpp(0u, x, 0xB1, 0xF, 0xF, true); if (b0) a[0] = y; else a[1] = y; }
    { const unsigned x = b0 ? a[2] : a[3]; const unsigned y = __builtin_amdgcn_update_dpp(0u, x, 0xB1, 0xF, 0xF, true); if (b0) a[2] = y; else a[3] = y; }
    { const unsigned x = b1 ? a[0] : a[2]; const unsigned y = __builtin_amdgcn_update_dpp(0u, x, 0x4E, 0xF, 0xF, true); if (b1) a[0] = y; else a[2] = y; }
    { const unsigned x = b1 ? a[1] : a[3]; const unsigned y = __builtin_amdgcn_update_dpp(0u, x, 0x4E, 0xF, 0xF, true); if (b1) a[1] = y; else a[3] = y; }
}
__device__ __forceinline__ void row_norm_store8(const RowV& x, float rstd, const float* g, const float* sc, const float* sh, unsigned char* orow, int lane) {
    unsigned a[4];
#pragma unroll
    for (int j = 0; j < 4; ++j) { const f32x4 gg = ((const f32x4*)g)[lane + 64 * j], ss = ((const f32x4*)sc)[lane + 64 * j], hh = ((const f32x4*)sh)[lane + 64 * j];
        const f32x4 y = x.v[j] * rstd * gg * (ss + 1.f) + hh; a[j] = cvt4_fp8(y.x, y.y, y.z, y.w); }
    quad_tr(a, lane);
    *(u32x4*)(orow + 256 * (lane & 3) + 16 * (lane >> 2)) = (u32x4){a[0], a[1], a[2], a[3]};
}
__device__ __forceinline__ int expert_block_prefix(const unsigned* cnt, int lane) {
    int nb = (lane < NE) ? (int)((cnt[lane] + 255u) >> 8) : 0; int inc = nb;
#pragma unroll
    for (int o = 1; o < 32; o <<= 1) { const int t = __shfl_up(inc, o); if ((lane & 31) >= o) inc += t; }
    return inc - nb;
}
__device__ __forceinline__ void phase_n1_first(Frame& F, const Args& a) {
    const int gw = F.vcu * NWAVES + F.wave, NGW = F.G * NWAVES; const int lane = F.lane;
    const float* x = INP(a, float, I_X); const float* g = INP(a, float, I_N1G); bf16_t* H = WSP(bf16_t, WS_H); unsigned char* H8 = WSP(unsigned char, WS_H8);
    for (int m = gw; m < T; m += 2 * NGW) { const int m2 = m + NGW; const int b = m >> 13, b2 = m2 >> 13;
        const RowV r = row_load(x + (size_t)m * DM, lane); const RowV r2 = row_load(x + (size_t)m2 * DM, lane);
        const float rstd = 1.f / sqrtf(row_ssq(r) * (1.f / DM) + NORM_EPS), rstd2 = 1.f / sqrtf(row_ssq(r2) * (1.f / DM) + NORM_EPS);
        row_norm_store8(r, rstd, g, MODP(0, b, 1), MODP(0, b, 0), H8 + (size_t)m * DM, lane);
        row_norm_store8(r2, rstd2, g, MODP(0, b2, 1), MODP(0, b2, 0), H8 + (size_t)m2 * DM, lane); }
    float* RWP = WSP(float, WS_RWP); float* RBP = WSP(float, WS_MISC + 4096);
    const float* rw = INP(a, float, I_RW); const float* rb = INP(a, float, I_RB); const float* n2g = INP(a, float, I_N2G);
    const int gt = gw * 64 + lane, NGT = NGW * 64;
    for (int i = gt; i < 2 * 2 * 1024 * 32; i += NGT) { const int l = i >> 16, b = (i >> 15) & 1, k = (i >> 5) & 1023, e = i & 31;
        RWP[i] = n2g[l * 1024 + k] * (1.f + MODP(l, b, 4)[k]) * rw[((size_t)l * 1024 + k) * 32 + e]; }
    for (int it = gw; it < 2 * 2 * 32; it += NGW) { const int l = it >> 6, b = (it >> 5) & 1, e = it & 31; float s = 0.f;
        for (int k = lane; k < 1024; k += 64) s += MODP(l, b, 3)[k] * rw[((size_t)l * 1024 + k) * 32 + e];
        s = wave_sum(s); if (lane == 0) RBP[it] = s + rb[l * 32 + e]; }
}
__device__ __forceinline__ void phase_combine(Frame& F, const Args& a, int l) {
    const int gw = F.vcu * NWAVES + F.wave, NGW = F.G * NWAVES; const int lane = F.lane;
    float* XR = WSP(float, WS_XR); bf16_t* H = WSP(bf16_t, WS_H); const unsigned char* YR = WSP(unsigned char, WS_YROWS);
    const int* ASG = WSP(int, WS_ASG); const float* G4 = WSP(float, WS_GATE4);
    const int myprefix = expert_block_prefix(F.ctl + CW_CNT + l * 32, lane);
    const bool last = (l == DEPTH - 1);
    const float* g = last ? INP(a, float, I_FING) : INP(a, float, I_N1G) + (l + 1) * 1024;
#define COMB_LOAD(R_, WV_, GT_, M_) do { const int4 as4_ = *(const int4*)(ASG + (M_) * 4); const f32x4 gt4_ = *(const f32x4*)(G4 + (M_) * 4); \
        R_ = row_load(XR + (size_t)(M_) * DM, lane); const int asv_[4] = {as4_.x, as4_.y, as4_.z, as4_.w}; GT_[0] = gt4_.x; GT_[1] = gt4_.y; GT_[2] = gt4_.z; GT_[3] = gt4_.w; \
        _Pragma("unroll") for (int k = 0; k < 4; ++k) { const int e = asv_[k] >> 16, slot = asv_[k] & 0xffff; const int blk = __shfl(myprefix, e); \
            const unsigned* yr = (const unsigned*)(YR + ((size_t)blk * 256 + slot) * DM) + lane; _Pragma("unroll") for (int j = 0; j < 4; ++j) WV_[k][j] = __builtin_nontemporal_load(yr + 64 * j); } } while (0)
#define COMB_FINISH(R_, WV_, GT_, M_) do { const int b = (M_) >> 13; f32x4 y[4]; \
        _Pragma("unroll") for (int j = 0; j < 4; ++j) y[j] = (f32x4){0.f, 0.f, 0.f, 0.f}; \
        _Pragma("unroll") for (int k = 0; k < 4; ++k) _Pragma("unroll") for (int j = 0; j < 4; ++j) { const int w = (int)WV_[k][j]; const f32x2 lo_ = __builtin_amdgcn_cvt_pk_f32_fp8(w, false), hi_ = __builtin_amdgcn_cvt_pk_f32_fp8(w, true); y[j] += (f32x4){lo_.x, lo_.y, hi_.x, hi_.y} * GT_[k]; } \
        const float* g2 = MODP(l, b, 5); \
        _Pragma("unroll") for (int j = 0; j < 4; ++j) R_.v[j] += ((const f32x4*)g2)[lane + 64 * j] * y[j]; \
        const float rstd = 1.f / sqrtf(row_ssq(R_) * (1.f / DM) + NORM_EPS); \
        if (last) { f32x4* o = (f32x4*)(a.out + (size_t)(M_) * DM) + lane; _Pragma("unroll") for (int j = 0; j < 4; ++j) o[64 * j] = R_.v[j] * rstd * ((const f32x4*)g)[lane + 64 * j]; } \
        else { f32x4* xo = (f32x4*)(XR + (size_t)(M_) * DM) + lane; _Pragma("unroll") for (int j = 0; j < 4; ++j) xo[64 * j] = R_.v[j]; \
            row_norm_store8(R_, rstd, g, MODP(l + 1, b, 1), MODP(l + 1, b, 0), WSP(unsigned char, WS_H8) + (size_t)(M_) * DM, lane); } } while (0)
    for (int m = gw; m < T; m += 2 * NGW) { const int m2 = m + NGW;
        RowV rA, rB; unsigned wA[4][4], wB[4][4]; float gA[4], gB[4];
        COMB_LOAD(rA, wA, gA, m); COMB_LOAD(rB, wB, gB, m2);
        COMB_FINISH(rA, wA, gA, m); COMB_FINISH(rB, wB, gB, m2);
    }
#undef COMB_LOAD
#undef COMB_FINISH
}
__device__ __forceinline__ void compress_item(Frame& F, const Args& a, int l, int item) {
    const int which = item >> 7, b = (item >> 6) & 1, g = (item >> 5) & 1, n0 = (item & 31) * 16;
    const int lane = F.lane, w = F.wave, r16 = lane & 15, kg = lane >> 4;
    const bf16_t* src = WSP(bf16_t, which ? WS_VC : WS_KC);
    const bf16_t* W1 = WSP(bf16_t, WS_CW1) + (size_t)(l * 2 + which) * 64 * 2048;
    LAS float* red = (LAS float*)F.lds;
    LAS float* hid = (LAS float*)(F.lds + 32768);
    f32x4 acc[4];
#pragma unroll
    for (int i = 0; i < 4; ++i) acc[i] = (f32x4){0.f, 0.f, 0.f, 0.f};
    const int n = n0 + r16; const bool nval = n < NCMP;
#pragma unroll 2
    for (int ks = 0; ks < 8; ++ks) { const int k = 256 * w + 32 * ks + 8 * kg; const int li = k >> 6, d = k & 63;
        bf16x8 af = (bf16x8){0, 0, 0, 0, 0, 0, 0, 0};
        if (nval) af = *(const bf16x8*)(src + ((size_t)b * SEQ + 16 * n + li) * 128 + g * 64 + d);
#pragma unroll
        for (int nt = 0; nt < 4; ++nt) { const bf16x8 bf = *(const bf16x8*)(W1 + (size_t)(nt * 16 + r16) * 2048 + k); acc[nt] = __builtin_amdgcn_mfma_f32_16x16x32_bf16(af, bf, acc[nt], 0, 0, 0); } }
#pragma unroll
    for (int nt = 0; nt < 4; ++nt)
#pragma unroll
        for (int i = 0; i < 4; ++i) red[(w * 16 + 4 * kg + i) * 64 + nt * 16 + r16] = acc[nt][i];
    __syncthreads();
    const float* cb = WSP(float, WS_MISC) + (l * 2 + which) * 64;
    for (int i = F.tid; i < 1024; i += NTHREADS) { float s = cb[i & 63];
#pragma unroll
        for (int ww = 0; ww < 8; ++ww) s += red[ww * 1024 + i];
        hid[i] = gelu_tanh(s); }
    { const float* w2 = INP(a, float, which ? I_CW2V : I_CW2K) + (size_t)l * 4096; LAS f32x4* w2s4 = (LAS f32x4*)(F.lds + 40960);
      for (int i = F.tid; i < 1024; i += NTHREADS) w2s4[i] = ((const f32x4*)w2)[i]; }
    __syncthreads();
    {
        const int nn = F.tid >> 5, c = F.tid & 31; LAS float* w2s = (LAS float*)(F.lds + 40960);
        float o1 = 0.f, o2 = 0.f;
#pragma unroll 16
        for (int k = 0; k < 64; ++k) { const float h = hid[nn * 64 + k]; o1 += h * w2s[k * 64 + c]; o2 += h * w2s[k * 64 + c + 32]; }
        const int np = n0 + nn; float nsq_ = 0.f;
        if (np < NCMP) {
            if (!which) { const float* cs = WSP(float, WS_ROPE) + (((size_t)b * SEQ + 16 * np + 31) * 32 + c) * 2; const float cc = cs[0], ss = cs[1];
                const float r1 = o1 * cc - o2 * ss, r2 = o2 * cc + o1 * ss;
                bf16_t* img = WSP(bf16_t, WS_KCMP) + (size_t)(b * 2 + g) * 512 * 64; img[kfrag_off(np, c >> 3) + (c & 7)] = (bf16_t)(cvtpk(r1, 0.f) & 0xffffu); img[kfrag_off(np, 4 + (c >> 3)) + (c & 7)] = (bf16_t)(cvtpk(r2, 0.f) & 0xffffu);
                nsq_ = r1 * r1 + r2 * r2;
            } else { bf16_t* img = WSP(bf16_t, WS_VCT) + (size_t)(b * 2 + g) * 512 * 64; img[vfrag_off(np, c)] = (bf16_t)(cvtpk(o1, 0.f) & 0xffffu); img[vfrag_off(np, c + 32)] = (bf16_t)(cvtpk(o2, 0.f) & 0xffffu); }
        }
        if (!which) {
            float mx = quad_sum(nsq_);
            mx += __uint_as_float(__builtin_amdgcn_update_dpp(0u, __float_as_uint(mx), 0x141, 0xF, 0xF, true)); mx += __uint_as_float(__builtin_amdgcn_update_dpp(0u, __float_as_uint(mx), 0x140, 0xF, 0xF, true));
            mx = x16_sum(mx);
            mx = x32_max(mx);
            if (F.lane == 0) atomicMax(F.ctl + CW_KMAX + l * 16 + 12 + b * 2 + g, __float_as_uint(mx * 1.02f));
        }
    }
    __syncthreads();
}
__device__ __forceinline__ void sgu_item(Frame& F, const Args& a, int l, int ch) {
    const size_t tok0 = (size_t)ch * 128;
    const int lane = F.lane, w = F.wave, r16 = lane & 15, kg = lane >> 4;
    const bf16_t* VG = WSP(bf16_t, WS_VG); const bf16_t* UG = WSP(bf16_t, WS_UG); bf16_t* Y = WSP(bf16_t, WS_Y);
    LAS float* stats = (LAS float*)F.lds;
    LAS bf16_t* vnT = (LAS bf16_t*)(F.lds + 1024);
    constexpr int VP = 136;
    static_assert(1024 + 8 * 64 * 136 * 2 <= ATT_LDS_BYTES, "SGU LDS map");
    {
        u32x4 vrow[16];
#pragma unroll
        for (int tt = 0; tt < 16; ++tt) vrow[tt] = *(const u32x4*)(VG + (tok0 + 16 * w + tt) * 512 + lane * 8);
#pragma unroll
        for (int tt = 0; tt < 16; ++tt) { const int s = 16 * w + tt; const u32x4 v = vrow[tt];
            const float f[8] = {bflo(v.x), bfhi(v.x), bflo(v.y), bfhi(v.y), bflo(v.z), bfhi(v.z), bflo(v.w), bfhi(v.w)};
            float sm = 0.f;
#pragma unroll
            for (int i = 0; i < 8; ++i) sm += f[i];
            const float mu = wave_sum(sm) * (1.f / 512.f); float q = 0.f;
#pragma unroll
            for (int i = 0; i < 8; ++i) q += (f[i] - mu) * (f[i] - mu);
            const float var = wave_sum(q) * (1.f / 512.f);
            if (lane == 0) { stats[2 * s] = mu; stats[2 * s + 1] = 1.f / sqrtf(var + NORM_EPS); } }
    }
    __syncthreads();
    {
        const int s = F.tid & 127, hq = F.tid >> 7; const float mu = stats[2 * s], rs = stats[2 * s + 1];
#pragma unroll
        for (int hp = 0; hp < 2; ++hp) { const int h = hq + 4 * hp; const int cbase = h * 64;
            const float* lg = INP(a, float, I_SGLNG) + l * 512 + cbase; const float* lb = INP(a, float, I_SGLNB) + l * 512 + cbase;
#pragma unroll 2
            for (int d0 = 0; d0 < 64; d0 += 8) { const u32x4 v = *(const u32x4*)(VG + (tok0 + s) * 512 + cbase + d0);
                const float f[8] = {bflo(v.x), bfhi(v.x), bflo(v.y), bfhi(v.y), bflo(v.z), bfhi(v.z), bflo(v.w), bfhi(v.w)};
#pragma unroll
                for (int i = 0; i < 8; ++i) vnT[(h * 64 + d0 + i) * VP + s] = (bf16_t)(cvtpk((f[i] - mu) * rs * lg[d0 + i] + lb[d0 + i], 0.f) & 0xffffu); } }
    }
    __syncthreads();
    {
        const int h = w;
        const bf16_t* Wm = WSP(bf16_t, WS_SGW) + (size_t)(l * 8 + h) * 128 * 128; const float* bs = INP(a, float, I_SGB) + (size_t)(l * 8 + h) * 128;
#pragma nounroll
        for (int tt = 0; tt < 8; ++tt) {
            const int t = 16 * tt + r16; const float bb = bs[t];
            bf16x8 bw[4]; u32x2 ugv[4];
#pragma unroll
            for (int ks = 0; ks < 4; ++ks) bw[ks] = *(const bf16x8*)(Wm + (size_t)t * 128 + 32 * ks + 8 * kg);
#pragma unroll
            for (int dt = 0; dt < 4; ++dt) ugv[dt] = *(const u32x2*)(UG + (tok0 + t) * 512 + h * 64 + dt * 16 + 4 * kg);
            f32x4 acc[4];
#pragma unroll
            for (int i = 0; i < 4; ++i) acc[i] = (f32x4){0.f, 0.f, 0.f, 0.f};
            const int nks = (16 * tt + 15) / 32 + 1;
#pragma unroll
            for (int ks = 0; ks < 4; ++ks) { if (ks < nks) {
#pragma unroll
                for (int dt = 0; dt < 4; ++dt) { const bf16x8 afr = *(const LAS bf16x8*)(vnT + (h * 64 + dt * 16 + r16) * VP + 32 * ks + 8 * kg); acc[dt] = __builtin_amdgcn_mfma_f32_16x16x32_bf16(afr, bw[ks], acc[dt], 0, 0, 0); } } }
#pragma unroll
            for (int dt = 0; dt < 4; ++dt) { const u32x2 uu = ugv[dt];
                u32x2 o; o.x = cvtpk(bflo(uu.x) * (acc[dt][0] + bb), bfhi(uu.x) * (acc[dt][1] + bb)); o.y = cvtpk(bflo(uu.y) * (acc[dt][2] + bb), bfhi(uu.y) * (acc[dt][3] + bb));
                *(u32x2*)(Y + (tok0 + t) * 1024 + h * 64 + dt * 16 + 4 * kg) = o; }
        }
    }
    __syncthreads();
}
namespace att {
constexpr int OSP = 65;
constexpr int L_OH = 0;
constexpr int L_OL = 66560;
constexpr int L_LS = 133120;
constexpr int L_MREF = L_LS + 2048;
constexpr int USP = 129;
constexpr int L_SEL = L_MREF + 1024;
constexpr int L_CNT = L_SEL + 1024;
constexpr int L_LIST = L_CNT + 512;
constexpr int L_WCTR = L_LIST + 8192;
static_assert(L_WCTR + 16 <= ATT_LDS_BYTES, "attention LDS map");

struct Ptrs { const bf16_t *Q, *KS, *KW, *VST, *VWT, *KCMP, *VCT; const float* GATES; bf16_t* Y; float* YPART; float kmax, vmax, kwmax, kcmax; };

#define MFMA16(a, b, c) __builtin_amdgcn_mfma_f32_16x16x32_bf16(a, b, c, 0, 0, 0)

__device__ __forceinline__ void attn_unit(Frame& F, const Ptrs& P, int b, int g, int qb) {
    LAS unsigned char* lds = F.lds;
    const int tid = F.tid, lane = F.lane, w = F.wave, r16 = lane & 15, kg = lane >> 4;
    LAS int* Oh = (LAS int*)(lds + L_OH); LAS int* Ol = (LAS int*)(lds + L_OL); LAS float* imp = (LAS float*)(lds + L_OH);
    LAS int* lsel = (LAS int*)(lds + L_LS); LAS float* mref = (LAS float*)(lds + L_MREF);
    LAS unsigned* selm = (LAS unsigned*)(lds + L_SEL); LAS int* cnts = (LAS int*)(lds + L_CNT); LAS unsigned char* lists = lds + L_LIST; LAS int* wctr = (LAS int*)(lds + L_WCTR);
    const size_t tokb = (size_t)b * SEQ; const int t0 = qb * 64;
    const bf16_t* Qg = P.Q + (tokb + t0) * 512 + g * 256;
    LAS float* U = (LAS float*)(lds + L_OH); LAS float* linvc = (LAS float*)(lds + L_LS);
    {
        const int q = tid >> 3, part = tid & 7, hd = part >> 1, hf = part & 1;
        const u32x4* src = (const u32x4*)(Qg + (size_t)q * 512 + part * 32);
        float ss = 0.f;
#pragma unroll
        for (int i = 0; i < 4; ++i) { const u32x4 v = src[i]; const float f[8] = {bflo(v.x), bfhi(v.x), bflo(v.y), bfhi(v.y), bflo(v.z), bfhi(v.z), bflo(v.w), bfhi(v.w)};
#pragma unroll
            for (int k = 0; k < 8; ++k) ss += f[k] * f[k]; }
        ss += __uint_as_float(__builtin_amdgcn_update_dpp(0u, __float_as_uint(ss), 0xB1, 0xF, 0xF, true));
        if (hf == 0) mref[q * 4 + hd] = sqrtf(ss);
        { u32x4 zz_ = {0u, 0u, 0u, 0u}; asm volatile("" : "+v"(zz_)); LAS u32x4* z4 = (LAS u32x4*)U; for (int i = tid; i < (256 * USP) / 4; i += NTHREADS) z4[i] = zz_; }
    }
    __syncthreads();
    const int hl = r16 & 3;
#define ATT_LDK(dst, base, key0) do { const char* kb_ = (const char*)(base) + (size_t)(key0) * 128; _Pragma("unroll") for (int u_ = 0; u_ < 2; ++u_) _Pragma("unroll") for (int ks_ = 0; ks_ < 2; ++ks_) \
        dst[u_][ks_] = *(const bf16x8*)(kb_ + koff + (u_ * 2 + ks_) * 1024); } while (0)
#define ATT_LDV(dst, vbase, LEN, key0) do { const char* vb_ = (const char*)(vbase) + (size_t)(key0) * 128; _Pragma("unroll") for (int dt_ = 0; dt_ < 4; ++dt_) \
        dst[dt_] = *(const bf16x8*)(vb_ + koff + dt_ * 1024); } while (0)
#define ATT_SHADOW() int ln_ = F.lane; asm volatile("" : "+v"(ln_)); const int r16 = ln_ & 15, kg = ln_ >> 4, hl = r16 & 3; const unsigned koff = (unsigned)ln_ * 16u
    {
        ATT_SHADOW();
        bf16x8 qf[2][2]; float mrc[2], lpart[2], carry[2] = {0.f, 0.f}; int nlim[2]; f32x4 o[2][4];
#pragma unroll
        for (int rt = 0; rt < 2; ++rt) { const int q = 8 * w + 4 * rt + (r16 >> 2);
#pragma unroll
            for (int ks = 0; ks < 2; ++ks) qf[rt][ks] = *(const bf16x8*)(Qg + (size_t)q * 512 + hl * 64 + ks * 32 + kg * 8);
            mrc[rt] = mref[q * 4 + hl] * P.kcmax; lpart[rt] = 0.f; nlim[rt] = (t0 + q - 31) >> 4;
#pragma unroll
            for (int dt = 0; dt < 4; ++dt) o[rt][dt] = (f32x4){0.f, 0.f, 0.f, 0.f}; }
        const int nkeys = 4 * qb + 3, NP = (nkeys + 31) >> 5;
        const int nlim_min = (t0 + 8 * w - 31) >> 4;
        const bf16_t* Kc = P.KCMP + (size_t)(b * 2 + g) * 512 * 64; const bf16_t* Vc = P.VCT + (size_t)(b * 2 + g) * 64 * 512;
#define ATT_S1_STEP(KF, VF, s_) do { _Pragma("unroll") for (int rt = 0; rt < 2; ++rt) { \
            f32x4 st[2]; float p[2][4]; \
            _Pragma("unroll") for (int u = 0; u < 2; ++u) { st[u] = MFMA16(KF[u][0], qf[rt][0], ((f32x4){0.f, 0.f, 0.f, 0.f})); st[u] = MFMA16(KF[u][1], qf[rt][1], st[u]); } \
            _Pragma("unroll") for (int u = 0; u < 2; ++u) _Pragma("unroll") for (int i = 0; i < 4; ++i) p[u][i] = fast_exp2(st[u][i] - mrc[rt]); \
            if (32 * (s_) + 31 > nlim_min) { _Pragma("unroll") for (int u = 0; u < 2; ++u) _Pragma("unroll") for (int i = 0; i < 4; ++i) { const int n = 32 * (s_) + 8 * kg + 4 * u + i; if (n > nlim[rt]) p[u][i] = 0.f; } } \
            const float s01 = (p[0][0] + p[0][1]) + (p[0][2] + p[0][3]), s11 = (p[1][0] + p[1][1]) + (p[1][2] + p[1][3]); lpart[rt] += s01 + s11; \
            {   \
                \
              const unsigned x_ = __float_as_uint(p[1][3]); const auto s16_ = __builtin_amdgcn_permlane16_swap(x_, x_, false, false); const auto s32_ = __builtin_amdgcn_permlane32_swap(s16_[1], s16_[1], false, false); \
              const float inc_ = (kg & 1) ? __uint_as_float(s16_[0]) : ((kg == 2) ? __uint_as_float(s32_[0]) : carry[rt]); carry[rt] = __uint_as_float(s32_[1]); \
              LAS float* ur = U + ((8 * w + 4 * rt + (r16 >> 2)) * 4 + hl) * USP + 8 * (s_) + 2 * kg; \
              ur[0] += (2.f * s01 - p[0][3]) + inc_; ur[1] += (2.f * s11 - p[1][3]) + p[0][3]; } \
            u32x4 pw; pw.x = cvtpk(p[0][0], p[0][1]); pw.y = cvtpk(p[0][2], p[0][3]); pw.z = cvtpk(p[1][0], p[1][1]); pw.w = cvtpk(p[1][2], p[1][3]); \
            const bf16x8 pf = __builtin_bit_cast(bf16x8, pw); \
            _Pragma("unroll") for (int dt = 0; dt < 4; ++dt) o[rt][dt] = MFMA16(VF[dt], pf, o[rt][dt]); } } while (0)
        {
            bf16x8 kA[2][2], vA[4], kB[2][2], vB[4];
            ATT_LDK(kA, Kc, 0); ATT_LDV(vA, Vc, 512, 0); if (NP > 1) { ATT_LDK(kB, Kc, 32); ATT_LDV(vB, Vc, 512, 32); }
#pragma nounroll
            for (int s2 = 0; s2 < NP; s2 += 2) {
                ATT_S1_STEP(kA, vA, s2);
                if (s2 + 2 < NP) { ATT_LDK(kA, Kc, 32 * (s2 + 2)); ATT_LDV(vA, Vc, 512, 32 * (s2 + 2)); }
                if (s2 + 1 < NP) { ATT_S1_STEP(kB, vB, s2 + 1);
                    if (s2 + 3 < NP) { ATT_LDK(kB, Kc, 32 * (s2 + 3)); ATT_LDV(vB, Vc, 512, 32 * (s2 + 3)); } }
            }
        }
#undef ATT_S1_STEP
#pragma unroll
        for (int rt = 0; rt < 2; ++rt) { const int q = 8 * w + 4 * rt + (r16 >> 2); const float lrow = kg_sum(lpart[rt]); const float linv = lrow > 0.f ? 1.f / lrow : 0.f;
            if (kg == 0) linvc[q * 4 + hl] = linv;
            const float gc = P.GATES[(tokb + t0 + q) * 24 + (g * 4 + hl) * 3 + 0] * linv;
            float* yp = P.YPART + (tokb + t0 + q) * 512 + (g * 4 + hl) * 64 + 4 * kg;
#pragma unroll
            for (int dt = 0; dt < 4; ++dt) *(f32x4*)(yp + dt * 16) = o[rt][dt] * gc; }
    }
    LDS_WAIT();
#pragma nounroll
    for (int qg = 0; qg < 2; ++qg) {
        if (qb <= 15) {
            if (lane < 4) { const int q = 8 * w + 4 * qg + lane; const unsigned long long m0 = (1ull << (qb + 1)) - 1ull;
                selm[q * 4 + 0] = (unsigned)m0; selm[q * 4 + 1] = (unsigned)(m0 >> 32); selm[q * 4 + 2] = 0u; selm[q * 4 + 3] = 0u; }
        } else {
            const int j0 = lane, j1 = lane + 64; int v0[4], v1[4], thr[4];
#pragma unroll
            for (int k = 0; k < 4; ++k) { const int q = 8 * w + 4 * qg + k; const LAS float* ur = U + (q * 4) * USP; const LAS float* li = linvc + q * 4;
                float i0 = 0.f, i1 = 0.f;
#pragma unroll
                for (int h = 0; h < 4; ++h) { i0 += ur[h * USP + j0] * li[h]; i1 += ur[h * USP + j1] * li[h]; }
                v0[k] = (j0 >= 1 && j0 <= qb - 2) ? (int)__float_as_uint(i0) : -1;
                v1[k] = (j1 <= qb - 2) ? (int)__float_as_uint(i1) : -1; thr[k] = 0; }
#pragma nounroll
            for (int bit = 30; bit >= 0; --bit) {
                const int c0_ = thr[0] | (1 << bit), c1_ = thr[1] | (1 << bit), c2_ = thr[2] | (1 << bit), c3_ = thr[3] | (1 << bit);
                const unsigned long long a0_ = __ballot(v0[0] >= c0_), a1_ = __ballot(v0[1] >= c1_), a2_ = __ballot(v0[2] >= c2_), a3_ = __ballot(v0[3] >= c3_);
                const unsigned long long b0_ = __ballot(v1[0] >= c0_), b1_ = __ballot(v1[1] >= c1_), b2_ = __ballot(v1[2] >= c2_), b3_ = __ballot(v1[3] >= c3_);
                asm volatile("" :: "s"(a0_), "s"(a1_), "s"(a2_), "s"(a3_), "s"(b0_), "s"(b1_), "s"(b2_), "s"(b3_));
                if (__popcll(a0_) + __popcll(b0_) >= 13) thr[0] = c0_;
                if (__popcll(a1_) + __popcll(b1_) >= 13) thr[1] = c1_;
                if (__popcll(a2_) + __popcll(b2_) >= 13) thr[2] = c2_;
                if (__popcll(a3_) + __popcll(b3_) >= 13) thr[3] = c3_; }
            const unsigned long long below = (1ull << lane) - 1ull;
#pragma nounroll
            for (int k = 0; k < 4; ++k) {
                const int vv0 = (k == 0) ? v0[0] : (k == 1) ? v0[1] : (k == 2) ? v0[2] : v0[3], vv1 = (k == 0) ? v1[0] : (k == 1) ? v1[1] : (k == 2) ? v1[2] : v1[3];
                const int th = (k == 0) ? thr[0] : (k == 1) ? thr[1] : (k == 2) ? thr[2] : thr[3];
                const bool gt0 = vv0 > th, gt1 = vv1 > th, eq0 = vv0 == th, eq1 = vv1 == th;
                const int need = 13 - (__popcll(__ballot(gt0)) + __popcll(__ballot(gt1)));
                const unsigned long long B0 = __ballot(eq0), B1 = __ballot(eq1);
                const int rk0 = __popcll(B0 & below), rk1 = __popcll(B0) + __popcll(B1 & below);
                unsigned long long m0 = __ballot(gt0 || (eq0 && rk0 < need)), m1 = __ballot(gt1 || (eq1 && rk1 < need));
                m0 |= 1ull;
                if (qb < 64) m0 |= (1ull << qb); else m1 |= (1ull << (qb - 64));
                if (qb - 1 < 64) m0 |= (1ull << (qb - 1)); else m1 |= (1ull << (qb - 65));
                if (lane == 0) { const int q = 8 * w + 4 * qg + k; selm[q * 4 + 0] = (unsigned)m0; selm[q * 4 + 1] = (unsigned)(m0 >> 32); selm[q * 4 + 2] = (unsigned)m1; selm[q * 4 + 3] = (unsigned)(m1 >> 32); } }
        }
    }
    __syncthreads();
    { u32x4 zz_ = {0u, 0u, 0u, 0u}; asm volatile("" : "+v"(zz_)); LAS u32x4* z4 = (LAS u32x4*)Oh; for (int i = tid; i < (2 * 256 * OSP) / 4; i += NTHREADS) z4[i] = zz_; }
    lsel[tid] = 0;
    if (tid == 0) wctr[0] = 0;
    { const unsigned m0 = selm[lane * 4 + (w >> 1)];
#pragma nounroll
      for (int jj = 0; jj < 16; ++jj) { const int j = 16 * w + jj; const bool hit = (j <= qb) && ((m0 >> (16 * (w & 1) + jj)) & 1u);
          const unsigned long long mk = __ballot(hit); if (hit) lists[j * 64 + __popcll(mk & ((1ull << lane) - 1ull))] = (unsigned char)lane;
          if (lane == 0) cnts[j] = __popcll(mk); } }
    __syncthreads();
    for (int rep5 = 0; rep5 < ((ATTREP & 8) ? NREP : 1); ++rep5)
    {
        if (rep5 > 0) { __syncthreads(); if (tid == 0) wctr[0] = 0; __syncthreads(); }
        ATT_SHADOW();
        const bf16_t* Ks = P.KS + (size_t)(b * 2 + g) * SEQ * 64; const bf16_t* Vs = P.VST + (size_t)(b * 2 + g) * 64 * SEQ;
        const float S1 = 1048576.f / fmaxf(P.vmax, 1e-30f);
#define ATT_FETCH(idx_) do { int i_ = 0; if (lane == 0) i_ = __hip_atomic_fetch_add(wctr, 1, __ATOMIC_RELAXED, __HIP_MEMORY_SCOPE_WORKGROUP); idx_ = __builtin_amdgcn_readfirstlane(i_); } while (0)
#define ATT_JOF(idx_) (((idx_) == 0) ? 0 : (((idx_) == 1) ? qb : (((idx_) == 2) ? qb - 1 : (idx_) - 2)))
        bf16x8 kn[2][2][2];
        int idx; ATT_FETCH(idx);
        if (idx <= qb) { const int j = ATT_JOF(idx); ATT_LDK(kn[0], Ks, 64 * j); ATT_LDK(kn[1], Ks, 64 * j + 32); }
#pragma nounroll
        while (idx <= qb) {
            const int j = ATT_JOF(idx);
            bf16x8 kf[2][2][2], vf[2][4];
#pragma unroll
            for (int sp = 0; sp < 2; ++sp) {
#pragma unroll
                for (int u = 0; u < 2; ++u) { kf[sp][u][0] = kn[sp][u][0]; kf[sp][u][1] = kn[sp][u][1]; } }
            ATT_LDV(vf[0], Vs, SEQ, 64 * j); ATT_LDV(vf[1], Vs, SEQ, 64 * j + 32);
            int idx2; ATT_FETCH(idx2);
            if (idx2 <= qb) { const int j2 = ATT_JOF(idx2); ATT_LDK(kn[0], Ks, 64 * j2); ATT_LDK(kn[1], Ks, 64 * j2 + 32); }
            const int cnt = cnts[j];
            const int nch = (cnt + 3) >> 2;
            bf16x8 qn0, qn1; int qnx; bool vnx;
            { const int qs = (r16 >> 2); vnx = qs < cnt; qnx = lists[j * 64 + (vnx ? qs : (cnt > 0 ? cnt - 1 : 0))];
              const bf16_t* qp = Qg + (size_t)qnx * 512 + hl * 64 + kg * 8; qn0 = *(const bf16x8*)qp; qn1 = *(const bf16x8*)(qp + 32); }
#pragma nounroll
            for (int c = 0; c < nch; ++c) {
                const bool valid = vnx; const int q = qnx; const int row = q * 4 + hl; const bf16x8 q0 = qn0, q1 = qn1;
                if (c + 1 < nch) { const int qs = 4 * (c + 1) + (r16 >> 2); vnx = qs < cnt; qnx = lists[j * 64 + (vnx ? qs : cnt - 1)];
                    const bf16_t* qp = Qg + (size_t)qnx * 512 + hl * 64 + kg * 8; qn0 = *(const bf16x8*)qp; qn1 = *(const bf16x8*)(qp + 32); }
                const float mr = mref[row] * P.kmax;
                f32x4 o[4];
                float ps = 0.f;
                const bool slow = (j == qb) || (4 * c + 4 > cnt);
#define ATT_CHUNK(MASKED) \
                _Pragma("unroll") for (int sp = 0; sp < 2; ++sp) { \
                    f32x4 st[2]; float p[2][4]; \
                    _Pragma("unroll") for (int u = 0; u < 2; ++u) { st[u] = MFMA16(kf[sp][u][0], q0, ((f32x4){0.f, 0.f, 0.f, 0.f})); st[u] = MFMA16(kf[sp][u][1], q1, st[u]); } \
                    _Pragma("unroll") for (int u = 0; u < 2; ++u) _Pragma("unroll") for (int i = 0; i < 4; ++i) { float e = fast_exp2(st[u][i] - mr); \
                        if (MASKED) { const int kk = 32 * sp + 8 * kg + 4 * u + i; if (!valid || (j == qb && kk > q)) e = 0.f; } p[u][i] = e; ps += e; } \
                    u32x4 pw; pw.x = cvtpk(p[0][0], p[0][1]); pw.y = cvtpk(p[0][2], p[0][3]); pw.z = cvtpk(p[1][0], p[1][1]); pw.w = cvtpk(p[1][2], p[1][3]); \
                    const bf16x8 pf = __builtin_bit_cast(bf16x8, pw); \
                    _Pragma("unroll") for (int dt = 0; dt < 4; ++dt) o[dt] = (sp == 0) ? MFMA16(vf[0][dt], pf, ((f32x4){0.f, 0.f, 0.f, 0.f})) : MFMA16(vf[1][dt], pf, o[dt]); }
                if (slow) { ATT_CHUNK(true) } else { ATT_CHUNK(false) }
#undef ATT_CHUNK
                ps = kg_sum(ps);
                if (valid) {
                    if (kg == 0) { const float xs = ps * 1048576.f, hf_ = __builtin_rintf(xs); __hip_atomic_fetch_add(lsel + row, (int)hf_, __ATOMIC_RELAXED, __HIP_MEMORY_SCOPE_WORKGROUP);
                        __hip_atomic_fetch_add(lsel + 256 + row, (int)((xs - hf_) * 1048576.f), __ATOMIC_RELAXED, __HIP_MEMORY_SCOPE_WORKGROUP); }
#pragma unroll
                    for (int dt = 0; dt < 4; ++dt)
#pragma unroll
                        for (int i = 0; i < 4; ++i) { const float xs = o[dt][i] * S1, hf_ = __builtin_rintf(xs); const int off = row * OSP + dt * 16 + 4 * kg + i;
                            __hip_atomic_fetch_add(Oh + off, (int)hf_, __ATOMIC_RELAXED, __HIP_MEMORY_SCOPE_WORKGROUP);
                            __hip_atomic_fetch_add(Ol + off, (int)((xs - hf_) * 1048576.f), __ATOMIC_RELAXED, __HIP_MEMORY_SCOPE_WORKGROUP); }
                }
            }
            idx = idx2;
        }
    }
    f32x4 yacc[2][4];
    {
        ATT_SHADOW();
        bf16x8 qf[2][2]; float mrw[2], lpart[2]; f32x4 o[2][4];
#pragma unroll
        for (int rt = 0; rt < 2; ++rt) { const int q = 8 * w + 4 * rt + (r16 >> 2);
#pragma unroll
            for (int ks = 0; ks < 2; ++ks) qf[rt][ks] = *(const bf16x8*)(Qg + (size_t)q * 512 + hl * 64 + ks * 32 + kg * 8);
            mrw[rt] = mref[q * 4 + hl] * P.kwmax; lpart[rt] = 0.f;
#pragma unroll
            for (int dt = 0; dt < 4; ++dt) o[rt][dt] = (f32x4){0.f, 0.f, 0.f, 0.f}; }
        const bf16_t* Kw = P.KW + (size_t)(b * 2 + g) * SEQ * 64; const bf16_t* Vw = P.VWT + (size_t)(b * 2 + g) * 64 * SEQ;
        const int jlo = qb >= 8 ? qb - 8 : 0; const int nit = 2 * (qb - jlo + 1);
#define ATT_S4_STEP(KF, VF, it_) do { const int jw_ = jlo + ((it_) >> 1), sp_ = (it_) & 1; const int mode_ = (jw_ == qb) ? 1 : ((jw_ == qb - 8) ? 2 : 0); \
        _Pragma("unroll") for (int rt = 0; rt < 2; ++rt) { \
            f32x4 st[2]; float p[2][4]; \
            _Pragma("unroll") for (int u = 0; u < 2; ++u) { st[u] = MFMA16(KF[u][0], qf[rt][0], ((f32x4){0.f, 0.f, 0.f, 0.f})); st[u] = MFMA16(KF[u][1], qf[rt][1], st[u]); } \
            _Pragma("unroll") for (int u = 0; u < 2; ++u) _Pragma("unroll") for (int i = 0; i < 4; ++i) p[u][i] = fast_exp2(st[u][i] - mrw[rt]); \
            if (mode_) { const int tq = 8 * w + 4 * rt + (r16 >> 2); \
                _Pragma("unroll") for (int u = 0; u < 2; ++u) _Pragma("unroll") for (int i = 0; i < 4; ++i) { const int kk = 32 * sp_ + 8 * kg + 4 * u + i; const bool vis = (mode_ == 1) ? (kk <= tq) : (kk > tq); if (!vis) p[u][i] = 0.f; } } \
            lpart[rt] += ((p[0][0] + p[0][1]) + (p[0][2] + p[0][3])) + ((p[1][0] + p[1][1]) + (p[1][2] + p[1][3])); \
            u32x4 pw; pw.x = cvtpk(p[0][0], p[0][1]); pw.y = cvtpk(p[0][2], p[0][3]); pw.z = cvtpk(p[1][0], p[1][1]); pw.w = cvtpk(p[1][2], p[1][3]); \
            const bf16x8 pf = __builtin_bit_cast(bf16x8, pw); \
            _Pragma("unroll") for (int dt = 0; dt < 4; ++dt) o[rt][dt] = MFMA16(VF[dt], pf, o[rt][dt]); } } while (0)
        {
            bf16x8 kA[2][2], vA[4], kB[2][2], vB[4];
            ATT_LDK(kA, Kw, 64 * jlo); ATT_LDV(vA, Vw, SEQ, 64 * jlo); ATT_LDK(kB, Kw, 64 * jlo + 32); ATT_LDV(vB, Vw, SEQ, 64 * jlo + 32);
#pragma nounroll
            for (int it = 0; it < nit; it += 2) {
                ATT_S4_STEP(kA, vA, it);
                if (it + 2 < nit) { ATT_LDK(kA, Kw, 64 * jlo + 32 * (it + 2)); ATT_LDV(vA, Vw, SEQ, 64 * jlo + 32 * (it + 2)); }
                ATT_S4_STEP(kB, vB, it + 1);
                if (it + 3 < nit) { ATT_LDK(kB, Kw, 64 * jlo + 32 * (it + 3)); ATT_LDV(vB, Vw, SEQ, 64 * jlo + 32 * (it + 3)); }
            }
        }
#undef ATT_S4_STEP
#pragma unroll
        for (int rt = 0; rt < 2; ++rt) { const int q = 8 * w + 4 * rt + (r16 >> 2); const float lw_ = kg_sum(lpart[rt]); const float sc = lw_ > 0.f ? P.GATES[(tokb + t0 + q) * 24 + (g * 4 + hl) * 3 + 2] / lw_ : 0.f;
#pragma unroll
            for (int dt = 0; dt < 4; ++dt) yacc[rt][dt] = o[rt][dt] * sc; }
    }
    __syncthreads();
#pragma unroll
    for (int rt = 0; rt < 2; ++rt) { const int q = 8 * w + 4 * rt + (r16 >> 2), row = q * 4 + hl;
        const float lrow = (float)lsel[row] * (1.f / 1048576.f) + (float)lsel[256 + row] * (1.f / 1099511627776.f);
        const float invS1 = fmaxf(P.vmax, 1e-30f) * (1.f / 1048576.f);
        const float sc = lrow > 0.f ? P.GATES[(tokb + t0 + q) * 24 + (g * 4 + hl) * 3 + 1] / lrow * invS1 : 0.f;
        bf16_t* dst = P.Y + (tokb + t0 + q) * 1024 + 512 + (g * 4 + hl) * 64 + 4 * kg;
        const float* yp = P.YPART + (tokb + t0 + q) * 512 + (g * 4 + hl) * 64 + 4 * kg;
#pragma unroll
        for (int dt = 0; dt < 4; ++dt) { const LAS int* oh = Oh + row * OSP + dt * 16 + 4 * kg; const LAS int* ol = Ol + row * OSP + dt * 16 + 4 * kg;
            const f32x4 osel = (f32x4){(float)oh[0] + (float)ol[0] * (1.f / 1048576.f), (float)oh[1] + (float)ol[1] * (1.f / 1048576.f), (float)oh[2] + (float)ol[2] * (1.f / 1048576.f), (float)oh[3] + (float)ol[3] * (1.f / 1048576.f)};
            const f32x4 v = yacc[rt][dt] + *(const f32x4*)(yp + dt * 16) + osel * sc;
            u32x2 o; o.x = cvtpk(v[0], v[1]); o.y = cvtpk(v[2], v[3]); *(u32x2*)(dst + dt * 16) = o; } }
    __syncthreads();
}
#undef MFMA16
#undef ATT_LDK
#undef ATT_LDV
#undef ATT_SHADOW
#undef ATT_FETCH
#undef ATT_JOF
}

__device__ __forceinline__ void phase_n2(Frame& F, const Args& a, int l) {
    const int lane = F.lane, w = F.wave;
    const float* XR = WSP(float, WS_XR); unsigned char* H8 = WSP(unsigned char, WS_H8);
    const float* g = INP(a, float, I_N2G) + l * 1024;
    LAS float* part = (LAS float*)F.lds;
    LAS float* ssqp = (LAS float*)(F.lds + 32768);
    LAS float* lg = (LAS float*)(F.lds + 32768 + 1024);
    int* CNTI = WSP(int, WS_CNTI); int* ASG = WSP(int, WS_ASG); float* G4 = WSP(float, WS_GATE4);
    for (int item = F.vcu; item < T / 64; item += F.G) {
        const int tk0 = item * 64, b = tk0 >> 13; const int tt = w & 1, kq = w >> 1;
        const float* rwp = WSP(float, WS_RWP) + (size_t)(l * 2 + b) * 1024 * 32; const float* rbp = WSP(float, WS_MISC + 4096) + (l * 2 + b) * 32;
        const int i31 = lane & 31, hf = lane >> 5;
        {
            const float* xp = XR + (size_t)(tk0 + tt * 32 + i31) * DM + kq * 256 + 4 * hf; const float* wp = rwp + (size_t)(kq * 256 + 4 * hf) * 32 + i31;
            f32x16 acc;
#pragma unroll
            for (int r = 0; r < 16; ++r) acc[r] = 0.f;
            float ssq = 0.f;
#pragma nounroll
            for (int bt = 0; bt < 4; ++bt) {
                f32x4 xv[8]; float wv[8][4];
#pragma unroll
                for (int s = 0; s < 8; ++s) { xv[s] = *(const f32x4*)(xp + 8 * (bt * 8 + s)); const float* wq = wp + (size_t)(8 * (bt * 8 + s)) * 32;
                    wv[s][0] = wq[0]; wv[s][1] = wq[32]; wv[s][2] = wq[64]; wv[s][3] = wq[96]; }
#pragma unroll
                for (int s = 0; s < 8; ++s) { ssq += (xv[s].x * xv[s].x + xv[s].y * xv[s].y) + (xv[s].z * xv[s].z + xv[s].w * xv[s].w);
                    acc = __builtin_amdgcn_mfma_f32_32x32x2f32(xv[s].x, wv[s][0], acc, 0, 0, 0); acc = __builtin_amdgcn_mfma_f32_32x32x2f32(xv[s].y, wv[s][1], acc, 0, 0, 0);
                    acc = __builtin_amdgcn_mfma_f32_32x32x2f32(xv[s].z, wv[s][2], acc, 0, 0, 0); acc = __builtin_amdgcn_mfma_f32_32x32x2f32(xv[s].w, wv[s][3], acc, 0, 0, 0); }
            }
            ssq += __shfl_xor(ssq, 32);
            if (hf == 0) ssqp[kq * 64 + tt * 32 + i31] = ssq;
#pragma unroll
            for (int r = 0; r < 16; ++r) { const int tk = (r & 3) + 8 * (r >> 2) + 4 * hf; part[(w * 32 + tk) * 32 + i31] = acc[r]; }
        }
        __syncthreads();
        for (int i = F.tid; i < 64 * 32; i += NTHREADS) { const int tk = i >> 5, e = i & 31, t2 = tk >> 5, tl = tk & 31;
            const float sq = (ssqp[tk] + ssqp[64 + tk]) + (ssqp[128 + tk] + ssqp[192 + tk]); const float rstd = 1.f / sqrtf(sq * (1.f / DM) + NORM_EPS);
            const float v = (part[((0 * 2 + t2) * 32 + tl) * 32 + e] + part[((1 * 2 + t2) * 32 + tl) * 32 + e]) + (part[((2 * 2 + t2) * 32 + tl) * 32 + e] + part[((3 * 2 + t2) * 32 + tl) * 32 + e]);
            lg[tk * 33 + e] = v * rstd + rbp[e]; }
        __syncthreads();
        if (w < 2) {
            const int it = item * 2 + w;
            float v0 = -INFINITY, v1 = -INFINITY, v2 = -INFINITY, v3 = -INFINITY; int i0 = -1, i1 = -1, i2 = -1, i3 = -1;
            if (lane < 32) {
#pragma unroll 8
                for (int e = 0; e < 32; ++e) { const float v = lg[(w * 32 + lane) * 33 + e];
                    if (v > v3) { if (v > v2) { v3 = v2; i3 = i2; if (v > v1) { v2 = v1; i2 = i1; if (v > v0) { v1 = v0; i1 = i0; v0 = v; i0 = e; } else { v1 = v; i1 = e; } } else { v2 = v; i2 = e; } } else { v3 = v; i3 = e; } } }
            }
            const float e1 = __expf(v1 - v0), e2 = __expf(v2 - v0), e3 = __expf(v3 - v0); const float inv = 1.f / (1.f + e1 + e2 + e3);
            int r0 = 0, r1 = 0, r2 = 0, r3 = 0, mycnt = 0;
            for (int e = 0; e < 32; ++e) { const bool hit = (i0 == e) | (i1 == e) | (i2 == e) | (i3 == e); const unsigned long long U = __ballot(hit);
                const int rk = __popcll(U & ((1ull << lane) - 1ull));
                if (i0 == e) r0 = rk; if (i1 == e) r1 = rk; if (i2 == e) r2 = rk; if (i3 == e) r3 = rk;
                if (lane == e) mycnt = __popcll(U); }
            if (lane < 32) { const int tk = tk0 + w * 32 + lane; CNTI[it * 32 + lane] = mycnt;
                if (mycnt > 0) { atomicAdd(F.ctl + CW_GCNT + (l * 32 + (it >> 4)) * 32 + lane, (unsigned)mycnt); atomicAdd(F.ctl + CW_CNT + l * 32 + lane, (unsigned)mycnt); }
                *(int4*)(ASG + tk * 4) = make_int4((i0 << 16) | r0, (i1 << 16) | r1, (i2 << 16) | r2, (i3 << 16) | r3);
                *(f32x4*)(G4 + tk * 4) = (f32x4){inv, e1 * inv, e2 * inv, e3 * inv}; }
        }
#pragma unroll 2
        for (int rr = 0; rr < 8; ++rr) { const int m = tk0 + w * 8 + rr; const RowV r = row_load(XR + (size_t)m * DM, lane);
            const float rstd = 1.f / sqrtf(row_ssq(r) * (1.f / DM) + NORM_EPS);
            row_norm_store8(r, rstd, g, MODP(l, b, 4), MODP(l, b, 3), H8 + (size_t)m * DM, lane); }
        __syncthreads();
    }
}

__device__ __forceinline__ void phase_n2b(Frame& F, int l) {
    const int gw = F.vcu * NWAVES + F.wave, NGW = F.G * NWAVES; const int lane = F.lane;
    const int* CNTI = WSP(int, WS_CNTI); int* TOK = WSP(int, WS_TOK); int* ASG = WSP(int, WS_ASG); unsigned* cnt = F.ctl + CW_CNT + l * 32;
    for (int it = gw; it < T / 32; it += NGW) {
        int base = 0;
        {
            const unsigned* gc = F.ctl + CW_GCNT + l * 1024; const int grp = it >> 4, e = lane & 31; int s0 = 0, s1 = 0;
#pragma unroll
            for (int gI = 0; gI < 32; ++gI) { const int v = (int)gc[gI * 32 + e]; s0 += (gI < grp) ? v : 0; }
#pragma unroll
            for (int i = 0; i < 16; ++i) { const int v = CNTI[((grp << 4) + i) * 32 + e]; s1 += (((grp << 4) + i) < it) ? v : 0; }
            base = s0 + s1; }
        { const int tk = it * 32 + (lane & 31); const int4 as = *(const int4*)(ASG + tk * 4); int v[4] = {as.x, as.y, as.z, as.w};
#pragma unroll
            for (int k = 0; k < 4; ++k) { const int e = v[k] >> 16, rk = v[k] & 0xffff; const int sl = __shfl(base, e & 31) + rk; if (lane < 32) TOK[e * 16384 + sl] = tk; v[k] = (e << 16) | sl; }
            if (lane < 32) *(int4*)(ASG + tk * 4) = make_int4(v[0], v[1], v[2], v[3]); }
    }
}

__device__ __forceinline__ void moe_tables(Frame& F, int l, int NT, int& total) {
    LAS int* ust = (LAS int*)(F.lds + MOE_OFF); LAS int* bst = ust + 33; LAS int* cn = bst + 33;
    if (F.tid < 64) { const unsigned* cnt = F.ctl + CW_CNT + l * 32; const int lane = F.tid;
        const int c = (lane < NE) ? (int)cnt[lane] : 0; const int nb = (c + 255) >> 8; int inc = nb;
#pragma unroll
        for (int o = 1; o < 32; o <<= 1) { const int t = __shfl_up(inc, o); if ((lane & 31) >= o) inc += t; }
        if (lane < NE) { bst[lane] = inc - nb; ust[lane] = (inc - nb) * NT; cn[lane] = c; if (lane == NE - 1) { bst[NE] = inc; ust[NE] = inc * NT; } } }
    __syncthreads();
    total = ust[NE];
}

constexpr int PH_PROLOGUE = 0, PH_N1 = 1, PH_LAYER0 = 2, PH_PER_LAYER = 9, NPHASES = PH_LAYER0 + DEPTH * PH_PER_LAYER;
__global__ void __launch_bounds__(NTHREADS, 2) fwd_kernel(Args args) {
    extern __shared__ __attribute__((aligned(16))) unsigned char lds_raw[];
    Frame F;
    F.lds = (LAS unsigned char*)lds_raw; F.ws = args.ws; F.ctl = (unsigned*)(args.ws + WS_CTL);
    F.tid = threadIdx.x; F.lane = F.tid & 63; F.wave = __builtin_amdgcn_readfirstlane(F.tid >> 6);
    F.G = gridDim.x; { const int bx = blockIdx.x; F.vcu = (F.G % 8 == 0) ? (bx % 8) * (F.G / 8) + bx / 8 : bx; }
    for (int u = F.tid; u < (LDS_BYTES - LDSCTL_OFF) / 4; u += NTHREADS) ((LAS unsigned*)(F.lds + LDSCTL_OFF))[u] = 0u;
    __syncthreads();
    volatile LAS unsigned* MISC = (volatile LAS unsigned*)(F.lds + MISC_OFF);
    XcdBarrier bar; bar.bar = F.ctl + CW_BAR; bar.x = 0; bar.st = nullptr;
#if !MK_PER_PHASE
    bar = xcd_barrier_post(F.ctl + CW_BAR, MISC + 8);
#endif
    const int lo = args.ph_lo, hi = args.ph_hi;
#define IN(k) (lo <= (k) && (k) < hi)
#define REFRESH() do { int t_ = threadIdx.x; asm volatile("" : "+v"(t_)); F.tid = t_; F.lane = t_ & 63; F.wave = __builtin_amdgcn_readfirstlane(t_ >> 6); } while (0)
#define SEAM(k) do { if (IN(k) && IN((k) + 1)) xcd_barrier(bar); } while (0)
#define REPS(bit, idem) (((REPMASK & (bit)) && (idem)) ? NREP : 1)

    if (IN(PH_PROLOGUE) && !(SKIPMASK & 1)) for (int rep = 0; rep < REPS(1, true); ++rep) { REFRESH(); phase_prologue(F, args); } SEAM(PH_PROLOGUE);
    if (IN(PH_N1) && !(SKIPMASK & 2)) for (int rep = 0; rep < REPS(2, true); ++rep) { REFRESH(); phase_n1_first(F, args); } SEAM(PH_N1);
    for (int l = 0; l < DEPTH; ++l) {
        const int p0 = PH_LAYER0 + l * PH_PER_LAYER;
        if (IN(p0 + 0) && !(SKIPMASK & 4)) for (int rep = 0; rep < REPS(4, l == 0); ++rep) {
            { pg8::DenseOrder S; S.init(T, 2560, F.G, ({ int b_ = (int)blockIdx.x; asm volatile("" : "+s"(b_)); b_; }));
              EpiProj E{WSP(bf16_t, WS_UG), WSP(bf16_t, WS_VG), WSP(bf16_t, WS_Q), WSP(bf16_t, WS_KC), WSP(bf16_t, WS_VC), WSP(bf16_t, WS_KS), WSP(bf16_t, WS_KW), WSP(bf16_t, WS_VST), WSP(bf16_t, WS_VWT),
                        WSP(float, WS_GATES), WSP(float, WS_ROPE), F.ctl + CW_KMAX + l * 16, 0};
              pg8::gemm_phase<EpiProj, pg8::DenseOrder, false, true, true>(F.lds, WSP(bf16_t, WS_H8), (const bf16_t*)(WSP(unsigned char, WS_WIN8) + (size_t)l * 2560 * 1024), 512, S, E); }
        }
        SEAM(p0 + 0);
        if (IN(p0 + 1) && !(SKIPMASK & 8)) for (int rep = 0; rep < REPS(8, l == 0); ++rep) { REFRESH();
            for (int it = F.vcu; it < 256; it += F.G) { if (it < 128) sgu_item(F, args, l, it); else { compress_item(F, args, l, 2 * (it - 128)); compress_item(F, args, l, 2 * (it - 128) + 1); } }
        }
        SEAM(p0 + 1);
        if (IN(p0 + 2) && !(SKIPMASK & 16)) for (int rep = 0; rep < REPS(16, l == 0); ++rep) { REFRESH();
            att::Ptrs P{WSP(bf16_t, WS_Q), WSP(bf16_t, WS_KS), WSP(bf16_t, WS_KW), WSP(bf16_t, WS_VST), WSP(bf16_t, WS_VWT), WSP(bf16_t, WS_KCMP), WSP(bf16_t, WS_VCT), WSP(float, WS_GATES), WSP(bf16_t, WS_Y), WSP(float, WS_YPART), 0.f};
            for (int it = F.vcu; it < 512; it += F.G) {
                const int uu = (it < 256) ? it : (767 - it);
                const int bg = uu >> 7, qb = uu & 127;
                const unsigned* km = F.ctl + CW_KMAX + l * 16 + bg;
                P.kmax = sqrtf(__uint_as_float(__hip_atomic_load(km, __ATOMIC_RELAXED, __HIP_MEMORY_SCOPE_AGENT)));
                P.vmax = __uint_as_float(__hip_atomic_load(km + 4, __ATOMIC_RELAXED, __HIP_MEMORY_SCOPE_AGENT));
                P.kwmax = sqrtf(__uint_as_float(__hip_atomic_load(km + 8, __ATOMIC_RELAXED, __HIP_MEMORY_SCOPE_AGENT)));
                P.kcmax = sqrtf(__uint_as_float(__hip_atomic_load(km + 12, __ATOMIC_RELAXED, __HIP_MEMORY_SCOPE_AGENT)));
                att::attn_unit(F, P, bg >> 1, bg & 1, qb);
            }
        }
        SEAM(p0 + 2);
        if (IN(p0 + 3) && !(SKIPMASK & 32)) for (int rep = 0; rep < REPS(32, l == 0); ++rep) {
            pg8::DenseOrder S; S.init(T, DM, F.G, ({ int b_ = (int)blockIdx.x; asm volatile("" : "+s"(b_)); b_; }));
            EpiOut E{l == 0 ? INP(args, float, I_X) : WSP(float, WS_XR), WSP(float, WS_XR), (const float*)(F.ctl + CW_MOD) + (size_t)l * 2 * 6144};
            pg8::gemm_phase<EpiOut, pg8::DenseOrder, false, true>(F.lds, WSP(bf16_t, WS_Y), WSP(bf16_t, WS_WOUT) + (size_t)l * 1024 * 1024, 1024, S, E);
        }
        SEAM(p0 + 3);
        if (IN(p0 + 4) && !(SKIPMASK & 64)) for (int rep = 0; rep < REPS(64, l == 0); ++rep) { REFRESH(); phase_n2(F, args, l); }
        SEAM(p0 + 4);
        if (IN(p0 + 5) && !(SKIPMASK & 64)) for (int rep = 0; rep < REPS(1024, l == 0); ++rep) { REFRESH(); phase_n2b(F, l); }
        SEAM(p0 + 5);
        if (IN(p0 + 6) && !(SKIPMASK & 128)) for (int rep = 0; rep < REPS(128, l == 0); ++rep) { REFRESH();
            int total; moe_tables(F, l, 8, total);
            LAS int* ust = (LAS int*)(F.lds + MOE_OFF);
            pg8::MoeOrder S{ust, ust + 33, ust + 66, WSP(int, WS_TOK), 8, F.G, F.vcu, total, 1024};
            EpiSwiglu E{WSP(unsigned char, WS_ACT), INP(args, float, I_EB1) + (size_t)l * NE * 2048};
            pg8::gemm_phase<EpiSwiglu, pg8::MoeOrder, true, true, true>(F.lds, WSP(bf16_t, WS_H8), (const bf16_t*)(WSP(unsigned char, WS_W1T) + (size_t)l * NE * 2048 * 1024), 512, S, E);
        }
        SEAM(p0 + 6);
        if (IN(p0 + 7) && !(SKIPMASK & 256)) for (int rep = 0; rep < REPS(256, l == 0); ++rep) { REFRESH();
            int total; moe_tables(F, l, 4, total);
            LAS int* ust = (LAS int*)(F.lds + MOE_OFF);
            pg8::MoeOrder S{ust, ust + 33, ust + 66, WSP(int, WS_TOK), 4, F.G, F.vcu, total, 1024};
            EpiDown E{WSP(unsigned char, WS_YROWS), INP(args, float, I_EB2) + (size_t)l * NE * 1024};
            pg8::gemm_phase<EpiDown, pg8::MoeOrder, false, true, true>(F.lds, WSP(bf16_t, WS_ACT), (const bf16_t*)(WSP(unsigned char, WS_W2T) + (size_t)l * NE * 1024 * 1024), 512, S, E);
        }
        SEAM(p0 + 7);
        if (IN(p0 + 8) && !(SKIPMASK & 512)) for (int rep = 0; rep < REPS(512, l == DEPTH - 1); ++rep) { REFRESH(); phase_combine(F, args, l); }
        if (l + 1 < DEPTH) SEAM(p0 + 8);
    }
#undef IN
#undef SEAM
}

extern "C" void kernel_launch(void* const* d_in, const int* in_sizes, int n_in, void* d_out, int out_size, void* d_ws, size_t ws_size, hipStream_t stream) {
    static int grid = 0;
    if (grid == 0) {
        if (n_in != 26 || out_size != T * DM || ws_size < WS_END) { fprintf(stderr, "kernel_launch: unexpected problem (n_in %d, out %d, ws %zu; need ws >= %zu)\n", n_in, out_size, ws_size, (size_t)WS_END); grid = -1; return; }
        int dev = 0, cus = 0, per_cu = 0;
        if (hipGetDevice(&dev) != hipSuccess || hipDeviceGetAttribute(&cus, hipDeviceAttributeMultiprocessorCount, dev) != hipSuccess) { grid = -1; return; }
        if (hipFuncSetAttribute((const void*)fwd_kernel, hipFuncAttributeMaxDynamicSharedMemorySize, LDS_BYTES) != hipSuccess) { fprintf(stderr, "kernel_launch: hipFuncSetAttribute failed\n"); grid = -1; return; }
        if (hipOccupancyMaxActiveBlocksPerMultiprocessor(&per_cu, (const void*)fwd_kernel, NTHREADS, LDS_BYTES) != hipSuccess || per_cu < 1) { fprintf(stderr, "kernel_launch: occupancy query says %d\n", per_cu); (void)hipGetLastError(); per_cu = 1; }
        grid = cus;
    }
    if (grid < 0) return;
    if (hipMemsetAsync((char*)d_ws + WS_CTL, 0, CTL_ZERO_BYTES, stream) != hipSuccess) { fprintf(stderr, "kernel_launch: memset failed\n"); return; }
    Args a{};
    for (int i = 0; i < 26; ++i) a.in[i] = d_in[i];
    a.out = (float*)d_out; a.ws = (unsigned char*)d_ws;
#if MK_PER_PHASE
    for (int p = 0; p < NPHASES; ++p) { a.ph_lo = p; a.ph_hi = p + 1; a.li = 0;
        hipLaunchKernelGGL(fwd_kernel, dim3(grid), dim3(NTHREADS), LDS_BYTES, stream, a); }
#else
    a.ph_lo = 0; a.ph_hi = NPHASES; a.li = 0;
    void* kargs[] = {&a};
    hipError_t e = hipLaunchCooperativeKernel((const void*)fwd_kernel, dim3(grid), dim3(NTHREADS), kargs, LDS_BYTES, stream);
    if (e != hipSuccess) fprintf(stderr, "kernel_launch: cooperative launch failed: %s (grid %d)\n", hipGetErrorString(e), grid);
#endif
}
```

```cpp
#include <hip/hip_runtime.h>
#include <cstdio>
#include <cstdint>

#ifndef SKIPMASK
#define SKIPMASK 0
#endif
#ifndef REPMASK
#define REPMASK 0
#endif
#ifndef NREP
#define NREP 3
#endif
#ifndef DUMMYINT
#define DUMMYINT 0
#endif
#ifndef ATTREP
#define ATTREP 0
#endif
#ifndef MK_PER_PHASE
#define MK_PER_PHASE 0
#endif

#define LAS __attribute__((address_space(3)))
typedef unsigned short bf16_t;
typedef short bf16x8 __attribute__((ext_vector_type(8)));
typedef float f32x4 __attribute__((ext_vector_type(4)));
typedef float f32x2 __attribute__((ext_vector_type(2)));
typedef float f32x16 __attribute__((ext_vector_type(16)));
typedef unsigned u32x4 __attribute__((ext_vector_type(4)));
typedef unsigned u32x2 __attribute__((ext_vector_type(2)));
typedef __bf16 bf16x2_t __attribute__((ext_vector_type(2)));
typedef int i32x4 __attribute__((ext_vector_type(4)));
typedef int i32x8 __attribute__((ext_vector_type(8)));

constexpr int BATCH = 2, SEQ = 8192, DM = 1024, T = BATCH * SEQ, DEPTH = 2;
constexpr int PIN = 2328, PINP = 2560;
constexpr int NE = 32, FF = 1024, TOPK = 4;
constexpr int NCMP = 511, NCMPP = 512;
constexpr float NORM_EPS = 1e-6f;
constexpr float W8SCALE = 64.f;
constexpr int W8_E8M0 = 0x79797979, ONE_E8M0 = 0x7f7f7f7f;
constexpr float QSCALE = 0.125f * 1.4426950408889634f;
constexpr int NWAVES = 8, NTHREADS = 512;

constexpr size_t MiB = 1u << 20;
constexpr size_t WS_CTL = 0, CTL_ZERO_BYTES = 1 * MiB;
constexpr size_t WS_WIN = 1 * MiB;
constexpr size_t WS_WOUT = 11 * MiB;
constexpr size_t WS_SGW = 15 * MiB;
constexpr size_t WS_CW1 = 15 * MiB + 512 * 1024;
constexpr size_t WS_ROPE = 17 * MiB;
constexpr size_t WS_RWP = 21 * MiB;
constexpr size_t WS_MISC = 21 * MiB + 512 * 1024;
constexpr size_t WS_W1T = 32 * MiB;
constexpr size_t WS_W2T = 288 * MiB;
constexpr size_t WS_XR = 416 * MiB;
constexpr size_t WS_H = 480 * MiB;
constexpr size_t WS_UG = 513 * MiB, WS_VG = 529 * MiB, WS_Q = 545 * MiB;
constexpr size_t WS_KC = 561 * MiB, WS_VC = 565 * MiB, WS_KS = 569 * MiB, WS_KW = 573 * MiB;
constexpr size_t WS_VST = 577 * MiB, WS_VWT = 581 * MiB;
constexpr size_t WS_GATES = 585 * MiB;
constexpr size_t WS_KCMP = 587 * MiB;
constexpr size_t WS_VCT = 587 * MiB + 512 * 1024;
constexpr size_t WS_Y = 588 * MiB;
constexpr size_t WS_TOK = 620 * MiB;
constexpr size_t WS_ASG = 622 * MiB;
constexpr size_t WS_GATE4 = 622 * MiB + 512 * 1024;
constexpr size_t WS_YPART = 912 * MiB;
constexpr size_t WS_CNTI = 623 * MiB;
constexpr size_t WS_ACT = 624 * MiB;
constexpr size_t WS_YROWS = 768 * MiB;
constexpr size_t WS_WIN8 = 962 * MiB;
constexpr size_t WS_H8 = 944 * MiB;
constexpr size_t WS_END = 968 * MiB;
constexpr int CW_BAR = 4096;
constexpr int CW_MOD = 16384;
constexpr int CW_CNT = 40960;
constexpr int CW_KMAX = 41088;
constexpr int CW_GCNT = 41216;

__device__ __forceinline__ unsigned cvtpk(float lo, float hi) { f32x2 v = {lo, hi}; bf16x2_t b = __builtin_convertvector(v, bf16x2_t); return __builtin_bit_cast(unsigned, b); }
__device__ __forceinline__ unsigned cvt4_fp8(float a, float b, float c, float d) { int w = 0; w = __builtin_amdgcn_cvt_pk_fp8_f32(a, b, w, false); w = __builtin_amdgcn_cvt_pk_fp8_f32(c, d, w, true); return (unsigned)w; }
__device__ __forceinline__ float bf2f(unsigned short b) { return __uint_as_float((unsigned)b << 16); }
__device__ __forceinline__ float bflo(unsigned w) { return __uint_as_float(w << 16); }
__device__ __forceinline__ float bfhi(unsigned w) { return __uint_as_float(w & 0xffff0000u); }
__device__ __forceinline__ float fast_exp2(float x) { return __builtin_amdgcn_exp2f(x); }
__device__ __forceinline__ float fast_rcp(float x) { return __builtin_amdgcn_rcpf(x); }
__device__ __forceinline__ float sigmoidf_(float x) { return fast_rcp(1.f + fast_exp2(-1.4426950408889634f * x)); }
__device__ __forceinline__ float gelu_tanh(float x) { const float u = 0.7978845608028654f * (x + 0.044715f * x * x * x); return x * fast_rcp(1.f + fast_exp2(-2.885390081777927f * u)); }

typedef float f32x2_t __attribute__((ext_vector_type(2)));
__device__ __forceinline__ f32x2_t gelu_tanh2(f32x2_t x) {
    const f32x2_t t = x * x; const f32x2_t p = __builtin_elementwise_fma(t, (f32x2_t){-0.10294324f, -0.10294324f}, (f32x2_t){-2.3022082f, -2.3022082f}); const f32x2_t z = x * p;
    const f32x2_t d = (f32x2_t){fast_exp2(z.x), fast_exp2(z.y)} + 1.f; return x * (f32x2_t){fast_rcp(d.x), fast_rcp(d.y)};
}
__device__ __forceinline__ int cvt_flr(float x) { int r; asm("v_cvt_flr_i32_f32 %0, %1" : "=v"(r) : "v"(x)); return r; }
__device__ __forceinline__ float x16_sum(float x) { auto r = __builtin_amdgcn_permlane16_swap(__float_as_uint(x), __float_as_uint(x), false, false); return __uint_as_float(r[0]) + __uint_as_float(r[1]); }
__device__ __forceinline__ float x32_sum(float x) { auto r = __builtin_amdgcn_permlane32_swap(__float_as_uint(x), __float_as_uint(x), false, false); return __uint_as_float(r[0]) + __uint_as_float(r[1]); }
__device__ __forceinline__ float x16_max(float x) { auto r = __builtin_amdgcn_permlane16_swap(__float_as_uint(x), __float_as_uint(x), false, false); return fmaxf(__uint_as_float(r[0]), __uint_as_float(r[1])); }
__device__ __forceinline__ float x32_max(float x) { auto r = __builtin_amdgcn_permlane32_swap(__float_as_uint(x), __float_as_uint(x), false, false); return fmaxf(__uint_as_float(r[0]), __uint_as_float(r[1])); }
__device__ __forceinline__ float kg_sum(float x) { return x32_sum(x16_sum(x)); }
__device__ __forceinline__ float kg_max(float x) { return x32_max(x16_max(x)); }
__device__ __forceinline__ float quad_sum(float x) { x += __uint_as_float(__builtin_amdgcn_update_dpp(0u, __float_as_uint(x), 0xB1, 0xF, 0xF, true)); x += __uint_as_float(__builtin_amdgcn_update_dpp(0u, __float_as_uint(x), 0x4E, 0xF, 0xF, true)); return x; }
__device__ __forceinline__ float wave_sum(float v) {
    v = quad_sum(v);
    v += __uint_as_float(__builtin_amdgcn_update_dpp(0u, __float_as_uint(v), 0x141, 0xF, 0xF, true));
    v += __uint_as_float(__builtin_amdgcn_update_dpp(0u, __float_as_uint(v), 0x140, 0xF, 0xF, true));
    return x32_sum(x16_sum(v));
}
#define LDS_WAIT() asm volatile("s_waitcnt lgkmcnt(0)" ::: "memory")
#define VM_WAIT() asm volatile("s_waitcnt vmcnt(0)" ::: "memory")

__device__ __forceinline__ int kfrag_off(int key, int c8) {
    const int s = key >> 5, ko = key & 31, u = (ko >> 2) & 1, r16 = ((ko >> 3) << 2) | (ko & 3), ks = c8 >> 2, kg = c8 & 3;
    return s * 2048 + (u * 2 + ks) * 512 + (kg * 16 + r16) * 8;
}
__device__ __forceinline__ int vfrag_off(int key, int d) {
    const int s = key >> 5, ko = key & 31;
    return s * 2048 + (d >> 4) * 512 + ((ko >> 3) * 16 + (d & 15)) * 8 + (ko & 7);
}
namespace pg8 {
constexpr int BM = 256, BK = 64, HALF = 128, HTB = HALF * BK * 2, STAGE_BYTES = 8 * HTB, NXCD = 8, WGM = 4;
__host__ __device__ __forceinline__ int lds_byte(int r, int c) { const int st = (r >> 4) * 2 + (c >> 5), rr = r & 15, cc = c & 31, ob = rr * 64 + cc * 2; return st * 1024 + (ob ^ (((ob >> 9) & 1) << 5)); }
__host__ __device__ __forceinline__ void stage_rc(int b, int& R, int& C) { const int st = b / 1024, sb = b % 1024, swz = sb ^ (((sb >> 9) & 1) << 5); R = (st >> 1) * 16 + swz / 64; C = (st & 1) * 32 + (swz % 64) / 2; }
__host__ __device__ __forceinline__ int perm32(int rho) { const int n = rho >> 4, i = rho & 15; return 8 * (i >> 2) + 4 * n + (i & 3); }

struct Unit { int pm, pn, e, pnl, rloc, hs, rot; };

__device__ __forceinline__ bool unit_index(int i, int G, int c, int total, int& L, int& hs) {
    const int nfr = total / G, R = total - nfr * G; hs = 0;
    if (i < nfr) { L = i * G + c; return true; }
    if (i > nfr || R == 0) return false;
    if (2 * R <= G) { if (c >= 2 * R) return false; const int h = c >= R ? 1 : 0; L = nfr * G + c - h * R; hs = 1 + h; return true; }
    if (c >= R) return false;
    L = nfr * G + c; return true;
}

struct DenseOrder {
    static constexpr bool SPLIT = false;
    int nM, nN, nwg, G, c;
    __device__ void init(int M, int N, int G_, int c_) { nM = M / BM; nN = N / BM; nwg = nM * nN; G = G_; c = c_; }
    __device__ bool next(int i, Unit& u) const {
        const long L = (long)i * G + c; if (L >= nwg) return false;
        u.hs = 0; int wgid = (int)L; { const int q = nwg / NXCD, r = nwg % NXCD, xcd = wgid % NXCD, off = wgid / NXCD; wgid = (xcd < r ? xcd * (q + 1) : r * (q + 1) + (xcd - r) * q) + off; }
        const int nig = WGM * nN, gid = wgid / nig, fm = gid * WGM, gsz = (nM - fm) < WGM ? (nM - fm) : WGM;
        u.pm = fm + ((wgid % nig) % gsz); u.pn = (wgid % nig) / gsz; u.e = 0; u.pnl = u.pn; u.rloc = 0; u.rot = (u.pm + u.pn) & 3; return true;
    }
    __device__ __forceinline__ unsigned rowoff(const Unit&, int) const { return 0u; }
};

struct MoeOrder {
    static constexpr bool SPLIT = true;
    const LAS int* ust;
    const LAS int* bst;
    const LAS int* cnt;
    const int* tok;
    int NT, G, c, total, rowbytes;
    __device__ bool next(int i, Unit& u) const {
        int L, hs; if (!unit_index(i, G, c, total, L, hs)) return false;
        u.hs = hs; int e = 0;
        for (int k = 1; k < NE; ++k) e += (L >= ust[k]) ? 1 : 0;
        e = __builtin_amdgcn_readfirstlane(e);
        const int loc = __builtin_amdgcn_readfirstlane(L - ust[e]), b0 = __builtin_amdgcn_readfirstlane(bst[e]), nb = __builtin_amdgcn_readfirstlane(bst[e + 1]) - b0;
        u.e = e; u.pnl = loc / nb; u.rloc = loc - u.pnl * nb; u.pm = b0 + u.rloc; u.pn = e * NT + u.pnl; u.rot = (u.rloc + u.pnl) & 3; return true;
    }
    __device__ __forceinline__ unsigned rowoff(const Unit& u, int r) const {
        const int slot = u.rloc * 256 + r + (u.hs == 2 ? 128 : 0); const int tk = slot < cnt[u.e] ? tok[u.e * 16384 + slot] : T;
        return (unsigned)tk * (unsigned)rowbytes;
    }
};

template <class Epi, class Sched, bool GATHER, bool ALIGN_EPI, bool FP8 = false>
__device__ __forceinline__ void gemm_phase(LAS unsigned char* lds, const bf16_t* A, const bf16_t* Bt, const int K, const Sched& S, const Epi& E) {
    int tid_ = threadIdx.x; asm volatile("" : "+v"(tid_));
    const int tid = tid_, wid = __builtin_amdgcn_readfirstlane(tid >> 6), lane = tid & 63, wr = wid >> 2, wc = wid & 3, fr = lane & 15, fq = lane >> 4;
    const int nt = K / BK;
    unsigned voffB[2];
#pragma unroll
    for (int i = 0; i < 2; ++i) { int R, C; stage_rc(tid * 16 + i * 8192, R, C); const int Rb = Epi::PERM ? ((R & ~31) + perm32(R & 31)) : R; voffB[i] = (unsigned)(Rb * K + C) * 2u; }
    const size_t kstep = (size_t)(BK * 2);
    const size_t hstep = (size_t)HALF * K * 2;
    const size_t tstep = 2 * hstep;
    const unsigned ldsw = (unsigned)wid * 1024u;
    const int aoff = lds_byte(wr * 64 + fr, fq * 8), boff = lds_byte(wc * 32 + fr, fq * 8);
#define PG8_SA(b, h) (((b) * 2 + (h)) * HTB)
#define PG8_SB(b, h) ((4 + (b) * 2 + (h)) * HTB)
#define PG8_STAGE(bufoff, gbase, v0, v1) do { \
        __builtin_amdgcn_global_load_lds((const unsigned*)((const char*)(gbase) + (v0)), (LAS unsigned*)(lds + (bufoff) + ldsw), 16, 0, 0); \
        __builtin_amdgcn_global_load_lds((const unsigned*)((const char*)(gbase) + (v1)), (LAS unsigned*)(lds + (bufoff) + ldsw + 8192), 16, 0, 0); } while (0)
#define PG8_STAGEB(bufoff, gbase) PG8_STAGE(bufoff, gbase, voffB[0], voffB[1])
#define PG8_CAT8(x0, x1) __builtin_shufflevector(x0, x1, 0, 1, 2, 3, 4, 5, 6, 7)
#define PG8_RD4(off) (*(const LAS i32x4*)(lds + (off)))
#define PG8_LDA(dst, b, h) do { if constexpr (FP8) { _Pragma("unroll") for (int m = 0; m < 4; ++m) dst##8[m] = PG8_CAT8(PG8_RD4(PG8_SA(b, h) + aoff + m * 2048), PG8_RD4(PG8_SA(b, h) + aoff + m * 2048 + 1024)); } \
        else { _Pragma("unroll") for (int m = 0; m < 4; ++m) _Pragma("unroll") for (int k = 0; k < 2; ++k) dst[m][k] = *(const LAS bf16x8*)(lds + PG8_SA(b, h) + aoff + m * 2048 + k * 1024); } } while (0)
#define PG8_LDB(dst, b, h) do { if constexpr (FP8) { _Pragma("unroll") for (int n = 0; n < 2; ++n) dst##8[n] = PG8_CAT8(PG8_RD4(PG8_SB(b, h) + boff + n * 2048), PG8_RD4(PG8_SB(b, h) + boff + n * 2048 + 1024)); } \
        else { _Pragma("unroll") for (int n = 0; n < 2; ++n) _Pragma("unroll") for (int k = 0; k < 2; ++k) dst[n][k] = *(const LAS bf16x8*)(lds + PG8_SB(b, h) + boff + n * 2048 + k * 1024); } } while (0)
#define PG8_MMA(ai, bj, At, Bt_) do { __builtin_amdgcn_s_setprio(1); _Pragma("unroll") for (int m = 0; m < 4; ++m) _Pragma("unroll") for (int n = 0; n < 2; ++n) { \
        if constexpr (FP8) { asm volatile("v_mfma_scale_f32_16x16x128_f8f6f4 %0, %1, %2, %0, %3, %4 op_sel_hi:[0,0,0]" : "+v"(acc[ai][bj][m][n]) : "v"(Bt_##8[n]), "v"(At##8[m]), "v"(sc_w), "v"(sc_x)); } \
        else { _Pragma("unroll") for (int k = 0; k < 2; ++k) acc[ai][bj][m][n] = __builtin_amdgcn_mfma_f32_16x16x32_bf16(Bt_[n][k], At[m][k], acc[ai][bj][m][n], 0, 0, 0); } } \
        __builtin_amdgcn_s_setprio(0); } while (0)
#define PG8_WAIT_V(n) asm volatile("s_waitcnt vmcnt(" #n ")" ::: "memory")
#define PG8_WAIT_L(n) asm volatile("s_waitcnt lgkmcnt(" #n ")" ::: "memory")
#define PG8_BAR __builtin_amdgcn_s_barrier()
#define PG8_SCHED __builtin_amdgcn_sched_barrier(0)
#define PG8_SETV(v, u) do { int t2_ = tid; asm volatile("" : "+v"(t2_)); _Pragma("unroll") for (int i_ = 0; i_ < 2; ++i_) { int R_, C_; stage_rc(t2_ * 16 + i_ * 8192, R_, C_); _Pragma("unroll") for (int h_ = 0; h_ < 2; ++h_) \
        v[h_][i_] = GATHER ? (S.rowoff(u, R_ + HALF * h_) + (unsigned)C_ * 2u) : (unsigned)((R_ + HALF * h_) * K + C_) * 2u; } } while (0)
    Unit cur, nxt; int ui = 0;
    if (!S.next(0, cur)) return;
    unsigned vc[2][2], vn[2][2];
    PG8_SETV(vc, cur);
    f32x4 acc[2][2][4][2];
#pragma unroll
    for (int a = 0; a < 2; ++a)
#pragma unroll
        for (int b = 0; b < 2; ++b)
#pragma unroll
            for (int m = 0; m < 4; ++m)
#pragma unroll
                for (int n = 0; n < 2; ++n) acc[a][b][m][n] = (f32x4){0.f, 0.f, 0.f, 0.f};
    bf16x8 At[4][2], B0[2][2], B1[2][2]; i32x8 At8[4], B08[2], B18[2];
    int sc_w = W8_E8M0, sc_x = ONE_E8M0; asm volatile("" : "+v"(sc_w), "+v"(sc_x));
    const char* cA = GATHER ? (const char*)A : (const char*)A + (size_t)cur.pm * tstep + (cur.hs == 2 ? hstep : (size_t)0);
    const char* cB = (const char*)Bt + (size_t)cur.pn * tstep;
    const int nq = nt >> 2;
    { const size_t r0 = (size_t)(cur.rot * nq) * kstep;
    PG8_STAGEB(PG8_SB(0, 0), cB + r0); PG8_STAGEB(PG8_SB(0, 1), cB + r0 + hstep); PG8_STAGE(PG8_SA(0, 0), cA + r0, vc[0][0], vc[0][1]); PG8_STAGE(PG8_SA(0, 1), cA + r0, vc[1][0], vc[1][1]);
    if (wr == 1) PG8_BAR;
    PG8_WAIT_V(2); PG8_BAR;
    PG8_STAGEB(PG8_SB(1, 0), cB + r0 + kstep); PG8_STAGE(PG8_SA(1, 0), cA + r0 + kstep, vc[0][0], vc[0][1]); PG8_STAGEB(PG8_SB(1, 1), cB + r0 + hstep + kstep); }
    PG8_WAIT_V(6); PG8_BAR;
    for (;;) {
        if constexpr (Epi::BIAS) { if (wid < 4) __builtin_amdgcn_global_load_lds((const unsigned*)(E.bias_src(cur) + tid), (LAS unsigned*)(lds + 131072 + (ui & 1) * 1024 + wid * 256), 4, 0, 0); }
        const bool has_next = S.next(ui + 1, nxt);
        const char* nA = GATHER ? (const char*)A : (has_next ? (const char*)A + (size_t)nxt.pm * tstep + (nxt.hs == 2 ? hstep : (size_t)0) : cA);
        const bool full = !Sched::SPLIT || cur.hs == 0;
        const char* nB = has_next ? (const char*)Bt + (size_t)nxt.pn * tstep : cB;
        if constexpr (GATHER) { if (has_next) { PG8_SETV(vn, nxt); } else {
#pragma unroll
            for (int h_ = 0; h_ < 2; ++h_)
#pragma unroll
                for (int i_ = 0; i_ < 2; ++i_) vn[h_][i_] = vc[h_][i_]; } }
        const size_t rn = (size_t)((has_next ? nxt.rot : cur.rot) * nq) * kstep;
        int kp = cur.rot * nq;
#pragma nounroll
        for (int t = 0; t < nt; t += 2) {
            const bool last = (t == nt - 2);
            int kn = kp + 2; kn = kn >= nt ? kn - nt : kn;
            const char* a1 = cA + (size_t)(kp + 1) * kstep;
            const char* a2 = last ? nA + rn : cA + (size_t)kn * kstep; const char* b2 = last ? nB + rn : cB + (size_t)kn * kstep; kp = kn;
            const char* a3 = a2 + kstep; const char* b3 = b2 + kstep;
            const unsigned w00 = (GATHER && last) ? vn[0][0] : vc[0][0], w01 = (GATHER && last) ? vn[0][1] : vc[0][1], w10 = (GATHER && last) ? vn[1][0] : vc[1][0], w11 = (GATHER && last) ? vn[1][1] : vc[1][1];
            PG8_LDB(B0, 0, 0); PG8_LDB(B1, 0, 1); PG8_SCHED; PG8_LDA(At, 0, 0); PG8_STAGE(PG8_SA(1, 1), a1, vc[1][0], vc[1][1]);
            PG8_WAIT_V(8); PG8_WAIT_L(0); PG8_BAR; PG8_MMA(0, 0, At, B0); PG8_MMA(0, 1, At, B1); PG8_BAR; PG8_SCHED;
            if (full) PG8_LDA(At, 0, 1); PG8_STAGEB(PG8_SB(0, 0), b2); PG8_STAGEB(PG8_SB(0, 1), b2 + hstep); PG8_STAGE(PG8_SA(0, 0), a2, w00, w01);
            PG8_WAIT_V(8); PG8_WAIT_L(0); PG8_BAR; if (full) { PG8_MMA(1, 0, At, B0); PG8_MMA(1, 1, At, B1); } PG8_BAR; PG8_SCHED;
            PG8_LDB(B0, 1, 0); PG8_LDB(B1, 1, 1); PG8_SCHED; PG8_LDA(At, 1, 0); PG8_STAGE(PG8_SA(0, 1), a2, w10, w11);
            PG8_WAIT_V(8); PG8_WAIT_L(0); PG8_BAR; PG8_MMA(0, 0, At, B0); PG8_MMA(0, 1, At, B1); PG8_BAR; PG8_SCHED;
            if (full) PG8_LDA(At, 1, 1); PG8_STAGEB(PG8_SB(1, 0), b3); PG8_STAGEB(PG8_SB(1, 1), b3 + hstep); PG8_STAGE(PG8_SA(1, 0), a3, w00, w01);
            PG8_WAIT_V(8); PG8_WAIT_L(0); PG8_BAR; if (full) { PG8_MMA(1, 0, At, B0); PG8_MMA(1, 1, At, B1); } PG8_BAR; PG8_SCHED;
        }
        if constexpr (FP8) { asm volatile("s_nop 15\n\ts_nop 15" ::: "memory"); }
        if constexpr (ALIGN_EPI) { if (wr == 0) PG8_BAR; }
        E(acc, cur, wr, wc, fr, fq, (const LAS float*)(lds + 131072 + (ui & 1) * 1024));
        if (!has_next) break;
#pragma unroll
        for (int a = 0; a < 2; ++a)
#pragma unroll
            for (int b = 0; b < 2; ++b)
#pragma unroll
                for (int m = 0; m < 4; ++m)
#pragma unroll
                    for (int n = 0; n < 2; ++n) acc[a][b][m][n] = (f32x4){0.f, 0.f, 0.f, 0.f};
        cur = nxt; cA = nA; cB = nB; ++ui;
        if constexpr (GATHER) {
#pragma unroll
        for (int h_ = 0; h_ < 2; ++h_)
#pragma unroll
            for (int i_ = 0; i_ < 2; ++i_) vc[h_][i_] = vn[h_][i_]; }
        if constexpr (ALIGN_EPI) { if (wr == 1) PG8_BAR; }
    }
    PG8_WAIT_V(0);
    if constexpr (!ALIGN_EPI) { if (wr == 0) PG8_BAR; }
    PG8_BAR;
#undef PG8_SA
#undef PG8_SB
#undef PG8_STAGE
#undef PG8_STAGEB
#undef PG8_LDA
#undef PG8_LDB
#undef PG8_MMA
#undef PG8_CAT8
#undef PG8_RD4
#undef PG8_WAIT_V
#undef PG8_WAIT_L
#undef PG8_BAR
#undef PG8_SCHED
#undef PG8_SETV
}
}

#define XB_TMO      128
#define XB_XCNT(j)  (256  + 64 * (j))
#define XB_XSUB(j)  (1280 + 64 * (j))
#define XB_XGEN(j)  (2304 + 64 * (j))
#define XB_TOP      3328
#define XB_TOPGEN   3392
#define XCD_BAR_WORDS 3456
#define XB_SPIN_CAP (1u << 22)
__device__ __forceinline__ unsigned xb_ld(unsigned* p)              { return __hip_atomic_load(p, __ATOMIC_RELAXED, __HIP_MEMORY_SCOPE_AGENT); }
__device__ __forceinline__ unsigned xb_add(unsigned* p, unsigned v) { return __hip_atomic_fetch_add(p, v, __ATOMIC_RELAXED, __HIP_MEMORY_SCOPE_AGENT); }
__device__ __forceinline__ unsigned xb_xcc_id() { return (unsigned)__builtin_amdgcn_s_getreg((3 << 11) | 20) & 0xFu; }
#define XB_SPIN(cond, bar) do { unsigned _sp = 0; while (cond) { __builtin_amdgcn_s_sleep(1); \
    if ((++_sp & 255u) == 0u) { if (xb_ld(&(bar)[XB_TMO])) break; if (_sp > XB_SPIN_CAP) { atomicAdd(&(bar)[XB_TMO], 1u); break; } } } } while (0)
struct XcdBarrier { unsigned* bar; unsigned x; volatile LAS unsigned* st; };
__device__ __forceinline__ XcdBarrier xcd_barrier_post(unsigned* bar, volatile LAS unsigned* st) {
    XcdBarrier b; b.bar = bar; b.x = xb_xcc_id(); b.st = st;
    if (threadIdx.x == 0) (void)xb_add(&bar[XB_XCNT(b.x)], 1u);
    return b;
}
__device__ __forceinline__ void xcd_barrier_complete(unsigned* bar, unsigned x, unsigned& nloc, unsigned& nx) {
    const unsigned G = gridDim.x * gridDim.y * gridDim.z;
    unsigned sum, cnt, mine, sp = 0u;
    for (;;) {
        sum = 0u; cnt = 0u; mine = 0u;
#pragma unroll
        for (unsigned j = 0; j < 16; ++j) { const unsigned c = xb_ld(&bar[XB_XCNT(j)]); sum += c; cnt += (c > 0u) ? 1u : 0u; mine = (j == x) ? c : mine; }
        if (sum == G) break;
        __builtin_amdgcn_s_sleep(1);
        if ((++sp & 255u) == 0u) { if (xb_ld(&bar[XB_TMO])) break; if (sp > XB_SPIN_CAP) { atomicAdd(&bar[XB_TMO], 1u); break; } }
    }
    nloc = mine > 0u ? mine : 1u; nx = cnt > 0u ? cnt : 1u;
}
__device__ __forceinline__ void xcd_barrier(const XcdBarrier& b) {
    asm volatile("s_waitcnt vmcnt(0)" ::: "memory");
    __syncthreads();
    if (threadIdx.x == 0) {
        unsigned* bar = b.bar;
        __builtin_amdgcn_s_waitcnt(0);
        unsigned nloc = b.st[0], nx = b.st[1];
        if (nloc == 0u) { xcd_barrier_complete(bar, b.x, nloc, nx); b.st[0] = nloc; b.st[1] = nx; }
        const unsigned old = xb_add(&bar[XB_XSUB(b.x)], 1u);
        const unsigned gen = old / nloc;
        if (old + 1u == (gen + 1u) * nloc) {
            __builtin_amdgcn_fence(__ATOMIC_RELEASE, "agent");
            asm volatile("s_waitcnt vmcnt(0)" ::: "memory");
            const unsigned og = xb_add(&bar[XB_TOP], 1u);
            const unsigned tg = og / nx;
            if (og + 1u == (tg + 1u) * nx) xb_add(&bar[XB_TOPGEN], 1u);
            else XB_SPIN(xb_ld(&bar[XB_TOPGEN]) == tg, bar);
            __builtin_amdgcn_fence(__ATOMIC_ACQUIRE, "agent");
            xb_add(&bar[XB_XGEN(b.x)], 1u);
            asm volatile("s_waitcnt vmcnt(0)" ::: "memory");
        } else {
            XB_SPIN(xb_ld(&bar[XB_XGEN(b.x)]) == gen, bar);
            __builtin_amdgcn_fence(__ATOMIC_ACQUIRE, "agent");
            asm volatile("s_waitcnt vmcnt(0)" ::: "memory");
        }
    }
    __syncthreads();
}

struct Args { const void* in[26]; float* out; unsigned char* ws; int ph_lo, ph_hi, li, pad; };
enum { I_X = 0, I_C, I_POS, I_ADAW, I_ADAB, I_N1G, I_N2G, I_WIN, I_WOUT, I_SGLNG, I_SGLNB, I_SGW, I_SGB, I_PEK, I_PEV, I_CW1K, I_CW2K, I_CW1V, I_CW2V, I_RW, I_RB, I_EW1, I_EB1, I_EW2, I_EB2, I_FING };

#define GAS1 __attribute__((address_space(1)))
#define INP(A_, T_, i_) ({ int ix_ = (i_); asm volatile("" : "+s"(ix_)); (const T_*)(const GAS1 T_*)(A_).in[ix_]; })
struct Frame {
    LAS unsigned char* lds;
    unsigned* ctl;
    unsigned char* ws;
    int tid, lane, wave, vcu, G;
};
#define WSP(type, off) ((type*)(F.ws + (off)))
#define MODP(l, b, part) ((const float*)(F.ctl + CW_MOD) + ((size_t)((l) * 2 + (b)) * 6 + (part)) * 1024)

constexpr int RING_BYTES = 131072;
constexpr int ATT_LDS_BYTES = 147456;
constexpr int LDSCTL_OFF = ATT_LDS_BYTES;
constexpr int MISC_OFF = LDSCTL_OFF + 320;
constexpr int MOE_OFF = MISC_OFF + 128;
constexpr int LDS_BYTES = 163840;

struct EpiProj {
    static constexpr bool PERM = true; static constexpr bool BIAS = false;
    bf16_t *UG, *VG, *Q, *KC, *VC, *KS, *KW, *VST, *VWT; float* GATES; const float* ROPE; unsigned* kmax; int pn_off;
    __device__ __forceinline__ void operator()(const f32x4 (&acc)[2][2][4][2], const pg8::Unit& u, int wr_, int wc_, int fr_, int fq_, const LAS float* lb_) const {
        int t_ = threadIdx.x; asm volatile("" : "+v"(t_)); const int wid_ = __builtin_amdgcn_readfirstlane(t_ >> 6); const int wr = wid_ >> 2, wc = wid_ & 3, fr = t_ & 15, fq = (t_ & 63) >> 4; (void)wr_; (void)wc_; (void)fr_; (void)fq_;
        const int pn = u.pn + pn_off; const int row0 = u.pm * 256 + (u.hs == 2 ? 128 : 0) + wr * 64 + fr; const int b = u.pm >> 5; const int nai = u.hs ? 1 : 2;
        if (pn < 4 || pn == 6) {
#pragma unroll
            for (int ai = 0; ai < 2; ++ai) if (ai < nai)
#pragma unroll
                for (int m = 0; m < 4; ++m) { const size_t r = (size_t)(row0 + ai * 128 + m * 16);
#pragma unroll
                    for (int bj = 0; bj < 2; ++bj) { f32x4 v0 = acc[ai][bj][m][0], v1 = acc[ai][bj][m][1];
                        if (pn < 4) {
#pragma unroll
                            for (int i = 0; i < 2; ++i) { const f32x2_t a_ = gelu_tanh2((f32x2_t){v0[2 * i], v0[2 * i + 1]}), b_ = gelu_tanh2((f32x2_t){v1[2 * i], v1[2 * i + 1]});
                                v0[2 * i] = a_.x; v0[2 * i + 1] = a_.y; v1[2 * i] = b_.x; v1[2 * i + 1] = b_.y; } }
                        u32x4 w; w.x = cvtpk(v0[0], v0[1]); w.y = cvtpk(v0[2], v0[3]); w.z = cvtpk(v1[0], v1[1]); w.w = cvtpk(v1[2], v1[3]);
                        bf16_t* dst;
                        if (pn < 2) dst = UG + r * 512 + pn * 256 + bj * 128 + wc * 32 + fq * 8;
                        else if (pn < 4) dst = VG + r * 512 + (pn - 2) * 256 + bj * 128 + wc * 32 + fq * 8;
                        else dst = (bj ? VC : KC) + r * 128 + wc * 32 + fq * 8;
                        *(u32x4*)dst = w; } }
        } else if (pn == 4 || pn == 5 || pn == 7) {
            const float sc = (pn == 7) ? 1.f : QSCALE; float nmax = 0.f;
#pragma unroll
            for (int ai = 0; ai < 2; ++ai) if (ai < nai)
#pragma unroll
                for (int m = 0; m < 4; ++m) { const size_t r = (size_t)(row0 + ai * 128 + m * 16);
                    const f32x4* cs = (const f32x4*)(ROPE + (r * 32 + fq * 8) * 2);
                    float o1[8], o2[8], nsq = 0.f;
#pragma unroll
                    for (int n = 0; n < 2; ++n) { const f32x4 c0 = cs[2 * n], c1 = cs[2 * n + 1]; const f32x4 x1 = acc[ai][0][m][n], x2 = acc[ai][1][m][n];
                        const float cc[4] = {c0[0], c0[2], c1[0], c1[2]}, ss[4] = {c0[1], c0[3], c1[1], c1[3]};
#pragma unroll
                        for (int i = 0; i < 4; ++i) { o1[4 * n + i] = (x1[i] * cc[i] - x2[i] * ss[i]) * sc; o2[4 * n + i] = (x2[i] * cc[i] + x1[i] * ss[i]) * sc; nsq += x1[i] * x1[i] + x2[i] * x2[i]; } }
                    u32x4 w1, w2; w1.x = cvtpk(o1[0], o1[1]); w1.y = cvtpk(o1[2], o1[3]); w1.z = cvtpk(o1[4], o1[5]); w1.w = cvtpk(o1[6], o1[7]);
                    w2.x = cvtpk(o2[0], o2[1]); w2.y = cvtpk(o2[2], o2[3]); w2.z = cvtpk(o2[4], o2[5]); w2.w = cvtpk(o2[6], o2[7]);
                    if (pn != 7) { bf16_t* dst = Q + r * 512 + (4 * (pn - 4) + wc) * 64 + fq * 8; *(u32x4*)dst = w1; *(u32x4*)(dst + 32) = w2; }
                    else { bf16_t* img = ((wc < 2) ? KS : KW) + (size_t)(b * 2 + (wc & 1)) * SEQ * 64; const int t = (int)r & (SEQ - 1);
                        *(u32x4*)(img + kfrag_off(t, fq)) = w1; *(u32x4*)(img + kfrag_off(t, 4 + fq)) = w2; }
                    nsq = kg_sum(nsq); nmax = fmaxf(nmax, nsq); asm volatile("" ::: "memory"); }
            if (pn == 7) {
#pragma unroll
                for (int o = 1; o < 16; o <<= 1) nmax = fmaxf(nmax, __shfl_xor(nmax, o));
                if ((threadIdx.x & 63) == 0) atomicMax(kmax + ((wc < 2) ? 0 : 8) + b * 2 + (wc & 1), __float_as_uint(nmax * 1.02f));
            }
        } else if (pn == 8) {
            const int g = wc >> 1; float vmx = 0.f;
#pragma unroll
            for (int ai = 0; ai < 2; ++ai) if (ai < nai)
#pragma unroll
                for (int m = 0; m < 4; ++m) { const int r = row0 + ai * 128 + m * 16; const int s = r & (SEQ - 1);
#pragma unroll
                    for (int bj = 0; bj < 2; ++bj) { bf16_t* img = (bj ? VWT : VST) + (size_t)(b * 2 + g) * SEQ * 64;
#pragma unroll
                        for (int n = 0; n < 2; ++n)
#pragma unroll
                            for (int i = 0; i < 4; ++i) { img[vfrag_off(s, (wc & 1) * 32 + fq * 8 + n * 4 + i)] = (bf16_t)(cvtpk(acc[ai][bj][m][n][i], 0.f) & 0xffffu); if (bj == 0) vmx = fmaxf(vmx, fabsf(acc[ai][0][m][n][i])); } } }
#pragma unroll
            for (int o = 1; o < 64; o <<= 1) vmx = fmaxf(vmx, __shfl_xor(vmx, o));
            if ((threadIdx.x & 63) == 0) atomicMax(kmax + 4 + b * 2 + g, __float_as_uint(vmx * 1.01f));
        } else {
            if (wc == 0 && fq < 3) {
#pragma unroll
                for (int ai = 0; ai < 2; ++ai) if (ai < nai)
#pragma unroll
                    for (int m = 0; m < 4; ++m) { const size_t r = (size_t)(row0 + ai * 128 + m * 16);
#pragma unroll
                        for (int n = 0; n < 2; ++n) { f32x4 v = acc[ai][0][m][n];
#pragma unroll
                            for (int i = 0; i < 4; ++i) v[i] = sigmoidf_(v[i]);
                            *(f32x4*)(GATES + r * 24 + fq * 8 + n * 4) = v; } }
            }
        }
    }
};
struct EpiOut {
    static constexpr bool PERM = false; static constexpr bool BIAS = false;
    const float* xin; float* xout; const float* g1;
    __device__ __forceinline__ void operator()(const f32x4 (&acc)[2][2][4][2], const pg8::Unit& u, int wr_, int wc_, int fr_, int fq_, const LAS float* lb_) const {
        int t_ = threadIdx.x; asm volatile("" : "+v"(t_)); const int wid_ = __builtin_amdgcn_readfirstlane(t_ >> 6); const int wr = wid_ >> 2, wc = wid_ & 3, fr = t_ & 15, fq = (t_ & 63) >> 4; (void)wr_; (void)wc_; (void)fr_; (void)fq_;
        const int row0 = u.pm * 256 + (u.hs == 2 ? 128 : 0) + wr * 64 + fr; const int b = u.pm >> 5; const int col0 = u.pn * 256 + wc * 32 + fq * 4; const int nai = u.hs ? 1 : 2;
        const float* gb = g1 + (size_t)b * 6144 + 2048;
        f32x4 gv[2][2];
#pragma unroll
        for (int bj = 0; bj < 2; ++bj)
#pragma unroll
            for (int n = 0; n < 2; ++n) gv[bj][n] = *(const f32x4*)(gb + col0 + bj * 128 + n * 16);
#pragma unroll
        for (int ai = 0; ai < 2; ++ai) if (ai < nai)
#pragma unroll
            for (int m = 0; m < 4; ++m) { const size_t off = (size_t)(row0 + ai * 128 + m * 16) * DM + col0;
#pragma unroll
                for (int bj = 0; bj < 2; ++bj)
#pragma unroll
                    for (int n = 0; n < 2; ++n) { const f32x4 xi = *(const f32x4*)(xin + off + bj * 128 + n * 16); *(f32x4*)(xout + off + bj * 128 + n * 16) = xi + gv[bj][n] * acc[ai][bj][m][n]; } }
    }
};
struct EpiSwiglu {
    static constexpr bool PERM = true; static constexpr bool BIAS = true;
    __device__ __forceinline__ const float* bias_src(const pg8::Unit& u) const { const int t_ = threadIdx.x; return b1 + (size_t)u.e * 2048 + u.pnl * 128 + ((t_ & 128) ? 896 : 0); }
    unsigned char* ACT; const float* b1;
    __device__ __forceinline__ void operator()(const f32x4 (&acc)[2][2][4][2], const pg8::Unit& u, int wr_, int wc_, int fr_, int fq_, const LAS float* lb_) const {
        int t_ = threadIdx.x; asm volatile("" : "+v"(t_)); const int wid_ = __builtin_amdgcn_readfirstlane(t_ >> 6); const int wr = wid_ >> 2, wc = wid_ & 3, fr = t_ & 15, fq = (t_ & 63) >> 4; (void)wr_; (void)wc_; (void)fr_; (void)fq_;
        const int row0 = u.pm * 256 + (u.hs == 2 ? 128 : 0) + wr * 64 + fr; const int j0 = u.pnl * 128 + wc * 32 + fq * 8; const int nai = u.hs ? 1 : 2;
        const LAS float* bb = lb_ + wc * 32 + fq * 8;
        f32x4 bg[2], bl[2];
#pragma unroll
        for (int n = 0; n < 2; ++n) { bg[n] = *(const LAS f32x4*)(bb + n * 4); bl[n] = *(const LAS f32x4*)(bb + 128 + n * 4) + 1.f; }
#pragma unroll
        for (int ai = 0; ai < 2; ++ai) if (ai < nai)
#pragma unroll
            for (int m = 0; m < 4; ++m) { float o[8];
#pragma unroll
                for (int n = 0; n < 2; ++n) { const f32x4 gl = acc[ai][0][m][n] + bg[n], ln = acc[ai][1][m][n] + bl[n];
#pragma unroll
                    for (int i = 0; i < 2; ++i) {
                        const f32x2_t gg = {fminf(gl[2 * i], 7.f), fminf(gl[2 * i + 1], 7.f)}, l1 = {__builtin_amdgcn_fmed3f(ln[2 * i], -6.f, 8.f), __builtin_amdgcn_fmed3f(ln[2 * i + 1], -6.f, 8.f)};
                        const f32x2_t z = gg * (-1.702f * 1.4426950408889634f); const f32x2_t d = (f32x2_t){fast_exp2(z.x), fast_exp2(z.y)} + 1.f;
                        const f32x2_t r = (gg * (f32x2_t){fast_rcp(d.x), fast_rcp(d.y)}) * l1; o[n * 4 + 2 * i] = r.x; o[n * 4 + 2 * i + 1] = r.y; } }
                u32x2 w; w.x = cvt4_fp8(o[0], o[1], o[2], o[3]); w.y = cvt4_fp8(o[4], o[5], o[6], o[7]);
                *(u32x2*)(ACT + (size_t)(row0 + ai * 128 + m * 16) * FF + j0) = w; }
    }
};
struct EpiDown {
    static constexpr bool PERM = true; static constexpr bool BIAS = true;
    __device__ __forceinline__ const float* bias_src(const pg8::Unit& u) const { return b2 + (size_t)u.e * 1024 + u.pnl * 256; }
    unsigned char* YR; const float* b2;
    __device__ __forceinline__ void operator()(const f32x4 (&acc)[2][2][4][2], const pg8::Unit& u, int wr_, int wc_, int fr_, int fq_, const LAS float* lb_) const {
        int t_ = threadIdx.x; asm volatile("" : "+v"(t_)); const int wid_ = __builtin_amdgcn_readfirstlane(t_ >> 6); const int wr = wid_ >> 2, wc = wid_ & 3, fr = t_ & 15, fq = (t_ & 63) >> 4; (void)wr_; (void)wc_; (void)fr_; (void)fq_;
        const int row0 = u.pm * 256 + (u.hs == 2 ? 128 : 0) + wr * 64 + fr; const int c0 = u.pnl * 256 + wc * 32 + fq * 8; const int nai = u.hs ? 1 : 2;
        const LAS float* bb = lb_ + wc * 32 + fq * 8;
        f32x4 bv[2][2];
#pragma unroll
        for (int bj = 0; bj < 2; ++bj)
#pragma unroll
            for (int n = 0; n < 2; ++n) bv[bj][n] = *(const LAS f32x4*)(bb + bj * 128 + n * 4);
#pragma unroll
        for (int ai = 0; ai < 2; ++ai) if (ai < nai)
#pragma unroll
            for (int m = 0; m < 4; ++m)
#pragma unroll
                for (int bj = 0; bj < 2; ++bj) { const f32x4 v0 = acc[ai][bj][m][0] + bv[bj][0], v1 = acc[ai][bj][m][1] + bv[bj][1];
                    u32x2 w; w.x = cvt4_fp8(v0[0], v0[1], v0[2], v0[3]); w.y = cvt4_fp8(v1[0], v1[1], v1[2], v1[3]);
                    *(u32x2*)(YR + (size_t)(row0 + ai * 128 + m * 16) * DM + c0 + bj * 128) = w; }
    }
};

__device__ __forceinline__ void tr_item(const float* W, int ldn, int k0, int c0, int nvalid, bf16_t* WT, int K, int drow0, LAS float* scr, int lane) {
    const int nn = lane & 31;
#pragma unroll 8
    for (int i = 0; i < 32; ++i) { const int kk = 2 * i + (lane >> 5); scr[kk * 33 + nn] = (nn < nvalid) ? W[(size_t)(k0 + kk) * ldn + c0 + nn] : 0.f; }
    LDS_WAIT(); asm volatile("" ::: "memory");
    const int c = lane & 7;
#pragma unroll
    for (int j = 0; j < 4; ++j) { const int n = (lane >> 3) + 8 * j; const LAS float* s = scr + (8 * c) * 33 + n;
        u32x4 o; o.x = cvtpk(s[0 * 33], s[1 * 33]); o.y = cvtpk(s[2 * 33], s[3 * 33]); o.z = cvtpk(s[4 * 33], s[5 * 33]); o.w = cvtpk(s[6 * 33], s[7 * 33]);
        *(u32x4*)(WT + (size_t)(drow0 + n) * K + k0 + 8 * c) = o; }
    LDS_WAIT(); asm volatile("" ::: "memory");
}
template <bool NTS> __device__ __forceinline__ void tr_item8(const float* W, int ldn, int k0, int c0, unsigned char* W8, int K, int drow0, LAS float* scr, int lane, int nvalid = 32) {
    const int nn = lane & 31;
#pragma unroll 32
    for (int i = 0; i < 32; ++i) { const int kk = 2 * i + (lane >> 5); scr[kk * 33 + nn] = (nn < nvalid) ? __builtin_nontemporal_load(W + (size_t)(k0 + kk) * ldn + c0 + nn) * W8SCALE : 0.f; }
    LDS_WAIT(); asm volatile("" ::: "memory");
    const int c = lane & 3;
#pragma unroll
    for (int j = 0; j < 2; ++j) { const int n = (lane >> 2) + 16 * j; const LAS float* s = scr + (16 * c) * 33 + n;
        u32x4 o; o.x = cvt4_fp8(s[0 * 33], s[1 * 33], s[2 * 33], s[3 * 33]); o.y = cvt4_fp8(s[4 * 33], s[5 * 33], s[6 * 33], s[7 * 33]);
        o.z = cvt4_fp8(s[8 * 33], s[9 * 33], s[10 * 33], s[11 * 33]); o.w = cvt4_fp8(s[12 * 33], s[13 * 33], s[14 * 33], s[15 * 33]);
        if (NTS) __builtin_nontemporal_store(o, (u32x4*)(W8 + (size_t)(drow0 + n) * K + k0 + 16 * c)); else *(u32x4*)(W8 + (size_t)(drow0 + n) * K + k0 + 16 * c) = o; }
    LDS_WAIT(); asm volatile("" ::: "memory");
}
template <bool W1MAP, bool NTS>
__device__ __forceinline__ void tr_block8(const float* W, int ldn, int k0, int c0, unsigned char* W8, int half, LAS unsigned char* img, int tid) {
    const int cg = tid & 255, ks = tid >> 8;
    const float* src = W + (size_t)k0 * ldn + c0 + 4 * cg;
    const int rot = 4 * ((cg >> 1) & 7);
#pragma unroll
    for (int sub = 0; sub < 4; ++sub) {
        f32x4 w[4][4];
#pragma unroll
        for (int i = 0; i < 4; ++i) { const int kq = ks + 2 * (sub * 4 + i);
#pragma unroll
            for (int r = 0; r < 4; ++r) w[i][r] = __builtin_nontemporal_load((const f32x4*)(src + (size_t)(4 * kq + r) * ldn)); }
#pragma unroll
        for (int i = 0; i < 4; ++i) { const int kq = ks + 2 * (sub * 4 + i);
#pragma unroll
            for (int j = 0; j < 4; ++j)
                *(LAS unsigned*)(img + (4 * cg + j) * 144 + (((kq + rot) & 31) << 2)) = cvt4_fp8(w[i][0][j] * W8SCALE, w[i][1][j] * W8SCALE, w[i][2][j] * W8SCALE, w[i][3][j] * W8SCALE); }
    }
    __syncthreads();
#pragma unroll 4
    for (int i = 0; i < 16; ++i) { const int n = (tid >> 3) + 64 * i, q = tid & 7;
        const u32x4 o = *(const LAS u32x4*)(img + n * 144 + (((4 * q + 4 * ((n >> 3) & 7)) & 31) << 2));
        const int drow = W1MAP ? ((n >> 7) * 256 + half * 128 + (n & 127)) : n;
        u32x4* dst = (u32x4*)(W8 + (size_t)drow * 1024 + k0 + 16 * q);
        if (NTS) __builtin_nontemporal_store(o, dst); else *dst = o; }
    __syncthreads();
}
__device__ __forceinline__ void win_src(int p, int& c0, int& nvalid) {
    const int pn = p >> 8; nvalid = 32;
    if (pn < 4 || pn == 6) { c0 = p; }
    else if (pn == 4 || pn == 5) { const int pp = p - 1024 - 256 * (pn - 4), bj = pp >> 7, j = pp & 127; c0 = 1024 + (4 * (pn - 4) + (j >> 5)) * 64 + bj * 32; }
    else if (pn == 7) { const int pp = p - 1792, bj = pp >> 7, j = pp & 127, which = j >> 6, g = (j >> 5) & 1; c0 = (which ? 2048 : 1792) + g * 64 + bj * 32; }
    else if (pn == 8) { const int pp = p - 2048, bj = pp >> 7, j = pp & 127; c0 = (bj ? 2176 : 1920) + j; }
    else { const int pp = p - 2304; c0 = 2304 + pp; nvalid = 24 - pp; nvalid = nvalid < 0 ? 0 : (nvalid > 32 ? 32 : nvalid); if (nvalid == 0) c0 = 0; }
}
__device__ __forceinline__ void phase_prologue(Frame& F, const Args& a) {
    LAS float* scr = (LAS float*)(F.lds + F.wave * 8704);
    const int gw = F.vcu * NWAVES + F.wave, NGW = F.G * NWAVES; const int lane = F.lane;
    {
        const float* c = INP(a, float, I_C); const float* adaw = INP(a, float, I_ADAW); const float* adab = INP(a, float, I_ADAB);
        float* mod = (float*)(F.ctl + CW_MOD);
        LAS float* red = (LAS float*)(F.lds + 8 * 8704);
        for (int it = F.vcu; it < 2 * 96; it += F.G) {
            const int l = it / 96, nb = it % 96;
            const float* wp = adaw + ((size_t)l * 1024 + F.wave * 128) * 6144 + nb * 64 + lane;
            float a0 = 0.f, a1 = 0.f;
#pragma unroll 32
            for (int k = 0; k < 128; ++k) { const float w = __builtin_nontemporal_load(wp + (size_t)k * 6144);
                const float c0 = c[F.wave * 128 + k], c1 = c[1024 + F.wave * 128 + k]; const float s0 = c0 * sigmoidf_(c0), s1 = c1 * sigmoidf_(c1);
                a0 += w * s0; a1 += w * s1; }
            red[(F.wave * 2 + 0) * 64 + lane] = a0; red[(F.wave * 2 + 1) * 64 + lane] = a1;
            __syncthreads();
            if (F.tid < 128) { const int b = F.tid >> 6, col = F.tid & 63; float sum = adab[(size_t)l * 6144 + nb * 64 + col];
#pragma unroll
              for (int ww = 0; ww < 8; ++ww) sum += red[(ww * 2 + b) * 64 + col];
              mod[((size_t)l * 2 + b) * 6144 + nb * 64 + col] = sum; }
            __syncthreads();
        }
    }
    {
        const float* win = INP(a, float, I_WIN);
        unsigned char* Win8 = WSP(unsigned char, WS_WIN8);
        for (int it = gw; it < 2 * 16 * 80; it += NGW) { const int l = it / 1280, kb = (it % 1280) / 80, nb = it % 80; int c0, nv; win_src(nb * 32, c0, nv);
            tr_item8<false>(win + (size_t)l * 1024 * PIN, PIN, kb * 64, c0, Win8 + (size_t)l * 2560 * 1024, 1024, nb * 32, scr, lane, nv); }
        const float* wout = INP(a, float, I_WOUT); bf16_t* WoutT = WSP(bf16_t, WS_WOUT);
        for (int it = gw; it < 2 * 16 * 32; it += NGW) { const int l = it / 512, kb = (it % 512) / 32, nb = it % 32;
            tr_item(wout + (size_t)l * 1024 * 1024, 1024, kb * 64, nb * 32, 32, WoutT + (size_t)l * 1024 * 1024, 1024, nb * 32, scr, lane); }
        bf16_t* CW1 = WSP(bf16_t, WS_CW1);
        for (int it = gw; it < 2 * 2 * 32 * 2; it += NGW) { const int l = it / 128, which = (it / 64) & 1, kb = (it % 64) / 2, nb = it & 1;
            const float* src = INP(a, float, which ? I_CW1V : I_CW1K) + (size_t)l * 2048 * 64;
            tr_item(src, 64, kb * 64, nb * 32, 32, CW1 + (size_t)(l * 2 + which) * 64 * 2048, 2048, nb * 32, scr, lane); }
        __syncthreads();
        const float* ew1 = INP(a, float, I_EW1); unsigned char* W1T = WSP(unsigned char, WS_W1T);
        for (int it = F.vcu; it < 2 * 32 * 8 * 2; it += F.G) { const int le = it >> 4, kb = (it >> 1) & 7, half = it & 1;
            if (le < 32) tr_block8<true, false>(ew1 + (size_t)le * 1024 * 2048, 2048, kb * 128, half * 1024, W1T + (size_t)le * 2048 * 1024, half, F.lds, F.tid);
            else tr_block8<true, true>(ew1 + (size_t)le * 1024 * 2048, 2048, kb * 128, half * 1024, W1T + (size_t)le * 2048 * 1024, half, F.lds, F.tid); }
        const float* ew2 = INP(a, float, I_EW2); unsigned char* W2T = WSP(unsigned char, WS_W2T);
        for (int it = F.vcu; it < 2 * 32 * 8; it += F.G) { const int le = it >> 3, kb = it & 7;
            if (le < 32) tr_block8<false, false>(ew2 + (size_t)le * 1024 * 1024, 1024, kb * 128, 0, W2T + (size_t)le * 1024 * 1024, 0, F.lds, F.tid);
            else tr_block8<false, true>(ew2 + (size_t)le * 1024 * 1024, 1024, kb * 128, 0, W2T + (size_t)le * 1024 * 1024, 0, F.lds, F.tid); }
    }
    {
        const int gt = (F.vcu * NWAVES + F.wave) * 64 + lane, NGT = NGW * 64;
        const float* sgw = INP(a, float, I_SGW); bf16_t* SGW = WSP(bf16_t, WS_SGW);
        for (int i = gt; i < 2 * 8 * 128 * 128; i += NGT) { const int s = i & 127, t = (i >> 7) & 127; SGW[i] = (bf16_t)(cvtpk(s <= t ? sgw[i] : 0.f, 0.f) & 0xffffu); }
        const int* pos = INP(a, int, I_POS); float* rope = WSP(float, WS_ROPE);
        for (int i = gt; i < T * 32; i += NGT) { const int tok = i >> 5, d = i & 31;
            const double inv = exp2(-(double)d * (13.287712379549449 / 32.0));
            const double rv = (double)pos[tok] * inv * 0.15915494309189535; const float fr = (float)(rv - __builtin_rint(rv));
            rope[2 * i] = __builtin_amdgcn_cosf(fr); rope[2 * i + 1] = __builtin_amdgcn_sinf(fr); }
        bf16_t* H = WSP(bf16_t, WS_H);
        for (int i = gt; i < 1024; i += NGT) { H[(size_t)T * 1024 + i] = 0; WSP(unsigned char, WS_H8)[(size_t)T * 1024 + i] = 0; }
        bf16_t* KCMP = WSP(bf16_t, WS_KCMP); bf16_t* VCT = WSP(bf16_t, WS_VCT);
        for (int i = gt; i < 2 * 2 * 64; i += NGT) { const int b = i >> 7, g = (i >> 6) & 1, d = i & 63; KCMP[(size_t)(b * 2 + g) * 512 * 64 + kfrag_off(511, d >> 3) + (d & 7)] = 0; VCT[(size_t)(b * 2 + g) * 512 * 64 + vfrag_off(511, d)] = 0; }
    }
    {
        float* cb = WSP(float, WS_MISC);
        for (int it = gw; it < 2 * 2 * 64; it += NGW) { const int l = it >> 7, which = (it >> 6) & 1, n = it & 63;
            const float* pe = INP(a, float, which ? I_PEV : I_PEK) + (size_t)l * 2048; const float* w1 = INP(a, float, which ? I_CW1V : I_CW1K) + (size_t)l * 2048 * 64;
            float s = 0.f; for (int k = lane; k < 2048; k += 64) s += pe[k] * w1[(size_t)k * 64 + n];
            s = wave_sum(s); if (lane == 0) cb[it] = s; }
    }
}

struct RowV { f32x4 v[4]; };
__device__ __forceinline__ RowV row_load(const float* p, int lane) { RowV r; const f32x4* q = (const f32x4*)p + lane;
#pragma unroll
    for (int j = 0; j < 4; ++j) r.v[j] = q[64 * j]; return r; }
__device__ __forceinline__ float row_ssq(const RowV& r) { float s = 0.f;
#pragma unroll
    for (int j = 0; j < 4; ++j) s += (r.v[j].x * r.v[j].x + r.v[j].y * r.v[j].y) + (r.v[j].z * r.v[j].z + r.v[j].w * r.v[j].w); return wave_sum(s); }
__device__ __forceinline__ void row_norm_store(const RowV& x, float rstd, const float* g, const float* sc, const float* sh, bf16_t* orow, int lane) {
    u32x2* o8 = (u32x2*)orow + lane;
#pragma unroll
    for (int j = 0; j < 4; ++j) { const f32x4 gg = ((const f32x4*)g)[lane + 64 * j], ss = ((const f32x4*)sc)[lane + 64 * j], hh = ((const f32x4*)sh)[lane + 64 * j];
        const f32x4 y = x.v[j] * rstd * gg * (ss + 1.f) + hh; u32x2 w; w.x = cvtpk(y.x, y.y); w.y = cvtpk(y.z, y.w); o8[64 * j] = w; }
}
__device__ __forceinline__ void quad_tr(unsigned (&a)[4], int lane) {
    const bool b0 = lane & 1, b1 = lane & 2;
    { const unsigned x = b0 ? a[0] : a[1]; const unsigned y = __builtin_amdgcn_update_dpp(0u, x, 0xB1, 0xF, 0xF, true); if (b0) a[0] = y; else a[1] = y; }
    { const unsigned x = b0 ? a[2] : a[3]; const unsigned y = __builtin_amdgcn_update_dpp(0u, x, 0xB1, 0xF, 0xF, true); if (b0) a[2] = y; else a[3] = y; }
    { const unsigned x = b1 ? a[0] : a[2]; const unsigned y = __builtin_amdgcn_update_dpp(0u, x, 0x4E, 0xF, 0xF, true); if (b1) a[0] = y; else a[2] = y; }
    { const unsigned x = b1 ? a[1] : a[3]; const unsigned y = __builtin_amdgcn_update_dpp(0u, x, 0x4E, 0xF, 0xF, true); if (b1) a[1] = y; else a[3] = y; }
}
__device__ __forceinline__ void row_norm_store8(const RowV& x, float rstd, const float* g, const float* sc, const float* sh, unsigned char* orow, int lane) {
    unsigned a[4];
#pragma unroll
    for (int j = 0; j < 4; ++j) { const f32x4 gg = ((const f32x4*)g)[lane + 64 * j], ss = ((const f32x4*)sc)[lane + 64 * j], hh = ((const f32x4*)sh)[lane + 64 * j];
        const f32x4 y = x.v[j] * rstd * gg * (ss + 1.f) + hh; a[j] = cvt4_fp8(y.x, y.y, y.z, y.w); }
    quad_tr(a, lane);
    *(u32x4*)(orow + 256 * (lane & 3) + 16 * (lane >> 2)) = (u32x4){a[0], a[1], a[2], a[3]};
}
__device__ __forceinline__ void row_norm_store8p(const RowV& x, float rstd, const f32x4 (&pa)[4], const f32x4 (&ph)[4], unsigned char* orow, int lane) {
    unsigned a[4];
#pragma unroll
    for (int j = 0; j < 4; ++j) { const f32x4 y = x.v[j] * rstd * pa[j] + ph[j]; a[j] = cvt4_fp8(y.x, y.y, y.z, y.w); }
    quad_tr(a, lane);
    *(u32x4*)(orow + 256 * (lane & 3) + 16 * (lane >> 2)) = (u32x4){a[0], a[1], a[2], a[3]};
}
__device__ __forceinline__ int expert_block_prefix(const unsigned* cnt, int lane) {
    int nb = (lane < NE) ? (int)((cnt[lane] + 255u) >> 8) : 0; int inc = nb;
#pragma unroll
    for (int o = 1; o < 32; o <<= 1) { const int t = __shfl_up(inc, o); if ((lane & 31) >= o) inc += t; }
    return inc - nb;
}
__device__ __forceinline__ void phase_n1_first(Frame& F, const Args& a) {
    const int gw = F.vcu * NWAVES + F.wave, NGW = F.G * NWAVES; const int lane = F.lane;
    const float* x = INP(a, float, I_X); const float* g = INP(a, float, I_N1G); bf16_t* H = WSP(bf16_t, WS_H); unsigned char* H8 = WSP(unsigned char, WS_H8);
    for (int m = gw; m < T; m += 2 * NGW) { const int m2 = m + NGW; const int b = m >> 13, b2 = m2 >> 13;
        const RowV r = row_load(x + (size_t)m * DM, lane); const RowV r2 = row_load(x + (size_t)m2 * DM, lane);
        const float rstd = 1.f / sqrtf(row_ssq(r) * (1.f / DM) + NORM_EPS), rstd2 = 1.f / sqrtf(row_ssq(r2) * (1.f / DM) + NORM_EPS);
        row_norm_store8(r, rstd, g, MODP(0, b, 1), MODP(0, b, 0), H8 + (size_t)m * DM, lane);
        row_norm_store8(r2, rstd2, g, MODP(0, b2, 1), MODP(0, b2, 0), H8 + (size_t)m2 * DM, lane); }
    float* RWP = WSP(float, WS_RWP); float* RBP = WSP(float, WS_MISC + 4096);
    const float* rw = INP(a, float, I_RW); const float* rb = INP(a, float, I_RB); const float* n2g = INP(a, float, I_N2G);
    const int gt = gw * 64 + lane, NGT = NGW * 64;
    for (int i = gt; i < 2 * 2 * 1024 * 32; i += NGT) { const int l = i >> 16, b = (i >> 15) & 1, k = (i >> 5) & 1023, e = i & 31;
        RWP[i] = n2g[l * 1024 + k] * (1.f + MODP(l, b, 4)[k]) * rw[((size_t)l * 1024 + k) * 32 + e]; }
    for (int it = gw; it < 2 * 2 * 32; it += NGW) { const int l = it >> 6, b = (it >> 5) & 1, e = it & 31; float s = 0.f;
        for (int k = lane; k < 1024; k += 64) s += MODP(l, b, 3)[k] * rw[((size_t)l * 1024 + k) * 32 + e];
        s = wave_sum(s); if (lane == 0) RBP[it] = s + rb[l * 32 + e]; }
}
__device__ __forceinline__ void phase_combine(Frame& F, const Args& a, int l) {
    const int gw = F.vcu * NWAVES + F.wave, NGW = F.G * NWAVES; const int lane = F.lane;
    float* XR = WSP(float, WS_XR); bf16_t* H = WSP(bf16_t, WS_H); const unsigned char* YR = WSP(unsigned char, WS_YROWS);
    const int* ASG = WSP(int, WS_ASG); const float* G4 = WSP(float, WS_GATE4);
    const int myprefix = expert_block_prefix(F.ctl + CW_CNT + l * 32, lane);
    const bool last = (l == DEPTH - 1);
    const float* g = last ? INP(a, float, I_FING) : INP(a, float, I_N1G) + (l + 1) * 1024;
#define COMB_LOAD(R_, WV_, GT_, M_, AS_, GTV_) do { const int4 as4_ = (AS_); const f32x4 gt4_ = (GTV_); \
        R_ = row_load(XR + (size_t)(M_) * DM, lane); const int asv_[4] = {as4_.x, as4_.y, as4_.z, as4_.w}; GT_[0] = gt4_.x; GT_[1] = gt4_.y; GT_[2] = gt4_.z; GT_[3] = gt4_.w; \
        _Pragma("unroll") for (int k = 0; k < 4; ++k) { const int e = asv_[k] >> 16, slot = asv_[k] & 0xffff; const int blk = __shfl(myprefix, e); \
            const unsigned* yr = (const unsigned*)(YR + ((size_t)blk * 256 + slot) * DM) + lane; _Pragma("unroll") for (int j = 0; j < 4; ++j) WV_[k][j] = __builtin_nontemporal_load(yr + 64 * j); } } while (0)
#define COMB_FINISH(R_, WV_, GT_, M_) do { const int b = (M_) >> 13; f32x4 y[4]; \
        _Pragma("unroll") for (int j = 0; j < 4; ++j) y[j] = (f32x4){0.f, 0.f, 0.f, 0.f}; \
        _Pragma("unroll") for (int k = 0; k < 4; ++k) _Pragma("unroll") for (int j = 0; j < 4; ++j) { const int w = (int)WV_[k][j]; const f32x2 lo_ = __builtin_amdgcn_cvt_pk_f32_fp8(w, false), hi_ = __builtin_amdgcn_cvt_pk_f32_fp8(w, true); y[j] += (f32x4){lo_.x, lo_.y, hi_.x, hi_.y} * GT_[k]; } \
        const float* g2 = MODP(l, b, 5); \
        _Pragma("unroll") for (int j = 0; j < 4; ++j) R_.v[j] += ((const f32x4*)g2)[lane + 64 * j] * y[j]; \
        const float rstd = 1.f / sqrtf(row_ssq(R_) * (1.f / DM) + NORM_EPS); \
        if (last) { f32x4* o = (f32x4*)(a.out + (size_t)(M_) * DM) + lane; _Pragma("unroll") for (int j = 0; j < 4; ++j) o[64 * j] = R_.v[j] * rstd * ((const f32x4*)g)[lane + 64 * j]; } \
        else { f32x4* xo = (f32x4*)(XR + (size_t)(M_) * DM) + lane; _Pragma("unroll") for (int j = 0; j < 4; ++j) xo[64 * j] = R_.v[j]; \
            row_norm_store8(R_, rstd, g, MODP(l + 1, b, 1), MODP(l + 1, b, 0), WSP(unsigned char, WS_H8) + (size_t)(M_) * DM, lane); } } while (0)
#define COMB_AS(AS_, GT_, M_) do { AS_ = *(const int4*)(ASG + (M_) * 4); GT_ = *(const f32x4*)(G4 + (M_) * 4); } while (0)
    const int TRIP = 2 * NGW;
    int4 asA0, asB0, asA1 = make_int4(0, 0, 0, 0), asB1 = make_int4(0, 0, 0, 0); f32x4 gtA0, gtB0, gtA1 = {0.f, 0.f, 0.f, 0.f}, gtB1 = {0.f, 0.f, 0.f, 0.f};
    RowV rA0, rB0, rA1, rB1; unsigned wA0[4][4], wB0[4][4], wA1[4][4], wB1[4][4]; float gA0[4], gB0[4], gA1[4], gB1[4];
    COMB_AS(asA0, gtA0, gw); COMB_AS(asB0, gtB0, gw + NGW);
    if (gw + TRIP < T) { COMB_AS(asA1, gtA1, gw + TRIP); COMB_AS(asB1, gtB1, gw + TRIP + NGW); }
    COMB_LOAD(rA0, wA0, gA0, gw, asA0, gtA0); COMB_LOAD(rB0, wB0, gB0, gw + NGW, asB0, gtB0);
    if (gw + 2 * TRIP < T) { COMB_AS(asA0, gtA0, gw + 2 * TRIP); COMB_AS(asB0, gtB0, gw + 2 * TRIP + NGW); }
    for (int m = gw; m < T; m += 2 * TRIP) {
        const int m1 = m + TRIP, m2 = m + 2 * TRIP;
        if (m1 < T) { COMB_LOAD(rA1, wA1, gA1, m1, asA1, gtA1); COMB_LOAD(rB1, wB1, gB1, m1 + NGW, asB1, gtB1);
            if (m1 + 2 * TRIP < T) { COMB_AS(asA1, gtA1, m1 + 2 * TRIP); COMB_AS(asB1, gtB1, m1 + 2 * TRIP + NGW); } }
        COMB_FINISH(rA0, wA0, gA0, m); COMB_FINISH(rB0, wB0, gB0, m + NGW);
        if (m2 < T) { COMB_LOAD(rA0, wA0, gA0, m2, asA0, gtA0); COMB_LOAD(rB0, wB0, gB0, m2 + NGW, asB0, gtB0);
            if (m2 + 2 * TRIP < T) { COMB_AS(asA0, gtA0, m2 + 2 * TRIP); COMB_AS(asB0, gtB0, m2 + 2 * TRIP + NGW); } }
        if (m1 < T) { COMB_FINISH(rA1, wA1, gA1, m1); COMB_FINISH(rB1, wB1, gB1, m1 + NGW); }
    }
#undef COMB_AS
#undef COMB_LOAD
#undef COMB_FINISH
}
__device__ __forceinline__ void compress_item(Frame& F, const Args& a, int l, int item) {
    const int which = item >> 7, b = (item >> 6) & 1, g = (item >> 5) & 1, n0 = (item & 31) * 16;
    const int lane = F.lane, w = F.wave, r16 = lane & 15, kg = lane >> 4;
    const bf16_t* src = WSP(bf16_t, which ? WS_VC : WS_KC);
    const bf16_t* W1 = WSP(bf16_t, WS_CW1) + (size_t)(l * 2 + which) * 64 * 2048;
    LAS float* red = (LAS float*)F.lds;
    LAS float* hid = (LAS float*)(F.lds + 32768);
    f32x4 acc[4];
#pragma unroll
    for (int i = 0; i < 4; ++i) acc[i] = (f32x4){0.f, 0.f, 0.f, 0.f};
    const int n = n0 + r16; const bool nval = n < NCMP;
    f32x4 w2r[2];
    { const float* w2 = INP(a, float, which ? I_CW2V : I_CW2K) + (size_t)l * 4096;
#pragma unroll
      for (int i = 0; i < 2; ++i) w2r[i] = ((const f32x4*)w2)[F.tid + NTHREADS * i]; }
    bf16x8 afv[8];
#pragma unroll
    for (int ks = 0; ks < 8; ++ks) { const int k = 256 * w + 32 * ks + 8 * kg; const int li = k >> 6, d = k & 63;
        afv[ks] = (bf16x8){0, 0, 0, 0, 0, 0, 0, 0};
        if (nval) afv[ks] = *(const bf16x8*)(src + ((size_t)b * SEQ + 16 * n + li) * 128 + g * 64 + d); }
#pragma unroll
    for (int ks = 0; ks < 8; ++ks) { const int k = 256 * w + 32 * ks + 8 * kg;
        const bf16x8 af = afv[ks];
#pragma unroll
        for (int nt = 0; nt < 4; ++nt) { const bf16x8 bf = *(const bf16x8*)(W1 + (size_t)(nt * 16 + r16) * 2048 + k); acc[nt] = __builtin_amdgcn_mfma_f32_16x16x32_bf16(af, bf, acc[nt], 0, 0, 0); } }
#pragma unroll
    for (int nt = 0; nt < 4; ++nt)
#pragma unroll
        for (int i = 0; i < 4; ++i) red[(w * 16 + 4 * kg + i) * 64 + nt * 16 + r16] = acc[nt][i];
    { LAS f32x4* w2s4 = (LAS f32x4*)(F.lds + 40960);
#pragma unroll
      for (int i = 0; i < 2; ++i) w2s4[F.tid + NTHREADS * i] = w2r[i]; }
    __syncthreads();
    const float* cb = WSP(float, WS_MISC) + (l * 2 + which) * 64;
    for (int i = F.tid; i < 1024; i += NTHREADS) { float s = cb[i & 63];
#pragma unroll
        for (int ww = 0; ww < 8; ++ww) s += red[ww * 1024 + i];
        hid[i] = gelu_tanh(s); }
    __syncthreads();
    {
        const int nn = F.tid >> 5, c = F.tid & 31; LAS float* w2s = (LAS float*)(F.lds + 40960);
        float o1 = 0.f, o2 = 0.f;
#pragma unroll 16
        for (int k = 0; k < 64; ++k) { const float h = hid[nn * 64 + k]; o1 += h * w2s[k * 64 + c]; o2 += h * w2s[k * 64 + c + 32]; }
        const int np = n0 + nn; float nsq_ = 0.f;
        if (np < NCMP) {
            if (!which) { const float* cs = WSP(float, WS_ROPE) + (((size_t)b * SEQ + 16 * np + 31) * 32 + c) * 2; const float cc = cs[0], ss = cs[1];
                const float r1 = o1 * cc - o2 * ss, r2 = o2 * cc + o1 * ss;
                bf16_t* img = WSP(bf16_t, WS_KCMP) + (size_t)(b * 2 + g) * 512 * 64; img[kfrag_off(np, c >> 3) + (c & 7)] = (bf16_t)(cvtpk(r1, 0.f) & 0xffffu); img[kfrag_off(np, 4 + (c >> 3)) + (c & 7)] = (bf16_t)(cvtpk(r2, 0.f) & 0xffffu);
                nsq_ = r1 * r1 + r2 * r2;
            } else { bf16_t* img = WSP(bf16_t, WS_VCT) + (size_t)(b * 2 + g) * 512 * 64; img[vfrag_off(np, c)] = (bf16_t)(cvtpk(o1, 0.f) & 0xffffu); img[vfrag_off(np, c + 32)] = (bf16_t)(cvtpk(o2, 0.f) & 0xffffu); }
        }
        if (!which) {
            float mx = quad_sum(nsq_);
            mx += __uint_as_float(__builtin_amdgcn_update_dpp(0u, __float_as_uint(mx), 0x141, 0xF, 0xF, true)); mx += __uint_as_float(__builtin_amdgcn_update_dpp(0u, __float_as_uint(mx), 0x140, 0xF, 0xF, true));
            mx = x16_sum(mx);
            mx = x32_max(mx);
            if (F.lane == 0) atomicMax(F.ctl + CW_KMAX + l * 16 + 12 + b * 2 + g, __float_as_uint(mx * 1.02f));
        }
    }
    __syncthreads();
}
__device__ __forceinline__ void sgu_item(Frame& F, const Args& a, int l, int ch) {
    const size_t tok0 = (size_t)ch * 128;
    const int lane = F.lane, w = F.wave, r16 = lane & 15, kg = lane >> 4;
    const bf16_t* VG = WSP(bf16_t, WS_VG); const bf16_t* UG = WSP(bf16_t, WS_UG); bf16_t* Y = WSP(bf16_t, WS_Y);
    LAS float* stats = (LAS float*)F.lds;
    LAS bf16_t* vnT = (LAS bf16_t*)(F.lds + 1024);
    constexpr int VP = 136;
    static_assert(1024 + 8 * 64 * 136 * 2 <= ATT_LDS_BYTES, "SGU LDS map");
    u32x2 ugv[8][4];
#pragma unroll
    for (int tt = 0; tt < 8; ++tt)
#pragma unroll
        for (int dt = 0; dt < 4; ++dt) ugv[tt][dt] = *(const u32x2*)(UG + (tok0 + 16 * tt + r16) * 512 + w * 64 + dt * 16 + 4 * kg);
    {
        u32x4 vrow[16];
#pragma unroll
        for (int tt = 0; tt < 16; ++tt) vrow[tt] = *(const u32x4*)(VG + (tok0 + 16 * w + tt) * 512 + lane * 8);
#pragma unroll
        for (int tt = 0; tt < 16; ++tt) { const int s = 16 * w + tt; const u32x4 v = vrow[tt];
            const float f[8] = {bflo(v.x), bfhi(v.x), bflo(v.y), bfhi(v.y), bflo(v.z), bfhi(v.z), bflo(v.w), bfhi(v.w)};
            float sm = 0.f;
#pragma unroll
            for (int i = 0; i < 8; ++i) sm += f[i];
            const float mu = wave_sum(sm) * (1.f / 512.f); float q = 0.f;
#pragma unroll
            for (int i = 0; i < 8; ++i) q += (f[i] - mu) * (f[i] - mu);
            const float var = wave_sum(q) * (1.f / 512.f);
            if (lane == 0) { stats[2 * s] = mu; stats[2 * s + 1] = 1.f / sqrtf(var + NORM_EPS); } }
    }
    __syncthreads();
    {
        const int s = F.tid & 127, hq = F.tid >> 7; const float mu = stats[2 * s], rs = stats[2 * s + 1];
#pragma unroll
        for (int hp = 0; hp < 2; ++hp) { const int h = hq + 4 * hp; const int cbase = h * 64;
            const float* lg = INP(a, float, I_SGLNG) + l * 512 + cbase; const float* lb = INP(a, float, I_SGLNB) + l * 512 + cbase;
            u32x4 vv[8];
#pragma unroll
            for (int j = 0; j < 8; ++j) vv[j] = *(const u32x4*)(VG + (tok0 + s) * 512 + cbase + 8 * j);
#pragma unroll
            for (int d0 = 0; d0 < 64; d0 += 8) { const u32x4 v = vv[d0 >> 3];
                const float f[8] = {bflo(v.x), bfhi(v.x), bflo(v.y), bfhi(v.y), bflo(v.z), bfhi(v.z), bflo(v.w), bfhi(v.w)};
#pragma unroll
                for (int i = 0; i < 8; ++i) vnT[(h * 64 + d0 + i) * VP + s] = (bf16_t)(cvtpk((f[i] - mu) * rs * lg[d0 + i] + lb[d0 + i], 0.f) & 0xffffu); } }
    }
    __syncthreads();
    {
        const int h = w;
        const bf16_t* Wm = WSP(bf16_t, WS_SGW) + (size_t)(l * 8 + h) * 128 * 128; const float* bs = INP(a, float, I_SGB) + (size_t)(l * 8 + h) * 128;
#pragma unroll
        for (int tt = 0; tt < 8; ++tt) {
            const int t = 16 * tt + r16; const float bb = bs[t];
            bf16x8 bw[4];
#pragma unroll
            for (int ks = 0; ks < 4; ++ks) bw[ks] = *(const bf16x8*)(Wm + (size_t)t * 128 + 32 * ks + 8 * kg);
            f32x4 acc[4];
#pragma unroll
            for (int i = 0; i < 4; ++i) acc[i] = (f32x4){0.f, 0.f, 0.f, 0.f};
            const int nks = (16 * tt + 15) / 32 + 1;
#pragma unroll
            for (int ks = 0; ks < 4; ++ks) { if (ks < nks) {
#pragma unroll
                for (int dt = 0; dt < 4; ++dt) { const bf16x8 afr = *(const LAS bf16x8*)(vnT + (h * 64 + dt * 16 + r16) * VP + 32 * ks + 8 * kg); acc[dt] = __builtin_amdgcn_mfma_f32_16x16x32_bf16(afr, bw[ks], acc[dt], 0, 0, 0); } } }
#pragma unroll
            for (int dt = 0; dt < 4; ++dt) { const u32x2 uu = ugv[tt][dt];
                u32x2 o; o.x = cvtpk(bflo(uu.x) * (acc[dt][0] + bb), bfhi(uu.x) * (acc[dt][1] + bb)); o.y = cvtpk(bflo(uu.y) * (acc[dt][2] + bb), bfhi(uu.y) * (acc[dt][3] + bb));
                *(u32x2*)(Y + (tok0 + t) * 1024 + h * 64 + dt * 16 + 4 * kg) = o; }
        }
    }
    __syncthreads();
}
namespace att {
constexpr int OSP = 65;
constexpr int L_OH = 0;
constexpr int L_OL = 66560;
constexpr int L_LS = 133120;
constexpr int L_MREF = L_LS + 2048;
constexpr int USP = 129;
constexpr int L_SEL = L_MREF + 1024;
constexpr int L_CNT = L_SEL + 1024;
constexpr int L_LIST = L_CNT + 512;
constexpr int L_WCTR = L_LIST + 8192;
static_assert(L_WCTR + 16 <= ATT_LDS_BYTES, "attention LDS map");

struct Ptrs { const bf16_t *Q, *KS, *KW, *VST, *VWT, *KCMP, *VCT; const float* GATES; bf16_t* Y; float* YPART; float kmax, vmax, kwmax, kcmax; };

#define MFMA16(a, b, c) __builtin_amdgcn_mfma_f32_16x16x32_bf16(a, b, c, 0, 0, 0)

__device__ __forceinline__ void attn_unit(Frame& F, const Ptrs& P, int b, int g, int qb) {
    LAS unsigned char* lds = F.lds;
    const int tid = F.tid, lane = F.lane, w = F.wave, r16 = lane & 15, kg = lane >> 4;
    LAS int* Oh = (LAS int*)(lds + L_OH); LAS int* Ol = (LAS int*)(lds + L_OL); LAS float* imp = (LAS float*)(lds + L_OH);
    LAS int* lsel = (LAS int*)(lds + L_LS); LAS float* mref = (LAS float*)(lds + L_MREF);
    LAS unsigned* selm = (LAS unsigned*)(lds + L_SEL); LAS int* cnts = (LAS int*)(lds + L_CNT); LAS unsigned char* lists = lds + L_LIST; LAS int* wctr = (LAS int*)(lds + L_WCTR);
    const size_t tokb = (size_t)b * SEQ; const int t0 = qb * 64;
    const bf16_t* Qg = P.Q + (tokb + t0) * 512 + g * 256;
    LAS float* U = (LAS float*)(lds + L_OH); LAS float* linvc = (LAS float*)(lds + L_LS);
    {
        const int q = tid >> 3, part = tid & 7, hd = part >> 1, hf = part & 1;
        const u32x4* src = (const u32x4*)(Qg + (size_t)q * 512 + part * 32);
        float ss = 0.f;
#pragma unroll
        for (int i = 0; i < 4; ++i) { const u32x4 v = src[i]; const float f[8] = {bflo(v.x), bfhi(v.x), bflo(v.y), bfhi(v.y), bflo(v.z), bfhi(v.z), bflo(v.w), bfhi(v.w)};
#pragma unroll
            for (int k = 0; k < 8; ++k) ss += f[k] * f[k]; }
        ss += __uint_as_float(__builtin_amdgcn_update_dpp(0u, __float_as_uint(ss), 0xB1, 0xF, 0xF, true));
        if (hf == 0) mref[q * 4 + hd] = sqrtf(ss);
        { u32x4 zz_ = {0u, 0u, 0u, 0u}; asm volatile("" : "+v"(zz_)); LAS u32x4* z4 = (LAS u32x4*)U; for (int i = tid; i < (256 * USP) / 4; i += NTHREADS) z4[i] = zz_; }
    }
    __syncthreads();
    const int hl = r16 & 3;
#define ATT_LDK(dst, base, key0) do { const char* kb_ = (const char*)(base) + (size_t)(key0) * 128; _Pragma("unroll") for (int u_ = 0; u_ < 2; ++u_) _Pragma("unroll") for (int ks_ = 0; ks_ < 2; ++ks_) \
        dst[u_][ks_] = *(const bf16x8*)(kb_ + koff + (u_ * 2 + ks_) * 1024); } while (0)
#define ATT_LDV(dst, vbase, LEN, key0) do { const char* vb_ = (const char*)(vbase) + (size_t)(key0) * 128; _Pragma("unroll") for (int dt_ = 0; dt_ < 4; ++dt_) \
        dst[dt_] = *(const bf16x8*)(vb_ + koff + dt_ * 1024); } while (0)
#define ATT_SHADOW() int ln_ = F.lane; asm volatile("" : "+v"(ln_)); const int r16 = ln_ & 15, kg = ln_ >> 4, hl = r16 & 3; const unsigned koff = (unsigned)ln_ * 16u
    {
        ATT_SHADOW();
        bf16x8 qf[2][2]; float mrc[2], lpart[2], carry[2] = {0.f, 0.f}; int nlim[2]; f32x4 o[2][4];
#pragma unroll
        for (int rt = 0; rt < 2; ++rt) { const int q = 8 * w + 4 * rt + (r16 >> 2);
#pragma unroll
            for (int ks = 0; ks < 2; ++ks) qf[rt][ks] = *(const bf16x8*)(Qg + (size_t)q * 512 + hl * 64 + ks * 32 + kg * 8);
            mrc[rt] = -(mref[q * 4 + hl] * P.kcmax); lpart[rt] = 0.f; nlim[rt] = (t0 + q - 31) >> 4;
#pragma unroll
            for (int dt = 0; dt < 4; ++dt) o[rt][dt] = (f32x4){0.f, 0.f, 0.f, 0.f}; }
        const int nkeys = 4 * qb + 3, NP = (nkeys + 31) >> 5;
        const int nlim_min = (t0 + 8 * w - 31) >> 4;
        const bf16_t* Kc = P.KCMP + (size_t)(b * 2 + g) * 512 * 64; const bf16_t* Vc = P.VCT + (size_t)(b * 2 + g) * 64 * 512;
#define ATT_S1_STEP(KF, VF, s_) do { _Pragma("unroll") for (int rt = 0; rt < 2; ++rt) { \
            f32x4 st[2]; float p[2][4]; \
            _Pragma("unroll") for (int u = 0; u < 2; ++u) { st[u] = MFMA16(KF[u][0], qf[rt][0], ((f32x4){mrc[rt], mrc[rt], mrc[rt], mrc[rt]})); st[u] = MFMA16(KF[u][1], qf[rt][1], st[u]); } \
            _Pragma("unroll") for (int u = 0; u < 2; ++u) _Pragma("unroll") for (int i = 0; i < 4; ++i) p[u][i] = fast_exp2(st[u][i]); \
            if (32 * (s_) + 31 > nlim_min) { _Pragma("unroll") for (int u = 0; u < 2; ++u) _Pragma("unroll") for (int i = 0; i < 4; ++i) { const int n = 32 * (s_) + 8 * kg + 4 * u + i; if (n > nlim[rt]) p[u][i] = 0.f; } } \
            const float s01 = (p[0][0] + p[0][1]) + (p[0][2] + p[0][3]), s11 = (p[1][0] + p[1][1]) + (p[1][2] + p[1][3]); lpart[rt] += s01 + s11; \
            {   \
                \
              const unsigned x_ = __float_as_uint(p[1][3]); const auto s16_ = __builtin_amdgcn_permlane16_swap(x_, x_, false, false); const auto s32_ = __builtin_amdgcn_permlane32_swap(s16_[1], s16_[1], false, false); \
              const float inc_ = (kg & 1) ? __uint_as_float(s16_[0]) : ((kg == 2) ? __uint_as_float(s32_[0]) : carry[rt]); carry[rt] = __uint_as_float(s32_[1]); \
              LAS float* ur = U + ((8 * w + 4 * rt + (r16 >> 2)) * 4 + hl) * USP + 8 * (s_) + 2 * kg; \
              ur[0] += (2.f * s01 - p[0][3]) + inc_; ur[1] += (2.f * s11 - p[1][3]) + p[0][3]; } \
            u32x4 pw; pw.x = cvtpk(p[0][0], p[0][1]); pw.y = cvtpk(p[0][2], p[0][3]); pw.z = cvtpk(p[1][0], p[1][1]); pw.w = cvtpk(p[1][2], p[1][3]); \
            const bf16x8 pf = __builtin_bit_cast(bf16x8, pw); \
            _Pragma("unroll") for (int dt = 0; dt < 4; ++dt) o[rt][dt] = MFMA16(VF[dt], pf, o[rt][dt]); } } while (0)
        {
            bf16x8 kA[2][2], vA[4], kB[2][2], vB[4];
            ATT_LDK(kA, Kc, 0); ATT_LDV(vA, Vc, 512, 0); if (NP > 1) { ATT_LDK(kB, Kc, 32); ATT_LDV(vB, Vc, 512, 32); }
#pragma nounroll
            for (int s2 = 0; s2 < NP; s2 += 2) {
                ATT_S1_STEP(kA, vA, s2);
                if (s2 + 2 < NP) { ATT_LDK(kA, Kc, 32 * (s2 + 2)); ATT_LDV(vA, Vc, 512, 32 * (s2 + 2)); }
                if (s2 + 1 < NP) { ATT_S1_STEP(kB, vB, s2 + 1);
                    if (s2 + 3 < NP) { ATT_LDK(kB, Kc, 32 * (s2 + 3)); ATT_LDV(vB, Vc, 512, 32 * (s2 + 3)); } }
            }
        }
#undef ATT_S1_STEP
#pragma unroll
        for (int rt = 0; rt < 2; ++rt) { const int q = 8 * w + 4 * rt + (r16 >> 2); const float lrow = kg_sum(lpart[rt]); const float linv = lrow > 0.f ? 1.f / lrow : 0.f;
            if (kg == 0) linvc[q * 4 + hl] = linv;
            const float gc = P.GATES[(tokb + t0 + q) * 24 + (g * 4 + hl) * 3 + 0] * linv;
            float* yp = P.YPART + (tokb + t0 + q) * 512 + (g * 4 + hl) * 64 + 4 * kg;
#pragma unroll
            for (int dt = 0; dt < 4; ++dt) *(f32x4*)(yp + dt * 16) = o[rt][dt] * gc; }
    }
    LDS_WAIT();
#pragma nounroll
    for (int qg = 0; qg < 2; ++qg) {
        if (qb <= 15) {
            if (lane < 4) { const int q = 8 * w + 4 * qg + lane; const unsigned long long m0 = (1ull << (qb + 1)) - 1ull;
                selm[q * 4 + 0] = (unsigned)m0; selm[q * 4 + 1] = (unsigned)(m0 >> 32); selm[q * 4 + 2] = 0u; selm[q * 4 + 3] = 0u; }
        } else {
            const int j0 = lane, j1 = lane + 64; int v0[4], v1[4], thr[4];
#pragma unroll
            for (int k = 0; k < 4; ++k) { const int q = 8 * w + 4 * qg + k; const LAS float* ur = U + (q * 4) * USP; const LAS float* li = linvc + q * 4;
                float i0 = 0.f, i1 = 0.f;
#pragma unroll
                for (int h = 0; h < 4; ++h) { i0 += ur[h * USP + j0] * li[h]; i1 += ur[h * USP + j1] * li[h]; }
                v0[k] = (j0 >= 1 && j0 <= qb - 2) ? (int)__float_as_uint(i0) : -1;
                v1[k] = (j1 <= qb - 2) ? (int)__float_as_uint(i1) : -1; thr[k] = 0; }
            int done_ = 0;
#pragma nounroll
            for (int bit = 30; bit >= 0; --bit) {
                const int c0_ = thr[0] | (1 << bit), c1_ = thr[1] | (1 << bit), c2_ = thr[2] | (1 << bit), c3_ = thr[3] | (1 << bit);
                const unsigned long long a0_ = __ballot(v0[0] >= c0_), a1_ = __ballot(v0[1] >= c1_), a2_ = __ballot(v0[2] >= c2_), a3_ = __ballot(v0[3] >= c3_);
                const unsigned long long b0_ = __ballot(v1[0] >= c0_), b1_ = __ballot(v1[1] >= c1_), b2_ = __ballot(v1[2] >= c2_), b3_ = __ballot(v1[3] >= c3_);
                asm volatile("" :: "s"(a0_), "s"(a1_), "s"(a2_), "s"(a3_), "s"(b0_), "s"(b1_), "s"(b2_), "s"(b3_));
                const int n0_ = __popcll(a0_) + __popcll(b0_), n1_ = __popcll(a1_) + __popcll(b1_), n2_ = __popcll(a2_) + __popcll(b2_), n3_ = __popcll(a3_) + __popcll(b3_);
                if (n0_ >= 13) thr[0] = c0_;
                if (n1_ >= 13) thr[1] = c1_;
                if (n2_ >= 13) thr[2] = c2_;
                if (n3_ >= 13) thr[3] = c3_;
                done_ |= (n0_ == 13 ? 1 : 0) | (n1_ == 13 ? 2 : 0) | (n2_ == 13 ? 4 : 0) | (n3_ == 13 ? 8 : 0);
                if (done_ == 15) break; }
            const unsigned long long below = (1ull << lane) - 1ull;
#pragma nounroll
            for (int k = 0; k < 4; ++k) {
                const int vv0 = (k == 0) ? v0[0] : (k == 1) ? v0[1] : (k == 2) ? v0[2] : v0[3], vv1 = (k == 0) ? v1[0] : (k == 1) ? v1[1] : (k == 2) ? v1[2] : v1[3];
                const int th = (k == 0) ? thr[0] : (k == 1) ? thr[1] : (k == 2) ? thr[2] : thr[3];
                const bool gt0 = vv0 > th, gt1 = vv1 > th, eq0 = vv0 == th, eq1 = vv1 == th;
                const int need = 13 - (__popcll(__ballot(gt0)) + __popcll(__ballot(gt1)));
                const unsigned long long B0 = __ballot(eq0), B1 = __ballot(eq1);
                const int rk0 = __popcll(B0 & below), rk1 = __popcll(B0) + __popcll(B1 & below);
                unsigned long long m0 = __ballot(gt0 || (eq0 && rk0 < need)), m1 = __ballot(gt1 || (eq1 && rk1 < need));
                m0 |= 1ull;
                if (qb < 64) m0 |= (1ull << qb); else m1 |= (1ull << (qb - 64));
                if (qb - 1 < 64) m0 |= (1ull << (qb - 1)); else m1 |= (1ull << (qb - 65));
                if (lane == 0) { const int q = 8 * w + 4 * qg + k; selm[q * 4 + 0] = (unsigned)m0; selm[q * 4 + 1] = (unsigned)(m0 >> 32); selm[q * 4 + 2] = (unsigned)m1; selm[q * 4 + 3] = (unsigned)(m1 >> 32); } }
        }
    }
    __syncthreads();
    { u32x4 zz_ = {0u, 0u, 0u, 0u}; asm volatile("" : "+v"(zz_)); LAS u32x4* z4 = (LAS u32x4*)Oh; for (int i = tid; i < (2 * 256 * OSP) / 4; i += NTHREADS) z4[i] = zz_; }
    lsel[tid] = 0;
    if (tid == 0) wctr[0] = 0;
    { const unsigned m0 = selm[lane * 4 + (w >> 1)];
#pragma nounroll
      for (int jj = 0; jj < 16; ++jj) { const int j = 16 * w + jj; const bool hit = (j <= qb) && ((m0 >> (16 * (w & 1) + jj)) & 1u);
          const unsigned long long mk = __ballot(hit); if (hit) lists[j * 64 + __popcll(mk & ((1ull << lane) - 1ull))] = (unsigned char)lane;
          if (lane == 0) cnts[j] = __popcll(mk); } }
    __syncthreads();
    for (int rep5 = 0; rep5 < ((ATTREP & 8) ? NREP : 1); ++rep5)
    {
        if (rep5 > 0) { __syncthreads(); if (tid == 0) wctr[0] = 0; __syncthreads(); }
        ATT_SHADOW();
        const bf16_t* Ks = P.KS + (size_t)(b * 2 + g) * SEQ * 64; const bf16_t* Vs = P.VST + (size_t)(b * 2 + g) * 64 * SEQ;
        const float eS = floorf(__log2f(1048576.f / fmaxf(P.vmax, 1e-30f))); const float lsc = exp2f(20.f - eS);
#define ATT_FETCH(idx_) do { int i_ = 0; if (lane == 0) i_ = __hip_atomic_fetch_add(wctr, 1, __ATOMIC_RELAXED, __HIP_MEMORY_SCOPE_WORKGROUP); idx_ = __builtin_amdgcn_readfirstlane(i_); } while (0)
#define ATT_JOF(idx_) (((idx_) == 0) ? 0 : (((idx_) == 1) ? qb : (((idx_) == 2) ? qb - 1 : (idx_) - 2)))
        bf16x8 kn[2][2][2];
        const bf16x8 ones8 = __builtin_bit_cast(bf16x8, (u32x4){0x3f803f80u, 0x3f803f80u, 0x3f803f80u, 0x3f803f80u});
        int idx; ATT_FETCH(idx);
        if (idx <= qb) { const int j = ATT_JOF(idx); ATT_LDK(kn[0], Ks, 64 * j); ATT_LDK(kn[1], Ks, 64 * j + 32); }
#pragma nounroll
        while (idx <= qb) {
            const int j = ATT_JOF(idx);
            bf16x8 kf[2][2][2], vf[2][4];
#pragma unroll
            for (int sp = 0; sp < 2; ++sp) {
#pragma unroll
                for (int u = 0; u < 2; ++u) { kf[sp][u][0] = kn[sp][u][0]; kf[sp][u][1] = kn[sp][u][1]; } }
            ATT_LDV(vf[0], Vs, SEQ, 64 * j); ATT_LDV(vf[1], Vs, SEQ, 64 * j + 32);
            int idx2; ATT_FETCH(idx2);
            if (idx2 <= qb) { const int j2 = ATT_JOF(idx2); ATT_LDK(kn[0], Ks, 64 * j2); ATT_LDK(kn[1], Ks, 64 * j2 + 32); }
            const int cnt = cnts[j];
            const int nch = (cnt + 3) >> 2;
            bf16x8 qn0, qn1; int qnx; bool vnx;
            { const int qs = (r16 >> 2); vnx = qs < cnt; qnx = lists[j * 64 + (vnx ? qs : (cnt > 0 ? cnt - 1 : 0))];
              const bf16_t* qp = Qg + (size_t)qnx * 512 + hl * 64 + kg * 8; qn0 = *(const bf16x8*)qp; qn1 = *(const bf16x8*)(qp + 32); }
#pragma nounroll
            for (int c = 0; c < nch; ++c) {
                const bool valid = vnx; const int q = qnx; const int row = q * 4 + hl; const bf16x8 q0 = qn0, q1 = qn1;
                if (c + 1 < nch) { const int qs = 4 * (c + 1) + (r16 >> 2); vnx = qs < cnt; qnx = lists[j * 64 + (vnx ? qs : cnt - 1)];
                    const bf16_t* qp = Qg + (size_t)qnx * 512 + hl * 64 + kg * 8; qn0 = *(const bf16x8*)qp; qn1 = *(const bf16x8*)(qp + 32); }
                const float nmr = eS - mref[row] * P.kmax; const f32x4 nm4 = {nmr, nmr, nmr, nmr};
                f32x4 o[4], lsum;
                const bool slow = (j == qb) || (4 * c + 4 > cnt);
#define ATT_CHUNK(MASKED) \
                _Pragma("unroll") for (int sp = 0; sp < 2; ++sp) { \
                    f32x4 st[2]; float p[2][4]; \
                    _Pragma("unroll") for (int u = 0; u < 2; ++u) { st[u] = MFMA16(kf[sp][u][0], q0, nm4); st[u] = MFMA16(kf[sp][u][1], q1, st[u]); } \
                    _Pragma("unroll") for (int u = 0; u < 2; ++u) _Pragma("unroll") for (int i = 0; i < 4; ++i) { float e = fast_exp2(st[u][i]); \
                        if (MASKED) { const int kk = 32 * sp + 8 * kg + 4 * u + i; if (!valid || (j == qb && kk > q)) e = 0.f; } p[u][i] = e; } \
                    u32x4 pw; pw.x = cvtpk(p[0][0], p[0][1]); pw.y = cvtpk(p[0][2], p[0][3]); pw.z = cvtpk(p[1][0], p[1][1]); pw.w = cvtpk(p[1][2], p[1][3]); \
                    const bf16x8 pf = __builtin_bit_cast(bf16x8, pw); \
                    lsum = (sp == 0) ? MFMA16(ones8, pf, ((f32x4){0.f, 0.f, 0.f, 0.f})) : MFMA16(ones8, pf, lsum); \
                    _Pragma("unroll") for (int dt = 0; dt < 4; ++dt) o[dt] = (sp == 0) ? MFMA16(vf[0][dt], pf, ((f32x4){0.f, 0.f, 0.f, 0.f})) : MFMA16(vf[1][dt], pf, o[dt]); }
                if (slow) { ATT_CHUNK(true) } else { ATT_CHUNK(false) }
#undef ATT_CHUNK
                const float ps = lsum[0];
                if (valid) {
                    if (kg == 0) { const float xs = ps * lsc, hf_ = __builtin_rintf(xs); __hip_atomic_fetch_add(lsel + row, (int)hf_, __ATOMIC_RELAXED, __HIP_MEMORY_SCOPE_WORKGROUP);
                        __hip_atomic_fetch_add(lsel + 256 + row, (int)((xs - hf_) * 1048576.f), __ATOMIC_RELAXED, __HIP_MEMORY_SCOPE_WORKGROUP); }
#pragma unroll
                    for (int dt = 0; dt < 4; ++dt)
#pragma unroll
                        for (int i = 0; i < 4; i += 2) {
                            const f32x2_t xs = (f32x2_t){o[dt][i], o[dt][i + 1]}; const f32x2_t fr = (f32x2_t){__builtin_amdgcn_fractf(xs.x), __builtin_amdgcn_fractf(xs.y)} * 1048576.f;
                            const int off = row * OSP + dt * 16 + 4 * kg + i;
                            __hip_atomic_fetch_add(Oh + off, cvt_flr(xs.x), __ATOMIC_RELAXED, __HIP_MEMORY_SCOPE_WORKGROUP); __hip_atomic_fetch_add(Ol + off, (int)fr.x, __ATOMIC_RELAXED, __HIP_MEMORY_SCOPE_WORKGROUP);
                            __hip_atomic_fetch_add(Oh + off + 1, cvt_flr(xs.y), __ATOMIC_RELAXED, __HIP_MEMORY_SCOPE_WORKGROUP); __hip_atomic_fetch_add(Ol + off + 1, (int)fr.y, __ATOMIC_RELAXED, __HIP_MEMORY_SCOPE_WORKGROUP); }
                }
            }
            idx = idx2;
        }
    }
    f32x4 yacc[2][4];
    {
        ATT_SHADOW();
        bf16x8 qf[2][2]; float mrw[2]; f32x4 lacc[2]; f32x4 o[2][4];
        const bf16x8 ones8w = __builtin_bit_cast(bf16x8, (u32x4){0x3f803f80u, 0x3f803f80u, 0x3f803f80u, 0x3f803f80u});
#pragma unroll
        for (int rt = 0; rt < 2; ++rt) { const int q = 8 * w + 4 * rt + (r16 >> 2);
#pragma unroll
            for (int ks = 0; ks < 2; ++ks) qf[rt][ks] = *(const bf16x8*)(Qg + (size_t)q * 512 + hl * 64 + ks * 32 + kg * 8);
            mrw[rt] = -(mref[q * 4 + hl] * P.kwmax); lacc[rt] = (f32x4){0.f, 0.f, 0.f, 0.f};
#pragma unroll
            for (int dt = 0; dt < 4; ++dt) o[rt][dt] = (f32x4){0.f, 0.f, 0.f, 0.f}; }
        const bf16_t* Kw = P.KW + (size_t)(b * 2 + g) * SEQ * 64; const bf16_t* Vw = P.VWT + (size_t)(b * 2 + g) * 64 * SEQ;
        const int jlo = qb >= 8 ? qb - 8 : 0; const int nit = 2 * (qb - jlo + 1);
#define ATT_S4_STEP(KF, VF, it_) do { const int jw_ = jlo + ((it_) >> 1), sp_ = (it_) & 1; const int mode_ = (jw_ == qb) ? 1 : ((jw_ == qb - 8) ? 2 : 0); \
        _Pragma("unroll") for (int rt = 0; rt < 2; ++rt) { \
            f32x4 st[2]; float p[2][4]; \
            _Pragma("unroll") for (int u = 0; u < 2; ++u) { st[u] = MFMA16(KF[u][0], qf[rt][0], ((f32x4){mrw[rt], mrw[rt], mrw[rt], mrw[rt]})); st[u] = MFMA16(KF[u][1], qf[rt][1], st[u]); } \
            _Pragma("unroll") for (int u = 0; u < 2; ++u) _Pragma("unroll") for (int i = 0; i < 4; ++i) p[u][i] = fast_exp2(st[u][i]); \
            if (mode_) { const int tq = 8 * w + 4 * rt + (r16 >> 2); \
                _Pragma("unroll") for (int u = 0; u < 2; ++u) _Pragma("unroll") for (int i = 0; i < 4; ++i) { const int kk = 32 * sp_ + 8 * kg + 4 * u + i; const bool vis = (mode_ == 1) ? (kk <= tq) : (kk > tq); if (!vis) p[u][i] = 0.f; } } \
            u32x4 pw; pw.x = cvtpk(p[0][0], p[0][1]); pw.y = cvtpk(p[0][2], p[0][3]); pw.z = cvtpk(p[1][0], p[1][1]); pw.w = cvtpk(p[1][2], p[1][3]); \
            const bf16x8 pf = __builtin_bit_cast(bf16x8, pw); lacc[rt] = MFMA16(ones8w, pf, lacc[rt]); \
            _Pragma("unroll") for (int dt = 0; dt < 4; ++dt) o[rt][dt] = MFMA16(VF[dt], pf, o[rt][dt]); } } while (0)
        {
            bf16x8 kA[2][2], vA[4], kB[2][2], vB[4];
            ATT_LDK(kA, Kw, 64 * jlo); ATT_LDV(vA, Vw, SEQ, 64 * jlo); ATT_LDK(kB, Kw, 64 * jlo + 32); ATT_LDV(vB, Vw, SEQ, 64 * jlo + 32);
#pragma nounroll
            for (int it = 0; it < nit; it += 2) {
                ATT_S4_STEP(kA, vA, it);
                if (it + 2 < nit) { ATT_LDK(kA, Kw, 64 * jlo + 32 * (it + 2)); ATT_LDV(vA, Vw, SEQ, 64 * jlo + 32 * (it + 2)); }
                ATT_S4_STEP(kB, vB, it + 1);
                if (it + 3 < nit) { ATT_LDK(kB, Kw, 64 * jlo + 32 * (it + 3)); ATT_LDV(vB, Vw, SEQ, 64 * jlo + 32 * (it + 3)); }
            }
        }
#undef ATT_S4_STEP
#pragma unroll
        for (int rt = 0; rt < 2; ++rt) { const int q = 8 * w + 4 * rt + (r16 >> 2); const float lw_ = lacc[rt][0];   const float sc = lw_ > 0.f ? P.GATES[(tokb + t0 + q) * 24 + (g * 4 + hl) * 3 + 2] / lw_ : 0.f;
#pragma unroll
            for (int dt = 0; dt < 4; ++dt) yacc[rt][dt] = o[rt][dt] * sc; }
    }
    __syncthreads();
#pragma unroll
    for (int rt = 0; rt < 2; ++rt) { const int q = 8 * w + 4 * rt + (r16 >> 2), row = q * 4 + hl;
        const float lrow = (float)lsel[row] * (1.f / 1048576.f) + (float)lsel[256 + row] * (1.f / 1099511627776.f);
        const float invS1 = exp2f(-floorf(__log2f(1048576.f / fmaxf(P.vmax, 1e-30f))));
        const float sc = lrow > 0.f ? P.GATES[(tokb + t0 + q) * 24 + (g * 4 + hl) * 3 + 1] / lrow * invS1 : 0.f;
        bf16_t* dst = P.Y + (tokb + t0 + q) * 1024 + 512 + (g * 4 + hl) * 64 + 4 * kg;
        const float* yp = P.YPART + (tokb + t0 + q) * 512 + (g * 4 + hl) * 64 + 4 * kg;
#pragma unroll
        for (int dt = 0; dt < 4; ++dt) { const LAS int* oh = Oh + row * OSP + dt * 16 + 4 * kg; const LAS int* ol = Ol + row * OSP + dt * 16 + 4 * kg;
            const f32x4 osel = (f32x4){(float)oh[0] + (float)ol[0] * (1.f / 1048576.f), (float)oh[1] + (float)ol[1] * (1.f / 1048576.f), (float)oh[2] + (float)ol[2] * (1.f / 1048576.f), (float)oh[3] + (float)ol[3] * (1.f / 1048576.f)};
            const f32x4 v = yacc[rt][dt] + *(const f32x4*)(yp + dt * 16) + osel * sc;
            u32x2 o; o.x = cvtpk(v[0], v[1]); o.y = cvtpk(v[2], v[3]); *(u32x2*)(dst + dt * 16) = o; } }
    __syncthreads();
}
#undef MFMA16
#undef ATT_LDK
#undef ATT_LDV
#undef ATT_SHADOW
#undef ATT_FETCH
#undef ATT_JOF
}

__device__ __forceinline__ void phase_n2(Frame& F, const Args& a, int l) {
    const int lane = F.lane, w = F.wave;
    const float* XR = WSP(float, WS_XR); unsigned char* H8 = WSP(unsigned char, WS_H8);
    const float* g = INP(a, float, I_N2G) + l * 1024;
    LAS float* part = (LAS float*)F.lds;
    LAS float* ssqp = (LAS float*)(F.lds + 32768);
    LAS float* lg = (LAS float*)(F.lds + 32768 + 1024);
    int* CNTI = WSP(int, WS_CNTI); int* ASG = WSP(int, WS_ASG); float* G4 = WSP(float, WS_GATE4);
    for (int item = F.vcu; item < T / 64; item += F.G) {
        const int tk0 = item * 64, b = tk0 >> 13; const int tt = w & 1, kq = w >> 1;
        const float* rwp = WSP(float, WS_RWP) + (size_t)(l * 2 + b) * 1024 * 32; const float* rbp = WSP(float, WS_MISC + 4096) + (l * 2 + b) * 32;
        const int i31 = lane & 31, hf = lane >> 5;
        {
            const float* xp = XR + (size_t)(tk0 + tt * 32 + i31) * DM + kq * 256 + 4 * hf; const float* wp = rwp + (size_t)(kq * 256 + 4 * hf) * 32 + i31;
            f32x16 acc;
#pragma unroll
            for (int r = 0; r < 16; ++r) acc[r] = 0.f;
            float ssq = 0.f;
#pragma nounroll
            for (int bt = 0; bt < 4; ++bt) {
                f32x4 xv[8]; float wv[8][4];
#pragma unroll
                for (int s = 0; s < 8; ++s) { xv[s] = *(const f32x4*)(xp + 8 * (bt * 8 + s)); const float* wq = wp + (size_t)(8 * (bt * 8 + s)) * 32;
                    wv[s][0] = wq[0]; wv[s][1] = wq[32]; wv[s][2] = wq[64]; wv[s][3] = wq[96]; }
#pragma unroll
                for (int s = 0; s < 8; ++s) { ssq += (xv[s].x * xv[s].x + xv[s].y * xv[s].y) + (xv[s].z * xv[s].z + xv[s].w * xv[s].w);
                    acc = __builtin_amdgcn_mfma_f32_32x32x2f32(xv[s].x, wv[s][0], acc, 0, 0, 0); acc = __builtin_amdgcn_mfma_f32_32x32x2f32(xv[s].y, wv[s][1], acc, 0, 0, 0);
                    acc = __builtin_amdgcn_mfma_f32_32x32x2f32(xv[s].z, wv[s][2], acc, 0, 0, 0); acc = __builtin_amdgcn_mfma_f32_32x32x2f32(xv[s].w, wv[s][3], acc, 0, 0, 0); }
            }
            ssq += __shfl_xor(ssq, 32);
            if (hf == 0) ssqp[kq * 64 + tt * 32 + i31] = ssq;
#pragma unroll
            for (int r = 0; r < 16; ++r) { const int tk = (r & 3) + 8 * (r >> 2) + 4 * hf; part[(w * 32 + tk) * 32 + i31] = acc[r]; }
        }
        __syncthreads();
        for (int i = F.tid; i < 64 * 32; i += NTHREADS) { const int tk = i >> 5, e = i & 31, t2 = tk >> 5, tl = tk & 31;
            const float sq = (ssqp[tk] + ssqp[64 + tk]) + (ssqp[128 + tk] + ssqp[192 + tk]); const float rstd = 1.f / sqrtf(sq * (1.f / DM) + NORM_EPS);
            const float v = (part[((0 * 2 + t2) * 32 + tl) * 32 + e] + part[((1 * 2 + t2) * 32 + tl) * 32 + e]) + (part[((2 * 2 + t2) * 32 + tl) * 32 + e] + part[((3 * 2 + t2) * 32 + tl) * 32 + e]);
            lg[tk * 33 + e] = v * rstd + rbp[e]; }
        __syncthreads();
        if (w < 2) {
            const int it = item * 2 + w;
            float v0 = -INFINITY, v1 = -INFINITY, v2 = -INFINITY, v3 = -INFINITY; int i0 = -1, i1 = -1, i2 = -1, i3 = -1;
            if (lane < 32) {
#pragma unroll 8
                for (int e = 0; e < 32; ++e) { const float v = lg[(w * 32 + lane) * 33 + e];
                    if (v > v3) { if (v > v2) { v3 = v2; i3 = i2; if (v > v1) { v2 = v1; i2 = i1; if (v > v0) { v1 = v0; i1 = i0; v0 = v; i0 = e; } else { v1 = v; i1 = e; } } else { v2 = v; i2 = e; } } else { v3 = v; i3 = e; } } }
            }
            const float e1 = __expf(v1 - v0), e2 = __expf(v2 - v0), e3 = __expf(v3 - v0); const float inv = 1.f / (1.f + e1 + e2 + e3);
            int r0 = 0, r1 = 0, r2 = 0, r3 = 0, mycnt = 0;
            for (int e = 0; e < 32; ++e) { const bool hit = (i0 == e) | (i1 == e) | (i2 == e) | (i3 == e); const unsigned long long U = __ballot(hit);
                const int rk = __popcll(U & ((1ull << lane) - 1ull));
                if (i0 == e) r0 = rk; if (i1 == e) r1 = rk; if (i2 == e) r2 = rk; if (i3 == e) r3 = rk;
                if (lane == e) mycnt = __popcll(U); }
            if (lane < 32) { const int tk = tk0 + w * 32 + lane; CNTI[it * 32 + lane] = mycnt;
                if (mycnt > 0) { atomicAdd(F.ctl + CW_GCNT + (l * 32 + (it >> 4)) * 32 + lane, (unsigned)mycnt); atomicAdd(F.ctl + CW_CNT + l * 32 + lane, (unsigned)mycnt); }
                *(int4*)(ASG + tk * 4) = make_int4((i0 << 16) | r0, (i1 << 16) | r1, (i2 << 16) | r2, (i3 << 16) | r3);
                *(f32x4*)(G4 + tk * 4) = (f32x4){inv, e1 * inv, e2 * inv, e3 * inv}; }
        }
        {
            f32x4 pa[4], ph[4];
#pragma unroll
            for (int j = 0; j < 4; ++j) { const f32x4 gg = ((const f32x4*)g)[lane + 64 * j], ss = ((const f32x4*)MODP(l, b, 4))[lane + 64 * j]; pa[j] = gg * (ss + 1.f); ph[j] = ((const f32x4*)MODP(l, b, 3))[lane + 64 * j]; }
            const int nr = (w < 2) ? 4 : (w < 4 ? 10 : 9), r0 = (w < 2) ? 4 * w : (w < 4 ? 8 + 10 * (w - 2) : 28 + 9 * (w - 4));
#pragma unroll 2
            for (int rr = 0; rr < nr; ++rr) { const int m = tk0 + r0 + rr; const RowV r = row_load(XR + (size_t)m * DM, lane);
                const float rstd = 1.f / sqrtf(row_ssq(r) * (1.f / DM) + NORM_EPS);
                row_norm_store8p(r, rstd, pa, ph, H8 + (size_t)m * DM, lane); }
        }
        __syncthreads();
    }
}

__device__ __forceinline__ void phase_n2b(Frame& F, int l) {
    const int gw = F.vcu * NWAVES + F.wave, NGW = F.G * NWAVES; const int lane = F.lane;
    const int* CNTI = WSP(int, WS_CNTI); int* TOK = WSP(int, WS_TOK); int* ASG = WSP(int, WS_ASG); unsigned* cnt = F.ctl + CW_CNT + l * 32;
    for (int it = gw; it < T / 32; it += NGW) {
        int base = 0;
        {
            const unsigned* gc = F.ctl + CW_GCNT + l * 1024; const int grp = it >> 4, e = lane & 31; int s0 = 0, s1 = 0;
#pragma unroll
            for (int gI = 0; gI < 32; ++gI) { const int v = (int)gc[gI * 32 + e]; s0 += (gI < grp) ? v : 0; }
#pragma unroll
            for (int i = 0; i < 16; ++i) { const int v = CNTI[((grp << 4) + i) * 32 + e]; s1 += (((grp << 4) + i) < it) ? v : 0; }
            base = s0 + s1; }
        { const int tk = it * 32 + (lane & 31); const int4 as = *(const int4*)(ASG + tk * 4); int v[4] = {as.x, as.y, as.z, as.w};
#pragma unroll
            for (int k = 0; k < 4; ++k) { const int e = v[k] >> 16, rk = v[k] & 0xffff; const int sl = __shfl(base, e & 31) + rk; if (lane < 32) TOK[e * 16384 + sl] = tk; v[k] = (e << 16) | sl; }
            if (lane < 32) *(int4*)(ASG + tk * 4) = make_int4(v[0], v[1], v[2], v[3]); }
    }
}

__device__ __forceinline__ void moe_tables(Frame& F, int l, int NT, int& total) {
    LAS int* ust = (LAS int*)(F.lds + MOE_OFF); LAS int* bst = ust + 33; LAS int* cn = bst + 33;
    if (F.tid < 64) { const unsigned* cnt = F.ctl + CW_CNT + l * 32; const int lane = F.tid;
        const int c = (lane < NE) ? (int)cnt[lane] : 0; const int nb = (c + 255) >> 8; int inc = nb;
#pragma unroll
        for (int o = 1; o < 32; o <<= 1) { const int t = __shfl_up(inc, o); if ((lane & 31) >= o) inc += t; }
        if (lane < NE) { bst[lane] = inc - nb; ust[lane] = (inc - nb) * NT; cn[lane] = c; if (lane == NE - 1) { bst[NE] = inc; ust[NE] = inc * NT; } } }
    __syncthreads();
    total = ust[NE];
}

constexpr int PH_PROLOGUE = 0, PH_N1 = 1, PH_LAYER0 = 2, PH_PER_LAYER = 9, NPHASES = PH_LAYER0 + DEPTH * PH_PER_LAYER;
__global__ void __launch_bounds__(NTHREADS, 2) fwd_kernel(Args args) {
    extern __shared__ __attribute__((aligned(16))) unsigned char lds_raw[];
    Frame F;
    F.lds = (LAS unsigned char*)lds_raw; F.ws = args.ws; F.ctl = (unsigned*)(args.ws + WS_CTL);
    F.tid = threadIdx.x; F.lane = F.tid & 63; F.wave = __builtin_amdgcn_readfirstlane(F.tid >> 6);
    F.G = gridDim.x; { const int bx = blockIdx.x; F.vcu = (F.G % 8 == 0) ? (bx % 8) * (F.G / 8) + bx / 8 : bx; }
    for (int u = F.tid; u < (LDS_BYTES - LDSCTL_OFF) / 4; u += NTHREADS) ((LAS unsigned*)(F.lds + LDSCTL_OFF))[u] = 0u;
    __syncthreads();
    volatile LAS unsigned* MISC = (volatile LAS unsigned*)(F.lds + MISC_OFF);
    XcdBarrier bar; bar.bar = F.ctl + CW_BAR; bar.x = 0; bar.st = nullptr;
#if !MK_PER_PHASE
    bar = xcd_barrier_post(F.ctl + CW_BAR, MISC + 8);
#endif
    const int lo = args.ph_lo, hi = args.ph_hi;
#define IN(k) (lo <= (k) && (k) < hi)
#define REFRESH() do { int t_ = threadIdx.x; asm volatile("" : "+v"(t_)); F.tid = t_; F.lane = t_ & 63; F.wave = __builtin_amdgcn_readfirstlane(t_ >> 6); } while (0)
#define SEAM(k) do { if (IN(k) && IN((k) + 1)) xcd_barrier(bar); } while (0)
#define REPS(bit, idem) (((REPMASK & (bit)) && (idem)) ? NREP : 1)

    if (IN(PH_PROLOGUE) && !(SKIPMASK & 1)) for (int rep = 0; rep < REPS(1, true); ++rep) { REFRESH(); phase_prologue(F, args); } SEAM(PH_PROLOGUE);
    if (IN(PH_N1) && !(SKIPMASK & 2)) for (int rep = 0; rep < REPS(2, true); ++rep) { REFRESH(); phase_n1_first(F, args); } SEAM(PH_N1);
    for (int l = 0; l < DEPTH; ++l) {
        const int p0 = PH_LAYER0 + l * PH_PER_LAYER;
        if (IN(p0 + 0) && !(SKIPMASK & 4)) for (int rep = 0; rep < REPS(4, l == 0); ++rep) {
            { pg8::DenseOrder S; S.init(T, 2560, F.G, ({ int b_ = (int)blockIdx.x; asm volatile("" : "+s"(b_)); b_; }));
              EpiProj E{WSP(bf16_t, WS_UG), WSP(bf16_t, WS_VG), WSP(bf16_t, WS_Q), WSP(bf16_t, WS_KC), WSP(bf16_t, WS_VC), WSP(bf16_t, WS_KS), WSP(bf16_t, WS_KW), WSP(bf16_t, WS_VST), WSP(bf16_t, WS_VWT),
                        WSP(float, WS_GATES), WSP(float, WS_ROPE), F.ctl + CW_KMAX + l * 16, 0};
              pg8::gemm_phase<EpiProj, pg8::DenseOrder, false, true, true>(F.lds, WSP(bf16_t, WS_H8), (const bf16_t*)(WSP(unsigned char, WS_WIN8) + (size_t)l * 2560 * 1024), 512, S, E); }
        }
        SEAM(p0 + 0);
        if (IN(p0 + 1) && !(SKIPMASK & 8)) for (int rep = 0; rep < REPS(8, l == 0); ++rep) { REFRESH();
            for (int it = F.vcu; it < 256; it += F.G) { if (it < 128) sgu_item(F, args, l, it); else { compress_item(F, args, l, 2 * (it - 128)); compress_item(F, args, l, 2 * (it - 128) + 1); } }
        }
        SEAM(p0 + 1);
        if (IN(p0 + 2) && !(SKIPMASK & 16)) for (int rep = 0; rep < REPS(16, l == 0); ++rep) { REFRESH();
            att::Ptrs P{WSP(bf16_t, WS_Q), WSP(bf16_t, WS_KS), WSP(bf16_t, WS_KW), WSP(bf16_t, WS_VST), WSP(bf16_t, WS_VWT), WSP(bf16_t, WS_KCMP), WSP(bf16_t, WS_VCT), WSP(float, WS_GATES), WSP(bf16_t, WS_Y), WSP(float, WS_YPART), 0.f};
            for (int it = F.vcu; it < 512; it += F.G) {
                const int uu = (it < 256) ? it : (767 - it);
                const int bg = uu >> 7, qb = uu & 127;
                const unsigned* km = F.ctl + CW_KMAX + l * 16 + bg;
                P.kmax = sqrtf(__uint_as_float(__hip_atomic_load(km, __ATOMIC_RELAXED, __HIP_MEMORY_SCOPE_AGENT)));
                P.vmax = __uint_as_float(__hip_atomic_load(km + 4, __ATOMIC_RELAXED, __HIP_MEMORY_SCOPE_AGENT));
                P.kwmax = sqrtf(__uint_as_float(__hip_atomic_load(km + 8, __ATOMIC_RELAXED, __HIP_MEMORY_SCOPE_AGENT)));
                P.kcmax = sqrtf(__uint_as_float(__hip_atomic_load(km + 12, __ATOMIC_RELAXED, __HIP_MEMORY_SCOPE_AGENT)));
                att::attn_unit(F, P, bg >> 1, bg & 1, qb);
            }
        }
        SEAM(p0 + 2);
        if (IN(p0 + 3) && !(SKIPMASK & 32)) for (int rep = 0; rep < REPS(32, l == 0); ++rep) {
            pg8::DenseOrder S; S.init(T, DM, F.G, ({ int b_ = (int)blockIdx.x; asm volatile("" : "+s"(b_)); b_; }));
            EpiOut E{l == 0 ? INP(args, float, I_X) : WSP(float, WS_XR), WSP(float, WS_XR), (const float*)(F.ctl + CW_MOD) + (size_t)l * 2 * 6144};
            pg8::gemm_phase<EpiOut, pg8::DenseOrder, false, true>(F.lds, WSP(bf16_t, WS_Y), WSP(bf16_t, WS_WOUT) + (size_t)l * 1024 * 1024, 1024, S, E);
        }
        SEAM(p0 + 3);
        if (IN(p0 + 4) && !(SKIPMASK & 64)) for (int rep = 0; rep < REPS(64, l == 0); ++rep) { REFRESH(); phase_n2(F, args, l); }
        SEAM(p0 + 4);
        if (IN(p0 + 5) && !(SKIPMASK & 64)) for (int rep = 0; rep < REPS(1024, l == 0); ++rep) { REFRESH(); phase_n2b(F, l); }
        SEAM(p0 + 5);
        if (IN(p0 + 6) && !(SKIPMASK & 128)) for (int rep = 0; rep < REPS(128, l == 0); ++rep) { REFRESH();
            int total; moe_tables(F, l, 8, total);
            LAS int* ust = (LAS int*)(F.lds + MOE_OFF);
            pg8::MoeOrder S{ust, ust + 33, ust + 66, WSP(int, WS_TOK), 8, F.G, F.vcu, total, 1024};
            EpiSwiglu E{WSP(unsigned char, WS_ACT), INP(args, float, I_EB1) + (size_t)l * NE * 2048};
            pg8::gemm_phase<EpiSwiglu, pg8::MoeOrder, true, true, true>(F.lds, WSP(bf16_t, WS_H8), (const bf16_t*)(WSP(unsigned char, WS_W1T) + (size_t)l * NE * 2048 * 1024), 512, S, E);
        }
        SEAM(p0 + 6);
        if (IN(p0 + 7) && !(SKIPMASK & 256)) for (int rep = 0; rep < REPS(256, l == 0); ++rep) { REFRESH();
            int total; moe_tables(F, l, 4, total);
            LAS int* ust = (LAS int*)(F.lds + MOE_OFF);
            pg8::MoeOrder S{ust, ust + 33, ust + 66, WSP(int, WS_TOK), 4, F.G, F.vcu, total, 1024};
            EpiDown E{WSP(unsigned char, WS_YROWS), INP(args, float, I_EB2) + (size_t)l * NE * 1024};
            pg8::gemm_phase<EpiDown, pg8::MoeOrder, false, true, true>(F.lds, WSP(bf16_t, WS_ACT), (const bf16_t*)(WSP(unsigned char, WS_W2T) + (size_t)l * NE * 1024 * 1024), 512, S, E);
        }
        SEAM(p0 + 7);
        if (IN(p0 + 8) && !(SKIPMASK & 512)) for (int rep = 0; rep < REPS(512, l == DEPTH - 1); ++rep) { REFRESH(); phase_combine(F, args, l); }
        if (l + 1 < DEPTH) SEAM(p0 + 8);
    }
#undef IN
#undef SEAM
}

extern "C" void kernel_launch(void* const* d_in, const int* in_sizes, int n_in, void* d_out, int out_size, void* d_ws, size_t ws_size, hipStream_t stream) {
    static int grid = 0;
    if (grid == 0) {
        if (n_in != 26 || out_size != T * DM || ws_size < WS_END) { fprintf(stderr, "kernel_launch: unexpected problem (n_in %d, out %d, ws %zu; need ws >= %zu)\n", n_in, out_size, ws_size, (size_t)WS_END); grid = -1; return; }
        int dev = 0, cus = 0, per_cu = 0;
        if (hipGetDevice(&dev) != hipSuccess || hipDeviceGetAttribute(&cus, hipDeviceAttributeMultiprocessorCount, dev) != hipSuccess) { grid = -1; return; }
        if (hipFuncSetAttribute((const void*)fwd_kernel, hipFuncAttributeMaxDynamicSharedMemorySize, LDS_BYTES) != hipSuccess) { fprintf(stderr, "kernel_launch: hipFuncSetAttribute failed\n"); grid = -1; return; }
        if (hipOccupancyMaxActiveBlocksPerMultiprocessor(&per_cu, (const void*)fwd_kernel, NTHREADS, LDS_BYTES) != hipSuccess || per_cu < 1) { fprintf(stderr, "kernel_launch: occupancy query says %d\n", per_cu); (void)hipGetLastError(); per_cu = 1; }
        grid = cus;
    }
    if (grid < 0) return;
    if (hipMemsetAsync((char*)d_ws + WS_CTL, 0, CTL_ZERO_BYTES, stream) != hipSuccess) { fprintf(stderr, "kernel_launch: memset failed\n"); return; }
    Args a{};
    for (int i = 0; i < 26; ++i) a.in[i] = d_in[i];
    a.out = (float*)d_out; a.ws = (unsigned char*)d_ws;
#if MK_PER_PHASE
    for (int p = 0; p < NPHASES; ++p) { a.ph_lo = p; a.ph_hi = p + 1; a.li = 0;
        hipLaunchKernelGGL(fwd_kernel, dim3(grid), dim3(NTHREADS), LDS_BYTES, stream, a); }
#else
    a.ph_lo = 0; a.ph_hi = NPHASES; a.li = 0;
    void* kargs[] = {&a};
    hipError_t e = hipLaunchCooperativeKernel((const void*)fwd_kernel, dim3(grid), dim3(NTHREADS), kargs, LDS_BYTES, stream);
    if (e != hipSuccess) fprintf(stderr, "kernel_launch: cooperative launch failed: %s (grid %d)\n", hipGetErrorString(e), grid);
#endif
}
```
